# Optimizing an MI355X kernel written in HIP

```python
import math
import jax
import jax.numpy as jnp
from jax import lax
import numpy as np

D_MODEL = 1024
BATCH = 4
SEQ = 4096
DEPTH = 2

GRID_W = 64

NA_HEADS = 8
NA_HEAD_DIM = 64
NA_WIN_ROWS = 8
NA_WIN_COLS = 16
NA_QBLOCK = 16
NA_KBLOCK = NA_QBLOCK + NA_WIN_COLS
WIDTH_A = NA_HEADS * NA_HEAD_DIM

GLA_HEADS = 4
GLA_DK = 64
GLA_DV = 128
GLA_RANK = 16
GLA_GATE_NORM = 16.0
WIDTH_B = GLA_HEADS * GLA_DV

HGRN_HEADS = 4
HGRN_DIM = 128
WIDTH_C = HGRN_HEADS * HGRN_DIM

SSD_HEADS = 8
SSD_HEAD_DIM = 64
SSD_GROUPS = 2
SSD_STATE = 128
SSD_CONV = 4
SSD_CHUNK = 64
WIDTH_D = SSD_HEADS * SSD_HEAD_DIM
SSD_CONV_CH = WIDTH_D + 2 * SSD_GROUPS * SSD_STATE
CONV_PAD = (SSD_CONV // 2, (SSD_CONV - 1) // 2)

REC_CHUNK = 16

N_EVEN = (DEPTH + 1) // 2
N_ODD = DEPTH // 2
EVEN_SPLITS = (WIDTH_A, WIDTH_A, WIDTH_A, WIDTH_A, GLA_HEADS * GLA_DK, GLA_HEADS * GLA_DK, WIDTH_B, WIDTH_B, GLA_RANK, GLA_RANK)
ODD_SPLITS = (WIDTH_C, WIDTH_C, WIDTH_C, WIDTH_C, WIDTH_C, WIDTH_D, SSD_CONV_CH, SSD_HEADS, SSD_HEADS)
EVEN_IN = 4 * WIDTH_A + 2 * GLA_HEADS * GLA_DK + 2 * WIDTH_B + 2 * GLA_RANK
ODD_IN = 5 * WIDTH_C + WIDTH_D + SSD_CONV_CH + 2 * SSD_HEADS

DEEPNORM_ALPHA = (2 * DEPTH) ** 0.25
DEEPNORM_BETA = (8 * DEPTH) ** -0.25
LN_EPS = 1e-5
RMS_EPS = 1e-6

kernel_name = 'hybrid_na_gla_hgrn2_ssd_encoder'


def split_cols(t, sizes):
    idx = np.cumsum(np.array(sizes))[:-1].tolist()
    return jnp.split(t, idx, axis=-1)


def layer_norm(x, g, b):
    xf = x.astype(jnp.float32)
    mu = jnp.mean(xf, -1, keepdims=True)
    var = jnp.mean(jnp.square(xf - mu), -1, keepdims=True)
    return ((xf - mu) * lax.rsqrt(var + LN_EPS) * g + b).astype(x.dtype)


def rms_norm(x, g):
    xf = x.astype(jnp.float32)
    return xf * lax.rsqrt(jnp.mean(jnp.square(xf), -1, keepdims=True) + RMS_EPS) * g.astype(jnp.float32)


def neighbourhood_attention(q, k, v, rpb):
    bsz, seq, heads, dh = q.shape
    rows = seq // GRID_W
    kr = min(NA_WIN_ROWS, rows)
    ncb = GRID_W // NA_QBLOCK
    r = jnp.arange(rows)
    row_start = jnp.clip(r - kr // 2, 0, rows - kr)
    key_rows = row_start[:, None] + jnp.arange(kr)[None, :]
    blk_start = jnp.clip(jnp.arange(ncb) * NA_QBLOCK - NA_WIN_COLS // 2, 0, GRID_W - NA_KBLOCK)
    key_cols = blk_start[:, None] + jnp.arange(NA_KBLOCK)[None, :]
    q_cols = (jnp.arange(ncb) * NA_QBLOCK)[:, None] + jnp.arange(NA_QBLOCK)[None, :]
    col_start = jnp.clip(q_cols - NA_WIN_COLS // 2, 0, GRID_W - NA_WIN_COLS)
    kc = key_cols[:, None, :]
    cs = col_start[:, :, None]
    col_ok = (kc >= cs) & (kc < cs + NA_WIN_COLS)
    nk = kr * NA_KBLOCK
    valid = jnp.broadcast_to(col_ok[:, :, None, :], (ncb, NA_QBLOCK, kr, NA_KBLOCK)).reshape(ncb, NA_QBLOCK, nk)
    dr_idx = key_rows - r[:, None] + NA_WIN_ROWS - 1
    dc_idx = jnp.clip(kc - q_cols[:, :, None], 1 - NA_WIN_COLS, NA_WIN_COLS - 1) + NA_WIN_COLS - 1
    bias = rpb[:, dr_idx[:, None, None, :, None], dc_idx[None, :, :, None, :]]
    bias = bias.reshape(heads, rows, ncb, NA_QBLOCK, nk).transpose(1, 2, 0, 3, 4).astype(jnp.float32)
    k_grid = k.reshape(bsz, rows, GRID_W, heads, dh)
    v_grid = v.reshape(bsz, rows, GRID_W, heads, dh)
    g_r = key_rows[:, None, :, None]
    g_c = key_cols[None, :, None, :]
    kg = k_grid[:, g_r, g_c].reshape(bsz, rows, ncb, nk, heads, dh)
    vg = v_grid[:, g_r, g_c].reshape(bsz, rows, ncb, nk, heads, dh)
    qb = q.reshape(bsz, rows, ncb, NA_QBLOCK, heads, dh)
    s = jnp.einsum('brnqhd,brnkhd->brnhqk', qb, kg).astype(jnp.float32) * (dh ** -0.5) + bias[None]
    s = jnp.where(valid[None, None, :, None], s, -jnp.inf)
    p = jax.nn.softmax(s, axis=-1).astype(v.dtype)
    o = jnp.einsum('brnhqk,brnkhd->brnqhd', p, vg)
    return o.reshape(bsz, seq, heads, dh)


def chunked_gated_recurrence(q, k, v, log_f):
    bsz, heads, seq, kd = q.shape
    vd = v.shape[-1]
    n = seq // REC_CHUNK
    q, k, log_f = [t.astype(jnp.float32).reshape(bsz, heads, n, REC_CHUNK, kd) for t in (q, k, log_f)]
    v = v.astype(jnp.float32).reshape(bsz, heads, n, REC_CHUNK, vd)
    b = jnp.cumsum(log_f, axis=3)
    mask = jnp.tril(jnp.ones((REC_CHUNK, REC_CHUNK), dtype=bool))
    diff = b[:, :, :, :, None, :] - b[:, :, :, None, :, :]
    decay_ij = jnp.exp(jnp.where(mask[:, :, None], diff, -jnp.inf))
    attn = jnp.einsum('bhnik,bhnjk,bhnijk->bhnij', q, k, decay_ij)
    o = jnp.einsum('bhnij,bhnjv->bhniv', attn, v)
    b_last = b[:, :, :, -1:, :]
    u = jnp.einsum('bhnjk,bhnjv->bhnkv', k * jnp.exp(b_last - b), v)
    chunk_decay = jnp.exp(b_last[:, :, :, 0, :])

    def step(s, inp):
        d, u_n = inp
        return d[..., None] * s + u_n, s

    s0 = jnp.zeros((bsz, heads, kd, vd), jnp.float32)
    _, s_prev = lax.scan(step, s0, (jnp.moveaxis(chunk_decay, 2, 0), jnp.moveaxis(u, 2, 0)))
    s_prev = jnp.moveaxis(s_prev, 0, 2)
    o = o + jnp.einsum('bhnik,bhnkv->bhniv', q * jnp.exp(b), s_prev)
    return o.reshape(bsz, heads, seq, vd)


def bidir_gated_recurrence(q, v, k_fwd, lf_fwd, k_bwd, lf_bwd):
    rev = lambda t: jnp.flip(t, axis=2)
    fwd = chunked_gated_recurrence(q, k_fwd, v, lf_fwd)
    bwd = rev(chunked_gated_recurrence(rev(q), rev(k_bwd), rev(v), rev(lf_bwd)))
    return fwd + bwd


def ssd_chunked(x, a, bm, cm):
    bsz, seq, heads, hp = x.shape
    groups, ns = bm.shape[2], bm.shape[3]
    rep = heads // groups
    n = seq // SSD_CHUNK
    x = x.astype(jnp.float32).reshape(bsz, n, SSD_CHUNK, groups, rep, hp)
    a = a.astype(jnp.float32).reshape(bsz, n, SSD_CHUNK, groups, rep).transpose(0, 3, 4, 1, 2)
    bm = bm.astype(jnp.float32).reshape(bsz, n, SSD_CHUNK, groups, ns)
    cm = cm.astype(jnp.float32).reshape(bsz, n, SSD_CHUNK, groups, ns)
    a_cum = jnp.cumsum(a, axis=-1)
    mask = jnp.tril(jnp.ones((SSD_CHUNK, SSD_CHUNK), dtype=bool))
    seg = jnp.exp(jnp.where(mask, a_cum[..., :, None] - a_cum[..., None, :], -jnp.inf))
    cb = jnp.einsum('bnigs,bnjgs->bgnij', cm, bm)
    y = jnp.einsum('bgnij,bgrnij,bnjgrp->bnigrp', cb, seg, x)
    decay_states = jnp.exp(a_cum[..., -1:] - a_cum)
    states = jnp.einsum('bnjgs,bgrnj,bnjgrp->bngrps', bm, decay_states, x)
    chunk_decay = jnp.exp(a_cum[..., -1])

    def step(s, inp):
        d, st = inp
        return d[..., None, None] * s + st, s

    s0 = jnp.zeros((bsz, groups, rep, hp, ns), jnp.float32)
    _, s_prev = lax.scan(step, s0, (jnp.moveaxis(chunk_decay, 3, 0), jnp.moveaxis(states, 1, 0)))
    s_prev = jnp.moveaxis(s_prev, 0, 1)
    y = y + jnp.einsum('bnigs,bgrni,bngrps->bnigrp', cm, jnp.exp(a_cum), s_prev)
    return y.reshape(bsz, seq, heads, hp)


def even_mixer(h, w_in, rpb, gla_w_up, gla_b, gla_norm_g, w_out):
    bsz, seq, _ = h.shape
    aq, ak, av, ag, bq, bk, bv, bg, lr_f, lr_b = split_cols(h @ w_in, EVEN_SPLITS)

    def heads(t, nh):
        return t.reshape(bsz, seq, nh, -1)

    def bhld(t, nh):
        return heads(t, nh).transpose(0, 2, 1, 3)

    ya = neighbourhood_attention(heads(aq, NA_HEADS), heads(ak, NA_HEADS), heads(av, NA_HEADS), rpb)
    ya = ya.reshape(bsz, seq, WIDTH_A) * jax.nn.silu(ag)

    def log_gate(lr, d):
        z = (lr @ gla_w_up[d] + gla_b[d]).astype(jnp.float32)
        return bhld(jax.nn.log_sigmoid(z) / GLA_GATE_NORM, GLA_HEADS)

    qb = bhld(bq, GLA_HEADS) * (GLA_DK ** -0.5)
    kb = bhld(bk, GLA_HEADS)
    ob = bidir_gated_recurrence(qb, bhld(bv, GLA_HEADS), kb, log_gate(lr_f, 0), kb, log_gate(lr_b, 1))
    ob = rms_norm(ob, gla_norm_g).transpose(0, 2, 1, 3).reshape(bsz, seq, WIDTH_B)
    yb = ob.astype(h.dtype) * jax.nn.silu(bg)
    return jnp.concatenate([ya, yb], axis=-1) @ w_out


def odd_mixer(h, w_in, lb, hgrn_norm_g, conv_w, conv_b, dt_bias, a_log, d_skip, ssm_norm_g, w_out):
    bsz, seq, _ = h.shape
    cq, cf_f, cf_b, ci, cg, dz, dxbc, dt_f, dt_b = split_cols(h @ w_in, ODD_SPLITS)

    def bhld(t, nh):
        return t.reshape(bsz, seq, nh, -1).transpose(0, 2, 1, 3)

    log_lb = jnp.log(lb)
    log_ub = jnp.log1p(-lb)

    def forget(z):
        z = z.astype(jnp.float32)
        log_f = jnp.logaddexp(log_lb, log_ub + jax.nn.log_sigmoid(z))
        k = (1.0 - lb) * jax.nn.sigmoid(-z)
        return bhld(k, HGRN_HEADS), bhld(log_f, HGRN_HEADS)

    k_f, lf_f = forget(cf_f)
    k_b, lf_b = forget(cf_b)
    qc = bhld(cq, HGRN_HEADS) * (HGRN_DIM ** -0.5)
    oc = bidir_gated_recurrence(qc, bhld(ci, HGRN_HEADS), k_f, lf_f, k_b, lf_b)
    oc = rms_norm(oc, hgrn_norm_g).transpose(0, 2, 1, 3).reshape(bsz, seq, WIDTH_C)
    yc = oc.astype(h.dtype) * jax.nn.silu(cg)

    xbc = lax.conv_general_dilated(dxbc, conv_w[:, None, :], (1,), [CONV_PAD],
                                   dimension_numbers=('NWC', 'WIO', 'NWC'),
                                   feature_group_count=SSD_CONV_CH)
    xbc = jax.nn.silu(xbc + conv_b)
    xs, bm, cm = split_cols(xbc, (WIDTH_D, SSD_GROUPS * SSD_STATE, SSD_GROUPS * SSD_STATE))
    xs = xs.reshape(bsz, seq, SSD_HEADS, SSD_HEAD_DIM).astype(jnp.float32)
    bm = bm.reshape(bsz, seq, SSD_GROUPS, SSD_STATE)
    cm = cm.reshape(bsz, seq, SSD_GROUPS, SSD_STATE)

    def dir_inputs(dt_raw, d):
        dt = jax.nn.softplus(dt_raw.astype(jnp.float32) + dt_bias[d].astype(jnp.float32))
        return xs * dt[..., None], dt * (-jnp.exp(a_log[d].astype(jnp.float32)))

    x_fw, a_fw = dir_inputs(dt_f, 0)
    x_bw, a_bw = dir_inputs(dt_b, 1)
    rev = lambda t: jnp.flip(t, axis=1)
    y = (ssd_chunked(x_fw, a_fw, bm, cm)
         + rev(ssd_chunked(rev(x_bw), rev(a_bw), rev(bm), rev(cm)))
         + d_skip.astype(jnp.float32)[:, None] * xs)
    y = rms_norm(y.reshape(bsz, seq, WIDTH_D) * jax.nn.silu(dz.astype(jnp.float32)), ssm_norm_g)
    yd = y.astype(h.dtype)
    return jnp.concatenate([yc, yd], axis=-1) @ w_out


def setup_inputs(seed: int = 0) -> dict:
    key = jax.random.key(seed)
    ks = jax.random.split(key, 24)

    def nrm(k, shape, s):
        return jax.random.normal(k, shape, jnp.float32) * s

    dt0 = jnp.exp(jax.random.uniform(ks[19], (N_ODD, 2, SSD_HEADS), jnp.float32)
                  * (math.log(0.1) - math.log(0.001)) + math.log(0.001))
    return {
        'x': nrm(ks[0], (BATCH, SEQ, D_MODEL), 1.0),
        'c': nrm(ks[1], (BATCH, D_MODEL), 1.0),
        'ada_w': nrm(ks[2], (DEPTH, D_MODEL, 3 * D_MODEL), D_MODEL ** -0.5),
        'ada_b': nrm(ks[3], (DEPTH, 3 * D_MODEL), 0.01),
        'ln_g': 1.0 + nrm(ks[4], (DEPTH, D_MODEL), 0.01),
        'ln_b': nrm(ks[5], (DEPTH, D_MODEL), 0.01),
        'e_w_in': nrm(ks[6], (N_EVEN, D_MODEL, EVEN_IN), D_MODEL ** -0.5),
        'e_rpb': nrm(ks[7], (N_EVEN, NA_HEADS, 2 * NA_WIN_ROWS - 1, 2 * NA_WIN_COLS - 1), 0.05),
        'e_gla_w_up': nrm(ks[8], (N_EVEN, 2, GLA_RANK, GLA_HEADS * GLA_DK), GLA_RANK ** -0.5),
        'e_gla_b': nrm(ks[9], (N_EVEN, 2, GLA_HEADS * GLA_DK), 0.01),
        'e_gla_norm_g': 1.0 + nrm(ks[10], (N_EVEN, GLA_DV), 0.01),
        'e_w_out': nrm(ks[11], (N_EVEN, WIDTH_A + WIDTH_B, D_MODEL), (WIDTH_A + WIDTH_B) ** -0.5 * DEEPNORM_BETA),
        'o_w_in': nrm(ks[12], (N_ODD, D_MODEL, ODD_IN), D_MODEL ** -0.5),
        'hgrn_lb': nrm(ks[13], (DEPTH, WIDTH_C), 1.0),
        'o_hgrn_norm_g': 1.0 + nrm(ks[14], (N_ODD, HGRN_DIM), 0.01),
        'o_conv_w': nrm(ks[15], (N_ODD, SSD_CONV, SSD_CONV_CH), SSD_CONV ** -0.5),
        'o_conv_b': nrm(ks[16], (N_ODD, SSD_CONV_CH), 0.01),
        'o_dt_bias': dt0 + jnp.log(-jnp.expm1(-dt0)),
        'o_a_log': jnp.log(jax.random.uniform(ks[17], (N_ODD, 2, SSD_HEADS), jnp.float32, 1.0, 16.0)),
        'o_d_skip': 1.0 + nrm(ks[18], (N_ODD, SSD_HEADS), 0.01),
        'o_ssm_norm_g': 1.0 + nrm(ks[20], (N_ODD, WIDTH_D), 0.01),
        'o_w_out': nrm(ks[21], (N_ODD, WIDTH_C + WIDTH_D, D_MODEL), (WIDTH_C + WIDTH_D) ** -0.5 * DEEPNORM_BETA),
    }


def reference(x, c, ada_w, ada_b, ln_g, ln_b, e_w_in, e_rpb, e_gla_w_up, e_gla_b, e_gla_norm_g, e_w_out,
              o_w_in, hgrn_lb, o_hgrn_norm_g, o_conv_w, o_conv_b, o_dt_bias, o_a_log, o_d_skip,
              o_ssm_norm_g, o_w_out):
    lb_cum = jnp.cumsum(jax.nn.softmax(hgrn_lb.astype(jnp.float32), axis=0), axis=0)
    cond = jax.nn.silu(c)
    for l in range(DEPTH):
        mod = cond @ ada_w[l] + ada_b[l]
        shift, scale, gate = jnp.split(mod[:, None, :], 3, axis=-1)
        h = x * (1.0 + scale) + shift
        i = l // 2
        if l % 2 == 0:
            y = even_mixer(h, e_w_in[i], e_rpb[i], e_gla_w_up[i], e_gla_b[i], e_gla_norm_g[i], e_w_out[i])
        else:
            y = odd_mixer(h, o_w_in[i], lb_cum[l] - lb_cum[0], o_hgrn_norm_g[i], o_conv_w[i], o_conv_b[i],
                          o_dt_bias[i], o_a_log[i], o_d_skip[i], o_ssm_norm_g[i], o_w_out[i])
        x = layer_norm(DEEPNORM_ALPHA * x + gate * y, ln_g[l], ln_b[l])
    return x
```

```cpp
#include <hip/hip_runtime.h>
#include <hip/hip_cooperative_groups.h>
#include <cstdio>
namespace cg = cooperative_groups;

typedef unsigned short bf16;
using bf16x8 = __attribute__((ext_vector_type(8))) short;
using f32x4 = __attribute__((ext_vector_type(4))) float;

#define M_TOK 16384
#define DM 1024
#define SEQ 4096
#define EVEN_N 3616
#define EVEN_NP 3712
#define ODD_N 4112
#define ODD_NP 4224
#define ALPHA 1.4142135623730951f

#define WS_MOD 0ull
#define WS_LB (WS_MOD + 98304ull)
#define WS_WEI (WS_LB + 2048ull)
#define WS_WEO (WS_WEI + 3712ull * 2048)
#define WS_WOI (WS_WEO + 1024ull * 2048)
#define WS_WOO (WS_WOI + 4224ull * 2048)
#define WS_H (WS_WOO + 1024ull * 2048)
#define WS_PROJ (WS_H + 16384ull * 2048)
#define WS_O (WS_PROJ + 16384ull * 4112 * 2)
#define WS_END (WS_O + 2ull * 16384 * 512 * 4)

struct P {
  const float *x, *c, *ada_w, *ada_b, *ln_g, *ln_b, *e_w_in, *e_rpb, *gla_w_up, *gla_b, *gla_g, *e_w_out;
  const float *o_w_in, *hgrn_lb, *hgrn_g, *conv_w, *conv_b, *dt_bias, *a_log, *d_skip, *ssm_g, *o_w_out;
  float* out;
  unsigned char* ws;
};

__device__ __forceinline__ bf16 f2bf(float f) {
  unsigned u = __float_as_uint(f);
  u += 0x7fffu + ((u >> 16) & 1u);
  return (bf16)(u >> 16);
}
__device__ __forceinline__ float bf2f(bf16 h) { return __uint_as_float(((unsigned)h) << 16); }
__device__ __forceinline__ float silu_f(float v) { return v / (1.f + __expf(-v)); }
__device__ __forceinline__ float sigmoid_f(float v) { return 1.f / (1.f + __expf(-v)); }
__device__ __forceinline__ float log_sigmoid_f(float z) { return fminf(z, 0.f) - log1pf(__expf(-fabsf(z))); }
__device__ __forceinline__ float softplus_f(float z) { return fmaxf(z, 0.f) + log1pf(__expf(-fabsf(z))); }
__device__ __forceinline__ float wave_sum(float v) {
#pragma unroll
  for (int o = 32; o > 0; o >>= 1) v += __shfl_xor(v, o, 64);
  return v;
}

__device__ __forceinline__ void transpose_item(const float* __restrict__ src, int N, bf16* __restrict__ dst, int li, unsigned char* smem) {
  float* tile = (float*)smem;
  const int tid = threadIdx.x;
  const int kt = li & 15, ntile = li >> 4;
#pragma unroll
  for (int i = 0; i < 16; ++i) {
    int row = i * 4 + (tid >> 6), col = tid & 63;
    int n = ntile * 64 + col;
    float v = (n < N) ? src[(size_t)(kt * 64 + row) * N + n] : 0.f;
    tile[row * 65 + col] = v;
  }
  __syncthreads();
#pragma unroll
  for (int i = 0; i < 16; ++i) {
    int r = i * 4 + (tid >> 6), cc = tid & 63;
    dst[(size_t)(ntile * 64 + r) * 1024 + kt * 64 + cc] = f2bf(tile[cc * 65 + r]);
  }
}

__device__ __forceinline__ void mod_item(const P& p, int idx, unsigned char* smem) {
  float* cond = (float*)smem;
  float* red = cond + 4096;
  const int tid = threadIdx.x;
  const int l = idx / 48, nc = idx % 48;
  for (int e = tid; e < 4096; e += 256) cond[e] = silu_f(p.c[e]);
  __syncthreads();
  const int kg = tid >> 6, col = tid & 63, n = nc * 64 + col;
  float a0 = 0.f, a1 = 0.f, a2 = 0.f, a3 = 0.f;
  const float* w = p.ada_w + (size_t)l * 1024 * 3072 + n;
#pragma unroll 8
  for (int k = kg * 256; k < kg * 256 + 256; ++k) {
    float wv = w[(size_t)k * 3072];
    a0 += cond[k] * wv; a1 += cond[1024 + k] * wv; a2 += cond[2048 + k] * wv; a3 += cond[3072 + k] * wv;
  }
  red[(kg * 4 + 0) * 64 + col] = a0; red[(kg * 4 + 1) * 64 + col] = a1;
  red[(kg * 4 + 2) * 64 + col] = a2; red[(kg * 4 + 3) * 64 + col] = a3;
  __syncthreads();
  float* mod = (float*)(p.ws + WS_MOD);
  {
    int b = tid >> 6;
    float s = red[(0 * 4 + b) * 64 + col] + red[(1 * 4 + b) * 64 + col] + red[(2 * 4 + b) * 64 + col] + red[(3 * 4 + b) * 64 + col];
    mod[(size_t)(l * 4 + b) * 3072 + n] = s + p.ada_b[l * 3072 + n];
  }
}

__device__ __forceinline__ void phase_setup(const P& p, unsigned char* smem) {
  const int T0 = 16 * 58, T1 = T0 + 256, T2 = T1 + 16 * 66, T3 = T2 + 256, T4 = T3 + 96, T5 = T4 + 1;
  for (int it = blockIdx.x; it < T5; it += gridDim.x) {
    if (it < T0) transpose_item(p.e_w_in, EVEN_N, (bf16*)(p.ws + WS_WEI), it, smem);
    else if (it < T1) transpose_item(p.e_w_out, 1024, (bf16*)(p.ws + WS_WEO), it - T0, smem);
    else if (it < T2) transpose_item(p.o_w_in, ODD_N, (bf16*)(p.ws + WS_WOI), it - T1, smem);
    else if (it < T3) transpose_item(p.o_w_out, 1024, (bf16*)(p.ws + WS_WOO), it - T2, smem);
    else if (it < T4) mod_item(p, it - T3, smem);
    else {
      float* lbv = (float*)(p.ws + WS_LB);
      for (int j = threadIdx.x; j < 512; j += 256) {
        float a = p.hgrn_lb[j], bb = p.hgrn_lb[512 + j];
        lbv[j] = 1.f / (1.f + __expf(a - bb));
      }
    }
    __syncthreads();
  }
}

__device__ __forceinline__ void phase_h0(const P& p) {
  const float* mod = (const float*)(p.ws + WS_MOD);
  bf16* hb = (bf16*)(p.ws + WS_H);
  const size_t total = (size_t)M_TOK * 128;
  for (size_t i = (size_t)blockIdx.x * 256 + threadIdx.x; i < total; i += (size_t)gridDim.x * 256) {
    int m = (int)(i >> 7), n = (int)(i & 127) * 8, b = m >> 12;
    const float4* xp = (const float4*)(p.x + (size_t)m * 1024 + n);
    const float4* sh = (const float4*)(mod + (size_t)b * 3072 + n);
    const float4* sc = (const float4*)(mod + (size_t)b * 3072 + 1024 + n);
    float4 x0 = xp[0], x1 = xp[1], s0 = sh[0], s1 = sh[1], c0 = sc[0], c1 = sc[1];
    uint4 o;
    o.x = (unsigned)f2bf(x0.x * (1.f + c0.x) + s0.x) | ((unsigned)f2bf(x0.y * (1.f + c0.y) + s0.y) << 16);
    o.y = (unsigned)f2bf(x0.z * (1.f + c0.z) + s0.z) | ((unsigned)f2bf(x0.w * (1.f + c0.w) + s0.w) << 16);
    o.z = (unsigned)f2bf(x1.x * (1.f + c1.x) + s1.x) | ((unsigned)f2bf(x1.y * (1.f + c1.y) + s1.y) << 16);
    o.w = (unsigned)f2bf(x1.z * (1.f + c1.z) + s1.z) | ((unsigned)f2bf(x1.w * (1.f + c1.w) + s1.w) << 16);
    *(uint4*)(hb + (size_t)m * 1024 + n) = o;
  }
}

#define LSTR 72
template <int EPI>
__device__ __forceinline__ void gemm_tile(const bf16* __restrict__ A, const bf16* __restrict__ Bt, int m0, int n0,
                                          unsigned char* smem, bf16* __restrict__ C, int ldc, int nreal,
                                          const float* __restrict__ X, float* __restrict__ R, const float* __restrict__ gate) {
  bf16* As = (bf16*)smem;
  bf16* Bs = As + 2 * 128 * LSTR;
  const int tid = threadIdx.x, lane = tid & 63, wave = tid >> 6;
  const int wm = wave >> 1, wn = wave & 1;
  f32x4 acc[4][4];
#pragma unroll
  for (int i = 0; i < 4; ++i)
#pragma unroll
    for (int j = 0; j < 4; ++j) acc[i][j] = (f32x4){0.f, 0.f, 0.f, 0.f};
  uint4 ra[4], rb[4];
  const int lrow = tid >> 3, lkc = tid & 7;
  const bf16* Ag = A + (size_t)(m0 + lrow) * 1024 + lkc * 8;
  const bf16* Bg = Bt + (size_t)(n0 + lrow) * 1024 + lkc * 8;
#pragma unroll
  for (int i = 0; i < 4; ++i) {
    ra[i] = *(const uint4*)(Ag + (size_t)i * 32 * 1024);
    rb[i] = *(const uint4*)(Bg + (size_t)i * 32 * 1024);
  }
#pragma unroll
  for (int i = 0; i < 4; ++i) {
    *(uint4*)(As + (lrow + i * 32) * LSTR + lkc * 8) = ra[i];
    *(uint4*)(Bs + (lrow + i * 32) * LSTR + lkc * 8) = rb[i];
  }
  __syncthreads();
  for (int kt = 0; kt < 16; ++kt) {
    const int buf = kt & 1;
    if (kt + 1 < 16) {
#pragma unroll
      for (int i = 0; i < 4; ++i) {
        ra[i] = *(const uint4*)(Ag + (size_t)i * 32 * 1024 + (kt + 1) * 64);
        rb[i] = *(const uint4*)(Bg + (size_t)i * 32 * 1024 + (kt + 1) * 64);
      }
    }
    const bf16* Ab = As + buf * 128 * LSTR;
    const bf16* Bb = Bs + buf * 128 * LSTR;
#pragma unroll
    for (int s = 0; s < 2; ++s) {
      bf16x8 wf[4], xf[4];
#pragma unroll
      for (int i = 0; i < 4; ++i) {
        wf[i] = *(const bf16x8*)(Bb + (wn * 64 + i * 16 + (lane & 15)) * LSTR + s * 32 + (lane >> 4) * 8);
        xf[i] = *(const bf16x8*)(Ab + (wm * 64 + i * 16 + (lane & 15)) * LSTR + s * 32 + (lane >> 4) * 8);
      }
#pragma unroll
      for (int i = 0; i < 4; ++i)
#pragma unroll
        for (int j = 0; j < 4; ++j) acc[i][j] = __builtin_amdgcn_mfma_f32_16x16x32_bf16(wf[i], xf[j], acc[i][j], 0, 0, 0);
    }
    if (kt + 1 < 16) {
      bf16* Aw = As + (buf ^ 1) * 128 * LSTR;
      bf16* Bw = Bs + (buf ^ 1) * 128 * LSTR;
#pragma unroll
      for (int i = 0; i < 4; ++i) {
        *(uint4*)(Aw + (lrow + i * 32) * LSTR + lkc * 8) = ra[i];
        *(uint4*)(Bw + (lrow + i * 32) * LSTR + lkc * 8) = rb[i];
      }
    }
    __syncthreads();
  }
#pragma unroll
  for (int i = 0; i < 4; ++i) {
    const int n = n0 + wn * 64 + i * 16 + (lane >> 4) * 4;
#pragma unroll
    for (int j = 0; j < 4; ++j) {
      const int m = m0 + wm * 64 + j * 16 + (lane & 15);
      f32x4 a = acc[i][j];
      if (EPI == 0) {
        if (n < nreal) {
          uint2 o;
          o.x = (unsigned)f2bf(a[0]) | ((unsigned)f2bf(a[1]) << 16);
          o.y = (unsigned)f2bf(a[2]) | ((unsigned)f2bf(a[3]) << 16);
          *(uint2*)(C + (size_t)m * ldc + n) = o;
        }
      } else {
        const int b = m >> 12;
        float4 xv = *(const float4*)(X + (size_t)m * 1024 + n);
        float4 g = *(const float4*)(gate + (size_t)b * 3072 + n);
        float4 o;
        o.x = ALPHA * xv.x + g.x * a[0];
        o.y = ALPHA * xv.y + g.y * a[1];
        o.z = ALPHA * xv.z + g.z * a[2];
        o.w = ALPHA * xv.w + g.w * a[3];
        *(float4*)(R + (size_t)m * 1024 + n) = o;
      }
    }
  }
}

template <int EPI>
__device__ __forceinline__ void phase_gemm(const bf16* A, const bf16* Bt, int ntn, unsigned char* smem, bf16* C, int ldc, int nreal,
                           const float* X, float* R, const float* gate) {
  const int total = (M_TOK / 128) * ntn;
  for (int t = blockIdx.x; t < total; t += gridDim.x) {
    int mt = t / ntn, nt = t % ntn;
    gemm_tile<EPI>(A, Bt, mt * 128, nt * 128, smem, C, ldc, nreal, X, R, gate);
  }
}

__device__ __forceinline__ void phase_ln(const P& p, int l, bool write_h) {
  const float* mod = (const float*)(p.ws + WS_MOD);
  bf16* hb = (bf16*)(p.ws + WS_H);
  const int lane = threadIdx.x & 63, wave = threadIdx.x >> 6;
  const float* g = p.ln_g + l * 1024;
  const float* bb = p.ln_b + l * 1024;
  for (int row = blockIdx.x * 4 + wave; row < M_TOK; row += gridDim.x * 4) {
    float* rp = p.out + (size_t)row * 1024;
    float4 v[4];
    float s = 0.f;
#pragma unroll
    for (int q = 0; q < 4; ++q) {
      v[q] = *(const float4*)(rp + (lane + 64 * q) * 4);
      s += v[q].x + v[q].y + v[q].z + v[q].w;
    }
    const float mu = wave_sum(s) * (1.f / 1024.f);
    float s2 = 0.f;
#pragma unroll
    for (int q = 0; q < 4; ++q) {
      float a = v[q].x - mu, b2 = v[q].y - mu, c2 = v[q].z - mu, d2 = v[q].w - mu;
      s2 += a * a + b2 * b2 + c2 * c2 + d2 * d2;
    }
    const float rstd = rsqrtf(wave_sum(s2) * (1.f / 1024.f) + 1e-5f);
    const int b = row >> 12;
#pragma unroll
    for (int q = 0; q < 4; ++q) {
      const int n = (lane + 64 * q) * 4;
      float4 gg = *(const float4*)(g + n), be = *(const float4*)(bb + n);
      float4 o;
      o.x = (v[q].x - mu) * rstd * gg.x + be.x;
      o.y = (v[q].y - mu) * rstd * gg.y + be.y;
      o.z = (v[q].z - mu) * rstd * gg.z + be.z;
      o.w = (v[q].w - mu) * rstd * gg.w + be.w;
      *(float4*)(rp + n) = o;
      if (write_h) {
        const float* md = mod + (size_t)(4 + b) * 3072;
        float4 sh = *(const float4*)(md + n), sc = *(const float4*)(md + 1024 + n);
        uint2 hh;
        hh.x = (unsigned)f2bf(o.x * (1.f + sc.x) + sh.x) | ((unsigned)f2bf(o.y * (1.f + sc.y) + sh.y) << 16);
        hh.y = (unsigned)f2bf(o.z * (1.f + sc.z) + sh.z) | ((unsigned)f2bf(o.w * (1.f + sc.w) + sh.w) << 16);
        *(uint2*)(hb + (size_t)row * 1024 + n) = hh;
      }
    }
  }
}

__device__ __forceinline__ void na_item(const P& p, int item) {
  const bf16* proj = (const bf16*)(p.ws + WS_PROJ);
  bf16* yb = (bf16*)(p.ws + WS_H);
  const int gt = item * 256 + threadIdx.x;
  const int h = gt & 7, tok = gt >> 3;
  const int b = tok >> 12, pos = tok & 4095, r = pos >> 6, qc = pos & 63;
  int rs = r - 4; rs = rs < 0 ? 0 : (rs > 56 ? 56 : rs);
  int cs = qc - 8; cs = cs < 0 ? 0 : (cs > 48 ? 48 : cs);
  float q[64], o[64];
  {
    const uint4* qp = (const uint4*)(proj + (size_t)tok * EVEN_N + h * 64);
#pragma unroll
    for (int i = 0; i < 8; ++i) {
      uint4 u = qp[i];
      q[i * 8 + 0] = __uint_as_float(u.x << 16); q[i * 8 + 1] = __uint_as_float(u.x & 0xffff0000u);
      q[i * 8 + 2] = __uint_as_float(u.y << 16); q[i * 8 + 3] = __uint_as_float(u.y & 0xffff0000u);
      q[i * 8 + 4] = __uint_as_float(u.z << 16); q[i * 8 + 5] = __uint_as_float(u.z & 0xffff0000u);
      q[i * 8 + 6] = __uint_as_float(u.w << 16); q[i * 8 + 7] = __uint_as_float(u.w & 0xffff0000u);
    }
  }
#pragma unroll
  for (int i = 0; i < 64; ++i) o[i] = 0.f;
  float mx = -1e30f, lsum = 0.f;
  const float* rpb = p.e_rpb + h * 15 * 31;
  for (int kr = 0; kr < 8; ++kr) {
    const int krow = rs + kr;
    const float* brow = rpb + (krow - r + 7) * 31;
    for (int kc2 = 0; kc2 < 16; ++kc2) {
      const int kcol = cs + kc2;
      const size_t ktok = (size_t)b * 4096 + krow * 64 + kcol;
      const uint4* kp = (const uint4*)(proj + ktok * EVEN_N + 512 + h * 64);
      float s = 0.f;
#pragma unroll
      for (int i = 0; i < 8; ++i) {
        uint4 u = kp[i];
        s += q[i * 8 + 0] * __uint_as_float(u.x << 16) + q[i * 8 + 1] * __uint_as_float(u.x & 0xffff0000u);
        s += q[i * 8 + 2] * __uint_as_float(u.y << 16) + q[i * 8 + 3] * __uint_as_float(u.y & 0xffff0000u);
        s += q[i * 8 + 4] * __uint_as_float(u.z << 16) + q[i * 8 + 5] * __uint_as_float(u.z & 0xffff0000u);
        s += q[i * 8 + 6] * __uint_as_float(u.w << 16) + q[i * 8 + 7] * __uint_as_float(u.w & 0xffff0000u);
      }
      s = s * 0.125f + brow[kcol - qc + 15];
      const float mn = fmaxf(mx, s);
      const float corr = __expf(mx - mn), pw = __expf(s - mn);
      mx = mn;
      lsum = lsum * corr + pw;
      const uint4* vp = (const uint4*)(proj + ktok * EVEN_N + 1024 + h * 64);
#pragma unroll
      for (int i = 0; i < 8; ++i) {
        uint4 u = vp[i];
        o[i * 8 + 0] = o[i * 8 + 0] * corr + pw * __uint_as_float(u.x << 16);
        o[i * 8 + 1] = o[i * 8 + 1] * corr + pw * __uint_as_float(u.x & 0xffff0000u);
        o[i * 8 + 2] = o[i * 8 + 2] * corr + pw * __uint_as_float(u.y << 16);
        o[i * 8 + 3] = o[i * 8 + 3] * corr + pw * __uint_as_float(u.y & 0xffff0000u);
        o[i * 8 + 4] = o[i * 8 + 4] * corr + pw * __uint_as_float(u.z << 16);
        o[i * 8 + 5] = o[i * 8 + 5] * corr + pw * __uint_as_float(u.z & 0xffff0000u);
        o[i * 8 + 6] = o[i * 8 + 6] * corr + pw * __uint_as_float(u.w << 16);
        o[i * 8 + 7] = o[i * 8 + 7] * corr + pw * __uint_as_float(u.w & 0xffff0000u);
      }
    }
  }
  const float inv = 1.f / lsum;
  const uint4* gp = (const uint4*)(proj + (size_t)tok * EVEN_N + 1536 + h * 64);
  uint4* op = (uint4*)(yb + (size_t)tok * 1024 + h * 64);
#pragma unroll
  for (int i = 0; i < 8; ++i) {
    uint4 u = gp[i];
    float g0 = __uint_as_float(u.x << 16), g1 = __uint_as_float(u.x & 0xffff0000u);
    float g2 = __uint_as_float(u.y << 16), g3 = __uint_as_float(u.y & 0xffff0000u);
    float g4 = __uint_as_float(u.z << 16), g5 = __uint_as_float(u.z & 0xffff0000u);
    float g6 = __uint_as_float(u.w << 16), g7 = __uint_as_float(u.w & 0xffff0000u);
    uint4 w;
    w.x = (unsigned)f2bf(o[i * 8 + 0] * inv * silu_f(g0)) | ((unsigned)f2bf(o[i * 8 + 1] * inv * silu_f(g1)) << 16);
    w.y = (unsigned)f2bf(o[i * 8 + 2] * inv * silu_f(g2)) | ((unsigned)f2bf(o[i * 8 + 3] * inv * silu_f(g3)) << 16);
    w.z = (unsigned)f2bf(o[i * 8 + 4] * inv * silu_f(g4)) | ((unsigned)f2bf(o[i * 8 + 5] * inv * silu_f(g5)) << 16);
    w.w = (unsigned)f2bf(o[i * 8 + 6] * inv * silu_f(g6)) | ((unsigned)f2bf(o[i * 8 + 7] * inv * silu_f(g7)) << 16);
    op[i] = w;
  }
}

__device__ __forceinline__ void gla_scan_item(const P& p, int item, unsigned char* smem) {
  const int b = item >> 2, h = item & 3;
  float* sq = (float*)smem;
  float* sk = sq + 2048;
  float* sf = sk + 2048;
  float* sv = sf + 2048;
  const int tid = threadIdx.x, dir = tid >> 7, col = tid & 127;
  const bf16* proj = (const bf16*)(p.ws + WS_PROJ);
  float* obuf = (float*)(p.ws + WS_O);
  float S[64];
#pragma unroll
  for (int i = 0; i < 64; ++i) S[i] = 0.f;
  for (int p0 = 0; p0 < 4096; p0 += 16) {
    __syncthreads();
#pragma unroll 1
    for (int i = 0; i < 8; ++i) {
      const int e = tid + i * 256;
      const int kch = e & 63, s = (e >> 6) & 15, d = e >> 10;
      const int t = d ? 4095 - (p0 + s) : (p0 + s);
      const bf16* row = proj + (size_t)(b * 4096 + t) * EVEN_N;
      const int ch = h * 64 + kch;
      float z = p.gla_b[d * 256 + ch];
#pragma unroll
      for (int r = 0; r < 16; ++r) z += bf2f(row[3584 + d * 16 + r]) * p.gla_w_up[(d * 16 + r) * 256 + ch];
      sq[e] = bf2f(row[2048 + ch]) * 0.125f;
      sk[e] = bf2f(row[2304 + ch]);
      sf[e] = __expf(log_sigmoid_f(z) * (1.f / 16.f));
    }
#pragma unroll 1
    for (int i = 0; i < 16; ++i) {
      const int e = tid + i * 256;
      const int c2 = e & 127, s = (e >> 7) & 15, d = e >> 11;
      const int t = d ? 4095 - (p0 + s) : (p0 + s);
      sv[e] = bf2f(proj[(size_t)(b * 4096 + t) * EVEN_N + 2560 + h * 128 + c2]);
    }
    __syncthreads();
#pragma unroll 1
    for (int s = 0; s < 16; ++s) {
      const float v = sv[(dir * 16 + s) * 128 + col];
      const float4* q4 = (const float4*)(sq + (dir * 16 + s) * 64);
      const float4* k4 = (const float4*)(sk + (dir * 16 + s) * 64);
      const float4* f4 = (const float4*)(sf + (dir * 16 + s) * 64);
      float o = 0.f;
#pragma unroll
      for (int kk = 0; kk < 16; ++kk) {
        float4 qq = q4[kk], kx = k4[kk], ff = f4[kk];
        S[kk * 4 + 0] = ff.x * S[kk * 4 + 0] + kx.x * v; o += qq.x * S[kk * 4 + 0];
        S[kk * 4 + 1] = ff.y * S[kk * 4 + 1] + kx.y * v; o += qq.y * S[kk * 4 + 1];
        S[kk * 4 + 2] = ff.z * S[kk * 4 + 2] + kx.z * v; o += qq.z * S[kk * 4 + 2];
        S[kk * 4 + 3] = ff.w * S[kk * 4 + 3] + kx.w * v; o += qq.w * S[kk * 4 + 3];
      }
      const int t = dir ? 4095 - (p0 + s) : (p0 + s);
      obuf[((size_t)dir * M_TOK + b * 4096 + t) * 512 + h * 128 + col] = o;
    }
  }
}

__device__ __forceinline__ void phase_post128(const P& p, const float* g, int ldp, int gate_off, int y_off) {
  const bf16* proj = (const bf16*)(p.ws + WS_PROJ);
  const float* obuf = (const float*)(p.ws + WS_O);
  bf16* yb = (bf16*)(p.ws + WS_H);
  const int lane = threadIdx.x & 63, wave = threadIdx.x >> 6;
  for (int it = blockIdx.x * 4 + wave; it < M_TOK * 4; it += gridDim.x * 4) {
    const int tok = it >> 2, h = it & 3;
    const int c = h * 128 + lane * 2;
    float2 a = *(const float2*)(obuf + (size_t)tok * 512 + c);
    float2 b2 = *(const float2*)(obuf + ((size_t)M_TOK + tok) * 512 + c);
    float o0 = a.x + b2.x, o1 = a.y + b2.y;
    float ss = wave_sum(o0 * o0 + o1 * o1);
    float rs = rsqrtf(ss * (1.f / 128.f) + 1e-6f);
    unsigned gg = *(const unsigned*)(proj + (size_t)tok * ldp + gate_off + c);
    float g0 = __uint_as_float(gg << 16), g1 = __uint_as_float(gg & 0xffff0000u);
    float y0 = o0 * rs * g[lane * 2] * silu_f(g0);
    float y1 = o1 * rs * g[lane * 2 + 1] * silu_f(g1);
    *(unsigned*)(yb + (size_t)tok * 1024 + y_off + c) = (unsigned)f2bf(y0) | ((unsigned)f2bf(y1) << 16);
  }
}

__device__ __forceinline__ void hgrn_scan_item(const P& p, int item, unsigned char* smem) {
  const int b = item >> 2, h = item & 3;
  float* sq = (float*)smem;
  float* sk = sq + 4096;
  float* sf = sk + 4096;
  float* sv = sf + 4096;
  const int tid = threadIdx.x, dir = tid >> 7, col = tid & 127;
  const bf16* proj = (const bf16*)(p.ws + WS_PROJ);
  const float* lbv = (const float*)(p.ws + WS_LB);
  float* obuf = (float*)(p.ws + WS_O);
  float S[128];
#pragma unroll
  for (int i = 0; i < 128; ++i) S[i] = 0.f;
  for (int p0 = 0; p0 < 4096; p0 += 16) {
    __syncthreads();
#pragma unroll 1
    for (int i = 0; i < 16; ++i) {
      const int e = tid + i * 256;
      const int kch = e & 127, s = (e >> 7) & 15, d = e >> 11;
      const int t = d ? 4095 - (p0 + s) : (p0 + s);
      const bf16* row = proj + (size_t)(b * 4096 + t) * ODD_N;
      const int ch = h * 128 + kch;
      const float lb = lbv[ch];
      const float z = bf2f(row[512 + d * 512 + ch]);
      sq[e] = bf2f(row[ch]) * 0.08838834764831845f;
      sk[e] = (1.f - lb) * sigmoid_f(-z);
      sf[e] = lb + (1.f - lb) * sigmoid_f(z);
      sv[e] = bf2f(row[1536 + ch]);
    }
    __syncthreads();
#pragma unroll 1
    for (int s = 0; s < 16; ++s) {
      const float v = sv[(dir * 16 + s) * 128 + col];
      const float4* q4 = (const float4*)(sq + (dir * 16 + s) * 128);
      const float4* k4 = (const float4*)(sk + (dir * 16 + s) * 128);
      const float4* f4 = (const float4*)(sf + (dir * 16 + s) * 128);
      float o = 0.f;
#pragma unroll
      for (int kk = 0; kk < 32; ++kk) {
        float4 qq = q4[kk], kx = k4[kk], ff = f4[kk];
        S[kk * 4 + 0] = ff.x * S[kk * 4 + 0] + kx.x * v; o += qq.x * S[kk * 4 + 0];
        S[kk * 4 + 1] = ff.y * S[kk * 4 + 1] + kx.y * v; o += qq.y * S[kk * 4 + 1];
        S[kk * 4 + 2] = ff.z * S[kk * 4 + 2] + kx.z * v; o += qq.z * S[kk * 4 + 2];
        S[kk * 4 + 3] = ff.w * S[kk * 4 + 3] + kx.w * v; o += qq.w * S[kk * 4 + 3];
      }
      const int t = dir ? 4095 - (p0 + s) : (p0 + s);
      obuf[((size_t)dir * M_TOK + b * 4096 + t) * 512 + h * 128 + col] = o;
    }
  }
}

__device__ __forceinline__ float conv_elem(const P& p, const bf16* proj, int b, int t, int c) {
  float acc = p.conv_b[c];
#pragma unroll
  for (int j = 0; j < 4; ++j) {
    const int tt = t + j - 2;
    if (tt >= 0 && tt < 4096) acc += p.conv_w[j * 1024 + c] * bf2f(proj[(size_t)(b * 4096 + tt) * ODD_N + 3072 + c]);
  }
  return silu_f(acc);
}

__device__ __forceinline__ void ssd_scan_item(const P& p, int item, unsigned char* smem) {
  const int b = item >> 2, g = (item >> 1) & 1, dir = item & 1;
  float* sB = (float*)smem;
  float* sC = sB + 2048;
  float* sx = sC + 2048;
  float* sdec = sx + 4096;
  const int tid = threadIdx.x, rp = tid >> 6, pp = tid & 63, head = g * 4 + rp;
  const bf16* proj = (const bf16*)(p.ws + WS_PROJ);
  float* obuf = (float*)(p.ws + WS_O);
  float S[128];
#pragma unroll
  for (int i = 0; i < 128; ++i) S[i] = 0.f;
  const float dtb = p.dt_bias[dir * 8 + head];
  const float Aneg = -__expf(p.a_log[dir * 8 + head]);
  for (int p0 = 0; p0 < 4096; p0 += 16) {
    __syncthreads();
#pragma unroll 1
    for (int i = 0; i < 16; ++i) {
      const int e = tid + i * 256;
      const int n = e & 127, bc = (e >> 7) & 1, s = e >> 8;
      const int t = dir ? 4095 - (p0 + s) : (p0 + s);
      const float v = conv_elem(p, proj, b, t, 512 + bc * 256 + g * 128 + n);
      if (bc == 0) sB[s * 128 + n] = v; else sC[s * 128 + n] = v;
    }
#pragma unroll 1
    for (int s = 0; s < 16; ++s) {
      const int t = dir ? 4095 - (p0 + s) : (p0 + s);
      const float dt = softplus_f(bf2f(proj[(size_t)(b * 4096 + t) * ODD_N + 4096 + dir * 8 + head]) + dtb);
      sx[s * 256 + tid] = conv_elem(p, proj, b, t, head * 64 + pp) * dt;
      if (pp == 0) sdec[s * 4 + rp] = __expf(Aneg * dt);
    }
    __syncthreads();
#pragma unroll 1
    for (int s = 0; s < 16; ++s) {
      const float v = sx[s * 256 + tid];
      const float dec = sdec[s * 4 + rp];
      const float4* b4 = (const float4*)(sB + s * 128);
      const float4* c4 = (const float4*)(sC + s * 128);
      float o = 0.f;
#pragma unroll
      for (int kk = 0; kk < 32; ++kk) {
        float4 bx = b4[kk], cx = c4[kk];
        S[kk * 4 + 0] = dec * S[kk * 4 + 0] + bx.x * v; o += cx.x * S[kk * 4 + 0];
        S[kk * 4 + 1] = dec * S[kk * 4 + 1] + bx.y * v; o += cx.y * S[kk * 4 + 1];
        S[kk * 4 + 2] = dec * S[kk * 4 + 2] + bx.z * v; o += cx.z * S[kk * 4 + 2];
        S[kk * 4 + 3] = dec * S[kk * 4 + 3] + bx.w * v; o += cx.w * S[kk * 4 + 3];
      }
      const int t = dir ? 4095 - (p0 + s) : (p0 + s);
      obuf[((size_t)dir * M_TOK + b * 4096 + t) * 512 + head * 64 + pp] = o;
    }
  }
}

__device__ __forceinline__ void phase_ssd_post(const P& p) {
  const bf16* proj = (const bf16*)(p.ws + WS_PROJ);
  const float* obuf = (const float*)(p.ws + WS_O);
  bf16* yb = (bf16*)(p.ws + WS_H);
  const int lane = threadIdx.x & 63, wave = threadIdx.x >> 6;
  for (int tok = blockIdx.x * 4 + wave; tok < M_TOK; tok += gridDim.x * 4) {
    const int b = tok >> 12, t = tok & 4095;
    float y[8];
    float ss = 0.f;
#pragma unroll
    for (int i = 0; i < 8; ++i) {
      const int c = lane * 8 + i;
      const float xs = conv_elem(p, proj, b, t, c);
      const float dz = bf2f(proj[(size_t)tok * ODD_N + 2560 + c]);
      float v = obuf[(size_t)tok * 512 + c] + obuf[((size_t)M_TOK + tok) * 512 + c] + p.d_skip[c >> 6] * xs;
      v *= silu_f(dz);
      y[i] = v;
      ss += v * v;
    }
    ss = wave_sum(ss);
    const float rs = rsqrtf(ss * (1.f / 512.f) + 1e-6f);
    uint4 w;
    unsigned u[4];
#pragma unroll
    for (int i = 0; i < 4; ++i) {
      const int c = lane * 8 + i * 2;
      u[i] = (unsigned)f2bf(y[i * 2] * rs * p.ssm_g[c]) | ((unsigned)f2bf(y[i * 2 + 1] * rs * p.ssm_g[c + 1]) << 16);
    }
    w.x = u[0]; w.y = u[1]; w.z = u[2]; w.w = u[3];
    *(uint4*)(yb + (size_t)tok * 1024 + 512 + lane * 8) = w;
  }
}

#define NPHASE 14
__global__ void __launch_bounds__(256) mega(P p, int ph_lo, int ph_hi) {
  __shared__ __align__(16) unsigned char smem[73728];
  cg::grid_group grid = cg::this_grid();
  const float* mod = (const float*)(p.ws + WS_MOD);
#define IN(k) (ph_lo <= (k) && (k) < ph_hi)
#define SYNC(k) if (IN(k) && (k) + 1 < ph_hi) grid.sync();
  if (IN(0)) phase_setup(p, smem);
  SYNC(0)
  if (IN(1)) phase_h0(p);
  SYNC(1)
  if (IN(2))
    phase_gemm<0>((const bf16*)(p.ws + WS_H), (const bf16*)(p.ws + WS_WEI), EVEN_NP / 128, smem,
                  (bf16*)(p.ws + WS_PROJ), EVEN_N, EVEN_N, nullptr, nullptr, nullptr);
  SYNC(2)
  if (IN(3)) {
    for (int it = blockIdx.x; it < 16 + 512; it += gridDim.x) {
      if (it < 16) gla_scan_item(p, it, smem); else na_item(p, it - 16);
      __syncthreads();
    }
  }
  SYNC(3)
  if (IN(4)) phase_post128(p, p.gla_g, EVEN_N, 3072, 512);
  SYNC(4)
  if (IN(5))
    phase_gemm<1>((const bf16*)(p.ws + WS_H), (const bf16*)(p.ws + WS_WEO), 8, smem, nullptr, 0, 0, p.x, p.out,
                  mod + 2048);
  SYNC(5)
  if (IN(6)) phase_ln(p, 0, true);
  SYNC(6)
  if (IN(7))
    phase_gemm<0>((const bf16*)(p.ws + WS_H), (const bf16*)(p.ws + WS_WOI), ODD_NP / 128, smem,
                  (bf16*)(p.ws + WS_PROJ), ODD_N, ODD_N, nullptr, nullptr, nullptr);
  SYNC(7)
  if (IN(8)) {
    for (int it = blockIdx.x; it < 16; it += gridDim.x) { hgrn_scan_item(p, it, smem); __syncthreads(); }
  }
  SYNC(8)
  if (IN(9)) phase_post128(p, p.hgrn_g, ODD_N, 2048, 0);
  SYNC(9)
  if (IN(10)) {
    for (int it = blockIdx.x; it < 16; it += gridDim.x) { ssd_scan_item(p, it, smem); __syncthreads(); }
  }
  SYNC(10)
  if (IN(11)) phase_ssd_post(p);
  SYNC(11)
  if (IN(12))
    phase_gemm<1>((const bf16*)(p.ws + WS_H), (const bf16*)(p.ws + WS_WOO), 8, smem, nullptr, 0, 0, p.out, p.out,
                  mod + 4 * 3072 + 2048);
  SYNC(12)
  if (IN(13)) phase_ln(p, 1, false);
}

extern "C" void kernel_launch(void* const* d_in, const int* in_sizes, int n_in, void* d_out, int out_size, void* d_ws,
                              size_t ws_size, hipStream_t stream) {
  static int grid_blocks = 0;
  if (!grid_blocks) {
    int dev = 0, cus = 0, per_cu = 0;
    hipGetDevice(&dev);
    hipDeviceGetAttribute(&cus, hipDeviceAttributeMultiprocessorCount, dev);
    hipOccupancyMaxActiveBlocksPerMultiprocessor(&per_cu, mega, 256, 0);
    if (per_cu < 1) per_cu = 1;
    grid_blocks = cus * per_cu;
    if (n_in != 22 || ws_size < WS_END) {
      fprintf(stderr, "kernel_launch: unexpected n_in %d / ws_size %zu (need %llu)\n", n_in, ws_size, (unsigned long long)WS_END);
      grid_blocks = -1;
    }
  }
  if (grid_blocks < 0) return;
  P p{};
  const float** f = (const float**)&p;
  for (int i = 0; i < 22; ++i) f[i] = (const float*)d_in[i];
  p.out = (float*)d_out;
  p.ws = (unsigned char*)d_ws;
#if 1
  int lo = 0, hi = NPHASE;
  void* args[] = {&p, &lo, &hi};
  hipError_t e = hipLaunchCooperativeKernel((void*)mega, dim3(grid_blocks), dim3(256), args, 0, stream);
  if (e != hipSuccess) fprintf(stderr, "cooperative launch failed: %s (grid %d)\n", hipGetErrorString(e), grid_blocks);
#else
  for (int ph = 0; ph < NPHASE; ++ph) hipLaunchKernelGGL(mega, dim3(grid_blocks), dim3(256), 0, stream, p, ph, ph + 1);
#endif
}
```

```cpp
#include <hip/hip_runtime.h>
#include <hip/hip_cooperative_groups.h>
#include <cstdio>
namespace cg = cooperative_groups;

typedef unsigned short bf16;
using bf16x8 = __attribute__((ext_vector_type(8))) short;
using f32x4 = __attribute__((ext_vector_type(4))) float;

#define M_TOK 16384
#define DM 1024
#define SEQ 4096
#define EVEN_N 3616
#define EVEN_NP 3712
#define ODD_N 4112
#define ODD_NP 4224
#define ALPHA 1.4142135623730951f

#define WS_MOD 0ull
#define WS_LB (WS_MOD + 98304ull)
#define WS_WEI (WS_LB + 2048ull)
#define WS_WEO (WS_WEI + 3712ull * 2048)
#define WS_WOI (WS_WEO + 1024ull * 2048)
#define WS_WOO (WS_WOI + 4224ull * 2048)
#define WS_H (WS_WOO + 1024ull * 2048)
#define WS_PROJ (WS_H + 16384ull * 2048)
#define WS_O (WS_PROJ + 16384ull * 4112 * 2)
#define WS_ST WS_O
#define WS_DEC (WS_O + 2ull * 16384 * 512 * 4)
#define WS_SSQ (WS_DEC + 2ull * 16 * 64 * 128 * 4)
#define WS_END (WS_SSQ + 2ull * 16384 * 4)

struct P {
  const float *x, *c, *ada_w, *ada_b, *ln_g, *ln_b, *e_w_in, *e_rpb, *gla_w_up, *gla_b, *gla_g, *e_w_out;
  const float *o_w_in, *hgrn_lb, *hgrn_g, *conv_w, *conv_b, *dt_bias, *a_log, *d_skip, *ssm_g, *o_w_out;
  float* out;
  unsigned char* ws;
};

__device__ __forceinline__ bf16 f2bf(float f) {
  unsigned u = __float_as_uint(f);
  u += 0x7fffu + ((u >> 16) & 1u);
  return (bf16)(u >> 16);
}
__device__ __forceinline__ float bf2f(bf16 h) { return __uint_as_float(((unsigned)h) << 16); }
__device__ __forceinline__ float silu_f(float v) { return v / (1.f + __expf(-v)); }
__device__ __forceinline__ float sigmoid_f(float v) { return 1.f / (1.f + __expf(-v)); }
__device__ __forceinline__ float log_sigmoid_f(float z) { return fminf(z, 0.f) - log1pf(__expf(-fabsf(z))); }
__device__ __forceinline__ float softplus_f(float z) { return fmaxf(z, 0.f) + log1pf(__expf(-fabsf(z))); }
__device__ __forceinline__ float wave_sum(float v) {
#pragma unroll
  for (int o = 32; o > 0; o >>= 1) v += __shfl_xor(v, o, 64);
  return v;
}

__device__ __forceinline__ void transpose_item(const float* __restrict__ src, int N, bf16* __restrict__ dst, int li, unsigned char* smem) {
  float* tile = (float*)smem;
  const int tid = threadIdx.x;
  const int kt = li & 15, ntile = li >> 4;
#pragma unroll
  for (int i = 0; i < 16; ++i) {
    int row = i * 4 + (tid >> 6), col = tid & 63;
    int n = ntile * 64 + col;
    float v = (n < N) ? src[(size_t)(kt * 64 + row) * N + n] : 0.f;
    tile[row * 65 + col] = v;
  }
  __syncthreads();
#pragma unroll
  for (int i = 0; i < 16; ++i) {
    int r = i * 4 + (tid >> 6), cc = tid & 63;
    dst[(size_t)(ntile * 64 + r) * 1024 + kt * 64 + cc] = f2bf(tile[cc * 65 + r]);
  }
}

__device__ __forceinline__ void mod_item(const P& p, int idx, unsigned char* smem) {
  float* cond = (float*)smem;
  float* red = cond + 4096;
  const int tid = threadIdx.x;
  const int l = idx / 48, nc = idx % 48;
  for (int e = tid; e < 4096; e += 256) cond[e] = silu_f(p.c[e]);
  __syncthreads();
  const int kg = tid >> 6, col = tid & 63, n = nc * 64 + col;
  float a0 = 0.f, a1 = 0.f, a2 = 0.f, a3 = 0.f;
  const float* w = p.ada_w + (size_t)l * 1024 * 3072 + n;
#pragma unroll 8
  for (int k = kg * 256; k < kg * 256 + 256; ++k) {
    float wv = w[(size_t)k * 3072];
    a0 += cond[k] * wv; a1 += cond[1024 + k] * wv; a2 += cond[2048 + k] * wv; a3 += cond[3072 + k] * wv;
  }
  red[(kg * 4 + 0) * 64 + col] = a0; red[(kg * 4 + 1) * 64 + col] = a1;
  red[(kg * 4 + 2) * 64 + col] = a2; red[(kg * 4 + 3) * 64 + col] = a3;
  __syncthreads();
  float* mod = (float*)(p.ws + WS_MOD);
  {
    int b = tid >> 6;
    float s = red[(0 * 4 + b) * 64 + col] + red[(1 * 4 + b) * 64 + col] + red[(2 * 4 + b) * 64 + col] + red[(3 * 4 + b) * 64 + col];
    mod[(size_t)(l * 4 + b) * 3072 + n] = s + p.ada_b[l * 3072 + n];
  }
}

__device__ __forceinline__ void phase_setup(const P& p, unsigned char* smem) {
  const int T0 = 16 * 58, T1 = T0 + 256, T2 = T1 + 16 * 66, T3 = T2 + 256, T4 = T3 + 96, T5 = T4 + 1;
  for (int it = blockIdx.x; it < T5; it += gridDim.x) {
    if (it < T0) transpose_item(p.e_w_in, EVEN_N, (bf16*)(p.ws + WS_WEI), it, smem);
    else if (it < T1) transpose_item(p.e_w_out, 1024, (bf16*)(p.ws + WS_WEO), it - T0, smem);
    else if (it < T2) transpose_item(p.o_w_in, ODD_N, (bf16*)(p.ws + WS_WOI), it - T1, smem);
    else if (it < T3) transpose_item(p.o_w_out, 1024, (bf16*)(p.ws + WS_WOO), it - T2, smem);
    else if (it < T4) mod_item(p, it - T3, smem);
    else {
      float* lbv = (float*)(p.ws + WS_LB);
      for (int j = threadIdx.x; j < 512; j += 256) {
        float a = p.hgrn_lb[j], bb = p.hgrn_lb[512 + j];
        lbv[j] = 1.f / (1.f + __expf(a - bb));
      }
    }
    __syncthreads();
  }
}

__device__ __forceinline__ void phase_h0(const P& p) {
  const float* mod = (const float*)(p.ws + WS_MOD);
  bf16* hb = (bf16*)(p.ws + WS_H);
  const size_t total = (size_t)M_TOK * 128;
  for (size_t i = (size_t)blockIdx.x * 256 + threadIdx.x; i < total; i += (size_t)gridDim.x * 256) {
    int m = (int)(i >> 7), n = (int)(i & 127) * 8, b = m >> 12;
    const float4* xp = (const float4*)(p.x + (size_t)m * 1024 + n);
    const float4* sh = (const float4*)(mod + (size_t)b * 3072 + n);
    const float4* sc = (const float4*)(mod + (size_t)b * 3072 + 1024 + n);
    float4 x0 = xp[0], x1 = xp[1], s0 = sh[0], s1 = sh[1], c0 = sc[0], c1 = sc[1];
    uint4 o;
    o.x = (unsigned)f2bf(x0.x * (1.f + c0.x) + s0.x) | ((unsigned)f2bf(x0.y * (1.f + c0.y) + s0.y) << 16);
    o.y = (unsigned)f2bf(x0.z * (1.f + c0.z) + s0.z) | ((unsigned)f2bf(x0.w * (1.f + c0.w) + s0.w) << 16);
    o.z = (unsigned)f2bf(x1.x * (1.f + c1.x) + s1.x) | ((unsigned)f2bf(x1.y * (1.f + c1.y) + s1.y) << 16);
    o.w = (unsigned)f2bf(x1.z * (1.f + c1.z) + s1.z) | ((unsigned)f2bf(x1.w * (1.f + c1.w) + s1.w) << 16);
    *(uint4*)(hb + (size_t)m * 1024 + n) = o;
  }
}

#define LSTR 72
template <int EPI>
__device__ __forceinline__ void gemm_tile(const bf16* __restrict__ A, const bf16* __restrict__ Bt, int m0, int n0,
                                          unsigned char* smem, bf16* __restrict__ C, int ldc, int nreal,
                                          const float* __restrict__ X, float* __restrict__ R, const float* __restrict__ gate) {
  bf16* As = (bf16*)smem;
  bf16* Bs = As + 2 * 128 * LSTR;
  const int tid = threadIdx.x, lane = tid & 63, wave = tid >> 6;
  const int wm = wave >> 1, wn = wave & 1;
  f32x4 acc[4][4];
#pragma unroll
  for (int i = 0; i < 4; ++i)
#pragma unroll
    for (int j = 0; j < 4; ++j) acc[i][j] = (f32x4){0.f, 0.f, 0.f, 0.f};
  uint4 ra[4], rb[4];
  const int lrow = tid >> 3, lkc = tid & 7;
  const bf16* Ag = A + (size_t)(m0 + lrow) * 1024 + lkc * 8;
  const bf16* Bg = Bt + (size_t)(n0 + lrow) * 1024 + lkc * 8;
#pragma unroll
  for (int i = 0; i < 4; ++i) {
    ra[i] = *(const uint4*)(Ag + (size_t)i * 32 * 1024);
    rb[i] = *(const uint4*)(Bg + (size_t)i * 32 * 1024);
  }
#pragma unroll
  for (int i = 0; i < 4; ++i) {
    *(uint4*)(As + (lrow + i * 32) * LSTR + lkc * 8) = ra[i];
    *(uint4*)(Bs + (lrow + i * 32) * LSTR + lkc * 8) = rb[i];
  }
  __syncthreads();
  for (int kt = 0; kt < 16; ++kt) {
    const int buf = kt & 1;
    if (kt + 1 < 16) {
#pragma unroll
      for (int i = 0; i < 4; ++i) {
        ra[i] = *(const uint4*)(Ag + (size_t)i * 32 * 1024 + (kt + 1) * 64);
        rb[i] = *(const uint4*)(Bg + (size_t)i * 32 * 1024 + (kt + 1) * 64);
      }
    }
    const bf16* Ab = As + buf * 128 * LSTR;
    const bf16* Bb = Bs + buf * 128 * LSTR;
#pragma unroll
    for (int s = 0; s < 2; ++s) {
      bf16x8 wf[4], xf[4];
#pragma unroll
      for (int i = 0; i < 4; ++i) {
        wf[i] = *(const bf16x8*)(Bb + (wn * 64 + i * 16 + (lane & 15)) * LSTR + s * 32 + (lane >> 4) * 8);
        xf[i] = *(const bf16x8*)(Ab + (wm * 64 + i * 16 + (lane & 15)) * LSTR + s * 32 + (lane >> 4) * 8);
      }
#pragma unroll
      for (int i = 0; i < 4; ++i)
#pragma unroll
        for (int j = 0; j < 4; ++j) acc[i][j] = __builtin_amdgcn_mfma_f32_16x16x32_bf16(wf[i], xf[j], acc[i][j], 0, 0, 0);
    }
    if (kt + 1 < 16) {
      bf16* Aw = As + (buf ^ 1) * 128 * LSTR;
      bf16* Bw = Bs + (buf ^ 1) * 128 * LSTR;
#pragma unroll
      for (int i = 0; i < 4; ++i) {
        *(uint4*)(Aw + (lrow + i * 32) * LSTR + lkc * 8) = ra[i];
        *(uint4*)(Bw + (lrow + i * 32) * LSTR + lkc * 8) = rb[i];
      }
    }
    __syncthreads();
  }
#pragma unroll
  for (int i = 0; i < 4; ++i) {
    const int n = n0 + wn * 64 + i * 16 + (lane >> 4) * 4;
#pragma unroll
    for (int j = 0; j < 4; ++j) {
      const int m = m0 + wm * 64 + j * 16 + (lane & 15);
      f32x4 a = acc[i][j];
      if (EPI == 0) {
        if (n < nreal) {
          uint2 o;
          o.x = (unsigned)f2bf(a[0]) | ((unsigned)f2bf(a[1]) << 16);
          o.y = (unsigned)f2bf(a[2]) | ((unsigned)f2bf(a[3]) << 16);
          *(uint2*)(C + (size_t)m * ldc + n) = o;
        }
      } else {
        const int b = m >> 12;
        float4 xv = *(const float4*)(X + (size_t)m * 1024 + n);
        float4 g = *(const float4*)(gate + (size_t)b * 3072 + n);
        float4 o;
        o.x = ALPHA * xv.x + g.x * a[0];
        o.y = ALPHA * xv.y + g.y * a[1];
        o.z = ALPHA * xv.z + g.z * a[2];
        o.w = ALPHA * xv.w + g.w * a[3];
        *(float4*)(R + (size_t)m * 1024 + n) = o;
      }
    }
  }
}

template <int EPI>
__device__ __forceinline__ void phase_gemm(const bf16* A, const bf16* Bt, int ntn, unsigned char* smem, bf16* C, int ldc, int nreal,
                           const float* X, float* R, const float* gate) {
  const int total = (M_TOK / 128) * ntn;
  for (int t = blockIdx.x; t < total; t += gridDim.x) {
    int mt = t / ntn, nt = t % ntn;
    gemm_tile<EPI>(A, Bt, mt * 128, nt * 128, smem, C, ldc, nreal, X, R, gate);
  }
}

__device__ __forceinline__ void phase_ln(const P& p, int l, bool write_h) {
  const float* mod = (const float*)(p.ws + WS_MOD);
  bf16* hb = (bf16*)(p.ws + WS_H);
  const int lane = threadIdx.x & 63, wave = threadIdx.x >> 6;
  const float* g = p.ln_g + l * 1024;
  const float* bb = p.ln_b + l * 1024;
  for (int row = blockIdx.x * 4 + wave; row < M_TOK; row += gridDim.x * 4) {
    float* rp = p.out + (size_t)row * 1024;
    float4 v[4];
    float s = 0.f;
#pragma unroll
    for (int q = 0; q < 4; ++q) {
      v[q] = *(const float4*)(rp + (lane + 64 * q) * 4);
      s += v[q].x + v[q].y + v[q].z + v[q].w;
    }
    const float mu = wave_sum(s) * (1.f / 1024.f);
    float s2 = 0.f;
#pragma unroll
    for (int q = 0; q < 4; ++q) {
      float a = v[q].x - mu, b2 = v[q].y - mu, c2 = v[q].z - mu, d2 = v[q].w - mu;
      s2 += a * a + b2 * b2 + c2 * c2 + d2 * d2;
    }
    const float rstd = rsqrtf(wave_sum(s2) * (1.f / 1024.f) + 1e-5f);
    const int b = row >> 12;
#pragma unroll
    for (int q = 0; q < 4; ++q) {
      const int n = (lane + 64 * q) * 4;
      float4 gg = *(const float4*)(g + n), be = *(const float4*)(bb + n);
      float4 o;
      o.x = (v[q].x - mu) * rstd * gg.x + be.x;
      o.y = (v[q].y - mu) * rstd * gg.y + be.y;
      o.z = (v[q].z - mu) * rstd * gg.z + be.z;
      o.w = (v[q].w - mu) * rstd * gg.w + be.w;
      *(float4*)(rp + n) = o;
      if (write_h) {
        const float* md = mod + (size_t)(4 + b) * 3072;
        float4 sh = *(const float4*)(md + n), sc = *(const float4*)(md + 1024 + n);
        uint2 hh;
        hh.x = (unsigned)f2bf(o.x * (1.f + sc.x) + sh.x) | ((unsigned)f2bf(o.y * (1.f + sc.y) + sh.y) << 16);
        hh.y = (unsigned)f2bf(o.z * (1.f + sc.z) + sh.z) | ((unsigned)f2bf(o.w * (1.f + sc.w) + sh.w) << 16);
        *(uint2*)(hb + (size_t)row * 1024 + n) = hh;
      }
    }
  }
}

__device__ __forceinline__ void na_item(const P& p, int item) {
  const bf16* proj = (const bf16*)(p.ws + WS_PROJ);
  bf16* yb = (bf16*)(p.ws + WS_H);
  const int gt = item * 256 + threadIdx.x;
  const int h = gt & 7, tok = gt >> 3;
  const int b = tok >> 12, pos = tok & 4095, r = pos >> 6, qc = pos & 63;
  int rs = r - 4; rs = rs < 0 ? 0 : (rs > 56 ? 56 : rs);
  int cs = qc - 8; cs = cs < 0 ? 0 : (cs > 48 ? 48 : cs);
  float q[64], o[64];
  {
    const uint4* qp = (const uint4*)(proj + (size_t)tok * EVEN_N + h * 64);
#pragma unroll
    for (int i = 0; i < 8; ++i) {
      uint4 u = qp[i];
      q[i * 8 + 0] = __uint_as_float(u.x << 16); q[i * 8 + 1] = __uint_as_float(u.x & 0xffff0000u);
      q[i * 8 + 2] = __uint_as_float(u.y << 16); q[i * 8 + 3] = __uint_as_float(u.y & 0xffff0000u);
      q[i * 8 + 4] = __uint_as_float(u.z << 16); q[i * 8 + 5] = __uint_as_float(u.z & 0xffff0000u);
      q[i * 8 + 6] = __uint_as_float(u.w << 16); q[i * 8 + 7] = __uint_as_float(u.w & 0xffff0000u);
    }
  }
#pragma unroll
  for (int i = 0; i < 64; ++i) o[i] = 0.f;
  float mx = -1e30f, lsum = 0.f;
  const float* rpb = p.e_rpb + h * 15 * 31;
  for (int kr = 0; kr < 8; ++kr) {
    const int krow = rs + kr;
    const float* brow = rpb + (krow - r + 7) * 31;
    for (int kc2 = 0; kc2 < 16; ++kc2) {
      const int kcol = cs + kc2;
      const size_t ktok = (size_t)b * 4096 + krow * 64 + kcol;
      const uint4* kp = (const uint4*)(proj + ktok * EVEN_N + 512 + h * 64);
      float s = 0.f;
#pragma unroll
      for (int i = 0; i < 8; ++i) {
        uint4 u = kp[i];
        s += q[i * 8 + 0] * __uint_as_float(u.x << 16) + q[i * 8 + 1] * __uint_as_float(u.x & 0xffff0000u);
        s += q[i * 8 + 2] * __uint_as_float(u.y << 16) + q[i * 8 + 3] * __uint_as_float(u.y & 0xffff0000u);
        s += q[i * 8 + 4] * __uint_as_float(u.z << 16) + q[i * 8 + 5] * __uint_as_float(u.z & 0xffff0000u);
        s += q[i * 8 + 6] * __uint_as_float(u.w << 16) + q[i * 8 + 7] * __uint_as_float(u.w & 0xffff0000u);
      }
      s = s * 0.125f + brow[kcol - qc + 15];
      const float mn = fmaxf(mx, s);
      const float corr = __expf(mx - mn), pw = __expf(s - mn);
      mx = mn;
      lsum = lsum * corr + pw;
      const uint4* vp = (const uint4*)(proj + ktok * EVEN_N + 1024 + h * 64);
#pragma unroll
      for (int i = 0; i < 8; ++i) {
        uint4 u = vp[i];
        o[i * 8 + 0] = o[i * 8 + 0] * corr + pw * __uint_as_float(u.x << 16);
        o[i * 8 + 1] = o[i * 8 + 1] * corr + pw * __uint_as_float(u.x & 0xffff0000u);
        o[i * 8 + 2] = o[i * 8 + 2] * corr + pw * __uint_as_float(u.y << 16);
        o[i * 8 + 3] = o[i * 8 + 3] * corr + pw * __uint_as_float(u.y & 0xffff0000u);
        o[i * 8 + 4] = o[i * 8 + 4] * corr + pw * __uint_as_float(u.z << 16);
        o[i * 8 + 5] = o[i * 8 + 5] * corr + pw * __uint_as_float(u.z & 0xffff0000u);
        o[i * 8 + 6] = o[i * 8 + 6] * corr + pw * __uint_as_float(u.w << 16);
        o[i * 8 + 7] = o[i * 8 + 7] * corr + pw * __uint_as_float(u.w & 0xffff0000u);
      }
    }
  }
  const float inv = 1.f / lsum;
  const uint4* gp = (const uint4*)(proj + (size_t)tok * EVEN_N + 1536 + h * 64);
  uint4* op = (uint4*)(yb + (size_t)tok * 1024 + h * 64);
#pragma unroll
  for (int i = 0; i < 8; ++i) {
    uint4 u = gp[i];
    float g0 = __uint_as_float(u.x << 16), g1 = __uint_as_float(u.x & 0xffff0000u);
    float g2 = __uint_as_float(u.y << 16), g3 = __uint_as_float(u.y & 0xffff0000u);
    float g4 = __uint_as_float(u.z << 16), g5 = __uint_as_float(u.z & 0xffff0000u);
    float g6 = __uint_as_float(u.w << 16), g7 = __uint_as_float(u.w & 0xffff0000u);
    uint4 w;
    w.x = (unsigned)f2bf(o[i * 8 + 0] * inv * silu_f(g0)) | ((unsigned)f2bf(o[i * 8 + 1] * inv * silu_f(g1)) << 16);
    w.y = (unsigned)f2bf(o[i * 8 + 2] * inv * silu_f(g2)) | ((unsigned)f2bf(o[i * 8 + 3] * inv * silu_f(g3)) << 16);
    w.z = (unsigned)f2bf(o[i * 8 + 4] * inv * silu_f(g4)) | ((unsigned)f2bf(o[i * 8 + 5] * inv * silu_f(g5)) << 16);
    w.w = (unsigned)f2bf(o[i * 8 + 6] * inv * silu_f(g6)) | ((unsigned)f2bf(o[i * 8 + 7] * inv * silu_f(g7)) << 16);
    op[i] = w;
  }
}

__device__ __forceinline__ void gla_scan_item(const P& p, int item, unsigned char* smem) {
  const int b = item >> 2, h = item & 3;
  float* sq = (float*)smem;
  float* sk = sq + 2048;
  float* sf = sk + 2048;
  float* sv = sf + 2048;
  const int tid = threadIdx.x, dir = tid >> 7, col = tid & 127;
  const bf16* proj = (const bf16*)(p.ws + WS_PROJ);
  float* obuf = (float*)(p.ws + WS_O);
  float S[64];
#pragma unroll
  for (int i = 0; i < 64; ++i) S[i] = 0.f;
  for (int p0 = 0; p0 < 4096; p0 += 16) {
    __syncthreads();
#pragma unroll 1
    for (int i = 0; i < 8; ++i) {
      const int e = tid + i * 256;
      const int kch = e & 63, s = (e >> 6) & 15, d = e >> 10;
      const int t = d ? 4095 - (p0 + s) : (p0 + s);
      const bf16* row = proj + (size_t)(b * 4096 + t) * EVEN_N;
      const int ch = h * 64 + kch;
      float z = p.gla_b[d * 256 + ch];
#pragma unroll
      for (int r = 0; r < 16; ++r) z += bf2f(row[3584 + d * 16 + r]) * p.gla_w_up[(d * 16 + r) * 256 + ch];
      sq[e] = bf2f(row[2048 + ch]) * 0.125f;
      sk[e] = bf2f(row[2304 + ch]);
      sf[e] = __expf(log_sigmoid_f(z) * (1.f / 16.f));
    }
#pragma unroll 1
    for (int i = 0; i < 16; ++i) {
      const int e = tid + i * 256;
      const int c2 = e & 127, s = (e >> 7) & 15, d = e >> 11;
      const int t = d ? 4095 - (p0 + s) : (p0 + s);
      sv[e] = bf2f(proj[(size_t)(b * 4096 + t) * EVEN_N + 2560 + h * 128 + c2]);
    }
    __syncthreads();
#pragma unroll 1
    for (int s = 0; s < 16; ++s) {
      const float v = sv[(dir * 16 + s) * 128 + col];
      const float4* q4 = (const float4*)(sq + (dir * 16 + s) * 64);
      const float4* k4 = (const float4*)(sk + (dir * 16 + s) * 64);
      const float4* f4 = (const float4*)(sf + (dir * 16 + s) * 64);
      float o = 0.f;
#pragma unroll
      for (int kk = 0; kk < 16; ++kk) {
        float4 qq = q4[kk], kx = k4[kk], ff = f4[kk];
        S[kk * 4 + 0] = ff.x * S[kk * 4 + 0] + kx.x * v; o += qq.x * S[kk * 4 + 0];
        S[kk * 4 + 1] = ff.y * S[kk * 4 + 1] + kx.y * v; o += qq.y * S[kk * 4 + 1];
        S[kk * 4 + 2] = ff.z * S[kk * 4 + 2] + kx.z * v; o += qq.z * S[kk * 4 + 2];
        S[kk * 4 + 3] = ff.w * S[kk * 4 + 3] + kx.w * v; o += qq.w * S[kk * 4 + 3];
      }
      const int t = dir ? 4095 - (p0 + s) : (p0 + s);
      obuf[((size_t)dir * M_TOK + b * 4096 + t) * 512 + h * 128 + col] = o;
    }
  }
}

__device__ __forceinline__ void phase_post128(const P& p, const float* g, int ldp, int gate_off, int y_off) {
  const bf16* proj = (const bf16*)(p.ws + WS_PROJ);
  const float* obuf = (const float*)(p.ws + WS_O);
  bf16* yb = (bf16*)(p.ws + WS_H);
  const int lane = threadIdx.x & 63, wave = threadIdx.x >> 6;
  for (int it = blockIdx.x * 4 + wave; it < M_TOK * 4; it += gridDim.x * 4) {
    const int tok = it >> 2, h = it & 3;
    const int c = h * 128 + lane * 2;
    float2 a = *(const float2*)(obuf + (size_t)tok * 512 + c);
    float2 b2 = *(const float2*)(obuf + ((size_t)M_TOK + tok) * 512 + c);
    float o0 = a.x + b2.x, o1 = a.y + b2.y;
    float ss = wave_sum(o0 * o0 + o1 * o1);
    float rs = rsqrtf(ss * (1.f / 128.f) + 1e-6f);
    unsigned gg = *(const unsigned*)(proj + (size_t)tok * ldp + gate_off + c);
    float g0 = __uint_as_float(gg << 16), g1 = __uint_as_float(gg & 0xffff0000u);
    float y0 = o0 * rs * g[lane * 2] * silu_f(g0);
    float y1 = o1 * rs * g[lane * 2 + 1] * silu_f(g1);
    *(unsigned*)(yb + (size_t)tok * 1024 + y_off + c) = (unsigned)f2bf(y0) | ((unsigned)f2bf(y1) << 16);
  }
}

__device__ __forceinline__ void hgrn_scan_item(const P& p, int item, unsigned char* smem) {
  const int b = item >> 2, h = item & 3;
  float* sq = (float*)smem;
  float* sk = sq + 4096;
  float* sf = sk + 4096;
  float* sv = sf + 4096;
  const int tid = threadIdx.x, dir = tid >> 7, col = tid & 127;
  const bf16* proj = (const bf16*)(p.ws + WS_PROJ);
  const float* lbv = (const float*)(p.ws + WS_LB);
  float* obuf = (float*)(p.ws + WS_O);
  float S[128];
#pragma unroll
  for (int i = 0; i < 128; ++i) S[i] = 0.f;
  for (int p0 = 0; p0 < 4096; p0 += 16) {
    __syncthreads();
#pragma unroll 1
    for (int i = 0; i < 16; ++i) {
      const int e = tid + i * 256;
      const int kch = e & 127, s = (e >> 7) & 15, d = e >> 11;
      const int t = d ? 4095 - (p0 + s) : (p0 + s);
      const bf16* row = proj + (size_t)(b * 4096 + t) * ODD_N;
      const int ch = h * 128 + kch;
      const float lb = lbv[ch];
      const float z = bf2f(row[512 + d * 512 + ch]);
      sq[e] = bf2f(row[ch]) * 0.08838834764831845f;
      sk[e] = (1.f - lb) * sigmoid_f(-z);
      sf[e] = lb + (1.f - lb) * sigmoid_f(z);
      sv[e] = bf2f(row[1536 + ch]);
    }
    __syncthreads();
#pragma unroll 1
    for (int s = 0; s < 16; ++s) {
      const float v = sv[(dir * 16 + s) * 128 + col];
      const float4* q4 = (const float4*)(sq + (dir * 16 + s) * 128);
      const float4* k4 = (const float4*)(sk + (dir * 16 + s) * 128);
      const float4* f4 = (const float4*)(sf + (dir * 16 + s) * 128);
      float o = 0.f;
#pragma unroll
      for (int kk = 0; kk < 32; ++kk) {
        float4 qq = q4[kk], kx = k4[kk], ff = f4[kk];
        S[kk * 4 + 0] = ff.x * S[kk * 4 + 0] + kx.x * v; o += qq.x * S[kk * 4 + 0];
        S[kk * 4 + 1] = ff.y * S[kk * 4 + 1] + kx.y * v; o += qq.y * S[kk * 4 + 1];
        S[kk * 4 + 2] = ff.z * S[kk * 4 + 2] + kx.z * v; o += qq.z * S[kk * 4 + 2];
        S[kk * 4 + 3] = ff.w * S[kk * 4 + 3] + kx.w * v; o += qq.w * S[kk * 4 + 3];
      }
      const int t = dir ? 4095 - (p0 + s) : (p0 + s);
      obuf[((size_t)dir * M_TOK + b * 4096 + t) * 512 + h * 128 + col] = o;
    }
  }
}


template <int K, int MODE>
struct GateC {
  float w[16];
  float bias, lb;
  int d, ch;
  __device__ __forceinline__ void init(const P& p, int d_, int h, int k) {
    d = d_; ch = h * K + k;
    if (MODE == 0) {
#pragma unroll
      for (int r = 0; r < 16; ++r) w[r] = p.gla_w_up[(d * 16 + r) * 256 + ch];
      bias = p.gla_b[d * 256 + ch];
      lb = 0.f;
    } else {
      lb = ((const float*)(p.ws + WS_LB))[ch];
      bias = 0.f;
    }
  }
  __device__ __forceinline__ void eval(const bf16* row, float& g, float& kval, float& qval) const {
    if (MODE == 0) {
      uint4 u0 = *(const uint4*)(row + 3584 + d * 16);
      uint4 u1 = *(const uint4*)(row + 3584 + d * 16 + 8);
      float z = bias;
      z += w[0] * __uint_as_float(u0.x << 16) + w[1] * __uint_as_float(u0.x & 0xffff0000u);
      z += w[2] * __uint_as_float(u0.y << 16) + w[3] * __uint_as_float(u0.y & 0xffff0000u);
      z += w[4] * __uint_as_float(u0.z << 16) + w[5] * __uint_as_float(u0.z & 0xffff0000u);
      z += w[6] * __uint_as_float(u0.w << 16) + w[7] * __uint_as_float(u0.w & 0xffff0000u);
      z += w[8] * __uint_as_float(u1.x << 16) + w[9] * __uint_as_float(u1.x & 0xffff0000u);
      z += w[10] * __uint_as_float(u1.y << 16) + w[11] * __uint_as_float(u1.y & 0xffff0000u);
      z += w[12] * __uint_as_float(u1.z << 16) + w[13] * __uint_as_float(u1.z & 0xffff0000u);
      z += w[14] * __uint_as_float(u1.w << 16) + w[15] * __uint_as_float(u1.w & 0xffff0000u);
      g = log_sigmoid_f(z) * (1.f / 16.f);
      kval = bf2f(row[2304 + ch]);
      qval = bf2f(row[2048 + ch]) * 0.125f;
    } else {
      const float z = bf2f(row[512 + d * 512 + ch]);
      const float e = __expf(-z);
      const float sg = 1.f / (1.f + e);
      kval = (1.f - lb) * e * sg;
      g = log1pf(-kval);
      qval = bf2f(row[ch]) * 0.08838834764831845f;
    }
  }
};

template <int MODE>
__device__ __forceinline__ void stage_vt(const bf16* proj, int h, bf16* VT) {
  constexpr int LDP = MODE == 0 ? EVEN_N : ODD_N;
  constexpr int VOFF = MODE == 0 ? 2560 : 1536;
  const int j = threadIdx.x & 63, cgp = threadIdx.x >> 6;
#pragma unroll
  for (int cc = 0; cc < 4; ++cc) {
    const int c = cgp * 4 + cc;
    uint4 u = *(const uint4*)(proj + (size_t)j * LDP + VOFF + h * 128 + c * 8);
    bf16* dst = VT + (c * 8) * 72 + j;
    dst[0 * 72] = (bf16)(u.x & 0xffffu); dst[1 * 72] = (bf16)(u.x >> 16);
    dst[2 * 72] = (bf16)(u.y & 0xffffu); dst[3 * 72] = (bf16)(u.y >> 16);
    dst[4 * 72] = (bf16)(u.z & 0xffffu); dst[5 * 72] = (bf16)(u.z >> 16);
    dst[6 * 72] = (bf16)(u.w & 0xffffu); dst[7 * 72] = (bf16)(u.w >> 16);
  }
}

__device__ __forceinline__ uint2 pack4(f32x4 a) {
  uint2 o;
  o.x = (unsigned)f2bf(a[0]) | ((unsigned)f2bf(a[1]) << 16);
  o.y = (unsigned)f2bf(a[2]) | ((unsigned)f2bf(a[3]) << 16);
  return o;
}

template <int K, int MODE>
__device__ __forceinline__ void rec_pass1_item(const P& p, int item, unsigned char* smem) {
  constexpr int LDP = MODE == 0 ? EVEN_N : ODD_N;
  const int h = item & 3, blk = (item >> 2) & 63, b = item >> 8;
  bf16* KT = (bf16*)smem;
  bf16* VT = KT + 2 * K * 72;
  const bf16* proj = (const bf16*)(p.ws + WS_PROJ) + (size_t)(b * 4096 + blk * 64) * LDP;
  bf16* ST = (bf16*)(p.ws + WS_ST);
  float* DEC = (float*)(p.ws + WS_DEC);
  const int tid = threadIdx.x, lane = tid & 63, wave = tid >> 6;
  stage_vt<MODE>(proj, h, VT);
  if (tid < 2 * K) {
    const int d = tid / K, k = tid % K;
    GateC<K, MODE> gc;
    gc.init(p, d, h, k);
    bf16* row = KT + (d * K + k) * 72;
    float r = 0.f;
#pragma unroll 4
    for (int i = 63; i >= 0; --i) {
      const int j = d ? 63 - i : i;
      float g, kv, qv;
      gc.eval(proj + (size_t)j * LDP, g, kv, qv);
      row[j] = f2bf(kv * __expf(r));
      r += g;
    }
    DEC[(size_t)((((d * 4 + b) * 4 + h) * 64 + blk)) * K + k] = __expf(r);
  }
  __syncthreads();
#pragma unroll 1
  for (int d = 0; d < 2; ++d) {
    f32x4 acc[K / 16][2];
#pragma unroll
    for (int kt = 0; kt < K / 16; ++kt) { acc[kt][0] = (f32x4){0.f, 0.f, 0.f, 0.f}; acc[kt][1] = (f32x4){0.f, 0.f, 0.f, 0.f}; }
#pragma unroll
    for (int ks = 0; ks < 2; ++ks) {
      bf16x8 vf0 = *(const bf16x8*)(VT + ((wave * 2 + 0) * 16 + (lane & 15)) * 72 + ks * 32 + (lane >> 4) * 8);
      bf16x8 vf1 = *(const bf16x8*)(VT + ((wave * 2 + 1) * 16 + (lane & 15)) * 72 + ks * 32 + (lane >> 4) * 8);
#pragma unroll
      for (int kt = 0; kt < K / 16; ++kt) {
        bf16x8 kf = *(const bf16x8*)(KT + (d * K + kt * 16 + (lane & 15)) * 72 + ks * 32 + (lane >> 4) * 8);
        acc[kt][0] = __builtin_amdgcn_mfma_f32_16x16x32_bf16(kf, vf0, acc[kt][0], 0, 0, 0);
        acc[kt][1] = __builtin_amdgcn_mfma_f32_16x16x32_bf16(kf, vf1, acc[kt][1], 0, 0, 0);
      }
    }
    bf16* stb = ST + (size_t)((((d * 4 + b) * 4 + h) * 64 + blk)) * 128 * K;
#pragma unroll
    for (int kt = 0; kt < K / 16; ++kt)
#pragma unroll
      for (int vv = 0; vv < 2; ++vv) {
        const int v = (wave * 2 + vv) * 16 + (lane & 15);
        const int k0 = kt * 16 + (lane >> 4) * 4;
        *(uint2*)(stb + (size_t)v * K + k0) = pack4(acc[kt][vv]);
      }
  }
}

template <int K>
__device__ __forceinline__ void phase_rec_scan(const P& p) {
  bf16* ST = (bf16*)(p.ws + WS_ST);
  const float* DEC = (const float*)(p.ws + WS_DEC);
  constexpr int KV = K / 4;
  const int total = 32 * 128 * KV;
  for (int idx = blockIdx.x * 256 + threadIdx.x; idx < total; idx += gridDim.x * 256) {
    const int kq = idx % KV, v = (idx / KV) & 127, s = idx / (KV * 128);
    const int d = s >> 4;
    float st0 = 0.f, st1 = 0.f, st2 = 0.f, st3 = 0.f;
#pragma unroll 1
    for (int n0 = 0; n0 < 64; n0 += 8) {
      uint2 u[8];
      float4 dc[8];
#pragma unroll
      for (int q = 0; q < 8; ++q) {
        const int blk = d ? 63 - (n0 + q) : (n0 + q);
        u[q] = *(const uint2*)(ST + ((size_t)(s * 64 + blk) * 128 + v) * K + kq * 4);
        dc[q] = *(const float4*)(DEC + (size_t)(s * 64 + blk) * K + kq * 4);
      }
#pragma unroll
      for (int q = 0; q < 8; ++q) {
        const int blk = d ? 63 - (n0 + q) : (n0 + q);
        uint2 o;
        o.x = (unsigned)f2bf(st0) | ((unsigned)f2bf(st1) << 16);
        o.y = (unsigned)f2bf(st2) | ((unsigned)f2bf(st3) << 16);
        *(uint2*)(ST + ((size_t)(s * 64 + blk) * 128 + v) * K + kq * 4) = o;
        st0 = dc[q].x * st0 + __uint_as_float(u[q].x << 16);
        st1 = dc[q].y * st1 + __uint_as_float(u[q].x & 0xffff0000u);
        st2 = dc[q].z * st2 + __uint_as_float(u[q].y << 16);
        st3 = dc[q].w * st3 + __uint_as_float(u[q].y & 0xffff0000u);
      }
    }
  }
}

template <int K, int MODE>
__device__ __forceinline__ void rec_pass3_item(const P& p, int item, unsigned char* smem) {
  constexpr int LDP = MODE == 0 ? EVEN_N : ODD_N;
  constexpr int KS = K + 8;
  constexpr int GOFF = MODE == 0 ? 3072 : 2048;
  constexpr int YOFF = MODE == 0 ? 512 : 0;
  const int h = item & 3, blk = (item >> 2) & 63, b = item >> 8;
  bf16* QI = (bf16*)smem;
  bf16* KI = QI + 64 * KS;
  bf16* VT = KI + 64 * KS;
  bf16* AI = VT + 128 * 72;
  float* CV = (float*)(AI + 64 * 72);
  float* SSQ = CV + K;
  const bf16* proj = (const bf16*)(p.ws + WS_PROJ) + (size_t)(b * 4096 + blk * 64) * LDP;
  const bf16* ST = (const bf16*)(p.ws + WS_ST);
  bf16* yb = (bf16*)(p.ws + WS_H);
  const int tid = threadIdx.x, lane = tid & 63, wave = tid >> 6;
  stage_vt<MODE>(proj, h, VT);
  f32x4 o[2][4];
#pragma unroll
  for (int vv = 0; vv < 2; ++vv)
#pragma unroll
    for (int it = 0; it < 4; ++it) o[vv][it] = (f32x4){0.f, 0.f, 0.f, 0.f};
#pragma unroll 1
  for (int d = 0; d < 2; ++d) {
    if (d) __syncthreads();
    if (tid < 2 * K) {
      const int k = tid % K, half = tid / K;
      GateC<K, MODE> gc;
      gc.init(p, d, h, k);
      float run = 0.f;
      if (half) {
#pragma unroll 4
        for (int i = 32; i < 64; ++i) {
          const int j = d ? 63 - i : i;
          float g, kv, qv;
          gc.eval(proj + (size_t)j * LDP, g, kv, qv);
          run += g;
          QI[j * KS + k] = f2bf(qv * __expf(run));
          KI[j * KS + k] = f2bf(kv * __expf(-run));
        }
      } else {
#pragma unroll 4
        for (int i = 31; i >= 0; --i) {
          const int j = d ? 63 - i : i;
          float g, kv, qv;
          gc.eval(proj + (size_t)j * LDP, g, kv, qv);
          QI[j * KS + k] = f2bf(qv * __expf(-run));
          KI[j * KS + k] = f2bf(kv * __expf(run));
          run += g;
        }
        CV[k] = __expf(run);
      }
    }
    __syncthreads();
    {
      f32x4 a[4];
#pragma unroll
      for (int jt = 0; jt < 4; ++jt) a[jt] = (f32x4){0.f, 0.f, 0.f, 0.f};
#pragma unroll
      for (int ks = 0; ks < K / 32; ++ks) {
        bf16x8 qf = *(const bf16x8*)(QI + (wave * 16 + (lane & 15)) * KS + ks * 32 + (lane >> 4) * 8);
#pragma unroll
        for (int jt = 0; jt < 4; ++jt) {
          bf16x8 kf = *(const bf16x8*)(KI + (jt * 16 + (lane & 15)) * KS + ks * 32 + (lane >> 4) * 8);
          a[jt] = __builtin_amdgcn_mfma_f32_16x16x32_bf16(kf, qf, a[jt], 0, 0, 0);
        }
      }
      const int i = wave * 16 + (lane & 15);
#pragma unroll
      for (int jt = 0; jt < 4; ++jt) {
        const int j0 = jt * 16 + (lane >> 4) * 4;
        f32x4 m;
#pragma unroll
        for (int r = 0; r < 4; ++r) {
          const int j = j0 + r;
          const bool valid = d ? (j >= i) : (j <= i);
          m[r] = valid ? a[jt][r] : 0.f;
        }
        *(uint2*)(AI + i * 72 + j0) = pack4(m);
      }
    }
    __syncthreads();
#pragma unroll
    for (int ks = 0; ks < 2; ++ks) {
      bf16x8 vf0 = *(const bf16x8*)(VT + ((wave * 2 + 0) * 16 + (lane & 15)) * 72 + ks * 32 + (lane >> 4) * 8);
      bf16x8 vf1 = *(const bf16x8*)(VT + ((wave * 2 + 1) * 16 + (lane & 15)) * 72 + ks * 32 + (lane >> 4) * 8);
#pragma unroll
      for (int it = 0; it < 4; ++it) {
        bf16x8 af = *(const bf16x8*)(AI + (it * 16 + (lane & 15)) * 72 + ks * 32 + (lane >> 4) * 8);
        o[0][it] = __builtin_amdgcn_mfma_f32_16x16x32_bf16(vf0, af, o[0][it], 0, 0, 0);
        o[1][it] = __builtin_amdgcn_mfma_f32_16x16x32_bf16(vf1, af, o[1][it], 0, 0, 0);
      }
    }
    const bf16* stb = ST + (size_t)((((d * 4 + b) * 4 + h) * 64 + blk)) * 128 * K;
#pragma unroll
    for (int ks = 0; ks < K / 32; ++ks) {
      const int kk = ks * 32 + (lane >> 4) * 8;
      float4 c0 = *(const float4*)(CV + kk), c1 = *(const float4*)(CV + kk + 4);
      bf16x8 sf[2];
#pragma unroll
      for (int vv = 0; vv < 2; ++vv) {
        uint4 u = *(const uint4*)(stb + (size_t)((wave * 2 + vv) * 16 + (lane & 15)) * K + kk);
        uint4 w;
        w.x = (unsigned)f2bf(__uint_as_float(u.x << 16) * c0.x) | ((unsigned)f2bf(__uint_as_float(u.x & 0xffff0000u) * c0.y) << 16);
        w.y = (unsigned)f2bf(__uint_as_float(u.y << 16) * c0.z) | ((unsigned)f2bf(__uint_as_float(u.y & 0xffff0000u) * c0.w) << 16);
        w.z = (unsigned)f2bf(__uint_as_float(u.z << 16) * c1.x) | ((unsigned)f2bf(__uint_as_float(u.z & 0xffff0000u) * c1.y) << 16);
        w.w = (unsigned)f2bf(__uint_as_float(u.w << 16) * c1.z) | ((unsigned)f2bf(__uint_as_float(u.w & 0xffff0000u) * c1.w) << 16);
        sf[vv] = *(bf16x8*)&w;
      }
#pragma unroll
      for (int it = 0; it < 4; ++it) {
        bf16x8 qf = *(const bf16x8*)(QI + (it * 16 + (lane & 15)) * KS + kk);
        o[0][it] = __builtin_amdgcn_mfma_f32_16x16x32_bf16(sf[0], qf, o[0][it], 0, 0, 0);
        o[1][it] = __builtin_amdgcn_mfma_f32_16x16x32_bf16(sf[1], qf, o[1][it], 0, 0, 0);
      }
    }
  }
  {
    float ss[4];
#pragma unroll
    for (int it = 0; it < 4; ++it) {
      float s = 0.f;
#pragma unroll
      for (int vv = 0; vv < 2; ++vv)
#pragma unroll
        for (int r = 0; r < 4; ++r) s += o[vv][it][r] * o[vv][it][r];
      s += __shfl_xor(s, 16, 64);
      s += __shfl_xor(s, 32, 64);
      ss[it] = s;
    }
    if (lane < 16) {
#pragma unroll
      for (int it = 0; it < 4; ++it) SSQ[wave * 64 + it * 16 + lane] = ss[it];
    }
    __syncthreads();
    const float* gn = MODE == 0 ? p.gla_g : p.hgrn_g;
#pragma unroll
    for (int it = 0; it < 4; ++it) {
      const int i = it * 16 + (lane & 15);
      const float tot = SSQ[i] + SSQ[64 + i] + SSQ[128 + i] + SSQ[192 + i];
      const float rs = rsqrtf(tot * (1.f / 128.f) + 1e-6f);
#pragma unroll
      for (int vv = 0; vv < 2; ++vv) {
        const int v0 = (wave * 2 + vv) * 16 + (lane >> 4) * 4;
        uint2 gu = *(const uint2*)(proj + (size_t)i * LDP + GOFF + h * 128 + v0);
        float4 gg = *(const float4*)(gn + v0);
        f32x4 y;
        y[0] = o[vv][it][0] * rs * gg.x * silu_f(__uint_as_float(gu.x << 16));
        y[1] = o[vv][it][1] * rs * gg.y * silu_f(__uint_as_float(gu.x & 0xffff0000u));
        y[2] = o[vv][it][2] * rs * gg.z * silu_f(__uint_as_float(gu.y << 16));
        y[3] = o[vv][it][3] * rs * gg.w * silu_f(__uint_as_float(gu.y & 0xffff0000u));
        *(uint2*)(yb + (size_t)(b * 4096 + blk * 64 + i) * 1024 + YOFF + h * 128 + v0) = pack4(y);
      }
    }
  }
}

__device__ __forceinline__ float conv_elem(const P& p, const bf16* proj, int b, int t, int c) {
  float acc = p.conv_b[c];
#pragma unroll
  for (int j = 0; j < 4; ++j) {
    const int tt = t + j - 2;
    if (tt >= 0 && tt < 4096) acc += p.conv_w[j * 1024 + c] * bf2f(proj[(size_t)(b * 4096 + tt) * ODD_N + 3072 + c]);
  }
  return silu_f(acc);
}

__device__ __forceinline__ void ssd_scan_item(const P& p, int item, unsigned char* smem) {
  const int b = item >> 2, g = (item >> 1) & 1, dir = item & 1;
  float* sB = (float*)smem;
  float* sC = sB + 2048;
  float* sx = sC + 2048;
  float* sdec = sx + 4096;
  const int tid = threadIdx.x, rp = tid >> 6, pp = tid & 63, head = g * 4 + rp;
  const bf16* proj = (const bf16*)(p.ws + WS_PROJ);
  float* obuf = (float*)(p.ws + WS_O);
  float S[128];
#pragma unroll
  for (int i = 0; i < 128; ++i) S[i] = 0.f;
  const float dtb = p.dt_bias[dir * 8 + head];
  const float Aneg = -__expf(p.a_log[dir * 8 + head]);
  for (int p0 = 0; p0 < 4096; p0 += 16) {
    __syncthreads();
#pragma unroll 1
    for (int i = 0; i < 16; ++i) {
      const int e = tid + i * 256;
      const int n = e & 127, bc = (e >> 7) & 1, s = e >> 8;
      const int t = dir ? 4095 - (p0 + s) : (p0 + s);
      const float v = conv_elem(p, proj, b, t, 512 + bc * 256 + g * 128 + n);
      if (bc == 0) sB[s * 128 + n] = v; else sC[s * 128 + n] = v;
    }
#pragma unroll 1
    for (int s = 0; s < 16; ++s) {
      const int t = dir ? 4095 - (p0 + s) : (p0 + s);
      const float dt = softplus_f(bf2f(proj[(size_t)(b * 4096 + t) * ODD_N + 4096 + dir * 8 + head]) + dtb);
      sx[s * 256 + tid] = conv_elem(p, proj, b, t, head * 64 + pp) * dt;
      if (pp == 0) sdec[s * 4 + rp] = __expf(Aneg * dt);
    }
    __syncthreads();
#pragma unroll 1
    for (int s = 0; s < 16; ++s) {
      const float v = sx[s * 256 + tid];
      const float dec = sdec[s * 4 + rp];
      const float4* b4 = (const float4*)(sB + s * 128);
      const float4* c4 = (const float4*)(sC + s * 128);
      float o = 0.f;
#pragma unroll
      for (int kk = 0; kk < 32; ++kk) {
        float4 bx = b4[kk], cx = c4[kk];
        S[kk * 4 + 0] = dec * S[kk * 4 + 0] + bx.x * v; o += cx.x * S[kk * 4 + 0];
        S[kk * 4 + 1] = dec * S[kk * 4 + 1] + bx.y * v; o += cx.y * S[kk * 4 + 1];
        S[kk * 4 + 2] = dec * S[kk * 4 + 2] + bx.z * v; o += cx.z * S[kk * 4 + 2];
        S[kk * 4 + 3] = dec * S[kk * 4 + 3] + bx.w * v; o += cx.w * S[kk * 4 + 3];
      }
      const int t = dir ? 4095 - (p0 + s) : (p0 + s);
      obuf[((size_t)dir * M_TOK + b * 4096 + t) * 512 + head * 64 + pp] = o;
    }
  }
}

__device__ __forceinline__ void phase_ssd_post(const P& p) {
  const bf16* proj = (const bf16*)(p.ws + WS_PROJ);
  const float* obuf = (const float*)(p.ws + WS_O);
  bf16* yb = (bf16*)(p.ws + WS_H);
  const int lane = threadIdx.x & 63, wave = threadIdx.x >> 6;
  for (int tok = blockIdx.x * 4 + wave; tok < M_TOK; tok += gridDim.x * 4) {
    const int b = tok >> 12, t = tok & 4095;
    float y[8];
    float ss = 0.f;
#pragma unroll
    for (int i = 0; i < 8; ++i) {
      const int c = lane * 8 + i;
      const float xs = conv_elem(p, proj, b, t, c);
      const float dz = bf2f(proj[(size_t)tok * ODD_N + 2560 + c]);
      float v = obuf[(size_t)tok * 512 + c] + obuf[((size_t)M_TOK + tok) * 512 + c] + p.d_skip[c >> 6] * xs;
      v *= silu_f(dz);
      y[i] = v;
      ss += v * v;
    }
    ss = wave_sum(ss);
    const float rs = rsqrtf(ss * (1.f / 512.f) + 1e-6f);
    uint4 w;
    unsigned u[4];
#pragma unroll
    for (int i = 0; i < 4; ++i) {
      const int c = lane * 8 + i * 2;
      u[i] = (unsigned)f2bf(y[i * 2] * rs * p.ssm_g[c]) | ((unsigned)f2bf(y[i * 2 + 1] * rs * p.ssm_g[c + 1]) << 16);
    }
    w.x = u[0]; w.y = u[1]; w.z = u[2]; w.w = u[3];
    *(uint4*)(yb + (size_t)tok * 1024 + 512 + lane * 8) = w;
  }
}


__device__ __forceinline__ void conv8(const P& p, const bf16* projb, int t, int c0, float* o8) {
  float4 b0 = *(const float4*)(p.conv_b + c0), b1 = *(const float4*)(p.conv_b + c0 + 4);
  float a[8] = {b0.x, b0.y, b0.z, b0.w, b1.x, b1.y, b1.z, b1.w};
#pragma unroll
  for (int jt = 0; jt < 4; ++jt) {
    const int tt = t + jt - 2;
    if (tt >= 0 && tt < 4096) {
      uint4 u = *(const uint4*)(projb + (size_t)tt * ODD_N + 3072 + c0);
      float4 w0 = *(const float4*)(p.conv_w + jt * 1024 + c0), w1 = *(const float4*)(p.conv_w + jt * 1024 + c0 + 4);
      a[0] += w0.x * __uint_as_float(u.x << 16); a[1] += w0.y * __uint_as_float(u.x & 0xffff0000u);
      a[2] += w0.z * __uint_as_float(u.y << 16); a[3] += w0.w * __uint_as_float(u.y & 0xffff0000u);
      a[4] += w1.x * __uint_as_float(u.z << 16); a[5] += w1.y * __uint_as_float(u.z & 0xffff0000u);
      a[6] += w1.z * __uint_as_float(u.w << 16); a[7] += w1.w * __uint_as_float(u.w & 0xffff0000u);
    }
  }
#pragma unroll
  for (int e = 0; e < 8; ++e) o8[e] = silu_f(a[e]);
}

__device__ __forceinline__ void ssd_prep_acum(const P& p, const bf16* projb, int blk, int g, float* ACUM, float* DTV, float* TOT) {
  const int lane = threadIdx.x & 63, wave = threadIdx.x >> 6;
#pragma unroll
  for (int q = 0; q < 2; ++q) {
    const int c = wave * 2 + q, dir = c >> 2, rp = c & 3, head = g * 4 + rp;
    const int j = dir ? 63 - lane : lane;
    const int t = blk * 64 + j;
    const float dt = softplus_f(bf2f(projb[(size_t)t * ODD_N + 4096 + dir * 8 + head]) + p.dt_bias[dir * 8 + head]);
    float v = -__expf(p.a_log[dir * 8 + head]) * dt;
#pragma unroll
    for (int off = 1; off < 64; off <<= 1) {
      float tmp = __shfl_up(v, off, 64);
      if (lane >= off) v += tmp;
    }
    ACUM[c * 64 + j] = v;
    DTV[c * 64 + j] = dt;
    if (lane == 63) TOT[c] = v;
  }
}

__device__ __forceinline__ void ssd_pass1_item(const P& p, int item, unsigned char* smem) {
  const int g = item & 1, blk = (item >> 1) & 63, b = item >> 7;
  bf16* BT = (bf16*)smem;
  bf16* XT = BT + 128 * 72;
  float* ACUM = (float*)(XT + 256 * 72);
  float* DTV = ACUM + 512;
  float* TOT = DTV + 512;
  const bf16* projb = (const bf16*)(p.ws + WS_PROJ) + (size_t)b * 4096 * ODD_N;
  bf16* ST = (bf16*)(p.ws + WS_ST);
  float* DEC = (float*)(p.ws + WS_DEC);
  const int tid = threadIdx.x, lane = tid & 63, wave = tid >> 6;
  const int t = blk * 64 + lane;
  ssd_prep_acum(p, projb, blk, g, ACUM, DTV, TOT);
#pragma unroll 1
  for (int q = 0; q < 4; ++q) {
    const int cc = wave + 4 * q;
    float v8[8];
    conv8(p, projb, t, 512 + g * 128 + cc * 8, v8);
#pragma unroll
    for (int e = 0; e < 8; ++e) BT[(cc * 8 + e) * 72 + lane] = f2bf(v8[e]);
  }
  float xs[8][8];
#pragma unroll
  for (int q = 0; q < 8; ++q) conv8(p, projb, t, g * 256 + (wave * 8 + q) * 8, xs[q]);
  __syncthreads();
  if (tid < 8) {
    const int dir = tid >> 2, head = g * 4 + (tid & 3);
    DEC[(size_t)((dir * 4 + b) * 8 + head) * 64 + blk] = __expf(TOT[tid]);
  }
#pragma unroll 1
  for (int dir = 0; dir < 2; ++dir) {
    if (dir) __syncthreads();
    const int c = dir * 4 + wave;
    const float fac = DTV[c * 64 + lane] * __expf(TOT[c] - ACUM[c * 64 + lane]);
#pragma unroll
    for (int q = 0; q < 8; ++q)
#pragma unroll
      for (int e = 0; e < 8; ++e) XT[((wave * 8 + q) * 8 + e) * 72 + lane] = f2bf(xs[q][e] * fac);
    __syncthreads();
    const int head = g * 4 + wave;
    bf16* stb = ST + (size_t)(((dir * 4 + b) * 8 + head) * 64 + blk) * 8192;
#pragma unroll 1
    for (int nh = 0; nh < 2; ++nh) {
      f32x4 acc[4][4];
#pragma unroll
      for (int nt = 0; nt < 4; ++nt)
#pragma unroll
        for (int pt = 0; pt < 4; ++pt) acc[nt][pt] = (f32x4){0.f, 0.f, 0.f, 0.f};
#pragma unroll
      for (int ks = 0; ks < 2; ++ks) {
        bf16x8 xf[4];
#pragma unroll
        for (int pt = 0; pt < 4; ++pt) xf[pt] = *(const bf16x8*)(XT + (wave * 64 + pt * 16 + (lane & 15)) * 72 + ks * 32 + (lane >> 4) * 8);
#pragma unroll
        for (int nt = 0; nt < 4; ++nt) {
          bf16x8 bfv = *(const bf16x8*)(BT + ((nh * 4 + nt) * 16 + (lane & 15)) * 72 + ks * 32 + (lane >> 4) * 8);
#pragma unroll
          for (int pt = 0; pt < 4; ++pt) acc[nt][pt] = __builtin_amdgcn_mfma_f32_16x16x32_bf16(bfv, xf[pt], acc[nt][pt], 0, 0, 0);
        }
      }
#pragma unroll
      for (int nt = 0; nt < 4; ++nt)
#pragma unroll
        for (int pt = 0; pt < 4; ++pt) {
          const int pp = pt * 16 + (lane & 15);
          const int n0 = (nh * 4 + nt) * 16 + (lane >> 4) * 4;
          *(uint2*)(stb + (size_t)pp * 128 + n0) = pack4(acc[nt][pt]);
        }
    }
  }
}

__device__ __forceinline__ void phase_ssd_scan(const P& p) {
  bf16* ST = (bf16*)(p.ws + WS_ST);
  const float* DEC = (const float*)(p.ws + WS_DEC);
  const int total = 64 * 2048;
  for (int idx = blockIdx.x * 256 + threadIdx.x; idx < total; idx += gridDim.x * 256) {
    const int e4 = idx & 2047, s = idx >> 11;
    const int d = s >> 5;
    float st0 = 0.f, st1 = 0.f, st2 = 0.f, st3 = 0.f;
#pragma unroll 1
    for (int n0 = 0; n0 < 64; n0 += 8) {
      uint2 u[8];
      float dc[8];
#pragma unroll
      for (int q = 0; q < 8; ++q) {
        const int blk = d ? 63 - (n0 + q) : (n0 + q);
        u[q] = *(const uint2*)(ST + (size_t)(s * 64 + blk) * 8192 + e4 * 4);
        dc[q] = DEC[s * 64 + blk];
      }
#pragma unroll
      for (int q = 0; q < 8; ++q) {
        const int blk = d ? 63 - (n0 + q) : (n0 + q);
        uint2 o;
        o.x = (unsigned)f2bf(st0) | ((unsigned)f2bf(st1) << 16);
        o.y = (unsigned)f2bf(st2) | ((unsigned)f2bf(st3) << 16);
        *(uint2*)(ST + (size_t)(s * 64 + blk) * 8192 + e4 * 4) = o;
        st0 = dc[q] * st0 + __uint_as_float(u[q].x << 16);
        st1 = dc[q] * st1 + __uint_as_float(u[q].x & 0xffff0000u);
        st2 = dc[q] * st2 + __uint_as_float(u[q].y << 16);
        st3 = dc[q] * st3 + __uint_as_float(u[q].y & 0xffff0000u);
      }
    }
  }
}

__device__ __forceinline__ void ssd_pass3_item(const P& p, int item, unsigned char* smem) {
  const int g = item & 1, blk = (item >> 1) & 63, b = item >> 7;
  bf16* CI = (bf16*)smem;
  bf16* BI = CI + 64 * 136;
  bf16* AI = BI;
  bf16* XT = BI + 64 * 136;
  float* ACUM = (float*)(XT + 64 * 72);
  float* DTV = ACUM + 512;
  float* TOT = DTV + 512;
  float* SSQ = TOT + 8;
  const bf16* projb = (const bf16*)(p.ws + WS_PROJ) + (size_t)b * 4096 * ODD_N;
  const bf16* ST = (const bf16*)(p.ws + WS_ST);
  bf16* yb = (bf16*)(p.ws + WS_H);
  const int tid = threadIdx.x, lane = tid & 63, wave = tid >> 6;
  const int t = blk * 64 + lane;
  ssd_prep_acum(p, projb, blk, g, ACUM, DTV, TOT);
#pragma unroll 1
  for (int q = 0; q < 8; ++q) {
    const int cc = wave * 8 + q, which = cc >> 4, ch = (cc & 15) * 8;
    float v8[8];
    conv8(p, projb, t, 512 + which * 256 + g * 128 + ch, v8);
    uint4 w;
    w.x = (unsigned)f2bf(v8[0]) | ((unsigned)f2bf(v8[1]) << 16);
    w.y = (unsigned)f2bf(v8[2]) | ((unsigned)f2bf(v8[3]) << 16);
    w.z = (unsigned)f2bf(v8[4]) | ((unsigned)f2bf(v8[5]) << 16);
    w.w = (unsigned)f2bf(v8[6]) | ((unsigned)f2bf(v8[7]) << 16);
    *(uint4*)((which ? CI : BI) + lane * 136 + ch) = w;
  }
  __syncthreads();
  f32x4 gt[4];
#pragma unroll
  for (int jt = 0; jt < 4; ++jt) gt[jt] = (f32x4){0.f, 0.f, 0.f, 0.f};
#pragma unroll
  for (int ks = 0; ks < 4; ++ks) {
    bf16x8 cf = *(const bf16x8*)(CI + (wave * 16 + (lane & 15)) * 136 + ks * 32 + (lane >> 4) * 8);
#pragma unroll
    for (int jt = 0; jt < 4; ++jt) {
      bf16x8 bfv = *(const bf16x8*)(BI + (jt * 16 + (lane & 15)) * 136 + ks * 32 + (lane >> 4) * 8);
      gt[jt] = __builtin_amdgcn_mfma_f32_16x16x32_bf16(bfv, cf, gt[jt], 0, 0, 0);
    }
  }
  __syncthreads();
  float ssq_acc[4] = {0.f, 0.f, 0.f, 0.f};
#pragma unroll 1
  for (int rp = 0; rp < 4; ++rp) {
    const int head = g * 4 + rp;
#pragma unroll 1
    for (int q = 0; q < 2; ++q) {
      const int cc = wave * 2 + q;
      float v8[8];
      conv8(p, projb, t, head * 64 + cc * 8, v8);
#pragma unroll
      for (int e = 0; e < 8; ++e) XT[(cc * 8 + e) * 72 + lane] = f2bf(v8[e]);
    }
    f32x4 o[4];
#pragma unroll
    for (int it = 0; it < 4; ++it) o[it] = (f32x4){0.f, 0.f, 0.f, 0.f};
#pragma unroll 1
    for (int dir = 0; dir < 2; ++dir) {
      const int c = dir * 4 + rp;
      {
        const int i = wave * 16 + (lane & 15);
        const float aci = ACUM[c * 64 + i];
#pragma unroll
        for (int jt = 0; jt < 4; ++jt) {
          const int j0 = jt * 16 + (lane >> 4) * 4;
          f32x4 m;
#pragma unroll
          for (int r = 0; r < 4; ++r) {
            const int j = j0 + r;
            const bool valid = dir ? (j >= i) : (j <= i);
            const float arg = fminf(aci - ACUM[c * 64 + j], 0.f);
            m[r] = valid ? gt[jt][r] * __expf(arg) * DTV[c * 64 + j] : 0.f;
          }
          *(uint2*)(AI + i * 72 + j0) = pack4(m);
        }
      }
      __syncthreads();
#pragma unroll
      for (int ks = 0; ks < 2; ++ks) {
        bf16x8 xf = *(const bf16x8*)(XT + (wave * 16 + (lane & 15)) * 72 + ks * 32 + (lane >> 4) * 8);
#pragma unroll
        for (int it = 0; it < 4; ++it) {
          bf16x8 af = *(const bf16x8*)(AI + (it * 16 + (lane & 15)) * 72 + ks * 32 + (lane >> 4) * 8);
          o[it] = __builtin_amdgcn_mfma_f32_16x16x32_bf16(xf, af, o[it], 0, 0, 0);
        }
      }
      f32x4 tI[4];
#pragma unroll
      for (int it = 0; it < 4; ++it) tI[it] = (f32x4){0.f, 0.f, 0.f, 0.f};
      const bf16* stb = ST + (size_t)(((dir * 4 + b) * 8 + head) * 64 + blk) * 8192;
#pragma unroll
      for (int ks = 0; ks < 4; ++ks) {
        bf16x8 sf = *(const bf16x8*)(stb + (size_t)(wave * 16 + (lane & 15)) * 128 + ks * 32 + (lane >> 4) * 8);
#pragma unroll
        for (int it = 0; it < 4; ++it) {
          bf16x8 cf = *(const bf16x8*)(CI + (it * 16 + (lane & 15)) * 136 + ks * 32 + (lane >> 4) * 8);
          tI[it] = __builtin_amdgcn_mfma_f32_16x16x32_bf16(sf, cf, tI[it], 0, 0, 0);
        }
      }
#pragma unroll
      for (int it = 0; it < 4; ++it) {
        const float ea = __expf(ACUM[c * 64 + it * 16 + (lane & 15)]);
#pragma unroll
        for (int r = 0; r < 4; ++r) o[it][r] += ea * tI[it][r];
      }
      __syncthreads();
    }
    {
      const float dsk = p.d_skip[head];
      const int p0 = wave * 16 + (lane >> 4) * 4;
      float4 gg = *(const float4*)(p.ssm_g + head * 64 + p0);
#pragma unroll
      for (int it = 0; it < 4; ++it) {
        const int i = it * 16 + (lane & 15);
        const size_t tok = (size_t)b * 4096 + blk * 64 + i;
        uint2 zu = *(const uint2*)(projb + (size_t)(blk * 64 + i) * ODD_N + 2560 + head * 64 + p0);
        f32x4 y;
        y[0] = (o[it][0] + dsk * bf2f(XT[(p0 + 0) * 72 + i])) * silu_f(__uint_as_float(zu.x << 16));
        y[1] = (o[it][1] + dsk * bf2f(XT[(p0 + 1) * 72 + i])) * silu_f(__uint_as_float(zu.x & 0xffff0000u));
        y[2] = (o[it][2] + dsk * bf2f(XT[(p0 + 2) * 72 + i])) * silu_f(__uint_as_float(zu.y << 16));
        y[3] = (o[it][3] + dsk * bf2f(XT[(p0 + 3) * 72 + i])) * silu_f(__uint_as_float(zu.y & 0xffff0000u));
        ssq_acc[it] += y[0] * y[0] + y[1] * y[1] + y[2] * y[2] + y[3] * y[3];
        y[0] *= gg.x; y[1] *= gg.y; y[2] *= gg.z; y[3] *= gg.w;
        *(uint2*)(yb + tok * 1024 + 512 + head * 64 + p0) = pack4(y);
      }
    }
    __syncthreads();
  }
#pragma unroll
  for (int it = 0; it < 4; ++it) {
    float s = ssq_acc[it];
    s += __shfl_xor(s, 16, 64);
    s += __shfl_xor(s, 32, 64);
    if (lane < 16) SSQ[wave * 64 + it * 16 + lane] = s;
  }
  __syncthreads();
  if (tid < 64) {
    float* ssqp = (float*)(p.ws + WS_SSQ);
    ssqp[(size_t)g * M_TOK + (size_t)b * 4096 + blk * 64 + tid] = SSQ[tid] + SSQ[64 + tid] + SSQ[128 + tid] + SSQ[192 + tid];
  }
}

__device__ __forceinline__ void phase_ssd_norm(const P& p) {
  const float* ssqp = (const float*)(p.ws + WS_SSQ);
  bf16* yb = (bf16*)(p.ws + WS_H);
  const int total = M_TOK * 64;
  for (int idx = blockIdx.x * 256 + threadIdx.x; idx < total; idx += gridDim.x * 256) {
    const int tok = idx >> 6, c8 = (idx & 63) * 8;
    const float rs = rsqrtf((ssqp[tok] + ssqp[M_TOK + tok]) * (1.f / 512.f) + 1e-6f);
    uint4* ptr = (uint4*)(yb + (size_t)tok * 1024 + 512 + c8);
    uint4 u = *ptr, w;
    w.x = (unsigned)f2bf(__uint_as_float(u.x << 16) * rs) | ((unsigned)f2bf(__uint_as_float(u.x & 0xffff0000u) * rs) << 16);
    w.y = (unsigned)f2bf(__uint_as_float(u.y << 16) * rs) | ((unsigned)f2bf(__uint_as_float(u.y & 0xffff0000u) * rs) << 16);
    w.z = (unsigned)f2bf(__uint_as_float(u.z << 16) * rs) | ((unsigned)f2bf(__uint_as_float(u.z & 0xffff0000u) * rs) << 16);
    w.w = (unsigned)f2bf(__uint_as_float(u.w << 16) * rs) | ((unsigned)f2bf(__uint_as_float(u.w & 0xffff0000u) * rs) << 16);
    *ptr = w;
  }
}

#define NPHASE 18
__global__ void __launch_bounds__(256) mega(P p, int ph_lo, int ph_hi) {
  __shared__ __align__(16) unsigned char smem[73728];
  cg::grid_group grid = cg::this_grid();
  const float* mod = (const float*)(p.ws + WS_MOD);
#define IN(k) (ph_lo <= (k) && (k) < ph_hi)
#define SYNC(k) if (IN(k) && (k) + 1 < ph_hi) grid.sync();
  if (IN(0)) phase_setup(p, smem);
  SYNC(0)
  if (IN(1)) phase_h0(p);
  SYNC(1)
  if (IN(2))
    phase_gemm<0>((const bf16*)(p.ws + WS_H), (const bf16*)(p.ws + WS_WEI), EVEN_NP / 128, smem,
                  (bf16*)(p.ws + WS_PROJ), EVEN_N, EVEN_N, nullptr, nullptr, nullptr);
  SYNC(2)
  if (IN(3)) {
    for (int it = blockIdx.x; it < 1024 + 512; it += gridDim.x) {
      if (it < 1024) rec_pass1_item<64, 0>(p, it, smem); else na_item(p, it - 1024);
      __syncthreads();
    }
  }
  SYNC(3)
  if (IN(4)) phase_rec_scan<64>(p);
  SYNC(4)
  if (IN(5)) {
    for (int it = blockIdx.x; it < 1024; it += gridDim.x) { rec_pass3_item<64, 0>(p, it, smem); __syncthreads(); }
  }
  SYNC(5)
  if (IN(6))
    phase_gemm<1>((const bf16*)(p.ws + WS_H), (const bf16*)(p.ws + WS_WEO), 8, smem, nullptr, 0, 0, p.x, p.out,
                  mod + 2048);
  SYNC(6)
  if (IN(7)) phase_ln(p, 0, true);
  SYNC(7)
  if (IN(8))
    phase_gemm<0>((const bf16*)(p.ws + WS_H), (const bf16*)(p.ws + WS_WOI), ODD_NP / 128, smem,
                  (bf16*)(p.ws + WS_PROJ), ODD_N, ODD_N, nullptr, nullptr, nullptr);
  SYNC(8)
  if (IN(9)) {
    for (int it = blockIdx.x; it < 1024; it += gridDim.x) { rec_pass1_item<128, 1>(p, it, smem); __syncthreads(); }
  }
  SYNC(9)
  if (IN(10)) phase_rec_scan<128>(p);
  SYNC(10)
  if (IN(11)) {
    for (int it = blockIdx.x; it < 1024; it += gridDim.x) { rec_pass3_item<128, 1>(p, it, smem); __syncthreads(); }
  }
  SYNC(11)
  if (IN(12)) {
    for (int it = blockIdx.x; it < 512; it += gridDim.x) { ssd_pass1_item(p, it, smem); __syncthreads(); }
  }
  SYNC(12)
  if (IN(13)) phase_ssd_scan(p);
  SYNC(13)
  if (IN(14)) {
    for (int it = blockIdx.x; it < 512; it += gridDim.x) { ssd_pass3_item(p, it, smem); __syncthreads(); }
  }
  SYNC(14)
  if (IN(15)) phase_ssd_norm(p);
  SYNC(15)
  if (IN(16))
    phase_gemm<1>((const bf16*)(p.ws + WS_H), (const bf16*)(p.ws + WS_WOO), 8, smem, nullptr, 0, 0, p.out, p.out,
                  mod + 4 * 3072 + 2048);
  SYNC(16)
  if (IN(17)) phase_ln(p, 1, false);
}

extern "C" void kernel_launch(void* const* d_in, const int* in_sizes, int n_in, void* d_out, int out_size, void* d_ws,
                              size_t ws_size, hipStream_t stream) {
  static int grid_blocks = 0;
  if (!grid_blocks) {
    int dev = 0, cus = 0, per_cu = 0;
    hipGetDevice(&dev);
    hipDeviceGetAttribute(&cus, hipDeviceAttributeMultiprocessorCount, dev);
    hipOccupancyMaxActiveBlocksPerMultiprocessor(&per_cu, mega, 256, 0);
    if (per_cu < 1) per_cu = 1;
    grid_blocks = cus * per_cu;
    if (n_in != 22 || ws_size < WS_END) {
      fprintf(stderr, "kernel_launch: unexpected n_in %d / ws_size %zu (need %llu)\n", n_in, ws_size, (unsigned long long)WS_END);
      grid_blocks = -1;
    }
  }
  if (grid_blocks < 0) return;
  P p{};
  const float** f = (const float**)&p;
  for (int i = 0; i < 22; ++i) f[i] = (const float*)d_in[i];
  p.out = (float*)d_out;
  p.ws = (unsigned char*)d_ws;
#if 1
  int lo = 0, hi = NPHASE;
  void* args[] = {&p, &lo, &hi};
  hipError_t e = hipLaunchCooperativeKernel((void*)mega, dim3(grid_blocks), dim3(256), args, 0, stream);
  if (e != hipSuccess) fprintf(stderr, "cooperative launch failed: %s (grid %d)\n", hipGetErrorString(e), grid_blocks);
#else
  for (int ph = 0; ph < NPHASE; ++ph) hipLaunchKernelGGL(mega, dim3(grid_blocks), dim3(256), 0, stream, p, ph, ph + 1);
#endif
}
```

```cpp
#include <hip/hip_runtime.h>
#include <hip/hip_cooperative_groups.h>
#include <cstdio>
namespace cg = cooperative_groups;

typedef unsigned short bf16;
using bf16x8 = __attribute__((ext_vector_type(8))) short;
using f32x4 = __attribute__((ext_vector_type(4))) float;

#define M_TOK 16384
#define DM 1024
#define SEQ 4096
#define EVEN_N 3616
#define EVEN_NP 3712
#define ODD_N 4112
#define ODD_NP 4224
#define ALPHA 1.4142135623730951f

#define WS_MOD 0ull
#define WS_LB (WS_MOD + 98304ull)
#define WS_WEI (WS_LB + 2048ull)
#define WS_WEO (WS_WEI + 3712ull * 2048)
#define WS_WOI (WS_WEO + 1024ull * 2048)
#define WS_WOO (WS_WOI + 4224ull * 2048)
#define WS_H (WS_WOO + 1024ull * 2048)
#define WS_PROJ (WS_H + 16384ull * 2048)
#define WS_O (WS_PROJ + 16384ull * 4112 * 2)
#define WS_ST WS_O
#define WS_DEC (WS_O + 2ull * 16384 * 512 * 4)
#define WS_SSQ (WS_DEC + 2ull * 16 * 64 * 128 * 4)
#define WS_BAR (WS_SSQ + 2ull * 16384 * 4)
#define WS_END (WS_BAR + 16384ull)

struct P {
  const float *x, *c, *ada_w, *ada_b, *ln_g, *ln_b, *e_w_in, *e_rpb, *gla_w_up, *gla_b, *gla_g, *e_w_out;
  const float *o_w_in, *hgrn_lb, *hgrn_g, *conv_w, *conv_b, *dt_bias, *a_log, *d_skip, *ssm_g, *o_w_out;
  float* out;
  unsigned char* ws;
};

__device__ __forceinline__ bf16 f2bf(float f) {
  unsigned u = __float_as_uint(f);
  u += 0x7fffu + ((u >> 16) & 1u);
  return (bf16)(u >> 16);
}
__device__ __forceinline__ float bf2f(bf16 h) { return __uint_as_float(((unsigned)h) << 16); }
__device__ __forceinline__ float silu_f(float v) { return v / (1.f + __expf(-v)); }
__device__ __forceinline__ float sigmoid_f(float v) { return 1.f / (1.f + __expf(-v)); }
__device__ __forceinline__ float log_sigmoid_f(float z) { return fminf(z, 0.f) - log1pf(__expf(-fabsf(z))); }
__device__ __forceinline__ float softplus_f(float z) { return fmaxf(z, 0.f) + log1pf(__expf(-fabsf(z))); }
__device__ __forceinline__ float wave_sum(float v) {
#pragma unroll
  for (int o = 32; o > 0; o >>= 1) v += __shfl_xor(v, o, 64);
  return v;
}

__device__ __forceinline__ void transpose_item(const float* __restrict__ src, int N, bf16* __restrict__ dst, int li, unsigned char* smem) {
  float* tile = (float*)smem;
  const int tid = threadIdx.x;
  const int kt = li & 15, ntile = li >> 4;
#pragma unroll
  for (int i = 0; i < 16; ++i) {
    int row = i * 4 + (tid >> 6), col = tid & 63;
    int n = ntile * 64 + col;
    float v = (n < N) ? src[(size_t)(kt * 64 + row) * N + n] : 0.f;
    tile[row * 65 + col] = v;
  }
  __syncthreads();
#pragma unroll
  for (int i = 0; i < 16; ++i) {
    int r = i * 4 + (tid >> 6), cc = tid & 63;
    dst[(size_t)(ntile * 64 + r) * 1024 + kt * 64 + cc] = f2bf(tile[cc * 65 + r]);
  }
}

__device__ __forceinline__ void mod_item(const P& p, int idx, unsigned char* smem) {
  float* cond = (float*)smem;
  float* red = cond + 4096;
  const int tid = threadIdx.x;
  const int l = idx / 192, nc = idx % 192;
  for (int e = tid; e < 4096; e += 256) cond[e] = silu_f(p.c[e]);
  __syncthreads();
  const int kg = tid >> 4, col = tid & 15, n = nc * 16 + col;
  float a0 = 0.f, a1 = 0.f, a2 = 0.f, a3 = 0.f;
  const float* w = p.ada_w + (size_t)l * 1024 * 3072 + n;
#pragma unroll 16
  for (int k = kg * 64; k < kg * 64 + 64; ++k) {
    float wv = w[(size_t)k * 3072];
    a0 += cond[k] * wv; a1 += cond[1024 + k] * wv; a2 += cond[2048 + k] * wv; a3 += cond[3072 + k] * wv;
  }
  red[(kg * 4 + 0) * 16 + col] = a0; red[(kg * 4 + 1) * 16 + col] = a1;
  red[(kg * 4 + 2) * 16 + col] = a2; red[(kg * 4 + 3) * 16 + col] = a3;
  __syncthreads();
  if (tid < 64) {
    const int b = tid >> 4;
    float sum = 0.f;
#pragma unroll
    for (int q = 0; q < 16; ++q) sum += red[(q * 4 + b) * 16 + col];
    float* mod = (float*)(p.ws + WS_MOD);
    mod[(size_t)(l * 4 + b) * 3072 + n] = sum + p.ada_b[l * 3072 + n];
  }
}

__device__ __forceinline__ void phase_setup(const P& p, unsigned char* smem) {
  const int M0 = 384, T0 = M0 + 16 * 58, T1 = T0 + 256, T2 = T1 + 16 * 66, T3 = T2 + 256, T5 = T3 + 1;
  for (int it = blockIdx.x; it < T5; it += gridDim.x) {
    if (it < M0) mod_item(p, it, smem);
    else if (it < T0) transpose_item(p.e_w_in, EVEN_N, (bf16*)(p.ws + WS_WEI), it - M0, smem);
    else if (it < T1) transpose_item(p.e_w_out, 1024, (bf16*)(p.ws + WS_WEO), it - T0, smem);
    else if (it < T2) transpose_item(p.o_w_in, ODD_N, (bf16*)(p.ws + WS_WOI), it - T1, smem);
    else if (it < T3) transpose_item(p.o_w_out, 1024, (bf16*)(p.ws + WS_WOO), it - T2, smem);
    else {
      float* lbv = (float*)(p.ws + WS_LB);
      for (int j = threadIdx.x; j < 512; j += 256) {
        float a = p.hgrn_lb[j], bb = p.hgrn_lb[512 + j];
        lbv[j] = 1.f / (1.f + __expf(a - bb));
      }
    }
    __syncthreads();
  }
}

__device__ __forceinline__ void phase_h0(const P& p) {
  const float* mod = (const float*)(p.ws + WS_MOD);
  bf16* hb = (bf16*)(p.ws + WS_H);
  const size_t total = (size_t)M_TOK * 128;
  for (size_t i = (size_t)blockIdx.x * 256 + threadIdx.x; i < total; i += (size_t)gridDim.x * 256) {
    int m = (int)(i >> 7), n = (int)(i & 127) * 8, b = m >> 12;
    const float4* xp = (const float4*)(p.x + (size_t)m * 1024 + n);
    const float4* sh = (const float4*)(mod + (size_t)b * 3072 + n);
    const float4* sc = (const float4*)(mod + (size_t)b * 3072 + 1024 + n);
    float4 x0 = xp[0], x1 = xp[1], s0 = sh[0], s1 = sh[1], c0 = sc[0], c1 = sc[1];
    uint4 o;
    o.x = (unsigned)f2bf(x0.x * (1.f + c0.x) + s0.x) | ((unsigned)f2bf(x0.y * (1.f + c0.y) + s0.y) << 16);
    o.y = (unsigned)f2bf(x0.z * (1.f + c0.z) + s0.z) | ((unsigned)f2bf(x0.w * (1.f + c0.w) + s0.w) << 16);
    o.z = (unsigned)f2bf(x1.x * (1.f + c1.x) + s1.x) | ((unsigned)f2bf(x1.y * (1.f + c1.y) + s1.y) << 16);
    o.w = (unsigned)f2bf(x1.z * (1.f + c1.z) + s1.z) | ((unsigned)f2bf(x1.w * (1.f + c1.w) + s1.w) << 16);
    *(uint4*)(hb + (size_t)m * 1024 + n) = o;
  }
}

#define LSTR 72
using u32x4 = __attribute__((ext_vector_type(4))) unsigned;
__device__ __forceinline__ u32x4 gload16_asm(const void* ptr) {
  u32x4 r;
  asm volatile("global_load_dwordx4 %0, %1, off" : "=v"(r) : "v"(ptr));
  return r;
}
template <int EPI>
__device__ __forceinline__ void gemm_tile(const bf16* __restrict__ A, const bf16* __restrict__ Bt, int m0, int n0,
                                          unsigned char* smem, bf16* __restrict__ C, int ldc, int nreal,
                                          const float* __restrict__ X, float* __restrict__ R, const float* __restrict__ gate) {
  bf16* As = (bf16*)smem;
  bf16* Bs = As + 2 * 128 * LSTR;
  const int tid = threadIdx.x, lane = tid & 63, wave = tid >> 6;
  const int wm = wave >> 1, wn = wave & 1;
  f32x4 acc[4][4];
#pragma unroll
  for (int i = 0; i < 4; ++i)
#pragma unroll
    for (int j = 0; j < 4; ++j) acc[i][j] = (f32x4){0.f, 0.f, 0.f, 0.f};
  u32x4 ra[4], rb[4];
  const int lrow = tid >> 3, lkc = tid & 7;
  const bf16* Ag = A + (size_t)(m0 + lrow) * 1024 + lkc * 8;
  const bf16* Bg = Bt + (size_t)(n0 + lrow) * 1024 + lkc * 8;
#pragma unroll
  for (int i = 0; i < 4; ++i) {
    ra[i] = *(const u32x4*)(Ag + (size_t)i * 32 * 1024);
    rb[i] = *(const u32x4*)(Bg + (size_t)i * 32 * 1024);
  }
#pragma unroll
  for (int i = 0; i < 4; ++i) {
    *(u32x4*)(As + (lrow + i * 32) * LSTR + lkc * 8) = ra[i];
    *(u32x4*)(Bs + (lrow + i * 32) * LSTR + lkc * 8) = rb[i];
  }
  __syncthreads();
  for (int kt = 0; kt < 16; ++kt) {
    const int buf = kt & 1;
    {
      const int kn = (kt + 1 < 16) ? kt + 1 : kt;
#pragma unroll
      for (int i = 0; i < 4; ++i) {
        ra[i] = gload16_asm(Ag + (size_t)i * 32 * 1024 + kn * 64);
        rb[i] = gload16_asm(Bg + (size_t)i * 32 * 1024 + kn * 64);
      }
    }
    const bf16* Ab = As + buf * 128 * LSTR;
    const bf16* Bb = Bs + buf * 128 * LSTR;
#pragma unroll
    for (int s = 0; s < 2; ++s) {
      bf16x8 wf[4], xf[4];
#pragma unroll
      for (int i = 0; i < 4; ++i) {
        wf[i] = *(const bf16x8*)(Bb + (wn * 64 + i * 16 + (lane & 15)) * LSTR + s * 32 + (lane >> 4) * 8);
        xf[i] = *(const bf16x8*)(Ab + (wm * 64 + i * 16 + (lane & 15)) * LSTR + s * 32 + (lane >> 4) * 8);
      }
#pragma unroll
      for (int i = 0; i < 4; ++i)
#pragma unroll
        for (int j = 0; j < 4; ++j) acc[i][j] = __builtin_amdgcn_mfma_f32_16x16x32_bf16(wf[i], xf[j], acc[i][j], 0, 0, 0);
    }
    asm volatile("s_waitcnt vmcnt(0)"
                 : "+v"(ra[0]), "+v"(ra[1]), "+v"(ra[2]), "+v"(ra[3]), "+v"(rb[0]), "+v"(rb[1]), "+v"(rb[2]), "+v"(rb[3])
                 :
                 : "memory");
    {
      bf16* Aw = As + (buf ^ 1) * 128 * LSTR;
      bf16* Bw = Bs + (buf ^ 1) * 128 * LSTR;
#pragma unroll
      for (int i = 0; i < 4; ++i) {
        *(u32x4*)(Aw + (lrow + i * 32) * LSTR + lkc * 8) = ra[i];
        *(u32x4*)(Bw + (lrow + i * 32) * LSTR + lkc * 8) = rb[i];
      }
    }
    __syncthreads();
  }
#pragma unroll
  for (int i = 0; i < 4; ++i) {
    const int n = n0 + wn * 64 + i * 16 + (lane >> 4) * 4;
#pragma unroll
    for (int j = 0; j < 4; ++j) {
      const int m = m0 + wm * 64 + j * 16 + (lane & 15);
      f32x4 a = acc[i][j];
      if (EPI == 0) {
        if (n < nreal) {
          uint2 o;
          o.x = (unsigned)f2bf(a[0]) | ((unsigned)f2bf(a[1]) << 16);
          o.y = (unsigned)f2bf(a[2]) | ((unsigned)f2bf(a[3]) << 16);
          *(uint2*)(C + (size_t)m * ldc + n) = o;
        }
      } else {
        const int b = m >> 12;
        float4 xv = *(const float4*)(X + (size_t)m * 1024 + n);
        float4 g = *(const float4*)(gate + (size_t)b * 3072 + n);
        float4 o;
        o.x = ALPHA * xv.x + g.x * a[0];
        o.y = ALPHA * xv.y + g.y * a[1];
        o.z = ALPHA * xv.z + g.z * a[2];
        o.w = ALPHA * xv.w + g.w * a[3];
        *(float4*)(R + (size_t)m * 1024 + n) = o;
      }
    }
  }
}

template <int EPI>
__device__ __forceinline__ void phase_gemm(const bf16* A, const bf16* Bt, int ntn, unsigned char* smem, bf16* C, int ldc, int nreal,
                           const float* X, float* R, const float* gate) {
  const int total = (M_TOK / 128) * ntn;
  for (int t = blockIdx.x; t < total; t += gridDim.x) {
    int mt = t / ntn, nt = t % ntn;
    gemm_tile<EPI>(A, Bt, mt * 128, nt * 128, smem, C, ldc, nreal, X, R, gate);
  }
}

__device__ __forceinline__ void phase_ln(const P& p, int l, bool write_h) {
  const float* mod = (const float*)(p.ws + WS_MOD);
  bf16* hb = (bf16*)(p.ws + WS_H);
  const int lane = threadIdx.x & 63, wave = threadIdx.x >> 6;
  const float* g = p.ln_g + l * 1024;
  const float* bb = p.ln_b + l * 1024;
  for (int row = blockIdx.x * 4 + wave; row < M_TOK; row += gridDim.x * 4) {
    float* rp = p.out + (size_t)row * 1024;
    float4 v[4];
    float s = 0.f;
#pragma unroll
    for (int q = 0; q < 4; ++q) {
      v[q] = *(const float4*)(rp + (lane + 64 * q) * 4);
      s += v[q].x + v[q].y + v[q].z + v[q].w;
    }
    const float mu = wave_sum(s) * (1.f / 1024.f);
    float s2 = 0.f;
#pragma unroll
    for (int q = 0; q < 4; ++q) {
      float a = v[q].x - mu, b2 = v[q].y - mu, c2 = v[q].z - mu, d2 = v[q].w - mu;
      s2 += a * a + b2 * b2 + c2 * c2 + d2 * d2;
    }
    const float rstd = rsqrtf(wave_sum(s2) * (1.f / 1024.f) + 1e-5f);
    const int b = row >> 12;
#pragma unroll
    for (int q = 0; q < 4; ++q) {
      const int n = (lane + 64 * q) * 4;
      float4 gg = *(const float4*)(g + n), be = *(const float4*)(bb + n);
      float4 o;
      o.x = (v[q].x - mu) * rstd * gg.x + be.x;
      o.y = (v[q].y - mu) * rstd * gg.y + be.y;
      o.z = (v[q].z - mu) * rstd * gg.z + be.z;
      o.w = (v[q].w - mu) * rstd * gg.w + be.w;
      *(float4*)(rp + n) = o;
      if (write_h) {
        const float* md = mod + (size_t)(4 + b) * 3072;
        float4 sh = *(const float4*)(md + n), sc = *(const float4*)(md + 1024 + n);
        uint2 hh;
        hh.x = (unsigned)f2bf(o.x * (1.f + sc.x) + sh.x) | ((unsigned)f2bf(o.y * (1.f + sc.y) + sh.y) << 16);
        hh.y = (unsigned)f2bf(o.z * (1.f + sc.z) + sh.z) | ((unsigned)f2bf(o.w * (1.f + sc.w) + sh.w) << 16);
        *(uint2*)(hb + (size_t)row * 1024 + n) = hh;
      }
    }
  }
}

__device__ __forceinline__ void na_item(const P& p, int item, unsigned char* smem) {
  const int h = item & 7, r = (item >> 3) & 63, b = item >> 9;
  bf16* VT = (bf16*)smem;
  float* RPB = (float*)(VT + 64 * 520);
  const bf16* projb = (const bf16*)(p.ws + WS_PROJ) + (size_t)b * 4096 * EVEN_N;
  bf16* yb = (bf16*)(p.ws + WS_H);
  const int tid = threadIdx.x, lane = tid & 63, n = tid >> 6;
  const int q = lane & 15, g4 = lane >> 4;
  int rs = r - 4; rs = rs < 0 ? 0 : (rs > 56 ? 56 : rs);
#pragma unroll 4
  for (int i = 0; i < 16; ++i) {
    const int pair = i * 256 + tid, key = pair & 511, ch = pair >> 9;
    const int tok = (rs + (key >> 6)) * 64 + (key & 63);
    uint4 u = *(const uint4*)(projb + (size_t)tok * EVEN_N + 1024 + h * 64 + ch * 8);
    bf16* dst = VT + (ch * 8) * 520 + key;
    dst[0 * 520] = (bf16)(u.x & 0xffffu); dst[1 * 520] = (bf16)(u.x >> 16);
    dst[2 * 520] = (bf16)(u.y & 0xffffu); dst[3 * 520] = (bf16)(u.y >> 16);
    dst[4 * 520] = (bf16)(u.z & 0xffffu); dst[5 * 520] = (bf16)(u.z >> 16);
    dst[6 * 520] = (bf16)(u.w & 0xffffu); dst[7 * 520] = (bf16)(u.w >> 16);
  }
  for (int i = tid; i < 465; i += 256) RPB[i] = p.e_rpb[h * 465 + i];
  const int qcol = n * 16 + q;
  const int qtok = r * 64 + qcol;
  const int bs = n == 0 ? 0 : (n == 1 ? 8 : (n == 2 ? 24 : 32));
  const bf16x8 qf0 = *(const bf16x8*)(projb + (size_t)qtok * EVEN_N + h * 64 + g4 * 8);
  const bf16x8 qf1 = *(const bf16x8*)(projb + (size_t)qtok * EVEN_N + h * 64 + 32 + g4 * 8);
  f32x4 st[16];
#pragma unroll
  for (int tt = 0; tt < 16; ++tt) {
    const int ktok = (rs + (tt >> 1)) * 64 + bs + (tt & 1) * 16 + q;
    const bf16* kp = projb + (size_t)ktok * EVEN_N + 512 + h * 64 + g4 * 8;
    bf16x8 kf0 = *(const bf16x8*)kp, kf1 = *(const bf16x8*)(kp + 32);
    f32x4 z = (f32x4){0.f, 0.f, 0.f, 0.f};
    z = __builtin_amdgcn_mfma_f32_16x16x32_bf16(kf0, qf0, z, 0, 0, 0);
    st[tt] = __builtin_amdgcn_mfma_f32_16x16x32_bf16(kf1, qf1, z, 0, 0, 0);
  }
  __syncthreads();
  int cs = qcol - 8; cs = cs < 0 ? 0 : (cs > 48 ? 48 : cs);
  float mx = -1e30f;
#pragma unroll
  for (int tt = 0; tt < 16; ++tt) {
    const float* brow = RPB + (rs + (tt >> 1) - r + 7) * 31;
#pragma unroll
    for (int rr = 0; rr < 4; ++rr) {
      const int kcol = bs + (tt & 1) * 16 + g4 * 4 + rr;
      const bool valid = (kcol >= cs) && (kcol < cs + 16);
      int dc = kcol - qcol + 15; dc = dc < 0 ? 0 : (dc > 30 ? 30 : dc);
      const float sc = valid ? st[tt][rr] * 0.125f + brow[dc] : -1e30f;
      st[tt][rr] = sc;
      mx = fmaxf(mx, sc);
    }
  }
  mx = fmaxf(mx, __shfl_xor(mx, 16, 64));
  mx = fmaxf(mx, __shfl_xor(mx, 32, 64));
  float lsum = 0.f;
#pragma unroll
  for (int tt = 0; tt < 16; ++tt)
#pragma unroll
    for (int rr = 0; rr < 4; ++rr) {
      const float pe = __expf(st[tt][rr] - mx);
      st[tt][rr] = pe;
      lsum += pe;
    }
  lsum += __shfl_xor(lsum, 16, 64);
  lsum += __shfl_xor(lsum, 32, 64);
  f32x4 ot[4];
#pragma unroll
  for (int dt = 0; dt < 4; ++dt) ot[dt] = (f32x4){0.f, 0.f, 0.f, 0.f};
#pragma unroll
  for (int kr = 0; kr < 8; ++kr) {
    uint4 pw;
    pw.x = (unsigned)f2bf(st[2 * kr][0]) | ((unsigned)f2bf(st[2 * kr][1]) << 16);
    pw.y = (unsigned)f2bf(st[2 * kr][2]) | ((unsigned)f2bf(st[2 * kr][3]) << 16);
    pw.z = (unsigned)f2bf(st[2 * kr + 1][0]) | ((unsigned)f2bf(st[2 * kr + 1][1]) << 16);
    pw.w = (unsigned)f2bf(st[2 * kr + 1][2]) | ((unsigned)f2bf(st[2 * kr + 1][3]) << 16);
    const bf16x8 pf = *(bf16x8*)&pw;
#pragma unroll
    for (int dt = 0; dt < 4; ++dt) {
      const bf16* vp = VT + (dt * 16 + q) * 520 + kr * 64 + bs + g4 * 4;
      uint2 lo = *(const uint2*)vp, hi = *(const uint2*)(vp + 16);
      uint4 vw; vw.x = lo.x; vw.y = lo.y; vw.z = hi.x; vw.w = hi.y;
      ot[dt] = __builtin_amdgcn_mfma_f32_16x16x32_bf16(*(bf16x8*)&vw, pf, ot[dt], 0, 0, 0);
    }
  }
  const float inv = 1.f / lsum;
#pragma unroll
  for (int dt = 0; dt < 4; ++dt) {
    const int d0 = dt * 16 + g4 * 4;
    uint2 gu = *(const uint2*)(projb + (size_t)qtok * EVEN_N + 1536 + h * 64 + d0);
    f32x4 y;
    y[0] = ot[dt][0] * inv * silu_f(__uint_as_float(gu.x << 16));
    y[1] = ot[dt][1] * inv * silu_f(__uint_as_float(gu.x & 0xffff0000u));
    y[2] = ot[dt][2] * inv * silu_f(__uint_as_float(gu.y << 16));
    y[3] = ot[dt][3] * inv * silu_f(__uint_as_float(gu.y & 0xffff0000u));
    uint2 o;
    o.x = (unsigned)f2bf(y[0]) | ((unsigned)f2bf(y[1]) << 16);
    o.y = (unsigned)f2bf(y[2]) | ((unsigned)f2bf(y[3]) << 16);
    *(uint2*)(yb + ((size_t)b * 4096 + qtok) * 1024 + h * 64 + d0) = o;
  }
}

template <int K, int MODE>
struct GateC {
  float w[16];
  float bias, lb;
  int d, ch;
  __device__ __forceinline__ void init(const P& p, int d_, int h, int k) {
    d = d_; ch = h * K + k;
    if (MODE == 0) {
#pragma unroll
      for (int r = 0; r < 16; ++r) w[r] = p.gla_w_up[(d * 16 + r) * 256 + ch];
      bias = p.gla_b[d * 256 + ch];
      lb = 0.f;
    } else {
      lb = ((const float*)(p.ws + WS_LB))[ch];
      bias = 0.f;
    }
  }
  __device__ __forceinline__ void eval_vals(bf16 a, bf16 bz, const bf16* lr, float& g, float& kval, float& qval) const {
    if (MODE == 0) {
      uint4 u0 = *(const uint4*)(lr);
      uint4 u1 = *(const uint4*)(lr + 8);
      float z = bias;
      z += w[0] * __uint_as_float(u0.x << 16) + w[1] * __uint_as_float(u0.x & 0xffff0000u);
      z += w[2] * __uint_as_float(u0.y << 16) + w[3] * __uint_as_float(u0.y & 0xffff0000u);
      z += w[4] * __uint_as_float(u0.z << 16) + w[5] * __uint_as_float(u0.z & 0xffff0000u);
      z += w[6] * __uint_as_float(u0.w << 16) + w[7] * __uint_as_float(u0.w & 0xffff0000u);
      z += w[8] * __uint_as_float(u1.x << 16) + w[9] * __uint_as_float(u1.x & 0xffff0000u);
      z += w[10] * __uint_as_float(u1.y << 16) + w[11] * __uint_as_float(u1.y & 0xffff0000u);
      z += w[12] * __uint_as_float(u1.z << 16) + w[13] * __uint_as_float(u1.z & 0xffff0000u);
      z += w[14] * __uint_as_float(u1.w << 16) + w[15] * __uint_as_float(u1.w & 0xffff0000u);
      g = log_sigmoid_f(z) * (1.f / 16.f);
      kval = bf2f(bz);
      qval = bf2f(a) * 0.125f;
    } else {
      const float z = bf2f(bz);
      const float e = __expf(-z);
      const float sg = 1.f / (1.f + e);
      kval = (1.f - lb) * e * sg;
      g = log1pf(-kval);
      qval = bf2f(a) * 0.08838834764831845f;
    }
  }
  __device__ __forceinline__ void eval(const bf16* row, float& g, float& kval, float& qval) const {
    if (MODE == 0) {
      uint4 u0 = *(const uint4*)(row + 3584 + d * 16);
      uint4 u1 = *(const uint4*)(row + 3584 + d * 16 + 8);
      float z = bias;
      z += w[0] * __uint_as_float(u0.x << 16) + w[1] * __uint_as_float(u0.x & 0xffff0000u);
      z += w[2] * __uint_as_float(u0.y << 16) + w[3] * __uint_as_float(u0.y & 0xffff0000u);
      z += w[4] * __uint_as_float(u0.z << 16) + w[5] * __uint_as_float(u0.z & 0xffff0000u);
      z += w[6] * __uint_as_float(u0.w << 16) + w[7] * __uint_as_float(u0.w & 0xffff0000u);
      z += w[8] * __uint_as_float(u1.x << 16) + w[9] * __uint_as_float(u1.x & 0xffff0000u);
      z += w[10] * __uint_as_float(u1.y << 16) + w[11] * __uint_as_float(u1.y & 0xffff0000u);
      z += w[12] * __uint_as_float(u1.z << 16) + w[13] * __uint_as_float(u1.z & 0xffff0000u);
      z += w[14] * __uint_as_float(u1.w << 16) + w[15] * __uint_as_float(u1.w & 0xffff0000u);
      g = log_sigmoid_f(z) * (1.f / 16.f);
      kval = bf2f(row[2304 + ch]);
      qval = bf2f(row[2048 + ch]) * 0.125f;
    } else {
      const float z = bf2f(row[512 + d * 512 + ch]);
      const float e = __expf(-z);
      const float sg = 1.f / (1.f + e);
      kval = (1.f - lb) * e * sg;
      g = log1pf(-kval);
      qval = bf2f(row[ch]) * 0.08838834764831845f;
    }
  }
};

template <int MODE>
__device__ __forceinline__ void stage_vt(const bf16* proj, int h, bf16* VT) {
  constexpr int LDP = MODE == 0 ? EVEN_N : ODD_N;
  constexpr int VOFF = MODE == 0 ? 2560 : 1536;
  const int j = threadIdx.x & 63, cgp = threadIdx.x >> 6;
#pragma unroll
  for (int cc = 0; cc < 4; ++cc) {
    const int c = cgp * 4 + cc;
    uint4 u = *(const uint4*)(proj + (size_t)j * LDP + VOFF + h * 128 + c * 8);
    bf16* dst = VT + (c * 8) * 72 + j;
    dst[0 * 72] = (bf16)(u.x & 0xffffu); dst[1 * 72] = (bf16)(u.x >> 16);
    dst[2 * 72] = (bf16)(u.y & 0xffffu); dst[3 * 72] = (bf16)(u.y >> 16);
    dst[4 * 72] = (bf16)(u.z & 0xffffu); dst[5 * 72] = (bf16)(u.z >> 16);
    dst[6 * 72] = (bf16)(u.w & 0xffffu); dst[7 * 72] = (bf16)(u.w >> 16);
  }
}

__device__ __forceinline__ uint2 pack4(f32x4 a) {
  uint2 o;
  o.x = (unsigned)f2bf(a[0]) | ((unsigned)f2bf(a[1]) << 16);
  o.y = (unsigned)f2bf(a[2]) | ((unsigned)f2bf(a[3]) << 16);
  return o;
}

template <int K, int MODE>
__device__ __forceinline__ void rec_pass1_item(const P& p, int item, unsigned char* smem) {
  constexpr int LDP = MODE == 0 ? EVEN_N : ODD_N;
  const int h = item & 3, blk = (item >> 2) & 63, b = item >> 8;
  bf16* KT = (bf16*)smem;
  bf16* VT = KT + 2 * K * 72;
  const bf16* proj = (const bf16*)(p.ws + WS_PROJ) + (size_t)(b * 4096 + blk * 64) * LDP;
  bf16* ST = (bf16*)(p.ws + WS_ST);
  float* DEC = (float*)(p.ws + WS_DEC);
  const int tid = threadIdx.x, lane = tid & 63, wave = tid >> 6;
  bf16* TMP = VT;
  if (MODE == 1) {
#pragma unroll
    for (int i = 0; i < 8; ++i) {
      const int c = i * 256 + tid;
      const int ch = c & 15, j = (c >> 4) & 63, d = c >> 10;
      *(uint4*)(TMP + (d * 64 + j) * 128 + ch * 8) = *(const uint4*)(proj + (size_t)j * LDP + 512 + d * 512 + h * 128 + ch * 8);
    }
  } else {
#pragma unroll
    for (int i = 0; i < 2; ++i) {
      const int c = i * 256 + tid;
      const int ch = c & 7, j = c >> 3;
      *(uint4*)(TMP + j * 64 + ch * 8) = *(const uint4*)(proj + (size_t)j * LDP + 2304 + h * 64 + ch * 8);
    }
    {
      const int ch = tid & 3, j = tid >> 2;
      *(uint4*)(TMP + 4096 + j * 32 + ch * 8) = *(const uint4*)(proj + (size_t)j * LDP + 3584 + ch * 8);
    }
  }
  __syncthreads();
  if (tid < 2 * K) {
    const int d = tid / K, k = tid % K;
    GateC<K, MODE> gc;
    gc.init(p, d, h, k);
    bf16* row = KT + (d * K + k) * 72;
    float r = 0.f;
#pragma unroll 4
    for (int i = 63; i >= 0; --i) {
      const int j = d ? 63 - i : i;
      float g, kv, qv;
      if (MODE == 1) gc.eval_vals(0, TMP[(d * 64 + j) * 128 + k], nullptr, g, kv, qv);
      else gc.eval_vals(0, TMP[j * 64 + k], TMP + 4096 + j * 32 + d * 16, g, kv, qv);
      row[j] = f2bf(kv * __expf(r));
      r += g;
    }
    DEC[(size_t)((((d * 4 + b) * 4 + h) * 64 + blk)) * K + k] = __expf(r);
  }
  __syncthreads();
  stage_vt<MODE>(proj, h, VT);
  __syncthreads();
#pragma unroll 1
  for (int d = 0; d < 2; ++d) {
    f32x4 acc[K / 16][2];
#pragma unroll
    for (int kt = 0; kt < K / 16; ++kt) { acc[kt][0] = (f32x4){0.f, 0.f, 0.f, 0.f}; acc[kt][1] = (f32x4){0.f, 0.f, 0.f, 0.f}; }
#pragma unroll
    for (int ks = 0; ks < 2; ++ks) {
      bf16x8 vf0 = *(const bf16x8*)(VT + ((wave * 2 + 0) * 16 + (lane & 15)) * 72 + ks * 32 + (lane >> 4) * 8);
      bf16x8 vf1 = *(const bf16x8*)(VT + ((wave * 2 + 1) * 16 + (lane & 15)) * 72 + ks * 32 + (lane >> 4) * 8);
#pragma unroll
      for (int kt = 0; kt < K / 16; ++kt) {
        bf16x8 kf = *(const bf16x8*)(KT + (d * K + kt * 16 + (lane & 15)) * 72 + ks * 32 + (lane >> 4) * 8);
        acc[kt][0] = __builtin_amdgcn_mfma_f32_16x16x32_bf16(kf, vf0, acc[kt][0], 0, 0, 0);
        acc[kt][1] = __builtin_amdgcn_mfma_f32_16x16x32_bf16(kf, vf1, acc[kt][1], 0, 0, 0);
      }
    }
    bf16* stb = ST + (size_t)((((d * 4 + b) * 4 + h) * 64 + blk)) * 128 * K;
#pragma unroll
    for (int kt = 0; kt < K / 16; ++kt)
#pragma unroll
      for (int vv = 0; vv < 2; ++vv) {
        const int v = (wave * 2 + vv) * 16 + (lane & 15);
        const int k0 = kt * 16 + (lane >> 4) * 4;
        *(uint2*)(stb + (size_t)v * K + k0) = pack4(acc[kt][vv]);
      }
  }
}

template <int K>
__device__ __forceinline__ void phase_rec_scan(const P& p) {
  bf16* ST = (bf16*)(p.ws + WS_ST);
  const float* DEC = (const float*)(p.ws + WS_DEC);
  constexpr int KV = K / 4;
  const int total = 32 * 128 * KV;
  for (int idx = blockIdx.x * 256 + threadIdx.x; idx < total; idx += gridDim.x * 256) {
    const int kq = idx % KV, v = (idx / KV) & 127, s = idx / (KV * 128);
    const int d = s >> 4;
    float st0 = 0.f, st1 = 0.f, st2 = 0.f, st3 = 0.f;
#pragma unroll 1
    for (int n0 = 0; n0 < 64; n0 += 8) {
      uint2 u[8];
      float4 dc[8];
#pragma unroll
      for (int q = 0; q < 8; ++q) {
        const int blk = d ? 63 - (n0 + q) : (n0 + q);
        u[q] = *(const uint2*)(ST + ((size_t)(s * 64 + blk) * 128 + v) * K + kq * 4);
        dc[q] = *(const float4*)(DEC + (size_t)(s * 64 + blk) * K + kq * 4);
      }
#pragma unroll
      for (int q = 0; q < 8; ++q) {
        const int blk = d ? 63 - (n0 + q) : (n0 + q);
        uint2 o;
        o.x = (unsigned)f2bf(st0) | ((unsigned)f2bf(st1) << 16);
        o.y = (unsigned)f2bf(st2) | ((unsigned)f2bf(st3) << 16);
        *(uint2*)(ST + ((size_t)(s * 64 + blk) * 128 + v) * K + kq * 4) = o;
        st0 = dc[q].x * st0 + __uint_as_float(u[q].x << 16);
        st1 = dc[q].y * st1 + __uint_as_float(u[q].x & 0xffff0000u);
        st2 = dc[q].z * st2 + __uint_as_float(u[q].y << 16);
        st3 = dc[q].w * st3 + __uint_as_float(u[q].y & 0xffff0000u);
      }
    }
  }
}

template <int K, int MODE>
__device__ __forceinline__ void rec_pass3_item(const P& p, int item, unsigned char* smem) {
  constexpr int LDP = MODE == 0 ? EVEN_N : ODD_N;
  constexpr int KS = K + 8;
  constexpr int GOFF = MODE == 0 ? 3072 : 2048;
  constexpr int YOFF = MODE == 0 ? 512 : 0;
  const int h = item & 3, blk = (item >> 2) & 63, b = item >> 8;
  bf16* QI = (bf16*)smem;
  bf16* KI = QI + 64 * KS;
  bf16* VT = KI + 64 * KS;
  bf16* AI = VT + 128 * 72;
  float* CV = (float*)(AI + 64 * 72);
  float* SSQ = CV + K;
  bf16* LRB = (bf16*)(SSQ + 256);
  const bf16* proj = (const bf16*)(p.ws + WS_PROJ) + (size_t)(b * 4096 + blk * 64) * LDP;
  const bf16* ST = (const bf16*)(p.ws + WS_ST);
  bf16* yb = (bf16*)(p.ws + WS_H);
  const int tid = threadIdx.x, lane = tid & 63, wave = tid >> 6;
  stage_vt<MODE>(proj, h, VT);
  f32x4 o[2][4];
#pragma unroll
  for (int vv = 0; vv < 2; ++vv)
#pragma unroll
    for (int it = 0; it < 4; ++it) o[vv][it] = (f32x4){0.f, 0.f, 0.f, 0.f};
#pragma unroll 1
  for (int d = 0; d < 2; ++d) {
    if (d) __syncthreads();
    {
      constexpr int QOFF = MODE == 0 ? 2048 : 0;
      const int zoff = MODE == 0 ? 2304 : 512 + d * 512;
#pragma unroll
      for (int i = 0; i < K / 32; ++i) {
        const int c = i * 256 + tid;
        const int ch = c % (K / 8), j = c / (K / 8);
        *(uint4*)(QI + j * KS + ch * 8) = *(const uint4*)(proj + (size_t)j * LDP + QOFF + h * K + ch * 8);
        *(uint4*)(KI + j * KS + ch * 8) = *(const uint4*)(proj + (size_t)j * LDP + zoff + h * K + ch * 8);
      }
      if (MODE == 0 && tid < 128) {
        const int ch = tid & 1, j = tid >> 1;
        *(uint4*)(LRB + j * 16 + ch * 8) = *(const uint4*)(proj + (size_t)j * LDP + 3584 + d * 16 + ch * 8);
      }
    }
    __syncthreads();
    if (tid < 2 * K) {
      const int k = tid % K, half = tid / K;
      GateC<K, MODE> gc;
      gc.init(p, d, h, k);
      float run = 0.f;
      if (half) {
#pragma unroll 4
        for (int i = 32; i < 64; ++i) {
          const int j = d ? 63 - i : i;
          float g, kv, qv;
          gc.eval_vals(QI[j * KS + k], KI[j * KS + k], LRB + j * 16, g, kv, qv);
          run += g;
          QI[j * KS + k] = f2bf(qv * __expf(run));
          KI[j * KS + k] = f2bf(kv * __expf(-run));
        }
      } else {
#pragma unroll 4
        for (int i = 31; i >= 0; --i) {
          const int j = d ? 63 - i : i;
          float g, kv, qv;
          gc.eval_vals(QI[j * KS + k], KI[j * KS + k], LRB + j * 16, g, kv, qv);
          QI[j * KS + k] = f2bf(qv * __expf(-run));
          KI[j * KS + k] = f2bf(kv * __expf(run));
          run += g;
        }
        CV[k] = __expf(run);
      }
    }
    __syncthreads();
    {
      f32x4 a[4];
#pragma unroll
      for (int jt = 0; jt < 4; ++jt) a[jt] = (f32x4){0.f, 0.f, 0.f, 0.f};
#pragma unroll
      for (int ks = 0; ks < K / 32; ++ks) {
        bf16x8 qf = *(const bf16x8*)(QI + (wave * 16 + (lane & 15)) * KS + ks * 32 + (lane >> 4) * 8);
#pragma unroll
        for (int jt = 0; jt < 4; ++jt) {
          bf16x8 kf = *(const bf16x8*)(KI + (jt * 16 + (lane & 15)) * KS + ks * 32 + (lane >> 4) * 8);
          a[jt] = __builtin_amdgcn_mfma_f32_16x16x32_bf16(kf, qf, a[jt], 0, 0, 0);
        }
      }
      const int i = wave * 16 + (lane & 15);
#pragma unroll
      for (int jt = 0; jt < 4; ++jt) {
        const int j0 = jt * 16 + (lane >> 4) * 4;
        f32x4 m;
#pragma unroll
        for (int r = 0; r < 4; ++r) {
          const int j = j0 + r;
          const bool valid = d ? (j >= i) : (j <= i);
          m[r] = valid ? a[jt][r] : 0.f;
        }
        *(uint2*)(AI + i * 72 + j0) = pack4(m);
      }
    }
    __syncthreads();
#pragma unroll
    for (int ks = 0; ks < 2; ++ks) {
      bf16x8 vf0 = *(const bf16x8*)(VT + ((wave * 2 + 0) * 16 + (lane & 15)) * 72 + ks * 32 + (lane >> 4) * 8);
      bf16x8 vf1 = *(const bf16x8*)(VT + ((wave * 2 + 1) * 16 + (lane & 15)) * 72 + ks * 32 + (lane >> 4) * 8);
#pragma unroll
      for (int it = 0; it < 4; ++it) {
        bf16x8 af = *(const bf16x8*)(AI + (it * 16 + (lane & 15)) * 72 + ks * 32 + (lane >> 4) * 8);
        o[0][it] = __builtin_amdgcn_mfma_f32_16x16x32_bf16(vf0, af, o[0][it], 0, 0, 0);
        o[1][it] = __builtin_amdgcn_mfma_f32_16x16x32_bf16(vf1, af, o[1][it], 0, 0, 0);
      }
    }
    const bf16* stb = ST + (size_t)((((d * 4 + b) * 4 + h) * 64 + blk)) * 128 * K;
#pragma unroll
    for (int ks = 0; ks < K / 32; ++ks) {
      const int kk = ks * 32 + (lane >> 4) * 8;
      float4 c0 = *(const float4*)(CV + kk), c1 = *(const float4*)(CV + kk + 4);
      bf16x8 sf[2];
#pragma unroll
      for (int vv = 0; vv < 2; ++vv) {
        uint4 u = *(const uint4*)(stb + (size_t)((wave * 2 + vv) * 16 + (lane & 15)) * K + kk);
        uint4 w;
        w.x = (unsigned)f2bf(__uint_as_float(u.x << 16) * c0.x) | ((unsigned)f2bf(__uint_as_float(u.x & 0xffff0000u) * c0.y) << 16);
        w.y = (unsigned)f2bf(__uint_as_float(u.y << 16) * c0.z) | ((unsigned)f2bf(__uint_as_float(u.y & 0xffff0000u) * c0.w) << 16);
        w.z = (unsigned)f2bf(__uint_as_float(u.z << 16) * c1.x) | ((unsigned)f2bf(__uint_as_float(u.z & 0xffff0000u) * c1.y) << 16);
        w.w = (unsigned)f2bf(__uint_as_float(u.w << 16) * c1.z) | ((unsigned)f2bf(__uint_as_float(u.w & 0xffff0000u) * c1.w) << 16);
        sf[vv] = *(bf16x8*)&w;
      }
#pragma unroll
      for (int it = 0; it < 4; ++it) {
        bf16x8 qf = *(const bf16x8*)(QI + (it * 16 + (lane & 15)) * KS + kk);
        o[0][it] = __builtin_amdgcn_mfma_f32_16x16x32_bf16(sf[0], qf, o[0][it], 0, 0, 0);
        o[1][it] = __builtin_amdgcn_mfma_f32_16x16x32_bf16(sf[1], qf, o[1][it], 0, 0, 0);
      }
    }
  }
  {
    float ss[4];
#pragma unroll
    for (int it = 0; it < 4; ++it) {
      float s = 0.f;
#pragma unroll
      for (int vv = 0; vv < 2; ++vv)
#pragma unroll
        for (int r = 0; r < 4; ++r) s += o[vv][it][r] * o[vv][it][r];
      s += __shfl_xor(s, 16, 64);
      s += __shfl_xor(s, 32, 64);
      ss[it] = s;
    }
    if (lane < 16) {
#pragma unroll
      for (int it = 0; it < 4; ++it) SSQ[wave * 64 + it * 16 + lane] = ss[it];
    }
    __syncthreads();
    const float* gn = MODE == 0 ? p.gla_g : p.hgrn_g;
#pragma unroll
    for (int it = 0; it < 4; ++it) {
      const int i = it * 16 + (lane & 15);
      const float tot = SSQ[i] + SSQ[64 + i] + SSQ[128 + i] + SSQ[192 + i];
      const float rs = rsqrtf(tot * (1.f / 128.f) + 1e-6f);
#pragma unroll
      for (int vv = 0; vv < 2; ++vv) {
        const int v0 = (wave * 2 + vv) * 16 + (lane >> 4) * 4;
        uint2 gu = *(const uint2*)(proj + (size_t)i * LDP + GOFF + h * 128 + v0);
        float4 gg = *(const float4*)(gn + v0);
        f32x4 y;
        y[0] = o[vv][it][0] * rs * gg.x * silu_f(__uint_as_float(gu.x << 16));
        y[1] = o[vv][it][1] * rs * gg.y * silu_f(__uint_as_float(gu.x & 0xffff0000u));
        y[2] = o[vv][it][2] * rs * gg.z * silu_f(__uint_as_float(gu.y << 16));
        y[3] = o[vv][it][3] * rs * gg.w * silu_f(__uint_as_float(gu.y & 0xffff0000u));
        *(uint2*)(yb + (size_t)(b * 4096 + blk * 64 + i) * 1024 + YOFF + h * 128 + v0) = pack4(y);
      }
    }
  }
}

__device__ __forceinline__ void conv8(const P& p, const bf16* projb, int t, int c0, float* o8) {
  float4 b0 = *(const float4*)(p.conv_b + c0), b1 = *(const float4*)(p.conv_b + c0 + 4);
  float a[8] = {b0.x, b0.y, b0.z, b0.w, b1.x, b1.y, b1.z, b1.w};
#pragma unroll
  for (int jt = 0; jt < 4; ++jt) {
    const int tt = t + jt - 2;
    if (tt >= 0 && tt < 4096) {
      uint4 u = *(const uint4*)(projb + (size_t)tt * ODD_N + 3072 + c0);
      float4 w0 = *(const float4*)(p.conv_w + jt * 1024 + c0), w1 = *(const float4*)(p.conv_w + jt * 1024 + c0 + 4);
      a[0] += w0.x * __uint_as_float(u.x << 16); a[1] += w0.y * __uint_as_float(u.x & 0xffff0000u);
      a[2] += w0.z * __uint_as_float(u.y << 16); a[3] += w0.w * __uint_as_float(u.y & 0xffff0000u);
      a[4] += w1.x * __uint_as_float(u.z << 16); a[5] += w1.y * __uint_as_float(u.z & 0xffff0000u);
      a[6] += w1.z * __uint_as_float(u.w << 16); a[7] += w1.w * __uint_as_float(u.w & 0xffff0000u);
    }
  }
#pragma unroll
  for (int e = 0; e < 8; ++e) o8[e] = silu_f(a[e]);
}

__device__ __forceinline__ void ssd_prep_acum(const P& p, const bf16* projb, int blk, int g, float* ACUM, float* DTV, float* TOT) {
  const int lane = threadIdx.x & 63, wave = threadIdx.x >> 6;
#pragma unroll
  for (int q = 0; q < 2; ++q) {
    const int c = wave * 2 + q, dir = c >> 2, rp = c & 3, head = g * 4 + rp;
    const int j = dir ? 63 - lane : lane;
    const int t = blk * 64 + j;
    const float dt = softplus_f(bf2f(projb[(size_t)t * ODD_N + 4096 + dir * 8 + head]) + p.dt_bias[dir * 8 + head]);
    float v = -__expf(p.a_log[dir * 8 + head]) * dt;
#pragma unroll
    for (int off = 1; off < 64; off <<= 1) {
      float tmp = __shfl_up(v, off, 64);
      if (lane >= off) v += tmp;
    }
    ACUM[c * 64 + j] = v;
    DTV[c * 64 + j] = dt;
    if (lane == 63) TOT[c] = v;
  }
}

__device__ __forceinline__ void ssd_pass1_item(const P& p, int item, unsigned char* smem) {
  const int g = item & 1, blk = (item >> 1) & 63, b = item >> 7;
  bf16* BT = (bf16*)smem;
  bf16* XT = BT + 128 * 72;
  float* ACUM = (float*)(XT + 256 * 72);
  float* DTV = ACUM + 512;
  float* TOT = DTV + 512;
  const bf16* projb = (const bf16*)(p.ws + WS_PROJ) + (size_t)b * 4096 * ODD_N;
  bf16* ST = (bf16*)(p.ws + WS_ST);
  float* DEC = (float*)(p.ws + WS_DEC);
  const int tid = threadIdx.x, lane = tid & 63, wave = tid >> 6;
  const int t = blk * 64 + lane;
  ssd_prep_acum(p, projb, blk, g, ACUM, DTV, TOT);
#pragma unroll 1
  for (int q = 0; q < 4; ++q) {
    const int cc = wave + 4 * q;
    float v8[8];
    conv8(p, projb, t, 512 + g * 128 + cc * 8, v8);
#pragma unroll
    for (int e = 0; e < 8; ++e) BT[(cc * 8 + e) * 72 + lane] = f2bf(v8[e]);
  }
  float xs[8][8];
#pragma unroll
  for (int q = 0; q < 8; ++q) conv8(p, projb, t, g * 256 + (wave * 8 + q) * 8, xs[q]);
  __syncthreads();
  if (tid < 8) {
    const int dir = tid >> 2, head = g * 4 + (tid & 3);
    DEC[(size_t)((dir * 4 + b) * 8 + head) * 64 + blk] = __expf(TOT[tid]);
  }
#pragma unroll 1
  for (int dir = 0; dir < 2; ++dir) {
    if (dir) __syncthreads();
    const int c = dir * 4 + wave;
    const float fac = DTV[c * 64 + lane] * __expf(TOT[c] - ACUM[c * 64 + lane]);
#pragma unroll
    for (int q = 0; q < 8; ++q)
#pragma unroll
      for (int e = 0; e < 8; ++e) XT[((wave * 8 + q) * 8 + e) * 72 + lane] = f2bf(xs[q][e] * fac);
    __syncthreads();
    const int head = g * 4 + wave;
    bf16* stb = ST + (size_t)(((dir * 4 + b) * 8 + head) * 64 + blk) * 8192;
#pragma unroll 1
    for (int nh = 0; nh < 2; ++nh) {
      f32x4 acc[4][4];
#pragma unroll
      for (int nt = 0; nt < 4; ++nt)
#pragma unroll
        for (int pt = 0; pt < 4; ++pt) acc[nt][pt] = (f32x4){0.f, 0.f, 0.f, 0.f};
#pragma unroll
      for (int ks = 0; ks < 2; ++ks) {
        bf16x8 xf[4];
#pragma unroll
        for (int pt = 0; pt < 4; ++pt) xf[pt] = *(const bf16x8*)(XT + (wave * 64 + pt * 16 + (lane & 15)) * 72 + ks * 32 + (lane >> 4) * 8);
#pragma unroll
        for (int nt = 0; nt < 4; ++nt) {
          bf16x8 bfv = *(const bf16x8*)(BT + ((nh * 4 + nt) * 16 + (lane & 15)) * 72 + ks * 32 + (lane >> 4) * 8);
#pragma unroll
          for (int pt = 0; pt < 4; ++pt) acc[nt][pt] = __builtin_amdgcn_mfma_f32_16x16x32_bf16(bfv, xf[pt], acc[nt][pt], 0, 0, 0);
        }
      }
#pragma unroll
      for (int nt = 0; nt < 4; ++nt)
#pragma unroll
        for (int pt = 0; pt < 4; ++pt) {
          const int pp = pt * 16 + (lane & 15);
          const int n0 = (nh * 4 + nt) * 16 + (lane >> 4) * 4;
          *(uint2*)(stb + (size_t)pp * 128 + n0) = pack4(acc[nt][pt]);
        }
    }
  }
}

__device__ __forceinline__ void phase_ssd_scan(const P& p) {
  bf16* ST = (bf16*)(p.ws + WS_ST);
  const float* DEC = (const float*)(p.ws + WS_DEC);
  const int total = 64 * 2048;
  for (int idx = blockIdx.x * 256 + threadIdx.x; idx < total; idx += gridDim.x * 256) {
    const int e4 = idx & 2047, s = idx >> 11;
    const int d = s >> 5;
    float st0 = 0.f, st1 = 0.f, st2 = 0.f, st3 = 0.f;
#pragma unroll 1
    for (int n0 = 0; n0 < 64; n0 += 8) {
      uint2 u[8];
      float dc[8];
#pragma unroll
      for (int q = 0; q < 8; ++q) {
        const int blk = d ? 63 - (n0 + q) : (n0 + q);
        u[q] = *(const uint2*)(ST + (size_t)(s * 64 + blk) * 8192 + e4 * 4);
        dc[q] = DEC[s * 64 + blk];
      }
#pragma unroll
      for (int q = 0; q < 8; ++q) {
        const int blk = d ? 63 - (n0 + q) : (n0 + q);
        uint2 o;
        o.x = (unsigned)f2bf(st0) | ((unsigned)f2bf(st1) << 16);
        o.y = (unsigned)f2bf(st2) | ((unsigned)f2bf(st3) << 16);
        *(uint2*)(ST + (size_t)(s * 64 + blk) * 8192 + e4 * 4) = o;
        st0 = dc[q] * st0 + __uint_as_float(u[q].x << 16);
        st1 = dc[q] * st1 + __uint_as_float(u[q].x & 0xffff0000u);
        st2 = dc[q] * st2 + __uint_as_float(u[q].y << 16);
        st3 = dc[q] * st3 + __uint_as_float(u[q].y & 0xffff0000u);
      }
    }
  }
}

__device__ __forceinline__ void ssd_pass3_item(const P& p, int item, unsigned char* smem) {
  const int g = item & 1, blk = (item >> 1) & 63, b = item >> 7;
  bf16* CI = (bf16*)smem;
  bf16* BI = CI + 64 * 136;
  bf16* AI = BI;
  bf16* XT = BI + 64 * 136;
  float* ACUM = (float*)(XT + 64 * 72);
  float* DTV = ACUM + 512;
  float* TOT = DTV + 512;
  float* SSQ = TOT + 8;
  const bf16* projb = (const bf16*)(p.ws + WS_PROJ) + (size_t)b * 4096 * ODD_N;
  const bf16* ST = (const bf16*)(p.ws + WS_ST);
  bf16* yb = (bf16*)(p.ws + WS_H);
  const int tid = threadIdx.x, lane = tid & 63, wave = tid >> 6;
  const int t = blk * 64 + lane;
  ssd_prep_acum(p, projb, blk, g, ACUM, DTV, TOT);
#pragma unroll 1
  for (int q = 0; q < 8; ++q) {
    const int cc = wave * 8 + q, which = cc >> 4, ch = (cc & 15) * 8;
    float v8[8];
    conv8(p, projb, t, 512 + which * 256 + g * 128 + ch, v8);
    uint4 w;
    w.x = (unsigned)f2bf(v8[0]) | ((unsigned)f2bf(v8[1]) << 16);
    w.y = (unsigned)f2bf(v8[2]) | ((unsigned)f2bf(v8[3]) << 16);
    w.z = (unsigned)f2bf(v8[4]) | ((unsigned)f2bf(v8[5]) << 16);
    w.w = (unsigned)f2bf(v8[6]) | ((unsigned)f2bf(v8[7]) << 16);
    *(uint4*)((which ? CI : BI) + lane * 136 + ch) = w;
  }
  __syncthreads();
  f32x4 gt[4];
#pragma unroll
  for (int jt = 0; jt < 4; ++jt) gt[jt] = (f32x4){0.f, 0.f, 0.f, 0.f};
#pragma unroll
  for (int ks = 0; ks < 4; ++ks) {
    bf16x8 cf = *(const bf16x8*)(CI + (wave * 16 + (lane & 15)) * 136 + ks * 32 + (lane >> 4) * 8);
#pragma unroll
    for (int jt = 0; jt < 4; ++jt) {
      bf16x8 bfv = *(const bf16x8*)(BI + (jt * 16 + (lane & 15)) * 136 + ks * 32 + (lane >> 4) * 8);
      gt[jt] = __builtin_amdgcn_mfma_f32_16x16x32_bf16(bfv, cf, gt[jt], 0, 0, 0);
    }
  }
  __syncthreads();
  float ssq_acc[4] = {0.f, 0.f, 0.f, 0.f};
#pragma unroll 1
  for (int rp = 0; rp < 4; ++rp) {
    const int head = g * 4 + rp;
#pragma unroll 1
    for (int q = 0; q < 2; ++q) {
      const int cc = wave * 2 + q;
      float v8[8];
      conv8(p, projb, t, head * 64 + cc * 8, v8);
#pragma unroll
      for (int e = 0; e < 8; ++e) XT[(cc * 8 + e) * 72 + lane] = f2bf(v8[e]);
    }
    f32x4 o[4];
#pragma unroll
    for (int it = 0; it < 4; ++it) o[it] = (f32x4){0.f, 0.f, 0.f, 0.f};
#pragma unroll 1
    for (int dir = 0; dir < 2; ++dir) {
      const int c = dir * 4 + rp;
      {
        const int i = wave * 16 + (lane & 15);
        const float aci = ACUM[c * 64 + i];
#pragma unroll
        for (int jt = 0; jt < 4; ++jt) {
          const int j0 = jt * 16 + (lane >> 4) * 4;
          f32x4 m;
#pragma unroll
          for (int r = 0; r < 4; ++r) {
            const int j = j0 + r;
            const bool valid = dir ? (j >= i) : (j <= i);
            const float arg = fminf(aci - ACUM[c * 64 + j], 0.f);
            m[r] = valid ? gt[jt][r] * __expf(arg) * DTV[c * 64 + j] : 0.f;
          }
          *(uint2*)(AI + i * 72 + j0) = pack4(m);
        }
      }
      __syncthreads();
#pragma unroll
      for (int ks = 0; ks < 2; ++ks) {
        bf16x8 xf = *(const bf16x8*)(XT + (wave * 16 + (lane & 15)) * 72 + ks * 32 + (lane >> 4) * 8);
#pragma unroll
        for (int it = 0; it < 4; ++it) {
          bf16x8 af = *(const bf16x8*)(AI + (it * 16 + (lane & 15)) * 72 + ks * 32 + (lane >> 4) * 8);
          o[it] = __builtin_amdgcn_mfma_f32_16x16x32_bf16(xf, af, o[it], 0, 0, 0);
        }
      }
      f32x4 tI[4];
#pragma unroll
      for (int it = 0; it < 4; ++it) tI[it] = (f32x4){0.f, 0.f, 0.f, 0.f};
      const bf16* stb = ST + (size_t)(((dir * 4 + b) * 8 + head) * 64 + blk) * 8192;
#pragma unroll
      for (int ks = 0; ks < 4; ++ks) {
        bf16x8 sf = *(const bf16x8*)(stb + (size_t)(wave * 16 + (lane & 15)) * 128 + ks * 32 + (lane >> 4) * 8);
#pragma unroll
        for (int it = 0; it < 4; ++it) {
          bf16x8 cf = *(const bf16x8*)(CI + (it * 16 + (lane & 15)) * 136 + ks * 32 + (lane >> 4) * 8);
          tI[it] = __builtin_amdgcn_mfma_f32_16x16x32_bf16(sf, cf, tI[it], 0, 0, 0);
        }
      }
#pragma unroll
      for (int it = 0; it < 4; ++it) {
        const float ea = __expf(ACUM[c * 64 + it * 16 + (lane & 15)]);
#pragma unroll
        for (int r = 0; r < 4; ++r) o[it][r] += ea * tI[it][r];
      }
      __syncthreads();
    }
    {
      const float dsk = p.d_skip[head];
      const int p0 = wave * 16 + (lane >> 4) * 4;
      float4 gg = *(const float4*)(p.ssm_g + head * 64 + p0);
#pragma unroll
      for (int it = 0; it < 4; ++it) {
        const int i = it * 16 + (lane & 15);
        const size_t tok = (size_t)b * 4096 + blk * 64 + i;
        uint2 zu = *(const uint2*)(projb + (size_t)(blk * 64 + i) * ODD_N + 2560 + head * 64 + p0);
        f32x4 y;
        y[0] = (o[it][0] + dsk * bf2f(XT[(p0 + 0) * 72 + i])) * silu_f(__uint_as_float(zu.x << 16));
        y[1] = (o[it][1] + dsk * bf2f(XT[(p0 + 1) * 72 + i])) * silu_f(__uint_as_float(zu.x & 0xffff0000u));
        y[2] = (o[it][2] + dsk * bf2f(XT[(p0 + 2) * 72 + i])) * silu_f(__uint_as_float(zu.y << 16));
        y[3] = (o[it][3] + dsk * bf2f(XT[(p0 + 3) * 72 + i])) * silu_f(__uint_as_float(zu.y & 0xffff0000u));
        ssq_acc[it] += y[0] * y[0] + y[1] * y[1] + y[2] * y[2] + y[3] * y[3];
        y[0] *= gg.x; y[1] *= gg.y; y[2] *= gg.z; y[3] *= gg.w;
        *(uint2*)(yb + tok * 1024 + 512 + head * 64 + p0) = pack4(y);
      }
    }
    __syncthreads();
  }
#pragma unroll
  for (int it = 0; it < 4; ++it) {
    float s = ssq_acc[it];
    s += __shfl_xor(s, 16, 64);
    s += __shfl_xor(s, 32, 64);
    if (lane < 16) SSQ[wave * 64 + it * 16 + lane] = s;
  }
  __syncthreads();
  if (tid < 64) {
    float* ssqp = (float*)(p.ws + WS_SSQ);
    ssqp[(size_t)g * M_TOK + (size_t)b * 4096 + blk * 64 + tid] = SSQ[tid] + SSQ[64 + tid] + SSQ[128 + tid] + SSQ[192 + tid];
  }
}

__device__ __forceinline__ void phase_ssd_norm(const P& p) {
  const float* ssqp = (const float*)(p.ws + WS_SSQ);
  bf16* yb = (bf16*)(p.ws + WS_H);
  const int total = M_TOK * 64;
  for (int idx = blockIdx.x * 256 + threadIdx.x; idx < total; idx += gridDim.x * 256) {
    const int tok = idx >> 6, c8 = (idx & 63) * 8;
    const float rs = rsqrtf((ssqp[tok] + ssqp[M_TOK + tok]) * (1.f / 512.f) + 1e-6f);
    uint4* ptr = (uint4*)(yb + (size_t)tok * 1024 + 512 + c8);
    uint4 u = *ptr, w;
    w.x = (unsigned)f2bf(__uint_as_float(u.x << 16) * rs) | ((unsigned)f2bf(__uint_as_float(u.x & 0xffff0000u) * rs) << 16);
    w.y = (unsigned)f2bf(__uint_as_float(u.y << 16) * rs) | ((unsigned)f2bf(__uint_as_float(u.y & 0xffff0000u) * rs) << 16);
    w.z = (unsigned)f2bf(__uint_as_float(u.z << 16) * rs) | ((unsigned)f2bf(__uint_as_float(u.z & 0xffff0000u) * rs) << 16);
    w.w = (unsigned)f2bf(__uint_as_float(u.w << 16) * rs) | ((unsigned)f2bf(__uint_as_float(u.w & 0xffff0000u) * rs) << 16);
    *ptr = w;
  }
}


#define XB_TMO      128
#define XB_XCNT(j)  (256  + 64 * (j))
#define XB_XSUB(j)  (1280 + 64 * (j))
#define XB_XGEN(j)  (2304 + 64 * (j))
#define XB_TOP      3328
#define XB_TOPGEN   3392
#define XCD_BAR_WORDS 3456
#define XB_SPIN_CAP (1u << 18)
#define LAS __attribute__((address_space(3)))
__device__ __forceinline__ unsigned xb_ld(unsigned* p) { return __hip_atomic_load(p, __ATOMIC_RELAXED, __HIP_MEMORY_SCOPE_AGENT); }
__device__ __forceinline__ unsigned xb_add(unsigned* p, unsigned v) { return __hip_atomic_fetch_add(p, v, __ATOMIC_RELAXED, __HIP_MEMORY_SCOPE_AGENT); }
__device__ __forceinline__ unsigned xb_xcc_id() { return (unsigned)__builtin_amdgcn_s_getreg((3 << 11) | 20) & 0xFu; }
#define XB_SPIN(cond, bar) do { unsigned _sp = 0; while (cond) { __builtin_amdgcn_s_sleep(1); \
    if ((++_sp & 255u) == 0u) { if (xb_ld(&(bar)[XB_TMO])) break; if (_sp > XB_SPIN_CAP) { atomicAdd(&(bar)[XB_TMO], 1u); break; } } } } while (0)
struct XcdBarrier { unsigned* bar; unsigned x; volatile LAS unsigned* st; };
__device__ __forceinline__ XcdBarrier xcd_barrier_post(unsigned* bar, volatile LAS unsigned* st) {
  XcdBarrier b; b.bar = bar; b.x = xb_xcc_id(); b.st = st;
  if (threadIdx.x == 0) (void)xb_add(&bar[XB_XCNT(b.x)], 1u);
  return b;
}
__device__ __forceinline__ void xcd_barrier_complete(unsigned* bar, unsigned x, unsigned& nloc, unsigned& nx) {
  const unsigned G = gridDim.x * gridDim.y * gridDim.z;
  unsigned sum, cnt, mine, sp = 0u;
  for (;;) {
    sum = 0u; cnt = 0u; mine = 0u;
#pragma unroll
    for (unsigned j = 0; j < 16; ++j) { const unsigned c = xb_ld(&bar[XB_XCNT(j)]); sum += c; cnt += (c > 0u) ? 1u : 0u; mine = (j == x) ? c : mine; }
    if (sum == G) break;
    __builtin_amdgcn_s_sleep(1);
    if ((++sp & 255u) == 0u) { if (xb_ld(&bar[XB_TMO])) break; if (sp > XB_SPIN_CAP) { atomicAdd(&bar[XB_TMO], 1u); break; } }
  }
  nloc = mine > 0u ? mine : 1u; nx = cnt > 0u ? cnt : 1u;
}
__device__ __forceinline__ void xcd_barrier(const XcdBarrier& b) {
  asm volatile("s_waitcnt vmcnt(0)" ::: "memory");
  __syncthreads();
  if (threadIdx.x == 0) {
    unsigned* bar = b.bar;
    __builtin_amdgcn_s_waitcnt(0);
    unsigned nloc = b.st[0], nx = b.st[1];
    if (nloc == 0u) { xcd_barrier_complete(bar, b.x, nloc, nx); b.st[0] = nloc; b.st[1] = nx; }
    const unsigned old = xb_add(&bar[XB_XSUB(b.x)], 1u);
    const unsigned gen = old / nloc;
    if (old + 1u == (gen + 1u) * nloc) {
      __builtin_amdgcn_fence(__ATOMIC_RELEASE, "agent");
      asm volatile("s_waitcnt vmcnt(0)" ::: "memory");
      const unsigned og = xb_add(&bar[XB_TOP], 1u);
      const unsigned tg = og / nx;
      if (og + 1u == (tg + 1u) * nx) xb_add(&bar[XB_TOPGEN], 1u);
      else XB_SPIN(xb_ld(&bar[XB_TOPGEN]) == tg, bar);
      __builtin_amdgcn_fence(__ATOMIC_ACQUIRE, "agent");
      xb_add(&bar[XB_XGEN(b.x)], 1u);
      asm volatile("s_waitcnt vmcnt(0)" ::: "memory");
    } else {
      XB_SPIN(xb_ld(&bar[XB_XGEN(b.x)]) == gen, bar);
      __builtin_amdgcn_fence(__ATOMIC_ACQUIRE, "agent");
      asm volatile("s_waitcnt vmcnt(0)" ::: "memory");
    }
  }
  __syncthreads();
}

#define NPHASE 18
#ifndef REPG
#define REPG 1
#endif
#ifndef REPN
#define REPN 1
#endif
#ifndef REP3
#define REP3 1
#endif
__global__ void __launch_bounds__(256, 2) mega(P p, int ph_lo, int ph_hi) {
  __shared__ __align__(16) unsigned char smem[73728 + 16];
  cg::grid_group grid = cg::this_grid();
  if (ph_lo < 0) grid.sync();
  if (threadIdx.x == 0) *(uint4*)(smem + 73728) = make_uint4(0u, 0u, 0u, 0u);
  __syncthreads();
  XcdBarrier xb = xcd_barrier_post((unsigned*)(p.ws + WS_BAR), (volatile LAS unsigned*)(smem + 73728));
  const float* mod = (const float*)(p.ws + WS_MOD);
#define IN(k) (ph_lo <= (k) && (k) < ph_hi)
#define SYNC(k) if (IN(k) && (k) + 1 < ph_hi) xcd_barrier(xb);
  if (IN(0)) phase_setup(p, smem);
  SYNC(0)
  if (IN(1)) phase_h0(p);
  SYNC(1)
  if (IN(2)) for (int rep = 0; rep < REPG; ++rep)
    phase_gemm<0>((const bf16*)(p.ws + WS_H), (const bf16*)(p.ws + WS_WEI), EVEN_NP / 128, smem,
                  (bf16*)(p.ws + WS_PROJ), EVEN_N, EVEN_N, nullptr, nullptr, nullptr);
  SYNC(2)
  if (IN(3)) {
    for (int it = blockIdx.x; it < 1024 + 2048 * REPN; it += gridDim.x) {
      if (it < 1024) rec_pass1_item<64, 0>(p, it, smem); else na_item(p, (it - 1024) & 2047, smem);
      __syncthreads();
    }
  }
  SYNC(3)
  if (IN(4)) phase_rec_scan<64>(p);
  SYNC(4)
  if (IN(5)) {
    for (int it = blockIdx.x; it < 1024; it += gridDim.x) { rec_pass3_item<64, 0>(p, it, smem); __syncthreads(); }
  }
  SYNC(5)
  if (IN(6))
    phase_gemm<1>((const bf16*)(p.ws + WS_H), (const bf16*)(p.ws + WS_WEO), 8, smem, nullptr, 0, 0, p.x, p.out,
                  mod + 2048);
  SYNC(6)
  if (IN(7)) phase_ln(p, 0, true);
  SYNC(7)
  if (IN(8)) for (int rep = 0; rep < REPG; ++rep)
    phase_gemm<0>((const bf16*)(p.ws + WS_H), (const bf16*)(p.ws + WS_WOI), ODD_NP / 128, smem,
                  (bf16*)(p.ws + WS_PROJ), ODD_N, ODD_N, nullptr, nullptr, nullptr);
  SYNC(8)
  if (IN(9)) {
    for (int it = blockIdx.x; it < 1024; it += gridDim.x) { rec_pass1_item<128, 1>(p, it, smem); __syncthreads(); }
  }
  SYNC(9)
  if (IN(10)) phase_rec_scan<128>(p);
  SYNC(10)
  if (IN(11)) {
    for (int it = blockIdx.x; it < 1024 * REP3; it += gridDim.x) { rec_pass3_item<128, 1>(p, it & 1023, smem); __syncthreads(); }
  }
  SYNC(11)
  if (IN(12)) {
    for (int it = blockIdx.x; it < 512; it += gridDim.x) { ssd_pass1_item(p, it, smem); __syncthreads(); }
  }
  SYNC(12)
  if (IN(13)) phase_ssd_scan(p);
  SYNC(13)
  if (IN(14)) {
    for (int it = blockIdx.x; it < 512; it += gridDim.x) { ssd_pass3_item(p, it, smem); __syncthreads(); }
  }
  SYNC(14)
  if (IN(15)) phase_ssd_norm(p);
  SYNC(15)
  if (IN(16))
    phase_gemm<1>((const bf16*)(p.ws + WS_H), (const bf16*)(p.ws + WS_WOO), 8, smem, nullptr, 0, 0, p.out, p.out,
                  mod + 4 * 3072 + 2048);
  SYNC(16)
  if (IN(17)) phase_ln(p, 1, false);
}

extern "C" void kernel_launch(void* const* d_in, const int* in_sizes, int n_in, void* d_out, int out_size, void* d_ws,
                              size_t ws_size, hipStream_t stream) {
  static int grid_blocks = 0;
  if (!grid_blocks) {
    int dev = 0, cus = 0, per_cu = 0;
    hipGetDevice(&dev);
    hipDeviceGetAttribute(&cus, hipDeviceAttributeMultiprocessorCount, dev);
    hipOccupancyMaxActiveBlocksPerMultiprocessor(&per_cu, mega, 256, 0);
    if (per_cu < 1) per_cu = 1;
    if (per_cu > 2) per_cu = 2;
    grid_blocks = cus * per_cu;
    if (n_in != 22 || ws_size < WS_END) {
      fprintf(stderr, "kernel_launch: unexpected n_in %d / ws_size %zu (need %llu)\n", n_in, ws_size, (unsigned long long)WS_END);
      grid_blocks = -1;
    }
  }
  if (grid_blocks < 0) return;
  P p{};
  const float** f = (const float**)&p;
  for (int i = 0; i < 22; ++i) f[i] = (const float*)d_in[i];
  p.out = (float*)d_out;
  p.ws = (unsigned char*)d_ws;
#if 1
  if (hipMemsetAsync((char*)d_ws + WS_BAR, 0, 16384, stream) != hipSuccess) { fprintf(stderr, "memset of barrier words failed\n"); return; }
  int lo = 0, hi = NPHASE;
  void* args[] = {&p, &lo, &hi};
  hipError_t e = hipLaunchCooperativeKernel((void*)mega, dim3(grid_blocks), dim3(256), args, 0, stream);
  if (e != hipSuccess) fprintf(stderr, "cooperative launch failed: %s (grid %d)\n", hipGetErrorString(e), grid_blocks);
#else
  for (int ph = 0; ph < NPHASE; ++ph) hipLaunchKernelGGL(mega, dim3(grid_blocks), dim3(256), 0, stream, p, ph, ph + 1);
#endif
}
```

```cpp
#include <hip/hip_runtime.h>
#include <hip/hip_cooperative_groups.h>
#include <cstdio>
namespace cg = cooperative_groups;

typedef unsigned short bf16;
using bf16x8 = __attribute__((ext_vector_type(8))) short;
using f32x4 = __attribute__((ext_vector_type(4))) float;

#define M_TOK 16384
#define DM 1024
#define SEQ 4096
#define EVEN_N 3616
#define EVEN_NP 3712
#define ODD_N 4112
#define ODD_NP 4224
#define ALPHA 1.4142135623730951f

#define WS_MOD 0ull
#define WS_LB (WS_MOD + 98304ull)
#define WS_WEI (WS_LB + 2048ull)
#define WS_WEO (WS_WEI + 3712ull * 2048)
#define WS_WOI (WS_WEO + 1024ull * 2048)
#define WS_WOO (WS_WOI + 4224ull * 2048)
#define WS_H (WS_WOO + 1024ull * 2048)
#define WS_PROJ (WS_H + 16384ull * 2048)
#define WS_O (WS_PROJ + 16384ull * 4112 * 2)
#define WS_ST WS_O
#define WS_DEC (WS_O + 2ull * 16384 * 512 * 4)
#define WS_SSQ (WS_DEC + 2ull * 16 * 64 * 128 * 4)
#define WS_BAR (WS_SSQ + 2ull * 16384 * 4)
#define WS_END (WS_BAR + 16384ull)

struct P {
  const float *x, *c, *ada_w, *ada_b, *ln_g, *ln_b, *e_w_in, *e_rpb, *gla_w_up, *gla_b, *gla_g, *e_w_out;
  const float *o_w_in, *hgrn_lb, *hgrn_g, *conv_w, *conv_b, *dt_bias, *a_log, *d_skip, *ssm_g, *o_w_out;
  float* out;
  unsigned char* ws;
};

__device__ __forceinline__ bf16 f2bf(float f) {
  __bf16 h = (__bf16)f;
  return *(bf16*)&h;
}
using u32x4 = __attribute__((ext_vector_type(4))) unsigned;
__device__ __forceinline__ u32x4 gload16_asm(const void* ptr) {
  u32x4 r;
  asm volatile("global_load_dwordx4 %0, %1, off" : "=v"(r) : "v"(ptr));
  return r;
}
__device__ __forceinline__ float bf2f(bf16 h) { return __uint_as_float(((unsigned)h) << 16); }
__device__ __forceinline__ float silu_f(float v) { return v / (1.f + __expf(-v)); }
__device__ __forceinline__ float sigmoid_f(float v) { return 1.f / (1.f + __expf(-v)); }
__device__ __forceinline__ float log_sigmoid_f(float z) { return fminf(z, 0.f) - __logf(1.f + __expf(-fabsf(z))); }
__device__ __forceinline__ float softplus_f(float z) { return fmaxf(z, 0.f) + log1pf(__expf(-fabsf(z))); }
__device__ __forceinline__ float wave_sum(float v) {
#pragma unroll
  for (int o = 32; o > 0; o >>= 1) v += __shfl_xor(v, o, 64);
  return v;
}

__device__ __forceinline__ void transpose_item(const float* __restrict__ src, int N, bf16* __restrict__ dst, int li, unsigned char* smem) {
  float* tile = (float*)smem;
  const int tid = threadIdx.x;
  const int kt = li & 15, ntile = li >> 4;
#pragma unroll
  for (int i = 0; i < 16; ++i) {
    int row = i * 4 + (tid >> 6), col = tid & 63;
    int n = ntile * 64 + col;
    float v = (n < N) ? src[(size_t)(kt * 64 + row) * N + n] : 0.f;
    tile[row * 65 + col] = v;
  }
  __syncthreads();
#pragma unroll
  for (int i = 0; i < 16; ++i) {
    int r = i * 4 + (tid >> 6), cc = tid & 63;
    dst[(size_t)(ntile * 64 + r) * 1024 + kt * 64 + cc] = f2bf(tile[cc * 65 + r]);
  }
}

__device__ __forceinline__ void mod_item(const P& p, int idx, unsigned char* smem) {
  float* cond = (float*)smem;
  float* red = cond + 4096;
  const int tid = threadIdx.x;
  const int l = idx / 192, nc = idx % 192;
  for (int e = tid; e < 4096; e += 256) cond[e] = silu_f(p.c[e]);
  __syncthreads();
  const int kg = tid >> 4, col = tid & 15, n = nc * 16 + col;
  float a0 = 0.f, a1 = 0.f, a2 = 0.f, a3 = 0.f;
  const float* w = p.ada_w + (size_t)l * 1024 * 3072 + n;
#pragma unroll 16
  for (int k = kg * 64; k < kg * 64 + 64; ++k) {
    float wv = w[(size_t)k * 3072];
    a0 += cond[k] * wv; a1 += cond[1024 + k] * wv; a2 += cond[2048 + k] * wv; a3 += cond[3072 + k] * wv;
  }
  red[(kg * 4 + 0) * 16 + col] = a0; red[(kg * 4 + 1) * 16 + col] = a1;
  red[(kg * 4 + 2) * 16 + col] = a2; red[(kg * 4 + 3) * 16 + col] = a3;
  __syncthreads();
  if (tid < 64) {
    const int b = tid >> 4;
    float sum = 0.f;
#pragma unroll
    for (int q = 0; q < 16; ++q) sum += red[(q * 4 + b) * 16 + col];
    float* mod = (float*)(p.ws + WS_MOD);
    mod[(size_t)(l * 4 + b) * 3072 + n] = sum + p.ada_b[l * 3072 + n];
  }
}

__device__ __forceinline__ void phase_setup(const P& p, unsigned char* smem) {
  const int M0 = 384, T0 = M0 + 16 * 58, T1 = T0 + 256, T2 = T1 + 16 * 66, T3 = T2 + 256, T5 = T3 + 1;
  for (int it = blockIdx.x; it < T5; it += gridDim.x) {
    if (it < M0) mod_item(p, it, smem);
    else if (it < T0) transpose_item(p.e_w_in, EVEN_N, (bf16*)(p.ws + WS_WEI), it - M0, smem);
    else if (it < T1) transpose_item(p.e_w_out, 1024, (bf16*)(p.ws + WS_WEO), it - T0, smem);
    else if (it < T2) transpose_item(p.o_w_in, ODD_N, (bf16*)(p.ws + WS_WOI), it - T1, smem);
    else if (it < T3) transpose_item(p.o_w_out, 1024, (bf16*)(p.ws + WS_WOO), it - T2, smem);
    else {
      float* lbv = (float*)(p.ws + WS_LB);
      for (int j = threadIdx.x; j < 512; j += 256) {
        float a = p.hgrn_lb[j], bb = p.hgrn_lb[512 + j];
        lbv[j] = 1.f / (1.f + __expf(a - bb));
      }
    }
    __syncthreads();
  }
}

__device__ __forceinline__ void phase_h0(const P& p) {
  const float* mod = (const float*)(p.ws + WS_MOD);
  bf16* hb = (bf16*)(p.ws + WS_H);
  const size_t total = (size_t)M_TOK * 128;
  for (size_t i = (size_t)blockIdx.x * 256 + threadIdx.x; i < total; i += (size_t)gridDim.x * 256) {
    int m = (int)(i >> 7), n = (int)(i & 127) * 8, b = m >> 12;
    const float4* xp = (const float4*)(p.x + (size_t)m * 1024 + n);
    const float4* sh = (const float4*)(mod + (size_t)b * 3072 + n);
    const float4* sc = (const float4*)(mod + (size_t)b * 3072 + 1024 + n);
    float4 x0 = xp[0], x1 = xp[1], s0 = sh[0], s1 = sh[1], c0 = sc[0], c1 = sc[1];
    uint4 o;
    o.x = (unsigned)f2bf(x0.x * (1.f + c0.x) + s0.x) | ((unsigned)f2bf(x0.y * (1.f + c0.y) + s0.y) << 16);
    o.y = (unsigned)f2bf(x0.z * (1.f + c0.z) + s0.z) | ((unsigned)f2bf(x0.w * (1.f + c0.w) + s0.w) << 16);
    o.z = (unsigned)f2bf(x1.x * (1.f + c1.x) + s1.x) | ((unsigned)f2bf(x1.y * (1.f + c1.y) + s1.y) << 16);
    o.w = (unsigned)f2bf(x1.z * (1.f + c1.z) + s1.z) | ((unsigned)f2bf(x1.w * (1.f + c1.w) + s1.w) << 16);
    *(uint4*)(hb + (size_t)m * 1024 + n) = o;
  }
}

#define LSTR 64
template <int EPI>
__device__ __forceinline__ void gemm_tile(const bf16* __restrict__ A, const bf16* __restrict__ Bt, int m0, int n0,
                                          unsigned char* smem, bf16* __restrict__ C, int ldc, int nreal,
                                          const float* __restrict__ X, float* __restrict__ R, const float* __restrict__ gate) {
  bf16* As = (bf16*)smem;
  bf16* Bs = As + 2 * 128 * LSTR;
  const int tid = threadIdx.x, lane = tid & 63, wave = tid >> 6;
  const int wm = wave >> 1, wn = wave & 1;
  f32x4 acc[4][4];
#pragma unroll
  for (int i = 0; i < 4; ++i)
#pragma unroll
    for (int j = 0; j < 4; ++j) acc[i][j] = (f32x4){0.f, 0.f, 0.f, 0.f};
  u32x4 ra[3][4], rb[3][4];
  const int lrow = tid >> 3, lkc = tid & 7;
  const int lsw = (lkc ^ (lrow & 7)) * 8;
  const bf16* Ag = A + (size_t)(m0 + lrow) * 1024 + lkc * 8;
  const bf16* Bg = Bt + (size_t)(n0 + lrow) * 1024 + lkc * 8;
#pragma unroll
  for (int t = 0; t < 3; ++t)
#pragma unroll
    for (int i = 0; i < 4; ++i) {
      ra[t][i] = gload16_asm(Ag + (size_t)i * 32 * 1024 + t * 64);
      rb[t][i] = gload16_asm(Bg + (size_t)i * 32 * 1024 + t * 64);
    }
  asm volatile("s_waitcnt vmcnt(16)"
               : "+v"(ra[0][0]), "+v"(ra[0][1]), "+v"(ra[0][2]), "+v"(ra[0][3]), "+v"(rb[0][0]), "+v"(rb[0][1]), "+v"(rb[0][2]), "+v"(rb[0][3])
               :: "memory");
#pragma unroll
  for (int i = 0; i < 4; ++i) {
    *(u32x4*)(As + (lrow + i * 32) * LSTR + lsw) = ra[0][i];
    *(u32x4*)(Bs + (lrow + i * 32) * LSTR + lsw) = rb[0][i];
  }
  __syncthreads();
#pragma unroll
  for (int kt = 0; kt < 16; ++kt) {
    const int buf = kt & 1;
    if (kt + 1 < 16) {
      const int sn = (kt + 1) % 3;
      if (kt + 2 < 16) {
        asm volatile("s_waitcnt vmcnt(8)"
                     : "+v"(ra[sn][0]), "+v"(ra[sn][1]), "+v"(ra[sn][2]), "+v"(ra[sn][3]), "+v"(rb[sn][0]), "+v"(rb[sn][1]), "+v"(rb[sn][2]), "+v"(rb[sn][3])
                     :: "memory");
      } else {
        asm volatile("s_waitcnt vmcnt(0)"
                     : "+v"(ra[sn][0]), "+v"(ra[sn][1]), "+v"(ra[sn][2]), "+v"(ra[sn][3]), "+v"(rb[sn][0]), "+v"(rb[sn][1]), "+v"(rb[sn][2]), "+v"(rb[sn][3])
                     :: "memory");
      }
      bf16* Aw = As + (buf ^ 1) * 128 * LSTR;
      bf16* Bw = Bs + (buf ^ 1) * 128 * LSTR;
#pragma unroll
      for (int i = 0; i < 4; ++i) {
        *(u32x4*)(Aw + (lrow + i * 32) * LSTR + lsw) = ra[sn][i];
        *(u32x4*)(Bw + (lrow + i * 32) * LSTR + lsw) = rb[sn][i];
      }
    }
    if (kt + 3 < 16) {
#pragma unroll
      for (int i = 0; i < 4; ++i) {
        ra[kt % 3][i] = gload16_asm(Ag + (size_t)i * 32 * 1024 + (kt + 3) * 64);
        rb[kt % 3][i] = gload16_asm(Bg + (size_t)i * 32 * 1024 + (kt + 3) * 64);
      }
    }
    const bf16* Ab = As + buf * 128 * LSTR;
    const bf16* Bb = Bs + buf * 128 * LSTR;
#pragma unroll
    for (int s = 0; s < 2; ++s) {
      bf16x8 wf[4], xf[4];
#pragma unroll
      for (int i = 0; i < 4; ++i) {
        wf[i] = *(const bf16x8*)(Bb + (wn * 64 + i * 16 + (lane & 15)) * LSTR + (((s * 4 + (lane >> 4)) ^ (lane & 7)) * 8));
        xf[i] = *(const bf16x8*)(Ab + (wm * 64 + i * 16 + (lane & 15)) * LSTR + (((s * 4 + (lane >> 4)) ^ (lane & 7)) * 8));
      }
#pragma unroll
      for (int i = 0; i < 4; ++i)
#pragma unroll
        for (int j = 0; j < 4; ++j) acc[i][j] = __builtin_amdgcn_mfma_f32_16x16x32_bf16(wf[i], xf[j], acc[i][j], 0, 0, 0);
    }
    __syncthreads();
  }
#pragma unroll
  for (int i = 0; i < 4; ++i) {
    const int n = n0 + wn * 64 + i * 16 + (lane >> 4) * 4;
#pragma unroll
    for (int j = 0; j < 4; ++j) {
      const int m = m0 + wm * 64 + j * 16 + (lane & 15);
      f32x4 a = acc[i][j];
      if (EPI == 0) {
        if (n < nreal) {
          uint2 o;
          o.x = (unsigned)f2bf(a[0]) | ((unsigned)f2bf(a[1]) << 16);
          o.y = (unsigned)f2bf(a[2]) | ((unsigned)f2bf(a[3]) << 16);
          *(uint2*)(C + (size_t)m * ldc + n) = o;
        }
      } else {
        const int b = m >> 12;
        float4 xv = *(const float4*)(X + (size_t)m * 1024 + n);
        float4 g = *(const float4*)(gate + (size_t)b * 3072 + n);
        float4 o;
        o.x = ALPHA * xv.x + g.x * a[0];
        o.y = ALPHA * xv.y + g.y * a[1];
        o.z = ALPHA * xv.z + g.z * a[2];
        o.w = ALPHA * xv.w + g.w * a[3];
        *(float4*)(R + (size_t)m * 1024 + n) = o;
      }
    }
  }
}

template <int EPI>
__device__ __forceinline__ void phase_gemm(const bf16* A, const bf16* Bt, int ntn, unsigned char* smem, bf16* C, int ldc, int nreal,
                           const float* X, float* R, const float* gate) {
  const int total = (M_TOK / 128) * ntn;
  for (int t = blockIdx.x; t < total; t += gridDim.x) {
    int mt = t / ntn, nt = t % ntn;
    gemm_tile<EPI>(A, Bt, mt * 128, nt * 128, smem, C, ldc, nreal, X, R, gate);
  }
}

__device__ __forceinline__ void phase_ln(const P& p, int l, bool write_h) {
  const float* mod = (const float*)(p.ws + WS_MOD);
  bf16* hb = (bf16*)(p.ws + WS_H);
  const int lane = threadIdx.x & 63, wave = threadIdx.x >> 6;
  const float* g = p.ln_g + l * 1024;
  const float* bb = p.ln_b + l * 1024;
  for (int row = blockIdx.x * 4 + wave; row < M_TOK; row += gridDim.x * 4) {
    float* rp = p.out + (size_t)row * 1024;
    float4 v[4];
    float s = 0.f;
#pragma unroll
    for (int q = 0; q < 4; ++q) {
      v[q] = *(const float4*)(rp + (lane + 64 * q) * 4);
      s += v[q].x + v[q].y + v[q].z + v[q].w;
    }
    const float mu = wave_sum(s) * (1.f / 1024.f);
    float s2 = 0.f;
#pragma unroll
    for (int q = 0; q < 4; ++q) {
      float a = v[q].x - mu, b2 = v[q].y - mu, c2 = v[q].z - mu, d2 = v[q].w - mu;
      s2 += a * a + b2 * b2 + c2 * c2 + d2 * d2;
    }
    const float rstd = rsqrtf(wave_sum(s2) * (1.f / 1024.f) + 1e-5f);
    const int b = row >> 12;
#pragma unroll
    for (int q = 0; q < 4; ++q) {
      const int n = (lane + 64 * q) * 4;
      float4 gg = *(const float4*)(g + n), be = *(const float4*)(bb + n);
      float4 o;
      o.x = (v[q].x - mu) * rstd * gg.x + be.x;
      o.y = (v[q].y - mu) * rstd * gg.y + be.y;
      o.z = (v[q].z - mu) * rstd * gg.z + be.z;
      o.w = (v[q].w - mu) * rstd * gg.w + be.w;
      *(float4*)(rp + n) = o;
      if (write_h) {
        const float* md = mod + (size_t)(4 + b) * 3072;
        float4 sh = *(const float4*)(md + n), sc = *(const float4*)(md + 1024 + n);
        uint2 hh;
        hh.x = (unsigned)f2bf(o.x * (1.f + sc.x) + sh.x) | ((unsigned)f2bf(o.y * (1.f + sc.y) + sh.y) << 16);
        hh.y = (unsigned)f2bf(o.z * (1.f + sc.z) + sh.z) | ((unsigned)f2bf(o.w * (1.f + sc.w) + sh.w) << 16);
        *(uint2*)(hb + (size_t)row * 1024 + n) = hh;
      }
    }
  }
}

__device__ __forceinline__ void na_item(const P& p, int item, unsigned char* smem) {
  const int h = item & 7, r = (item >> 3) & 63, b = item >> 9;
  bf16* VT = (bf16*)smem;
  float* RPB = (float*)(VT + 64 * 520);
  const bf16* projb = (const bf16*)(p.ws + WS_PROJ) + (size_t)b * 4096 * EVEN_N;
  bf16* yb = (bf16*)(p.ws + WS_H);
  const int tid = threadIdx.x, lane = tid & 63, n = tid >> 6;
  const int q = lane & 15, g4 = lane >> 4;
  int rs = r - 4; rs = rs < 0 ? 0 : (rs > 56 ? 56 : rs);
#pragma unroll 4
  for (int i = 0; i < 16; ++i) {
    const int pair = i * 256 + tid, key = pair & 511, ch = pair >> 9;
    const int tok = (rs + (key >> 6)) * 64 + (key & 63);
    uint4 u = *(const uint4*)(projb + (size_t)tok * EVEN_N + 1024 + h * 64 + ch * 8);
    bf16* dst = VT + (ch * 8) * 520 + key;
    dst[0 * 520] = (bf16)(u.x & 0xffffu); dst[1 * 520] = (bf16)(u.x >> 16);
    dst[2 * 520] = (bf16)(u.y & 0xffffu); dst[3 * 520] = (bf16)(u.y >> 16);
    dst[4 * 520] = (bf16)(u.z & 0xffffu); dst[5 * 520] = (bf16)(u.z >> 16);
    dst[6 * 520] = (bf16)(u.w & 0xffffu); dst[7 * 520] = (bf16)(u.w >> 16);
  }
  for (int i = tid; i < 465; i += 256) RPB[i] = p.e_rpb[h * 465 + i];
  const int qcol = n * 16 + q;
  const int qtok = r * 64 + qcol;
  const int bs = n == 0 ? 0 : (n == 1 ? 8 : (n == 2 ? 24 : 32));
  const bf16x8 qf0 = *(const bf16x8*)(projb + (size_t)qtok * EVEN_N + h * 64 + g4 * 8);
  const bf16x8 qf1 = *(const bf16x8*)(projb + (size_t)qtok * EVEN_N + h * 64 + 32 + g4 * 8);
  f32x4 st[16];
#pragma unroll
  for (int tt = 0; tt < 16; ++tt) {
    const int ktok = (rs + (tt >> 1)) * 64 + bs + (tt & 1) * 16 + q;
    const bf16* kp = projb + (size_t)ktok * EVEN_N + 512 + h * 64 + g4 * 8;
    bf16x8 kf0 = *(const bf16x8*)kp, kf1 = *(const bf16x8*)(kp + 32);
    f32x4 z = (f32x4){0.f, 0.f, 0.f, 0.f};
    z = __builtin_amdgcn_mfma_f32_16x16x32_bf16(kf0, qf0, z, 0, 0, 0);
    st[tt] = __builtin_amdgcn_mfma_f32_16x16x32_bf16(kf1, qf1, z, 0, 0, 0);
  }
  __syncthreads();
  int cs = qcol - 8; cs = cs < 0 ? 0 : (cs > 48 ? 48 : cs);
  float mx = -1e30f;
#pragma unroll
  for (int tt = 0; tt < 16; ++tt) {
    const float* brow = RPB + (rs + (tt >> 1) - r + 7) * 31;
#pragma unroll
    for (int rr = 0; rr < 4; ++rr) {
      const int kcol = bs + (tt & 1) * 16 + g4 * 4 + rr;
      const bool valid = (kcol >= cs) && (kcol < cs + 16);
      int dc = kcol - qcol + 15; dc = dc < 0 ? 0 : (dc > 30 ? 30 : dc);
      const float sc = valid ? st[tt][rr] * 0.125f + brow[dc] : -1e30f;
      st[tt][rr] = sc;
      mx = fmaxf(mx, sc);
    }
  }
  mx = fmaxf(mx, __shfl_xor(mx, 16, 64));
  mx = fmaxf(mx, __shfl_xor(mx, 32, 64));
  float lsum = 0.f;
#pragma unroll
  for (int tt = 0; tt < 16; ++tt)
#pragma unroll
    for (int rr = 0; rr < 4; ++rr) {
      const float pe = __expf(st[tt][rr] - mx);
      st[tt][rr] = pe;
      lsum += pe;
    }
  lsum += __shfl_xor(lsum, 16, 64);
  lsum += __shfl_xor(lsum, 32, 64);
  f32x4 ot[4];
#pragma unroll
  for (int dt = 0; dt < 4; ++dt) ot[dt] = (f32x4){0.f, 0.f, 0.f, 0.f};
#pragma unroll
  for (int kr = 0; kr < 8; ++kr) {
    uint4 pw;
    pw.x = (unsigned)f2bf(st[2 * kr][0]) | ((unsigned)f2bf(st[2 * kr][1]) << 16);
    pw.y = (unsigned)f2bf(st[2 * kr][2]) | ((unsigned)f2bf(st[2 * kr][3]) << 16);
    pw.z = (unsigned)f2bf(st[2 * kr + 1][0]) | ((unsigned)f2bf(st[2 * kr + 1][1]) << 16);
    pw.w = (unsigned)f2bf(st[2 * kr + 1][2]) | ((unsigned)f2bf(st[2 * kr + 1][3]) << 16);
    const bf16x8 pf = *(bf16x8*)&pw;
#pragma unroll
    for (int dt = 0; dt < 4; ++dt) {
      const bf16* vp = VT + (dt * 16 + q) * 520 + kr * 64 + bs + g4 * 4;
      uint2 lo = *(const uint2*)vp, hi = *(const uint2*)(vp + 16);
      uint4 vw; vw.x = lo.x; vw.y = lo.y; vw.z = hi.x; vw.w = hi.y;
      ot[dt] = __builtin_amdgcn_mfma_f32_16x16x32_bf16(*(bf16x8*)&vw, pf, ot[dt], 0, 0, 0);
    }
  }
  const float inv = 1.f / lsum;
#pragma unroll
  for (int dt = 0; dt < 4; ++dt) {
    const int d0 = dt * 16 + g4 * 4;
    uint2 gu = *(const uint2*)(projb + (size_t)qtok * EVEN_N + 1536 + h * 64 + d0);
    f32x4 y;
    y[0] = ot[dt][0] * inv * silu_f(__uint_as_float(gu.x << 16));
    y[1] = ot[dt][1] * inv * silu_f(__uint_as_float(gu.x & 0xffff0000u));
    y[2] = ot[dt][2] * inv * silu_f(__uint_as_float(gu.y << 16));
    y[3] = ot[dt][3] * inv * silu_f(__uint_as_float(gu.y & 0xffff0000u));
    uint2 o;
    o.x = (unsigned)f2bf(y[0]) | ((unsigned)f2bf(y[1]) << 16);
    o.y = (unsigned)f2bf(y[2]) | ((unsigned)f2bf(y[3]) << 16);
    *(uint2*)(yb + ((size_t)b * 4096 + qtok) * 1024 + h * 64 + d0) = o;
  }
}

template <int K, int MODE>
struct GateC {
  float w[16];
  float bias, lb;
  int d, ch;
  __device__ __forceinline__ void init(const P& p, int d_, int h, int k) {
    d = d_; ch = h * K + k;
    if (MODE == 0) {
#pragma unroll
      for (int r = 0; r < 16; ++r) w[r] = p.gla_w_up[(d * 16 + r) * 256 + ch];
      bias = p.gla_b[d * 256 + ch];
      lb = 0.f;
    } else {
      lb = ((const float*)(p.ws + WS_LB))[ch];
      bias = 0.f;
    }
  }
  __device__ __forceinline__ void eval_vals(bf16 a, bf16 bz, const bf16* lr, float& g, float& kval, float& qval) const {
    if (MODE == 0) {
      uint4 u0 = *(const uint4*)(lr);
      uint4 u1 = *(const uint4*)(lr + 8);
      float z = bias;
      z += w[0] * __uint_as_float(u0.x << 16) + w[1] * __uint_as_float(u0.x & 0xffff0000u);
      z += w[2] * __uint_as_float(u0.y << 16) + w[3] * __uint_as_float(u0.y & 0xffff0000u);
      z += w[4] * __uint_as_float(u0.z << 16) + w[5] * __uint_as_float(u0.z & 0xffff0000u);
      z += w[6] * __uint_as_float(u0.w << 16) + w[7] * __uint_as_float(u0.w & 0xffff0000u);
      z += w[8] * __uint_as_float(u1.x << 16) + w[9] * __uint_as_float(u1.x & 0xffff0000u);
      z += w[10] * __uint_as_float(u1.y << 16) + w[11] * __uint_as_float(u1.y & 0xffff0000u);
      z += w[12] * __uint_as_float(u1.z << 16) + w[13] * __uint_as_float(u1.z & 0xffff0000u);
      z += w[14] * __uint_as_float(u1.w << 16) + w[15] * __uint_as_float(u1.w & 0xffff0000u);
      g = log_sigmoid_f(z) * (1.f / 16.f);
      kval = bf2f(bz);
      qval = bf2f(a) * 0.125f;
    } else {
      const float z = bf2f(bz);
      const float e = __expf(-z);
      const float sg = 1.f / (1.f + e);
      kval = (1.f - lb) * e * sg;
      g = __logf(1.f - kval);
      qval = bf2f(a) * 0.08838834764831845f;
    }
  }
  __device__ __forceinline__ void eval(const bf16* row, float& g, float& kval, float& qval) const {
    if (MODE == 0) {
      uint4 u0 = *(const uint4*)(row + 3584 + d * 16);
      uint4 u1 = *(const uint4*)(row + 3584 + d * 16 + 8);
      float z = bias;
      z += w[0] * __uint_as_float(u0.x << 16) + w[1] * __uint_as_float(u0.x & 0xffff0000u);
      z += w[2] * __uint_as_float(u0.y << 16) + w[3] * __uint_as_float(u0.y & 0xffff0000u);
      z += w[4] * __uint_as_float(u0.z << 16) + w[5] * __uint_as_float(u0.z & 0xffff0000u);
      z += w[6] * __uint_as_float(u0.w << 16) + w[7] * __uint_as_float(u0.w & 0xffff0000u);
      z += w[8] * __uint_as_float(u1.x << 16) + w[9] * __uint_as_float(u1.x & 0xffff0000u);
      z += w[10] * __uint_as_float(u1.y << 16) + w[11] * __uint_as_float(u1.y & 0xffff0000u);
      z += w[12] * __uint_as_float(u1.z << 16) + w[13] * __uint_as_float(u1.z & 0xffff0000u);
      z += w[14] * __uint_as_float(u1.w << 16) + w[15] * __uint_as_float(u1.w & 0xffff0000u);
      g = log_sigmoid_f(z) * (1.f / 16.f);
      kval = bf2f(row[2304 + ch]);
      qval = bf2f(row[2048 + ch]) * 0.125f;
    } else {
      const float z = bf2f(row[512 + d * 512 + ch]);
      const float e = __expf(-z);
      const float sg = 1.f / (1.f + e);
      kval = (1.f - lb) * e * sg;
      g = __logf(1.f - kval);
      qval = bf2f(row[ch]) * 0.08838834764831845f;
    }
  }
};

template <int MODE>
__device__ __forceinline__ void stage_vt(const bf16* proj, int h, bf16* VT) {
  constexpr int LDP = MODE == 0 ? EVEN_N : ODD_N;
  constexpr int VOFF = MODE == 0 ? 2560 : 1536;
  const int j = threadIdx.x & 63, cgp = threadIdx.x >> 6;
#pragma unroll
  for (int cc = 0; cc < 4; ++cc) {
    const int c = cgp * 4 + cc;
    uint4 u = *(const uint4*)(proj + (size_t)j * LDP + VOFF + h * 128 + c * 8);
    bf16* dst = VT + (c * 8) * 72 + j;
    dst[0 * 72] = (bf16)(u.x & 0xffffu); dst[1 * 72] = (bf16)(u.x >> 16);
    dst[2 * 72] = (bf16)(u.y & 0xffffu); dst[3 * 72] = (bf16)(u.y >> 16);
    dst[4 * 72] = (bf16)(u.z & 0xffffu); dst[5 * 72] = (bf16)(u.z >> 16);
    dst[6 * 72] = (bf16)(u.w & 0xffffu); dst[7 * 72] = (bf16)(u.w >> 16);
  }
}

__device__ __forceinline__ uint2 pack4(f32x4 a) {
  uint2 o;
  o.x = (unsigned)f2bf(a[0]) | ((unsigned)f2bf(a[1]) << 16);
  o.y = (unsigned)f2bf(a[2]) | ((unsigned)f2bf(a[3]) << 16);
  return o;
}

template <int K, int MODE>
__device__ __forceinline__ void rec_pass1_item(const P& p, int item, unsigned char* smem) {
  constexpr int LDP = MODE == 0 ? EVEN_N : ODD_N;
  const int h = item & 3, blk = (item >> 2) & 63, b = item >> 8;
  bf16* KT = (bf16*)smem;
  bf16* VT = KT + 2 * K * 72;
  const bf16* proj = (const bf16*)(p.ws + WS_PROJ) + (size_t)(b * 4096 + blk * 64) * LDP;
  bf16* ST = (bf16*)(p.ws + WS_ST);
  float* DEC = (float*)(p.ws + WS_DEC);
  const int tid = threadIdx.x, lane = tid & 63, wave = tid >> 6;
  bf16* TMP = VT;
  if (MODE == 1) {
#pragma unroll
    for (int i = 0; i < 8; ++i) {
      const int c = i * 256 + tid;
      const int ch = c & 15, j = (c >> 4) & 63, d = c >> 10;
      *(uint4*)(TMP + (d * 64 + j) * 128 + ch * 8) = *(const uint4*)(proj + (size_t)j * LDP + 512 + d * 512 + h * 128 + ch * 8);
    }
  } else {
#pragma unroll
    for (int i = 0; i < 2; ++i) {
      const int c = i * 256 + tid;
      const int ch = c & 7, j = c >> 3;
      *(uint4*)(TMP + j * 64 + ch * 8) = *(const uint4*)(proj + (size_t)j * LDP + 2304 + h * 64 + ch * 8);
    }
    {
      const int ch = tid & 3, j = tid >> 2;
      *(uint4*)(TMP + 4096 + j * 32 + ch * 8) = *(const uint4*)(proj + (size_t)j * LDP + 3584 + ch * 8);
    }
  }
  __syncthreads();
  if (tid < 2 * K) {
    const int d = tid / K, k = tid % K;
    GateC<K, MODE> gc;
    gc.init(p, d, h, k);
    bf16* row = KT + (d * K + k) * 72;
    float r = 0.f;
#pragma unroll 4
    for (int i = 63; i >= 0; --i) {
      const int j = d ? 63 - i : i;
      float g, kv, qv;
      if (MODE == 1) gc.eval_vals(0, TMP[(d * 64 + j) * 128 + k], nullptr, g, kv, qv);
      else gc.eval_vals(0, TMP[j * 64 + k], TMP + 4096 + j * 32 + d * 16, g, kv, qv);
      row[j] = f2bf(kv * __expf(r));
      r += g;
    }
    DEC[(size_t)((((d * 4 + b) * 4 + h) * 64 + blk)) * K + k] = __expf(r);
  }
  __syncthreads();
  stage_vt<MODE>(proj, h, VT);
  __syncthreads();
#pragma unroll 1
  for (int d = 0; d < 2; ++d) {
    f32x4 acc[K / 16][2];
#pragma unroll
    for (int kt = 0; kt < K / 16; ++kt) { acc[kt][0] = (f32x4){0.f, 0.f, 0.f, 0.f}; acc[kt][1] = (f32x4){0.f, 0.f, 0.f, 0.f}; }
#pragma unroll
    for (int ks = 0; ks < 2; ++ks) {
      bf16x8 vf0 = *(const bf16x8*)(VT + ((wave * 2 + 0) * 16 + (lane & 15)) * 72 + ks * 32 + (lane >> 4) * 8);
      bf16x8 vf1 = *(const bf16x8*)(VT + ((wave * 2 + 1) * 16 + (lane & 15)) * 72 + ks * 32 + (lane >> 4) * 8);
#pragma unroll
      for (int kt = 0; kt < K / 16; ++kt) {
        bf16x8 kf = *(const bf16x8*)(KT + (d * K + kt * 16 + (lane & 15)) * 72 + ks * 32 + (lane >> 4) * 8);
        acc[kt][0] = __builtin_amdgcn_mfma_f32_16x16x32_bf16(kf, vf0, acc[kt][0], 0, 0, 0);
        acc[kt][1] = __builtin_amdgcn_mfma_f32_16x16x32_bf16(kf, vf1, acc[kt][1], 0, 0, 0);
      }
    }
    bf16* stb = ST + (size_t)((((d * 4 + b) * 4 + h) * 64 + blk)) * 128 * K;
#pragma unroll
    for (int kt = 0; kt < K / 16; ++kt)
#pragma unroll
      for (int vv = 0; vv < 2; ++vv) {
        const int v = (wave * 2 + vv) * 16 + (lane & 15);
        const int k0 = kt * 16 + (lane >> 4) * 4;
        *(uint2*)(stb + (size_t)v * K + k0) = pack4(acc[kt][vv]);
      }
  }
}

template <int K>
__device__ __forceinline__ void phase_rec_scan(const P& p) {
  bf16* ST = (bf16*)(p.ws + WS_ST);
  const float* DEC = (const float*)(p.ws + WS_DEC);
  constexpr int KV = K / 4;
  const int total = 32 * 128 * KV;
  for (int idx = blockIdx.x * 256 + threadIdx.x; idx < total; idx += gridDim.x * 256) {
    const int kq = idx % KV, v = (idx / KV) & 127, s = idx / (KV * 128);
    const int d = s >> 4;
    float st0 = 0.f, st1 = 0.f, st2 = 0.f, st3 = 0.f;
#pragma unroll 1
    for (int n0 = 0; n0 < 64; n0 += 8) {
      uint2 u[8];
      float4 dc[8];
#pragma unroll
      for (int q = 0; q < 8; ++q) {
        const int blk = d ? 63 - (n0 + q) : (n0 + q);
        u[q] = *(const uint2*)(ST + ((size_t)(s * 64 + blk) * 128 + v) * K + kq * 4);
        dc[q] = *(const float4*)(DEC + (size_t)(s * 64 + blk) * K + kq * 4);
      }
#pragma unroll
      for (int q = 0; q < 8; ++q) {
        const int blk = d ? 63 - (n0 + q) : (n0 + q);
        uint2 o;
        o.x = (unsigned)f2bf(st0) | ((unsigned)f2bf(st1) << 16);
        o.y = (unsigned)f2bf(st2) | ((unsigned)f2bf(st3) << 16);
        *(uint2*)(ST + ((size_t)(s * 64 + blk) * 128 + v) * K + kq * 4) = o;
        st0 = dc[q].x * st0 + __uint_as_float(u[q].x << 16);
        st1 = dc[q].y * st1 + __uint_as_float(u[q].x & 0xffff0000u);
        st2 = dc[q].z * st2 + __uint_as_float(u[q].y << 16);
        st3 = dc[q].w * st3 + __uint_as_float(u[q].y & 0xffff0000u);
      }
    }
  }
}

template <int K, int MODE>
__device__ __forceinline__ void rec_pass3_item(const P& p, int item, unsigned char* smem) {
  constexpr int LDP = MODE == 0 ? EVEN_N : ODD_N;
  constexpr int KS = K + 8;
  constexpr int GOFF = MODE == 0 ? 3072 : 2048;
  constexpr int YOFF = MODE == 0 ? 512 : 0;
  const int h = item & 3, blk = (item >> 2) & 63, b = item >> 8;
  bf16* QI = (bf16*)smem;
  bf16* KI = QI + 64 * KS;
  bf16* VT = KI + 64 * KS;
  bf16* AI = VT + 128 * 72;
  float* CV = (float*)(AI + 64 * 72);
  float* SSQ = CV + K;
  bf16* LRB = (bf16*)(SSQ + 256);
  const bf16* proj = (const bf16*)(p.ws + WS_PROJ) + (size_t)(b * 4096 + blk * 64) * LDP;
  const bf16* ST = (const bf16*)(p.ws + WS_ST);
  bf16* yb = (bf16*)(p.ws + WS_H);
  const int tid = threadIdx.x, lane = tid & 63, wave = tid >> 6;
  stage_vt<MODE>(proj, h, VT);
  f32x4 o[2][4];
#pragma unroll
  for (int vv = 0; vv < 2; ++vv)
#pragma unroll
    for (int it = 0; it < 4; ++it) o[vv][it] = (f32x4){0.f, 0.f, 0.f, 0.f};
#pragma unroll 1
  for (int d = 0; d < 2; ++d) {
    if (d) __syncthreads();
    const bf16* stb = ST + (size_t)((((d * 4 + b) * 4 + h) * 64 + blk)) * 128 * K;
    u32x4 stf[K / 32][2];
#pragma unroll
    for (int ks = 0; ks < K / 32; ++ks)
#pragma unroll
      for (int vv = 0; vv < 2; ++vv)
        stf[ks][vv] = gload16_asm(stb + (size_t)((wave * 2 + vv) * 16 + (lane & 15)) * K + ks * 32 + (lane >> 4) * 8);
    {
      constexpr int QOFF = MODE == 0 ? 2048 : 0;
      const int zoff = MODE == 0 ? 2304 : 512 + d * 512;
#pragma unroll
      for (int i = 0; i < K / 32; ++i) {
        const int c = i * 256 + tid;
        const int ch = c % (K / 8), j = c / (K / 8);
        *(uint4*)(QI + j * KS + ch * 8) = *(const uint4*)(proj + (size_t)j * LDP + QOFF + h * K + ch * 8);
        *(uint4*)(KI + j * KS + ch * 8) = *(const uint4*)(proj + (size_t)j * LDP + zoff + h * K + ch * 8);
      }
      if (MODE == 0 && tid < 128) {
        const int ch = tid & 1, j = tid >> 1;
        *(uint4*)(LRB + j * 16 + ch * 8) = *(const uint4*)(proj + (size_t)j * LDP + 3584 + d * 16 + ch * 8);
      }
    }
    __syncthreads();
    if (tid < 2 * K) {
      const int k = tid % K, half = tid / K;
      GateC<K, MODE> gc;
      gc.init(p, d, h, k);
      float run = 0.f;
      if (half) {
#pragma unroll 4
        for (int i = 32; i < 64; ++i) {
          const int j = d ? 63 - i : i;
          float g, kv, qv;
          gc.eval_vals(QI[j * KS + k], KI[j * KS + k], LRB + j * 16, g, kv, qv);
          run += g;
          QI[j * KS + k] = f2bf(qv * __expf(run));
          KI[j * KS + k] = f2bf(kv * __expf(-run));
        }
      } else {
#pragma unroll 4
        for (int i = 31; i >= 0; --i) {
          const int j = d ? 63 - i : i;
          float g, kv, qv;
          gc.eval_vals(QI[j * KS + k], KI[j * KS + k], LRB + j * 16, g, kv, qv);
          QI[j * KS + k] = f2bf(qv * __expf(-run));
          KI[j * KS + k] = f2bf(kv * __expf(run));
          run += g;
        }
        CV[k] = __expf(run);
      }
    }
    __syncthreads();
    {
      f32x4 a[4];
#pragma unroll
      for (int jt = 0; jt < 4; ++jt) a[jt] = (f32x4){0.f, 0.f, 0.f, 0.f};
#pragma unroll
      for (int ks = 0; ks < K / 32; ++ks) {
        bf16x8 qf = *(const bf16x8*)(QI + (wave * 16 + (lane & 15)) * KS + ks * 32 + (lane >> 4) * 8);
#pragma unroll
        for (int jt = 0; jt < 4; ++jt) {
          bf16x8 kf = *(const bf16x8*)(KI + (jt * 16 + (lane & 15)) * KS + ks * 32 + (lane >> 4) * 8);
          a[jt] = __builtin_amdgcn_mfma_f32_16x16x32_bf16(kf, qf, a[jt], 0, 0, 0);
        }
      }
      const int i = wave * 16 + (lane & 15);
#pragma unroll
      for (int jt = 0; jt < 4; ++jt) {
        const int j0 = jt * 16 + (lane >> 4) * 4;
        f32x4 m;
#pragma unroll
        for (int r = 0; r < 4; ++r) {
          const int j = j0 + r;
          const bool valid = d ? (j >= i) : (j <= i);
          m[r] = valid ? a[jt][r] : 0.f;
        }
        *(uint2*)(AI + i * 72 + j0) = pack4(m);
      }
    }
    __syncthreads();
#pragma unroll
    for (int ks = 0; ks < 2; ++ks) {
      bf16x8 vf0 = *(const bf16x8*)(VT + ((wave * 2 + 0) * 16 + (lane & 15)) * 72 + ks * 32 + (lane >> 4) * 8);
      bf16x8 vf1 = *(const bf16x8*)(VT + ((wave * 2 + 1) * 16 + (lane & 15)) * 72 + ks * 32 + (lane >> 4) * 8);
#pragma unroll
      for (int it = 0; it < 4; ++it) {
        bf16x8 af = *(const bf16x8*)(AI + (it * 16 + (lane & 15)) * 72 + ks * 32 + (lane >> 4) * 8);
        o[0][it] = __builtin_amdgcn_mfma_f32_16x16x32_bf16(vf0, af, o[0][it], 0, 0, 0);
        o[1][it] = __builtin_amdgcn_mfma_f32_16x16x32_bf16(vf1, af, o[1][it], 0, 0, 0);
      }
    }
    if (K == 128) {
      asm volatile("s_waitcnt vmcnt(0)"
                   : "+v"(stf[0][0]), "+v"(stf[0][1]), "+v"(stf[1][0]), "+v"(stf[1][1]), "+v"(stf[K / 32 - 2][0]), "+v"(stf[K / 32 - 2][1]), "+v"(stf[K / 32 - 1][0]), "+v"(stf[K / 32 - 1][1])
                   :: "memory");
    } else {
      asm volatile("s_waitcnt vmcnt(0)" : "+v"(stf[0][0]), "+v"(stf[0][1]), "+v"(stf[1][0]), "+v"(stf[1][1]) :: "memory");
    }
#pragma unroll
    for (int ks = 0; ks < K / 32; ++ks) {
      const int kk = ks * 32 + (lane >> 4) * 8;
      float4 c0 = *(const float4*)(CV + kk), c1 = *(const float4*)(CV + kk + 4);
      bf16x8 sf[2];
#pragma unroll
      for (int vv = 0; vv < 2; ++vv) {
        uint4 u; u.x = stf[ks][vv][0]; u.y = stf[ks][vv][1]; u.z = stf[ks][vv][2]; u.w = stf[ks][vv][3];
        uint4 w;
        w.x = (unsigned)f2bf(__uint_as_float(u.x << 16) * c0.x) | ((unsigned)f2bf(__uint_as_float(u.x & 0xffff0000u) * c0.y) << 16);
        w.y = (unsigned)f2bf(__uint_as_float(u.y << 16) * c0.z) | ((unsigned)f2bf(__uint_as_float(u.y & 0xffff0000u) * c0.w) << 16);
        w.z = (unsigned)f2bf(__uint_as_float(u.z << 16) * c1.x) | ((unsigned)f2bf(__uint_as_float(u.z & 0xffff0000u) * c1.y) << 16);
        w.w = (unsigned)f2bf(__uint_as_float(u.w << 16) * c1.z) | ((unsigned)f2bf(__uint_as_float(u.w & 0xffff0000u) * c1.w) << 16);
        sf[vv] = *(bf16x8*)&w;
      }
#pragma unroll
      for (int it = 0; it < 4; ++it) {
        bf16x8 qf = *(const bf16x8*)(QI + (it * 16 + (lane & 15)) * KS + kk);
        o[0][it] = __builtin_amdgcn_mfma_f32_16x16x32_bf16(sf[0], qf, o[0][it], 0, 0, 0);
        o[1][it] = __builtin_amdgcn_mfma_f32_16x16x32_bf16(sf[1], qf, o[1][it], 0, 0, 0);
      }
    }
  }
  {
    float ss[4];
#pragma unroll
    for (int it = 0; it < 4; ++it) {
      float s = 0.f;
#pragma unroll
      for (int vv = 0; vv < 2; ++vv)
#pragma unroll
        for (int r = 0; r < 4; ++r) s += o[vv][it][r] * o[vv][it][r];
      s += __shfl_xor(s, 16, 64);
      s += __shfl_xor(s, 32, 64);
      ss[it] = s;
    }
    if (lane < 16) {
#pragma unroll
      for (int it = 0; it < 4; ++it) SSQ[wave * 64 + it * 16 + lane] = ss[it];
    }
    __syncthreads();
    const float* gn = MODE == 0 ? p.gla_g : p.hgrn_g;
#pragma unroll
    for (int it = 0; it < 4; ++it) {
      const int i = it * 16 + (lane & 15);
      const float tot = SSQ[i] + SSQ[64 + i] + SSQ[128 + i] + SSQ[192 + i];
      const float rs = rsqrtf(tot * (1.f / 128.f) + 1e-6f);
#pragma unroll
      for (int vv = 0; vv < 2; ++vv) {
        const int v0 = (wave * 2 + vv) * 16 + (lane >> 4) * 4;
        uint2 gu = *(const uint2*)(proj + (size_t)i * LDP + GOFF + h * 128 + v0);
        float4 gg = *(const float4*)(gn + v0);
        f32x4 y;
        y[0] = o[vv][it][0] * rs * gg.x * silu_f(__uint_as_float(gu.x << 16));
        y[1] = o[vv][it][1] * rs * gg.y * silu_f(__uint_as_float(gu.x & 0xffff0000u));
        y[2] = o[vv][it][2] * rs * gg.z * silu_f(__uint_as_float(gu.y << 16));
        y[3] = o[vv][it][3] * rs * gg.w * silu_f(__uint_as_float(gu.y & 0xffff0000u));
        *(uint2*)(yb + (size_t)(b * 4096 + blk * 64 + i) * 1024 + YOFF + h * 128 + v0) = pack4(y);
      }
    }
  }
}

__device__ __forceinline__ void conv8(const P& p, const bf16* projb, int t, int c0, float* o8) {
  float4 b0 = *(const float4*)(p.conv_b + c0), b1 = *(const float4*)(p.conv_b + c0 + 4);
  float a[8] = {b0.x, b0.y, b0.z, b0.w, b1.x, b1.y, b1.z, b1.w};
#pragma unroll
  for (int jt = 0; jt < 4; ++jt) {
    const int tt = t + jt - 2;
    if (tt >= 0 && tt < 4096) {
      uint4 u = *(const uint4*)(projb + (size_t)tt * ODD_N + 3072 + c0);
      float4 w0 = *(const float4*)(p.conv_w + jt * 1024 + c0), w1 = *(const float4*)(p.conv_w + jt * 1024 + c0 + 4);
      a[0] += w0.x * __uint_as_float(u.x << 16); a[1] += w0.y * __uint_as_float(u.x & 0xffff0000u);
      a[2] += w0.z * __uint_as_float(u.y << 16); a[3] += w0.w * __uint_as_float(u.y & 0xffff0000u);
      a[4] += w1.x * __uint_as_float(u.z << 16); a[5] += w1.y * __uint_as_float(u.z & 0xffff0000u);
      a[6] += w1.z * __uint_as_float(u.w << 16); a[7] += w1.w * __uint_as_float(u.w & 0xffff0000u);
    }
  }
#pragma unroll
  for (int e = 0; e < 8; ++e) o8[e] = silu_f(a[e]);
}

__device__ __forceinline__ void ssd_prep_acum(const P& p, const bf16* projb, int blk, int g, float* ACUM, float* DTV, float* TOT) {
  const int lane = threadIdx.x & 63, wave = threadIdx.x >> 6;
#pragma unroll
  for (int q = 0; q < 2; ++q) {
    const int c = wave * 2 + q, dir = c >> 2, rp = c & 3, head = g * 4 + rp;
    const int j = dir ? 63 - lane : lane;
    const int t = blk * 64 + j;
    const float dt = softplus_f(bf2f(projb[(size_t)t * ODD_N + 4096 + dir * 8 + head]) + p.dt_bias[dir * 8 + head]);
    float v = -__expf(p.a_log[dir * 8 + head]) * dt;
#pragma unroll
    for (int off = 1; off < 64; off <<= 1) {
      float tmp = __shfl_up(v, off, 64);
      if (lane >= off) v += tmp;
    }
    ACUM[c * 64 + j] = v;
    DTV[c * 64 + j] = dt;
    if (lane == 63) TOT[c] = v;
  }
}

__device__ __forceinline__ void ssd_pass1_item(const P& p, int item, unsigned char* smem) {
  const int g = item & 1, blk = (item >> 1) & 63, b = item >> 7;
  bf16* BT = (bf16*)smem;
  bf16* XT = BT + 128 * 72;
  float* ACUM = (float*)(XT + 256 * 72);
  float* DTV = ACUM + 512;
  float* TOT = DTV + 512;
  const bf16* projb = (const bf16*)(p.ws + WS_PROJ) + (size_t)b * 4096 * ODD_N;
  bf16* ST = (bf16*)(p.ws + WS_ST);
  float* DEC = (float*)(p.ws + WS_DEC);
  const int tid = threadIdx.x, lane = tid & 63, wave = tid >> 6;
  const int t = blk * 64 + lane;
  ssd_prep_acum(p, projb, blk, g, ACUM, DTV, TOT);
#pragma unroll 1
  for (int q = 0; q < 4; ++q) {
    const int cc = wave + 4 * q;
    float v8[8];
    conv8(p, projb, t, 512 + g * 128 + cc * 8, v8);
#pragma unroll
    for (int e = 0; e < 8; ++e) BT[(cc * 8 + e) * 72 + lane] = f2bf(v8[e]);
  }
  float xs[8][8];
#pragma unroll
  for (int q = 0; q < 8; ++q) conv8(p, projb, t, g * 256 + (wave * 8 + q) * 8, xs[q]);
  __syncthreads();
  if (tid < 8) {
    const int dir = tid >> 2, head = g * 4 + (tid & 3);
    DEC[(size_t)((dir * 4 + b) * 8 + head) * 64 + blk] = __expf(TOT[tid]);
  }
#pragma unroll 1
  for (int dir = 0; dir < 2; ++dir) {
    if (dir) __syncthreads();
    const int c = dir * 4 + wave;
    const float fac = DTV[c * 64 + lane] * __expf(TOT[c] - ACUM[c * 64 + lane]);
#pragma unroll
    for (int q = 0; q < 8; ++q)
#pragma unroll
      for (int e = 0; e < 8; ++e) XT[((wave * 8 + q) * 8 + e) * 72 + lane] = f2bf(xs[q][e] * fac);
    __syncthreads();
    const int head = g * 4 + wave;
    bf16* stb = ST + (size_t)(((dir * 4 + b) * 8 + head) * 64 + blk) * 8192;
#pragma unroll 1
    for (int nh = 0; nh < 2; ++nh) {
      f32x4 acc[4][4];
#pragma unroll
      for (int nt = 0; nt < 4; ++nt)
#pragma unroll
        for (int pt = 0; pt < 4; ++pt) acc[nt][pt] = (f32x4){0.f, 0.f, 0.f, 0.f};
#pragma unroll
      for (int ks = 0; ks < 2; ++ks) {
        bf16x8 xf[4];
#pragma unroll
        for (int pt = 0; pt < 4; ++pt) xf[pt] = *(const bf16x8*)(XT + (wave * 64 + pt * 16 + (lane & 15)) * 72 + ks * 32 + (lane >> 4) * 8);
#pragma unroll
        for (int nt = 0; nt < 4; ++nt) {
          bf16x8 bfv = *(const bf16x8*)(BT + ((nh * 4 + nt) * 16 + (lane & 15)) * 72 + ks * 32 + (lane >> 4) * 8);
#pragma unroll
          for (int pt = 0; pt < 4; ++pt) acc[nt][pt] = __builtin_amdgcn_mfma_f32_16x16x32_bf16(bfv, xf[pt], acc[nt][pt], 0, 0, 0);
        }
      }
#pragma unroll
      for (int nt = 0; nt < 4; ++nt)
#pragma unroll
        for (int pt = 0; pt < 4; ++pt) {
          const int pp = pt * 16 + (lane & 15);
          const int n0 = (nh * 4 + nt) * 16 + (lane >> 4) * 4;
          *(uint2*)(stb + (size_t)pp * 128 + n0) = pack4(acc[nt][pt]);
        }
    }
  }
}

__device__ __forceinline__ void phase_ssd_scan(const P& p) {
  bf16* ST = (bf16*)(p.ws + WS_ST);
  const float* DEC = (const float*)(p.ws + WS_DEC);
  const int total = 64 * 2048;
  for (int idx = blockIdx.x * 256 + threadIdx.x; idx < total; idx += gridDim.x * 256) {
    const int e4 = idx & 2047, s = idx >> 11;
    const int d = s >> 5;
    float st0 = 0.f, st1 = 0.f, st2 = 0.f, st3 = 0.f;
#pragma unroll 1
    for (int n0 = 0; n0 < 64; n0 += 8) {
      uint2 u[8];
      float dc[8];
#pragma unroll
      for (int q = 0; q < 8; ++q) {
        const int blk = d ? 63 - (n0 + q) : (n0 + q);
        u[q] = *(const uint2*)(ST + (size_t)(s * 64 + blk) * 8192 + e4 * 4);
        dc[q] = DEC[s * 64 + blk];
      }
#pragma unroll
      for (int q = 0; q < 8; ++q) {
        const int blk = d ? 63 - (n0 + q) : (n0 + q);
        uint2 o;
        o.x = (unsigned)f2bf(st0) | ((unsigned)f2bf(st1) << 16);
        o.y = (unsigned)f2bf(st2) | ((unsigned)f2bf(st3) << 16);
        *(uint2*)(ST + (size_t)(s * 64 + blk) * 8192 + e4 * 4) = o;
        st0 = dc[q] * st0 + __uint_as_float(u[q].x << 16);
        st1 = dc[q] * st1 + __uint_as_float(u[q].x & 0xffff0000u);
        st2 = dc[q] * st2 + __uint_as_float(u[q].y << 16);
        st3 = dc[q] * st3 + __uint_as_float(u[q].y & 0xffff0000u);
      }
    }
  }
}

__device__ __forceinline__ void ssd_pass3_item(const P& p, int item, unsigned char* smem) {
  const int g = item & 1, blk = (item >> 1) & 63, b = item >> 7;
  bf16* CI = (bf16*)smem;
  bf16* BI = CI + 64 * 136;
  bf16* AI = BI;
  bf16* XT = BI + 64 * 136;
  float* ACUM = (float*)(XT + 64 * 72);
  float* DTV = ACUM + 512;
  float* TOT = DTV + 512;
  float* SSQ = TOT + 8;
  const bf16* projb = (const bf16*)(p.ws + WS_PROJ) + (size_t)b * 4096 * ODD_N;
  const bf16* ST = (const bf16*)(p.ws + WS_ST);
  bf16* yb = (bf16*)(p.ws + WS_H);
  const int tid = threadIdx.x, lane = tid & 63, wave = tid >> 6;
  const int t = blk * 64 + lane;
  ssd_prep_acum(p, projb, blk, g, ACUM, DTV, TOT);
#pragma unroll 1
  for (int q = 0; q < 8; ++q) {
    const int cc = wave * 8 + q, which = cc >> 4, ch = (cc & 15) * 8;
    float v8[8];
    conv8(p, projb, t, 512 + which * 256 + g * 128 + ch, v8);
    uint4 w;
    w.x = (unsigned)f2bf(v8[0]) | ((unsigned)f2bf(v8[1]) << 16);
    w.y = (unsigned)f2bf(v8[2]) | ((unsigned)f2bf(v8[3]) << 16);
    w.z = (unsigned)f2bf(v8[4]) | ((unsigned)f2bf(v8[5]) << 16);
    w.w = (unsigned)f2bf(v8[6]) | ((unsigned)f2bf(v8[7]) << 16);
    *(uint4*)((which ? CI : BI) + lane * 136 + ch) = w;
  }
  __syncthreads();
  f32x4 gt[4];
#pragma unroll
  for (int jt = 0; jt < 4; ++jt) gt[jt] = (f32x4){0.f, 0.f, 0.f, 0.f};
#pragma unroll
  for (int ks = 0; ks < 4; ++ks) {
    bf16x8 cf = *(const bf16x8*)(CI + (wave * 16 + (lane & 15)) * 136 + ks * 32 + (lane >> 4) * 8);
#pragma unroll
    for (int jt = 0; jt < 4; ++jt) {
      bf16x8 bfv = *(const bf16x8*)(BI + (jt * 16 + (lane & 15)) * 136 + ks * 32 + (lane >> 4) * 8);
      gt[jt] = __builtin_amdgcn_mfma_f32_16x16x32_bf16(bfv, cf, gt[jt], 0, 0, 0);
    }
  }
  __syncthreads();
  float ssq_acc[4] = {0.f, 0.f, 0.f, 0.f};
#pragma unroll 1
  for (int rp = 0; rp < 4; ++rp) {
    const int head = g * 4 + rp;
#pragma unroll 1
    for (int q = 0; q < 2; ++q) {
      const int cc = wave * 2 + q;
      float v8[8];
      conv8(p, projb, t, head * 64 + cc * 8, v8);
#pragma unroll
      for (int e = 0; e < 8; ++e) XT[(cc * 8 + e) * 72 + lane] = f2bf(v8[e]);
    }
    f32x4 o[4];
#pragma unroll
    for (int it = 0; it < 4; ++it) o[it] = (f32x4){0.f, 0.f, 0.f, 0.f};
#pragma unroll 1
    for (int dir = 0; dir < 2; ++dir) {
      const int c = dir * 4 + rp;
      const bf16* stb = ST + (size_t)(((dir * 4 + b) * 8 + head) * 64 + blk) * 8192;
      u32x4 stf[4];
#pragma unroll
      for (int ks = 0; ks < 4; ++ks) stf[ks] = gload16_asm(stb + (size_t)(wave * 16 + (lane & 15)) * 128 + ks * 32 + (lane >> 4) * 8);
      {
        const int i = wave * 16 + (lane & 15);
        const float aci = ACUM[c * 64 + i];
#pragma unroll
        for (int jt = 0; jt < 4; ++jt) {
          const int j0 = jt * 16 + (lane >> 4) * 4;
          f32x4 m;
#pragma unroll
          for (int r = 0; r < 4; ++r) {
            const int j = j0 + r;
            const bool valid = dir ? (j >= i) : (j <= i);
            const float arg = fminf(aci - ACUM[c * 64 + j], 0.f);
            m[r] = valid ? gt[jt][r] * __expf(arg) * DTV[c * 64 + j] : 0.f;
          }
          *(uint2*)(AI + i * 72 + j0) = pack4(m);
        }
      }
      __syncthreads();
#pragma unroll
      for (int ks = 0; ks < 2; ++ks) {
        bf16x8 xf = *(const bf16x8*)(XT + (wave * 16 + (lane & 15)) * 72 + ks * 32 + (lane >> 4) * 8);
#pragma unroll
        for (int it = 0; it < 4; ++it) {
          bf16x8 af = *(const bf16x8*)(AI + (it * 16 + (lane & 15)) * 72 + ks * 32 + (lane >> 4) * 8);
          o[it] = __builtin_amdgcn_mfma_f32_16x16x32_bf16(xf, af, o[it], 0, 0, 0);
        }
      }
      f32x4 tI[4];
#pragma unroll
      for (int it = 0; it < 4; ++it) tI[it] = (f32x4){0.f, 0.f, 0.f, 0.f};
      asm volatile("s_waitcnt vmcnt(0)" : "+v"(stf[0]), "+v"(stf[1]), "+v"(stf[2]), "+v"(stf[3]) :: "memory");
#pragma unroll
      for (int ks = 0; ks < 4; ++ks) {
        bf16x8 sf = *(bf16x8*)&stf[ks];
#pragma unroll
        for (int it = 0; it < 4; ++it) {
          bf16x8 cf = *(const bf16x8*)(CI + (it * 16 + (lane & 15)) * 136 + ks * 32 + (lane >> 4) * 8);
          tI[it] = __builtin_amdgcn_mfma_f32_16x16x32_bf16(sf, cf, tI[it], 0, 0, 0);
        }
      }
#pragma unroll
      for (int it = 0; it < 4; ++it) {
        const float ea = __expf(ACUM[c * 64 + it * 16 + (lane & 15)]);
#pragma unroll
        for (int r = 0; r < 4; ++r) o[it][r] += ea * tI[it][r];
      }
      __syncthreads();
    }
    {
      const float dsk = p.d_skip[head];
      const int p0 = wave * 16 + (lane >> 4) * 4;
      float4 gg = *(const float4*)(p.ssm_g + head * 64 + p0);
#pragma unroll
      for (int it = 0; it < 4; ++it) {
        const int i = it * 16 + (lane & 15);
        const size_t tok = (size_t)b * 4096 + blk * 64 + i;
        uint2 zu = *(const uint2*)(projb + (size_t)(blk * 64 + i) * ODD_N + 2560 + head * 64 + p0);
        f32x4 y;
        y[0] = (o[it][0] + dsk * bf2f(XT[(p0 + 0) * 72 + i])) * silu_f(__uint_as_float(zu.x << 16));
        y[1] = (o[it][1] + dsk * bf2f(XT[(p0 + 1) * 72 + i])) * silu_f(__uint_as_float(zu.x & 0xffff0000u));
        y[2] = (o[it][2] + dsk * bf2f(XT[(p0 + 2) * 72 + i])) * silu_f(__uint_as_float(zu.y << 16));
        y[3] = (o[it][3] + dsk * bf2f(XT[(p0 + 3) * 72 + i])) * silu_f(__uint_as_float(zu.y & 0xffff0000u));
        ssq_acc[it] += y[0] * y[0] + y[1] * y[1] + y[2] * y[2] + y[3] * y[3];
        y[0] *= gg.x; y[1] *= gg.y; y[2] *= gg.z; y[3] *= gg.w;
        *(uint2*)(yb + tok * 1024 + 512 + head * 64 + p0) = pack4(y);
      }
    }
    __syncthreads();
  }
#pragma unroll
  for (int it = 0; it < 4; ++it) {
    float s = ssq_acc[it];
    s += __shfl_xor(s, 16, 64);
    s += __shfl_xor(s, 32, 64);
    if (lane < 16) SSQ[wave * 64 + it * 16 + lane] = s;
  }
  __syncthreads();
  if (tid < 64) {
    float* ssqp = (float*)(p.ws + WS_SSQ);
    ssqp[(size_t)g * M_TOK + (size_t)b * 4096 + blk * 64 + tid] = SSQ[tid] + SSQ[64 + tid] + SSQ[128 + tid] + SSQ[192 + tid];
  }
}

__device__ __forceinline__ void phase_ssd_norm(const P& p) {
  const float* ssqp = (const float*)(p.ws + WS_SSQ);
  bf16* yb = (bf16*)(p.ws + WS_H);
  const int total = M_TOK * 64;
  for (int idx = blockIdx.x * 256 + threadIdx.x; idx < total; idx += gridDim.x * 256) {
    const int tok = idx >> 6, c8 = (idx & 63) * 8;
    const float rs = rsqrtf((ssqp[tok] + ssqp[M_TOK + tok]) * (1.f / 512.f) + 1e-6f);
    uint4* ptr = (uint4*)(yb + (size_t)tok * 1024 + 512 + c8);
    uint4 u = *ptr, w;
    w.x = (unsigned)f2bf(__uint_as_float(u.x << 16) * rs) | ((unsigned)f2bf(__uint_as_float(u.x & 0xffff0000u) * rs) << 16);
    w.y = (unsigned)f2bf(__uint_as_float(u.y << 16) * rs) | ((unsigned)f2bf(__uint_as_float(u.y & 0xffff0000u) * rs) << 16);
    w.z = (unsigned)f2bf(__uint_as_float(u.z << 16) * rs) | ((unsigned)f2bf(__uint_as_float(u.z & 0xffff0000u) * rs) << 16);
    w.w = (unsigned)f2bf(__uint_as_float(u.w << 16) * rs) | ((unsigned)f2bf(__uint_as_float(u.w & 0xffff0000u) * rs) << 16);
    *ptr = w;
  }
}


#define XB_TMO      128
#define XB_XCNT(j)  (256  + 64 * (j))
#define XB_XSUB(j)  (1280 + 64 * (j))
#define XB_XGEN(j)  (2304 + 64 * (j))
#define XB_TOP      3328
#define XB_TOPGEN   3392
#define XCD_BAR_WORDS 3456
#define XB_SPIN_CAP (1u << 18)
#define LAS __attribute__((address_space(3)))
__device__ __forceinline__ unsigned xb_ld(unsigned* p) { return __hip_atomic_load(p, __ATOMIC_RELAXED, __HIP_MEMORY_SCOPE_AGENT); }
__device__ __forceinline__ unsigned xb_add(unsigned* p, unsigned v) { return __hip_atomic_fetch_add(p, v, __ATOMIC_RELAXED, __HIP_MEMORY_SCOPE_AGENT); }
__device__ __forceinline__ unsigned xb_xcc_id() { return (unsigned)__builtin_amdgcn_s_getreg((3 << 11) | 20) & 0xFu; }
#define XB_SPIN(cond, bar) do { unsigned _sp = 0; while (cond) { __builtin_amdgcn_s_sleep(1); \
    if ((++_sp & 255u) == 0u) { if (xb_ld(&(bar)[XB_TMO])) break; if (_sp > XB_SPIN_CAP) { atomicAdd(&(bar)[XB_TMO], 1u); break; } } } } while (0)
struct XcdBarrier { unsigned* bar; unsigned x; volatile LAS unsigned* st; };
__device__ __forceinline__ XcdBarrier xcd_barrier_post(unsigned* bar, volatile LAS unsigned* st) {
  XcdBarrier b; b.bar = bar; b.x = xb_xcc_id(); b.st = st;
  if (threadIdx.x == 0) (void)xb_add(&bar[XB_XCNT(b.x)], 1u);
  return b;
}
__device__ __forceinline__ void xcd_barrier_complete(unsigned* bar, unsigned x, unsigned& nloc, unsigned& nx) {
  const unsigned G = gridDim.x * gridDim.y * gridDim.z;
  unsigned sum, cnt, mine, sp = 0u;
  for (;;) {
    sum = 0u; cnt = 0u; mine = 0u;
#pragma unroll
    for (unsigned j = 0; j < 16; ++j) { const unsigned c = xb_ld(&bar[XB_XCNT(j)]); sum += c; cnt += (c > 0u) ? 1u : 0u; mine = (j == x) ? c : mine; }
    if (sum == G) break;
    __builtin_amdgcn_s_sleep(1);
    if ((++sp & 255u) == 0u) { if (xb_ld(&bar[XB_TMO])) break; if (sp > XB_SPIN_CAP) { atomicAdd(&bar[XB_TMO], 1u); break; } }
  }
  nloc = mine > 0u ? mine : 1u; nx = cnt > 0u ? cnt : 1u;
}
__device__ __forceinline__ void xcd_barrier(const XcdBarrier& b) {
  asm volatile("s_waitcnt vmcnt(0)" ::: "memory");
  __syncthreads();
  if (threadIdx.x == 0) {
    unsigned* bar = b.bar;
    __builtin_amdgcn_s_waitcnt(0);
    unsigned nloc = b.st[0], nx = b.st[1];
    if (nloc == 0u) { xcd_barrier_complete(bar, b.x, nloc, nx); b.st[0] = nloc; b.st[1] = nx; }
    const unsigned old = xb_add(&bar[XB_XSUB(b.x)], 1u);
    const unsigned gen = old / nloc;
    if (old + 1u == (gen + 1u) * nloc) {
      __builtin_amdgcn_fence(__ATOMIC_RELEASE, "agent");
      asm volatile("s_waitcnt vmcnt(0)" ::: "memory");
      const unsigned og = xb_add(&bar[XB_TOP], 1u);
      const unsigned tg = og / nx;
      if (og + 1u == (tg + 1u) * nx) xb_add(&bar[XB_TOPGEN], 1u);
      else XB_SPIN(xb_ld(&bar[XB_TOPGEN]) == tg, bar);
      __builtin_amdgcn_fence(__ATOMIC_ACQUIRE, "agent");
      xb_add(&bar[XB_XGEN(b.x)], 1u);
      asm volatile("s_waitcnt vmcnt(0)" ::: "memory");
    } else {
      XB_SPIN(xb_ld(&bar[XB_XGEN(b.x)]) == gen, bar);
      __builtin_amdgcn_fence(__ATOMIC_ACQUIRE, "agent");
      asm volatile("s_waitcnt vmcnt(0)" ::: "memory");
    }
  }
  __syncthreads();
}

#define NPHASE 18
#ifndef REPG
#define REPG 1
#endif
#ifndef REPN
#define REPN 1
#endif
#ifndef REP3
#define REP3 1
#endif
#ifndef REPS
#define REPS 1
#endif
#ifndef REPR
#define REPR 1
#endif
__global__ void __launch_bounds__(256, 2) mega(P p, int ph_lo, int ph_hi) {
  __shared__ __align__(16) unsigned char smem[73728 + 16];
  cg::grid_group grid = cg::this_grid();
  if (ph_lo < 0) grid.sync();
  if (threadIdx.x == 0) *(uint4*)(smem + 73728) = make_uint4(0u, 0u, 0u, 0u);
  __syncthreads();
  XcdBarrier xb = xcd_barrier_post((unsigned*)(p.ws + WS_BAR), (volatile LAS unsigned*)(smem + 73728));
  const float* mod = (const float*)(p.ws + WS_MOD);
#define IN(k) (ph_lo <= (k) && (k) < ph_hi)
#define SYNC(k) if (IN(k) && (k) + 1 < ph_hi) xcd_barrier(xb);
  if (IN(0)) phase_setup(p, smem);
  SYNC(0)
  if (IN(1)) phase_h0(p);
  SYNC(1)
  if (IN(2)) for (int rep = 0; rep < REPG; ++rep)
    phase_gemm<0>((const bf16*)(p.ws + WS_H), (const bf16*)(p.ws + WS_WEI), EVEN_NP / 128, smem,
                  (bf16*)(p.ws + WS_PROJ), EVEN_N, EVEN_N, nullptr, nullptr, nullptr);
  SYNC(2)
  if (IN(3)) {
    for (int it = blockIdx.x; it < 1024 + 2048 * REPN; it += gridDim.x) {
      if (it < 1024) rec_pass1_item<64, 0>(p, it, smem); else na_item(p, (it - 1024) & 2047, smem);
      __syncthreads();
    }
  }
  SYNC(3)
  if (IN(4)) phase_rec_scan<64>(p);
  SYNC(4)
  if (IN(5)) {
    for (int it = blockIdx.x; it < 1024 * REPR; it += gridDim.x) { rec_pass3_item<64, 0>(p, it & 1023, smem); __syncthreads(); }
  }
  SYNC(5)
  if (IN(6))
    phase_gemm<1>((const bf16*)(p.ws + WS_H), (const bf16*)(p.ws + WS_WEO), 8, smem, nullptr, 0, 0, p.x, p.out,
                  mod + 2048);
  SYNC(6)
  if (IN(7)) phase_ln(p, 0, true);
  SYNC(7)
  if (IN(8)) for (int rep = 0; rep < REPG; ++rep)
    phase_gemm<0>((const bf16*)(p.ws + WS_H), (const bf16*)(p.ws + WS_WOI), ODD_NP / 128, smem,
                  (bf16*)(p.ws + WS_PROJ), ODD_N, ODD_N, nullptr, nullptr, nullptr);
  SYNC(8)
  if (IN(9)) {
    for (int it = blockIdx.x; it < 1024 * REPR; it += gridDim.x) { rec_pass1_item<128, 1>(p, it & 1023, smem); __syncthreads(); }
  }
  SYNC(9)
  if (IN(10)) phase_rec_scan<128>(p);
  SYNC(10)
  if (IN(11)) {
    for (int it = blockIdx.x; it < 1024 * REP3 * REPR; it += gridDim.x) { rec_pass3_item<128, 1>(p, it & 1023, smem); __syncthreads(); }
  }
  SYNC(11)
  if (IN(12)) {
    for (int it = blockIdx.x; it < 512 * REPS; it += gridDim.x) { ssd_pass1_item(p, it & 511, smem); __syncthreads(); }
  }
  SYNC(12)
  if (IN(13)) phase_ssd_scan(p);
  SYNC(13)
  if (IN(14)) {
    for (int it = blockIdx.x; it < 512 * REPS; it += gridDim.x) { ssd_pass3_item(p, it & 511, smem); __syncthreads(); }
  }
  SYNC(14)
  if (IN(15)) phase_ssd_norm(p);
  SYNC(15)
  if (IN(16))
    phase_gemm<1>((const bf16*)(p.ws + WS_H), (const bf16*)(p.ws + WS_WOO), 8, smem, nullptr, 0, 0, p.out, p.out,
                  mod + 4 * 3072 + 2048);
  SYNC(16)
  if (IN(17)) phase_ln(p, 1, false);
}

extern "C" void kernel_launch(void* const* d_in, const int* in_sizes, int n_in, void* d_out, int out_size, void* d_ws,
                              size_t ws_size, hipStream_t stream) {
  static int grid_blocks = 0;
  if (!grid_blocks) {
    int dev = 0, cus = 0, per_cu = 0;
    hipGetDevice(&dev);
    hipDeviceGetAttribute(&cus, hipDeviceAttributeMultiprocessorCount, dev);
    hipOccupancyMaxActiveBlocksPerMultiprocessor(&per_cu, mega, 256, 0);
    if (per_cu < 1) per_cu = 1;
    if (per_cu > 2) per_cu = 2;
    grid_blocks = cus * per_cu;
    if (n_in != 22 || ws_size < WS_END) {
      fprintf(stderr, "kernel_launch: unexpected n_in %d / ws_size %zu (need %llu)\n", n_in, ws_size, (unsigned long long)WS_END);
      grid_blocks = -1;
    }
  }
  if (grid_blocks < 0) return;
  P p{};
  const float** f = (const float**)&p;
  for (int i = 0; i < 22; ++i) f[i] = (const float*)d_in[i];
  p.out = (float*)d_out;
  p.ws = (unsigned char*)d_ws;
#if 1
  if (hipMemsetAsync((char*)d_ws + WS_BAR, 0, 16384, stream) != hipSuccess) { fprintf(stderr, "memset of barrier words failed\n"); return; }
  int lo = 0, hi = NPHASE;
  void* args[] = {&p, &lo, &hi};
  hipError_t e = hipLaunchCooperativeKernel((void*)mega, dim3(grid_blocks), dim3(256), args, 0, stream);
  if (e != hipSuccess) fprintf(stderr, "cooperative launch failed: %s (grid %d)\n", hipGetErrorString(e), grid_blocks);
#else
  for (int ph = 0; ph < NPHASE; ++ph) hipLaunchKernelGGL(mega, dim3(grid_blocks), dim3(256), 0, stream, p, ph, ph + 1);
#endif
}
```

```cpp
#include <hip/hip_runtime.h>
#include <hip/hip_cooperative_groups.h>
#include <cstdio>
namespace cg = cooperative_groups;

typedef unsigned short bf16;
using bf16x8 = __attribute__((ext_vector_type(8))) short;
using f32x4 = __attribute__((ext_vector_type(4))) float;

#define M_TOK 16384
#define DM 1024
#define SEQ 4096
#define EVEN_N 3616
#define EVEN_NP 3712
#define ODD_N 4112
#define ODD_NP 4224
#define ALPHA 1.4142135623730951f
#ifndef REPG
#define REPG 1
#endif
#ifndef REPN
#define REPN 1
#endif
#ifndef REP3
#define REP3 1
#endif
#ifndef REPS
#define REPS 1
#endif
#ifndef REP0
#define REP0 1
#endif
#ifndef REPR
#define REPR 1
#endif

#define WS_MOD 0ull
#define WS_LB (WS_MOD + 98304ull)
#define WS_WEI (WS_LB + 2048ull)
#define WS_WEO (WS_WEI + 3712ull * 2048)
#define WS_WOI (WS_WEO + 1024ull * 2048)
#define WS_WOO (WS_WOI + 4224ull * 2048)
#define WS_H (WS_WOO + 1024ull * 2048)
#define WS_PROJ (WS_H + 16384ull * 2048)
#define WS_O (WS_PROJ + 16384ull * 4112 * 2)
#define WS_ST WS_O
#define WS_DEC (WS_O + 2ull * 16384 * 512 * 4)
#define WS_SSQ (WS_DEC + 2ull * 16 * 64 * 128 * 4)
#define WS_BAR (WS_SSQ + 2ull * 16384 * 4)
#define WS_END (WS_BAR + 16384ull)

struct P {
  const float *x, *c, *ada_w, *ada_b, *ln_g, *ln_b, *e_w_in, *e_rpb, *gla_w_up, *gla_b, *gla_g, *e_w_out;
  const float *o_w_in, *hgrn_lb, *hgrn_g, *conv_w, *conv_b, *dt_bias, *a_log, *d_skip, *ssm_g, *o_w_out;
  float* out;
  unsigned char* ws;
};

__device__ __forceinline__ bf16 f2bf(float f) {
  __bf16 h = (__bf16)f;
  return *(bf16*)&h;
}
using u32x4 = __attribute__((ext_vector_type(4))) unsigned;
__device__ __forceinline__ u32x4 gload16_asm(const void* ptr) {
  u32x4 r;
  asm volatile("global_load_dwordx4 %0, %1, off" : "=v"(r) : "v"(ptr));
  return r;
}
__device__ __forceinline__ float bf2f(bf16 h) { return __uint_as_float(((unsigned)h) << 16); }
__device__ __forceinline__ float silu_f(float v) { return v / (1.f + __expf(-v)); }
__device__ __forceinline__ float sigmoid_f(float v) { return 1.f / (1.f + __expf(-v)); }
__device__ __forceinline__ float log_sigmoid_f(float z) { return fminf(z, 0.f) - __logf(1.f + __expf(-fabsf(z))); }
__device__ __forceinline__ float softplus_f(float z) { return fmaxf(z, 0.f) + log1pf(__expf(-fabsf(z))); }
__device__ __forceinline__ float wave_sum(float v) {
#pragma unroll
  for (int o = 32; o > 0; o >>= 1) v += __shfl_xor(v, o, 64);
  return v;
}

__device__ __forceinline__ void transpose_item(const float* __restrict__ src, int N, bf16* __restrict__ dst, int li, unsigned char* smem) {
  float* tile = (float*)smem;
  const int tid = threadIdx.x;
  const int kt = li & 15, ntile = li >> 4;
#pragma unroll
  for (int i = 0; i < 16; ++i) {
    int row = i * 4 + (tid >> 6), col = tid & 63;
    int n = ntile * 64 + col;
    float v = (n < N) ? src[(size_t)(kt * 64 + row) * N + n] : 0.f;
    tile[row * 65 + col] = v;
  }
  __syncthreads();
#pragma unroll
  for (int i = 0; i < 16; ++i) {
    int r = i * 4 + (tid >> 6), cc = tid & 63;
    dst[(size_t)(ntile * 64 + r) * 1024 + kt * 64 + cc] = f2bf(tile[cc * 65 + r]);
  }
}

__device__ __forceinline__ void mod_item(const P& p, int idx, unsigned char* smem) {
  float* cond = (float*)smem;
  float* red = cond + 4096;
  const int tid = threadIdx.x;
  const int l = idx / 192, nc = idx % 192;
  for (int e = tid; e < 4096; e += 256) cond[e] = silu_f(p.c[e]);
  __syncthreads();
  const int kg = tid >> 4, col = tid & 15, n = nc * 16 + col;
  float a0 = 0.f, a1 = 0.f, a2 = 0.f, a3 = 0.f;
  const float* w = p.ada_w + (size_t)l * 1024 * 3072 + n;
#pragma unroll 16
  for (int k = kg * 64; k < kg * 64 + 64; ++k) {
    float wv = w[(size_t)k * 3072];
    a0 += cond[k] * wv; a1 += cond[1024 + k] * wv; a2 += cond[2048 + k] * wv; a3 += cond[3072 + k] * wv;
  }
  red[(kg * 4 + 0) * 16 + col] = a0; red[(kg * 4 + 1) * 16 + col] = a1;
  red[(kg * 4 + 2) * 16 + col] = a2; red[(kg * 4 + 3) * 16 + col] = a3;
  __syncthreads();
  if (tid < 64) {
    const int b = tid >> 4;
    float sum = 0.f;
#pragma unroll
    for (int q = 0; q < 16; ++q) sum += red[(q * 4 + b) * 16 + col];
    float* mod = (float*)(p.ws + WS_MOD);
    mod[(size_t)(l * 4 + b) * 3072 + n] = sum + p.ada_b[l * 3072 + n];
  }
}

__device__ __forceinline__ void phase_setup(const P& p, unsigned char* smem) {
  const int M0 = 384, T0 = M0 + 16 * 58, T1 = T0 + 256, T5 = T1 + 1;
  for (int rep = 0; rep < REP0; ++rep)
  for (int it = blockIdx.x; it < T5; it += gridDim.x) {
    if (it < M0) mod_item(p, it, smem);
    else if (it < T0) transpose_item(p.e_w_in, EVEN_N, (bf16*)(p.ws + WS_WEI), it - M0, smem);
    else if (it < T1) transpose_item(p.e_w_out, 1024, (bf16*)(p.ws + WS_WEO), it - T0, smem);
    else {
      float* lbv = (float*)(p.ws + WS_LB);
      for (int j = threadIdx.x; j < 512; j += 256) {
        float a = p.hgrn_lb[j], bb = p.hgrn_lb[512 + j];
        lbv[j] = 1.f / (1.f + __expf(a - bb));
      }
    }
    __syncthreads();
  }
}

__device__ __forceinline__ void phase_h0(const P& p) {
  const float* mod = (const float*)(p.ws + WS_MOD);
  bf16* hb = (bf16*)(p.ws + WS_H);
  const size_t total = (size_t)M_TOK * 128;
  for (size_t i = (size_t)blockIdx.x * 256 + threadIdx.x; i < total; i += (size_t)gridDim.x * 256) {
    int m = (int)(i >> 7), n = (int)(i & 127) * 8, b = m >> 12;
    const float4* xp = (const float4*)(p.x + (size_t)m * 1024 + n);
    const float4* sh = (const float4*)(mod + (size_t)b * 3072 + n);
    const float4* sc = (const float4*)(mod + (size_t)b * 3072 + 1024 + n);
    float4 x0 = xp[0], x1 = xp[1], s0 = sh[0], s1 = sh[1], c0 = sc[0], c1 = sc[1];
    uint4 o;
    o.x = (unsigned)f2bf(x0.x * (1.f + c0.x) + s0.x) | ((unsigned)f2bf(x0.y * (1.f + c0.y) + s0.y) << 16);
    o.y = (unsigned)f2bf(x0.z * (1.f + c0.z) + s0.z) | ((unsigned)f2bf(x0.w * (1.f + c0.w) + s0.w) << 16);
    o.z = (unsigned)f2bf(x1.x * (1.f + c1.x) + s1.x) | ((unsigned)f2bf(x1.y * (1.f + c1.y) + s1.y) << 16);
    o.w = (unsigned)f2bf(x1.z * (1.f + c1.z) + s1.z) | ((unsigned)f2bf(x1.w * (1.f + c1.w) + s1.w) << 16);
    *(uint4*)(hb + (size_t)m * 1024 + n) = o;
  }
}

#define LSTR 64
template <int EPI>
__device__ __forceinline__ void gemm_tile(const bf16* __restrict__ A, const bf16* __restrict__ Bt, int m0, int n0,
                                          unsigned char* smem, bf16* __restrict__ C, int ldc, int nreal,
                                          const float* __restrict__ X, float* __restrict__ R, const float* __restrict__ gate,
                                          const float* __restrict__ ssqp = nullptr) {
  bf16* As = (bf16*)smem;
  bf16* Bs = As + 2 * 128 * LSTR;
  const int tid = threadIdx.x, lane = tid & 63, wave = tid >> 6;
  const int wm = wave >> 1, wn = wave & 1;
  f32x4 acc[4][4];
#pragma unroll
  for (int i = 0; i < 4; ++i)
#pragma unroll
    for (int j = 0; j < 4; ++j) acc[i][j] = (f32x4){0.f, 0.f, 0.f, 0.f};
  float rsv[4] = {1.f, 1.f, 1.f, 1.f};
  if (EPI == 2) {
#pragma unroll
    for (int j = 0; j < 4; ++j) {
      const int m = m0 + wm * 64 + j * 16 + (lane & 15);
      rsv[j] = rsqrtf((ssqp[m] + ssqp[M_TOK + m]) * (1.f / 512.f) + 1e-6f);
    }
  }
  u32x4 ra[3][4], rb[3][4];
  const int lrow = tid >> 3, lkc = tid & 7;
  const int lsw = (lkc ^ (lrow & 7)) * 8;
  const bf16* Ag = A + (size_t)(m0 + lrow) * 1024 + lkc * 8;
  const bf16* Bg = Bt + (size_t)(n0 + lrow) * 1024 + lkc * 8;
#pragma unroll
  for (int t = 0; t < 3; ++t)
#pragma unroll
    for (int i = 0; i < 4; ++i) {
      ra[t][i] = gload16_asm(Ag + (size_t)i * 32 * 1024 + t * 64);
      rb[t][i] = gload16_asm(Bg + (size_t)i * 32 * 1024 + t * 64);
    }
  asm volatile("s_waitcnt vmcnt(16)"
               : "+v"(ra[0][0]), "+v"(ra[0][1]), "+v"(ra[0][2]), "+v"(ra[0][3]), "+v"(rb[0][0]), "+v"(rb[0][1]), "+v"(rb[0][2]), "+v"(rb[0][3])
               :: "memory");
#pragma unroll
  for (int i = 0; i < 4; ++i) {
    *(u32x4*)(As + (lrow + i * 32) * LSTR + lsw) = ra[0][i];
    *(u32x4*)(Bs + (lrow + i * 32) * LSTR + lsw) = rb[0][i];
  }
  __syncthreads();
#pragma unroll
  for (int kt = 0; kt < 16; ++kt) {
    const int buf = kt & 1;
    if (kt + 1 < 16) {
      const int sn = (kt + 1) % 3;
      if (kt + 2 < 16) {
        asm volatile("s_waitcnt vmcnt(8)"
                     : "+v"(ra[sn][0]), "+v"(ra[sn][1]), "+v"(ra[sn][2]), "+v"(ra[sn][3]), "+v"(rb[sn][0]), "+v"(rb[sn][1]), "+v"(rb[sn][2]), "+v"(rb[sn][3])
                     :: "memory");
      } else {
        asm volatile("s_waitcnt vmcnt(0)"
                     : "+v"(ra[sn][0]), "+v"(ra[sn][1]), "+v"(ra[sn][2]), "+v"(ra[sn][3]), "+v"(rb[sn][0]), "+v"(rb[sn][1]), "+v"(rb[sn][2]), "+v"(rb[sn][3])
                     :: "memory");
      }
      bf16* Aw = As + (buf ^ 1) * 128 * LSTR;
      bf16* Bw = Bs + (buf ^ 1) * 128 * LSTR;
#pragma unroll
      for (int i = 0; i < 4; ++i) {
        *(u32x4*)(Aw + (lrow + i * 32) * LSTR + lsw) = ra[sn][i];
        *(u32x4*)(Bw + (lrow + i * 32) * LSTR + lsw) = rb[sn][i];
      }
    }
    if (kt + 3 < 16) {
#pragma unroll
      for (int i = 0; i < 4; ++i) {
        ra[kt % 3][i] = gload16_asm(Ag + (size_t)i * 32 * 1024 + (kt + 3) * 64);
        rb[kt % 3][i] = gload16_asm(Bg + (size_t)i * 32 * 1024 + (kt + 3) * 64);
      }
    }
    const bf16* Ab = As + buf * 128 * LSTR;
    const bf16* Bb = Bs + buf * 128 * LSTR;
    if (EPI == 2 && kt == 8) {
#pragma unroll
      for (int j = 0; j < 4; ++j) {
        const float inv = 1.f / rsv[j];
#pragma unroll
        for (int i = 0; i < 4; ++i) { acc[i][j][0] *= inv; acc[i][j][1] *= inv; acc[i][j][2] *= inv; acc[i][j][3] *= inv; }
      }
    }
#pragma unroll
    for (int s = 0; s < 2; ++s) {
      bf16x8 wf[4], xf[4];
#pragma unroll
      for (int i = 0; i < 4; ++i) {
        wf[i] = *(const bf16x8*)(Bb + (wn * 64 + i * 16 + (lane & 15)) * LSTR + (((s * 4 + (lane >> 4)) ^ (lane & 7)) * 8));
        xf[i] = *(const bf16x8*)(Ab + (wm * 64 + i * 16 + (lane & 15)) * LSTR + (((s * 4 + (lane >> 4)) ^ (lane & 7)) * 8));
      }
#pragma unroll
      for (int i = 0; i < 4; ++i)
#pragma unroll
        for (int j = 0; j < 4; ++j) acc[i][j] = __builtin_amdgcn_mfma_f32_16x16x32_bf16(wf[i], xf[j], acc[i][j], 0, 0, 0);
    }
    __syncthreads();
  }
#pragma unroll
  for (int i = 0; i < 4; ++i) {
    const int n = n0 + wn * 64 + i * 16 + (lane >> 4) * 4;
#pragma unroll
    for (int j = 0; j < 4; ++j) {
      const int m = m0 + wm * 64 + j * 16 + (lane & 15);
      f32x4 a = acc[i][j];
      if (EPI == 2) { a[0] *= rsv[j]; a[1] *= rsv[j]; a[2] *= rsv[j]; a[3] *= rsv[j]; }
      if (EPI == 0) {
        if (n < nreal) {
          uint2 o;
          o.x = (unsigned)f2bf(a[0]) | ((unsigned)f2bf(a[1]) << 16);
          o.y = (unsigned)f2bf(a[2]) | ((unsigned)f2bf(a[3]) << 16);
          *(uint2*)(C + (size_t)m * ldc + n) = o;
        }
      } else {
        const int b = m >> 12;
        float4 xv = *(const float4*)(X + (size_t)m * 1024 + n);
        float4 g = *(const float4*)(gate + (size_t)b * 3072 + n);
        float4 o;
        o.x = ALPHA * xv.x + g.x * a[0];
        o.y = ALPHA * xv.y + g.y * a[1];
        o.z = ALPHA * xv.z + g.z * a[2];
        o.w = ALPHA * xv.w + g.w * a[3];
        *(float4*)(R + (size_t)m * 1024 + n) = o;
      }
    }
  }
}

template <int EPI>
__device__ __forceinline__ void phase_gemm(const bf16* A, const bf16* Bt, int ntn, unsigned char* smem, bf16* C, int ldc, int nreal,
                           const float* X, float* R, const float* gate, const float* ssqp = nullptr) {
  const int total = (M_TOK / 128) * ntn;
  for (int t = blockIdx.x; t < total; t += gridDim.x) {
    int mt = t / ntn, nt = t % ntn;
    gemm_tile<EPI>(A, Bt, mt * 128, nt * 128, smem, C, ldc, nreal, X, R, gate, ssqp);
  }
}

__device__ __forceinline__ void phase_ln(const P& p, int l, bool write_h) {
  const float* mod = (const float*)(p.ws + WS_MOD);
  bf16* hb = (bf16*)(p.ws + WS_H);
  const int lane = threadIdx.x & 63, wave = threadIdx.x >> 6;
  const float* g = p.ln_g + l * 1024;
  const float* bb = p.ln_b + l * 1024;
  for (int row = blockIdx.x * 4 + wave; row < M_TOK; row += gridDim.x * 4) {
    float* rp = p.out + (size_t)row * 1024;
    float4 v[4];
    float s = 0.f;
#pragma unroll
    for (int q = 0; q < 4; ++q) {
      v[q] = *(const float4*)(rp + (lane + 64 * q) * 4);
      s += v[q].x + v[q].y + v[q].z + v[q].w;
    }
    const float mu = wave_sum(s) * (1.f / 1024.f);
    float s2 = 0.f;
#pragma unroll
    for (int q = 0; q < 4; ++q) {
      float a = v[q].x - mu, b2 = v[q].y - mu, c2 = v[q].z - mu, d2 = v[q].w - mu;
      s2 += a * a + b2 * b2 + c2 * c2 + d2 * d2;
    }
    const float rstd = rsqrtf(wave_sum(s2) * (1.f / 1024.f) + 1e-5f);
    const int b = row >> 12;
#pragma unroll
    for (int q = 0; q < 4; ++q) {
      const int n = (lane + 64 * q) * 4;
      float4 gg = *(const float4*)(g + n), be = *(const float4*)(bb + n);
      float4 o;
      o.x = (v[q].x - mu) * rstd * gg.x + be.x;
      o.y = (v[q].y - mu) * rstd * gg.y + be.y;
      o.z = (v[q].z - mu) * rstd * gg.z + be.z;
      o.w = (v[q].w - mu) * rstd * gg.w + be.w;
      *(float4*)(rp + n) = o;
      if (write_h) {
        const float* md = mod + (size_t)(4 + b) * 3072;
        float4 sh = *(const float4*)(md + n), sc = *(const float4*)(md + 1024 + n);
        uint2 hh;
        hh.x = (unsigned)f2bf(o.x * (1.f + sc.x) + sh.x) | ((unsigned)f2bf(o.y * (1.f + sc.y) + sh.y) << 16);
        hh.y = (unsigned)f2bf(o.z * (1.f + sc.z) + sh.z) | ((unsigned)f2bf(o.w * (1.f + sc.w) + sh.w) << 16);
        *(uint2*)(hb + (size_t)row * 1024 + n) = hh;
      }
    }
  }
}

__device__ __forceinline__ void na_item(const P& p, int item, unsigned char* smem) {
  const int h = item & 7, r = (item >> 3) & 63, b = item >> 9;
  bf16* VT = (bf16*)smem;
  float* RPB = (float*)(VT + 64 * 520);
  const bf16* projb = (const bf16*)(p.ws + WS_PROJ) + (size_t)b * 4096 * EVEN_N;
  bf16* yb = (bf16*)(p.ws + WS_H);
  const int tid = threadIdx.x, lane = tid & 63, n = tid >> 6;
  const int q = lane & 15, g4 = lane >> 4;
  int rs = r - 4; rs = rs < 0 ? 0 : (rs > 56 ? 56 : rs);
#pragma unroll 4
  for (int i = 0; i < 16; ++i) {
    const int pair = i * 256 + tid, key = pair & 511, ch = pair >> 9;
    const int tok = (rs + (key >> 6)) * 64 + (key & 63);
    uint4 u = *(const uint4*)(projb + (size_t)tok * EVEN_N + 1024 + h * 64 + ch * 8);
    bf16* dst = VT + (ch * 8) * 520 + key;
    dst[0 * 520] = (bf16)(u.x & 0xffffu); dst[1 * 520] = (bf16)(u.x >> 16);
    dst[2 * 520] = (bf16)(u.y & 0xffffu); dst[3 * 520] = (bf16)(u.y >> 16);
    dst[4 * 520] = (bf16)(u.z & 0xffffu); dst[5 * 520] = (bf16)(u.z >> 16);
    dst[6 * 520] = (bf16)(u.w & 0xffffu); dst[7 * 520] = (bf16)(u.w >> 16);
  }
  for (int i = tid; i < 465; i += 256) RPB[i] = p.e_rpb[h * 465 + i];
  const int qcol = n * 16 + q;
  const int qtok = r * 64 + qcol;
  const int bs = n == 0 ? 0 : (n == 1 ? 8 : (n == 2 ? 24 : 32));
  const bf16x8 qf0 = *(const bf16x8*)(projb + (size_t)qtok * EVEN_N + h * 64 + g4 * 8);
  const bf16x8 qf1 = *(const bf16x8*)(projb + (size_t)qtok * EVEN_N + h * 64 + 32 + g4 * 8);
  f32x4 st[16];
#pragma unroll
  for (int tt = 0; tt < 16; ++tt) {
    const int ktok = (rs + (tt >> 1)) * 64 + bs + (tt & 1) * 16 + q;
    const bf16* kp = projb + (size_t)ktok * EVEN_N + 512 + h * 64 + g4 * 8;
    bf16x8 kf0 = *(const bf16x8*)kp, kf1 = *(const bf16x8*)(kp + 32);
    f32x4 z = (f32x4){0.f, 0.f, 0.f, 0.f};
    z = __builtin_amdgcn_mfma_f32_16x16x32_bf16(kf0, qf0, z, 0, 0, 0);
    st[tt] = __builtin_amdgcn_mfma_f32_16x16x32_bf16(kf1, qf1, z, 0, 0, 0);
  }
  __syncthreads();
  int cs = qcol - 8; cs = cs < 0 ? 0 : (cs > 48 ? 48 : cs);
  float mx = -1e30f;
#pragma unroll
  for (int tt = 0; tt < 16; ++tt) {
    const float* brow = RPB + (rs + (tt >> 1) - r + 7) * 31;
#pragma unroll
    for (int rr = 0; rr < 4; ++rr) {
      const int kcol = bs + (tt & 1) * 16 + g4 * 4 + rr;
      const bool valid = (kcol >= cs) && (kcol < cs + 16);
      int dc = kcol - qcol + 15; dc = dc < 0 ? 0 : (dc > 30 ? 30 : dc);
      const float sc = valid ? st[tt][rr] * 0.125f + brow[dc] : -1e30f;
      st[tt][rr] = sc;
      mx = fmaxf(mx, sc);
    }
  }
  mx = fmaxf(mx, __shfl_xor(mx, 16, 64));
  mx = fmaxf(mx, __shfl_xor(mx, 32, 64));
  float lsum = 0.f;
#pragma unroll
  for (int tt = 0; tt < 16; ++tt)
#pragma unroll
    for (int rr = 0; rr < 4; ++rr) {
      const float pe = __expf(st[tt][rr] - mx);
      st[tt][rr] = pe;
      lsum += pe;
    }
  lsum += __shfl_xor(lsum, 16, 64);
  lsum += __shfl_xor(lsum, 32, 64);
  f32x4 ot[4];
#pragma unroll
  for (int dt = 0; dt < 4; ++dt) ot[dt] = (f32x4){0.f, 0.f, 0.f, 0.f};
#pragma unroll
  for (int kr = 0; kr < 8; ++kr) {
    uint4 pw;
    pw.x = (unsigned)f2bf(st[2 * kr][0]) | ((unsigned)f2bf(st[2 * kr][1]) << 16);
    pw.y = (unsigned)f2bf(st[2 * kr][2]) | ((unsigned)f2bf(st[2 * kr][3]) << 16);
    pw.z = (unsigned)f2bf(st[2 * kr + 1][0]) | ((unsigned)f2bf(st[2 * kr + 1][1]) << 16);
    pw.w = (unsigned)f2bf(st[2 * kr + 1][2]) | ((unsigned)f2bf(st[2 * kr + 1][3]) << 16);
    const bf16x8 pf = *(bf16x8*)&pw;
#pragma unroll
    for (int dt = 0; dt < 4; ++dt) {
      const bf16* vp = VT + (dt * 16 + q) * 520 + kr * 64 + bs + g4 * 4;
      uint2 lo = *(const uint2*)vp, hi = *(const uint2*)(vp + 16);
      uint4 vw; vw.x = lo.x; vw.y = lo.y; vw.z = hi.x; vw.w = hi.y;
      ot[dt] = __builtin_amdgcn_mfma_f32_16x16x32_bf16(*(bf16x8*)&vw, pf, ot[dt], 0, 0, 0);
    }
  }
  const float inv = 1.f / lsum;
#pragma unroll
  for (int dt = 0; dt < 4; ++dt) {
    const int d0 = dt * 16 + g4 * 4;
    uint2 gu = *(const uint2*)(projb + (size_t)qtok * EVEN_N + 1536 + h * 64 + d0);
    f32x4 y;
    y[0] = ot[dt][0] * inv * silu_f(__uint_as_float(gu.x << 16));
    y[1] = ot[dt][1] * inv * silu_f(__uint_as_float(gu.x & 0xffff0000u));
    y[2] = ot[dt][2] * inv * silu_f(__uint_as_float(gu.y << 16));
    y[3] = ot[dt][3] * inv * silu_f(__uint_as_float(gu.y & 0xffff0000u));
    uint2 o;
    o.x = (unsigned)f2bf(y[0]) | ((unsigned)f2bf(y[1]) << 16);
    o.y = (unsigned)f2bf(y[2]) | ((unsigned)f2bf(y[3]) << 16);
    *(uint2*)(yb + ((size_t)b * 4096 + qtok) * 1024 + h * 64 + d0) = o;
  }
}

template <int K, int MODE>
struct GateC {
  float w[16];
  float bias, lb;
  int d, ch;
  __device__ __forceinline__ void init(const P& p, int d_, int h, int k) {
    d = d_; ch = h * K + k;
    if (MODE == 0) {
#pragma unroll
      for (int r = 0; r < 16; ++r) w[r] = p.gla_w_up[(d * 16 + r) * 256 + ch];
      bias = p.gla_b[d * 256 + ch];
      lb = 0.f;
    } else {
      lb = ((const float*)(p.ws + WS_LB))[ch];
      bias = 0.f;
    }
  }
  __device__ __forceinline__ void eval_vals(bf16 a, bf16 bz, const bf16* lr, float& g, float& kval, float& qval) const {
    if (MODE == 0) {
      uint4 u0 = *(const uint4*)(lr);
      uint4 u1 = *(const uint4*)(lr + 8);
      float z = bias;
      z += w[0] * __uint_as_float(u0.x << 16) + w[1] * __uint_as_float(u0.x & 0xffff0000u);
      z += w[2] * __uint_as_float(u0.y << 16) + w[3] * __uint_as_float(u0.y & 0xffff0000u);
      z += w[4] * __uint_as_float(u0.z << 16) + w[5] * __uint_as_float(u0.z & 0xffff0000u);
      z += w[6] * __uint_as_float(u0.w << 16) + w[7] * __uint_as_float(u0.w & 0xffff0000u);
      z += w[8] * __uint_as_float(u1.x << 16) + w[9] * __uint_as_float(u1.x & 0xffff0000u);
      z += w[10] * __uint_as_float(u1.y << 16) + w[11] * __uint_as_float(u1.y & 0xffff0000u);
      z += w[12] * __uint_as_float(u1.z << 16) + w[13] * __uint_as_float(u1.z & 0xffff0000u);
      z += w[14] * __uint_as_float(u1.w << 16) + w[15] * __uint_as_float(u1.w & 0xffff0000u);
      g = log_sigmoid_f(z) * (1.f / 16.f);
      kval = bf2f(bz);
      qval = bf2f(a) * 0.125f;
    } else {
      const float z = bf2f(bz);
      const float e = __expf(-z);
      const float sg = 1.f / (1.f + e);
      kval = (1.f - lb) * e * sg;
      g = __logf(1.f - kval);
      qval = bf2f(a) * 0.08838834764831845f;
    }
  }
  __device__ __forceinline__ void eval(const bf16* row, float& g, float& kval, float& qval) const {
    if (MODE == 0) {
      uint4 u0 = *(const uint4*)(row + 3584 + d * 16);
      uint4 u1 = *(const uint4*)(row + 3584 + d * 16 + 8);
      float z = bias;
      z += w[0] * __uint_as_float(u0.x << 16) + w[1] * __uint_as_float(u0.x & 0xffff0000u);
      z += w[2] * __uint_as_float(u0.y << 16) + w[3] * __uint_as_float(u0.y & 0xffff0000u);
      z += w[4] * __uint_as_float(u0.z << 16) + w[5] * __uint_as_float(u0.z & 0xffff0000u);
      z += w[6] * __uint_as_float(u0.w << 16) + w[7] * __uint_as_float(u0.w & 0xffff0000u);
      z += w[8] * __uint_as_float(u1.x << 16) + w[9] * __uint_as_float(u1.x & 0xffff0000u);
      z += w[10] * __uint_as_float(u1.y << 16) + w[11] * __uint_as_float(u1.y & 0xffff0000u);
      z += w[12] * __uint_as_float(u1.z << 16) + w[13] * __uint_as_float(u1.z & 0xffff0000u);
      z += w[14] * __uint_as_float(u1.w << 16) + w[15] * __uint_as_float(u1.w & 0xffff0000u);
      g = log_sigmoid_f(z) * (1.f / 16.f);
      kval = bf2f(row[2304 + ch]);
      qval = bf2f(row[2048 + ch]) * 0.125f;
    } else {
      const float z = bf2f(row[512 + d * 512 + ch]);
      const float e = __expf(-z);
      const float sg = 1.f / (1.f + e);
      kval = (1.f - lb) * e * sg;
      g = __logf(1.f - kval);
      qval = bf2f(row[ch]) * 0.08838834764831845f;
    }
  }
};

template <int MODE>
__device__ __forceinline__ void stage_vt(const bf16* proj, int h, bf16* VT) {
  constexpr int LDP = MODE == 0 ? EVEN_N : ODD_N;
  constexpr int VOFF = MODE == 0 ? 2560 : 1536;
  const int j = threadIdx.x & 63, cgp = threadIdx.x >> 6;
#pragma unroll
  for (int cc = 0; cc < 4; ++cc) {
    const int c = cgp * 4 + cc;
    uint4 u = *(const uint4*)(proj + (size_t)j * LDP + VOFF + h * 128 + c * 8);
    bf16* dst = VT + (c * 8) * 72 + j;
    dst[0 * 72] = (bf16)(u.x & 0xffffu); dst[1 * 72] = (bf16)(u.x >> 16);
    dst[2 * 72] = (bf16)(u.y & 0xffffu); dst[3 * 72] = (bf16)(u.y >> 16);
    dst[4 * 72] = (bf16)(u.z & 0xffffu); dst[5 * 72] = (bf16)(u.z >> 16);
    dst[6 * 72] = (bf16)(u.w & 0xffffu); dst[7 * 72] = (bf16)(u.w >> 16);
  }
}

__device__ __forceinline__ uint2 pack4(f32x4 a) {
  uint2 o;
  o.x = (unsigned)f2bf(a[0]) | ((unsigned)f2bf(a[1]) << 16);
  o.y = (unsigned)f2bf(a[2]) | ((unsigned)f2bf(a[3]) << 16);
  return o;
}

template <int K, int MODE>
__device__ __forceinline__ void rec_pass1_item(const P& p, int item, unsigned char* smem) {
  constexpr int LDP = MODE == 0 ? EVEN_N : ODD_N;
  const int h = item & 3, blk = (item >> 2) & 63, b = item >> 8;
  bf16* KT = (bf16*)smem;
  bf16* VT = KT + 2 * K * 72;
  const bf16* proj = (const bf16*)(p.ws + WS_PROJ) + (size_t)(b * 4096 + blk * 64) * LDP;
  bf16* ST = (bf16*)(p.ws + WS_ST);
  float* DEC = (float*)(p.ws + WS_DEC);
  const int tid = threadIdx.x, lane = tid & 63, wave = tid >> 6;
  bf16* TMP = VT;
  if (MODE == 1) {
#pragma unroll
    for (int i = 0; i < 8; ++i) {
      const int c = i * 256 + tid;
      const int ch = c & 15, j = (c >> 4) & 63, d = c >> 10;
      *(uint4*)(TMP + (d * 64 + j) * 128 + ch * 8) = *(const uint4*)(proj + (size_t)j * LDP + 512 + d * 512 + h * 128 + ch * 8);
    }
  } else {
#pragma unroll
    for (int i = 0; i < 2; ++i) {
      const int c = i * 256 + tid;
      const int ch = c & 7, j = c >> 3;
      *(uint4*)(TMP + j * 64 + ch * 8) = *(const uint4*)(proj + (size_t)j * LDP + 2304 + h * 64 + ch * 8);
    }
    {
      const int ch = tid & 3, j = tid >> 2;
      *(uint4*)(TMP + 4096 + j * 32 + ch * 8) = *(const uint4*)(proj + (size_t)j * LDP + 3584 + ch * 8);
    }
  }
  __syncthreads();
  if (tid < 2 * K) {
    const int d = tid / K, k = tid % K;
    GateC<K, MODE> gc;
    gc.init(p, d, h, k);
    bf16* row = KT + (d * K + k) * 72;
    float r = 0.f;
#pragma unroll 4
    for (int i = 63; i >= 0; --i) {
      const int j = d ? 63 - i : i;
      float g, kv, qv;
      if (MODE == 1) gc.eval_vals(0, TMP[(d * 64 + j) * 128 + k], nullptr, g, kv, qv);
      else gc.eval_vals(0, TMP[j * 64 + k], TMP + 4096 + j * 32 + d * 16, g, kv, qv);
      row[j] = f2bf(kv * __expf(r));
      r += g;
    }
    DEC[(size_t)((((d * 4 + b) * 4 + h) * 64 + blk)) * K + k] = __expf(r);
  }
  __syncthreads();
  stage_vt<MODE>(proj, h, VT);
  __syncthreads();
#pragma unroll 1
  for (int d = 0; d < 2; ++d) {
    f32x4 acc[K / 16][2];
#pragma unroll
    for (int kt = 0; kt < K / 16; ++kt) { acc[kt][0] = (f32x4){0.f, 0.f, 0.f, 0.f}; acc[kt][1] = (f32x4){0.f, 0.f, 0.f, 0.f}; }
#pragma unroll
    for (int ks = 0; ks < 2; ++ks) {
      bf16x8 vf0 = *(const bf16x8*)(VT + ((wave * 2 + 0) * 16 + (lane & 15)) * 72 + ks * 32 + (lane >> 4) * 8);
      bf16x8 vf1 = *(const bf16x8*)(VT + ((wave * 2 + 1) * 16 + (lane & 15)) * 72 + ks * 32 + (lane >> 4) * 8);
#pragma unroll
      for (int kt = 0; kt < K / 16; ++kt) {
        bf16x8 kf = *(const bf16x8*)(KT + (d * K + kt * 16 + (lane & 15)) * 72 + ks * 32 + (lane >> 4) * 8);
        acc[kt][0] = __builtin_amdgcn_mfma_f32_16x16x32_bf16(kf, vf0, acc[kt][0], 0, 0, 0);
        acc[kt][1] = __builtin_amdgcn_mfma_f32_16x16x32_bf16(kf, vf1, acc[kt][1], 0, 0, 0);
      }
    }
    bf16* stb = ST + (size_t)((((d * 4 + b) * 4 + h) * 64 + blk)) * 128 * K;
#pragma unroll
    for (int kt = 0; kt < K / 16; ++kt)
#pragma unroll
      for (int vv = 0; vv < 2; ++vv) {
        const int v = (wave * 2 + vv) * 16 + (lane & 15);
        const int k0 = kt * 16 + (lane >> 4) * 4;
        *(uint2*)(stb + (size_t)v * K + k0) = pack4(acc[kt][vv]);
      }
  }
}

template <int K>
__device__ __forceinline__ void phase_rec_scan(const P& p) {
  bf16* ST = (bf16*)(p.ws + WS_ST);
  const float* DEC = (const float*)(p.ws + WS_DEC);
  constexpr int KV = K / 4;
  const int total = 32 * 128 * KV;
  for (int idx = blockIdx.x * 256 + threadIdx.x; idx < total; idx += gridDim.x * 256) {
    const int kq = idx % KV, v = (idx / KV) & 127, s = idx / (KV * 128);
    const int d = s >> 4;
    float st0 = 0.f, st1 = 0.f, st2 = 0.f, st3 = 0.f;
#pragma unroll 1
    for (int n0 = 0; n0 < 64; n0 += 8) {
      uint2 u[8];
      float4 dc[8];
#pragma unroll
      for (int q = 0; q < 8; ++q) {
        const int blk = d ? 63 - (n0 + q) : (n0 + q);
        u[q] = *(const uint2*)(ST + ((size_t)(s * 64 + blk) * 128 + v) * K + kq * 4);
        dc[q] = *(const float4*)(DEC + (size_t)(s * 64 + blk) * K + kq * 4);
      }
#pragma unroll
      for (int q = 0; q < 8; ++q) {
        const int blk = d ? 63 - (n0 + q) : (n0 + q);
        uint2 o;
        o.x = (unsigned)f2bf(st0) | ((unsigned)f2bf(st1) << 16);
        o.y = (unsigned)f2bf(st2) | ((unsigned)f2bf(st3) << 16);
        *(uint2*)(ST + ((size_t)(s * 64 + blk) * 128 + v) * K + kq * 4) = o;
        st0 = dc[q].x * st0 + __uint_as_float(u[q].x << 16);
        st1 = dc[q].y * st1 + __uint_as_float(u[q].x & 0xffff0000u);
        st2 = dc[q].z * st2 + __uint_as_float(u[q].y << 16);
        st3 = dc[q].w * st3 + __uint_as_float(u[q].y & 0xffff0000u);
      }
    }
  }
}

template <int K, int MODE>
__device__ __forceinline__ void rec_pass3_item(const P& p, int item, unsigned char* smem) {
  constexpr int LDP = MODE == 0 ? EVEN_N : ODD_N;
  constexpr int KS = K + 8;
  constexpr int GOFF = MODE == 0 ? 3072 : 2048;
  constexpr int YOFF = MODE == 0 ? 512 : 0;
  const int h = item & 3, blk = (item >> 2) & 63, b = item >> 8;
  bf16* QI = (bf16*)smem;
  bf16* KI = QI + 64 * KS;
  bf16* VT = KI + 64 * KS;
  bf16* AI = VT + 128 * 72;
  float* CV = (float*)(AI + 64 * 72);
  float* SSQ = CV + K;
  bf16* LRB = (bf16*)(SSQ + 256);
  const bf16* proj = (const bf16*)(p.ws + WS_PROJ) + (size_t)(b * 4096 + blk * 64) * LDP;
  const bf16* ST = (const bf16*)(p.ws + WS_ST);
  bf16* yb = (bf16*)(p.ws + WS_H);
  const int tid = threadIdx.x, lane = tid & 63, wave = tid >> 6;
  stage_vt<MODE>(proj, h, VT);
  f32x4 o[2][4];
#pragma unroll
  for (int vv = 0; vv < 2; ++vv)
#pragma unroll
    for (int it = 0; it < 4; ++it) o[vv][it] = (f32x4){0.f, 0.f, 0.f, 0.f};
#pragma unroll 1
  for (int d = 0; d < 2; ++d) {
    if (d) __syncthreads();
    const bf16* stb = ST + (size_t)((((d * 4 + b) * 4 + h) * 64 + blk)) * 128 * K;
    u32x4 stf[K / 32][2];
#pragma unroll
    for (int ks = 0; ks < K / 32; ++ks)
#pragma unroll
      for (int vv = 0; vv < 2; ++vv)
        stf[ks][vv] = gload16_asm(stb + (size_t)((wave * 2 + vv) * 16 + (lane & 15)) * K + ks * 32 + (lane >> 4) * 8);
    {
      constexpr int QOFF = MODE == 0 ? 2048 : 0;
      const int zoff = MODE == 0 ? 2304 : 512 + d * 512;
#pragma unroll
      for (int i = 0; i < K / 32; ++i) {
        const int c = i * 256 + tid;
        const int ch = c % (K / 8), j = c / (K / 8);
        *(uint4*)(QI + j * KS + ch * 8) = *(const uint4*)(proj + (size_t)j * LDP + QOFF + h * K + ch * 8);
        *(uint4*)(KI + j * KS + ch * 8) = *(const uint4*)(proj + (size_t)j * LDP + zoff + h * K + ch * 8);
      }
      if (MODE == 0 && tid < 128) {
        const int ch = tid & 1, j = tid >> 1;
        *(uint4*)(LRB + j * 16 + ch * 8) = *(const uint4*)(proj + (size_t)j * LDP + 3584 + d * 16 + ch * 8);
      }
    }
    __syncthreads();
    if (tid < 2 * K) {
      const int k = tid % K, half = tid / K;
      GateC<K, MODE> gc;
      gc.init(p, d, h, k);
      float run = 0.f;
      if (half) {
#pragma unroll 4
        for (int i = 32; i < 64; ++i) {
          const int j = d ? 63 - i : i;
          float g, kv, qv;
          gc.eval_vals(QI[j * KS + k], KI[j * KS + k], LRB + j * 16, g, kv, qv);
          run += g;
          QI[j * KS + k] = f2bf(qv * __expf(run));
          KI[j * KS + k] = f2bf(kv * __expf(-run));
        }
      } else {
#pragma unroll 4
        for (int i = 31; i >= 0; --i) {
          const int j = d ? 63 - i : i;
          float g, kv, qv;
          gc.eval_vals(QI[j * KS + k], KI[j * KS + k], LRB + j * 16, g, kv, qv);
          QI[j * KS + k] = f2bf(qv * __expf(-run));
          KI[j * KS + k] = f2bf(kv * __expf(run));
          run += g;
        }
        CV[k] = __expf(run);
      }
    }
    __syncthreads();
    {
      f32x4 a[4];
#pragma unroll
      for (int jt = 0; jt < 4; ++jt) a[jt] = (f32x4){0.f, 0.f, 0.f, 0.f};
#pragma unroll
      for (int ks = 0; ks < K / 32; ++ks) {
        bf16x8 qf = *(const bf16x8*)(QI + (wave * 16 + (lane & 15)) * KS + ks * 32 + (lane >> 4) * 8);
#pragma unroll
        for (int jt = 0; jt < 4; ++jt) {
          bf16x8 kf = *(const bf16x8*)(KI + (jt * 16 + (lane & 15)) * KS + ks * 32 + (lane >> 4) * 8);
          a[jt] = __builtin_amdgcn_mfma_f32_16x16x32_bf16(kf, qf, a[jt], 0, 0, 0);
        }
      }
      const int i = wave * 16 + (lane & 15);
#pragma unroll
      for (int jt = 0; jt < 4; ++jt) {
        const int j0 = jt * 16 + (lane >> 4) * 4;
        f32x4 m;
#pragma unroll
        for (int r = 0; r < 4; ++r) {
          const int j = j0 + r;
          const bool valid = d ? (j >= i) : (j <= i);
          m[r] = valid ? a[jt][r] : 0.f;
        }
        *(uint2*)(AI + i * 72 + j0) = pack4(m);
      }
    }
    __syncthreads();
#pragma unroll
    for (int ks = 0; ks < 2; ++ks) {
      bf16x8 vf0 = *(const bf16x8*)(VT + ((wave * 2 + 0) * 16 + (lane & 15)) * 72 + ks * 32 + (lane >> 4) * 8);
      bf16x8 vf1 = *(const bf16x8*)(VT + ((wave * 2 + 1) * 16 + (lane & 15)) * 72 + ks * 32 + (lane >> 4) * 8);
#pragma unroll
      for (int it = 0; it < 4; ++it) {
        bf16x8 af = *(const bf16x8*)(AI + (it * 16 + (lane & 15)) * 72 + ks * 32 + (lane >> 4) * 8);
        o[0][it] = __builtin_amdgcn_mfma_f32_16x16x32_bf16(vf0, af, o[0][it], 0, 0, 0);
        o[1][it] = __builtin_amdgcn_mfma_f32_16x16x32_bf16(vf1, af, o[1][it], 0, 0, 0);
      }
    }
    if (K == 128) {
      asm volatile("s_waitcnt vmcnt(0)"
                   : "+v"(stf[0][0]), "+v"(stf[0][1]), "+v"(stf[1][0]), "+v"(stf[1][1]), "+v"(stf[K / 32 - 2][0]), "+v"(stf[K / 32 - 2][1]), "+v"(stf[K / 32 - 1][0]), "+v"(stf[K / 32 - 1][1])
                   :: "memory");
    } else {
      asm volatile("s_waitcnt vmcnt(0)" : "+v"(stf[0][0]), "+v"(stf[0][1]), "+v"(stf[1][0]), "+v"(stf[1][1]) :: "memory");
    }
#pragma unroll
    for (int ks = 0; ks < K / 32; ++ks) {
      const int kk = ks * 32 + (lane >> 4) * 8;
      float4 c0 = *(const float4*)(CV + kk), c1 = *(const float4*)(CV + kk + 4);
      bf16x8 sf[2];
#pragma unroll
      for (int vv = 0; vv < 2; ++vv) {
        uint4 u; u.x = stf[ks][vv][0]; u.y = stf[ks][vv][1]; u.z = stf[ks][vv][2]; u.w = stf[ks][vv][3];
        uint4 w;
        w.x = (unsigned)f2bf(__uint_as_float(u.x << 16) * c0.x) | ((unsigned)f2bf(__uint_as_float(u.x & 0xffff0000u) * c0.y) << 16);
        w.y = (unsigned)f2bf(__uint_as_float(u.y << 16) * c0.z) | ((unsigned)f2bf(__uint_as_float(u.y & 0xffff0000u) * c0.w) << 16);
        w.z = (unsigned)f2bf(__uint_as_float(u.z << 16) * c1.x) | ((unsigned)f2bf(__uint_as_float(u.z & 0xffff0000u) * c1.y) << 16);
        w.w = (unsigned)f2bf(__uint_as_float(u.w << 16) * c1.z) | ((unsigned)f2bf(__uint_as_float(u.w & 0xffff0000u) * c1.w) << 16);
        sf[vv] = *(bf16x8*)&w;
      }
#pragma unroll
      for (int it = 0; it < 4; ++it) {
        bf16x8 qf = *(const bf16x8*)(QI + (it * 16 + (lane & 15)) * KS + kk);
        o[0][it] = __builtin_amdgcn_mfma_f32_16x16x32_bf16(sf[0], qf, o[0][it], 0, 0, 0);
        o[1][it] = __builtin_amdgcn_mfma_f32_16x16x32_bf16(sf[1], qf, o[1][it], 0, 0, 0);
      }
    }
  }
  {
    float ss[4];
#pragma unroll
    for (int it = 0; it < 4; ++it) {
      float s = 0.f;
#pragma unroll
      for (int vv = 0; vv < 2; ++vv)
#pragma unroll
        for (int r = 0; r < 4; ++r) s += o[vv][it][r] * o[vv][it][r];
      s += __shfl_xor(s, 16, 64);
      s += __shfl_xor(s, 32, 64);
      ss[it] = s;
    }
    if (lane < 16) {
#pragma unroll
      for (int it = 0; it < 4; ++it) SSQ[wave * 64 + it * 16 + lane] = ss[it];
    }
    __syncthreads();
    const float* gn = MODE == 0 ? p.gla_g : p.hgrn_g;
#pragma unroll
    for (int it = 0; it < 4; ++it) {
      const int i = it * 16 + (lane & 15);
      const float tot = SSQ[i] + SSQ[64 + i] + SSQ[128 + i] + SSQ[192 + i];
      const float rs = rsqrtf(tot * (1.f / 128.f) + 1e-6f);
#pragma unroll
      for (int vv = 0; vv < 2; ++vv) {
        const int v0 = (wave * 2 + vv) * 16 + (lane >> 4) * 4;
        uint2 gu = *(const uint2*)(proj + (size_t)i * LDP + GOFF + h * 128 + v0);
        float4 gg = *(const float4*)(gn + v0);
        f32x4 y;
        y[0] = o[vv][it][0] * rs * gg.x * silu_f(__uint_as_float(gu.x << 16));
        y[1] = o[vv][it][1] * rs * gg.y * silu_f(__uint_as_float(gu.x & 0xffff0000u));
        y[2] = o[vv][it][2] * rs * gg.z * silu_f(__uint_as_float(gu.y << 16));
        y[3] = o[vv][it][3] * rs * gg.w * silu_f(__uint_as_float(gu.y & 0xffff0000u));
        *(uint2*)(yb + (size_t)(b * 4096 + blk * 64 + i) * 1024 + YOFF + h * 128 + v0) = pack4(y);
      }
    }
  }
}

__device__ __forceinline__ void conv8(const P& p, const bf16* projb, int t, int c0, float* o8) {
  float4 b0 = *(const float4*)(p.conv_b + c0), b1 = *(const float4*)(p.conv_b + c0 + 4);
  float a[8] = {b0.x, b0.y, b0.z, b0.w, b1.x, b1.y, b1.z, b1.w};
#pragma unroll
  for (int jt = 0; jt < 4; ++jt) {
    const int tt = t + jt - 2;
    if (tt >= 0 && tt < 4096) {
      uint4 u = *(const uint4*)(projb + (size_t)tt * ODD_N + 3072 + c0);
      float4 w0 = *(const float4*)(p.conv_w + jt * 1024 + c0), w1 = *(const float4*)(p.conv_w + jt * 1024 + c0 + 4);
      a[0] += w0.x * __uint_as_float(u.x << 16); a[1] += w0.y * __uint_as_float(u.x & 0xffff0000u);
      a[2] += w0.z * __uint_as_float(u.y << 16); a[3] += w0.w * __uint_as_float(u.y & 0xffff0000u);
      a[4] += w1.x * __uint_as_float(u.z << 16); a[5] += w1.y * __uint_as_float(u.z & 0xffff0000u);
      a[6] += w1.z * __uint_as_float(u.w << 16); a[7] += w1.w * __uint_as_float(u.w & 0xffff0000u);
    }
  }
#pragma unroll
  for (int e = 0; e < 8; ++e) o8[e] = silu_f(a[e]);
}

__device__ __forceinline__ void ssd_prep_acum(const P& p, const bf16* projb, int blk, int g, float* ACUM, float* DTV, float* TOT) {
  const int lane = threadIdx.x & 63, wave = threadIdx.x >> 6;
#pragma unroll
  for (int q = 0; q < 2; ++q) {
    const int c = wave * 2 + q, dir = c >> 2, rp = c & 3, head = g * 4 + rp;
    const int j = dir ? 63 - lane : lane;
    const int t = blk * 64 + j;
    const float dt = softplus_f(bf2f(projb[(size_t)t * ODD_N + 4096 + dir * 8 + head]) + p.dt_bias[dir * 8 + head]);
    float v = -__expf(p.a_log[dir * 8 + head]) * dt;
#pragma unroll
    for (int off = 1; off < 64; off <<= 1) {
      float tmp = __shfl_up(v, off, 64);
      if (lane >= off) v += tmp;
    }
    ACUM[c * 64 + j] = v;
    DTV[c * 64 + j] = dt;
    if (lane == 63) TOT[c] = v;
  }
}

__device__ __forceinline__ void ssd_pass1_item(const P& p, int item, unsigned char* smem) {
  const int g = item & 1, blk = (item >> 1) & 63, b = item >> 7;
  bf16* BT = (bf16*)smem;
  bf16* XT = BT + 128 * 72;
  float* ACUM = (float*)(XT + 256 * 72);
  float* DTV = ACUM + 512;
  float* TOT = DTV + 512;
  const bf16* projb = (const bf16*)(p.ws + WS_PROJ) + (size_t)b * 4096 * ODD_N;
  bf16* ST = (bf16*)(p.ws + WS_ST);
  float* DEC = (float*)(p.ws + WS_DEC);
  const int tid = threadIdx.x, lane = tid & 63, wave = tid >> 6;
  const int t = blk * 64 + lane;
  ssd_prep_acum(p, projb, blk, g, ACUM, DTV, TOT);
#pragma unroll 1
  for (int q = 0; q < 4; ++q) {
    const int cc = wave + 4 * q;
    float v8[8];
    conv8(p, projb, t, 512 + g * 128 + cc * 8, v8);
#pragma unroll
    for (int e = 0; e < 8; ++e) BT[(cc * 8 + e) * 72 + lane] = f2bf(v8[e]);
  }
  float xs[8][8];
#pragma unroll
  for (int q = 0; q < 8; ++q) conv8(p, projb, t, g * 256 + (wave * 8 + q) * 8, xs[q]);
  __syncthreads();
  if (tid < 8) {
    const int dir = tid >> 2, head = g * 4 + (tid & 3);
    DEC[(size_t)((dir * 4 + b) * 8 + head) * 64 + blk] = __expf(TOT[tid]);
  }
#pragma unroll 1
  for (int dir = 0; dir < 2; ++dir) {
    if (dir) __syncthreads();
    const int c = dir * 4 + wave;
    const float fac = DTV[c * 64 + lane] * __expf(TOT[c] - ACUM[c * 64 + lane]);
#pragma unroll
    for (int q = 0; q < 8; ++q)
#pragma unroll
      for (int e = 0; e < 8; ++e) XT[((wave * 8 + q) * 8 + e) * 72 + lane] = f2bf(xs[q][e] * fac);
    __syncthreads();
    const int head = g * 4 + wave;
    bf16* stb = ST + (size_t)(((dir * 4 + b) * 8 + head) * 64 + blk) * 8192;
#pragma unroll 1
    for (int nh = 0; nh < 2; ++nh) {
      f32x4 acc[4][4];
#pragma unroll
      for (int nt = 0; nt < 4; ++nt)
#pragma unroll
        for (int pt = 0; pt < 4; ++pt) acc[nt][pt] = (f32x4){0.f, 0.f, 0.f, 0.f};
#pragma unroll
      for (int ks = 0; ks < 2; ++ks) {
        bf16x8 xf[4];
#pragma unroll
        for (int pt = 0; pt < 4; ++pt) xf[pt] = *(const bf16x8*)(XT + (wave * 64 + pt * 16 + (lane & 15)) * 72 + ks * 32 + (lane >> 4) * 8);
#pragma unroll
        for (int nt = 0; nt < 4; ++nt) {
          bf16x8 bfv = *(const bf16x8*)(BT + ((nh * 4 + nt) * 16 + (lane & 15)) * 72 + ks * 32 + (lane >> 4) * 8);
#pragma unroll
          for (int pt = 0; pt < 4; ++pt) acc[nt][pt] = __builtin_amdgcn_mfma_f32_16x16x32_bf16(bfv, xf[pt], acc[nt][pt], 0, 0, 0);
        }
      }
#pragma unroll
      for (int nt = 0; nt < 4; ++nt)
#pragma unroll
        for (int pt = 0; pt < 4; ++pt) {
          const int pp = pt * 16 + (lane & 15);
          const int n0 = (nh * 4 + nt) * 16 + (lane >> 4) * 4;
          *(uint2*)(stb + (size_t)pp * 128 + n0) = pack4(acc[nt][pt]);
        }
    }
  }
}

__device__ __forceinline__ void phase_ssd_scan(const P& p) {
  bf16* ST = (bf16*)(p.ws + WS_ST);
  const float* DEC = (const float*)(p.ws + WS_DEC);
  const int total = 64 * 2048;
  for (int idx = blockIdx.x * 256 + threadIdx.x; idx < total; idx += gridDim.x * 256) {
    const int e4 = idx & 2047, s = idx >> 11;
    const int d = s >> 5;
    float st0 = 0.f, st1 = 0.f, st2 = 0.f, st3 = 0.f;
#pragma unroll 1
    for (int n0 = 0; n0 < 64; n0 += 8) {
      uint2 u[8];
      float dc[8];
#pragma unroll
      for (int q = 0; q < 8; ++q) {
        const int blk = d ? 63 - (n0 + q) : (n0 + q);
        u[q] = *(const uint2*)(ST + (size_t)(s * 64 + blk) * 8192 + e4 * 4);
        dc[q] = DEC[s * 64 + blk];
      }
#pragma unroll
      for (int q = 0; q < 8; ++q) {
        const int blk = d ? 63 - (n0 + q) : (n0 + q);
        uint2 o;
        o.x = (unsigned)f2bf(st0) | ((unsigned)f2bf(st1) << 16);
        o.y = (unsigned)f2bf(st2) | ((unsigned)f2bf(st3) << 16);
        *(uint2*)(ST + (size_t)(s * 64 + blk) * 8192 + e4 * 4) = o;
        st0 = dc[q] * st0 + __uint_as_float(u[q].x << 16);
        st1 = dc[q] * st1 + __uint_as_float(u[q].x & 0xffff0000u);
        st2 = dc[q] * st2 + __uint_as_float(u[q].y << 16);
        st3 = dc[q] * st3 + __uint_as_float(u[q].y & 0xffff0000u);
      }
    }
  }
}

__device__ __forceinline__ void ssd_pass3_item(const P& p, int item, unsigned char* smem) {
  const int g = item & 1, blk = (item >> 1) & 63, b = item >> 7;
  bf16* CI = (bf16*)smem;
  bf16* BI = CI + 64 * 136;
  bf16* AI = BI;
  bf16* XT = BI + 64 * 136;
  float* ACUM = (float*)(XT + 64 * 72);
  float* DTV = ACUM + 512;
  float* TOT = DTV + 512;
  float* SSQ = TOT + 8;
  const bf16* projb = (const bf16*)(p.ws + WS_PROJ) + (size_t)b * 4096 * ODD_N;
  const bf16* ST = (const bf16*)(p.ws + WS_ST);
  bf16* yb = (bf16*)(p.ws + WS_H);
  const int tid = threadIdx.x, lane = tid & 63, wave = tid >> 6;
  const int t = blk * 64 + lane;
  ssd_prep_acum(p, projb, blk, g, ACUM, DTV, TOT);
#pragma unroll 1
  for (int q = 0; q < 8; ++q) {
    const int cc = wave * 8 + q, which = cc >> 4, ch = (cc & 15) * 8;
    float v8[8];
    conv8(p, projb, t, 512 + which * 256 + g * 128 + ch, v8);
    uint4 w;
    w.x = (unsigned)f2bf(v8[0]) | ((unsigned)f2bf(v8[1]) << 16);
    w.y = (unsigned)f2bf(v8[2]) | ((unsigned)f2bf(v8[3]) << 16);
    w.z = (unsigned)f2bf(v8[4]) | ((unsigned)f2bf(v8[5]) << 16);
    w.w = (unsigned)f2bf(v8[6]) | ((unsigned)f2bf(v8[7]) << 16);
    *(uint4*)((which ? CI : BI) + lane * 136 + ch) = w;
  }
  __syncthreads();
  f32x4 gt[4];
#pragma unroll
  for (int jt = 0; jt < 4; ++jt) gt[jt] = (f32x4){0.f, 0.f, 0.f, 0.f};
#pragma unroll
  for (int ks = 0; ks < 4; ++ks) {
    bf16x8 cf = *(const bf16x8*)(CI + (wave * 16 + (lane & 15)) * 136 + ks * 32 + (lane >> 4) * 8);
#pragma unroll
    for (int jt = 0; jt < 4; ++jt) {
      bf16x8 bfv = *(const bf16x8*)(BI + (jt * 16 + (lane & 15)) * 136 + ks * 32 + (lane >> 4) * 8);
      gt[jt] = __builtin_amdgcn_mfma_f32_16x16x32_bf16(bfv, cf, gt[jt], 0, 0, 0);
    }
  }
  __syncthreads();
  float ssq_acc[4] = {0.f, 0.f, 0.f, 0.f};
#pragma unroll 1
  for (int rp = 0; rp < 4; ++rp) {
    const int head = g * 4 + rp;
#pragma unroll 1
    for (int q = 0; q < 2; ++q) {
      const int cc = wave * 2 + q;
      float v8[8];
      conv8(p, projb, t, head * 64 + cc * 8, v8);
#pragma unroll
      for (int e = 0; e < 8; ++e) XT[(cc * 8 + e) * 72 + lane] = f2bf(v8[e]);
    }
    f32x4 o[4];
#pragma unroll
    for (int it = 0; it < 4; ++it) o[it] = (f32x4){0.f, 0.f, 0.f, 0.f};
#pragma unroll 1
    for (int dir = 0; dir < 2; ++dir) {
      const int c = dir * 4 + rp;
      const bf16* stb = ST + (size_t)(((dir * 4 + b) * 8 + head) * 64 + blk) * 8192;
      u32x4 stf[4];
#pragma unroll
      for (int ks = 0; ks < 4; ++ks) stf[ks] = gload16_asm(stb + (size_t)(wave * 16 + (lane & 15)) * 128 + ks * 32 + (lane >> 4) * 8);
      {
        const int i = wave * 16 + (lane & 15);
        const float aci = ACUM[c * 64 + i];
#pragma unroll
        for (int jt = 0; jt < 4; ++jt) {
          const int j0 = jt * 16 + (lane >> 4) * 4;
          f32x4 m;
#pragma unroll
          for (int r = 0; r < 4; ++r) {
            const int j = j0 + r;
            const bool valid = dir ? (j >= i) : (j <= i);
            const float arg = fminf(aci - ACUM[c * 64 + j], 0.f);
            m[r] = valid ? gt[jt][r] * __expf(arg) * DTV[c * 64 + j] : 0.f;
          }
          *(uint2*)(AI + i * 72 + j0) = pack4(m);
        }
      }
      __syncthreads();
#pragma unroll
      for (int ks = 0; ks < 2; ++ks) {
        bf16x8 xf = *(const bf16x8*)(XT + (wave * 16 + (lane & 15)) * 72 + ks * 32 + (lane >> 4) * 8);
#pragma unroll
        for (int it = 0; it < 4; ++it) {
          bf16x8 af = *(const bf16x8*)(AI + (it * 16 + (lane & 15)) * 72 + ks * 32 + (lane >> 4) * 8);
          o[it] = __builtin_amdgcn_mfma_f32_16x16x32_bf16(xf, af, o[it], 0, 0, 0);
        }
      }
      f32x4 tI[4];
#pragma unroll
      for (int it = 0; it < 4; ++it) tI[it] = (f32x4){0.f, 0.f, 0.f, 0.f};
      asm volatile("s_waitcnt vmcnt(0)" : "+v"(stf[0]), "+v"(stf[1]), "+v"(stf[2]), "+v"(stf[3]) :: "memory");
#pragma unroll
      for (int ks = 0; ks < 4; ++ks) {
        bf16x8 sf = *(bf16x8*)&stf[ks];
#pragma unroll
        for (int it = 0; it < 4; ++it) {
          bf16x8 cf = *(const bf16x8*)(CI + (it * 16 + (lane & 15)) * 136 + ks * 32 + (lane >> 4) * 8);
          tI[it] = __builtin_amdgcn_mfma_f32_16x16x32_bf16(sf, cf, tI[it], 0, 0, 0);
        }
      }
#pragma unroll
      for (int it = 0; it < 4; ++it) {
        const float ea = __expf(ACUM[c * 64 + it * 16 + (lane & 15)]);
#pragma unroll
        for (int r = 0; r < 4; ++r) o[it][r] += ea * tI[it][r];
      }
      __syncthreads();
    }
    {
      const float dsk = p.d_skip[head];
      const int p0 = wave * 16 + (lane >> 4) * 4;
      float4 gg = *(const float4*)(p.ssm_g + head * 64 + p0);
#pragma unroll
      for (int it = 0; it < 4; ++it) {
        const int i = it * 16 + (lane & 15);
        const size_t tok = (size_t)b * 4096 + blk * 64 + i;
        uint2 zu = *(const uint2*)(projb + (size_t)(blk * 64 + i) * ODD_N + 2560 + head * 64 + p0);
        f32x4 y;
        y[0] = (o[it][0] + dsk * bf2f(XT[(p0 + 0) * 72 + i])) * silu_f(__uint_as_float(zu.x << 16));
        y[1] = (o[it][1] + dsk * bf2f(XT[(p0 + 1) * 72 + i])) * silu_f(__uint_as_float(zu.x & 0xffff0000u));
        y[2] = (o[it][2] + dsk * bf2f(XT[(p0 + 2) * 72 + i])) * silu_f(__uint_as_float(zu.y << 16));
        y[3] = (o[it][3] + dsk * bf2f(XT[(p0 + 3) * 72 + i])) * silu_f(__uint_as_float(zu.y & 0xffff0000u));
        ssq_acc[it] += y[0] * y[0] + y[1] * y[1] + y[2] * y[2] + y[3] * y[3];
        y[0] *= gg.x; y[1] *= gg.y; y[2] *= gg.z; y[3] *= gg.w;
        *(uint2*)(yb + tok * 1024 + 512 + head * 64 + p0) = pack4(y);
      }
    }
    __syncthreads();
  }
#pragma unroll
  for (int it = 0; it < 4; ++it) {
    float s = ssq_acc[it];
    s += __shfl_xor(s, 16, 64);
    s += __shfl_xor(s, 32, 64);
    if (lane < 16) SSQ[wave * 64 + it * 16 + lane] = s;
  }
  __syncthreads();
  if (tid < 64) {
    float* ssqp = (float*)(p.ws + WS_SSQ);
    ssqp[(size_t)g * M_TOK + (size_t)b * 4096 + blk * 64 + tid] = SSQ[tid] + SSQ[64 + tid] + SSQ[128 + tid] + SSQ[192 + tid];
  }
}

__device__ __forceinline__ void phase_ssd_norm(const P& p) {
  const float* ssqp = (const float*)(p.ws + WS_SSQ);
  bf16* yb = (bf16*)(p.ws + WS_H);
  const int total = M_TOK * 64;
  for (int idx = blockIdx.x * 256 + threadIdx.x; idx < total; idx += gridDim.x * 256) {
    const int tok = idx >> 6, c8 = (idx & 63) * 8;
    const float rs = rsqrtf((ssqp[tok] + ssqp[M_TOK + tok]) * (1.f / 512.f) + 1e-6f);
    uint4* ptr = (uint4*)(yb + (size_t)tok * 1024 + 512 + c8);
    uint4 u = *ptr, w;
    w.x = (unsigned)f2bf(__uint_as_float(u.x << 16) * rs) | ((unsigned)f2bf(__uint_as_float(u.x & 0xffff0000u) * rs) << 16);
    w.y = (unsigned)f2bf(__uint_as_float(u.y << 16) * rs) | ((unsigned)f2bf(__uint_as_float(u.y & 0xffff0000u) * rs) << 16);
    w.z = (unsigned)f2bf(__uint_as_float(u.z << 16) * rs) | ((unsigned)f2bf(__uint_as_float(u.z & 0xffff0000u) * rs) << 16);
    w.w = (unsigned)f2bf(__uint_as_float(u.w << 16) * rs) | ((unsigned)f2bf(__uint_as_float(u.w & 0xffff0000u) * rs) << 16);
    *ptr = w;
  }
}


#define XB_TMO      128
#define XB_XCNT(j)  (256  + 64 * (j))
#define XB_XSUB(j)  (1280 + 64 * (j))
#define XB_XGEN(j)  (2304 + 64 * (j))
#define XB_TOP      3328
#define XB_TOPGEN   3392
#define XCD_BAR_WORDS 3456
#define XB_SPIN_CAP (1u << 18)
#define LAS __attribute__((address_space(3)))
__device__ __forceinline__ unsigned xb_ld(unsigned* p) { return __hip_atomic_load(p, __ATOMIC_RELAXED, __HIP_MEMORY_SCOPE_AGENT); }
__device__ __forceinline__ unsigned xb_add(unsigned* p, unsigned v) { return __hip_atomic_fetch_add(p, v, __ATOMIC_RELAXED, __HIP_MEMORY_SCOPE_AGENT); }
__device__ __forceinline__ unsigned xb_xcc_id() { return (unsigned)__builtin_amdgcn_s_getreg((3 << 11) | 20) & 0xFu; }
#define XB_SPIN(cond, bar) do { unsigned _sp = 0; while (cond) { __builtin_amdgcn_s_sleep(1); \
    if ((++_sp & 255u) == 0u) { if (xb_ld(&(bar)[XB_TMO])) break; if (_sp > XB_SPIN_CAP) { atomicAdd(&(bar)[XB_TMO], 1u); break; } } } } while (0)
struct XcdBarrier { unsigned* bar; unsigned x; volatile LAS unsigned* st; };
__device__ __forceinline__ XcdBarrier xcd_barrier_post(unsigned* bar, volatile LAS unsigned* st) {
  XcdBarrier b; b.bar = bar; b.x = xb_xcc_id(); b.st = st;
  if (threadIdx.x == 0) (void)xb_add(&bar[XB_XCNT(b.x)], 1u);
  return b;
}
__device__ __forceinline__ void xcd_barrier_complete(unsigned* bar, unsigned x, unsigned& nloc, unsigned& nx) {
  const unsigned G = gridDim.x * gridDim.y * gridDim.z;
  unsigned sum, cnt, mine, sp = 0u;
  for (;;) {
    sum = 0u; cnt = 0u; mine = 0u;
#pragma unroll
    for (unsigned j = 0; j < 16; ++j) { const unsigned c = xb_ld(&bar[XB_XCNT(j)]); sum += c; cnt += (c > 0u) ? 1u : 0u; mine = (j == x) ? c : mine; }
    if (sum == G) break;
    __builtin_amdgcn_s_sleep(1);
    if ((++sp & 255u) == 0u) { if (xb_ld(&bar[XB_TMO])) break; if (sp > XB_SPIN_CAP) { atomicAdd(&bar[XB_TMO], 1u); break; } }
  }
  nloc = mine > 0u ? mine : 1u; nx = cnt > 0u ? cnt : 1u;
}
__device__ __forceinline__ void xcd_barrier(const XcdBarrier& b) {
  asm volatile("s_waitcnt vmcnt(0)" ::: "memory");
  __syncthreads();
  if (threadIdx.x == 0) {
    unsigned* bar = b.bar;
    __builtin_amdgcn_s_waitcnt(0);
    unsigned nloc = b.st[0], nx = b.st[1];
    if (nloc == 0u) { xcd_barrier_complete(bar, b.x, nloc, nx); b.st[0] = nloc; b.st[1] = nx; }
    const unsigned old = xb_add(&bar[XB_XSUB(b.x)], 1u);
    const unsigned gen = old / nloc;
    if (old + 1u == (gen + 1u) * nloc) {
      __builtin_amdgcn_fence(__ATOMIC_RELEASE, "agent");
      asm volatile("s_waitcnt vmcnt(0)" ::: "memory");
      const unsigned og = xb_add(&bar[XB_TOP], 1u);
      const unsigned tg = og / nx;
      if (og + 1u == (tg + 1u) * nx) xb_add(&bar[XB_TOPGEN], 1u);
      else XB_SPIN(xb_ld(&bar[XB_TOPGEN]) == tg, bar);
      __builtin_amdgcn_fence(__ATOMIC_ACQUIRE, "agent");
      xb_add(&bar[XB_XGEN(b.x)], 1u);
      asm volatile("s_waitcnt vmcnt(0)" ::: "memory");
    } else {
      XB_SPIN(xb_ld(&bar[XB_XGEN(b.x)]) == gen, bar);
      __builtin_amdgcn_fence(__ATOMIC_ACQUIRE, "agent");
      asm volatile("s_waitcnt vmcnt(0)" ::: "memory");
    }
  }
  __syncthreads();
}

#define NPHASE 17
__global__ void __launch_bounds__(256, 2) mega(P p, int ph_lo, int ph_hi) {
  __shared__ __align__(16) unsigned char smem[73728 + 16];
  cg::grid_group grid = cg::this_grid();
  if (ph_lo < 0) grid.sync();
  if (threadIdx.x == 0) *(uint4*)(smem + 73728) = make_uint4(0u, 0u, 0u, 0u);
  __syncthreads();
  XcdBarrier xb = xcd_barrier_post((unsigned*)(p.ws + WS_BAR), (volatile LAS unsigned*)(smem + 73728));
  const float* mod = (const float*)(p.ws + WS_MOD);
#define IN(k) (ph_lo <= (k) && (k) < ph_hi)
#define SYNC(k) if (IN(k) && (k) + 1 < ph_hi) xcd_barrier(xb);
  if (IN(0)) phase_setup(p, smem);
  SYNC(0)
  if (IN(1)) phase_h0(p);
  SYNC(1)
  if (IN(2)) for (int rep = 0; rep < REPG; ++rep)
    phase_gemm<0>((const bf16*)(p.ws + WS_H), (const bf16*)(p.ws + WS_WEI), EVEN_NP / 128, smem,
                  (bf16*)(p.ws + WS_PROJ), EVEN_N, EVEN_N, nullptr, nullptr, nullptr);
  SYNC(2)
  if (IN(3)) {
    for (int it = blockIdx.x; it < 1024; it += gridDim.x) { rec_pass1_item<64, 0>(p, it, smem); __syncthreads(); }
  }
  SYNC(3)
  if (IN(4)) {
    phase_rec_scan<64>(p);
    for (int it = blockIdx.x; it < 2048 * REPN + 16 * 66 + 256; it += gridDim.x) {
      if (it < 2048 * REPN) na_item(p, it & 2047, smem);
      else if (it < 2048 * REPN + 16 * 66) transpose_item(p.o_w_in, ODD_N, (bf16*)(p.ws + WS_WOI), it - 2048 * REPN, smem);
      else transpose_item(p.o_w_out, 1024, (bf16*)(p.ws + WS_WOO), it - 2048 * REPN - 16 * 66, smem);
      __syncthreads();
    }
  }
  SYNC(4)
  if (IN(5)) {
    for (int it = blockIdx.x; it < 1024 * REPR; it += gridDim.x) { rec_pass3_item<64, 0>(p, it & 1023, smem); __syncthreads(); }
  }
  SYNC(5)
  if (IN(6))
    phase_gemm<1>((const bf16*)(p.ws + WS_H), (const bf16*)(p.ws + WS_WEO), 8, smem, nullptr, 0, 0, p.x, p.out,
                  mod + 2048);
  SYNC(6)
  if (IN(7)) phase_ln(p, 0, true);
  SYNC(7)
  if (IN(8)) for (int rep = 0; rep < REPG; ++rep)
    phase_gemm<0>((const bf16*)(p.ws + WS_H), (const bf16*)(p.ws + WS_WOI), ODD_NP / 128, smem,
                  (bf16*)(p.ws + WS_PROJ), ODD_N, ODD_N, nullptr, nullptr, nullptr);
  SYNC(8)
  if (IN(9)) {
    for (int it = blockIdx.x; it < 1024 * REPR; it += gridDim.x) { rec_pass1_item<128, 1>(p, it & 1023, smem); __syncthreads(); }
  }
  SYNC(9)
  if (IN(10)) phase_rec_scan<128>(p);
  SYNC(10)
  if (IN(11)) {
    for (int it = blockIdx.x; it < 1024 * REP3 * REPR; it += gridDim.x) { rec_pass3_item<128, 1>(p, it & 1023, smem); __syncthreads(); }
  }
  SYNC(11)
  if (IN(12)) {
    for (int it = blockIdx.x; it < 512 * REPS; it += gridDim.x) { ssd_pass1_item(p, it & 511, smem); __syncthreads(); }
  }
  SYNC(12)
  if (IN(13)) phase_ssd_scan(p);
  SYNC(13)
  if (IN(14)) {
    for (int it = blockIdx.x; it < 512 * REPS; it += gridDim.x) { ssd_pass3_item(p, it & 511, smem); __syncthreads(); }
  }
  SYNC(14)
  if (IN(15))
    phase_gemm<2>((const bf16*)(p.ws + WS_H), (const bf16*)(p.ws + WS_WOO), 8, smem, nullptr, 0, 0, p.out, p.out,
                  mod + 4 * 3072 + 2048, (const float*)(p.ws + WS_SSQ));
  SYNC(15)
  if (IN(16)) phase_ln(p, 1, false);
}

extern "C" void kernel_launch(void* const* d_in, const int* in_sizes, int n_in, void* d_out, int out_size, void* d_ws,
                              size_t ws_size, hipStream_t stream) {
  static int grid_blocks = 0;
  if (!grid_blocks) {
    int dev = 0, cus = 0, per_cu = 0;
    hipGetDevice(&dev);
    hipDeviceGetAttribute(&cus, hipDeviceAttributeMultiprocessorCount, dev);
    hipOccupancyMaxActiveBlocksPerMultiprocessor(&per_cu, mega, 256, 0);
    if (per_cu < 1) per_cu = 1;
    if (per_cu > 2) per_cu = 2;
    grid_blocks = cus * per_cu;
    if (n_in != 22 || ws_size < WS_END) {
      fprintf(stderr, "kernel_launch: unexpected n_in %d / ws_size %zu (need %llu)\n", n_in, ws_size, (unsigned long long)WS_END);
      grid_blocks = -1;
    }
  }
  if (grid_blocks < 0) return;
  P p{};
  const float** f = (const float**)&p;
  for (int i = 0; i < 22; ++i) f[i] = (const float*)d_in[i];
  p.out = (float*)d_out;
  p.ws = (unsigned char*)d_ws;
#if 1
  if (hipMemsetAsync((char*)d_ws + WS_BAR, 0, 16384, stream) != hipSuccess) { fprintf(stderr, "memset of barrier words failed\n"); return; }
  int lo = 0, hi = NPHASE;
  void* args[] = {&p, &lo, &hi};
  hipError_t e = hipLaunchCooperativeKernel((void*)mega, dim3(grid_blocks), dim3(256), args, 0, stream);
  if (e != hipSuccess) fprintf(stderr, "cooperative launch failed: %s (grid %d)\n", hipGetErrorString(e), grid_blocks);
#else
  for (int ph = 0; ph < NPHASE; ++ph) hipLaunchKernelGGL(mega, dim3(grid_blocks), dim3(256), 0, stream, p, ph, ph + 1);
#endif
}
```

```cpp
#include <hip/hip_runtime.h>
#include <hip/hip_cooperative_groups.h>
#include <cstdio>
namespace cg = cooperative_groups;

typedef unsigned short bf16;
using bf16x8 = __attribute__((ext_vector_type(8))) short;
using f32x4 = __attribute__((ext_vector_type(4))) float;

#define M_TOK 16384
#define DM 1024
#define SEQ 4096
#define EVEN_N 3616
#define EVEN_NP 3712
#define ODD_N 4112
#define ODD_NP 4224
#define ALPHA 1.4142135623730951f
#ifndef REPG
#define REPG 1
#endif
#ifndef REPN
#define REPN 1
#endif
#ifndef REP3
#define REP3 1
#endif
#ifndef REPS
#define REPS 1
#endif
#ifndef REP0
#define REP0 1
#endif
#ifndef REPR
#define REPR 1
#endif

#define WS_MOD 0ull
#define WS_LB (WS_MOD + 98304ull)
#define WS_WEI (WS_LB + 2048ull)
#define WS_WEO (WS_WEI + 3712ull * 2048)
#define WS_WOI (WS_WEO + 1024ull * 2048)
#define WS_WOO (WS_WOI + 4224ull * 2048)
#define WS_H (WS_WOO + 1024ull * 2048)
#define WS_PROJ (WS_H + 16384ull * 2048)
#define WS_O (WS_PROJ + 16384ull * 4112 * 2)
#define WS_ST WS_O
#define WS_DEC (WS_O + 2ull * 16384 * 512 * 4)
#define WS_SSQ (WS_DEC + 2ull * 16 * 64 * 128 * 4)
#define WS_BAR (WS_SSQ + 2ull * 16384 * 4)
#define WS_CMID (WS_BAR + 16384ull)
#define WS_END (WS_CMID + 2ull * 16 * 64 * 128 * 4)

struct P {
  const float *x, *c, *ada_w, *ada_b, *ln_g, *ln_b, *e_w_in, *e_rpb, *gla_w_up, *gla_b, *gla_g, *e_w_out;
  const float *o_w_in, *hgrn_lb, *hgrn_g, *conv_w, *conv_b, *dt_bias, *a_log, *d_skip, *ssm_g, *o_w_out;
  float* out;
  unsigned char* ws;
};

__device__ __forceinline__ bf16 f2bf(float f) {
  __bf16 h = (__bf16)f;
  return *(bf16*)&h;
}
using u32x4 = __attribute__((ext_vector_type(4))) unsigned;
__device__ __forceinline__ u32x4 gload16_asm(const void* ptr) {
  u32x4 r;
  asm volatile("global_load_dwordx4 %0, %1, off" : "=v"(r) : "v"(ptr));
  return r;
}
__device__ __forceinline__ float bf2f(bf16 h) { return __uint_as_float(((unsigned)h) << 16); }
__device__ __forceinline__ float silu_f(float v) { return v / (1.f + __expf(-v)); }
__device__ __forceinline__ float sigmoid_f(float v) { return 1.f / (1.f + __expf(-v)); }
__device__ __forceinline__ float log_sigmoid_f(float z) { return fminf(z, 0.f) - __logf(1.f + __expf(-fabsf(z))); }
__device__ __forceinline__ float softplus_f(float z) { return fmaxf(z, 0.f) + log1pf(__expf(-fabsf(z))); }
__device__ __forceinline__ float wave_sum(float v) {
#pragma unroll
  for (int o = 32; o > 0; o >>= 1) v += __shfl_xor(v, o, 64);
  return v;
}

__device__ __forceinline__ void transpose_item(const float* __restrict__ src, int N, bf16* __restrict__ dst, int li, unsigned char* smem) {
  float* tile = (float*)smem;
  const int tid = threadIdx.x;
  const int kt = li & 15, ntile = li >> 4;
#pragma unroll
  for (int i = 0; i < 16; ++i) {
    int row = i * 4 + (tid >> 6), col = tid & 63;
    int n = ntile * 64 + col;
    float v = (n < N) ? src[(size_t)(kt * 64 + row) * N + n] : 0.f;
    tile[row * 65 + col] = v;
  }
  __syncthreads();
#pragma unroll
  for (int i = 0; i < 16; ++i) {
    int r = i * 4 + (tid >> 6), cc = tid & 63;
    dst[(size_t)(ntile * 64 + r) * 1024 + kt * 64 + cc] = f2bf(tile[cc * 65 + r]);
  }
}

__device__ __forceinline__ void mod_item(const P& p, int idx, unsigned char* smem) {
  float* cond = (float*)smem;
  float* red = cond + 4096;
  const int tid = threadIdx.x;
  const int l = idx / 192, nc = idx % 192;
  for (int e = tid; e < 4096; e += 256) cond[e] = silu_f(p.c[e]);
  __syncthreads();
  const int kg = tid >> 4, col = tid & 15, n = nc * 16 + col;
  float a0 = 0.f, a1 = 0.f, a2 = 0.f, a3 = 0.f;
  const float* w = p.ada_w + (size_t)l * 1024 * 3072 + n;
#pragma unroll 16
  for (int k = kg * 64; k < kg * 64 + 64; ++k) {
    float wv = w[(size_t)k * 3072];
    a0 += cond[k] * wv; a1 += cond[1024 + k] * wv; a2 += cond[2048 + k] * wv; a3 += cond[3072 + k] * wv;
  }
  red[(kg * 4 + 0) * 16 + col] = a0; red[(kg * 4 + 1) * 16 + col] = a1;
  red[(kg * 4 + 2) * 16 + col] = a2; red[(kg * 4 + 3) * 16 + col] = a3;
  __syncthreads();
  if (tid < 64) {
    const int b = tid >> 4;
    float sum = 0.f;
#pragma unroll
    for (int q = 0; q < 16; ++q) sum += red[(q * 4 + b) * 16 + col];
    float* mod = (float*)(p.ws + WS_MOD);
    mod[(size_t)(l * 4 + b) * 3072 + n] = sum + p.ada_b[l * 3072 + n];
  }
}

__device__ __forceinline__ void phase_setup(const P& p, unsigned char* smem) {
  const int M0 = 384, T0 = M0 + 16 * 58, T1 = T0 + 256, T5 = T1 + 1;
  for (int rep = 0; rep < REP0; ++rep)
  for (int it = blockIdx.x; it < T5; it += gridDim.x) {
    if (it < M0) mod_item(p, it, smem);
    else if (it < T0) transpose_item(p.e_w_in, EVEN_N, (bf16*)(p.ws + WS_WEI), it - M0, smem);
    else if (it < T1) transpose_item(p.e_w_out, 1024, (bf16*)(p.ws + WS_WEO), it - T0, smem);
    else {
      float* lbv = (float*)(p.ws + WS_LB);
      for (int j = threadIdx.x; j < 512; j += 256) {
        float a = p.hgrn_lb[j], bb = p.hgrn_lb[512 + j];
        lbv[j] = 1.f / (1.f + __expf(a - bb));
      }
    }
    __syncthreads();
  }
}

__device__ __forceinline__ void phase_h0(const P& p) {
  const float* mod = (const float*)(p.ws + WS_MOD);
  bf16* hb = (bf16*)(p.ws + WS_H);
  const size_t total = (size_t)M_TOK * 128;
  for (size_t i = (size_t)blockIdx.x * 256 + threadIdx.x; i < total; i += (size_t)gridDim.x * 256) {
    int m = (int)(i >> 7), n = (int)(i & 127) * 8, b = m >> 12;
    const float4* xp = (const float4*)(p.x + (size_t)m * 1024 + n);
    const float4* sh = (const float4*)(mod + (size_t)b * 3072 + n);
    const float4* sc = (const float4*)(mod + (size_t)b * 3072 + 1024 + n);
    float4 x0 = xp[0], x1 = xp[1], s0 = sh[0], s1 = sh[1], c0 = sc[0], c1 = sc[1];
    uint4 o;
    o.x = (unsigned)f2bf(x0.x * (1.f + c0.x) + s0.x) | ((unsigned)f2bf(x0.y * (1.f + c0.y) + s0.y) << 16);
    o.y = (unsigned)f2bf(x0.z * (1.f + c0.z) + s0.z) | ((unsigned)f2bf(x0.w * (1.f + c0.w) + s0.w) << 16);
    o.z = (unsigned)f2bf(x1.x * (1.f + c1.x) + s1.x) | ((unsigned)f2bf(x1.y * (1.f + c1.y) + s1.y) << 16);
    o.w = (unsigned)f2bf(x1.z * (1.f + c1.z) + s1.z) | ((unsigned)f2bf(x1.w * (1.f + c1.w) + s1.w) << 16);
    *(uint4*)(hb + (size_t)m * 1024 + n) = o;
  }
}

#define LSTR 64
template <int EPI>
__device__ __forceinline__ void gemm_tile(const bf16* __restrict__ A, const bf16* __restrict__ Bt, int m0, int n0,
                                          unsigned char* smem, bf16* __restrict__ C, int ldc, int nreal,
                                          const float* __restrict__ X, float* __restrict__ R, const float* __restrict__ gate,
                                          const float* __restrict__ ssqp = nullptr) {
  bf16* As = (bf16*)smem;
  bf16* Bs = As + 2 * 128 * LSTR;
  const int tid = threadIdx.x, lane = tid & 63, wave = tid >> 6;
  const int wm = wave >> 1, wn = wave & 1;
  f32x4 acc[4][4];
#pragma unroll
  for (int i = 0; i < 4; ++i)
#pragma unroll
    for (int j = 0; j < 4; ++j) acc[i][j] = (f32x4){0.f, 0.f, 0.f, 0.f};
  float rsv[4] = {1.f, 1.f, 1.f, 1.f};
  if (EPI == 2) {
#pragma unroll
    for (int j = 0; j < 4; ++j) {
      const int m = m0 + wm * 64 + j * 16 + (lane & 15);
      rsv[j] = rsqrtf((ssqp[m] + ssqp[M_TOK + m]) * (1.f / 512.f) + 1e-6f);
    }
  }
  u32x4 ra[3][4], rb[3][4];
  const int lrow = tid >> 3, lkc = tid & 7;
  const int lsw = (lkc ^ (lrow & 7)) * 8;
  const bf16* Ag = A + (size_t)(m0 + lrow) * 1024 + lkc * 8;
  const bf16* Bg = Bt + (size_t)(n0 + lrow) * 1024 + lkc * 8;
#pragma unroll
  for (int t = 0; t < 3; ++t)
#pragma unroll
    for (int i = 0; i < 4; ++i) {
      ra[t][i] = gload16_asm(Ag + (size_t)i * 32 * 1024 + t * 64);
      rb[t][i] = gload16_asm(Bg + (size_t)i * 32 * 1024 + t * 64);
    }
  asm volatile("s_waitcnt vmcnt(16)"
               : "+v"(ra[0][0]), "+v"(ra[0][1]), "+v"(ra[0][2]), "+v"(ra[0][3]), "+v"(rb[0][0]), "+v"(rb[0][1]), "+v"(rb[0][2]), "+v"(rb[0][3])
               :: "memory");
#pragma unroll
  for (int i = 0; i < 4; ++i) {
    *(u32x4*)(As + (lrow + i * 32) * LSTR + lsw) = ra[0][i];
    *(u32x4*)(Bs + (lrow + i * 32) * LSTR + lsw) = rb[0][i];
  }
  __syncthreads();
#pragma unroll
  for (int kt = 0; kt < 16; ++kt) {
    const int buf = kt & 1;
    if (kt + 1 < 16) {
      const int sn = (kt + 1) % 3;
      if (kt + 2 < 16) {
        asm volatile("s_waitcnt vmcnt(8)"
                     : "+v"(ra[sn][0]), "+v"(ra[sn][1]), "+v"(ra[sn][2]), "+v"(ra[sn][3]), "+v"(rb[sn][0]), "+v"(rb[sn][1]), "+v"(rb[sn][2]), "+v"(rb[sn][3])
                     :: "memory");
      } else {
        asm volatile("s_waitcnt vmcnt(0)"
                     : "+v"(ra[sn][0]), "+v"(ra[sn][1]), "+v"(ra[sn][2]), "+v"(ra[sn][3]), "+v"(rb[sn][0]), "+v"(rb[sn][1]), "+v"(rb[sn][2]), "+v"(rb[sn][3])
                     :: "memory");
      }
      bf16* Aw = As + (buf ^ 1) * 128 * LSTR;
      bf16* Bw = Bs + (buf ^ 1) * 128 * LSTR;
#pragma unroll
      for (int i = 0; i < 4; ++i) {
        *(u32x4*)(Aw + (lrow + i * 32) * LSTR + lsw) = ra[sn][i];
        *(u32x4*)(Bw + (lrow + i * 32) * LSTR + lsw) = rb[sn][i];
      }
    }
    if (kt + 3 < 16) {
#pragma unroll
      for (int i = 0; i < 4; ++i) {
        ra[kt % 3][i] = gload16_asm(Ag + (size_t)i * 32 * 1024 + (kt + 3) * 64);
        rb[kt % 3][i] = gload16_asm(Bg + (size_t)i * 32 * 1024 + (kt + 3) * 64);
      }
    }
    const bf16* Ab = As + buf * 128 * LSTR;
    const bf16* Bb = Bs + buf * 128 * LSTR;
    if (EPI == 2 && kt == 8) {
#pragma unroll
      for (int j = 0; j < 4; ++j) {
        const float inv = 1.f / rsv[j];
#pragma unroll
        for (int i = 0; i < 4; ++i) { acc[i][j][0] *= inv; acc[i][j][1] *= inv; acc[i][j][2] *= inv; acc[i][j][3] *= inv; }
      }
    }
#pragma unroll
    for (int s = 0; s < 2; ++s) {
      bf16x8 wf[4], xf[4];
#pragma unroll
      for (int i = 0; i < 4; ++i) {
        wf[i] = *(const bf16x8*)(Bb + (wn * 64 + i * 16 + (lane & 15)) * LSTR + (((s * 4 + (lane >> 4)) ^ (lane & 7)) * 8));
        xf[i] = *(const bf16x8*)(Ab + (wm * 64 + i * 16 + (lane & 15)) * LSTR + (((s * 4 + (lane >> 4)) ^ (lane & 7)) * 8));
      }
#pragma unroll
      for (int i = 0; i < 4; ++i)
#pragma unroll
        for (int j = 0; j < 4; ++j) acc[i][j] = __builtin_amdgcn_mfma_f32_16x16x32_bf16(wf[i], xf[j], acc[i][j], 0, 0, 0);
    }
    __syncthreads();
  }
#pragma unroll
  for (int i = 0; i < 4; ++i) {
    const int n = n0 + wn * 64 + i * 16 + (lane >> 4) * 4;
#pragma unroll
    for (int j = 0; j < 4; ++j) {
      const int m = m0 + wm * 64 + j * 16 + (lane & 15);
      f32x4 a = acc[i][j];
      if (EPI == 2) { a[0] *= rsv[j]; a[1] *= rsv[j]; a[2] *= rsv[j]; a[3] *= rsv[j]; }
      if (EPI == 0) {
        if (n < nreal) {
          uint2 o;
          o.x = (unsigned)f2bf(a[0]) | ((unsigned)f2bf(a[1]) << 16);
          o.y = (unsigned)f2bf(a[2]) | ((unsigned)f2bf(a[3]) << 16);
          *(uint2*)(C + (size_t)m * ldc + n) = o;
        }
      } else {
        const int b = m >> 12;
        float4 xv = *(const float4*)(X + (size_t)m * 1024 + n);
        float4 g = *(const float4*)(gate + (size_t)b * 3072 + n);
        float4 o;
        o.x = ALPHA * xv.x + g.x * a[0];
        o.y = ALPHA * xv.y + g.y * a[1];
        o.z = ALPHA * xv.z + g.z * a[2];
        o.w = ALPHA * xv.w + g.w * a[3];
        *(float4*)(R + (size_t)m * 1024 + n) = o;
      }
    }
  }
}

template <int EPI>
__device__ __forceinline__ void phase_gemm(const bf16* A, const bf16* Bt, int ntn, unsigned char* smem, bf16* C, int ldc, int nreal,
                           const float* X, float* R, const float* gate, unsigned* bar, int gidx, const float* ssqp = nullptr) {
  volatile unsigned* stw = (volatile unsigned*)(smem + 73728);
  const unsigned xid = (unsigned)__builtin_amdgcn_s_getreg((3 << 11) | 20) & 0xFu;
  int xidx = 0, nx = 0;
#pragma unroll
  for (int j = 0; j < 16; ++j) {
    const unsigned c = __hip_atomic_load(&bar[256 + 64 * j], __ATOMIC_RELAXED, __HIP_MEMORY_SCOPE_AGENT);
    if (c > 0u) { nx++; if ((unsigned)j < xid) xidx++; }
  }
  const int mt_lo = (xidx * 128) / nx, mt_hi = ((xidx + 1) * 128) / nx;
  const int total = (mt_hi - mt_lo) * ntn;
  unsigned* qc = bar + 3456 + (gidx * 16 + xidx) * 8;
  for (;;) {
    __syncthreads();
    if (threadIdx.x == 0) stw[2] = __hip_atomic_fetch_add(qc, 1u, __ATOMIC_RELAXED, __HIP_MEMORY_SCOPE_AGENT);
    __syncthreads();
    const int t = (int)stw[2];
    if (t >= total) break;
    const int g8 = t / (8 * ntn), r = t - g8 * 8 * ntn;
    int mt, nt;
    const int rows = mt_hi - mt_lo - g8 * 8;
    const int gm = rows < 8 ? rows : 8;
    nt = r / gm; mt = mt_lo + g8 * 8 + (r - nt * gm);
    gemm_tile<EPI>(A, Bt, mt * 128, nt * 128, smem, C, ldc, nreal, X, R, gate, ssqp);
  }
}

__device__ __forceinline__ void phase_ln(const P& p, int l, bool write_h) {
  const float* mod = (const float*)(p.ws + WS_MOD);
  bf16* hb = (bf16*)(p.ws + WS_H);
  const int lane = threadIdx.x & 63, wave = threadIdx.x >> 6;
  const float* g = p.ln_g + l * 1024;
  const float* bb = p.ln_b + l * 1024;
  for (int row = blockIdx.x * 4 + wave; row < M_TOK; row += gridDim.x * 4) {
    float* rp = p.out + (size_t)row * 1024;
    float4 v[4];
    float s = 0.f;
#pragma unroll
    for (int q = 0; q < 4; ++q) {
      v[q] = *(const float4*)(rp + (lane + 64 * q) * 4);
      s += v[q].x + v[q].y + v[q].z + v[q].w;
    }
    const float mu = wave_sum(s) * (1.f / 1024.f);
    float s2 = 0.f;
#pragma unroll
    for (int q = 0; q < 4; ++q) {
      float a = v[q].x - mu, b2 = v[q].y - mu, c2 = v[q].z - mu, d2 = v[q].w - mu;
      s2 += a * a + b2 * b2 + c2 * c2 + d2 * d2;
    }
    const float rstd = rsqrtf(wave_sum(s2) * (1.f / 1024.f) + 1e-5f);
    const int b = row >> 12;
#pragma unroll
    for (int q = 0; q < 4; ++q) {
      const int n = (lane + 64 * q) * 4;
      float4 gg = *(const float4*)(g + n), be = *(const float4*)(bb + n);
      float4 o;
      o.x = (v[q].x - mu) * rstd * gg.x + be.x;
      o.y = (v[q].y - mu) * rstd * gg.y + be.y;
      o.z = (v[q].z - mu) * rstd * gg.z + be.z;
      o.w = (v[q].w - mu) * rstd * gg.w + be.w;
      *(float4*)(rp + n) = o;
      if (write_h) {
        const float* md = mod + (size_t)(4 + b) * 3072;
        float4 sh = *(const float4*)(md + n), sc = *(const float4*)(md + 1024 + n);
        uint2 hh;
        hh.x = (unsigned)f2bf(o.x * (1.f + sc.x) + sh.x) | ((unsigned)f2bf(o.y * (1.f + sc.y) + sh.y) << 16);
        hh.y = (unsigned)f2bf(o.z * (1.f + sc.z) + sh.z) | ((unsigned)f2bf(o.w * (1.f + sc.w) + sh.w) << 16);
        *(uint2*)(hb + (size_t)row * 1024 + n) = hh;
      }
    }
  }
}

__device__ __forceinline__ void na_item(const P& p, int item, unsigned char* smem) {
  const int h = item & 7, r = (item >> 3) & 63, b = item >> 9;
  bf16* VT = (bf16*)smem;
  float* RPB = (float*)(VT + 64 * 520);
  const bf16* projb = (const bf16*)(p.ws + WS_PROJ) + (size_t)b * 4096 * EVEN_N;
  bf16* yb = (bf16*)(p.ws + WS_H);
  const int tid = threadIdx.x, lane = tid & 63, n = tid >> 6;
  const int q = lane & 15, g4 = lane >> 4;
  int rs = r - 4; rs = rs < 0 ? 0 : (rs > 56 ? 56 : rs);
#pragma unroll 4
  for (int i = 0; i < 16; ++i) {
    const int pair = i * 256 + tid, key = pair & 511, ch = pair >> 9;
    const int tok = (rs + (key >> 6)) * 64 + (key & 63);
    uint4 u = *(const uint4*)(projb + (size_t)tok * EVEN_N + 1024 + h * 64 + ch * 8);
    bf16* dst = VT + (ch * 8) * 520 + key;
    dst[0 * 520] = (bf16)(u.x & 0xffffu); dst[1 * 520] = (bf16)(u.x >> 16);
    dst[2 * 520] = (bf16)(u.y & 0xffffu); dst[3 * 520] = (bf16)(u.y >> 16);
    dst[4 * 520] = (bf16)(u.z & 0xffffu); dst[5 * 520] = (bf16)(u.z >> 16);
    dst[6 * 520] = (bf16)(u.w & 0xffffu); dst[7 * 520] = (bf16)(u.w >> 16);
  }
  for (int i = tid; i < 465; i += 256) RPB[i] = p.e_rpb[h * 465 + i];
  const int qcol = n * 16 + q;
  const int qtok = r * 64 + qcol;
  const int bs = n == 0 ? 0 : (n == 1 ? 8 : (n == 2 ? 24 : 32));
  const bf16x8 qf0 = *(const bf16x8*)(projb + (size_t)qtok * EVEN_N + h * 64 + g4 * 8);
  const bf16x8 qf1 = *(const bf16x8*)(projb + (size_t)qtok * EVEN_N + h * 64 + 32 + g4 * 8);
  f32x4 st[16];
#pragma unroll
  for (int tt = 0; tt < 16; ++tt) {
    const int ktok = (rs + (tt >> 1)) * 64 + bs + (tt & 1) * 16 + q;
    const bf16* kp = projb + (size_t)ktok * EVEN_N + 512 + h * 64 + g4 * 8;
    bf16x8 kf0 = *(const bf16x8*)kp, kf1 = *(const bf16x8*)(kp + 32);
    f32x4 z = (f32x4){0.f, 0.f, 0.f, 0.f};
    z = __builtin_amdgcn_mfma_f32_16x16x32_bf16(kf0, qf0, z, 0, 0, 0);
    st[tt] = __builtin_amdgcn_mfma_f32_16x16x32_bf16(kf1, qf1, z, 0, 0, 0);
  }
  __syncthreads();
  int cs = qcol - 8; cs = cs < 0 ? 0 : (cs > 48 ? 48 : cs);
  float mx = -1e30f;
#pragma unroll
  for (int tt = 0; tt < 16; ++tt) {
    const float* brow = RPB + (rs + (tt >> 1) - r + 7) * 31;
#pragma unroll
    for (int rr = 0; rr < 4; ++rr) {
      const int kcol = bs + (tt & 1) * 16 + g4 * 4 + rr;
      const bool valid = (kcol >= cs) && (kcol < cs + 16);
      int dc = kcol - qcol + 15; dc = dc < 0 ? 0 : (dc > 30 ? 30 : dc);
      const float sc = valid ? st[tt][rr] * 0.125f + brow[dc] : -1e30f;
      st[tt][rr] = sc;
      mx = fmaxf(mx, sc);
    }
  }
  mx = fmaxf(mx, __shfl_xor(mx, 16, 64));
  mx = fmaxf(mx, __shfl_xor(mx, 32, 64));
  float lsum = 0.f;
#pragma unroll
  for (int tt = 0; tt < 16; ++tt)
#pragma unroll
    for (int rr = 0; rr < 4; ++rr) {
      const float pe = __expf(st[tt][rr] - mx);
      st[tt][rr] = pe;
      lsum += pe;
    }
  lsum += __shfl_xor(lsum, 16, 64);
  lsum += __shfl_xor(lsum, 32, 64);
  f32x4 ot[4];
#pragma unroll
  for (int dt = 0; dt < 4; ++dt) ot[dt] = (f32x4){0.f, 0.f, 0.f, 0.f};
#pragma unroll
  for (int kr = 0; kr < 8; ++kr) {
    uint4 pw;
    pw.x = (unsigned)f2bf(st[2 * kr][0]) | ((unsigned)f2bf(st[2 * kr][1]) << 16);
    pw.y = (unsigned)f2bf(st[2 * kr][2]) | ((unsigned)f2bf(st[2 * kr][3]) << 16);
    pw.z = (unsigned)f2bf(st[2 * kr + 1][0]) | ((unsigned)f2bf(st[2 * kr + 1][1]) << 16);
    pw.w = (unsigned)f2bf(st[2 * kr + 1][2]) | ((unsigned)f2bf(st[2 * kr + 1][3]) << 16);
    const bf16x8 pf = *(bf16x8*)&pw;
#pragma unroll
    for (int dt = 0; dt < 4; ++dt) {
      const bf16* vp = VT + (dt * 16 + q) * 520 + kr * 64 + bs + g4 * 4;
      uint2 lo = *(const uint2*)vp, hi = *(const uint2*)(vp + 16);
      uint4 vw; vw.x = lo.x; vw.y = lo.y; vw.z = hi.x; vw.w = hi.y;
      ot[dt] = __builtin_amdgcn_mfma_f32_16x16x32_bf16(*(bf16x8*)&vw, pf, ot[dt], 0, 0, 0);
    }
  }
  const float inv = 1.f / lsum;
#pragma unroll
  for (int dt = 0; dt < 4; ++dt) {
    const int d0 = dt * 16 + g4 * 4;
    uint2 gu = *(const uint2*)(projb + (size_t)qtok * EVEN_N + 1536 + h * 64 + d0);
    f32x4 y;
    y[0] = ot[dt][0] * inv * silu_f(__uint_as_float(gu.x << 16));
    y[1] = ot[dt][1] * inv * silu_f(__uint_as_float(gu.x & 0xffff0000u));
    y[2] = ot[dt][2] * inv * silu_f(__uint_as_float(gu.y << 16));
    y[3] = ot[dt][3] * inv * silu_f(__uint_as_float(gu.y & 0xffff0000u));
    uint2 o;
    o.x = (unsigned)f2bf(y[0]) | ((unsigned)f2bf(y[1]) << 16);
    o.y = (unsigned)f2bf(y[2]) | ((unsigned)f2bf(y[3]) << 16);
    *(uint2*)(yb + ((size_t)b * 4096 + qtok) * 1024 + h * 64 + d0) = o;
  }
}

template <int K, int MODE>
struct GateC {
  float w[16];
  float bias, lb;
  int d, ch;
  __device__ __forceinline__ void init(const P& p, int d_, int h, int k) {
    d = d_; ch = h * K + k;
    if (MODE == 0) {
#pragma unroll
      for (int r = 0; r < 16; ++r) w[r] = p.gla_w_up[(d * 16 + r) * 256 + ch];
      bias = p.gla_b[d * 256 + ch];
      lb = 0.f;
    } else {
      lb = ((const float*)(p.ws + WS_LB))[ch];
      bias = 0.f;
    }
  }
  __device__ __forceinline__ void eval_vals(bf16 a, bf16 bz, const bf16* lr, float& g, float& kval, float& qval) const {
    if (MODE == 0) {
      uint4 u0 = *(const uint4*)(lr);
      uint4 u1 = *(const uint4*)(lr + 8);
      float z = bias;
      z += w[0] * __uint_as_float(u0.x << 16) + w[1] * __uint_as_float(u0.x & 0xffff0000u);
      z += w[2] * __uint_as_float(u0.y << 16) + w[3] * __uint_as_float(u0.y & 0xffff0000u);
      z += w[4] * __uint_as_float(u0.z << 16) + w[5] * __uint_as_float(u0.z & 0xffff0000u);
      z += w[6] * __uint_as_float(u0.w << 16) + w[7] * __uint_as_float(u0.w & 0xffff0000u);
      z += w[8] * __uint_as_float(u1.x << 16) + w[9] * __uint_as_float(u1.x & 0xffff0000u);
      z += w[10] * __uint_as_float(u1.y << 16) + w[11] * __uint_as_float(u1.y & 0xffff0000u);
      z += w[12] * __uint_as_float(u1.z << 16) + w[13] * __uint_as_float(u1.z & 0xffff0000u);
      z += w[14] * __uint_as_float(u1.w << 16) + w[15] * __uint_as_float(u1.w & 0xffff0000u);
      g = log_sigmoid_f(z) * (1.f / 16.f);
      kval = bf2f(bz);
      qval = bf2f(a) * 0.125f;
    } else {
      const float z = bf2f(bz);
      const float e = __expf(-z);
      const float sg = 1.f / (1.f + e);
      kval = (1.f - lb) * e * sg;
      g = __logf(1.f - kval);
      qval = bf2f(a) * 0.08838834764831845f;
    }
  }
  __device__ __forceinline__ void eval(const bf16* row, float& g, float& kval, float& qval) const {
    if (MODE == 0) {
      uint4 u0 = *(const uint4*)(row + 3584 + d * 16);
      uint4 u1 = *(const uint4*)(row + 3584 + d * 16 + 8);
      float z = bias;
      z += w[0] * __uint_as_float(u0.x << 16) + w[1] * __uint_as_float(u0.x & 0xffff0000u);
      z += w[2] * __uint_as_float(u0.y << 16) + w[3] * __uint_as_float(u0.y & 0xffff0000u);
      z += w[4] * __uint_as_float(u0.z << 16) + w[5] * __uint_as_float(u0.z & 0xffff0000u);
      z += w[6] * __uint_as_float(u0.w << 16) + w[7] * __uint_as_float(u0.w & 0xffff0000u);
      z += w[8] * __uint_as_float(u1.x << 16) + w[9] * __uint_as_float(u1.x & 0xffff0000u);
      z += w[10] * __uint_as_float(u1.y << 16) + w[11] * __uint_as_float(u1.y & 0xffff0000u);
      z += w[12] * __uint_as_float(u1.z << 16) + w[13] * __uint_as_float(u1.z & 0xffff0000u);
      z += w[14] * __uint_as_float(u1.w << 16) + w[15] * __uint_as_float(u1.w & 0xffff0000u);
      g = log_sigmoid_f(z) * (1.f / 16.f);
      kval = bf2f(row[2304 + ch]);
      qval = bf2f(row[2048 + ch]) * 0.125f;
    } else {
      const float z = bf2f(row[512 + d * 512 + ch]);
      const float e = __expf(-z);
      const float sg = 1.f / (1.f + e);
      kval = (1.f - lb) * e * sg;
      g = __logf(1.f - kval);
      qval = bf2f(row[ch]) * 0.08838834764831845f;
    }
  }
};

template <int MODE>
__device__ __forceinline__ void stage_vt(const bf16* proj, int h, bf16* VT) {
  constexpr int LDP = MODE == 0 ? EVEN_N : ODD_N;
  constexpr int VOFF = MODE == 0 ? 2560 : 1536;
  const int j = threadIdx.x & 63, cgp = threadIdx.x >> 6;
#pragma unroll
  for (int cc = 0; cc < 4; ++cc) {
    const int c = cgp * 4 + cc;
    uint4 u = *(const uint4*)(proj + (size_t)j * LDP + VOFF + h * 128 + c * 8);
    bf16* dst = VT + (c * 8) * 72 + j;
    dst[0 * 72] = (bf16)(u.x & 0xffffu); dst[1 * 72] = (bf16)(u.x >> 16);
    dst[2 * 72] = (bf16)(u.y & 0xffffu); dst[3 * 72] = (bf16)(u.y >> 16);
    dst[4 * 72] = (bf16)(u.z & 0xffffu); dst[5 * 72] = (bf16)(u.z >> 16);
    dst[6 * 72] = (bf16)(u.w & 0xffffu); dst[7 * 72] = (bf16)(u.w >> 16);
  }
}

__device__ __forceinline__ uint2 pack4(f32x4 a) {
  uint2 o;
  o.x = (unsigned)f2bf(a[0]) | ((unsigned)f2bf(a[1]) << 16);
  o.y = (unsigned)f2bf(a[2]) | ((unsigned)f2bf(a[3]) << 16);
  return o;
}

template <int K, int MODE>
__device__ __forceinline__ void rec_pass1_item(const P& p, int item, unsigned char* smem) {
  constexpr int LDP = MODE == 0 ? EVEN_N : ODD_N;
  const int h = item & 3, blk = (item >> 2) & 63, b = item >> 8;
  bf16* KT = (bf16*)smem;
  bf16* VT = KT + 2 * K * 72;
  const bf16* proj = (const bf16*)(p.ws + WS_PROJ) + (size_t)(b * 4096 + blk * 64) * LDP;
  bf16* ST = (bf16*)(p.ws + WS_ST);
  float* DEC = (float*)(p.ws + WS_DEC);
  const int tid = threadIdx.x, lane = tid & 63, wave = tid >> 6;
  bf16* TMP = VT;
  if (MODE == 1) {
#pragma unroll
    for (int i = 0; i < 8; ++i) {
      const int c = i * 256 + tid;
      const int ch = c & 15, j = (c >> 4) & 63, d = c >> 10;
      *(uint4*)(TMP + (d * 64 + j) * 128 + ch * 8) = *(const uint4*)(proj + (size_t)j * LDP + 512 + d * 512 + h * 128 + ch * 8);
    }
  } else {
#pragma unroll
    for (int i = 0; i < 2; ++i) {
      const int c = i * 256 + tid;
      const int ch = c & 7, j = c >> 3;
      *(uint4*)(TMP + j * 64 + ch * 8) = *(const uint4*)(proj + (size_t)j * LDP + 2304 + h * 64 + ch * 8);
    }
    {
      const int ch = tid & 3, j = tid >> 2;
      *(uint4*)(TMP + 4096 + j * 32 + ch * 8) = *(const uint4*)(proj + (size_t)j * LDP + 3584 + ch * 8);
    }
  }
  __syncthreads();
  if (tid < 2 * K) {
    const int d = tid / K, k = tid % K;
    GateC<K, MODE> gc;
    gc.init(p, d, h, k);
    bf16* row = KT + (d * K + k) * 72;
    float r = 0.f, rhi = 0.f;
#pragma unroll 4
    for (int i = 63; i >= 0; --i) {
      const int j = d ? 63 - i : i;
      float g, kv, qv;
      if (MODE == 1) gc.eval_vals(0, TMP[(d * 64 + j) * 128 + k], nullptr, g, kv, qv);
      else gc.eval_vals(0, TMP[j * 64 + k], TMP + 4096 + j * 32 + d * 16, g, kv, qv);
      row[j] = f2bf(kv * __expf(r));
      r += g;
      if (i == 32) rhi = r;
    }
    DEC[(size_t)((((d * 4 + b) * 4 + h) * 64 + blk)) * K + k] = __expf(r);
    ((float*)(p.ws + WS_CMID))[(size_t)((((d * 4 + b) * 4 + h) * 64 + blk)) * K + k] = __expf(r - rhi);
  }
  __syncthreads();
  stage_vt<MODE>(proj, h, VT);
  __syncthreads();
#pragma unroll 1
  for (int d = 0; d < 2; ++d) {
    f32x4 acc[K / 16][2];
#pragma unroll
    for (int kt = 0; kt < K / 16; ++kt) { acc[kt][0] = (f32x4){0.f, 0.f, 0.f, 0.f}; acc[kt][1] = (f32x4){0.f, 0.f, 0.f, 0.f}; }
#pragma unroll
    for (int ks = 0; ks < 2; ++ks) {
      bf16x8 vf0 = *(const bf16x8*)(VT + ((wave * 2 + 0) * 16 + (lane & 15)) * 72 + ks * 32 + (lane >> 4) * 8);
      bf16x8 vf1 = *(const bf16x8*)(VT + ((wave * 2 + 1) * 16 + (lane & 15)) * 72 + ks * 32 + (lane >> 4) * 8);
#pragma unroll
      for (int kt = 0; kt < K / 16; ++kt) {
        bf16x8 kf = *(const bf16x8*)(KT + (d * K + kt * 16 + (lane & 15)) * 72 + ks * 32 + (lane >> 4) * 8);
        acc[kt][0] = __builtin_amdgcn_mfma_f32_16x16x32_bf16(kf, vf0, acc[kt][0], 0, 0, 0);
        acc[kt][1] = __builtin_amdgcn_mfma_f32_16x16x32_bf16(kf, vf1, acc[kt][1], 0, 0, 0);
      }
    }
    bf16* stb = ST + (size_t)((((d * 4 + b) * 4 + h) * 64 + blk)) * 128 * K;
#pragma unroll
    for (int kt = 0; kt < K / 16; ++kt)
#pragma unroll
      for (int vv = 0; vv < 2; ++vv) {
        const int v = (wave * 2 + vv) * 16 + (lane & 15);
        const int k0 = kt * 16 + (lane >> 4) * 4;
        *(uint2*)(stb + (size_t)v * K + k0) = pack4(acc[kt][vv]);
      }
  }
}

template <int K>
__device__ __forceinline__ void phase_rec_scan(const P& p) {
  bf16* ST = (bf16*)(p.ws + WS_ST);
  const float* DEC = (const float*)(p.ws + WS_DEC);
  const float* CMID = (const float*)(p.ws + WS_CMID);
  constexpr int KV = K / 4;
  const int total = 32 * 128 * KV;
  for (int idx = blockIdx.x * 256 + threadIdx.x; idx < total; idx += gridDim.x * 256) {
    const int kq = idx % KV, v = (idx / KV) & 127, s = idx / (KV * 128);
    const int d = s >> 4;
    float st0 = 0.f, st1 = 0.f, st2 = 0.f, st3 = 0.f;
#pragma unroll 1
    for (int n0 = 0; n0 < 64; n0 += 8) {
      uint2 u[8];
      float4 dc[8], cm[8];
#pragma unroll
      for (int q = 0; q < 8; ++q) {
        const int blk = d ? 63 - (n0 + q) : (n0 + q);
        u[q] = *(const uint2*)(ST + ((size_t)(s * 64 + blk) * 128 + v) * K + kq * 4);
        dc[q] = *(const float4*)(DEC + (size_t)(s * 64 + blk) * K + kq * 4);
        cm[q] = *(const float4*)(CMID + (size_t)(s * 64 + blk) * K + kq * 4);
      }
#pragma unroll
      for (int q = 0; q < 8; ++q) {
        const int blk = d ? 63 - (n0 + q) : (n0 + q);
        uint2 o;
        o.x = (unsigned)f2bf(st0 * cm[q].x) | ((unsigned)f2bf(st1 * cm[q].y) << 16);
        o.y = (unsigned)f2bf(st2 * cm[q].z) | ((unsigned)f2bf(st3 * cm[q].w) << 16);
        *(uint2*)(ST + ((size_t)(s * 64 + blk) * 128 + v) * K + kq * 4) = o;
        st0 = dc[q].x * st0 + __uint_as_float(u[q].x << 16);
        st1 = dc[q].y * st1 + __uint_as_float(u[q].x & 0xffff0000u);
        st2 = dc[q].z * st2 + __uint_as_float(u[q].y << 16);
        st3 = dc[q].w * st3 + __uint_as_float(u[q].y & 0xffff0000u);
      }
    }
  }
}

template <int K, int MODE>
__device__ __forceinline__ void rec_pass3_item(const P& p, int item, unsigned char* smem) {
  constexpr int LDP = MODE == 0 ? EVEN_N : ODD_N;
  constexpr int KS = K + 8;
  constexpr int GOFF = MODE == 0 ? 3072 : 2048;
  constexpr int YOFF = MODE == 0 ? 512 : 0;
  const int h = item & 3, blk = (item >> 2) & 63, b = item >> 8;
  bf16* QI = (bf16*)smem;
  bf16* KI = QI + 64 * KS;
  bf16* VT = KI + 64 * KS;
  bf16* AI = VT + 128 * 72;
  float* CV = (float*)(AI + 64 * 72);
  float* SSQ = CV + K;
  bf16* LRB = (bf16*)(SSQ + 256);
  const bf16* proj = (const bf16*)(p.ws + WS_PROJ) + (size_t)(b * 4096 + blk * 64) * LDP;
  const bf16* ST = (const bf16*)(p.ws + WS_ST);
  bf16* yb = (bf16*)(p.ws + WS_H);
  const int tid = threadIdx.x, lane = tid & 63, wave = tid >> 6;
  stage_vt<MODE>(proj, h, VT);
  f32x4 o[2][4];
#pragma unroll
  for (int vv = 0; vv < 2; ++vv)
#pragma unroll
    for (int it = 0; it < 4; ++it) o[vv][it] = (f32x4){0.f, 0.f, 0.f, 0.f};
#pragma unroll 1
  for (int d = 0; d < 2; ++d) {
    if (d) __syncthreads();
    const bf16* stb = ST + (size_t)((((d * 4 + b) * 4 + h) * 64 + blk)) * 128 * K;
    u32x4 stf[K / 32][2];
#pragma unroll
    for (int ks = 0; ks < K / 32; ++ks)
#pragma unroll
      for (int vv = 0; vv < 2; ++vv)
        stf[ks][vv] = gload16_asm(stb + (size_t)((wave * 2 + vv) * 16 + (lane & 15)) * K + ks * 32 + (lane >> 4) * 8);
    {
      constexpr int QOFF = MODE == 0 ? 2048 : 0;
      const int zoff = MODE == 0 ? 2304 : 512 + d * 512;
#pragma unroll
      for (int i = 0; i < K / 32; ++i) {
        const int c = i * 256 + tid;
        const int ch = c % (K / 8), j = c / (K / 8);
        *(uint4*)(QI + j * KS + ch * 8) = *(const uint4*)(proj + (size_t)j * LDP + QOFF + h * K + ch * 8);
        *(uint4*)(KI + j * KS + ch * 8) = *(const uint4*)(proj + (size_t)j * LDP + zoff + h * K + ch * 8);
      }
      if (MODE == 0 && tid < 128) {
        const int ch = tid & 1, j = tid >> 1;
        *(uint4*)(LRB + j * 16 + ch * 8) = *(const uint4*)(proj + (size_t)j * LDP + 3584 + d * 16 + ch * 8);
      }
    }
    __syncthreads();
    if (tid < 2 * K) {
      const int k = tid % K, half = tid / K;
      GateC<K, MODE> gc;
      gc.init(p, d, h, k);
      float run = 0.f;
      if (half) {
#pragma unroll 4
        for (int i = 32; i < 64; ++i) {
          const int j = d ? 63 - i : i;
          float g, kv, qv;
          gc.eval_vals(QI[j * KS + k], KI[j * KS + k], LRB + j * 16, g, kv, qv);
          run += g;
          QI[j * KS + k] = f2bf(qv * __expf(run));
          KI[j * KS + k] = f2bf(kv * __expf(-run));
        }
      } else {
#pragma unroll 4
        for (int i = 31; i >= 0; --i) {
          const int j = d ? 63 - i : i;
          float g, kv, qv;
          gc.eval_vals(QI[j * KS + k], KI[j * KS + k], LRB + j * 16, g, kv, qv);
          QI[j * KS + k] = f2bf(qv * __expf(-run));
          KI[j * KS + k] = f2bf(kv * __expf(run));
          run += g;
        }
        CV[k] = __expf(run);
      }
    }
    __syncthreads();
    {
      f32x4 a[4];
#pragma unroll
      for (int jt = 0; jt < 4; ++jt) a[jt] = (f32x4){0.f, 0.f, 0.f, 0.f};
#pragma unroll
      for (int ks = 0; ks < K / 32; ++ks) {
        bf16x8 qf = *(const bf16x8*)(QI + (wave * 16 + (lane & 15)) * KS + ks * 32 + (lane >> 4) * 8);
#pragma unroll
        for (int jt = 0; jt < 4; ++jt) {
          bf16x8 kf = *(const bf16x8*)(KI + (jt * 16 + (lane & 15)) * KS + ks * 32 + (lane >> 4) * 8);
          a[jt] = __builtin_amdgcn_mfma_f32_16x16x32_bf16(kf, qf, a[jt], 0, 0, 0);
        }
      }
      const int i = wave * 16 + (lane & 15);
#pragma unroll
      for (int jt = 0; jt < 4; ++jt) {
        const int j0 = jt * 16 + (lane >> 4) * 4;
        f32x4 m;
#pragma unroll
        for (int r = 0; r < 4; ++r) {
          const int j = j0 + r;
          const bool valid = d ? (j >= i) : (j <= i);
          m[r] = valid ? a[jt][r] : 0.f;
        }
        *(uint2*)(AI + i * 72 + j0) = pack4(m);
      }
    }
    __syncthreads();
#pragma unroll
    for (int ks = 0; ks < 2; ++ks) {
      bf16x8 vf0 = *(const bf16x8*)(VT + ((wave * 2 + 0) * 16 + (lane & 15)) * 72 + ks * 32 + (lane >> 4) * 8);
      bf16x8 vf1 = *(const bf16x8*)(VT + ((wave * 2 + 1) * 16 + (lane & 15)) * 72 + ks * 32 + (lane >> 4) * 8);
#pragma unroll
      for (int it = 0; it < 4; ++it) {
        bf16x8 af = *(const bf16x8*)(AI + (it * 16 + (lane & 15)) * 72 + ks * 32 + (lane >> 4) * 8);
        o[0][it] = __builtin_amdgcn_mfma_f32_16x16x32_bf16(vf0, af, o[0][it], 0, 0, 0);
        o[1][it] = __builtin_amdgcn_mfma_f32_16x16x32_bf16(vf1, af, o[1][it], 0, 0, 0);
      }
    }
    if (K == 128) {
      asm volatile("s_waitcnt vmcnt(0)"
                   : "+v"(stf[0][0]), "+v"(stf[0][1]), "+v"(stf[1][0]), "+v"(stf[1][1]), "+v"(stf[K / 32 - 2][0]), "+v"(stf[K / 32 - 2][1]), "+v"(stf[K / 32 - 1][0]), "+v"(stf[K / 32 - 1][1])
                   :: "memory");
    } else {
      asm volatile("s_waitcnt vmcnt(0)" : "+v"(stf[0][0]), "+v"(stf[0][1]), "+v"(stf[1][0]), "+v"(stf[1][1]) :: "memory");
    }
#pragma unroll
    for (int ks = 0; ks < K / 32; ++ks) {
      const int kk = ks * 32 + (lane >> 4) * 8;
      bf16x8 sf[2];
      sf[0] = *(bf16x8*)&stf[ks][0];
      sf[1] = *(bf16x8*)&stf[ks][1];
#pragma unroll
      for (int it = 0; it < 4; ++it) {
        bf16x8 qf = *(const bf16x8*)(QI + (it * 16 + (lane & 15)) * KS + kk);
        o[0][it] = __builtin_amdgcn_mfma_f32_16x16x32_bf16(sf[0], qf, o[0][it], 0, 0, 0);
        o[1][it] = __builtin_amdgcn_mfma_f32_16x16x32_bf16(sf[1], qf, o[1][it], 0, 0, 0);
      }
    }
  }
  {
    float ss[4];
#pragma unroll
    for (int it = 0; it < 4; ++it) {
      float s = 0.f;
#pragma unroll
      for (int vv = 0; vv < 2; ++vv)
#pragma unroll
        for (int r = 0; r < 4; ++r) s += o[vv][it][r] * o[vv][it][r];
      s += __shfl_xor(s, 16, 64);
      s += __shfl_xor(s, 32, 64);
      ss[it] = s;
    }
    if (lane < 16) {
#pragma unroll
      for (int it = 0; it < 4; ++it) SSQ[wave * 64 + it * 16 + lane] = ss[it];
    }
    __syncthreads();
    const float* gn = MODE == 0 ? p.gla_g : p.hgrn_g;
#pragma unroll
    for (int it = 0; it < 4; ++it) {
      const int i = it * 16 + (lane & 15);
      const float tot = SSQ[i] + SSQ[64 + i] + SSQ[128 + i] + SSQ[192 + i];
      const float rs = rsqrtf(tot * (1.f / 128.f) + 1e-6f);
#pragma unroll
      for (int vv = 0; vv < 2; ++vv) {
        const int v0 = (wave * 2 + vv) * 16 + (lane >> 4) * 4;
        uint2 gu = *(const uint2*)(proj + (size_t)i * LDP + GOFF + h * 128 + v0);
        float4 gg = *(const float4*)(gn + v0);
        f32x4 y;
        y[0] = o[vv][it][0] * rs * gg.x * silu_f(__uint_as_float(gu.x << 16));
        y[1] = o[vv][it][1] * rs * gg.y * silu_f(__uint_as_float(gu.x & 0xffff0000u));
        y[2] = o[vv][it][2] * rs * gg.z * silu_f(__uint_as_float(gu.y << 16));
        y[3] = o[vv][it][3] * rs * gg.w * silu_f(__uint_as_float(gu.y & 0xffff0000u));
        *(uint2*)(yb + (size_t)(b * 4096 + blk * 64 + i) * 1024 + YOFF + h * 128 + v0) = pack4(y);
      }
    }
  }
}

__device__ __forceinline__ void conv8(const P& p, const bf16* projb, int t, int c0, float* o8) {
  float4 b0 = *(const float4*)(p.conv_b + c0), b1 = *(const float4*)(p.conv_b + c0 + 4);
  float a[8] = {b0.x, b0.y, b0.z, b0.w, b1.x, b1.y, b1.z, b1.w};
#pragma unroll
  for (int jt = 0; jt < 4; ++jt) {
    const int tt = t + jt - 2;
    if (tt >= 0 && tt < 4096) {
      uint4 u = *(const uint4*)(projb + (size_t)tt * ODD_N + 3072 + c0);
      float4 w0 = *(const float4*)(p.conv_w + jt * 1024 + c0), w1 = *(const float4*)(p.conv_w + jt * 1024 + c0 + 4);
      a[0] += w0.x * __uint_as_float(u.x << 16); a[1] += w0.y * __uint_as_float(u.x & 0xffff0000u);
      a[2] += w0.z * __uint_as_float(u.y << 16); a[3] += w0.w * __uint_as_float(u.y & 0xffff0000u);
      a[4] += w1.x * __uint_as_float(u.z << 16); a[5] += w1.y * __uint_as_float(u.z & 0xffff0000u);
      a[6] += w1.z * __uint_as_float(u.w << 16); a[7] += w1.w * __uint_as_float(u.w & 0xffff0000u);
    }
  }
#pragma unroll
  for (int e = 0; e < 8; ++e) o8[e] = silu_f(a[e]);
}

__device__ __forceinline__ void ssd_prep_acum(const P& p, const bf16* projb, int blk, int g, float* ACUM, float* DTV, float* TOT) {
  const int lane = threadIdx.x & 63, wave = threadIdx.x >> 6;
#pragma unroll
  for (int q = 0; q < 2; ++q) {
    const int c = wave * 2 + q, dir = c >> 2, rp = c & 3, head = g * 4 + rp;
    const int j = dir ? 63 - lane : lane;
    const int t = blk * 64 + j;
    const float dt = softplus_f(bf2f(projb[(size_t)t * ODD_N + 4096 + dir * 8 + head]) + p.dt_bias[dir * 8 + head]);
    float v = -__expf(p.a_log[dir * 8 + head]) * dt;
#pragma unroll
    for (int off = 1; off < 64; off <<= 1) {
      float tmp = __shfl_up(v, off, 64);
      if (lane >= off) v += tmp;
    }
    ACUM[c * 64 + j] = v;
    DTV[c * 64 + j] = dt;
    if (lane == 63) TOT[c] = v;
  }
}

__device__ __forceinline__ void ssd_pass1_item(const P& p, int item, unsigned char* smem) {
  const int g = item & 1, blk = (item >> 1) & 63, b = item >> 7;
  bf16* BT = (bf16*)smem;
  bf16* XT = BT + 128 * 72;
  float* ACUM = (float*)(XT + 256 * 72);
  float* DTV = ACUM + 512;
  float* TOT = DTV + 512;
  const bf16* projb = (const bf16*)(p.ws + WS_PROJ) + (size_t)b * 4096 * ODD_N;
  bf16* ST = (bf16*)(p.ws + WS_ST);
  float* DEC = (float*)(p.ws + WS_DEC);
  const int tid = threadIdx.x, lane = tid & 63, wave = tid >> 6;
  const int t = blk * 64 + lane;
  ssd_prep_acum(p, projb, blk, g, ACUM, DTV, TOT);
#pragma unroll 1
  for (int q = 0; q < 4; ++q) {
    const int cc = wave + 4 * q;
    float v8[8];
    conv8(p, projb, t, 512 + g * 128 + cc * 8, v8);
#pragma unroll
    for (int e = 0; e < 8; ++e) BT[(cc * 8 + e) * 72 + lane] = f2bf(v8[e]);
  }
  float xs[8][8];
#pragma unroll
  for (int q = 0; q < 8; ++q) conv8(p, projb, t, g * 256 + (wave * 8 + q) * 8, xs[q]);
  __syncthreads();
  if (tid < 8) {
    const int dir = tid >> 2, head = g * 4 + (tid & 3);
    DEC[(size_t)((dir * 4 + b) * 8 + head) * 64 + blk] = __expf(TOT[tid]);
  }
#pragma unroll 1
  for (int dir = 0; dir < 2; ++dir) {
    if (dir) __syncthreads();
    const int c = dir * 4 + wave;
    const float fac = DTV[c * 64 + lane] * __expf(TOT[c] - ACUM[c * 64 + lane]);
#pragma unroll
    for (int q = 0; q < 8; ++q)
#pragma unroll
      for (int e = 0; e < 8; ++e) XT[((wave * 8 + q) * 8 + e) * 72 + lane] = f2bf(xs[q][e] * fac);
    __syncthreads();
    const int head = g * 4 + wave;
    bf16* stb = ST + (size_t)(((dir * 4 + b) * 8 + head) * 64 + blk) * 8192;
#pragma unroll 1
    for (int nh = 0; nh < 2; ++nh) {
      f32x4 acc[4][4];
#pragma unroll
      for (int nt = 0; nt < 4; ++nt)
#pragma unroll
        for (int pt = 0; pt < 4; ++pt) acc[nt][pt] = (f32x4){0.f, 0.f, 0.f, 0.f};
#pragma unroll
      for (int ks = 0; ks < 2; ++ks) {
        bf16x8 xf[4];
#pragma unroll
        for (int pt = 0; pt < 4; ++pt) xf[pt] = *(const bf16x8*)(XT + (wave * 64 + pt * 16 + (lane & 15)) * 72 + ks * 32 + (lane >> 4) * 8);
#pragma unroll
        for (int nt = 0; nt < 4; ++nt) {
          bf16x8 bfv = *(const bf16x8*)(BT + ((nh * 4 + nt) * 16 + (lane & 15)) * 72 + ks * 32 + (lane >> 4) * 8);
#pragma unroll
          for (int pt = 0; pt < 4; ++pt) acc[nt][pt] = __builtin_amdgcn_mfma_f32_16x16x32_bf16(bfv, xf[pt], acc[nt][pt], 0, 0, 0);
        }
      }
#pragma unroll
      for (int nt = 0; nt < 4; ++nt)
#pragma unroll
        for (int pt = 0; pt < 4; ++pt) {
          const int pp = pt * 16 + (lane & 15);
          const int n0 = (nh * 4 + nt) * 16 + (lane >> 4) * 4;
          *(uint2*)(stb + (size_t)pp * 128 + n0) = pack4(acc[nt][pt]);
        }
    }
  }
}

__device__ __forceinline__ void phase_ssd_scan(const P& p) {
  bf16* ST = (bf16*)(p.ws + WS_ST);
  const float* DEC = (const float*)(p.ws + WS_DEC);
  const int total = 64 * 2048;
  for (int idx = blockIdx.x * 256 + threadIdx.x; idx < total; idx += gridDim.x * 256) {
    const int e4 = idx & 2047, s = idx >> 11;
    const int d = s >> 5;
    float st0 = 0.f, st1 = 0.f, st2 = 0.f, st3 = 0.f;
#pragma unroll 1
    for (int n0 = 0; n0 < 64; n0 += 8) {
      uint2 u[8];
      float dc[8];
#pragma unroll
      for (int q = 0; q < 8; ++q) {
        const int blk = d ? 63 - (n0 + q) : (n0 + q);
        u[q] = *(const uint2*)(ST + (size_t)(s * 64 + blk) * 8192 + e4 * 4);
        dc[q] = DEC[s * 64 + blk];
      }
#pragma unroll
      for (int q = 0; q < 8; ++q) {
        const int blk = d ? 63 - (n0 + q) : (n0 + q);
        uint2 o;
        o.x = (unsigned)f2bf(st0) | ((unsigned)f2bf(st1) << 16);
        o.y = (unsigned)f2bf(st2) | ((unsigned)f2bf(st3) << 16);
        *(uint2*)(ST + (size_t)(s * 64 + blk) * 8192 + e4 * 4) = o;
        st0 = dc[q] * st0 + __uint_as_float(u[q].x << 16);
        st1 = dc[q] * st1 + __uint_as_float(u[q].x & 0xffff0000u);
        st2 = dc[q] * st2 + __uint_as_float(u[q].y << 16);
        st3 = dc[q] * st3 + __uint_as_float(u[q].y & 0xffff0000u);
      }
    }
  }
}

__device__ __forceinline__ void ssd_pass3_item(const P& p, int item, unsigned char* smem) {
  const int g = item & 1, blk = (item >> 1) & 63, b = item >> 7;
  bf16* CI = (bf16*)smem;
  bf16* BI = CI + 64 * 136;
  bf16* AI = BI;
  bf16* XT = BI + 64 * 136;
  float* ACUM = (float*)(XT + 64 * 72);
  float* DTV = ACUM + 512;
  float* TOT = DTV + 512;
  float* SSQ = TOT + 8;
  const bf16* projb = (const bf16*)(p.ws + WS_PROJ) + (size_t)b * 4096 * ODD_N;
  const bf16* ST = (const bf16*)(p.ws + WS_ST);
  bf16* yb = (bf16*)(p.ws + WS_H);
  const int tid = threadIdx.x, lane = tid & 63, wave = tid >> 6;
  const int t = blk * 64 + lane;
  ssd_prep_acum(p, projb, blk, g, ACUM, DTV, TOT);
#pragma unroll 1
  for (int q = 0; q < 8; ++q) {
    const int cc = wave * 8 + q, which = cc >> 4, ch = (cc & 15) * 8;
    float v8[8];
    conv8(p, projb, t, 512 + which * 256 + g * 128 + ch, v8);
    uint4 w;
    w.x = (unsigned)f2bf(v8[0]) | ((unsigned)f2bf(v8[1]) << 16);
    w.y = (unsigned)f2bf(v8[2]) | ((unsigned)f2bf(v8[3]) << 16);
    w.z = (unsigned)f2bf(v8[4]) | ((unsigned)f2bf(v8[5]) << 16);
    w.w = (unsigned)f2bf(v8[6]) | ((unsigned)f2bf(v8[7]) << 16);
    *(uint4*)((which ? CI : BI) + lane * 136 + ch) = w;
  }
  __syncthreads();
  f32x4 gt[4];
#pragma unroll
  for (int jt = 0; jt < 4; ++jt) gt[jt] = (f32x4){0.f, 0.f, 0.f, 0.f};
#pragma unroll
  for (int ks = 0; ks < 4; ++ks) {
    bf16x8 cf = *(const bf16x8*)(CI + (wave * 16 + (lane & 15)) * 136 + ks * 32 + (lane >> 4) * 8);
#pragma unroll
    for (int jt = 0; jt < 4; ++jt) {
      bf16x8 bfv = *(const bf16x8*)(BI + (jt * 16 + (lane & 15)) * 136 + ks * 32 + (lane >> 4) * 8);
      gt[jt] = __builtin_amdgcn_mfma_f32_16x16x32_bf16(bfv, cf, gt[jt], 0, 0, 0);
    }
  }
  __syncthreads();
  float ssq_acc[4] = {0.f, 0.f, 0.f, 0.f};
#pragma unroll 1
  for (int rp = 0; rp < 4; ++rp) {
    const int head = g * 4 + rp;
#pragma unroll 1
    for (int q = 0; q < 2; ++q) {
      const int cc = wave * 2 + q;
      float v8[8];
      conv8(p, projb, t, head * 64 + cc * 8, v8);
#pragma unroll
      for (int e = 0; e < 8; ++e) XT[(cc * 8 + e) * 72 + lane] = f2bf(v8[e]);
    }
    f32x4 o[4];
#pragma unroll
    for (int it = 0; it < 4; ++it) o[it] = (f32x4){0.f, 0.f, 0.f, 0.f};
#pragma unroll 1
    for (int dir = 0; dir < 2; ++dir) {
      const int c = dir * 4 + rp;
      const bf16* stb = ST + (size_t)(((dir * 4 + b) * 8 + head) * 64 + blk) * 8192;
      u32x4 stf[4];
#pragma unroll
      for (int ks = 0; ks < 4; ++ks) stf[ks] = gload16_asm(stb + (size_t)(wave * 16 + (lane & 15)) * 128 + ks * 32 + (lane >> 4) * 8);
      {
        const int i = wave * 16 + (lane & 15);
        const float aci = ACUM[c * 64 + i];
#pragma unroll
        for (int jt = 0; jt < 4; ++jt) {
          const int j0 = jt * 16 + (lane >> 4) * 4;
          f32x4 m;
#pragma unroll
          for (int r = 0; r < 4; ++r) {
            const int j = j0 + r;
            const bool valid = dir ? (j >= i) : (j <= i);
            const float arg = fminf(aci - ACUM[c * 64 + j], 0.f);
            m[r] = valid ? gt[jt][r] * __expf(arg) * DTV[c * 64 + j] : 0.f;
          }
          *(uint2*)(AI + i * 72 + j0) = pack4(m);
        }
      }
      __syncthreads();
#pragma unroll
      for (int ks = 0; ks < 2; ++ks) {
        bf16x8 xf = *(const bf16x8*)(XT + (wave * 16 + (lane & 15)) * 72 + ks * 32 + (lane >> 4) * 8);
#pragma unroll
        for (int it = 0; it < 4; ++it) {
          bf16x8 af = *(const bf16x8*)(AI + (it * 16 + (lane & 15)) * 72 + ks * 32 + (lane >> 4) * 8);
          o[it] = __builtin_amdgcn_mfma_f32_16x16x32_bf16(xf, af, o[it], 0, 0, 0);
        }
      }
      f32x4 tI[4];
#pragma unroll
      for (int it = 0; it < 4; ++it) tI[it] = (f32x4){0.f, 0.f, 0.f, 0.f};
      asm volatile("s_waitcnt vmcnt(0)" : "+v"(stf[0]), "+v"(stf[1]), "+v"(stf[2]), "+v"(stf[3]) :: "memory");
#pragma unroll
      for (int ks = 0; ks < 4; ++ks) {
        bf16x8 sf = *(bf16x8*)&stf[ks];
#pragma unroll
        for (int it = 0; it < 4; ++it) {
          bf16x8 cf = *(const bf16x8*)(CI + (it * 16 + (lane & 15)) * 136 + ks * 32 + (lane >> 4) * 8);
          tI[it] = __builtin_amdgcn_mfma_f32_16x16x32_bf16(sf, cf, tI[it], 0, 0, 0);
        }
      }
#pragma unroll
      for (int it = 0; it < 4; ++it) {
        const float ea = __expf(ACUM[c * 64 + it * 16 + (lane & 15)]);
#pragma unroll
        for (int r = 0; r < 4; ++r) o[it][r] += ea * tI[it][r];
      }
      __syncthreads();
    }
    {
      const float dsk = p.d_skip[head];
      const int p0 = wave * 16 + (lane >> 4) * 4;
      float4 gg = *(const float4*)(p.ssm_g + head * 64 + p0);
#pragma unroll
      for (int it = 0; it < 4; ++it) {
        const int i = it * 16 + (lane & 15);
        const size_t tok = (size_t)b * 4096 + blk * 64 + i;
        uint2 zu = *(const uint2*)(projb + (size_t)(blk * 64 + i) * ODD_N + 2560 + head * 64 + p0);
        f32x4 y;
        y[0] = (o[it][0] + dsk * bf2f(XT[(p0 + 0) * 72 + i])) * silu_f(__uint_as_float(zu.x << 16));
        y[1] = (o[it][1] + dsk * bf2f(XT[(p0 + 1) * 72 + i])) * silu_f(__uint_as_float(zu.x & 0xffff0000u));
        y[2] = (o[it][2] + dsk * bf2f(XT[(p0 + 2) * 72 + i])) * silu_f(__uint_as_float(zu.y << 16));
        y[3] = (o[it][3] + dsk * bf2f(XT[(p0 + 3) * 72 + i])) * silu_f(__uint_as_float(zu.y & 0xffff0000u));
        ssq_acc[it] += y[0] * y[0] + y[1] * y[1] + y[2] * y[2] + y[3] * y[3];
        y[0] *= gg.x; y[1] *= gg.y; y[2] *= gg.z; y[3] *= gg.w;
        *(uint2*)(yb + tok * 1024 + 512 + head * 64 + p0) = pack4(y);
      }
    }
    __syncthreads();
  }
#pragma unroll
  for (int it = 0; it < 4; ++it) {
    float s = ssq_acc[it];
    s += __shfl_xor(s, 16, 64);
    s += __shfl_xor(s, 32, 64);
    if (lane < 16) SSQ[wave * 64 + it * 16 + lane] = s;
  }
  __syncthreads();
  if (tid < 64) {
    float* ssqp = (float*)(p.ws + WS_SSQ);
    ssqp[(size_t)g * M_TOK + (size_t)b * 4096 + blk * 64 + tid] = SSQ[tid] + SSQ[64 + tid] + SSQ[128 + tid] + SSQ[192 + tid];
  }
}

__device__ __forceinline__ void phase_ssd_norm(const P& p) {
  const float* ssqp = (const float*)(p.ws + WS_SSQ);
  bf16* yb = (bf16*)(p.ws + WS_H);
  const int total = M_TOK * 64;
  for (int idx = blockIdx.x * 256 + threadIdx.x; idx < total; idx += gridDim.x * 256) {
    const int tok = idx >> 6, c8 = (idx & 63) * 8;
    const float rs = rsqrtf((ssqp[tok] + ssqp[M_TOK + tok]) * (1.f / 512.f) + 1e-6f);
    uint4* ptr = (uint4*)(yb + (size_t)tok * 1024 + 512 + c8);
    uint4 u = *ptr, w;
    w.x = (unsigned)f2bf(__uint_as_float(u.x << 16) * rs) | ((unsigned)f2bf(__uint_as_float(u.x & 0xffff0000u) * rs) << 16);
    w.y = (unsigned)f2bf(__uint_as_float(u.y << 16) * rs) | ((unsigned)f2bf(__uint_as_float(u.y & 0xffff0000u) * rs) << 16);
    w.z = (unsigned)f2bf(__uint_as_float(u.z << 16) * rs) | ((unsigned)f2bf(__uint_as_float(u.z & 0xffff0000u) * rs) << 16);
    w.w = (unsigned)f2bf(__uint_as_float(u.w << 16) * rs) | ((unsigned)f2bf(__uint_as_float(u.w & 0xffff0000u) * rs) << 16);
    *ptr = w;
  }
}


#define XB_TMO      128
#define XB_XCNT(j)  (256  + 64 * (j))
#define XB_XSUB(j)  (1280 + 64 * (j))
#define XB_XGEN(j)  (2304 + 64 * (j))
#define XB_TOP      3328
#define XB_TOPGEN   3392
#define XCD_BAR_WORDS 3456
#define XB_SPIN_CAP (1u << 18)
#define LAS __attribute__((address_space(3)))
__device__ __forceinline__ unsigned xb_ld(unsigned* p) { return __hip_atomic_load(p, __ATOMIC_RELAXED, __HIP_MEMORY_SCOPE_AGENT); }
__device__ __forceinline__ unsigned xb_add(unsigned* p, unsigned v) { return __hip_atomic_fetch_add(p, v, __ATOMIC_RELAXED, __HIP_MEMORY_SCOPE_AGENT); }
__device__ __forceinline__ unsigned xb_xcc_id() { return (unsigned)__builtin_amdgcn_s_getreg((3 << 11) | 20) & 0xFu; }
#define XB_SPIN(cond, bar) do { unsigned _sp = 0; while (cond) { __builtin_amdgcn_s_sleep(1); \
    if ((++_sp & 255u) == 0u) { if (xb_ld(&(bar)[XB_TMO])) break; if (_sp > XB_SPIN_CAP) { atomicAdd(&(bar)[XB_TMO], 1u); break; } } } } while (0)
struct XcdBarrier { unsigned* bar; unsigned x; volatile LAS unsigned* st; };
__device__ __forceinline__ XcdBarrier xcd_barrier_post(unsigned* bar, volatile LAS unsigned* st) {
  XcdBarrier b; b.bar = bar; b.x = xb_xcc_id(); b.st = st;
  if (threadIdx.x == 0) (void)xb_add(&bar[XB_XCNT(b.x)], 1u);
  return b;
}
__device__ __forceinline__ void xcd_barrier_complete(unsigned* bar, unsigned x, unsigned& nloc, unsigned& nx) {
  const unsigned G = gridDim.x * gridDim.y * gridDim.z;
  unsigned sum, cnt, mine, sp = 0u;
  for (;;) {
    sum = 0u; cnt = 0u; mine = 0u;
#pragma unroll
    for (unsigned j = 0; j < 16; ++j) { const unsigned c = xb_ld(&bar[XB_XCNT(j)]); sum += c; cnt += (c > 0u) ? 1u : 0u; mine = (j == x) ? c : mine; }
    if (sum == G) break;
    __builtin_amdgcn_s_sleep(1);
    if ((++sp & 255u) == 0u) { if (xb_ld(&bar[XB_TMO])) break; if (sp > XB_SPIN_CAP) { atomicAdd(&bar[XB_TMO], 1u); break; } }
  }
  nloc = mine > 0u ? mine : 1u; nx = cnt > 0u ? cnt : 1u;
}
__device__ __forceinline__ void xcd_barrier(const XcdBarrier& b) {
  asm volatile("s_waitcnt vmcnt(0)" ::: "memory");
  __syncthreads();
  if (threadIdx.x == 0) {
    unsigned* bar = b.bar;
    __builtin_amdgcn_s_waitcnt(0);
    unsigned nloc = b.st[0], nx = b.st[1];
    if (nloc == 0u) { xcd_barrier_complete(bar, b.x, nloc, nx); b.st[0] = nloc; b.st[1] = nx; }
    const unsigned old = xb_add(&bar[XB_XSUB(b.x)], 1u);
    const unsigned gen = old / nloc;
    if (old + 1u == (gen + 1u) * nloc) {
      __builtin_amdgcn_fence(__ATOMIC_RELEASE, "agent");
      asm volatile("s_waitcnt vmcnt(0)" ::: "memory");
      const unsigned og = xb_add(&bar[XB_TOP], 1u);
      const unsigned tg = og / nx;
      if (og + 1u == (tg + 1u) * nx) xb_add(&bar[XB_TOPGEN], 1u);
      else XB_SPIN(xb_ld(&bar[XB_TOPGEN]) == tg, bar);
      __builtin_amdgcn_fence(__ATOMIC_ACQUIRE, "agent");
      xb_add(&bar[XB_XGEN(b.x)], 1u);
      asm volatile("s_waitcnt vmcnt(0)" ::: "memory");
    } else {
      XB_SPIN(xb_ld(&bar[XB_XGEN(b.x)]) == gen, bar);
      __builtin_amdgcn_fence(__ATOMIC_ACQUIRE, "agent");
      asm volatile("s_waitcnt vmcnt(0)" ::: "memory");
    }
  }
  __syncthreads();
}

#define NPHASE 17
__global__ void __launch_bounds__(256, 2) mega(P p, int ph_lo, int ph_hi) {
  __shared__ __align__(16) unsigned char smem[73728 + 16];
  cg::grid_group grid = cg::this_grid();
  if (ph_lo < 0) grid.sync();
  if (threadIdx.x == 0) *(uint4*)(smem + 73728) = make_uint4(0u, 0u, 0u, 0u);
  __syncthreads();
  XcdBarrier xb = xcd_barrier_post((unsigned*)(p.ws + WS_BAR), (volatile LAS unsigned*)(smem + 73728));
  const float* mod = (const float*)(p.ws + WS_MOD);
#define IN(k) (ph_lo <= (k) && (k) < ph_hi)
#define SYNC(k) if (IN(k) && (k) + 1 < ph_hi) xcd_barrier(xb);
  if (IN(0)) phase_setup(p, smem);
  SYNC(0)
  if (IN(1)) phase_h0(p);
  SYNC(1)
  if (IN(2))
    phase_gemm<0>((const bf16*)(p.ws + WS_H), (const bf16*)(p.ws + WS_WEI), EVEN_NP / 128, smem,
                  (bf16*)(p.ws + WS_PROJ), EVEN_N, EVEN_N, nullptr, nullptr, nullptr, (unsigned*)(p.ws + WS_BAR), 0);
  SYNC(2)
  if (IN(3)) {
    for (int it = blockIdx.x; it < 1024; it += gridDim.x) { rec_pass1_item<64, 0>(p, it, smem); __syncthreads(); }
  }
  SYNC(3)
  if (IN(4)) {
    phase_rec_scan<64>(p);
    for (int it = blockIdx.x; it < 2048 * REPN + 16 * 66 + 256; it += gridDim.x) {
      if (it < 2048 * REPN) na_item(p, it & 2047, smem);
      else if (it < 2048 * REPN + 16 * 66) transpose_item(p.o_w_in, ODD_N, (bf16*)(p.ws + WS_WOI), it - 2048 * REPN, smem);
      else transpose_item(p.o_w_out, 1024, (bf16*)(p.ws + WS_WOO), it - 2048 * REPN - 16 * 66, smem);
      __syncthreads();
    }
  }
  SYNC(4)
  if (IN(5)) {
    for (int it = blockIdx.x; it < 1024 * REPR; it += gridDim.x) { rec_pass3_item<64, 0>(p, it & 1023, smem); __syncthreads(); }
  }
  SYNC(5)
  if (IN(6))
    phase_gemm<1>((const bf16*)(p.ws + WS_H), (const bf16*)(p.ws + WS_WEO), 8, smem, nullptr, 0, 0, p.x, p.out,
                  mod + 2048, (unsigned*)(p.ws + WS_BAR), 1);
  SYNC(6)
  if (IN(7)) phase_ln(p, 0, true);
  SYNC(7)
  if (IN(8))
    phase_gemm<0>((const bf16*)(p.ws + WS_H), (const bf16*)(p.ws + WS_WOI), ODD_NP / 128, smem,
                  (bf16*)(p.ws + WS_PROJ), ODD_N, ODD_N, nullptr, nullptr, nullptr, (unsigned*)(p.ws + WS_BAR), 2);
  SYNC(8)
  if (IN(9)) {
    for (int it = blockIdx.x; it < 1024 * REPR; it += gridDim.x) { rec_pass1_item<128, 1>(p, it & 1023, smem); __syncthreads(); }
  }
  SYNC(9)
  if (IN(10)) phase_rec_scan<128>(p);
  SYNC(10)
  if (IN(11)) {
    for (int it = blockIdx.x; it < 1024 * REP3 * REPR; it += gridDim.x) { rec_pass3_item<128, 1>(p, it & 1023, smem); __syncthreads(); }
  }
  SYNC(11)
  if (IN(12)) {
    for (int it = blockIdx.x; it < 512 * REPS; it += gridDim.x) { ssd_pass1_item(p, it & 511, smem); __syncthreads(); }
  }
  SYNC(12)
  if (IN(13)) phase_ssd_scan(p);
  SYNC(13)
  if (IN(14)) {
    for (int it = blockIdx.x; it < 512 * REPS; it += gridDim.x) { ssd_pass3_item(p, it & 511, smem); __syncthreads(); }
  }
  SYNC(14)
  if (IN(15))
    phase_gemm<2>((const bf16*)(p.ws + WS_H), (const bf16*)(p.ws + WS_WOO), 8, smem, nullptr, 0, 0, p.out, p.out,
                  mod + 4 * 3072 + 2048, (unsigned*)(p.ws + WS_BAR), 3, (const float*)(p.ws + WS_SSQ));
  SYNC(15)
  if (IN(16)) phase_ln(p, 1, false);
}

extern "C" void kernel_launch(void* const* d_in, const int* in_sizes, int n_in, void* d_out, int out_size, void* d_ws,
                              size_t ws_size, hipStream_t stream) {
  static int grid_blocks = 0;
  if (!grid_blocks) {
    int dev = 0, cus = 0, per_cu = 0;
    hipGetDevice(&dev);
    hipDeviceGetAttribute(&cus, hipDeviceAttributeMultiprocessorCount, dev);
    hipOccupancyMaxActiveBlocksPerMultiprocessor(&per_cu, mega, 256, 0);
    if (per_cu < 1) per_cu = 1;
    if (per_cu > 2) per_cu = 2;
    grid_blocks = cus * per_cu;
    if (n_in != 22 || ws_size < WS_END) {
      fprintf(stderr, "kernel_launch: unexpected n_in %d / ws_size %zu (need %llu)\n", n_in, ws_size, (unsigned long long)WS_END);
      grid_blocks = -1;
    }
  }
  if (grid_blocks < 0) return;
  P p{};
  const float** f = (const float**)&p;
  for (int i = 0; i < 22; ++i) f[i] = (const float*)d_in[i];
  p.out = (float*)d_out;
  p.ws = (unsigned char*)d_ws;
#if 1
  if (hipMemsetAsync((char*)d_ws + WS_BAR, 0, 16384, stream) != hipSuccess) { fprintf(stderr, "memset of barrier words failed\n"); return; }
  int lo = 0, hi = NPHASE;
  void* args[] = {&p, &lo, &hi};
  hipError_t e = hipLaunchCooperativeKernel((void*)mega, dim3(grid_blocks), dim3(256), args, 0, stream);
  if (e != hipSuccess) fprintf(stderr, "cooperative launch failed: %s (grid %d)\n", hipGetErrorString(e), grid_blocks);
#else
  for (int ph = 0; ph < NPHASE; ++ph) hipLaunchKernelGGL(mega, dim3(grid_blocks), dim3(256), 0, stream, p, ph, ph + 1);
#endif
}
```

```cpp
#include <hip/hip_runtime.h>
#include <hip/hip_cooperative_groups.h>
#include <cstdio>
namespace cg = cooperative_groups;

typedef unsigned short bf16;
using bf16x8 = __attribute__((ext_vector_type(8))) short;
using f32x4 = __attribute__((ext_vector_type(4))) float;

#define M_TOK 16384
#define DM 1024
#define SEQ 4096
#define EVEN_N 3616
#define EVEN_NP 3712
#define ODD_N 4112
#define ODD_NP 4224
#define ALPHA 1.4142135623730951f
#ifndef PROBE_PH
#define PROBE_PH -1
#endif
#ifndef REPG
#define REPG 1
#endif
#ifndef REPN
#define REPN 1
#endif
#ifndef REP3
#define REP3 1
#endif
#ifndef REPS
#define REPS 1
#endif
#ifndef REP0
#define REP0 1
#endif
#ifndef REPR
#define REPR 1
#endif

#define WS_MOD 0ull
#define WS_LB (WS_MOD + 98304ull)
#define WS_WEI (WS_LB + 2048ull)
#define WS_WEO (WS_WEI + 3712ull * 2048)
#define WS_WOI (WS_WEO + 1024ull * 2048)
#define WS_WOO (WS_WOI + 4224ull * 2048)
#define WS_H (WS_WOO + 1024ull * 2048)
#define WS_PROJ (WS_H + 16384ull * 2048)
#define WS_O (WS_PROJ + 16384ull * 4112 * 2)
#define WS_ST WS_O
#define WS_DEC (WS_O + 2ull * 16384 * 512 * 4)
#define WS_SSQ (WS_DEC + 2ull * 16 * 64 * 128 * 4)
#define WS_BAR (WS_SSQ + 2ull * 16384 * 4)
#define WS_CMID (WS_BAR + 16384ull)
#define WS_END (WS_CMID + 2ull * 16 * 64 * 128 * 4)

struct P {
  const float *x, *c, *ada_w, *ada_b, *ln_g, *ln_b, *e_w_in, *e_rpb, *gla_w_up, *gla_b, *gla_g, *e_w_out;
  const float *o_w_in, *hgrn_lb, *hgrn_g, *conv_w, *conv_b, *dt_bias, *a_log, *d_skip, *ssm_g, *o_w_out;
  float* out;
  unsigned char* ws;
};

__device__ __forceinline__ bf16 f2bf(float f) {
  __bf16 h = (__bf16)f;
  return *(bf16*)&h;
}
using u32x4 = __attribute__((ext_vector_type(4))) unsigned;
__device__ __forceinline__ u32x4 gload16_asm(const void* ptr) {
  u32x4 r;
  asm volatile("global_load_dwordx4 %0, %1, off" : "=v"(r) : "v"(ptr));
  return r;
}
__device__ __forceinline__ float bf2f(bf16 h) { return __uint_as_float(((unsigned)h) << 16); }
__device__ __forceinline__ float frcp(float x) { return __builtin_amdgcn_rcpf(x); }
__device__ __forceinline__ float silu_f(float v) { return v * frcp(1.f + __expf(-v)); }
__device__ __forceinline__ float sigmoid_f(float v) { return frcp(1.f + __expf(-v)); }
__device__ __forceinline__ float flog(float x) { return __builtin_amdgcn_logf(x) * 0.6931471805599453f; }
__device__ __forceinline__ float log_sigmoid_f(float z) { return fminf(z, 0.f) - flog(1.f + __expf(-fabsf(z))); }
__device__ __forceinline__ float softplus_f(float z) { return fmaxf(z, 0.f) + log1pf(__expf(-fabsf(z))); }
__device__ __forceinline__ float wave_sum(float v) {
#pragma unroll
  for (int o = 32; o > 0; o >>= 1) v += __shfl_xor(v, o, 64);
  return v;
}

__device__ __forceinline__ void transpose_item(const float* __restrict__ src, int N, bf16* __restrict__ dst, int li, unsigned char* smem) {
  float* tile = (float*)smem;
  const int tid = threadIdx.x;
  const int kt = li & 15, ntile = li >> 4;
#pragma unroll
  for (int i = 0; i < 16; ++i) {
    int row = i * 4 + (tid >> 6), col = tid & 63;
    int n = ntile * 64 + col;
    float v = (n < N) ? src[(size_t)(kt * 64 + row) * N + n] : 0.f;
    tile[row * 65 + col] = v;
  }
  __syncthreads();
#pragma unroll
  for (int i = 0; i < 16; ++i) {
    int r = i * 4 + (tid >> 6), cc = tid & 63;
    dst[(size_t)(ntile * 64 + r) * 1024 + kt * 64 + cc] = f2bf(tile[cc * 65 + r]);
  }
}

__device__ __forceinline__ void mod_item(const P& p, int idx, unsigned char* smem) {
  float* cond = (float*)smem;
  float* red = cond + 4096;
  const int tid = threadIdx.x;
  const int l = idx / 192, nc = idx % 192;
  for (int e = tid; e < 4096; e += 256) cond[e] = silu_f(p.c[e]);
  __syncthreads();
  const int kg = tid >> 4, col = tid & 15, n = nc * 16 + col;
  float a0 = 0.f, a1 = 0.f, a2 = 0.f, a3 = 0.f;
  const float* w = p.ada_w + (size_t)l * 1024 * 3072 + n;
#pragma unroll 16
  for (int k = kg * 64; k < kg * 64 + 64; ++k) {
    float wv = w[(size_t)k * 3072];
    a0 += cond[k] * wv; a1 += cond[1024 + k] * wv; a2 += cond[2048 + k] * wv; a3 += cond[3072 + k] * wv;
  }
  red[(kg * 4 + 0) * 16 + col] = a0; red[(kg * 4 + 1) * 16 + col] = a1;
  red[(kg * 4 + 2) * 16 + col] = a2; red[(kg * 4 + 3) * 16 + col] = a3;
  __syncthreads();
  if (tid < 64) {
    const int b = tid >> 4;
    float sum = 0.f;
#pragma unroll
    for (int q = 0; q < 16; ++q) sum += red[(q * 4 + b) * 16 + col];
    float* mod = (float*)(p.ws + WS_MOD);
    mod[(size_t)(l * 4 + b) * 3072 + n] = sum + p.ada_b[l * 3072 + n];
  }
}

__device__ __forceinline__ void phase_setup(const P& p, unsigned char* smem) {
  const int M0 = 384, T0 = M0 + 16 * 58, T1 = T0 + 256, T5 = T1 + 1;
  for (int rep = 0; rep < REP0; ++rep)
  for (int it = blockIdx.x; it < T5; it += gridDim.x) {
    if (it < M0) mod_item(p, it, smem);
    else if (it < T0) transpose_item(p.e_w_in, EVEN_N, (bf16*)(p.ws + WS_WEI), it - M0, smem);
    else if (it < T1) transpose_item(p.e_w_out, 1024, (bf16*)(p.ws + WS_WEO), it - T0, smem);
    else {
      float* lbv = (float*)(p.ws + WS_LB);
      for (int j = threadIdx.x; j < 512; j += 256) {
        float a = p.hgrn_lb[j], bb = p.hgrn_lb[512 + j];
        lbv[j] = 1.f / (1.f + __expf(a - bb));
      }
    }
    __syncthreads();
  }
}

__device__ __forceinline__ void phase_h0(const P& p) {
  const float* mod = (const float*)(p.ws + WS_MOD);
  bf16* hb = (bf16*)(p.ws + WS_H);
  const size_t total = (size_t)M_TOK * 128;
  for (size_t i = (size_t)blockIdx.x * 256 + threadIdx.x; i < total; i += (size_t)gridDim.x * 256) {
    int m = (int)(i >> 7), n = (int)(i & 127) * 8, b = m >> 12;
    const float4* xp = (const float4*)(p.x + (size_t)m * 1024 + n);
    const float4* sh = (const float4*)(mod + (size_t)b * 3072 + n);
    const float4* sc = (const float4*)(mod + (size_t)b * 3072 + 1024 + n);
    float4 x0 = xp[0], x1 = xp[1], s0 = sh[0], s1 = sh[1], c0 = sc[0], c1 = sc[1];
    uint4 o;
    o.x = (unsigned)f2bf(x0.x * (1.f + c0.x) + s0.x) | ((unsigned)f2bf(x0.y * (1.f + c0.y) + s0.y) << 16);
    o.y = (unsigned)f2bf(x0.z * (1.f + c0.z) + s0.z) | ((unsigned)f2bf(x0.w * (1.f + c0.w) + s0.w) << 16);
    o.z = (unsigned)f2bf(x1.x * (1.f + c1.x) + s1.x) | ((unsigned)f2bf(x1.y * (1.f + c1.y) + s1.y) << 16);
    o.w = (unsigned)f2bf(x1.z * (1.f + c1.z) + s1.z) | ((unsigned)f2bf(x1.w * (1.f + c1.w) + s1.w) << 16);
    *(uint4*)(hb + (size_t)m * 1024 + n) = o;
  }
}

#ifndef GEMM_NST
#define GEMM_NST 2
#endif
#define LSTR 64
template <int EPI>
__device__ __forceinline__ void gemm_tile(const bf16* __restrict__ A, const bf16* __restrict__ Bt, int m0, int n0,
                                          unsigned char* smem, bf16* __restrict__ C, int ldc, int nreal,
                                          const float* __restrict__ X, float* __restrict__ R, const float* __restrict__ gate,
                                          const float* __restrict__ ssqp = nullptr) {
  bf16* As = (bf16*)smem;
  bf16* Bs = As + 2 * 128 * LSTR;
  const int tid = threadIdx.x, lane = tid & 63, wave = tid >> 6;
  const int wm = wave >> 1, wn = wave & 1;
  f32x4 acc[4][4];
#pragma unroll
  for (int i = 0; i < 4; ++i)
#pragma unroll
    for (int j = 0; j < 4; ++j) acc[i][j] = (f32x4){0.f, 0.f, 0.f, 0.f};
  float rsv[4] = {1.f, 1.f, 1.f, 1.f};
  if (EPI == 2) {
#pragma unroll
    for (int j = 0; j < 4; ++j) {
      const int m = m0 + wm * 64 + j * 16 + (lane & 15);
      rsv[j] = rsqrtf((ssqp[m] + ssqp[M_TOK + m]) * (1.f / 512.f) + 1e-6f);
    }
  }
  u32x4 ra[GEMM_NST][4], rb[GEMM_NST][4];
  const int lrow = tid >> 3, lkc = tid & 7;
  const int lsw = (lkc ^ (lrow & 7)) * 8;
  const bf16* Ag = A + (size_t)(m0 + lrow) * 1024 + lkc * 8;
  const bf16* Bg = Bt + (size_t)(n0 + lrow) * 1024 + lkc * 8;
#pragma unroll
  for (int t = 0; t < GEMM_NST; ++t)
#pragma unroll
    for (int i = 0; i < 4; ++i) {
      ra[t][i] = gload16_asm(Ag + (size_t)i * 32 * 1024 + t * 64);
      rb[t][i] = gload16_asm(Bg + (size_t)i * 32 * 1024 + t * 64);
    }
  if (GEMM_NST == 3) {
    asm volatile("s_waitcnt vmcnt(16)"
                 : "+v"(ra[0][0]), "+v"(ra[0][1]), "+v"(ra[0][2]), "+v"(ra[0][3]), "+v"(rb[0][0]), "+v"(rb[0][1]), "+v"(rb[0][2]), "+v"(rb[0][3])
                 :: "memory");
  } else {
    asm volatile("s_waitcnt vmcnt(8)"
                 : "+v"(ra[0][0]), "+v"(ra[0][1]), "+v"(ra[0][2]), "+v"(ra[0][3]), "+v"(rb[0][0]), "+v"(rb[0][1]), "+v"(rb[0][2]), "+v"(rb[0][3])
                 :: "memory");
  }
#pragma unroll
  for (int i = 0; i < 4; ++i) {
    *(u32x4*)(As + (lrow + i * 32) * LSTR + lsw) = ra[0][i];
    *(u32x4*)(Bs + (lrow + i * 32) * LSTR + lsw) = rb[0][i];
  }
  __syncthreads();
#pragma unroll
  for (int kt = 0; kt < 16; ++kt) {
    const int buf = kt & 1;
    if (kt + 1 < 16) {
      const int sn = (kt + 1) % GEMM_NST;
      if (GEMM_NST == 3 && kt + 2 < 16) {
        asm volatile("s_waitcnt vmcnt(8)"
                     : "+v"(ra[sn][0]), "+v"(ra[sn][1]), "+v"(ra[sn][2]), "+v"(ra[sn][3]), "+v"(rb[sn][0]), "+v"(rb[sn][1]), "+v"(rb[sn][2]), "+v"(rb[sn][3])
                     :: "memory");
      } else {
        asm volatile("s_waitcnt vmcnt(0)"
                     : "+v"(ra[sn][0]), "+v"(ra[sn][1]), "+v"(ra[sn][2]), "+v"(ra[sn][3]), "+v"(rb[sn][0]), "+v"(rb[sn][1]), "+v"(rb[sn][2]), "+v"(rb[sn][3])
                     :: "memory");
      }
      bf16* Aw = As + (buf ^ 1) * 128 * LSTR;
      bf16* Bw = Bs + (buf ^ 1) * 128 * LSTR;
#pragma unroll
      for (int i = 0; i < 4; ++i) {
        *(u32x4*)(Aw + (lrow + i * 32) * LSTR + lsw) = ra[sn][i];
        *(u32x4*)(Bw + (lrow + i * 32) * LSTR + lsw) = rb[sn][i];
      }
    }
    if (kt + GEMM_NST < 16) {
#pragma unroll
      for (int i = 0; i < 4; ++i) {
        ra[kt % GEMM_NST][i] = gload16_asm(Ag + (size_t)i * 32 * 1024 + (kt + GEMM_NST) * 64);
        rb[kt % GEMM_NST][i] = gload16_asm(Bg + (size_t)i * 32 * 1024 + (kt + GEMM_NST) * 64);
      }
    }
    const bf16* Ab = As + buf * 128 * LSTR;
    const bf16* Bb = Bs + buf * 128 * LSTR;
    if (EPI == 2 && kt == 8) {
#pragma unroll
      for (int j = 0; j < 4; ++j) {
        const float inv = frcp(rsv[j]);
#pragma unroll
        for (int i = 0; i < 4; ++i) { acc[i][j][0] *= inv; acc[i][j][1] *= inv; acc[i][j][2] *= inv; acc[i][j][3] *= inv; }
      }
    }
#pragma unroll
    for (int s = 0; s < 2; ++s) {
      bf16x8 wf[4], xf[4];
#pragma unroll
      for (int i = 0; i < 4; ++i) {
        wf[i] = *(const bf16x8*)(Bb + (wn * 64 + i * 16 + (lane & 15)) * LSTR + (((s * 4 + (lane >> 4)) ^ (lane & 7)) * 8));
        xf[i] = *(const bf16x8*)(Ab + (wm * 64 + i * 16 + (lane & 15)) * LSTR + (((s * 4 + (lane >> 4)) ^ (lane & 7)) * 8));
      }
#pragma unroll
      for (int i = 0; i < 4; ++i)
#pragma unroll
        for (int j = 0; j < 4; ++j) acc[i][j] = __builtin_amdgcn_mfma_f32_16x16x32_bf16(wf[i], xf[j], acc[i][j], 0, 0, 0);
    }
    __syncthreads();
  }
#pragma unroll
  for (int i = 0; i < 4; ++i) {
    const int n = n0 + wn * 64 + i * 16 + (lane >> 4) * 4;
#pragma unroll
    for (int j = 0; j < 4; ++j) {
      const int m = m0 + wm * 64 + j * 16 + (lane & 15);
      f32x4 a = acc[i][j];
      if (EPI == 2) { a[0] *= rsv[j]; a[1] *= rsv[j]; a[2] *= rsv[j]; a[3] *= rsv[j]; }
      if (EPI == 0) {
        if (n < nreal) {
          uint2 o;
          o.x = (unsigned)f2bf(a[0]) | ((unsigned)f2bf(a[1]) << 16);
          o.y = (unsigned)f2bf(a[2]) | ((unsigned)f2bf(a[3]) << 16);
          *(uint2*)(C + (size_t)m * ldc + n) = o;
        }
      } else {
        const int b = m >> 12;
        float4 xv = *(const float4*)(X + (size_t)m * 1024 + n);
        float4 g = *(const float4*)(gate + (size_t)b * 3072 + n);
        float4 o;
        o.x = ALPHA * xv.x + g.x * a[0];
        o.y = ALPHA * xv.y + g.y * a[1];
        o.z = ALPHA * xv.z + g.z * a[2];
        o.w = ALPHA * xv.w + g.w * a[3];
        *(float4*)(R + (size_t)m * 1024 + n) = o;
      }
    }
  }
}

template <int EPI>
__device__ __forceinline__ void phase_gemm(const bf16* A, const bf16* Bt, int ntn, unsigned char* smem, bf16* C, int ldc, int nreal,
                           const float* X, float* R, const float* gate, unsigned* bar, int gidx, const float* ssqp = nullptr) {
  volatile unsigned* stw = (volatile unsigned*)(smem + 73728);
  const unsigned xid = (unsigned)__builtin_amdgcn_s_getreg((3 << 11) | 20) & 0xFu;
  int xidx = 0, nx = 0;
#pragma unroll
  for (int j = 0; j < 16; ++j) {
    const unsigned c = __hip_atomic_load(&bar[256 + 64 * j], __ATOMIC_RELAXED, __HIP_MEMORY_SCOPE_AGENT);
    if (c > 0u) { nx++; if ((unsigned)j < xid) xidx++; }
  }
  const int mt_lo = (xidx * 128) / nx, mt_hi = ((xidx + 1) * 128) / nx;
  const int total = (mt_hi - mt_lo) * ntn;
  unsigned* qc = bar + 3456 + (gidx * 16 + xidx) * 8;
  for (;;) {
    __syncthreads();
    if (threadIdx.x == 0) stw[2] = __hip_atomic_fetch_add(qc, 1u, __ATOMIC_RELAXED, __HIP_MEMORY_SCOPE_AGENT);
    __syncthreads();
    const int t = (int)stw[2];
    if (t >= total) break;
    const int g8 = t / (8 * ntn), r = t - g8 * 8 * ntn;
    int mt, nt;
    const int rows = mt_hi - mt_lo - g8 * 8;
    const int gm = rows < 8 ? rows : 8;
    nt = r / gm; mt = mt_lo + g8 * 8 + (r - nt * gm);
    gemm_tile<EPI>(A, Bt, mt * 128, nt * 128, smem, C, ldc, nreal, X, R, gate, ssqp);
  }
}

__device__ __forceinline__ void phase_ln(const P& p, int l, bool write_h, const unsigned char* probe_ts = nullptr) {
  const float* mod = (const float*)(p.ws + WS_MOD);
  bf16* hb = (bf16*)(p.ws + WS_H);
  const int lane = threadIdx.x & 63, wave = threadIdx.x >> 6;
  const float* g = p.ln_g + l * 1024;
  const float* bb = p.ln_b + l * 1024;
  for (int row = blockIdx.x * 4 + wave; row < M_TOK; row += gridDim.x * 4) {
    float* rp = p.out + (size_t)row * 1024;
    float4 v[4];
    float s = 0.f;
#pragma unroll
    for (int q = 0; q < 4; ++q) {
      v[q] = *(const float4*)(rp + (lane + 64 * q) * 4);
      s += v[q].x + v[q].y + v[q].z + v[q].w;
    }
    const float mu = wave_sum(s) * (1.f / 1024.f);
    float s2 = 0.f;
#pragma unroll
    for (int q = 0; q < 4; ++q) {
      float a = v[q].x - mu, b2 = v[q].y - mu, c2 = v[q].z - mu, d2 = v[q].w - mu;
      s2 += a * a + b2 * b2 + c2 * c2 + d2 * d2;
    }
    const float rstd = rsqrtf(wave_sum(s2) * (1.f / 1024.f) + 1e-5f);
    const int b = row >> 12;
#pragma unroll
    for (int q = 0; q < 4; ++q) {
      const int n = (lane + 64 * q) * 4;
      float4 gg = *(const float4*)(g + n), be = *(const float4*)(bb + n);
      float4 o;
      o.x = (v[q].x - mu) * rstd * gg.x + be.x;
      o.y = (v[q].y - mu) * rstd * gg.y + be.y;
      o.z = (v[q].z - mu) * rstd * gg.z + be.z;
      o.w = (v[q].w - mu) * rstd * gg.w + be.w;
      if (PROBE_PH >= 0 && l == 1 && row == 0) {
        const long long* ts = (const long long*)(probe_ts);
        const int kus = (int)((ts[PROBE_PH + 1] - ts[PROBE_PH]) / 100);
        if (n + 0 < kus) o.x += 0.125f;
        if (n + 1 < kus) o.y += 0.125f;
        if (n + 2 < kus) o.z += 0.125f;
        if (n + 3 < kus) o.w += 0.125f;
      }
      *(float4*)(rp + n) = o;
      if (write_h) {
        const float* md = mod + (size_t)(4 + b) * 3072;
        float4 sh = *(const float4*)(md + n), sc = *(const float4*)(md + 1024 + n);
        uint2 hh;
        hh.x = (unsigned)f2bf(o.x * (1.f + sc.x) + sh.x) | ((unsigned)f2bf(o.y * (1.f + sc.y) + sh.y) << 16);
        hh.y = (unsigned)f2bf(o.z * (1.f + sc.z) + sh.z) | ((unsigned)f2bf(o.w * (1.f + sc.w) + sh.w) << 16);
        *(uint2*)(hb + (size_t)row * 1024 + n) = hh;
      }
    }
  }
}

__device__ __forceinline__ void na_item(const P& p, int item, unsigned char* smem) {
  const int h = item & 7, r = (item >> 3) & 63, b = item >> 9;
  bf16* VT = (bf16*)smem;
  float* RPB = (float*)(VT + 64 * 520);
  const bf16* projb = (const bf16*)(p.ws + WS_PROJ) + (size_t)b * 4096 * EVEN_N;
  bf16* yb = (bf16*)(p.ws + WS_H);
  const int tid = threadIdx.x, lane = tid & 63, n = tid >> 6;
  const int q = lane & 15, g4 = lane >> 4;
  int rs = r - 4; rs = rs < 0 ? 0 : (rs > 56 ? 56 : rs);
#pragma unroll 4
  for (int i = 0; i < 16; ++i) {
    const int pair = i * 256 + tid, key = pair & 511, ch = pair >> 9;
    const int tok = (rs + (key >> 6)) * 64 + (key & 63);
    uint4 u = *(const uint4*)(projb + (size_t)tok * EVEN_N + 1024 + h * 64 + ch * 8);
    bf16* dst = VT + (ch * 8) * 520 + key;
    dst[0 * 520] = (bf16)(u.x & 0xffffu); dst[1 * 520] = (bf16)(u.x >> 16);
    dst[2 * 520] = (bf16)(u.y & 0xffffu); dst[3 * 520] = (bf16)(u.y >> 16);
    dst[4 * 520] = (bf16)(u.z & 0xffffu); dst[5 * 520] = (bf16)(u.z >> 16);
    dst[6 * 520] = (bf16)(u.w & 0xffffu); dst[7 * 520] = (bf16)(u.w >> 16);
  }
  for (int i = tid; i < 465; i += 256) RPB[i] = p.e_rpb[h * 465 + i];
  const int qcol = n * 16 + q;
  const int qtok = r * 64 + qcol;
  const int bs = n == 0 ? 0 : (n == 1 ? 8 : (n == 2 ? 24 : 32));
  const bf16x8 qf0 = *(const bf16x8*)(projb + (size_t)qtok * EVEN_N + h * 64 + g4 * 8);
  const bf16x8 qf1 = *(const bf16x8*)(projb + (size_t)qtok * EVEN_N + h * 64 + 32 + g4 * 8);
  f32x4 st[16];
#pragma unroll
  for (int tt = 0; tt < 16; ++tt) {
    const int ktok = (rs + (tt >> 1)) * 64 + bs + (tt & 1) * 16 + q;
    const bf16* kp = projb + (size_t)ktok * EVEN_N + 512 + h * 64 + g4 * 8;
    bf16x8 kf0 = *(const bf16x8*)kp, kf1 = *(const bf16x8*)(kp + 32);
    f32x4 z = (f32x4){0.f, 0.f, 0.f, 0.f};
    z = __builtin_amdgcn_mfma_f32_16x16x32_bf16(kf0, qf0, z, 0, 0, 0);
    st[tt] = __builtin_amdgcn_mfma_f32_16x16x32_bf16(kf1, qf1, z, 0, 0, 0);
  }
  __syncthreads();
  int cs = qcol - 8; cs = cs < 0 ? 0 : (cs > 48 ? 48 : cs);
  float mx = -1e30f;
#pragma unroll
  for (int tt = 0; tt < 16; ++tt) {
    const float* brow = RPB + (rs + (tt >> 1) - r + 7) * 31;
#pragma unroll
    for (int rr = 0; rr < 4; ++rr) {
      const int kcol = bs + (tt & 1) * 16 + g4 * 4 + rr;
      const bool valid = (kcol >= cs) && (kcol < cs + 16);
      int dc = kcol - qcol + 15; dc = dc < 0 ? 0 : (dc > 30 ? 30 : dc);
      const float sc = valid ? st[tt][rr] * 0.125f + brow[dc] : -1e30f;
      st[tt][rr] = sc;
      mx = fmaxf(mx, sc);
    }
  }
  mx = fmaxf(mx, __shfl_xor(mx, 16, 64));
  mx = fmaxf(mx, __shfl_xor(mx, 32, 64));
  float lsum = 0.f;
#pragma unroll
  for (int tt = 0; tt < 16; ++tt)
#pragma unroll
    for (int rr = 0; rr < 4; ++rr) {
      const float pe = __expf(st[tt][rr] - mx);
      st[tt][rr] = pe;
      lsum += pe;
    }
  lsum += __shfl_xor(lsum, 16, 64);
  lsum += __shfl_xor(lsum, 32, 64);
  f32x4 ot[4];
#pragma unroll
  for (int dt = 0; dt < 4; ++dt) ot[dt] = (f32x4){0.f, 0.f, 0.f, 0.f};
#pragma unroll
  for (int kr = 0; kr < 8; ++kr) {
    uint4 pw;
    pw.x = (unsigned)f2bf(st[2 * kr][0]) | ((unsigned)f2bf(st[2 * kr][1]) << 16);
    pw.y = (unsigned)f2bf(st[2 * kr][2]) | ((unsigned)f2bf(st[2 * kr][3]) << 16);
    pw.z = (unsigned)f2bf(st[2 * kr + 1][0]) | ((unsigned)f2bf(st[2 * kr + 1][1]) << 16);
    pw.w = (unsigned)f2bf(st[2 * kr + 1][2]) | ((unsigned)f2bf(st[2 * kr + 1][3]) << 16);
    const bf16x8 pf = *(bf16x8*)&pw;
#pragma unroll
    for (int dt = 0; dt < 4; ++dt) {
      const bf16* vp = VT + (dt * 16 + q) * 520 + kr * 64 + bs + g4 * 4;
      uint2 lo = *(const uint2*)vp, hi = *(const uint2*)(vp + 16);
      uint4 vw; vw.x = lo.x; vw.y = lo.y; vw.z = hi.x; vw.w = hi.y;
      ot[dt] = __builtin_amdgcn_mfma_f32_16x16x32_bf16(*(bf16x8*)&vw, pf, ot[dt], 0, 0, 0);
    }
  }
  const float inv = frcp(lsum);
#pragma unroll
  for (int dt = 0; dt < 4; ++dt) {
    const int d0 = dt * 16 + g4 * 4;
    uint2 gu = *(const uint2*)(projb + (size_t)qtok * EVEN_N + 1536 + h * 64 + d0);
    f32x4 y;
    y[0] = ot[dt][0] * inv * silu_f(__uint_as_float(gu.x << 16));
    y[1] = ot[dt][1] * inv * silu_f(__uint_as_float(gu.x & 0xffff0000u));
    y[2] = ot[dt][2] * inv * silu_f(__uint_as_float(gu.y << 16));
    y[3] = ot[dt][3] * inv * silu_f(__uint_as_float(gu.y & 0xffff0000u));
    uint2 o;
    o.x = (unsigned)f2bf(y[0]) | ((unsigned)f2bf(y[1]) << 16);
    o.y = (unsigned)f2bf(y[2]) | ((unsigned)f2bf(y[3]) << 16);
    *(uint2*)(yb + ((size_t)b * 4096 + qtok) * 1024 + h * 64 + d0) = o;
  }
}

template <int K, int MODE>
struct GateC {
  float w[16];
  float bias, lb;
  int d, ch;
  __device__ __forceinline__ void init(const P& p, int d_, int h, int k) {
    d = d_; ch = h * K + k;
    if (MODE == 0) {
#pragma unroll
      for (int r = 0; r < 16; ++r) w[r] = p.gla_w_up[(d * 16 + r) * 256 + ch];
      bias = p.gla_b[d * 256 + ch];
      lb = 0.f;
    } else {
      lb = ((const float*)(p.ws + WS_LB))[ch];
      bias = 0.f;
    }
  }
  __device__ __forceinline__ void eval_vals(bf16 a, bf16 bz, const bf16* lr, float& g, float& kval, float& qval) const {
    if (MODE == 0) {
      uint4 u0 = *(const uint4*)(lr);
      uint4 u1 = *(const uint4*)(lr + 8);
      float z = bias;
      z += w[0] * __uint_as_float(u0.x << 16) + w[1] * __uint_as_float(u0.x & 0xffff0000u);
      z += w[2] * __uint_as_float(u0.y << 16) + w[3] * __uint_as_float(u0.y & 0xffff0000u);
      z += w[4] * __uint_as_float(u0.z << 16) + w[5] * __uint_as_float(u0.z & 0xffff0000u);
      z += w[6] * __uint_as_float(u0.w << 16) + w[7] * __uint_as_float(u0.w & 0xffff0000u);
      z += w[8] * __uint_as_float(u1.x << 16) + w[9] * __uint_as_float(u1.x & 0xffff0000u);
      z += w[10] * __uint_as_float(u1.y << 16) + w[11] * __uint_as_float(u1.y & 0xffff0000u);
      z += w[12] * __uint_as_float(u1.z << 16) + w[13] * __uint_as_float(u1.z & 0xffff0000u);
      z += w[14] * __uint_as_float(u1.w << 16) + w[15] * __uint_as_float(u1.w & 0xffff0000u);
      g = log_sigmoid_f(z) * (1.f / 16.f);
      kval = bf2f(bz);
      qval = bf2f(a) * 0.125f;
    } else {
      const float z = bf2f(bz);
      const float e = __expf(-z);
      const float sg = frcp(1.f + e);
      kval = (1.f - lb) * e * sg;
      g = flog(1.f - kval);
      qval = bf2f(a) * 0.08838834764831845f;
    }
  }
  __device__ __forceinline__ void eval(const bf16* row, float& g, float& kval, float& qval) const {
    if (MODE == 0) {
      uint4 u0 = *(const uint4*)(row + 3584 + d * 16);
      uint4 u1 = *(const uint4*)(row + 3584 + d * 16 + 8);
      float z = bias;
      z += w[0] * __uint_as_float(u0.x << 16) + w[1] * __uint_as_float(u0.x & 0xffff0000u);
      z += w[2] * __uint_as_float(u0.y << 16) + w[3] * __uint_as_float(u0.y & 0xffff0000u);
      z += w[4] * __uint_as_float(u0.z << 16) + w[5] * __uint_as_float(u0.z & 0xffff0000u);
      z += w[6] * __uint_as_float(u0.w << 16) + w[7] * __uint_as_float(u0.w & 0xffff0000u);
      z += w[8] * __uint_as_float(u1.x << 16) + w[9] * __uint_as_float(u1.x & 0xffff0000u);
      z += w[10] * __uint_as_float(u1.y << 16) + w[11] * __uint_as_float(u1.y & 0xffff0000u);
      z += w[12] * __uint_as_float(u1.z << 16) + w[13] * __uint_as_float(u1.z & 0xffff0000u);
      z += w[14] * __uint_as_float(u1.w << 16) + w[15] * __uint_as_float(u1.w & 0xffff0000u);
      g = log_sigmoid_f(z) * (1.f / 16.f);
      kval = bf2f(row[2304 + ch]);
      qval = bf2f(row[2048 + ch]) * 0.125f;
    } else {
      const float z = bf2f(row[512 + d * 512 + ch]);
      const float e = __expf(-z);
      const float sg = frcp(1.f + e);
      kval = (1.f - lb) * e * sg;
      g = flog(1.f - kval);
      qval = bf2f(row[ch]) * 0.08838834764831845f;
    }
  }
};

template <int MODE>
__device__ __forceinline__ void stage_vt(const bf16* proj, int h, bf16* VT) {
  constexpr int LDP = MODE == 0 ? EVEN_N : ODD_N;
  constexpr int VOFF = MODE == 0 ? 2560 : 1536;
  const int j = threadIdx.x & 63, cgp = threadIdx.x >> 6;
#pragma unroll
  for (int cc = 0; cc < 4; ++cc) {
    const int c = cgp * 4 + cc;
    uint4 u = *(const uint4*)(proj + (size_t)j * LDP + VOFF + h * 128 + c * 8);
    bf16* dst = VT + (c * 8) * 72 + j;
    dst[0 * 72] = (bf16)(u.x & 0xffffu); dst[1 * 72] = (bf16)(u.x >> 16);
    dst[2 * 72] = (bf16)(u.y & 0xffffu); dst[3 * 72] = (bf16)(u.y >> 16);
    dst[4 * 72] = (bf16)(u.z & 0xffffu); dst[5 * 72] = (bf16)(u.z >> 16);
    dst[6 * 72] = (bf16)(u.w & 0xffffu); dst[7 * 72] = (bf16)(u.w >> 16);
  }
}

__device__ __forceinline__ uint2 pack4(f32x4 a) {
  uint2 o;
  o.x = (unsigned)f2bf(a[0]) | ((unsigned)f2bf(a[1]) << 16);
  o.y = (unsigned)f2bf(a[2]) | ((unsigned)f2bf(a[3]) << 16);
  return o;
}

template <int K, int MODE>
__device__ __forceinline__ void rec_pass1_item(const P& p, int item, unsigned char* smem) {
  constexpr int LDP = MODE == 0 ? EVEN_N : ODD_N;
  const int h = item & 3, blk = (item >> 2) & 63, b = item >> 8;
  bf16* KT = (bf16*)smem;
  bf16* VT = KT + 2 * K * 72;
  const bf16* proj = (const bf16*)(p.ws + WS_PROJ) + (size_t)(b * 4096 + blk * 64) * LDP;
  bf16* ST = (bf16*)(p.ws + WS_ST);
  float* DEC = (float*)(p.ws + WS_DEC);
  const int tid = threadIdx.x, lane = tid & 63, wave = tid >> 6;
  bf16* TMP = VT;
  if (MODE == 1) {
#pragma unroll
    for (int i = 0; i < 8; ++i) {
      const int c = i * 256 + tid;
      const int ch = c & 15, j = (c >> 4) & 63, d = c >> 10;
      *(uint4*)(TMP + (d * 64 + j) * 128 + ch * 8) = *(const uint4*)(proj + (size_t)j * LDP + 512 + d * 512 + h * 128 + ch * 8);
    }
  } else {
#pragma unroll
    for (int i = 0; i < 2; ++i) {
      const int c = i * 256 + tid;
      const int ch = c & 7, j = c >> 3;
      *(uint4*)(TMP + j * 64 + ch * 8) = *(const uint4*)(proj + (size_t)j * LDP + 2304 + h * 64 + ch * 8);
    }
    {
      const int ch = tid & 3, j = tid >> 2;
      *(uint4*)(TMP + 4096 + j * 32 + ch * 8) = *(const uint4*)(proj + (size_t)j * LDP + 3584 + ch * 8);
    }
  }
  __syncthreads();
  if (tid < 2 * K) {
    const int d = tid / K, k = tid % K;
    GateC<K, MODE> gc;
    gc.init(p, d, h, k);
    bf16* row = KT + (d * K + k) * 72;
    float r = 0.f, rhi = 0.f;
#pragma unroll 4
    for (int i = 63; i >= 0; --i) {
      const int j = d ? 63 - i : i;
      float g, kv, qv;
      if (MODE == 1) gc.eval_vals(0, TMP[(d * 64 + j) * 128 + k], nullptr, g, kv, qv);
      else gc.eval_vals(0, TMP[j * 64 + k], TMP + 4096 + j * 32 + d * 16, g, kv, qv);
      row[j] = f2bf(kv * __expf(r));
      r += g;
      if (i == 32) rhi = r;
    }
    DEC[(size_t)((((d * 4 + b) * 4 + h) * 64 + blk)) * K + k] = __expf(r);
    ((float*)(p.ws + WS_CMID))[(size_t)((((d * 4 + b) * 4 + h) * 64 + blk)) * K + k] = __expf(r - rhi);
  }
  __syncthreads();
  stage_vt<MODE>(proj, h, VT);
  __syncthreads();
#pragma unroll 1
  for (int d = 0; d < 2; ++d) {
    f32x4 acc[K / 16][2];
#pragma unroll
    for (int kt = 0; kt < K / 16; ++kt) { acc[kt][0] = (f32x4){0.f, 0.f, 0.f, 0.f}; acc[kt][1] = (f32x4){0.f, 0.f, 0.f, 0.f}; }
#pragma unroll
    for (int ks = 0; ks < 2; ++ks) {
      bf16x8 vf0 = *(const bf16x8*)(VT + ((wave * 2 + 0) * 16 + (lane & 15)) * 72 + ks * 32 + (lane >> 4) * 8);
      bf16x8 vf1 = *(const bf16x8*)(VT + ((wave * 2 + 1) * 16 + (lane & 15)) * 72 + ks * 32 + (lane >> 4) * 8);
#pragma unroll
      for (int kt = 0; kt < K / 16; ++kt) {
        bf16x8 kf = *(const bf16x8*)(KT + (d * K + kt * 16 + (lane & 15)) * 72 + ks * 32 + (lane >> 4) * 8);
        acc[kt][0] = __builtin_amdgcn_mfma_f32_16x16x32_bf16(kf, vf0, acc[kt][0], 0, 0, 0);
        acc[kt][1] = __builtin_amdgcn_mfma_f32_16x16x32_bf16(kf, vf1, acc[kt][1], 0, 0, 0);
      }
    }
    bf16* stb = ST + (size_t)((((d * 4 + b) * 4 + h) * 64 + blk)) * 128 * K;
#pragma unroll
    for (int kt = 0; kt < K / 16; ++kt)
#pragma unroll
      for (int vv = 0; vv < 2; ++vv) {
        const int v = (wave * 2 + vv) * 16 + (lane & 15);
        const int k0 = kt * 16 + (lane >> 4) * 4;
        *(uint2*)(stb + (size_t)v * K + k0) = pack4(acc[kt][vv]);
      }
  }
}

template <int K>
__device__ __forceinline__ void phase_rec_scan(const P& p) {
  bf16* ST = (bf16*)(p.ws + WS_ST);
  const float* DEC = (const float*)(p.ws + WS_DEC);
  const float* CMID = (const float*)(p.ws + WS_CMID);
  constexpr int KV = K / 4;
  const int total = 32 * 128 * KV;
  for (int idx = blockIdx.x * 256 + threadIdx.x; idx < total; idx += gridDim.x * 256) {
    const int kq = idx % KV, v = (idx / KV) & 127, s = idx / (KV * 128);
    const int d = s >> 4;
    float st0 = 0.f, st1 = 0.f, st2 = 0.f, st3 = 0.f;
#pragma unroll 1
    for (int n0 = 0; n0 < 64; n0 += 8) {
      uint2 u[8];
      float4 dc[8], cm[8];
#pragma unroll
      for (int q = 0; q < 8; ++q) {
        const int blk = d ? 63 - (n0 + q) : (n0 + q);
        u[q] = *(const uint2*)(ST + ((size_t)(s * 64 + blk) * 128 + v) * K + kq * 4);
        dc[q] = *(const float4*)(DEC + (size_t)(s * 64 + blk) * K + kq * 4);
        cm[q] = *(const float4*)(CMID + (size_t)(s * 64 + blk) * K + kq * 4);
      }
#pragma unroll
      for (int q = 0; q < 8; ++q) {
        const int blk = d ? 63 - (n0 + q) : (n0 + q);
        uint2 o;
        o.x = (unsigned)f2bf(st0 * cm[q].x) | ((unsigned)f2bf(st1 * cm[q].y) << 16);
        o.y = (unsigned)f2bf(st2 * cm[q].z) | ((unsigned)f2bf(st3 * cm[q].w) << 16);
        *(uint2*)(ST + ((size_t)(s * 64 + blk) * 128 + v) * K + kq * 4) = o;
        st0 = dc[q].x * st0 + __uint_as_float(u[q].x << 16);
        st1 = dc[q].y * st1 + __uint_as_float(u[q].x & 0xffff0000u);
        st2 = dc[q].z * st2 + __uint_as_float(u[q].y << 16);
        st3 = dc[q].w * st3 + __uint_as_float(u[q].y & 0xffff0000u);
      }
    }
  }
}

template <int K, int MODE>
__device__ __forceinline__ void rec_pass3_item(const P& p, int item, unsigned char* smem) {
  constexpr int LDP = MODE == 0 ? EVEN_N : ODD_N;
  constexpr int KS = K + 8;
  constexpr int GOFF = MODE == 0 ? 3072 : 2048;
  constexpr int YOFF = MODE == 0 ? 512 : 0;
  const int h = item & 3, blk = (item >> 2) & 63, b = item >> 8;
  bf16* QI = (bf16*)smem;
  bf16* KI = QI + 64 * KS;
  bf16* VT = KI + 64 * KS;
  bf16* AI = VT + 128 * 72;
  float* CV = (float*)(AI + 64 * 72);
  float* SSQ = CV + K;
  bf16* LRB = (bf16*)(SSQ + 256);
  const bf16* proj = (const bf16*)(p.ws + WS_PROJ) + (size_t)(b * 4096 + blk * 64) * LDP;
  const bf16* ST = (const bf16*)(p.ws + WS_ST);
  bf16* yb = (bf16*)(p.ws + WS_H);
  const int tid = threadIdx.x, lane = tid & 63, wave = tid >> 6;
  stage_vt<MODE>(proj, h, VT);
  f32x4 o[2][4];
#pragma unroll
  for (int vv = 0; vv < 2; ++vv)
#pragma unroll
    for (int it = 0; it < 4; ++it) o[vv][it] = (f32x4){0.f, 0.f, 0.f, 0.f};
#pragma unroll 1
  for (int d = 0; d < 2; ++d) {
    if (d) __syncthreads();
    const bf16* stb = ST + (size_t)((((d * 4 + b) * 4 + h) * 64 + blk)) * 128 * K;
    u32x4 stf[K / 32][2];
#pragma unroll
    for (int ks = 0; ks < K / 32; ++ks)
#pragma unroll
      for (int vv = 0; vv < 2; ++vv)
        stf[ks][vv] = gload16_asm(stb + (size_t)((wave * 2 + vv) * 16 + (lane & 15)) * K + ks * 32 + (lane >> 4) * 8);
    {
      constexpr int QOFF = MODE == 0 ? 2048 : 0;
      const int zoff = MODE == 0 ? 2304 : 512 + d * 512;
#pragma unroll
      for (int i = 0; i < K / 32; ++i) {
        const int c = i * 256 + tid;
        const int ch = c % (K / 8), j = c / (K / 8);
        *(uint4*)(QI + j * KS + ch * 8) = *(const uint4*)(proj + (size_t)j * LDP + QOFF + h * K + ch * 8);
        *(uint4*)(KI + j * KS + ch * 8) = *(const uint4*)(proj + (size_t)j * LDP + zoff + h * K + ch * 8);
      }
      if (MODE == 0 && tid < 128) {
        const int ch = tid & 1, j = tid >> 1;
        *(uint4*)(LRB + j * 16 + ch * 8) = *(const uint4*)(proj + (size_t)j * LDP + 3584 + d * 16 + ch * 8);
      }
    }
    __syncthreads();
    if (tid < 2 * K) {
      const int k = tid % K, half = tid / K;
      GateC<K, MODE> gc;
      gc.init(p, d, h, k);
      float run = 0.f;
      if (half) {
#pragma unroll 4
        for (int i = 32; i < 64; ++i) {
          const int j = d ? 63 - i : i;
          float g, kv, qv;
          gc.eval_vals(QI[j * KS + k], KI[j * KS + k], LRB + j * 16, g, kv, qv);
          run += g;
          QI[j * KS + k] = f2bf(qv * __expf(run));
          KI[j * KS + k] = f2bf(kv * __expf(-run));
        }
      } else {
#pragma unroll 4
        for (int i = 31; i >= 0; --i) {
          const int j = d ? 63 - i : i;
          float g, kv, qv;
          gc.eval_vals(QI[j * KS + k], KI[j * KS + k], LRB + j * 16, g, kv, qv);
          QI[j * KS + k] = f2bf(qv * __expf(-run));
          KI[j * KS + k] = f2bf(kv * __expf(run));
          run += g;
        }
        CV[k] = __expf(run);
      }
    }
    __syncthreads();
    {
      f32x4 a[4];
#pragma unroll
      for (int jt = 0; jt < 4; ++jt) a[jt] = (f32x4){0.f, 0.f, 0.f, 0.f};
#pragma unroll
      for (int ks = 0; ks < K / 32; ++ks) {
        bf16x8 qf = *(const bf16x8*)(QI + (wave * 16 + (lane & 15)) * KS + ks * 32 + (lane >> 4) * 8);
#pragma unroll
        for (int jt = 0; jt < 4; ++jt) {
          bf16x8 kf = *(const bf16x8*)(KI + (jt * 16 + (lane & 15)) * KS + ks * 32 + (lane >> 4) * 8);
          a[jt] = __builtin_amdgcn_mfma_f32_16x16x32_bf16(kf, qf, a[jt], 0, 0, 0);
        }
      }
      const int i = wave * 16 + (lane & 15);
#pragma unroll
      for (int jt = 0; jt < 4; ++jt) {
        const int j0 = jt * 16 + (lane >> 4) * 4;
        f32x4 m;
#pragma unroll
        for (int r = 0; r < 4; ++r) {
          const int j = j0 + r;
          const bool valid = d ? (j >= i) : (j <= i);
          m[r] = valid ? a[jt][r] : 0.f;
        }
        *(uint2*)(AI + i * 72 + j0) = pack4(m);
      }
    }
    __syncthreads();
#pragma unroll
    for (int ks = 0; ks < 2; ++ks) {
      bf16x8 vf0 = *(const bf16x8*)(VT + ((wave * 2 + 0) * 16 + (lane & 15)) * 72 + ks * 32 + (lane >> 4) * 8);
      bf16x8 vf1 = *(const bf16x8*)(VT + ((wave * 2 + 1) * 16 + (lane & 15)) * 72 + ks * 32 + (lane >> 4) * 8);
#pragma unroll
      for (int it = 0; it < 4; ++it) {
        bf16x8 af = *(const bf16x8*)(AI + (it * 16 + (lane & 15)) * 72 + ks * 32 + (lane >> 4) * 8);
        o[0][it] = __builtin_amdgcn_mfma_f32_16x16x32_bf16(vf0, af, o[0][it], 0, 0, 0);
        o[1][it] = __builtin_amdgcn_mfma_f32_16x16x32_bf16(vf1, af, o[1][it], 0, 0, 0);
      }
    }
    if (K == 128) {
      asm volatile("s_waitcnt vmcnt(0)"
                   : "+v"(stf[0][0]), "+v"(stf[0][1]), "+v"(stf[1][0]), "+v"(stf[1][1]), "+v"(stf[K / 32 - 2][0]), "+v"(stf[K / 32 - 2][1]), "+v"(stf[K / 32 - 1][0]), "+v"(stf[K / 32 - 1][1])
                   :: "memory");
    } else {
      asm volatile("s_waitcnt vmcnt(0)" : "+v"(stf[0][0]), "+v"(stf[0][1]), "+v"(stf[1][0]), "+v"(stf[1][1]) :: "memory");
    }
#pragma unroll
    for (int ks = 0; ks < K / 32; ++ks) {
      const int kk = ks * 32 + (lane >> 4) * 8;
      bf16x8 sf[2];
      sf[0] = *(bf16x8*)&stf[ks][0];
      sf[1] = *(bf16x8*)&stf[ks][1];
#pragma unroll
      for (int it = 0; it < 4; ++it) {
        bf16x8 qf = *(const bf16x8*)(QI + (it * 16 + (lane & 15)) * KS + kk);
        o[0][it] = __builtin_amdgcn_mfma_f32_16x16x32_bf16(sf[0], qf, o[0][it], 0, 0, 0);
        o[1][it] = __builtin_amdgcn_mfma_f32_16x16x32_bf16(sf[1], qf, o[1][it], 0, 0, 0);
      }
    }
  }
  {
    float ss[4];
#pragma unroll
    for (int it = 0; it < 4; ++it) {
      float s = 0.f;
#pragma unroll
      for (int vv = 0; vv < 2; ++vv)
#pragma unroll
        for (int r = 0; r < 4; ++r) s += o[vv][it][r] * o[vv][it][r];
      s += __shfl_xor(s, 16, 64);
      s += __shfl_xor(s, 32, 64);
      ss[it] = s;
    }
    if (lane < 16) {
#pragma unroll
      for (int it = 0; it < 4; ++it) SSQ[wave * 64 + it * 16 + lane] = ss[it];
    }
    __syncthreads();
    const float* gn = MODE == 0 ? p.gla_g : p.hgrn_g;
#pragma unroll
    for (int it = 0; it < 4; ++it) {
      const int i = it * 16 + (lane & 15);
      const float tot = SSQ[i] + SSQ[64 + i] + SSQ[128 + i] + SSQ[192 + i];
      const float rs = rsqrtf(tot * (1.f / 128.f) + 1e-6f);
#pragma unroll
      for (int vv = 0; vv < 2; ++vv) {
        const int v0 = (wave * 2 + vv) * 16 + (lane >> 4) * 4;
        uint2 gu = *(const uint2*)(proj + (size_t)i * LDP + GOFF + h * 128 + v0);
        float4 gg = *(const float4*)(gn + v0);
        f32x4 y;
        y[0] = o[vv][it][0] * rs * gg.x * silu_f(__uint_as_float(gu.x << 16));
        y[1] = o[vv][it][1] * rs * gg.y * silu_f(__uint_as_float(gu.x & 0xffff0000u));
        y[2] = o[vv][it][2] * rs * gg.z * silu_f(__uint_as_float(gu.y << 16));
        y[3] = o[vv][it][3] * rs * gg.w * silu_f(__uint_as_float(gu.y & 0xffff0000u));
        *(uint2*)(yb + (size_t)(b * 4096 + blk * 64 + i) * 1024 + YOFF + h * 128 + v0) = pack4(y);
      }
    }
  }
}

__device__ __forceinline__ void conv8(const P& p, const bf16* projb, int t, int c0, float* o8) {
  c0 = __builtin_amdgcn_readfirstlane(c0);
  float4 b0 = *(const float4*)(p.conv_b + c0), b1 = *(const float4*)(p.conv_b + c0 + 4);
  float a[8] = {b0.x, b0.y, b0.z, b0.w, b1.x, b1.y, b1.z, b1.w};
#pragma unroll
  for (int jt = 0; jt < 4; ++jt) {
    const int tt = t + jt - 2;
    if (tt >= 0 && tt < 4096) {
      uint4 u = *(const uint4*)(projb + (size_t)tt * ODD_N + 3072 + c0);
      float4 w0 = *(const float4*)(p.conv_w + jt * 1024 + c0), w1 = *(const float4*)(p.conv_w + jt * 1024 + c0 + 4);
      a[0] += w0.x * __uint_as_float(u.x << 16); a[1] += w0.y * __uint_as_float(u.x & 0xffff0000u);
      a[2] += w0.z * __uint_as_float(u.y << 16); a[3] += w0.w * __uint_as_float(u.y & 0xffff0000u);
      a[4] += w1.x * __uint_as_float(u.z << 16); a[5] += w1.y * __uint_as_float(u.z & 0xffff0000u);
      a[6] += w1.z * __uint_as_float(u.w << 16); a[7] += w1.w * __uint_as_float(u.w & 0xffff0000u);
    }
  }
#pragma unroll
  for (int e = 0; e < 8; ++e) o8[e] = silu_f(a[e]);
}

__device__ __forceinline__ void ssd_prep_acum(const P& p, const bf16* projb, int blk, int g, float* ACUM, float* DTV, float* TOT) {
  const int lane = threadIdx.x & 63, wave = threadIdx.x >> 6;
#pragma unroll
  for (int q = 0; q < 2; ++q) {
    const int c = wave * 2 + q, dir = c >> 2, rp = c & 3, head = g * 4 + rp;
    const int j = dir ? 63 - lane : lane;
    const int t = blk * 64 + j;
    const float dt = softplus_f(bf2f(projb[(size_t)t * ODD_N + 4096 + dir * 8 + head]) + p.dt_bias[dir * 8 + head]);
    float v = -__expf(p.a_log[dir * 8 + head]) * dt;
#pragma unroll
    for (int off = 1; off < 64; off <<= 1) {
      float tmp = __shfl_up(v, off, 64);
      if (lane >= off) v += tmp;
    }
    ACUM[c * 64 + j] = v;
    DTV[c * 64 + j] = dt;
    if (lane == 63) TOT[c] = v;
  }
}

__device__ __forceinline__ void ssd_pass1_item(const P& p, int item, unsigned char* smem) {
  const int g = item & 1, blk = (item >> 1) & 63, b = item >> 7;
  bf16* BT = (bf16*)smem;
  bf16* XT = BT + 128 * 72;
  float* ACUM = (float*)(XT + 256 * 72);
  float* DTV = ACUM + 512;
  float* TOT = DTV + 512;
  const bf16* projb = (const bf16*)(p.ws + WS_PROJ) + (size_t)b * 4096 * ODD_N;
  bf16* ST = (bf16*)(p.ws + WS_ST);
  float* DEC = (float*)(p.ws + WS_DEC);
  const int tid = threadIdx.x, lane = tid & 63, wave = tid >> 6;
  const int t = blk * 64 + lane;
  ssd_prep_acum(p, projb, blk, g, ACUM, DTV, TOT);
#pragma unroll 2
  for (int q = 0; q < 4; ++q) {
    const int cc = wave + 4 * q;
    float v8[8];
    conv8(p, projb, t, 512 + g * 128 + cc * 8, v8);
#pragma unroll
    for (int e = 0; e < 8; ++e) BT[(cc * 8 + e) * 72 + lane] = f2bf(v8[e]);
  }
  float xs[8][8];
#pragma unroll
  for (int q = 0; q < 8; ++q) conv8(p, projb, t, g * 256 + (wave * 8 + q) * 8, xs[q]);
  __syncthreads();
  if (tid < 8) {
    const int dir = tid >> 2, head = g * 4 + (tid & 3);
    DEC[(size_t)((dir * 4 + b) * 8 + head) * 64 + blk] = __expf(TOT[tid]);
  }
#pragma unroll 1
  for (int dir = 0; dir < 2; ++dir) {
    if (dir) __syncthreads();
    const int c = dir * 4 + wave;
    const float fac = DTV[c * 64 + lane] * __expf(TOT[c] - ACUM[c * 64 + lane]);
#pragma unroll
    for (int q = 0; q < 8; ++q)
#pragma unroll
      for (int e = 0; e < 8; ++e) XT[((wave * 8 + q) * 8 + e) * 72 + lane] = f2bf(xs[q][e] * fac);
    __syncthreads();
    const int head = g * 4 + wave;
    bf16* stb = ST + (size_t)(((dir * 4 + b) * 8 + head) * 64 + blk) * 8192;
#pragma unroll 1
    for (int nh = 0; nh < 4; ++nh) {
      f32x4 acc[2][4];
#pragma unroll
      for (int nt = 0; nt < 2; ++nt)
#pragma unroll
        for (int pt = 0; pt < 4; ++pt) acc[nt][pt] = (f32x4){0.f, 0.f, 0.f, 0.f};
#pragma unroll
      for (int ks = 0; ks < 2; ++ks) {
        bf16x8 xf[4];
#pragma unroll
        for (int pt = 0; pt < 4; ++pt) xf[pt] = *(const bf16x8*)(XT + (wave * 64 + pt * 16 + (lane & 15)) * 72 + ks * 32 + (lane >> 4) * 8);
#pragma unroll
        for (int nt = 0; nt < 2; ++nt) {
          bf16x8 bfv = *(const bf16x8*)(BT + ((nh * 2 + nt) * 16 + (lane & 15)) * 72 + ks * 32 + (lane >> 4) * 8);
#pragma unroll
          for (int pt = 0; pt < 4; ++pt) acc[nt][pt] = __builtin_amdgcn_mfma_f32_16x16x32_bf16(bfv, xf[pt], acc[nt][pt], 0, 0, 0);
        }
      }
#pragma unroll
      for (int nt = 0; nt < 2; ++nt)
#pragma unroll
        for (int pt = 0; pt < 4; ++pt) {
          const int pp = pt * 16 + (lane & 15);
          const int n0 = (nh * 2 + nt) * 16 + (lane >> 4) * 4;
          *(uint2*)(stb + (size_t)pp * 128 + n0) = pack4(acc[nt][pt]);
        }
    }
  }
}

__device__ __forceinline__ void phase_ssd_scan(const P& p) {
  bf16* ST = (bf16*)(p.ws + WS_ST);
  const float* DEC = (const float*)(p.ws + WS_DEC);
  const int total = 64 * 2048;
  for (int idx = blockIdx.x * 256 + threadIdx.x; idx < total; idx += gridDim.x * 256) {
    const int e4 = idx & 2047, s = idx >> 11;
    const int d = s >> 5;
    float st0 = 0.f, st1 = 0.f, st2 = 0.f, st3 = 0.f;
#pragma unroll 1
    for (int n0 = 0; n0 < 64; n0 += 8) {
      uint2 u[8];
      float dc[8];
#pragma unroll
      for (int q = 0; q < 8; ++q) {
        const int blk = d ? 63 - (n0 + q) : (n0 + q);
        u[q] = *(const uint2*)(ST + (size_t)(s * 64 + blk) * 8192 + e4 * 4);
        dc[q] = DEC[s * 64 + blk];
      }
#pragma unroll
      for (int q = 0; q < 8; ++q) {
        const int blk = d ? 63 - (n0 + q) : (n0 + q);
        uint2 o;
        o.x = (unsigned)f2bf(st0) | ((unsigned)f2bf(st1) << 16);
        o.y = (unsigned)f2bf(st2) | ((unsigned)f2bf(st3) << 16);
        *(uint2*)(ST + (size_t)(s * 64 + blk) * 8192 + e4 * 4) = o;
        st0 = dc[q] * st0 + __uint_as_float(u[q].x << 16);
        st1 = dc[q] * st1 + __uint_as_float(u[q].x & 0xffff0000u);
        st2 = dc[q] * st2 + __uint_as_float(u[q].y << 16);
        st3 = dc[q] * st3 + __uint_as_float(u[q].y & 0xffff0000u);
      }
    }
  }
}

__device__ __forceinline__ void ssd_pass3_item(const P& p, int item, unsigned char* smem) {
  const int g = item & 1, blk = (item >> 1) & 63, b = item >> 7;
  bf16* CI = (bf16*)smem;
  bf16* BI = CI + 64 * 136;
  bf16* AI = BI;
  bf16* XT = BI + 64 * 136;
  float* ACUM = (float*)(XT + 64 * 72);
  float* DTV = ACUM + 512;
  float* TOT = DTV + 512;
  float* SSQ = TOT + 8;
  const bf16* projb = (const bf16*)(p.ws + WS_PROJ) + (size_t)b * 4096 * ODD_N;
  const bf16* ST = (const bf16*)(p.ws + WS_ST);
  bf16* yb = (bf16*)(p.ws + WS_H);
  const int tid = threadIdx.x, lane = tid & 63, wave = tid >> 6;
  const int t = blk * 64 + lane;
  ssd_prep_acum(p, projb, blk, g, ACUM, DTV, TOT);
#pragma unroll 4
  for (int q = 0; q < 8; ++q) {
    const int cc = wave * 8 + q, which = cc >> 4, ch = (cc & 15) * 8;
    float v8[8];
    conv8(p, projb, t, 512 + which * 256 + g * 128 + ch, v8);
    uint4 w;
    w.x = (unsigned)f2bf(v8[0]) | ((unsigned)f2bf(v8[1]) << 16);
    w.y = (unsigned)f2bf(v8[2]) | ((unsigned)f2bf(v8[3]) << 16);
    w.z = (unsigned)f2bf(v8[4]) | ((unsigned)f2bf(v8[5]) << 16);
    w.w = (unsigned)f2bf(v8[6]) | ((unsigned)f2bf(v8[7]) << 16);
    *(uint4*)((which ? CI : BI) + lane * 136 + ch) = w;
  }
  __syncthreads();
  f32x4 gt[4];
#pragma unroll
  for (int jt = 0; jt < 4; ++jt) gt[jt] = (f32x4){0.f, 0.f, 0.f, 0.f};
#pragma unroll
  for (int ks = 0; ks < 4; ++ks) {
    bf16x8 cf = *(const bf16x8*)(CI + (wave * 16 + (lane & 15)) * 136 + ks * 32 + (lane >> 4) * 8);
#pragma unroll
    for (int jt = 0; jt < 4; ++jt) {
      bf16x8 bfv = *(const bf16x8*)(BI + (jt * 16 + (lane & 15)) * 136 + ks * 32 + (lane >> 4) * 8);
      gt[jt] = __builtin_amdgcn_mfma_f32_16x16x32_bf16(bfv, cf, gt[jt], 0, 0, 0);
    }
  }
  __syncthreads();
  float ssq_acc[4] = {0.f, 0.f, 0.f, 0.f};
#pragma unroll 1
  for (int rp = 0; rp < 4; ++rp) {
    const int head = g * 4 + rp;
#pragma unroll 2
    for (int q = 0; q < 2; ++q) {
      const int cc = wave * 2 + q;
      float v8[8];
      conv8(p, projb, t, head * 64 + cc * 8, v8);
#pragma unroll
      for (int e = 0; e < 8; ++e) XT[(cc * 8 + e) * 72 + lane] = f2bf(v8[e]);
    }
    f32x4 o[4];
#pragma unroll
    for (int it = 0; it < 4; ++it) o[it] = (f32x4){0.f, 0.f, 0.f, 0.f};
#pragma unroll 1
    for (int dir = 0; dir < 2; ++dir) {
      const int c = dir * 4 + rp;
      const bf16* stb = ST + (size_t)(((dir * 4 + b) * 8 + head) * 64 + blk) * 8192;
      u32x4 stf[4];
#pragma unroll
      for (int ks = 0; ks < 4; ++ks) stf[ks] = gload16_asm(stb + (size_t)(wave * 16 + (lane & 15)) * 128 + ks * 32 + (lane >> 4) * 8);
      {
        const int i = wave * 16 + (lane & 15);
        const float aci = ACUM[c * 64 + i];
#pragma unroll
        for (int jt = 0; jt < 4; ++jt) {
          const int j0 = jt * 16 + (lane >> 4) * 4;
          f32x4 m;
#pragma unroll
          for (int r = 0; r < 4; ++r) {
            const int j = j0 + r;
            const bool valid = dir ? (j >= i) : (j <= i);
            const float arg = fminf(aci - ACUM[c * 64 + j], 0.f);
            m[r] = valid ? gt[jt][r] * __expf(arg) * DTV[c * 64 + j] : 0.f;
          }
          *(uint2*)(AI + i * 72 + j0) = pack4(m);
        }
      }
      __syncthreads();
#pragma unroll
      for (int ks = 0; ks < 2; ++ks) {
        bf16x8 xf = *(const bf16x8*)(XT + (wave * 16 + (lane & 15)) * 72 + ks * 32 + (lane >> 4) * 8);
#pragma unroll
        for (int it = 0; it < 4; ++it) {
          bf16x8 af = *(const bf16x8*)(AI + (it * 16 + (lane & 15)) * 72 + ks * 32 + (lane >> 4) * 8);
          o[it] = __builtin_amdgcn_mfma_f32_16x16x32_bf16(xf, af, o[it], 0, 0, 0);
        }
      }
      f32x4 tI[4];
#pragma unroll
      for (int it = 0; it < 4; ++it) tI[it] = (f32x4){0.f, 0.f, 0.f, 0.f};
      asm volatile("s_waitcnt vmcnt(0)" : "+v"(stf[0]), "+v"(stf[1]), "+v"(stf[2]), "+v"(stf[3]) :: "memory");
#pragma unroll
      for (int ks = 0; ks < 4; ++ks) {
        bf16x8 sf = *(bf16x8*)&stf[ks];
#pragma unroll
        for (int it = 0; it < 4; ++it) {
          bf16x8 cf = *(const bf16x8*)(CI + (it * 16 + (lane & 15)) * 136 + ks * 32 + (lane >> 4) * 8);
          tI[it] = __builtin_amdgcn_mfma_f32_16x16x32_bf16(sf, cf, tI[it], 0, 0, 0);
        }
      }
#pragma unroll
      for (int it = 0; it < 4; ++it) {
        const float ea = __expf(ACUM[c * 64 + it * 16 + (lane & 15)]);
#pragma unroll
        for (int r = 0; r < 4; ++r) o[it][r] += ea * tI[it][r];
      }
      __syncthreads();
    }
    {
      const float dsk = p.d_skip[head];
      const int p0 = wave * 16 + (lane >> 4) * 4;
      float4 gg = *(const float4*)(p.ssm_g + head * 64 + p0);
#pragma unroll
      for (int it = 0; it < 4; ++it) {
        const int i = it * 16 + (lane & 15);
        const size_t tok = (size_t)b * 4096 + blk * 64 + i;
        uint2 zu = *(const uint2*)(projb + (size_t)(blk * 64 + i) * ODD_N + 2560 + head * 64 + p0);
        f32x4 y;
        y[0] = (o[it][0] + dsk * bf2f(XT[(p0 + 0) * 72 + i])) * silu_f(__uint_as_float(zu.x << 16));
        y[1] = (o[it][1] + dsk * bf2f(XT[(p0 + 1) * 72 + i])) * silu_f(__uint_as_float(zu.x & 0xffff0000u));
        y[2] = (o[it][2] + dsk * bf2f(XT[(p0 + 2) * 72 + i])) * silu_f(__uint_as_float(zu.y << 16));
        y[3] = (o[it][3] + dsk * bf2f(XT[(p0 + 3) * 72 + i])) * silu_f(__uint_as_float(zu.y & 0xffff0000u));
        ssq_acc[it] += y[0] * y[0] + y[1] * y[1] + y[2] * y[2] + y[3] * y[3];
        y[0] *= gg.x; y[1] *= gg.y; y[2] *= gg.z; y[3] *= gg.w;
        *(uint2*)(yb + tok * 1024 + 512 + head * 64 + p0) = pack4(y);
      }
    }
    __syncthreads();
  }
#pragma unroll
  for (int it = 0; it < 4; ++it) {
    float s = ssq_acc[it];
    s += __shfl_xor(s, 16, 64);
    s += __shfl_xor(s, 32, 64);
    if (lane < 16) SSQ[wave * 64 + it * 16 + lane] = s;
  }
  __syncthreads();
  if (tid < 64) {
    float* ssqp = (float*)(p.ws + WS_SSQ);
    ssqp[(size_t)g * M_TOK + (size_t)b * 4096 + blk * 64 + tid] = SSQ[tid] + SSQ[64 + tid] + SSQ[128 + tid] + SSQ[192 + tid];
  }
}

__device__ __forceinline__ void phase_ssd_norm(const P& p) {
  const float* ssqp = (const float*)(p.ws + WS_SSQ);
  bf16* yb = (bf16*)(p.ws + WS_H);
  const int total = M_TOK * 64;
  for (int idx = blockIdx.x * 256 + threadIdx.x; idx < total; idx += gridDim.x * 256) {
    const int tok = idx >> 6, c8 = (idx & 63) * 8;
    const float rs = rsqrtf((ssqp[tok] + ssqp[M_TOK + tok]) * (1.f / 512.f) + 1e-6f);
    uint4* ptr = (uint4*)(yb + (size_t)tok * 1024 + 512 + c8);
    uint4 u = *ptr, w;
    w.x = (unsigned)f2bf(__uint_as_float(u.x << 16) * rs) | ((unsigned)f2bf(__uint_as_float(u.x & 0xffff0000u) * rs) << 16);
    w.y = (unsigned)f2bf(__uint_as_float(u.y << 16) * rs) | ((unsigned)f2bf(__uint_as_float(u.y & 0xffff0000u) * rs) << 16);
    w.z = (unsigned)f2bf(__uint_as_float(u.z << 16) * rs) | ((unsigned)f2bf(__uint_as_float(u.z & 0xffff0000u) * rs) << 16);
    w.w = (unsigned)f2bf(__uint_as_float(u.w << 16) * rs) | ((unsigned)f2bf(__uint_as_float(u.w & 0xffff0000u) * rs) << 16);
    *ptr = w;
  }
}


#define XB_TMO      128
#define XB_XCNT(j)  (256  + 64 * (j))
#define XB_XSUB(j)  (1280 + 64 * (j))
#define XB_XGEN(j)  (2304 + 64 * (j))
#define XB_TOP      3328
#define XB_TOPGEN   3392
#define XCD_BAR_WORDS 3456
#define XB_SPIN_CAP (1u << 18)
#define LAS __attribute__((address_space(3)))
__device__ __forceinline__ unsigned xb_ld(unsigned* p) { return __hip_atomic_load(p, __ATOMIC_RELAXED, __HIP_MEMORY_SCOPE_AGENT); }
__device__ __forceinline__ unsigned xb_add(unsigned* p, unsigned v) { return __hip_atomic_fetch_add(p, v, __ATOMIC_RELAXED, __HIP_MEMORY_SCOPE_AGENT); }
__device__ __forceinline__ unsigned xb_xcc_id() { return (unsigned)__builtin_amdgcn_s_getreg((3 << 11) | 20) & 0xFu; }
#define XB_SPIN(cond, bar) do { unsigned _sp = 0; while (cond) { __builtin_amdgcn_s_sleep(1); \
    if ((++_sp & 255u) == 0u) { if (xb_ld(&(bar)[XB_TMO])) break; if (_sp > XB_SPIN_CAP) { atomicAdd(&(bar)[XB_TMO], 1u); break; } } } } while (0)
struct XcdBarrier { unsigned* bar; unsigned x; volatile LAS unsigned* st; };
__device__ __forceinline__ XcdBarrier xcd_barrier_post(unsigned* bar, volatile LAS unsigned* st) {
  XcdBarrier b; b.bar = bar; b.x = xb_xcc_id(); b.st = st;
  if (threadIdx.x == 0) (void)xb_add(&bar[XB_XCNT(b.x)], 1u);
  return b;
}
__device__ __forceinline__ void xcd_barrier_complete(unsigned* bar, unsigned x, unsigned& nloc, unsigned& nx) {
  const unsigned G = gridDim.x * gridDim.y * gridDim.z;
  unsigned sum, cnt, mine, sp = 0u;
  for (;;) {
    sum = 0u; cnt = 0u; mine = 0u;
#pragma unroll
    for (unsigned j = 0; j < 16; ++j) { const unsigned c = xb_ld(&bar[XB_XCNT(j)]); sum += c; cnt += (c > 0u) ? 1u : 0u; mine = (j == x) ? c : mine; }
    if (sum == G) break;
    __builtin_amdgcn_s_sleep(1);
    if ((++sp & 255u) == 0u) { if (xb_ld(&bar[XB_TMO])) break; if (sp > XB_SPIN_CAP) { atomicAdd(&bar[XB_TMO], 1u); break; } }
  }
  nloc = mine > 0u ? mine : 1u; nx = cnt > 0u ? cnt : 1u;
}
__device__ __forceinline__ void xcd_barrier(const XcdBarrier& b) {
  asm volatile("s_waitcnt vmcnt(0)" ::: "memory");
  __syncthreads();
  if (threadIdx.x == 0) {
    unsigned* bar = b.bar;
    __builtin_amdgcn_s_waitcnt(0);
    unsigned nloc = b.st[0], nx = b.st[1];
    if (nloc == 0u) { xcd_barrier_complete(bar, b.x, nloc, nx); b.st[0] = nloc; b.st[1] = nx; }
    const unsigned old = xb_add(&bar[XB_XSUB(b.x)], 1u);
    const unsigned gen = old / nloc;
    if (old + 1u == (gen + 1u) * nloc) {
      __builtin_amdgcn_fence(__ATOMIC_RELEASE, "agent");
      asm volatile("s_waitcnt vmcnt(0)" ::: "memory");
      const unsigned og = xb_add(&bar[XB_TOP], 1u);
      const unsigned tg = og / nx;
      if (og + 1u == (tg + 1u) * nx) xb_add(&bar[XB_TOPGEN], 1u);
      else XB_SPIN(xb_ld(&bar[XB_TOPGEN]) == tg, bar);
      __builtin_amdgcn_fence(__ATOMIC_ACQUIRE, "agent");
      xb_add(&bar[XB_XGEN(b.x)], 1u);
      asm volatile("s_waitcnt vmcnt(0)" ::: "memory");
    } else {
      XB_SPIN(xb_ld(&bar[XB_XGEN(b.x)]) == gen, bar);
      __builtin_amdgcn_fence(__ATOMIC_ACQUIRE, "agent");
      asm volatile("s_waitcnt vmcnt(0)" ::: "memory");
    }
  }
  __syncthreads();
}

#define NPHASE 17
__global__ void __launch_bounds__(256, 2) mega(P p, int ph_lo, int ph_hi) {
  __shared__ __align__(16) unsigned char smem[73728 + 16 + (PROBE_PH >= 0 ? 256 : 0)];
  cg::grid_group grid = cg::this_grid();
  if (ph_lo < 0) grid.sync();
  if (threadIdx.x == 0) *(uint4*)(smem + 73728) = make_uint4(0u, 0u, 0u, 0u);
  __syncthreads();
  XcdBarrier xb = xcd_barrier_post((unsigned*)(p.ws + WS_BAR), (volatile LAS unsigned*)(smem + 73728));
  const float* mod = (const float*)(p.ws + WS_MOD);
#define IN(k) (ph_lo <= (k) && (k) < ph_hi)
#define SYNC(k) if (IN(k) && (k) + 1 < ph_hi) { xcd_barrier(xb); if (PROBE_PH >= 0 && blockIdx.x == 0 && threadIdx.x == 0) ((long long*)(smem + 73744))[(k) + 1] = __builtin_amdgcn_s_memrealtime(); }
  if (PROBE_PH >= 0 && blockIdx.x == 0 && threadIdx.x == 0) ((long long*)(smem + 73744))[0] = __builtin_amdgcn_s_memrealtime();
  if (IN(0)) phase_setup(p, smem);
  SYNC(0)
  if (IN(1)) phase_h0(p);
  SYNC(1)
  if (IN(2))
    phase_gemm<0>((const bf16*)(p.ws + WS_H), (const bf16*)(p.ws + WS_WEI), EVEN_NP / 128, smem,
                  (bf16*)(p.ws + WS_PROJ), EVEN_N, EVEN_N, nullptr, nullptr, nullptr, (unsigned*)(p.ws + WS_BAR), 0);
  SYNC(2)
  if (IN(3)) {
    for (int it = blockIdx.x; it < 1024; it += gridDim.x) { rec_pass1_item<64, 0>(p, it, smem); __syncthreads(); }
  }
  SYNC(3)
  if (IN(4)) {
    phase_rec_scan<64>(p);
    for (int it = blockIdx.x; it < 2048 * REPN + 16 * 66 + 256; it += gridDim.x) {
      if (it < 2048 * REPN) na_item(p, it & 2047, smem);
      else if (it < 2048 * REPN + 16 * 66) transpose_item(p.o_w_in, ODD_N, (bf16*)(p.ws + WS_WOI), it - 2048 * REPN, smem);
      else transpose_item(p.o_w_out, 1024, (bf16*)(p.ws + WS_WOO), it - 2048 * REPN - 16 * 66, smem);
      __syncthreads();
    }
  }
  SYNC(4)
  if (IN(5)) {
    for (int it = blockIdx.x; it < 1024 * REPR; it += gridDim.x) { rec_pass3_item<64, 0>(p, it & 1023, smem); __syncthreads(); }
  }
  SYNC(5)
  if (IN(6))
    phase_gemm<1>((const bf16*)(p.ws + WS_H), (const bf16*)(p.ws + WS_WEO), 8, smem, nullptr, 0, 0, p.x, p.out,
                  mod + 2048, (unsigned*)(p.ws + WS_BAR), 1);
  SYNC(6)
  if (IN(7)) phase_ln(p, 0, true);
  SYNC(7)
  if (IN(8))
    phase_gemm<0>((const bf16*)(p.ws + WS_H), (const bf16*)(p.ws + WS_WOI), ODD_NP / 128, smem,
                  (bf16*)(p.ws + WS_PROJ), ODD_N, ODD_N, nullptr, nullptr, nullptr, (unsigned*)(p.ws + WS_BAR), 2);
  SYNC(8)
  if (IN(9)) {
    for (int it = blockIdx.x; it < 1024 * REPR; it += gridDim.x) { rec_pass1_item<128, 1>(p, it & 1023, smem); __syncthreads(); }
  }
  SYNC(9)
  if (IN(10)) phase_rec_scan<128>(p);
  SYNC(10)
  if (IN(11)) {
    for (int it = blockIdx.x; it < 1024 * REP3 * REPR; it += gridDim.x) { rec_pass3_item<128, 1>(p, it & 1023, smem); __syncthreads(); }
  }
  SYNC(11)
  if (IN(12)) {
    for (int it = blockIdx.x; it < 512 * REPS; it += gridDim.x) { ssd_pass1_item(p, it & 511, smem); __syncthreads(); }
  }
  SYNC(12)
  if (IN(13)) phase_ssd_scan(p);
  SYNC(13)
  if (IN(14)) {
    for (int it = blockIdx.x; it < 512 * REPS; it += gridDim.x) { ssd_pass3_item(p, it & 511, smem); __syncthreads(); }
  }
  SYNC(14)
  if (IN(15))
    phase_gemm<2>((const bf16*)(p.ws + WS_H), (const bf16*)(p.ws + WS_WOO), 8, smem, nullptr, 0, 0, p.out, p.out,
                  mod + 4 * 3072 + 2048, (unsigned*)(p.ws + WS_BAR), 3, (const float*)(p.ws + WS_SSQ));
  SYNC(15)
  if (IN(16)) phase_ln(p, 1, false, smem + 73744);
}

extern "C" void kernel_launch(void* const* d_in, const int* in_sizes, int n_in, void* d_out, int out_size, void* d_ws,
                              size_t ws_size, hipStream_t stream) {
  static int grid_blocks = 0;
  if (!grid_blocks) {
    int dev = 0, cus = 0, per_cu = 0;
    hipGetDevice(&dev);
    hipDeviceGetAttribute(&cus, hipDeviceAttributeMultiprocessorCount, dev);
    hipOccupancyMaxActiveBlocksPerMultiprocessor(&per_cu, mega, 256, 0);
    if (per_cu < 1) per_cu = 1;
    if (per_cu > 2) per_cu = 2;
    grid_blocks = cus * per_cu;
    if (n_in != 22 || ws_size < WS_END) {
      fprintf(stderr, "kernel_launch: unexpected n_in %d / ws_size %zu (need %llu)\n", n_in, ws_size, (unsigned long long)WS_END);
      grid_blocks = -1;
    }
  }
  if (grid_blocks < 0) return;
  P p{};
  const float** f = (const float**)&p;
  for (int i = 0; i < 22; ++i) f[i] = (const float*)d_in[i];
  p.out = (float*)d_out;
  p.ws = (unsigned char*)d_ws;
#if 1
  if (hipMemsetAsync((char*)d_ws + WS_BAR, 0, 16384, stream) != hipSuccess) { fprintf(stderr, "memset of barrier words failed\n"); return; }
  int lo = 0, hi = NPHASE;
  void* args[] = {&p, &lo, &hi};
  hipError_t e = hipLaunchCooperativeKernel((void*)mega, dim3(grid_blocks), dim3(256), args, 0, stream);
  if (e != hipSuccess) fprintf(stderr, "cooperative launch failed: %s (grid %d)\n", hipGetErrorString(e), grid_blocks);
#else
  for (int ph = 0; ph < NPHASE; ++ph) hipLaunchKernelGGL(mega, dim3(grid_blocks), dim3(256), 0, stream, p, ph, ph + 1);
#endif
}
```

```cpp
#include <hip/hip_runtime.h>
#include <hip/hip_cooperative_groups.h>
#include <cstdio>
namespace cg = cooperative_groups;

typedef unsigned short bf16;
using bf16x8 = __attribute__((ext_vector_type(8))) short;
using f32x4 = __attribute__((ext_vector_type(4))) float;

#define M_TOK 16384
#define DM 1024
#define SEQ 4096
#define EVEN_N 3616
#define EVEN_NP 3712
#define ODD_N 4112
#define ODD_NP 4224
#define ALPHA 1.4142135623730951f
#ifndef PROBE_PH
#define PROBE_PH -1
#endif
#ifndef REPG
#define REPG 1
#endif
#ifndef REPN
#define REPN 1
#endif
#ifndef REP3
#define REP3 1
#endif
#ifndef REPS
#define REPS 1
#endif
#ifndef REP0
#define REP0 1
#endif
#ifndef REPR
#define REPR 1
#endif

#define WS_MOD 0ull
#define WS_LB (WS_MOD + 98304ull)
#define WS_WEI (WS_LB + 2048ull)
#define WS_WEO (WS_WEI + 3712ull * 2048)
#define WS_WOI (WS_WEO + 1024ull * 2048)
#define WS_WOO (WS_WOI + 4224ull * 2048)
#define WS_H (WS_WOO + 1024ull * 2048)
#define WS_PROJ (WS_H + 16384ull * 2048)
#define WS_O (WS_PROJ + 16384ull * 4112 * 2)
#define WS_ST WS_O
#define WS_DEC (WS_O + 2ull * 16384 * 512 * 4)
#define WS_SSQ (WS_DEC + 2ull * 16 * 64 * 128 * 4)
#define WS_BAR (WS_SSQ + 2ull * 16384 * 4)
#define WS_CMID (WS_BAR + 16384ull)
#define WS_DECS (WS_CMID + 2ull * 16 * 64 * 128 * 4)
#define WS_END (WS_DECS + 16384ull)

struct P {
  const float *x, *c, *ada_w, *ada_b, *ln_g, *ln_b, *e_w_in, *e_rpb, *gla_w_up, *gla_b, *gla_g, *e_w_out;
  const float *o_w_in, *hgrn_lb, *hgrn_g, *conv_w, *conv_b, *dt_bias, *a_log, *d_skip, *ssm_g, *o_w_out;
  float* out;
  unsigned char* ws;
};

__device__ __forceinline__ bf16 f2bf(float f) {
  __bf16 h = (__bf16)f;
  return *(bf16*)&h;
}
using u32x4 = __attribute__((ext_vector_type(4))) unsigned;
__device__ __forceinline__ u32x4 gload16_asm(const void* ptr) {
  u32x4 r;
  asm volatile("global_load_dwordx4 %0, %1, off" : "=v"(r) : "v"(ptr));
  return r;
}
__device__ __forceinline__ float bf2f(bf16 h) { return __uint_as_float(((unsigned)h) << 16); }
__device__ __forceinline__ float frcp(float x) { return __builtin_amdgcn_rcpf(x); }
__device__ __forceinline__ float silu_f(float v) { return v * frcp(1.f + __expf(-v)); }
__device__ __forceinline__ float sigmoid_f(float v) { return frcp(1.f + __expf(-v)); }
__device__ __forceinline__ float flog(float x) { return __builtin_amdgcn_logf(x) * 0.6931471805599453f; }
__device__ __forceinline__ float log_sigmoid_f(float z) { return fminf(z, 0.f) - flog(1.f + __expf(-fabsf(z))); }
__device__ __forceinline__ float softplus_f(float z) { return fmaxf(z, 0.f) + log1pf(__expf(-fabsf(z))); }
__device__ __forceinline__ float wave_sum(float v) {
#pragma unroll
  for (int o = 32; o > 0; o >>= 1) v += __shfl_xor(v, o, 64);
  return v;
}

__device__ __forceinline__ void transpose_item(const float* __restrict__ src, int N, bf16* __restrict__ dst, int li, unsigned char* smem) {
  float* tile = (float*)smem;
  const int tid = threadIdx.x;
  const int kt = li & 15, ntile = li >> 4;
#pragma unroll
  for (int i = 0; i < 16; ++i) {
    int row = i * 4 + (tid >> 6), col = tid & 63;
    int n = ntile * 64 + col;
    float v = (n < N) ? src[(size_t)(kt * 64 + row) * N + n] : 0.f;
    tile[row * 65 + col] = v;
  }
  __syncthreads();
#pragma unroll
  for (int i = 0; i < 16; ++i) {
    int r = i * 4 + (tid >> 6), cc = tid & 63;
    dst[(size_t)(ntile * 64 + r) * 1024 + kt * 64 + cc] = f2bf(tile[cc * 65 + r]);
  }
}

__device__ __forceinline__ void mod_item(const P& p, int idx, unsigned char* smem) {
  float* cond = (float*)smem;
  float* red = cond + 4096;
  const int tid = threadIdx.x;
  const int l = idx / 192, nc = idx % 192;
  for (int e = tid; e < 4096; e += 256) cond[e] = silu_f(p.c[e]);
  __syncthreads();
  const int kg = tid >> 4, col = tid & 15, n = nc * 16 + col;
  float a0 = 0.f, a1 = 0.f, a2 = 0.f, a3 = 0.f;
  const float* w = p.ada_w + (size_t)l * 1024 * 3072 + n;
#pragma unroll 16
  for (int k = kg * 64; k < kg * 64 + 64; ++k) {
    float wv = w[(size_t)k * 3072];
    a0 += cond[k] * wv; a1 += cond[1024 + k] * wv; a2 += cond[2048 + k] * wv; a3 += cond[3072 + k] * wv;
  }
  red[(kg * 4 + 0) * 16 + col] = a0; red[(kg * 4 + 1) * 16 + col] = a1;
  red[(kg * 4 + 2) * 16 + col] = a2; red[(kg * 4 + 3) * 16 + col] = a3;
  __syncthreads();
  if (tid < 64) {
    const int b = tid >> 4;
    float sum = 0.f;
#pragma unroll
    for (int q = 0; q < 16; ++q) sum += red[(q * 4 + b) * 16 + col];
    float* mod = (float*)(p.ws + WS_MOD);
    mod[(size_t)(l * 4 + b) * 3072 + n] = sum + p.ada_b[l * 3072 + n];
  }
}

__device__ __forceinline__ void phase_setup(const P& p, unsigned char* smem) {
  const int M0 = 384, T0 = M0 + 16 * 58, T1 = T0 + 256, T5 = T1 + 1;
  for (int rep = 0; rep < REP0; ++rep)
  for (int it = blockIdx.x; it < T5; it += gridDim.x) {
    if (it < M0) mod_item(p, it, smem);
    else if (it < T0) transpose_item(p.e_w_in, EVEN_N, (bf16*)(p.ws + WS_WEI), it - M0, smem);
    else if (it < T1) transpose_item(p.e_w_out, 1024, (bf16*)(p.ws + WS_WEO), it - T0, smem);
    else {
      float* lbv = (float*)(p.ws + WS_LB);
      for (int j = threadIdx.x; j < 512; j += 256) {
        float a = p.hgrn_lb[j], bb = p.hgrn_lb[512 + j];
        lbv[j] = 1.f / (1.f + __expf(a - bb));
      }
    }
    __syncthreads();
  }
}

__device__ __forceinline__ void phase_h0(const P& p) {
  const float* mod = (const float*)(p.ws + WS_MOD);
  bf16* hb = (bf16*)(p.ws + WS_H);
  const size_t total = (size_t)M_TOK * 128;
  for (size_t i = (size_t)blockIdx.x * 256 + threadIdx.x; i < total; i += (size_t)gridDim.x * 256) {
    int m = (int)(i >> 7), n = (int)(i & 127) * 8, b = m >> 12;
    const float4* xp = (const float4*)(p.x + (size_t)m * 1024 + n);
    const float4* sh = (const float4*)(mod + (size_t)b * 3072 + n);
    const float4* sc = (const float4*)(mod + (size_t)b * 3072 + 1024 + n);
    float4 x0 = xp[0], x1 = xp[1], s0 = sh[0], s1 = sh[1], c0 = sc[0], c1 = sc[1];
    uint4 o;
    o.x = (unsigned)f2bf(x0.x * (1.f + c0.x) + s0.x) | ((unsigned)f2bf(x0.y * (1.f + c0.y) + s0.y) << 16);
    o.y = (unsigned)f2bf(x0.z * (1.f + c0.z) + s0.z) | ((unsigned)f2bf(x0.w * (1.f + c0.w) + s0.w) << 16);
    o.z = (unsigned)f2bf(x1.x * (1.f + c1.x) + s1.x) | ((unsigned)f2bf(x1.y * (1.f + c1.y) + s1.y) << 16);
    o.w = (unsigned)f2bf(x1.z * (1.f + c1.z) + s1.z) | ((unsigned)f2bf(x1.w * (1.f + c1.w) + s1.w) << 16);
    *(uint4*)(hb + (size_t)m * 1024 + n) = o;
  }
}

#ifndef GEMM_NST
#define GEMM_NST 2
#endif
#define LSTR 64
template <int EPI>
__device__ __forceinline__ void gemm_tile(const bf16* __restrict__ A, int lda, const bf16* __restrict__ Bt, int m0, int n0,
                                          unsigned char* smem, bf16* __restrict__ C, int ldc, int nreal,
                                          const float* __restrict__ X, float* __restrict__ R, const float* __restrict__ gate,
                                          const float* __restrict__ ssqp = nullptr) {
  bf16* As = (bf16*)smem;
  bf16* Bs = As + 2 * 128 * LSTR;
  const int tid = threadIdx.x, lane = tid & 63, wave = tid >> 6;
  const int wm = wave >> 1, wn = wave & 1;
  f32x4 acc[4][4];
#pragma unroll
  for (int i = 0; i < 4; ++i)
#pragma unroll
    for (int j = 0; j < 4; ++j) acc[i][j] = (f32x4){0.f, 0.f, 0.f, 0.f};
  float rsv[4] = {1.f, 1.f, 1.f, 1.f};
  if (EPI == 2) {
#pragma unroll
    for (int j = 0; j < 4; ++j) {
      const int m = m0 + wm * 64 + j * 16 + (lane & 15);
      rsv[j] = rsqrtf((ssqp[m] + ssqp[M_TOK + m]) * (1.f / 512.f) + 1e-6f);
    }
  }
  u32x4 ra[GEMM_NST][4], rb[GEMM_NST][4];
  const int lrow = tid >> 3, lkc = tid & 7;
  const int lsw = (lkc ^ (lrow & 7)) * 8;
  const bf16* Ag = A + (size_t)(m0 + lrow) * lda + lkc * 8;
  const bf16* Bg = Bt + (size_t)(n0 + lrow) * 1024 + lkc * 8;
#pragma unroll
  for (int t = 0; t < GEMM_NST; ++t)
#pragma unroll
    for (int i = 0; i < 4; ++i) {
      ra[t][i] = gload16_asm(Ag + (size_t)i * 32 * lda + t * 64);
      rb[t][i] = gload16_asm(Bg + (size_t)i * 32 * 1024 + t * 64);
    }
  if (GEMM_NST == 3) {
    asm volatile("s_waitcnt vmcnt(16)"
                 : "+v"(ra[0][0]), "+v"(ra[0][1]), "+v"(ra[0][2]), "+v"(ra[0][3]), "+v"(rb[0][0]), "+v"(rb[0][1]), "+v"(rb[0][2]), "+v"(rb[0][3])
                 :: "memory");
  } else {
    asm volatile("s_waitcnt vmcnt(8)"
                 : "+v"(ra[0][0]), "+v"(ra[0][1]), "+v"(ra[0][2]), "+v"(ra[0][3]), "+v"(rb[0][0]), "+v"(rb[0][1]), "+v"(rb[0][2]), "+v"(rb[0][3])
                 :: "memory");
  }
#pragma unroll
  for (int i = 0; i < 4; ++i) {
    *(u32x4*)(As + (lrow + i * 32) * LSTR + lsw) = ra[0][i];
    *(u32x4*)(Bs + (lrow + i * 32) * LSTR + lsw) = rb[0][i];
  }
  __syncthreads();
#pragma unroll
  for (int kt = 0; kt < 16; ++kt) {
    const int buf = kt & 1;
    if (kt + 1 < 16) {
      const int sn = (kt + 1) % GEMM_NST;
      if (GEMM_NST == 3 && kt + 2 < 16) {
        asm volatile("s_waitcnt vmcnt(8)"
                     : "+v"(ra[sn][0]), "+v"(ra[sn][1]), "+v"(ra[sn][2]), "+v"(ra[sn][3]), "+v"(rb[sn][0]), "+v"(rb[sn][1]), "+v"(rb[sn][2]), "+v"(rb[sn][3])
                     :: "memory");
      } else {
        asm volatile("s_waitcnt vmcnt(0)"
                     : "+v"(ra[sn][0]), "+v"(ra[sn][1]), "+v"(ra[sn][2]), "+v"(ra[sn][3]), "+v"(rb[sn][0]), "+v"(rb[sn][1]), "+v"(rb[sn][2]), "+v"(rb[sn][3])
                     :: "memory");
      }
      bf16* Aw = As + (buf ^ 1) * 128 * LSTR;
      bf16* Bw = Bs + (buf ^ 1) * 128 * LSTR;
#pragma unroll
      for (int i = 0; i < 4; ++i) {
        *(u32x4*)(Aw + (lrow + i * 32) * LSTR + lsw) = ra[sn][i];
        *(u32x4*)(Bw + (lrow + i * 32) * LSTR + lsw) = rb[sn][i];
      }
    }
    if (kt + GEMM_NST < 16) {
#pragma unroll
      for (int i = 0; i < 4; ++i) {
        ra[kt % GEMM_NST][i] = gload16_asm(Ag + (size_t)i * 32 * lda + (kt + GEMM_NST) * 64);
        rb[kt % GEMM_NST][i] = gload16_asm(Bg + (size_t)i * 32 * 1024 + (kt + GEMM_NST) * 64);
      }
    }
    const bf16* Ab = As + buf * 128 * LSTR;
    const bf16* Bb = Bs + buf * 128 * LSTR;
    if (EPI == 2 && kt == 8) {
#pragma unroll
      for (int j = 0; j < 4; ++j) {
        const float inv = frcp(rsv[j]);
#pragma unroll
        for (int i = 0; i < 4; ++i) { acc[i][j][0] *= inv; acc[i][j][1] *= inv; acc[i][j][2] *= inv; acc[i][j][3] *= inv; }
      }
    }
#pragma unroll
    for (int s = 0; s < 2; ++s) {
      bf16x8 wf[4], xf[4];
#pragma unroll
      for (int i = 0; i < 4; ++i) {
        wf[i] = *(const bf16x8*)(Bb + (wn * 64 + i * 16 + (lane & 15)) * LSTR + (((s * 4 + (lane >> 4)) ^ (lane & 7)) * 8));
        xf[i] = *(const bf16x8*)(Ab + (wm * 64 + i * 16 + (lane & 15)) * LSTR + (((s * 4 + (lane >> 4)) ^ (lane & 7)) * 8));
      }
#pragma unroll
      for (int i = 0; i < 4; ++i)
#pragma unroll
        for (int j = 0; j < 4; ++j) acc[i][j] = __builtin_amdgcn_mfma_f32_16x16x32_bf16(wf[i], xf[j], acc[i][j], 0, 0, 0);
    }
    __syncthreads();
  }
#pragma unroll
  for (int i = 0; i < 4; ++i) {
    const int n = n0 + wn * 64 + i * 16 + (lane >> 4) * 4;
#pragma unroll
    for (int j = 0; j < 4; ++j) {
      const int m = m0 + wm * 64 + j * 16 + (lane & 15);
      f32x4 a = acc[i][j];
      if (EPI == 2) { a[0] *= rsv[j]; a[1] *= rsv[j]; a[2] *= rsv[j]; a[3] *= rsv[j]; }
      if (EPI == 0) {
        if (n < nreal) {
          uint2 o;
          o.x = (unsigned)f2bf(a[0]) | ((unsigned)f2bf(a[1]) << 16);
          o.y = (unsigned)f2bf(a[2]) | ((unsigned)f2bf(a[3]) << 16);
          *(uint2*)(C + (size_t)m * ldc + n) = o;
        }
      } else {
        const int b = m >> 12;
        float4 xv;
        if (EPI == 2) {
          uint2 xu = *(const uint2*)((const bf16*)X + (size_t)m * 1024 + n);
          xv.x = __uint_as_float(xu.x << 16); xv.y = __uint_as_float(xu.x & 0xffff0000u);
          xv.z = __uint_as_float(xu.y << 16); xv.w = __uint_as_float(xu.y & 0xffff0000u);
        } else xv = *(const float4*)(X + (size_t)m * 1024 + n);
        float4 g = *(const float4*)(gate + (size_t)b * 3072 + n);
        float4 o;
        o.x = ALPHA * xv.x + g.x * a[0];
        o.y = ALPHA * xv.y + g.y * a[1];
        o.z = ALPHA * xv.z + g.z * a[2];
        o.w = ALPHA * xv.w + g.w * a[3];
        *(float4*)(R + (size_t)m * 1024 + n) = o;
      }
    }
  }
}

template <int EPI>
__device__ __forceinline__ void phase_gemm(const bf16* A, int lda, const bf16* Bt, int ntn, unsigned char* smem, bf16* C, int ldc, int nreal,
                           const float* X, float* R, const float* gate, unsigned* bar, int gidx, const float* ssqp = nullptr) {
  volatile unsigned* stw = (volatile unsigned*)(smem + 73728);
  const unsigned xid = (unsigned)__builtin_amdgcn_s_getreg((3 << 11) | 20) & 0xFu;
  int xidx = 0, nx = 0;
#pragma unroll
  for (int j = 0; j < 16; ++j) {
    const unsigned c = __hip_atomic_load(&bar[256 + 64 * j], __ATOMIC_RELAXED, __HIP_MEMORY_SCOPE_AGENT);
    if (c > 0u) { nx++; if ((unsigned)j < xid) xidx++; }
  }
  const int mt_lo = (xidx * 128) / nx, mt_hi = ((xidx + 1) * 128) / nx;
  const int total = (mt_hi - mt_lo) * ntn;
  unsigned* qc = bar + 3456 + (gidx * 16 + xidx) * 8;
  for (;;) {
    __syncthreads();
    if (threadIdx.x == 0) stw[2] = __hip_atomic_fetch_add(qc, 1u, __ATOMIC_RELAXED, __HIP_MEMORY_SCOPE_AGENT);
    __syncthreads();
    const int t = (int)stw[2];
    if (t >= total) break;
    const int g8 = t / (8 * ntn), r = t - g8 * 8 * ntn;
    int mt, nt;
    const int rows = mt_hi - mt_lo - g8 * 8;
    const int gm = rows < 8 ? rows : 8;
    nt = r / gm; mt = mt_lo + g8 * 8 + (r - nt * gm);
    gemm_tile<EPI>(A, lda, Bt, mt * 128, nt * 128, smem, C, ldc, nreal, X, R, gate, ssqp);
  }
}

__device__ __forceinline__ void phase_ln(const P& p, int l, bool write_h, const unsigned char* probe_ts = nullptr) {
  const float* mod = (const float*)(p.ws + WS_MOD);
  bf16* hb = (bf16*)(p.ws + WS_H);
  const int lane = threadIdx.x & 63, wave = threadIdx.x >> 6;
  const float* g = p.ln_g + l * 1024;
  const float* bb = p.ln_b + l * 1024;
  for (int row = blockIdx.x * 4 + wave; row < M_TOK; row += gridDim.x * 4) {
    const float* rp = (const float*)(p.ws + WS_ST) + (size_t)row * 1024;
    float4 v[4];
    float s = 0.f;
#pragma unroll
    for (int q = 0; q < 4; ++q) {
      v[q] = *(const float4*)(rp + (lane + 64 * q) * 4);
      s += v[q].x + v[q].y + v[q].z + v[q].w;
    }
    const float mu = wave_sum(s) * (1.f / 1024.f);
    float s2 = 0.f;
#pragma unroll
    for (int q = 0; q < 4; ++q) {
      float a = v[q].x - mu, b2 = v[q].y - mu, c2 = v[q].z - mu, d2 = v[q].w - mu;
      s2 += a * a + b2 * b2 + c2 * c2 + d2 * d2;
    }
    const float rstd = rsqrtf(wave_sum(s2) * (1.f / 1024.f) + 1e-5f);
    const int b = row >> 12;
#pragma unroll
    for (int q = 0; q < 4; ++q) {
      const int n = (lane + 64 * q) * 4;
      float4 gg = *(const float4*)(g + n), be = *(const float4*)(bb + n);
      float4 o;
      o.x = (v[q].x - mu) * rstd * gg.x + be.x;
      o.y = (v[q].y - mu) * rstd * gg.y + be.y;
      o.z = (v[q].z - mu) * rstd * gg.z + be.z;
      o.w = (v[q].w - mu) * rstd * gg.w + be.w;
      if (PROBE_PH >= 0 && l == 1 && row == 0) {
        const long long* ts = (const long long*)(probe_ts);
        const int kus = (int)((ts[PROBE_PH + 1] - ts[PROBE_PH]) / 100);
        if (n + 0 < kus) o.x += 0.125f;
        if (n + 1 < kus) o.y += 0.125f;
        if (n + 2 < kus) o.z += 0.125f;
        if (n + 3 < kus) o.w += 0.125f;
      }
      if (!write_h) *(float4*)(p.out + (size_t)row * 1024 + n) = o;
      if (write_h) {
        uint2 xb16;
        xb16.x = (unsigned)f2bf(o.x) | ((unsigned)f2bf(o.y) << 16);
        xb16.y = (unsigned)f2bf(o.z) | ((unsigned)f2bf(o.w) << 16);
        *(uint2*)((bf16*)p.out + (size_t)row * 1024 + n) = xb16;
        const float* md = mod + (size_t)(4 + b) * 3072;
        float4 sh = *(const float4*)(md + n), sc = *(const float4*)(md + 1024 + n);
        uint2 hh;
        hh.x = (unsigned)f2bf(o.x * (1.f + sc.x) + sh.x) | ((unsigned)f2bf(o.y * (1.f + sc.y) + sh.y) << 16);
        hh.y = (unsigned)f2bf(o.z * (1.f + sc.z) + sh.z) | ((unsigned)f2bf(o.w * (1.f + sc.w) + sh.w) << 16);
        *(uint2*)(hb + (size_t)row * 1024 + n) = hh;
      }
    }
  }
}

__device__ __forceinline__ void na_item(const P& p, int item, unsigned char* smem) {
  const int h = item & 7, r = (item >> 3) & 63, b = item >> 9;
  bf16* VT = (bf16*)smem;
  float* RPB = (float*)(VT + 64 * 520);
  const bf16* projb = (const bf16*)(p.ws + WS_PROJ) + (size_t)b * 4096 * EVEN_N;
  bf16* yb = (bf16*)(p.ws + WS_H);
  const int tid = threadIdx.x, lane = tid & 63, n = tid >> 6;
  const int q = lane & 15, g4 = lane >> 4;
  int rs = r - 4; rs = rs < 0 ? 0 : (rs > 56 ? 56 : rs);
#pragma unroll 4
  for (int i = 0; i < 16; ++i) {
    const int pair = i * 256 + tid, key = pair & 511, ch = pair >> 9;
    const int tok = (rs + (key >> 6)) * 64 + (key & 63);
    uint4 u = *(const uint4*)(projb + (size_t)tok * EVEN_N + 1024 + h * 64 + ch * 8);
    bf16* dst = VT + (ch * 8) * 520 + key;
    dst[0 * 520] = (bf16)(u.x & 0xffffu); dst[1 * 520] = (bf16)(u.x >> 16);
    dst[2 * 520] = (bf16)(u.y & 0xffffu); dst[3 * 520] = (bf16)(u.y >> 16);
    dst[4 * 520] = (bf16)(u.z & 0xffffu); dst[5 * 520] = (bf16)(u.z >> 16);
    dst[6 * 520] = (bf16)(u.w & 0xffffu); dst[7 * 520] = (bf16)(u.w >> 16);
  }
  for (int i = tid; i < 465; i += 256) RPB[i] = p.e_rpb[h * 465 + i];
  const int qcol = n * 16 + q;
  const int qtok = r * 64 + qcol;
  const int bs = n == 0 ? 0 : (n == 1 ? 8 : (n == 2 ? 24 : 32));
  const bf16x8 qf0 = *(const bf16x8*)(projb + (size_t)qtok * EVEN_N + h * 64 + g4 * 8);
  const bf16x8 qf1 = *(const bf16x8*)(projb + (size_t)qtok * EVEN_N + h * 64 + 32 + g4 * 8);
  f32x4 st[16];
#pragma unroll
  for (int tt = 0; tt < 16; ++tt) {
    const int ktok = (rs + (tt >> 1)) * 64 + bs + (tt & 1) * 16 + q;
    const bf16* kp = projb + (size_t)ktok * EVEN_N + 512 + h * 64 + g4 * 8;
    bf16x8 kf0 = *(const bf16x8*)kp, kf1 = *(const bf16x8*)(kp + 32);
    f32x4 z = (f32x4){0.f, 0.f, 0.f, 0.f};
    z = __builtin_amdgcn_mfma_f32_16x16x32_bf16(kf0, qf0, z, 0, 0, 0);
    st[tt] = __builtin_amdgcn_mfma_f32_16x16x32_bf16(kf1, qf1, z, 0, 0, 0);
  }
  __syncthreads();
  int cs = qcol - 8; cs = cs < 0 ? 0 : (cs > 48 ? 48 : cs);
  float mx = -1e30f;
#pragma unroll
  for (int tt = 0; tt < 16; ++tt) {
    const float* brow = RPB + (rs + (tt >> 1) - r + 7) * 31;
#pragma unroll
    for (int rr = 0; rr < 4; ++rr) {
      const int kcol = bs + (tt & 1) * 16 + g4 * 4 + rr;
      const bool valid = (kcol >= cs) && (kcol < cs + 16);
      int dc = kcol - qcol + 15; dc = dc < 0 ? 0 : (dc > 30 ? 30 : dc);
      const float sc = valid ? st[tt][rr] * 0.125f + brow[dc] : -1e30f;
      st[tt][rr] = sc;
      mx = fmaxf(mx, sc);
    }
  }
  mx = fmaxf(mx, __shfl_xor(mx, 16, 64));
  mx = fmaxf(mx, __shfl_xor(mx, 32, 64));
  float lsum = 0.f;
#pragma unroll
  for (int tt = 0; tt < 16; ++tt)
#pragma unroll
    for (int rr = 0; rr < 4; ++rr) {
      const float pe = __expf(st[tt][rr] - mx);
      st[tt][rr] = pe;
      lsum += pe;
    }
  lsum += __shfl_xor(lsum, 16, 64);
  lsum += __shfl_xor(lsum, 32, 64);
  f32x4 ot[4];
#pragma unroll
  for (int dt = 0; dt < 4; ++dt) ot[dt] = (f32x4){0.f, 0.f, 0.f, 0.f};
#pragma unroll
  for (int kr = 0; kr < 8; ++kr) {
    uint4 pw;
    pw.x = (unsigned)f2bf(st[2 * kr][0]) | ((unsigned)f2bf(st[2 * kr][1]) << 16);
    pw.y = (unsigned)f2bf(st[2 * kr][2]) | ((unsigned)f2bf(st[2 * kr][3]) << 16);
    pw.z = (unsigned)f2bf(st[2 * kr + 1][0]) | ((unsigned)f2bf(st[2 * kr + 1][1]) << 16);
    pw.w = (unsigned)f2bf(st[2 * kr + 1][2]) | ((unsigned)f2bf(st[2 * kr + 1][3]) << 16);
    const bf16x8 pf = *(bf16x8*)&pw;
#pragma unroll
    for (int dt = 0; dt < 4; ++dt) {
      const bf16* vp = VT + (dt * 16 + q) * 520 + kr * 64 + bs + g4 * 4;
      uint2 lo = *(const uint2*)vp, hi = *(const uint2*)(vp + 16);
      uint4 vw; vw.x = lo.x; vw.y = lo.y; vw.z = hi.x; vw.w = hi.y;
      ot[dt] = __builtin_amdgcn_mfma_f32_16x16x32_bf16(*(bf16x8*)&vw, pf, ot[dt], 0, 0, 0);
    }
  }
  const float inv = frcp(lsum);
#pragma unroll
  for (int dt = 0; dt < 4; ++dt) {
    const int d0 = dt * 16 + g4 * 4;
    uint2 gu = *(const uint2*)(projb + (size_t)qtok * EVEN_N + 1536 + h * 64 + d0);
    f32x4 y;
    y[0] = ot[dt][0] * inv * silu_f(__uint_as_float(gu.x << 16));
    y[1] = ot[dt][1] * inv * silu_f(__uint_as_float(gu.x & 0xffff0000u));
    y[2] = ot[dt][2] * inv * silu_f(__uint_as_float(gu.y << 16));
    y[3] = ot[dt][3] * inv * silu_f(__uint_as_float(gu.y & 0xffff0000u));
    uint2 o;
    o.x = (unsigned)f2bf(y[0]) | ((unsigned)f2bf(y[1]) << 16);
    o.y = (unsigned)f2bf(y[2]) | ((unsigned)f2bf(y[3]) << 16);
    *(uint2*)(yb + ((size_t)b * 4096 + qtok) * 1024 + h * 64 + d0) = o;
  }
}

template <int K, int MODE>
struct GateC {
  float w[16];
  float bias, lb;
  int d, ch;
  __device__ __forceinline__ void init(const P& p, int d_, int h, int k) {
    d = d_; ch = h * K + k;
    if (MODE == 0) {
#pragma unroll
      for (int r = 0; r < 16; ++r) w[r] = p.gla_w_up[(d * 16 + r) * 256 + ch];
      bias = p.gla_b[d * 256 + ch];
      lb = 0.f;
    } else {
      lb = ((const float*)(p.ws + WS_LB))[ch];
      bias = 0.f;
    }
  }
  __device__ __forceinline__ void eval_vals(bf16 a, bf16 bz, const bf16* lr, float& g, float& kval, float& qval) const {
    if (MODE == 0) {
      uint4 u0 = *(const uint4*)(lr);
      uint4 u1 = *(const uint4*)(lr + 8);
      float z = bias;
      z += w[0] * __uint_as_float(u0.x << 16) + w[1] * __uint_as_float(u0.x & 0xffff0000u);
      z += w[2] * __uint_as_float(u0.y << 16) + w[3] * __uint_as_float(u0.y & 0xffff0000u);
      z += w[4] * __uint_as_float(u0.z << 16) + w[5] * __uint_as_float(u0.z & 0xffff0000u);
      z += w[6] * __uint_as_float(u0.w << 16) + w[7] * __uint_as_float(u0.w & 0xffff0000u);
      z += w[8] * __uint_as_float(u1.x << 16) + w[9] * __uint_as_float(u1.x & 0xffff0000u);
      z += w[10] * __uint_as_float(u1.y << 16) + w[11] * __uint_as_float(u1.y & 0xffff0000u);
      z += w[12] * __uint_as_float(u1.z << 16) + w[13] * __uint_as_float(u1.z & 0xffff0000u);
      z += w[14] * __uint_as_float(u1.w << 16) + w[15] * __uint_as_float(u1.w & 0xffff0000u);
      g = log_sigmoid_f(z) * (1.f / 16.f);
      kval = bf2f(bz);
      qval = bf2f(a) * 0.125f;
    } else {
      const float z = bf2f(bz);
      const float e = __expf(-z);
      const float sg = frcp(1.f + e);
      kval = (1.f - lb) * e * sg;
      g = flog(1.f - kval);
      qval = bf2f(a) * 0.08838834764831845f;
    }
  }
  __device__ __forceinline__ void eval(const bf16* row, float& g, float& kval, float& qval) const {
    if (MODE == 0) {
      uint4 u0 = *(const uint4*)(row + 3584 + d * 16);
      uint4 u1 = *(const uint4*)(row + 3584 + d * 16 + 8);
      float z = bias;
      z += w[0] * __uint_as_float(u0.x << 16) + w[1] * __uint_as_float(u0.x & 0xffff0000u);
      z += w[2] * __uint_as_float(u0.y << 16) + w[3] * __uint_as_float(u0.y & 0xffff0000u);
      z += w[4] * __uint_as_float(u0.z << 16) + w[5] * __uint_as_float(u0.z & 0xffff0000u);
      z += w[6] * __uint_as_float(u0.w << 16) + w[7] * __uint_as_float(u0.w & 0xffff0000u);
      z += w[8] * __uint_as_float(u1.x << 16) + w[9] * __uint_as_float(u1.x & 0xffff0000u);
      z += w[10] * __uint_as_float(u1.y << 16) + w[11] * __uint_as_float(u1.y & 0xffff0000u);
      z += w[12] * __uint_as_float(u1.z << 16) + w[13] * __uint_as_float(u1.z & 0xffff0000u);
      z += w[14] * __uint_as_float(u1.w << 16) + w[15] * __uint_as_float(u1.w & 0xffff0000u);
      g = log_sigmoid_f(z) * (1.f / 16.f);
      kval = bf2f(row[2304 + ch]);
      qval = bf2f(row[2048 + ch]) * 0.125f;
    } else {
      const float z = bf2f(row[512 + d * 512 + ch]);
      const float e = __expf(-z);
      const float sg = frcp(1.f + e);
      kval = (1.f - lb) * e * sg;
      g = flog(1.f - kval);
      qval = bf2f(row[ch]) * 0.08838834764831845f;
    }
  }
};

template <int MODE>
__device__ __forceinline__ void stage_vt(const bf16* proj, int h, bf16* VT) {
  constexpr int LDP = MODE == 0 ? EVEN_N : ODD_N;
  constexpr int VOFF = MODE == 0 ? 2560 : 1536;
  const int j = threadIdx.x & 63, cgp = threadIdx.x >> 6;
#pragma unroll
  for (int cc = 0; cc < 4; ++cc) {
    const int c = cgp * 4 + cc;
    uint4 u = *(const uint4*)(proj + (size_t)j * LDP + VOFF + h * 128 + c * 8);
    bf16* dst = VT + (c * 8) * 72 + j;
    dst[0 * 72] = (bf16)(u.x & 0xffffu); dst[1 * 72] = (bf16)(u.x >> 16);
    dst[2 * 72] = (bf16)(u.y & 0xffffu); dst[3 * 72] = (bf16)(u.y >> 16);
    dst[4 * 72] = (bf16)(u.z & 0xffffu); dst[5 * 72] = (bf16)(u.z >> 16);
    dst[6 * 72] = (bf16)(u.w & 0xffffu); dst[7 * 72] = (bf16)(u.w >> 16);
  }
}

__device__ __forceinline__ uint2 pack4(f32x4 a) {
  uint2 o;
  o.x = (unsigned)f2bf(a[0]) | ((unsigned)f2bf(a[1]) << 16);
  o.y = (unsigned)f2bf(a[2]) | ((unsigned)f2bf(a[3]) << 16);
  return o;
}

template <int K, int MODE>
__device__ __forceinline__ void rec_pass1_item(const P& p, int item, unsigned char* smem) {
  constexpr int LDP = MODE == 0 ? EVEN_N : ODD_N;
  const int h = item & 3, blk = (item >> 2) & 63, b = item >> 8;
  bf16* KT = (bf16*)smem;
  bf16* VT = KT + 2 * K * 72;
  const bf16* proj = (const bf16*)(p.ws + WS_PROJ) + (size_t)(b * 4096 + blk * 64) * LDP;
  bf16* ST = (bf16*)(p.ws + WS_ST);
  float* DEC = (float*)(p.ws + WS_DEC);
  const int tid = threadIdx.x, lane = tid & 63, wave = tid >> 6;
  bf16* TMP = VT;
  if (MODE == 1) {
#pragma unroll
    for (int i = 0; i < 8; ++i) {
      const int c = i * 256 + tid;
      const int ch = c & 15, j = (c >> 4) & 63, d = c >> 10;
      *(uint4*)(TMP + (d * 64 + j) * 128 + ch * 8) = *(const uint4*)(proj + (size_t)j * LDP + 512 + d * 512 + h * 128 + ch * 8);
    }
  } else {
#pragma unroll
    for (int i = 0; i < 2; ++i) {
      const int c = i * 256 + tid;
      const int ch = c & 7, j = c >> 3;
      *(uint4*)(TMP + j * 64 + ch * 8) = *(const uint4*)(proj + (size_t)j * LDP + 2304 + h * 64 + ch * 8);
    }
    {
      const int ch = tid & 3, j = tid >> 2;
      *(uint4*)(TMP + 4096 + j * 32 + ch * 8) = *(const uint4*)(proj + (size_t)j * LDP + 3584 + ch * 8);
    }
  }
  __syncthreads();
  if (tid < 2 * K) {
    const int d = tid / K, k = tid % K;
    GateC<K, MODE> gc;
    gc.init(p, d, h, k);
    bf16* row = KT + (d * K + k) * 72;
    float r = 0.f, rhi = 0.f;
#pragma unroll 4
    for (int i = 63; i >= 0; --i) {
      const int j = d ? 63 - i : i;
      float g, kv, qv;
      if (MODE == 1) gc.eval_vals(0, TMP[(d * 64 + j) * 128 + k], nullptr, g, kv, qv);
      else gc.eval_vals(0, TMP[j * 64 + k], TMP + 4096 + j * 32 + d * 16, g, kv, qv);
      row[j] = f2bf(kv * __expf(r));
      r += g;
      if (i == 32) rhi = r;
    }
    DEC[(size_t)((((d * 4 + b) * 4 + h) * 64 + blk)) * K + k] = __expf(r);
    ((float*)(p.ws + WS_CMID))[(size_t)((((d * 4 + b) * 4 + h) * 64 + blk)) * K + k] = __expf(r - rhi);
  }
  __syncthreads();
  stage_vt<MODE>(proj, h, VT);
  __syncthreads();
#pragma unroll 1
  for (int d = 0; d < 2; ++d) {
    f32x4 acc[K / 16][2];
#pragma unroll
    for (int kt = 0; kt < K / 16; ++kt) { acc[kt][0] = (f32x4){0.f, 0.f, 0.f, 0.f}; acc[kt][1] = (f32x4){0.f, 0.f, 0.f, 0.f}; }
#pragma unroll
    for (int ks = 0; ks < 2; ++ks) {
      bf16x8 vf0 = *(const bf16x8*)(VT + ((wave * 2 + 0) * 16 + (lane & 15)) * 72 + ks * 32 + (lane >> 4) * 8);
      bf16x8 vf1 = *(const bf16x8*)(VT + ((wave * 2 + 1) * 16 + (lane & 15)) * 72 + ks * 32 + (lane >> 4) * 8);
#pragma unroll
      for (int kt = 0; kt < K / 16; ++kt) {
        bf16x8 kf = *(const bf16x8*)(KT + (d * K + kt * 16 + (lane & 15)) * 72 + ks * 32 + (lane >> 4) * 8);
        acc[kt][0] = __builtin_amdgcn_mfma_f32_16x16x32_bf16(kf, vf0, acc[kt][0], 0, 0, 0);
        acc[kt][1] = __builtin_amdgcn_mfma_f32_16x16x32_bf16(kf, vf1, acc[kt][1], 0, 0, 0);
      }
    }
    bf16* stb = ST + (size_t)((((d * 4 + b) * 4 + h) * 64 + blk)) * 128 * K;
#pragma unroll
    for (int kt = 0; kt < K / 16; ++kt)
#pragma unroll
      for (int vv = 0; vv < 2; ++vv) {
        const int v = (wave * 2 + vv) * 16 + (lane & 15);
        const int k0 = kt * 16 + (lane >> 4) * 4;
        *(uint2*)(stb + (size_t)v * K + k0) = pack4(acc[kt][vv]);
      }
  }
}

template <int K>
__device__ __forceinline__ void phase_rec_scan(const P& p) {
  bf16* ST = (bf16*)(p.ws + WS_ST);
  const float* DEC = (const float*)(p.ws + WS_DEC);
  const float* CMID = (const float*)(p.ws + WS_CMID);
  constexpr int KV = K / 4;
  const int total = 32 * 128 * KV;
  for (int idx = blockIdx.x * 256 + threadIdx.x; idx < total; idx += gridDim.x * 256) {
    const int kq = idx % KV, v = (idx / KV) & 127, s = idx / (KV * 128);
    const int d = s >> 4;
    float st0 = 0.f, st1 = 0.f, st2 = 0.f, st3 = 0.f;
#pragma unroll 1
    for (int n0 = 0; n0 < 64; n0 += 8) {
      uint2 u[8];
      float4 dc[8], cm[8];
#pragma unroll
      for (int q = 0; q < 8; ++q) {
        const int blk = d ? 63 - (n0 + q) : (n0 + q);
        u[q] = *(const uint2*)(ST + ((size_t)(s * 64 + blk) * 128 + v) * K + kq * 4);
        dc[q] = *(const float4*)(DEC + (size_t)(s * 64 + blk) * K + kq * 4);
        cm[q] = *(const float4*)(CMID + (size_t)(s * 64 + blk) * K + kq * 4);
      }
#pragma unroll
      for (int q = 0; q < 8; ++q) {
        const int blk = d ? 63 - (n0 + q) : (n0 + q);
        uint2 o;
        o.x = (unsigned)f2bf(st0 * cm[q].x) | ((unsigned)f2bf(st1 * cm[q].y) << 16);
        o.y = (unsigned)f2bf(st2 * cm[q].z) | ((unsigned)f2bf(st3 * cm[q].w) << 16);
        *(uint2*)(ST + ((size_t)(s * 64 + blk) * 128 + v) * K + kq * 4) = o;
        st0 = dc[q].x * st0 + __uint_as_float(u[q].x << 16);
        st1 = dc[q].y * st1 + __uint_as_float(u[q].x & 0xffff0000u);
        st2 = dc[q].z * st2 + __uint_as_float(u[q].y << 16);
        st3 = dc[q].w * st3 + __uint_as_float(u[q].y & 0xffff0000u);
      }
    }
  }
}

template <int K, int MODE>
__device__ __forceinline__ void rec_pass3_item(const P& p, int item, unsigned char* smem) {
  constexpr int LDP = MODE == 0 ? EVEN_N : ODD_N;
  constexpr int KS = K + 8;
  constexpr int GOFF = MODE == 0 ? 3072 : 2048;
  constexpr int YOFF = MODE == 0 ? 512 : 0;
  const int h = item & 3, blk = (item >> 2) & 63, b = item >> 8;
  bf16* QI = (bf16*)smem;
  bf16* KI = QI + 64 * KS;
  bf16* VT = KI + 64 * KS;
  bf16* AI = VT + 128 * 72;
  float* CV = (float*)(AI + 64 * 72);
  float* SSQ = CV + K;
  bf16* LRB = (bf16*)(SSQ + 256);
  const bf16* proj = (const bf16*)(p.ws + WS_PROJ) + (size_t)(b * 4096 + blk * 64) * LDP;
  const bf16* ST = (const bf16*)(p.ws + WS_ST);
  bf16* yb = (bf16*)(p.ws + WS_H);
  const int tid = threadIdx.x, lane = tid & 63, wave = tid >> 6;
  stage_vt<MODE>(proj, h, VT);
  f32x4 o[2][4];
#pragma unroll
  for (int vv = 0; vv < 2; ++vv)
#pragma unroll
    for (int it = 0; it < 4; ++it) o[vv][it] = (f32x4){0.f, 0.f, 0.f, 0.f};
#pragma unroll 1
  for (int d = 0; d < 2; ++d) {
    if (d) __syncthreads();
    const bf16* stb = ST + (size_t)((((d * 4 + b) * 4 + h) * 64 + blk)) * 128 * K;
    u32x4 stf[K / 32][2];
#pragma unroll
    for (int ks = 0; ks < K / 32; ++ks)
#pragma unroll
      for (int vv = 0; vv < 2; ++vv)
        stf[ks][vv] = gload16_asm(stb + (size_t)((wave * 2 + vv) * 16 + (lane & 15)) * K + ks * 32 + (lane >> 4) * 8);
    {
      constexpr int QOFF = MODE == 0 ? 2048 : 0;
      const int zoff = MODE == 0 ? 2304 : 512 + d * 512;
#pragma unroll
      for (int i = 0; i < K / 32; ++i) {
        const int c = i * 256 + tid;
        const int ch = c % (K / 8), j = c / (K / 8);
        *(uint4*)(QI + j * KS + ch * 8) = *(const uint4*)(proj + (size_t)j * LDP + QOFF + h * K + ch * 8);
        *(uint4*)(KI + j * KS + ch * 8) = *(const uint4*)(proj + (size_t)j * LDP + zoff + h * K + ch * 8);
      }
      if (MODE == 0 && tid < 128) {
        const int ch = tid & 1, j = tid >> 1;
        *(uint4*)(LRB + j * 16 + ch * 8) = *(const uint4*)(proj + (size_t)j * LDP + 3584 + d * 16 + ch * 8);
      }
    }
    __syncthreads();
    if (tid < 2 * K) {
      const int k = tid % K, half = tid / K;
      GateC<K, MODE> gc;
      gc.init(p, d, h, k);
      float run = 0.f;
      if (half) {
#pragma unroll 4
        for (int i = 32; i < 64; ++i) {
          const int j = d ? 63 - i : i;
          float g, kv, qv;
          gc.eval_vals(QI[j * KS + k], KI[j * KS + k], LRB + j * 16, g, kv, qv);
          run += g;
          QI[j * KS + k] = f2bf(qv * __expf(run));
          KI[j * KS + k] = f2bf(kv * __expf(-run));
        }
      } else {
#pragma unroll 4
        for (int i = 31; i >= 0; --i) {
          const int j = d ? 63 - i : i;
          float g, kv, qv;
          gc.eval_vals(QI[j * KS + k], KI[j * KS + k], LRB + j * 16, g, kv, qv);
          QI[j * KS + k] = f2bf(qv * __expf(-run));
          KI[j * KS + k] = f2bf(kv * __expf(run));
          run += g;
        }
        CV[k] = __expf(run);
      }
    }
    __syncthreads();
    {
      f32x4 a[4];
#pragma unroll
      for (int jt = 0; jt < 4; ++jt) a[jt] = (f32x4){0.f, 0.f, 0.f, 0.f};
#pragma unroll
      for (int ks = 0; ks < K / 32; ++ks) {
        bf16x8 qf = *(const bf16x8*)(QI + (wave * 16 + (lane & 15)) * KS + ks * 32 + (lane >> 4) * 8);
#pragma unroll
        for (int jt = 0; jt < 4; ++jt) {
          bf16x8 kf = *(const bf16x8*)(KI + (jt * 16 + (lane & 15)) * KS + ks * 32 + (lane >> 4) * 8);
          a[jt] = __builtin_amdgcn_mfma_f32_16x16x32_bf16(kf, qf, a[jt], 0, 0, 0);
        }
      }
      const int i = wave * 16 + (lane & 15);
#pragma unroll
      for (int jt = 0; jt < 4; ++jt) {
        const int j0 = jt * 16 + (lane >> 4) * 4;
        f32x4 m;
#pragma unroll
        for (int r = 0; r < 4; ++r) {
          const int j = j0 + r;
          const bool valid = d ? (j >= i) : (j <= i);
          m[r] = valid ? a[jt][r] : 0.f;
        }
        *(uint2*)(AI + i * 72 + j0) = pack4(m);
      }
    }
    __syncthreads();
#pragma unroll
    for (int ks = 0; ks < 2; ++ks) {
      bf16x8 vf0 = *(const bf16x8*)(VT + ((wave * 2 + 0) * 16 + (lane & 15)) * 72 + ks * 32 + (lane >> 4) * 8);
      bf16x8 vf1 = *(const bf16x8*)(VT + ((wave * 2 + 1) * 16 + (lane & 15)) * 72 + ks * 32 + (lane >> 4) * 8);
#pragma unroll
      for (int it = 0; it < 4; ++it) {
        bf16x8 af = *(const bf16x8*)(AI + (it * 16 + (lane & 15)) * 72 + ks * 32 + (lane >> 4) * 8);
        o[0][it] = __builtin_amdgcn_mfma_f32_16x16x32_bf16(vf0, af, o[0][it], 0, 0, 0);
        o[1][it] = __builtin_amdgcn_mfma_f32_16x16x32_bf16(vf1, af, o[1][it], 0, 0, 0);
      }
    }
    if (K == 128) {
      asm volatile("s_waitcnt vmcnt(0)"
                   : "+v"(stf[0][0]), "+v"(stf[0][1]), "+v"(stf[1][0]), "+v"(stf[1][1]), "+v"(stf[K / 32 - 2][0]), "+v"(stf[K / 32 - 2][1]), "+v"(stf[K / 32 - 1][0]), "+v"(stf[K / 32 - 1][1])
                   :: "memory");
    } else {
      asm volatile("s_waitcnt vmcnt(0)" : "+v"(stf[0][0]), "+v"(stf[0][1]), "+v"(stf[1][0]), "+v"(stf[1][1]) :: "memory");
    }
#pragma unroll
    for (int ks = 0; ks < K / 32; ++ks) {
      const int kk = ks * 32 + (lane >> 4) * 8;
      bf16x8 sf[2];
      sf[0] = *(bf16x8*)&stf[ks][0];
      sf[1] = *(bf16x8*)&stf[ks][1];
#pragma unroll
      for (int it = 0; it < 4; ++it) {
        bf16x8 qf = *(const bf16x8*)(QI + (it * 16 + (lane & 15)) * KS + kk);
        o[0][it] = __builtin_amdgcn_mfma_f32_16x16x32_bf16(sf[0], qf, o[0][it], 0, 0, 0);
        o[1][it] = __builtin_amdgcn_mfma_f32_16x16x32_bf16(sf[1], qf, o[1][it], 0, 0, 0);
      }
    }
  }
  {
    float ss[4];
#pragma unroll
    for (int it = 0; it < 4; ++it) {
      float s = 0.f;
#pragma unroll
      for (int vv = 0; vv < 2; ++vv)
#pragma unroll
        for (int r = 0; r < 4; ++r) s += o[vv][it][r] * o[vv][it][r];
      s += __shfl_xor(s, 16, 64);
      s += __shfl_xor(s, 32, 64);
      ss[it] = s;
    }
    if (lane < 16) {
#pragma unroll
      for (int it = 0; it < 4; ++it) SSQ[wave * 64 + it * 16 + lane] = ss[it];
    }
    __syncthreads();
    const float* gn = MODE == 0 ? p.gla_g : p.hgrn_g;
#pragma unroll
    for (int it = 0; it < 4; ++it) {
      const int i = it * 16 + (lane & 15);
      const float tot = SSQ[i] + SSQ[64 + i] + SSQ[128 + i] + SSQ[192 + i];
      const float rs = rsqrtf(tot * (1.f / 128.f) + 1e-6f);
#pragma unroll
      for (int vv = 0; vv < 2; ++vv) {
        const int v0 = (wave * 2 + vv) * 16 + (lane >> 4) * 4;
        uint2 gu = *(const uint2*)(proj + (size_t)i * LDP + GOFF + h * 128 + v0);
        float4 gg = *(const float4*)(gn + v0);
        f32x4 y;
        y[0] = o[vv][it][0] * rs * gg.x * silu_f(__uint_as_float(gu.x << 16));
        y[1] = o[vv][it][1] * rs * gg.y * silu_f(__uint_as_float(gu.x & 0xffff0000u));
        y[2] = o[vv][it][2] * rs * gg.z * silu_f(__uint_as_float(gu.y << 16));
        y[3] = o[vv][it][3] * rs * gg.w * silu_f(__uint_as_float(gu.y & 0xffff0000u));
        if (MODE == 1) *(uint2*)((bf16*)proj + (size_t)i * LDP + GOFF + h * 128 + v0) = pack4(y);
        else *(uint2*)(yb + (size_t)(b * 4096 + blk * 64 + i) * 1024 + YOFF + h * 128 + v0) = pack4(y);
      }
    }
  }
}

__device__ __forceinline__ void conv8(const P& p, const bf16* projb, int t, int c0, float* o8) {
  c0 = __builtin_amdgcn_readfirstlane(c0);
  float4 b0 = *(const float4*)(p.conv_b + c0), b1 = *(const float4*)(p.conv_b + c0 + 4);
  float a[8] = {b0.x, b0.y, b0.z, b0.w, b1.x, b1.y, b1.z, b1.w};
#pragma unroll
  for (int jt = 0; jt < 4; ++jt) {
    const int tt = t + jt - 2;
    if (tt >= 0 && tt < 4096) {
      uint4 u = *(const uint4*)(projb + (size_t)tt * ODD_N + 3072 + c0);
      float4 w0 = *(const float4*)(p.conv_w + jt * 1024 + c0), w1 = *(const float4*)(p.conv_w + jt * 1024 + c0 + 4);
      a[0] += w0.x * __uint_as_float(u.x << 16); a[1] += w0.y * __uint_as_float(u.x & 0xffff0000u);
      a[2] += w0.z * __uint_as_float(u.y << 16); a[3] += w0.w * __uint_as_float(u.y & 0xffff0000u);
      a[4] += w1.x * __uint_as_float(u.z << 16); a[5] += w1.y * __uint_as_float(u.z & 0xffff0000u);
      a[6] += w1.z * __uint_as_float(u.w << 16); a[7] += w1.w * __uint_as_float(u.w & 0xffff0000u);
    }
  }
#pragma unroll
  for (int e = 0; e < 8; ++e) o8[e] = silu_f(a[e]);
}

__device__ __forceinline__ void ssd_prep_acum(const P& p, const bf16* projb, int blk, int g, float* ACUM, float* DTV, float* TOT) {
  const int lane = threadIdx.x & 63, wave = threadIdx.x >> 6;
#pragma unroll
  for (int q = 0; q < 2; ++q) {
    const int c = wave * 2 + q, dir = c >> 2, rp = c & 3, head = g * 4 + rp;
    const int j = dir ? 63 - lane : lane;
    const int t = blk * 64 + j;
    const float dt = softplus_f(bf2f(projb[(size_t)t * ODD_N + 4096 + dir * 8 + head]) + p.dt_bias[dir * 8 + head]);
    float v = -__expf(p.a_log[dir * 8 + head]) * dt;
#pragma unroll
    for (int off = 1; off < 64; off <<= 1) {
      float tmp = __shfl_up(v, off, 64);
      if (lane >= off) v += tmp;
    }
    ACUM[c * 64 + j] = v;
    DTV[c * 64 + j] = dt;
    if (lane == 63) TOT[c] = v;
  }
}

__device__ __forceinline__ bf16* ssd_st(const P& p, int s) {
  return s < 32 ? (bf16*)(p.ws + WS_H) + (size_t)s * 524288 : (bf16*)((unsigned char*)p.out + 33554432) + (size_t)(s - 32) * 524288;
}
__device__ __forceinline__ void ssd_pass1_item(const P& p, int item, unsigned char* smem) {
  const int g = item & 1, blk = (item >> 1) & 63, b = item >> 7;
  bf16* BT = (bf16*)smem;
  bf16* XT = BT + 128 * 72;
  float* ACUM = (float*)(XT + 256 * 72);
  float* DTV = ACUM + 512;
  float* TOT = DTV + 512;
  const bf16* projb = (const bf16*)(p.ws + WS_PROJ) + (size_t)b * 4096 * ODD_N;
  float* DEC = (float*)(p.ws + WS_DECS);
  const int tid = threadIdx.x, lane = tid & 63, wave = tid >> 6;
  const int t = blk * 64 + lane;
  ssd_prep_acum(p, projb, blk, g, ACUM, DTV, TOT);
#pragma unroll 2
  for (int q = 0; q < 4; ++q) {
    const int cc = wave + 4 * q;
    float v8[8];
    conv8(p, projb, t, 512 + g * 128 + cc * 8, v8);
#pragma unroll
    for (int e = 0; e < 8; ++e) BT[(cc * 8 + e) * 72 + lane] = f2bf(v8[e]);
  }
  float xs[8][8];
#pragma unroll
  for (int q = 0; q < 8; ++q) conv8(p, projb, t, g * 256 + (wave * 8 + q) * 8, xs[q]);
  __syncthreads();
  if (tid < 8) {
    const int dir = tid >> 2, head = g * 4 + (tid & 3);
    DEC[(size_t)((dir * 4 + b) * 8 + head) * 64 + blk] = __expf(TOT[tid]);
  }
#pragma unroll 1
  for (int dir = 0; dir < 2; ++dir) {
    if (dir) __syncthreads();
    const int c = dir * 4 + wave;
    const float fac = DTV[c * 64 + lane] * __expf(TOT[c] - ACUM[c * 64 + lane]);
#pragma unroll
    for (int q = 0; q < 8; ++q)
#pragma unroll
      for (int e = 0; e < 8; ++e) XT[((wave * 8 + q) * 8 + e) * 72 + lane] = f2bf(xs[q][e] * fac);
    __syncthreads();
    const int head = g * 4 + wave;
    bf16* stb = ssd_st(p, (dir * 4 + b) * 8 + head) + (size_t)blk * 8192;
#pragma unroll 1
    for (int nh = 0; nh < 4; ++nh) {
      f32x4 acc[2][4];
#pragma unroll
      for (int nt = 0; nt < 2; ++nt)
#pragma unroll
        for (int pt = 0; pt < 4; ++pt) acc[nt][pt] = (f32x4){0.f, 0.f, 0.f, 0.f};
#pragma unroll
      for (int ks = 0; ks < 2; ++ks) {
        bf16x8 xf[4];
#pragma unroll
        for (int pt = 0; pt < 4; ++pt) xf[pt] = *(const bf16x8*)(XT + (wave * 64 + pt * 16 + (lane & 15)) * 72 + ks * 32 + (lane >> 4) * 8);
#pragma unroll
        for (int nt = 0; nt < 2; ++nt) {
          bf16x8 bfv = *(const bf16x8*)(BT + ((nh * 2 + nt) * 16 + (lane & 15)) * 72 + ks * 32 + (lane >> 4) * 8);
#pragma unroll
          for (int pt = 0; pt < 4; ++pt) acc[nt][pt] = __builtin_amdgcn_mfma_f32_16x16x32_bf16(bfv, xf[pt], acc[nt][pt], 0, 0, 0);
        }
      }
#pragma unroll
      for (int nt = 0; nt < 2; ++nt)
#pragma unroll
        for (int pt = 0; pt < 4; ++pt) {
          const int pp = pt * 16 + (lane & 15);
          const int n0 = (nh * 2 + nt) * 16 + (lane >> 4) * 4;
          *(uint2*)(stb + (size_t)pp * 128 + n0) = pack4(acc[nt][pt]);
        }
    }
  }
}

__device__ __forceinline__ void phase_ssd_scan(const P& p) {
  const float* DEC = (const float*)(p.ws + WS_DECS);
  const int total = 64 * 2048;
  for (int idx = blockIdx.x * 256 + threadIdx.x; idx < total; idx += gridDim.x * 256) {
    const int e4 = idx & 2047, s = idx >> 11;
    const int d = s >> 5;
    bf16* ST = ssd_st(p, s);
    float st0 = 0.f, st1 = 0.f, st2 = 0.f, st3 = 0.f;
#pragma unroll 1
    for (int n0 = 0; n0 < 64; n0 += 8) {
      uint2 u[8];
      float dc[8];
#pragma unroll
      for (int q = 0; q < 8; ++q) {
        const int blk = d ? 63 - (n0 + q) : (n0 + q);
        u[q] = *(const uint2*)(ST + (size_t)blk * 8192 + e4 * 4);
        dc[q] = DEC[s * 64 + blk];
      }
#pragma unroll
      for (int q = 0; q < 8; ++q) {
        const int blk = d ? 63 - (n0 + q) : (n0 + q);
        uint2 o;
        o.x = (unsigned)f2bf(st0) | ((unsigned)f2bf(st1) << 16);
        o.y = (unsigned)f2bf(st2) | ((unsigned)f2bf(st3) << 16);
        *(uint2*)(ST + (size_t)blk * 8192 + e4 * 4) = o;
        st0 = dc[q] * st0 + __uint_as_float(u[q].x << 16);
        st1 = dc[q] * st1 + __uint_as_float(u[q].x & 0xffff0000u);
        st2 = dc[q] * st2 + __uint_as_float(u[q].y << 16);
        st3 = dc[q] * st3 + __uint_as_float(u[q].y & 0xffff0000u);
      }
    }
  }
}

__device__ __forceinline__ void ssd_pass3_item(const P& p, int item, unsigned char* smem) {
  const int g = item & 1, blk = (item >> 1) & 63, b = item >> 7;
  bf16* CI = (bf16*)smem;
  bf16* BI = CI + 64 * 136;
  bf16* AI = BI;
  bf16* XT = BI + 64 * 136;
  float* ACUM = (float*)(XT + 64 * 72);
  float* DTV = ACUM + 512;
  float* TOT = DTV + 512;
  float* SSQ = TOT + 8;
  bf16* projb = (bf16*)(p.ws + WS_PROJ) + (size_t)b * 4096 * ODD_N;
  const int tid = threadIdx.x, lane = tid & 63, wave = tid >> 6;
  const int t = blk * 64 + lane;
  ssd_prep_acum(p, projb, blk, g, ACUM, DTV, TOT);
#pragma unroll 4
  for (int q = 0; q < 8; ++q) {
    const int cc = wave * 8 + q, which = cc >> 4, ch = (cc & 15) * 8;
    float v8[8];
    conv8(p, projb, t, 512 + which * 256 + g * 128 + ch, v8);
    uint4 w;
    w.x = (unsigned)f2bf(v8[0]) | ((unsigned)f2bf(v8[1]) << 16);
    w.y = (unsigned)f2bf(v8[2]) | ((unsigned)f2bf(v8[3]) << 16);
    w.z = (unsigned)f2bf(v8[4]) | ((unsigned)f2bf(v8[5]) << 16);
    w.w = (unsigned)f2bf(v8[6]) | ((unsigned)f2bf(v8[7]) << 16);
    *(uint4*)((which ? CI : BI) + lane * 136 + ch) = w;
  }
  __syncthreads();
  f32x4 gt[4];
#pragma unroll
  for (int jt = 0; jt < 4; ++jt) gt[jt] = (f32x4){0.f, 0.f, 0.f, 0.f};
#pragma unroll
  for (int ks = 0; ks < 4; ++ks) {
    bf16x8 cf = *(const bf16x8*)(CI + (wave * 16 + (lane & 15)) * 136 + ks * 32 + (lane >> 4) * 8);
#pragma unroll
    for (int jt = 0; jt < 4; ++jt) {
      bf16x8 bfv = *(const bf16x8*)(BI + (jt * 16 + (lane & 15)) * 136 + ks * 32 + (lane >> 4) * 8);
      gt[jt] = __builtin_amdgcn_mfma_f32_16x16x32_bf16(bfv, cf, gt[jt], 0, 0, 0);
    }
  }
  __syncthreads();
  float ssq_acc[4] = {0.f, 0.f, 0.f, 0.f};
#pragma unroll 1
  for (int rp = 0; rp < 4; ++rp) {
    const int head = g * 4 + rp;
#pragma unroll 2
    for (int q = 0; q < 2; ++q) {
      const int cc = wave * 2 + q;
      float v8[8];
      conv8(p, projb, t, head * 64 + cc * 8, v8);
#pragma unroll
      for (int e = 0; e < 8; ++e) XT[(cc * 8 + e) * 72 + lane] = f2bf(v8[e]);
    }
    f32x4 o[4];
#pragma unroll
    for (int it = 0; it < 4; ++it) o[it] = (f32x4){0.f, 0.f, 0.f, 0.f};
#pragma unroll 1
    for (int dir = 0; dir < 2; ++dir) {
      const int c = dir * 4 + rp;
      const bf16* stb = ssd_st(p, (dir * 4 + b) * 8 + head) + (size_t)blk * 8192;
      u32x4 stf[4];
#pragma unroll
      for (int ks = 0; ks < 4; ++ks) stf[ks] = gload16_asm(stb + (size_t)(wave * 16 + (lane & 15)) * 128 + ks * 32 + (lane >> 4) * 8);
      {
        const int i = wave * 16 + (lane & 15);
        const float aci = ACUM[c * 64 + i];
#pragma unroll
        for (int jt = 0; jt < 4; ++jt) {
          const int j0 = jt * 16 + (lane >> 4) * 4;
          f32x4 m;
#pragma unroll
          for (int r = 0; r < 4; ++r) {
            const int j = j0 + r;
            const bool valid = dir ? (j >= i) : (j <= i);
            const float arg = fminf(aci - ACUM[c * 64 + j], 0.f);
            m[r] = valid ? gt[jt][r] * __expf(arg) * DTV[c * 64 + j] : 0.f;
          }
          *(uint2*)(AI + i * 72 + j0) = pack4(m);
        }
      }
      __syncthreads();
#pragma unroll
      for (int ks = 0; ks < 2; ++ks) {
        bf16x8 xf = *(const bf16x8*)(XT + (wave * 16 + (lane & 15)) * 72 + ks * 32 + (lane >> 4) * 8);
#pragma unroll
        for (int it = 0; it < 4; ++it) {
          bf16x8 af = *(const bf16x8*)(AI + (it * 16 + (lane & 15)) * 72 + ks * 32 + (lane >> 4) * 8);
          o[it] = __builtin_amdgcn_mfma_f32_16x16x32_bf16(xf, af, o[it], 0, 0, 0);
        }
      }
      f32x4 tI[4];
#pragma unroll
      for (int it = 0; it < 4; ++it) tI[it] = (f32x4){0.f, 0.f, 0.f, 0.f};
      asm volatile("s_waitcnt vmcnt(0)" : "+v"(stf[0]), "+v"(stf[1]), "+v"(stf[2]), "+v"(stf[3]) :: "memory");
#pragma unroll
      for (int ks = 0; ks < 4; ++ks) {
        bf16x8 sf = *(bf16x8*)&stf[ks];
#pragma unroll
        for (int it = 0; it < 4; ++it) {
          bf16x8 cf = *(const bf16x8*)(CI + (it * 16 + (lane & 15)) * 136 + ks * 32 + (lane >> 4) * 8);
          tI[it] = __builtin_amdgcn_mfma_f32_16x16x32_bf16(sf, cf, tI[it], 0, 0, 0);
        }
      }
#pragma unroll
      for (int it = 0; it < 4; ++it) {
        const float ea = __expf(ACUM[c * 64 + it * 16 + (lane & 15)]);
#pragma unroll
        for (int r = 0; r < 4; ++r) o[it][r] += ea * tI[it][r];
      }
      __syncthreads();
    }
    {
      const float dsk = p.d_skip[head];
      const int p0 = wave * 16 + (lane >> 4) * 4;
      float4 gg = *(const float4*)(p.ssm_g + head * 64 + p0);
#pragma unroll
      for (int it = 0; it < 4; ++it) {
        const int i = it * 16 + (lane & 15);
        uint2 zu = *(const uint2*)(projb + (size_t)(blk * 64 + i) * ODD_N + 2560 + head * 64 + p0);
        f32x4 y;
        y[0] = (o[it][0] + dsk * bf2f(XT[(p0 + 0) * 72 + i])) * silu_f(__uint_as_float(zu.x << 16));
        y[1] = (o[it][1] + dsk * bf2f(XT[(p0 + 1) * 72 + i])) * silu_f(__uint_as_float(zu.x & 0xffff0000u));
        y[2] = (o[it][2] + dsk * bf2f(XT[(p0 + 2) * 72 + i])) * silu_f(__uint_as_float(zu.y << 16));
        y[3] = (o[it][3] + dsk * bf2f(XT[(p0 + 3) * 72 + i])) * silu_f(__uint_as_float(zu.y & 0xffff0000u));
        ssq_acc[it] += y[0] * y[0] + y[1] * y[1] + y[2] * y[2] + y[3] * y[3];
        y[0] *= gg.x; y[1] *= gg.y; y[2] *= gg.z; y[3] *= gg.w;
        *(uint2*)(projb + (size_t)(blk * 64 + i) * ODD_N + 2560 + head * 64 + p0) = pack4(y);
      }
    }
    __syncthreads();
  }
#pragma unroll
  for (int it = 0; it < 4; ++it) {
    float s = ssq_acc[it];
    s += __shfl_xor(s, 16, 64);
    s += __shfl_xor(s, 32, 64);
    if (lane < 16) SSQ[wave * 64 + it * 16 + lane] = s;
  }
  __syncthreads();
  if (tid < 64) {
    float* ssqp = (float*)(p.ws + WS_SSQ);
    ssqp[(size_t)g * M_TOK + (size_t)b * 4096 + blk * 64 + tid] = SSQ[tid] + SSQ[64 + tid] + SSQ[128 + tid] + SSQ[192 + tid];
  }
}

__device__ __forceinline__ void phase_ssd_norm(const P& p) {
  const float* ssqp = (const float*)(p.ws + WS_SSQ);
  bf16* yb = (bf16*)(p.ws + WS_H);
  const int total = M_TOK * 64;
  for (int idx = blockIdx.x * 256 + threadIdx.x; idx < total; idx += gridDim.x * 256) {
    const int tok = idx >> 6, c8 = (idx & 63) * 8;
    const float rs = rsqrtf((ssqp[tok] + ssqp[M_TOK + tok]) * (1.f / 512.f) + 1e-6f);
    uint4* ptr = (uint4*)(yb + (size_t)tok * 1024 + 512 + c8);
    uint4 u = *ptr, w;
    w.x = (unsigned)f2bf(__uint_as_float(u.x << 16) * rs) | ((unsigned)f2bf(__uint_as_float(u.x & 0xffff0000u) * rs) << 16);
    w.y = (unsigned)f2bf(__uint_as_float(u.y << 16) * rs) | ((unsigned)f2bf(__uint_as_float(u.y & 0xffff0000u) * rs) << 16);
    w.z = (unsigned)f2bf(__uint_as_float(u.z << 16) * rs) | ((unsigned)f2bf(__uint_as_float(u.z & 0xffff0000u) * rs) << 16);
    w.w = (unsigned)f2bf(__uint_as_float(u.w << 16) * rs) | ((unsigned)f2bf(__uint_as_float(u.w & 0xffff0000u) * rs) << 16);
    *ptr = w;
  }
}


#define XB_TMO      128
#define XB_XCNT(j)  (256  + 64 * (j))
#define XB_XSUB(j)  (1280 + 64 * (j))
#define XB_XGEN(j)  (2304 + 64 * (j))
#define XB_TOP      3328
#define XB_TOPGEN   3392
#define XCD_BAR_WORDS 3456
#define XB_SPIN_CAP (1u << 18)
#define LAS __attribute__((address_space(3)))
__device__ __forceinline__ unsigned xb_ld(unsigned* p) { return __hip_atomic_load(p, __ATOMIC_RELAXED, __HIP_MEMORY_SCOPE_AGENT); }
__device__ __forceinline__ unsigned xb_add(unsigned* p, unsigned v) { return __hip_atomic_fetch_add(p, v, __ATOMIC_RELAXED, __HIP_MEMORY_SCOPE_AGENT); }
__device__ __forceinline__ unsigned xb_xcc_id() { return (unsigned)__builtin_amdgcn_s_getreg((3 << 11) | 20) & 0xFu; }
#define XB_SPIN(cond, bar) do { unsigned _sp = 0; while (cond) { __builtin_amdgcn_s_sleep(1); \
    if ((++_sp & 255u) == 0u) { if (xb_ld(&(bar)[XB_TMO])) break; if (_sp > XB_SPIN_CAP) { atomicAdd(&(bar)[XB_TMO], 1u); break; } } } } while (0)
struct XcdBarrier { unsigned* bar; unsigned x; volatile LAS unsigned* st; };
__device__ __forceinline__ XcdBarrier xcd_barrier_post(unsigned* bar, volatile LAS unsigned* st) {
  XcdBarrier b; b.bar = bar; b.x = xb_xcc_id(); b.st = st;
  if (threadIdx.x == 0) (void)xb_add(&bar[XB_XCNT(b.x)], 1u);
  return b;
}
__device__ __forceinline__ void xcd_barrier_complete(unsigned* bar, unsigned x, unsigned& nloc, unsigned& nx) {
  const unsigned G = gridDim.x * gridDim.y * gridDim.z;
  unsigned sum, cnt, mine, sp = 0u;
  for (;;) {
    sum = 0u; cnt = 0u; mine = 0u;
#pragma unroll
    for (unsigned j = 0; j < 16; ++j) { const unsigned c = xb_ld(&bar[XB_XCNT(j)]); sum += c; cnt += (c > 0u) ? 1u : 0u; mine = (j == x) ? c : mine; }
    if (sum == G) break;
    __builtin_amdgcn_s_sleep(1);
    if ((++sp & 255u) == 0u) { if (xb_ld(&bar[XB_TMO])) break; if (sp > XB_SPIN_CAP) { atomicAdd(&bar[XB_TMO], 1u); break; } }
  }
  nloc = mine > 0u ? mine : 1u; nx = cnt > 0u ? cnt : 1u;
}
__device__ __forceinline__ void xcd_barrier(const XcdBarrier& b) {
  asm volatile("s_waitcnt vmcnt(0)" ::: "memory");
  __syncthreads();
  if (threadIdx.x == 0) {
    unsigned* bar = b.bar;
    __builtin_amdgcn_s_waitcnt(0);
    unsigned nloc = b.st[0], nx = b.st[1];
    if (nloc == 0u) { xcd_barrier_complete(bar, b.x, nloc, nx); b.st[0] = nloc; b.st[1] = nx; }
    const unsigned old = xb_add(&bar[XB_XSUB(b.x)], 1u);
    const unsigned gen = old / nloc;
    if (old + 1u == (gen + 1u) * nloc) {
      __builtin_amdgcn_fence(__ATOMIC_RELEASE, "agent");
      asm volatile("s_waitcnt vmcnt(0)" ::: "memory");
      const unsigned og = xb_add(&bar[XB_TOP], 1u);
      const unsigned tg = og / nx;
      if (og + 1u == (tg + 1u) * nx) xb_add(&bar[XB_TOPGEN], 1u);
      else XB_SPIN(xb_ld(&bar[XB_TOPGEN]) == tg, bar);
      __builtin_amdgcn_fence(__ATOMIC_ACQUIRE, "agent");
      xb_add(&bar[XB_XGEN(b.x)], 1u);
      asm volatile("s_waitcnt vmcnt(0)" ::: "memory");
    } else {
      XB_SPIN(xb_ld(&bar[XB_XGEN(b.x)]) == gen, bar);
      __builtin_amdgcn_fence(__ATOMIC_ACQUIRE, "agent");
      asm volatile("s_waitcnt vmcnt(0)" ::: "memory");
    }
  }
  __syncthreads();
}

#define NPHASE 14
__global__ void __launch_bounds__(256, 2) mega(P p, int ph_lo, int ph_hi) {
  __shared__ __align__(16) unsigned char smem[73728 + 16 + (PROBE_PH >= 0 ? 256 : 0)];
  cg::grid_group grid = cg::this_grid();
  if (ph_lo < 0) grid.sync();
  if (threadIdx.x == 0) *(uint4*)(smem + 73728) = make_uint4(0u, 0u, 0u, 0u);
  __syncthreads();
  XcdBarrier xb = xcd_barrier_post((unsigned*)(p.ws + WS_BAR), (volatile LAS unsigned*)(smem + 73728));
  const float* mod = (const float*)(p.ws + WS_MOD);
#define IN(k) (ph_lo <= (k) && (k) < ph_hi)
#define SYNC(k) if (IN(k) && (k) + 1 < ph_hi) { xcd_barrier(xb); if (PROBE_PH >= 0 && blockIdx.x == 0 && threadIdx.x == 0) ((long long*)(smem + 73744))[(k) + 1] = __builtin_amdgcn_s_memrealtime(); }
  if (PROBE_PH >= 0 && blockIdx.x == 0 && threadIdx.x == 0) ((long long*)(smem + 73744))[0] = __builtin_amdgcn_s_memrealtime();
  if (IN(0)) phase_setup(p, smem);
  SYNC(0)
  if (IN(1)) phase_h0(p);
  SYNC(1)
  if (IN(2))
    phase_gemm<0>((const bf16*)(p.ws + WS_H), 1024, (const bf16*)(p.ws + WS_WEI), EVEN_NP / 128, smem,
                  (bf16*)(p.ws + WS_PROJ), EVEN_N, EVEN_N, nullptr, nullptr, nullptr, (unsigned*)(p.ws + WS_BAR), 0);
  SYNC(2)
  if (IN(3)) {
    for (int it = blockIdx.x; it < 1024; it += gridDim.x) { rec_pass1_item<64, 0>(p, it, smem); __syncthreads(); }
  }
  SYNC(3)
  if (IN(4)) {
    phase_rec_scan<64>(p);
    for (int it = blockIdx.x; it < 2048 * REPN + 16 * 66 + 256; it += gridDim.x) {
      if (it < 2048 * REPN) na_item(p, it & 2047, smem);
      else if (it < 2048 * REPN + 16 * 66) transpose_item(p.o_w_in, ODD_N, (bf16*)(p.ws + WS_WOI), it - 2048 * REPN, smem);
      else transpose_item(p.o_w_out, 1024, (bf16*)(p.ws + WS_WOO), it - 2048 * REPN - 16 * 66, smem);
      __syncthreads();
    }
  }
  SYNC(4)
  if (IN(5)) {
    for (int it = blockIdx.x; it < 1024 * REPR; it += gridDim.x) { rec_pass3_item<64, 0>(p, it & 1023, smem); __syncthreads(); }
  }
  SYNC(5)
  if (IN(6))
    phase_gemm<1>((const bf16*)(p.ws + WS_H), 1024, (const bf16*)(p.ws + WS_WEO), 8, smem, nullptr, 0, 0, p.x, (float*)(p.ws + WS_ST),
                  mod + 2048, (unsigned*)(p.ws + WS_BAR), 1);
  SYNC(6)
  if (IN(7)) phase_ln(p, 0, true);
  SYNC(7)
  if (IN(8))
    phase_gemm<0>((const bf16*)(p.ws + WS_H), 1024, (const bf16*)(p.ws + WS_WOI), ODD_NP / 128, smem,
                  (bf16*)(p.ws + WS_PROJ), ODD_N, ODD_N, nullptr, nullptr, nullptr, (unsigned*)(p.ws + WS_BAR), 2);
  SYNC(8)
  if (IN(9)) {
    for (int it = blockIdx.x; it < 512 + 1024; it += gridDim.x) {
      if (it < 512) ssd_pass1_item(p, it, smem); else rec_pass1_item<128, 1>(p, it - 512, smem);
      __syncthreads();
    }
  }
  SYNC(9)
  if (IN(10)) { phase_rec_scan<128>(p); phase_ssd_scan(p); }
  SYNC(10)
  if (IN(11)) {
    for (int it = blockIdx.x; it < 512 + 1024; it += gridDim.x) {
      if (it < 512) ssd_pass3_item(p, it, smem); else rec_pass3_item<128, 1>(p, it - 512, smem);
      __syncthreads();
    }
  }
  SYNC(11)
  if (IN(12))
    phase_gemm<2>((const bf16*)(p.ws + WS_PROJ) + 2048, ODD_N, (const bf16*)(p.ws + WS_WOO), 8, smem, nullptr, 0, 0,
                  (const float*)p.out, (float*)(p.ws + WS_ST), mod + 4 * 3072 + 2048, (unsigned*)(p.ws + WS_BAR), 3,
                  (const float*)(p.ws + WS_SSQ));
  SYNC(12)
  if (IN(13)) phase_ln(p, 1, false, smem + 73744);
}

extern "C" void kernel_launch(void* const* d_in, const int* in_sizes, int n_in, void* d_out, int out_size, void* d_ws,
                              size_t ws_size, hipStream_t stream) {
  static int grid_blocks = 0;
  if (!grid_blocks) {
    int dev = 0, cus = 0, per_cu = 0;
    hipGetDevice(&dev);
    hipDeviceGetAttribute(&cus, hipDeviceAttributeMultiprocessorCount, dev);
    hipOccupancyMaxActiveBlocksPerMultiprocessor(&per_cu, mega, 256, 0);
    if (per_cu < 1) per_cu = 1;
    if (per_cu > 2) per_cu = 2;
    grid_blocks = cus * per_cu;
    if (n_in != 22 || ws_size < WS_END) {
      fprintf(stderr, "kernel_launch: unexpected n_in %d / ws_size %zu (need %llu)\n", n_in, ws_size, (unsigned long long)WS_END);
      grid_blocks = -1;
    }
  }
  if (grid_blocks < 0) return;
  P p{};
  const float** f = (const float**)&p;
  for (int i = 0; i < 22; ++i) f[i] = (const float*)d_in[i];
  p.out = (float*)d_out;
  p.ws = (unsigned char*)d_ws;
#if 1
  if (hipMemsetAsync((char*)d_ws + WS_BAR, 0, 16384, stream) != hipSuccess) { fprintf(stderr, "memset of barrier words failed\n"); return; }
  int lo = 0, hi = NPHASE;
  void* args[] = {&p, &lo, &hi};
  hipError_t e = hipLaunchCooperativeKernel((void*)mega, dim3(grid_blocks), dim3(256), args, 0, stream);
  if (e != hipSuccess) fprintf(stderr, "cooperative launch failed: %s (grid %d)\n", hipGetErrorString(e), grid_blocks);
#else
  for (int ph = 0; ph < NPHASE; ++ph) hipLaunchKernelGGL(mega, dim3(grid_blocks), dim3(256), 0, stream, p, ph, ph + 1);
#endif
}
```

```cpp
#include <hip/hip_runtime.h>
#include <hip/hip_cooperative_groups.h>
#include <cstdio>
namespace cg = cooperative_groups;

typedef unsigned short bf16;
using bf16x8 = __attribute__((ext_vector_type(8))) short;
using f32x4 = __attribute__((ext_vector_type(4))) float;

#define M_TOK 16384
#define DM 1024
#define SEQ 4096
#define EVEN_N 3616
#define EVEN_NP 3712
#define ODD_N 4112
#define ODD_NP 4224
#define ALPHA 1.4142135623730951f
#ifndef PROBE_PH
#define PROBE_PH -1
#endif
#ifndef REPG
#define REPG 1
#endif
#ifndef REPN
#define REPN 1
#endif
#ifndef REP3
#define REP3 1
#endif
#ifndef REPS
#define REPS 1
#endif
#ifndef REP0
#define REP0 1
#endif
#ifndef REPR
#define REPR 1
#endif

#define WS_MOD 0ull
#define WS_LB (WS_MOD + 98304ull)
#define WS_WEI (WS_LB + 2048ull)
#define WS_WEO (WS_WEI + 3712ull * 2048)
#define WS_WOI (WS_WEO + 1024ull * 2048)
#define WS_WOO (WS_WOI + 4224ull * 2048)
#define WS_H (WS_WOO + 1024ull * 2048)
#define WS_PROJ (WS_H + 16384ull * 2048)
#define WS_O (WS_PROJ + 16384ull * 4112 * 2)
#define WS_ST WS_O
#define WS_DEC (WS_O + 2ull * 16384 * 512 * 4)
#define WS_SSQ (WS_DEC + 2ull * 16 * 64 * 128 * 4)
#define WS_BAR (WS_SSQ + 2ull * 16384 * 4)
#define WS_CMID (WS_BAR + 16384ull)
#define WS_DECS (WS_CMID + 2ull * 16 * 64 * 128 * 4)
#define WS_END (WS_DECS + 16384ull)

struct P {
  const float *x, *c, *ada_w, *ada_b, *ln_g, *ln_b, *e_w_in, *e_rpb, *gla_w_up, *gla_b, *gla_g, *e_w_out;
  const float *o_w_in, *hgrn_lb, *hgrn_g, *conv_w, *conv_b, *dt_bias, *a_log, *d_skip, *ssm_g, *o_w_out;
  float* out;
  unsigned char* ws;
};

__device__ __forceinline__ bf16 f2bf(float f) {
  __bf16 h = (__bf16)f;
  return *(bf16*)&h;
}
using u32x4 = __attribute__((ext_vector_type(4))) unsigned;
__device__ __forceinline__ u32x4 gload16_asm(const void* ptr) {
  u32x4 r;
  asm volatile("global_load_dwordx4 %0, %1, off" : "=v"(r) : "v"(ptr));
  return r;
}
__device__ __forceinline__ float bf2f(bf16 h) { return __uint_as_float(((unsigned)h) << 16); }
__device__ __forceinline__ float frcp(float x) { return __builtin_amdgcn_rcpf(x); }
__device__ __forceinline__ float silu_f(float v) { return v * frcp(1.f + __expf(-v)); }
__device__ __forceinline__ float sigmoid_f(float v) { return frcp(1.f + __expf(-v)); }
__device__ __forceinline__ float flog(float x) { return __builtin_amdgcn_logf(x) * 0.6931471805599453f; }
__device__ __forceinline__ float log_sigmoid_f(float z) { return fminf(z, 0.f) - flog(1.f + __expf(-fabsf(z))); }
__device__ __forceinline__ float softplus_f(float z) { return fmaxf(z, 0.f) + log1pf(__expf(-fabsf(z))); }
__device__ __forceinline__ float wave_sum(float v) {
#pragma unroll
  for (int o = 32; o > 0; o >>= 1) v += __shfl_xor(v, o, 64);
  return v;
}

__device__ __forceinline__ void transpose_item(const float* __restrict__ src, int N, bf16* __restrict__ dst, int li, unsigned char* smem) {
  float* tile = (float*)smem;
  const int tid = threadIdx.x;
  const int kt = li & 15, ntile = li >> 4;
#pragma unroll
  for (int i = 0; i < 16; ++i) {
    int row = i * 4 + (tid >> 6), col = tid & 63;
    int n = ntile * 64 + col;
    float v = (n < N) ? src[(size_t)(kt * 64 + row) * N + n] : 0.f;
    tile[row * 65 + col] = v;
  }
  __syncthreads();
#pragma unroll
  for (int i = 0; i < 16; ++i) {
    int r = i * 4 + (tid >> 6), cc = tid & 63;
    dst[(size_t)(ntile * 64 + r) * 1024 + kt * 64 + cc] = f2bf(tile[cc * 65 + r]);
  }
}

__device__ __forceinline__ void mod_item(const P& p, int idx, unsigned char* smem) {
  float* cond = (float*)smem;
  float* red = cond + 4096;
  const int tid = threadIdx.x;
  const int l = idx / 192, nc = idx % 192;
  for (int e = tid; e < 4096; e += 256) cond[e] = silu_f(p.c[e]);
  __syncthreads();
  const int kg = tid >> 4, col = tid & 15, n = nc * 16 + col;
  float a0 = 0.f, a1 = 0.f, a2 = 0.f, a3 = 0.f;
  const float* w = p.ada_w + (size_t)l * 1024 * 3072 + n;
#pragma unroll 16
  for (int k = kg * 64; k < kg * 64 + 64; ++k) {
    float wv = w[(size_t)k * 3072];
    a0 += cond[k] * wv; a1 += cond[1024 + k] * wv; a2 += cond[2048 + k] * wv; a3 += cond[3072 + k] * wv;
  }
  red[(kg * 4 + 0) * 16 + col] = a0; red[(kg * 4 + 1) * 16 + col] = a1;
  red[(kg * 4 + 2) * 16 + col] = a2; red[(kg * 4 + 3) * 16 + col] = a3;
  __syncthreads();
  if (tid < 64) {
    const int b = tid >> 4;
    float sum = 0.f;
#pragma unroll
    for (int q = 0; q < 16; ++q) sum += red[(q * 4 + b) * 16 + col];
    float* mod = (float*)(p.ws + WS_MOD);
    mod[(size_t)(l * 4 + b) * 3072 + n] = sum + p.ada_b[l * 3072 + n];
  }
}

__device__ __forceinline__ void phase_setup(const P& p, unsigned char* smem) {
  const int M0 = 384, T0 = M0 + 16 * 58, T1 = T0 + 256, T5 = T1 + 1;
  for (int rep = 0; rep < REP0; ++rep)
  for (int it = blockIdx.x; it < T5; it += gridDim.x) {
    if (it < M0) mod_item(p, it, smem);
    else if (it < T0) transpose_item(p.e_w_in, EVEN_N, (bf16*)(p.ws + WS_WEI), it - M0, smem);
    else if (it < T1) transpose_item(p.e_w_out, 1024, (bf16*)(p.ws + WS_WEO), it - T0, smem);
    else {
      float* lbv = (float*)(p.ws + WS_LB);
      for (int j = threadIdx.x; j < 512; j += 256) {
        float a = p.hgrn_lb[j], bb = p.hgrn_lb[512 + j];
        lbv[j] = 1.f / (1.f + __expf(a - bb));
      }
    }
    __syncthreads();
  }
}

__device__ __forceinline__ void phase_h0(const P& p) {
  const float* mod = (const float*)(p.ws + WS_MOD);
  bf16* hb = (bf16*)(p.ws + WS_H);
  const size_t total = (size_t)M_TOK * 128;
  for (size_t i = (size_t)blockIdx.x * 256 + threadIdx.x; i < total; i += (size_t)gridDim.x * 256) {
    int m = (int)(i >> 7), n = (int)(i & 127) * 8, b = m >> 12;
    const float4* xp = (const float4*)(p.x + (size_t)m * 1024 + n);
    const float4* sh = (const float4*)(mod + (size_t)b * 3072 + n);
    const float4* sc = (const float4*)(mod + (size_t)b * 3072 + 1024 + n);
    float4 x0 = xp[0], x1 = xp[1], s0 = sh[0], s1 = sh[1], c0 = sc[0], c1 = sc[1];
    uint4 o;
    o.x = (unsigned)f2bf(x0.x * (1.f + c0.x) + s0.x) | ((unsigned)f2bf(x0.y * (1.f + c0.y) + s0.y) << 16);
    o.y = (unsigned)f2bf(x0.z * (1.f + c0.z) + s0.z) | ((unsigned)f2bf(x0.w * (1.f + c0.w) + s0.w) << 16);
    o.z = (unsigned)f2bf(x1.x * (1.f + c1.x) + s1.x) | ((unsigned)f2bf(x1.y * (1.f + c1.y) + s1.y) << 16);
    o.w = (unsigned)f2bf(x1.z * (1.f + c1.z) + s1.z) | ((unsigned)f2bf(x1.w * (1.f + c1.w) + s1.w) << 16);
    *(uint4*)(hb + (size_t)m * 1024 + n) = o;
  }
}

#ifndef GEMM_NST
#define GEMM_NST 2
#endif
#define LSTR 64
template <int EPI>
__device__ __forceinline__ void gemm_tile(const bf16* __restrict__ A, int lda, const bf16* __restrict__ Bt, int m0, int n0,
                                          unsigned char* smem, bf16* __restrict__ C, int ldc, int nreal,
                                          const float* __restrict__ X, float* __restrict__ R, const float* __restrict__ gate,
                                          const float* __restrict__ ssqp = nullptr) {
  bf16* As = (bf16*)smem;
  bf16* Bs = As + 2 * 128 * LSTR;
  const int tid = threadIdx.x, lane = tid & 63, wave = tid >> 6;
  const int wm = wave >> 1, wn = wave & 1;
  f32x4 acc[4][4];
#pragma unroll
  for (int i = 0; i < 4; ++i)
#pragma unroll
    for (int j = 0; j < 4; ++j) acc[i][j] = (f32x4){0.f, 0.f, 0.f, 0.f};
  float rsv[4] = {1.f, 1.f, 1.f, 1.f};
  if (EPI == 2) {
#pragma unroll
    for (int j = 0; j < 4; ++j) {
      const int m = m0 + wm * 64 + j * 16 + (lane & 15);
      rsv[j] = rsqrtf((ssqp[m] + ssqp[M_TOK + m]) * (1.f / 512.f) + 1e-6f);
    }
  }
  u32x4 ra[GEMM_NST][4], rb[GEMM_NST][4];
  const int lrow = tid >> 3, lkc = tid & 7;
  const int lsw = (lkc ^ (lrow & 7)) * 8;
  const bf16* Ag = A + (size_t)(m0 + lrow) * lda + lkc * 8;
  const bf16* Bg = Bt + (size_t)(n0 + lrow) * 1024 + lkc * 8;
#pragma unroll
  for (int t = 0; t < GEMM_NST; ++t)
#pragma unroll
    for (int i = 0; i < 4; ++i) {
      ra[t][i] = gload16_asm(Ag + (size_t)i * 32 * lda + t * 64);
      rb[t][i] = gload16_asm(Bg + (size_t)i * 32 * 1024 + t * 64);
    }
  if (GEMM_NST == 3) {
    asm volatile("s_waitcnt vmcnt(16)"
                 : "+v"(ra[0][0]), "+v"(ra[0][1]), "+v"(ra[0][2]), "+v"(ra[0][3]), "+v"(rb[0][0]), "+v"(rb[0][1]), "+v"(rb[0][2]), "+v"(rb[0][3])
                 :: "memory");
  } else {
    asm volatile("s_waitcnt vmcnt(8)"
                 : "+v"(ra[0][0]), "+v"(ra[0][1]), "+v"(ra[0][2]), "+v"(ra[0][3]), "+v"(rb[0][0]), "+v"(rb[0][1]), "+v"(rb[0][2]), "+v"(rb[0][3])
                 :: "memory");
  }
#pragma unroll
  for (int i = 0; i < 4; ++i) {
    *(u32x4*)(As + (lrow + i * 32) * LSTR + lsw) = ra[0][i];
    *(u32x4*)(Bs + (lrow + i * 32) * LSTR + lsw) = rb[0][i];
  }
  __syncthreads();
#pragma unroll
  for (int kt = 0; kt < 16; ++kt) {
    const int buf = kt & 1;
    if (kt + 1 < 16) {
      const int sn = (kt + 1) % GEMM_NST;
      if (GEMM_NST == 3 && kt + 2 < 16) {
        asm volatile("s_waitcnt vmcnt(8)"
                     : "+v"(ra[sn][0]), "+v"(ra[sn][1]), "+v"(ra[sn][2]), "+v"(ra[sn][3]), "+v"(rb[sn][0]), "+v"(rb[sn][1]), "+v"(rb[sn][2]), "+v"(rb[sn][3])
                     :: "memory");
      } else {
        asm volatile("s_waitcnt vmcnt(0)"
                     : "+v"(ra[sn][0]), "+v"(ra[sn][1]), "+v"(ra[sn][2]), "+v"(ra[sn][3]), "+v"(rb[sn][0]), "+v"(rb[sn][1]), "+v"(rb[sn][2]), "+v"(rb[sn][3])
                     :: "memory");
      }
      bf16* Aw = As + (buf ^ 1) * 128 * LSTR;
      bf16* Bw = Bs + (buf ^ 1) * 128 * LSTR;
#pragma unroll
      for (int i = 0; i < 4; ++i) {
        *(u32x4*)(Aw + (lrow + i * 32) * LSTR + lsw) = ra[sn][i];
        *(u32x4*)(Bw + (lrow + i * 32) * LSTR + lsw) = rb[sn][i];
      }
    }
    if (kt + GEMM_NST < 16) {
#pragma unroll
      for (int i = 0; i < 4; ++i) {
        ra[kt % GEMM_NST][i] = gload16_asm(Ag + (size_t)i * 32 * lda + (kt + GEMM_NST) * 64);
        rb[kt % GEMM_NST][i] = gload16_asm(Bg + (size_t)i * 32 * 1024 + (kt + GEMM_NST) * 64);
      }
    }
    const bf16* Ab = As + buf * 128 * LSTR;
    const bf16* Bb = Bs + buf * 128 * LSTR;
    if (EPI == 2 && kt == 8) {
#pragma unroll
      for (int j = 0; j < 4; ++j) {
        const float inv = frcp(rsv[j]);
#pragma unroll
        for (int i = 0; i < 4; ++i) { acc[i][j][0] *= inv; acc[i][j][1] *= inv; acc[i][j][2] *= inv; acc[i][j][3] *= inv; }
      }
    }
#pragma unroll
    for (int s = 0; s < 2; ++s) {
      bf16x8 wf[4], xf[4];
#pragma unroll
      for (int i = 0; i < 4; ++i) {
        wf[i] = *(const bf16x8*)(Bb + (wn * 64 + i * 16 + (lane & 15)) * LSTR + (((s * 4 + (lane >> 4)) ^ (lane & 7)) * 8));
        xf[i] = *(const bf16x8*)(Ab + (wm * 64 + i * 16 + (lane & 15)) * LSTR + (((s * 4 + (lane >> 4)) ^ (lane & 7)) * 8));
      }
#pragma unroll
      for (int i = 0; i < 4; ++i)
#pragma unroll
        for (int j = 0; j < 4; ++j) acc[i][j] = __builtin_amdgcn_mfma_f32_16x16x32_bf16(wf[i], xf[j], acc[i][j], 0, 0, 0);
    }
    __syncthreads();
  }
#pragma unroll
  for (int i = 0; i < 4; ++i) {
    const int n = n0 + wn * 64 + i * 16 + (lane >> 4) * 4;
#pragma unroll
    for (int j = 0; j < 4; ++j) {
      const int m = m0 + wm * 64 + j * 16 + (lane & 15);
      f32x4 a = acc[i][j];
      if (EPI == 2) { a[0] *= rsv[j]; a[1] *= rsv[j]; a[2] *= rsv[j]; a[3] *= rsv[j]; }
      if (EPI == 0) {
        if (n < nreal) {
          uint2 o;
          o.x = (unsigned)f2bf(a[0]) | ((unsigned)f2bf(a[1]) << 16);
          o.y = (unsigned)f2bf(a[2]) | ((unsigned)f2bf(a[3]) << 16);
          *(uint2*)(C + (size_t)m * ldc + n) = o;
        }
      } else {
        const int b = m >> 12;
        float4 xv;
        if (EPI == 2) {
          uint2 xu = *(const uint2*)((const bf16*)X + (size_t)m * 1024 + n);
          xv.x = __uint_as_float(xu.x << 16); xv.y = __uint_as_float(xu.x & 0xffff0000u);
          xv.z = __uint_as_float(xu.y << 16); xv.w = __uint_as_float(xu.y & 0xffff0000u);
        } else xv = *(const float4*)(X + (size_t)m * 1024 + n);
        float4 g = *(const float4*)(gate + (size_t)b * 3072 + n);
        float4 o;
        o.x = ALPHA * xv.x + g.x * a[0];
        o.y = ALPHA * xv.y + g.y * a[1];
        o.z = ALPHA * xv.z + g.z * a[2];
        o.w = ALPHA * xv.w + g.w * a[3];
        *(float4*)(R + (size_t)m * 1024 + n) = o;
      }
    }
  }
}

template <int EPI>
__device__ __forceinline__ void phase_gemm(const bf16* A, int lda, const bf16* Bt, int ntn, unsigned char* smem, bf16* C, int ldc, int nreal,
                           const float* X, float* R, const float* gate, unsigned* bar, int gidx, const float* ssqp = nullptr) {
  volatile unsigned* stw = (volatile unsigned*)(smem + 73728);
  const unsigned xid = (unsigned)__builtin_amdgcn_s_getreg((3 << 11) | 20) & 0xFu;
  int xidx = 0, nx = 0;
#pragma unroll
  for (int j = 0; j < 16; ++j) {
    const unsigned c = __hip_atomic_load(&bar[256 + 64 * j], __ATOMIC_RELAXED, __HIP_MEMORY_SCOPE_AGENT);
    if (c > 0u) { nx++; if ((unsigned)j < xid) xidx++; }
  }
  const int mt_lo = (xidx * 128) / nx, mt_hi = ((xidx + 1) * 128) / nx;
  const int total = (mt_hi - mt_lo) * ntn;
  unsigned* qc = bar + 3456 + (gidx * 16 + xidx) * 8;
  for (;;) {
    __syncthreads();
    if (threadIdx.x == 0) stw[2] = __hip_atomic_fetch_add(qc, 1u, __ATOMIC_RELAXED, __HIP_MEMORY_SCOPE_AGENT);
    __syncthreads();
    const int t = (int)stw[2];
    if (t >= total) break;
    const int g8 = t / (8 * ntn), r = t - g8 * 8 * ntn;
    int mt, nt;
    const int rows = mt_hi - mt_lo - g8 * 8;
    const int gm = rows < 8 ? rows : 8;
    nt = r / gm; mt = mt_lo + g8 * 8 + (r - nt * gm);
    gemm_tile<EPI>(A, lda, Bt, mt * 128, nt * 128, smem, C, ldc, nreal, X, R, gate, ssqp);
  }
}

__device__ __forceinline__ void phase_ln(const P& p, int l, bool write_h, const unsigned char* probe_ts = nullptr) {
  const float* mod = (const float*)(p.ws + WS_MOD);
  bf16* hb = (bf16*)(p.ws + WS_H);
  const int lane = threadIdx.x & 63, wave = threadIdx.x >> 6;
  const float* g = p.ln_g + l * 1024;
  const float* bb = p.ln_b + l * 1024;
  constexpr int NR = 4;
  for (int grp = blockIdx.x * 4 + wave; grp < M_TOK / NR; grp += gridDim.x * 4) {
    float4 v[NR][4];
    float s[NR];
#pragma unroll
    for (int r = 0; r < NR; ++r) {
      const float* rp = (const float*)(p.ws + WS_ST) + (size_t)(grp * NR + r) * 1024;
#pragma unroll
      for (int q = 0; q < 4; ++q) v[r][q] = *(const float4*)(rp + (lane + 64 * q) * 4);
    }
#pragma unroll
    for (int r = 0; r < NR; ++r) {
      s[r] = 0.f;
#pragma unroll
      for (int q = 0; q < 4; ++q) s[r] += v[r][q].x + v[r][q].y + v[r][q].z + v[r][q].w;
    }
#pragma unroll
    for (int o = 32; o > 0; o >>= 1)
#pragma unroll
      for (int r = 0; r < NR; ++r) s[r] += __shfl_xor(s[r], o, 64);
    float mu[NR], s2[NR];
#pragma unroll
    for (int r = 0; r < NR; ++r) {
      mu[r] = s[r] * (1.f / 1024.f);
      s2[r] = 0.f;
#pragma unroll
      for (int q = 0; q < 4; ++q) {
        float a = v[r][q].x - mu[r], b2 = v[r][q].y - mu[r], c2 = v[r][q].z - mu[r], d2 = v[r][q].w - mu[r];
        s2[r] += a * a + b2 * b2 + c2 * c2 + d2 * d2;
      }
    }
#pragma unroll
    for (int o = 32; o > 0; o >>= 1)
#pragma unroll
      for (int r = 0; r < NR; ++r) s2[r] += __shfl_xor(s2[r], o, 64);
#pragma unroll
    for (int q = 0; q < 4; ++q) {
      const int n = (lane + 64 * q) * 4;
      const float4 gg = *(const float4*)(g + n), be = *(const float4*)(bb + n);
#pragma unroll
      for (int r = 0; r < NR; ++r) {
        const int row = grp * NR + r;
        const float rstd = rsqrtf(s2[r] * (1.f / 1024.f) + 1e-5f);
        float4 o;
        o.x = (v[r][q].x - mu[r]) * rstd * gg.x + be.x;
        o.y = (v[r][q].y - mu[r]) * rstd * gg.y + be.y;
        o.z = (v[r][q].z - mu[r]) * rstd * gg.z + be.z;
        o.w = (v[r][q].w - mu[r]) * rstd * gg.w + be.w;
        if (PROBE_PH >= 0 && l == 1 && row == 0) {
          const long long* ts = (const long long*)(probe_ts);
          const int kus = (int)((ts[PROBE_PH + 1] - ts[PROBE_PH]) / 100);
          if (n + 0 < kus) o.x += 0.125f;
          if (n + 1 < kus) o.y += 0.125f;
          if (n + 2 < kus) o.z += 0.125f;
          if (n + 3 < kus) o.w += 0.125f;
        }
        if (!write_h) *(float4*)(p.out + (size_t)row * 1024 + n) = o;
        if (write_h) {
          const int b = row >> 12;
          uint2 xb16;
          xb16.x = (unsigned)f2bf(o.x) | ((unsigned)f2bf(o.y) << 16);
          xb16.y = (unsigned)f2bf(o.z) | ((unsigned)f2bf(o.w) << 16);
          *(uint2*)((bf16*)p.out + (size_t)row * 1024 + n) = xb16;
          const float* md = mod + (size_t)(4 + b) * 3072;
          float4 sh = *(const float4*)(md + n), sc = *(const float4*)(md + 1024 + n);
          uint2 hh;
          hh.x = (unsigned)f2bf(o.x * (1.f + sc.x) + sh.x) | ((unsigned)f2bf(o.y * (1.f + sc.y) + sh.y) << 16);
          hh.y = (unsigned)f2bf(o.z * (1.f + sc.z) + sh.z) | ((unsigned)f2bf(o.w * (1.f + sc.w) + sh.w) << 16);
          *(uint2*)(hb + (size_t)row * 1024 + n) = hh;
        }
      }
    }
  }
}

__device__ __forceinline__ void na_item(const P& p, int item, unsigned char* smem) {
  const int h = item & 7, r = (item >> 3) & 63, b = item >> 9;
  bf16* VT = (bf16*)smem;
  float* RPB = (float*)(VT + 64 * 520);
  const bf16* projb = (const bf16*)(p.ws + WS_PROJ) + (size_t)b * 4096 * EVEN_N;
  bf16* yb = (bf16*)(p.ws + WS_H);
  const int tid = threadIdx.x, lane = tid & 63, n = tid >> 6;
  const int q = lane & 15, g4 = lane >> 4;
  int rs = r - 4; rs = rs < 0 ? 0 : (rs > 56 ? 56 : rs);
#pragma unroll 8
  for (int i = 0; i < 16; ++i) {
    const int key = (i >> 3) * 256 + tid, ch = i & 7;
    const int tok = (rs + (key >> 6)) * 64 + (key & 63);
    uint4 u = *(const uint4*)(projb + (size_t)tok * EVEN_N + 1024 + h * 64 + ch * 8);
    bf16* dst = VT + (ch * 8) * 520 + key;
    dst[0 * 520] = (bf16)(u.x & 0xffffu); dst[1 * 520] = (bf16)(u.x >> 16);
    dst[2 * 520] = (bf16)(u.y & 0xffffu); dst[3 * 520] = (bf16)(u.y >> 16);
    dst[4 * 520] = (bf16)(u.z & 0xffffu); dst[5 * 520] = (bf16)(u.z >> 16);
    dst[6 * 520] = (bf16)(u.w & 0xffffu); dst[7 * 520] = (bf16)(u.w >> 16);
  }
  for (int i = tid; i < 465; i += 256) RPB[i] = p.e_rpb[h * 465 + i];
  const int qcol = n * 16 + q;
  const int qtok = r * 64 + qcol;
  const int bs = n == 0 ? 0 : (n == 1 ? 8 : (n == 2 ? 24 : 32));
  const bf16x8 qf0 = *(const bf16x8*)(projb + (size_t)qtok * EVEN_N + h * 64 + g4 * 8);
  const bf16x8 qf1 = *(const bf16x8*)(projb + (size_t)qtok * EVEN_N + h * 64 + 32 + g4 * 8);
  f32x4 st[16];
#pragma unroll
  for (int tt = 0; tt < 16; ++tt) {
    const int ktok = (rs + (tt >> 1)) * 64 + bs + (tt & 1) * 16 + q;
    const bf16* kp = projb + (size_t)ktok * EVEN_N + 512 + h * 64 + g4 * 8;
    bf16x8 kf0 = *(const bf16x8*)kp, kf1 = *(const bf16x8*)(kp + 32);
    f32x4 z = (f32x4){0.f, 0.f, 0.f, 0.f};
    z = __builtin_amdgcn_mfma_f32_16x16x32_bf16(kf0, qf0, z, 0, 0, 0);
    st[tt] = __builtin_amdgcn_mfma_f32_16x16x32_bf16(kf1, qf1, z, 0, 0, 0);
  }
  __syncthreads();
  int cs = qcol - 8; cs = cs < 0 ? 0 : (cs > 48 ? 48 : cs);
  float mx = -1e30f;
#pragma unroll
  for (int tt = 0; tt < 16; ++tt) {
    const float* brow = RPB + (rs + (tt >> 1) - r + 7) * 31;
#pragma unroll
    for (int rr = 0; rr < 4; ++rr) {
      const int kcol = bs + (tt & 1) * 16 + g4 * 4 + rr;
      const bool valid = (kcol >= cs) && (kcol < cs + 16);
      int dc = kcol - qcol + 15; dc = dc < 0 ? 0 : (dc > 30 ? 30 : dc);
      const float sc = valid ? st[tt][rr] * 0.125f + brow[dc] : -1e30f;
      st[tt][rr] = sc;
      mx = fmaxf(mx, sc);
    }
  }
  mx = fmaxf(mx, __shfl_xor(mx, 16, 64));
  mx = fmaxf(mx, __shfl_xor(mx, 32, 64));
  float lsum = 0.f;
#pragma unroll
  for (int tt = 0; tt < 16; ++tt)
#pragma unroll
    for (int rr = 0; rr < 4; ++rr) {
      const float pe = __expf(st[tt][rr] - mx);
      st[tt][rr] = pe;
      lsum += pe;
    }
  lsum += __shfl_xor(lsum, 16, 64);
  lsum += __shfl_xor(lsum, 32, 64);
  f32x4 ot[4];
#pragma unroll
  for (int dt = 0; dt < 4; ++dt) ot[dt] = (f32x4){0.f, 0.f, 0.f, 0.f};
#pragma unroll
  for (int kr = 0; kr < 8; ++kr) {
    uint4 pw;
    pw.x = (unsigned)f2bf(st[2 * kr][0]) | ((unsigned)f2bf(st[2 * kr][1]) << 16);
    pw.y = (unsigned)f2bf(st[2 * kr][2]) | ((unsigned)f2bf(st[2 * kr][3]) << 16);
    pw.z = (unsigned)f2bf(st[2 * kr + 1][0]) | ((unsigned)f2bf(st[2 * kr + 1][1]) << 16);
    pw.w = (unsigned)f2bf(st[2 * kr + 1][2]) | ((unsigned)f2bf(st[2 * kr + 1][3]) << 16);
    const bf16x8 pf = *(bf16x8*)&pw;
#pragma unroll
    for (int dt = 0; dt < 4; ++dt) {
      const bf16* vp = VT + (dt * 16 + q) * 520 + kr * 64 + bs + g4 * 4;
      uint2 lo = *(const uint2*)vp, hi = *(const uint2*)(vp + 16);
      uint4 vw; vw.x = lo.x; vw.y = lo.y; vw.z = hi.x; vw.w = hi.y;
      ot[dt] = __builtin_amdgcn_mfma_f32_16x16x32_bf16(*(bf16x8*)&vw, pf, ot[dt], 0, 0, 0);
    }
  }
  const float inv = frcp(lsum);
#pragma unroll
  for (int dt = 0; dt < 4; ++dt) {
    const int d0 = dt * 16 + g4 * 4;
    uint2 gu = *(const uint2*)(projb + (size_t)qtok * EVEN_N + 1536 + h * 64 + d0);
    f32x4 y;
    y[0] = ot[dt][0] * inv * silu_f(__uint_as_float(gu.x << 16));
    y[1] = ot[dt][1] * inv * silu_f(__uint_as_float(gu.x & 0xffff0000u));
    y[2] = ot[dt][2] * inv * silu_f(__uint_as_float(gu.y << 16));
    y[3] = ot[dt][3] * inv * silu_f(__uint_as_float(gu.y & 0xffff0000u));
    uint2 o;
    o.x = (unsigned)f2bf(y[0]) | ((unsigned)f2bf(y[1]) << 16);
    o.y = (unsigned)f2bf(y[2]) | ((unsigned)f2bf(y[3]) << 16);
    *(uint2*)(yb + ((size_t)b * 4096 + qtok) * 1024 + h * 64 + d0) = o;
  }
}

template <int K, int MODE>
struct GateC {
  float w[16];
  float bias, lb;
  int d, ch;
  __device__ __forceinline__ void init(const P& p, int d_, int h, int k) {
    d = d_; ch = h * K + k;
    if (MODE == 0) {
#pragma unroll
      for (int r = 0; r < 16; ++r) w[r] = p.gla_w_up[(d * 16 + r) * 256 + ch];
      bias = p.gla_b[d * 256 + ch];
      lb = 0.f;
    } else {
      lb = ((const float*)(p.ws + WS_LB))[ch];
      bias = 0.f;
    }
  }
  __device__ __forceinline__ void eval_vals(bf16 a, bf16 bz, const bf16* lr, float& g, float& kval, float& qval) const {
    if (MODE == 0) {
      uint4 u0 = *(const uint4*)(lr);
      uint4 u1 = *(const uint4*)(lr + 8);
      float z = bias;
      z += w[0] * __uint_as_float(u0.x << 16) + w[1] * __uint_as_float(u0.x & 0xffff0000u);
      z += w[2] * __uint_as_float(u0.y << 16) + w[3] * __uint_as_float(u0.y & 0xffff0000u);
      z += w[4] * __uint_as_float(u0.z << 16) + w[5] * __uint_as_float(u0.z & 0xffff0000u);
      z += w[6] * __uint_as_float(u0.w << 16) + w[7] * __uint_as_float(u0.w & 0xffff0000u);
      z += w[8] * __uint_as_float(u1.x << 16) + w[9] * __uint_as_float(u1.x & 0xffff0000u);
      z += w[10] * __uint_as_float(u1.y << 16) + w[11] * __uint_as_float(u1.y & 0xffff0000u);
      z += w[12] * __uint_as_float(u1.z << 16) + w[13] * __uint_as_float(u1.z & 0xffff0000u);
      z += w[14] * __uint_as_float(u1.w << 16) + w[15] * __uint_as_float(u1.w & 0xffff0000u);
      g = log_sigmoid_f(z) * (1.f / 16.f);
      kval = bf2f(bz);
      qval = bf2f(a) * 0.125f;
    } else {
      const float z = bf2f(bz);
      const float e = __expf(-z);
      const float sg = frcp(1.f + e);
      kval = (1.f - lb) * e * sg;
      g = flog(1.f - kval);
      qval = bf2f(a) * 0.08838834764831845f;
    }
  }
  __device__ __forceinline__ void eval(const bf16* row, float& g, float& kval, float& qval) const {
    if (MODE == 0) {
      uint4 u0 = *(const uint4*)(row + 3584 + d * 16);
      uint4 u1 = *(const uint4*)(row + 3584 + d * 16 + 8);
      float z = bias;
      z += w[0] * __uint_as_float(u0.x << 16) + w[1] * __uint_as_float(u0.x & 0xffff0000u);
      z += w[2] * __uint_as_float(u0.y << 16) + w[3] * __uint_as_float(u0.y & 0xffff0000u);
      z += w[4] * __uint_as_float(u0.z << 16) + w[5] * __uint_as_float(u0.z & 0xffff0000u);
      z += w[6] * __uint_as_float(u0.w << 16) + w[7] * __uint_as_float(u0.w & 0xffff0000u);
      z += w[8] * __uint_as_float(u1.x << 16) + w[9] * __uint_as_float(u1.x & 0xffff0000u);
      z += w[10] * __uint_as_float(u1.y << 16) + w[11] * __uint_as_float(u1.y & 0xffff0000u);
      z += w[12] * __uint_as_float(u1.z << 16) + w[13] * __uint_as_float(u1.z & 0xffff0000u);
      z += w[14] * __uint_as_float(u1.w << 16) + w[15] * __uint_as_float(u1.w & 0xffff0000u);
      g = log_sigmoid_f(z) * (1.f / 16.f);
      kval = bf2f(row[2304 + ch]);
      qval = bf2f(row[2048 + ch]) * 0.125f;
    } else {
      const float z = bf2f(row[512 + d * 512 + ch]);
      const float e = __expf(-z);
      const float sg = frcp(1.f + e);
      kval = (1.f - lb) * e * sg;
      g = flog(1.f - kval);
      qval = bf2f(row[ch]) * 0.08838834764831845f;
    }
  }
};

template <int MODE>
__device__ __forceinline__ void stage_vt(const bf16* proj, int h, bf16* VT) {
  constexpr int LDP = MODE == 0 ? EVEN_N : ODD_N;
  constexpr int VOFF = MODE == 0 ? 2560 : 1536;
  const int j = threadIdx.x & 63, cgp = threadIdx.x >> 6;
#pragma unroll
  for (int cc = 0; cc < 4; ++cc) {
    const int c = cgp * 4 + cc;
    uint4 u = *(const uint4*)(proj + (size_t)j * LDP + VOFF + h * 128 + c * 8);
    bf16* dst = VT + (c * 8) * 72 + j;
    dst[0 * 72] = (bf16)(u.x & 0xffffu); dst[1 * 72] = (bf16)(u.x >> 16);
    dst[2 * 72] = (bf16)(u.y & 0xffffu); dst[3 * 72] = (bf16)(u.y >> 16);
    dst[4 * 72] = (bf16)(u.z & 0xffffu); dst[5 * 72] = (bf16)(u.z >> 16);
    dst[6 * 72] = (bf16)(u.w & 0xffffu); dst[7 * 72] = (bf16)(u.w >> 16);
  }
}

__device__ __forceinline__ uint2 pack4(f32x4 a) {
  uint2 o;
  o.x = (unsigned)f2bf(a[0]) | ((unsigned)f2bf(a[1]) << 16);
  o.y = (unsigned)f2bf(a[2]) | ((unsigned)f2bf(a[3]) << 16);
  return o;
}

template <int K, int MODE>
__device__ __forceinline__ void rec_pass1_item(const P& p, int item, unsigned char* smem) {
  constexpr int LDP = MODE == 0 ? EVEN_N : ODD_N;
  const int h = item & 3, blk = (item >> 2) & 63, b = item >> 8;
  bf16* KT = (bf16*)smem;
  bf16* VT = KT + 2 * K * 72;
  const bf16* proj = (const bf16*)(p.ws + WS_PROJ) + (size_t)(b * 4096 + blk * 64) * LDP;
  bf16* ST = (bf16*)(p.ws + WS_ST);
  float* DEC = (float*)(p.ws + WS_DEC);
  const int tid = threadIdx.x, lane = tid & 63, wave = tid >> 6;
  bf16* TMP = VT;
  if (MODE == 1) {
#pragma unroll
    for (int i = 0; i < 8; ++i) {
      const int c = i * 256 + tid;
      const int ch = c & 15, j = (c >> 4) & 63, d = c >> 10;
      *(uint4*)(TMP + (d * 64 + j) * 128 + ch * 8) = *(const uint4*)(proj + (size_t)j * LDP + 512 + d * 512 + h * 128 + ch * 8);
    }
  } else {
#pragma unroll
    for (int i = 0; i < 2; ++i) {
      const int c = i * 256 + tid;
      const int ch = c & 7, j = c >> 3;
      *(uint4*)(TMP + j * 64 + ch * 8) = *(const uint4*)(proj + (size_t)j * LDP + 2304 + h * 64 + ch * 8);
    }
    {
      const int ch = tid & 3, j = tid >> 2;
      *(uint4*)(TMP + 4096 + j * 32 + ch * 8) = *(const uint4*)(proj + (size_t)j * LDP + 3584 + ch * 8);
    }
  }
  __syncthreads();
  if (tid < 2 * K) {
    const int d = tid / K, k = tid % K;
    GateC<K, MODE> gc;
    gc.init(p, d, h, k);
    bf16* row = KT + (d * K + k) * 72;
    float r = 0.f, rhi = 0.f;
#pragma unroll 4
    for (int i = 63; i >= 0; --i) {
      const int j = d ? 63 - i : i;
      float g, kv, qv;
      if (MODE == 1) gc.eval_vals(0, TMP[(d * 64 + j) * 128 + k], nullptr, g, kv, qv);
      else gc.eval_vals(0, TMP[j * 64 + k], TMP + 4096 + j * 32 + d * 16, g, kv, qv);
      row[j] = f2bf(kv * __expf(r));
      r += g;
      if (i == 32) rhi = r;
    }
    DEC[(size_t)((((d * 4 + b) * 4 + h) * 64 + blk)) * K + k] = __expf(r);
    ((float*)(p.ws + WS_CMID))[(size_t)((((d * 4 + b) * 4 + h) * 64 + blk)) * K + k] = __expf(r - rhi);
  }
  __syncthreads();
  stage_vt<MODE>(proj, h, VT);
  __syncthreads();
#pragma unroll 1
  for (int d = 0; d < 2; ++d) {
    f32x4 acc[K / 16][2];
#pragma unroll
    for (int kt = 0; kt < K / 16; ++kt) { acc[kt][0] = (f32x4){0.f, 0.f, 0.f, 0.f}; acc[kt][1] = (f32x4){0.f, 0.f, 0.f, 0.f}; }
#pragma unroll
    for (int ks = 0; ks < 2; ++ks) {
      bf16x8 vf0 = *(const bf16x8*)(VT + ((wave * 2 + 0) * 16 + (lane & 15)) * 72 + ks * 32 + (lane >> 4) * 8);
      bf16x8 vf1 = *(const bf16x8*)(VT + ((wave * 2 + 1) * 16 + (lane & 15)) * 72 + ks * 32 + (lane >> 4) * 8);
#pragma unroll
      for (int kt = 0; kt < K / 16; ++kt) {
        bf16x8 kf = *(const bf16x8*)(KT + (d * K + kt * 16 + (lane & 15)) * 72 + ks * 32 + (lane >> 4) * 8);
        acc[kt][0] = __builtin_amdgcn_mfma_f32_16x16x32_bf16(kf, vf0, acc[kt][0], 0, 0, 0);
        acc[kt][1] = __builtin_amdgcn_mfma_f32_16x16x32_bf16(kf, vf1, acc[kt][1], 0, 0, 0);
      }
    }
    bf16* stb = ST + (size_t)((((d * 4 + b) * 4 + h) * 64 + blk)) * 128 * K;
#pragma unroll
    for (int kt = 0; kt < K / 16; ++kt)
#pragma unroll
      for (int vv = 0; vv < 2; ++vv) {
        const int v = (wave * 2 + vv) * 16 + (lane & 15);
        const int k0 = kt * 16 + (lane >> 4) * 4;
        *(uint2*)(stb + (size_t)v * K + k0) = pack4(acc[kt][vv]);
      }
  }
}

template <int K>
__device__ __forceinline__ void phase_rec_scan(const P& p) {
  bf16* ST = (bf16*)(p.ws + WS_ST);
  const float* DEC = (const float*)(p.ws + WS_DEC);
  const float* CMID = (const float*)(p.ws + WS_CMID);
  constexpr int KV = K / 4;
  const int total = 32 * 128 * KV;
  for (int idx = blockIdx.x * 256 + threadIdx.x; idx < total; idx += gridDim.x * 256) {
    const int kq = idx % KV, v = (idx / KV) & 127, s = idx / (KV * 128);
    const int d = s >> 4;
    float st0 = 0.f, st1 = 0.f, st2 = 0.f, st3 = 0.f;
#pragma unroll 1
    for (int n0 = 0; n0 < 64; n0 += 8) {
      uint2 u[8];
      float4 dc[8], cm[8];
#pragma unroll
      for (int q = 0; q < 8; ++q) {
        const int blk = d ? 63 - (n0 + q) : (n0 + q);
        u[q] = *(const uint2*)(ST + ((size_t)(s * 64 + blk) * 128 + v) * K + kq * 4);
        dc[q] = *(const float4*)(DEC + (size_t)(s * 64 + blk) * K + kq * 4);
        cm[q] = *(const float4*)(CMID + (size_t)(s * 64 + blk) * K + kq * 4);
      }
#pragma unroll
      for (int q = 0; q < 8; ++q) {
        const int blk = d ? 63 - (n0 + q) : (n0 + q);
        uint2 o;
        o.x = (unsigned)f2bf(st0 * cm[q].x) | ((unsigned)f2bf(st1 * cm[q].y) << 16);
        o.y = (unsigned)f2bf(st2 * cm[q].z) | ((unsigned)f2bf(st3 * cm[q].w) << 16);
        *(uint2*)(ST + ((size_t)(s * 64 + blk) * 128 + v) * K + kq * 4) = o;
        st0 = dc[q].x * st0 + __uint_as_float(u[q].x << 16);
        st1 = dc[q].y * st1 + __uint_as_float(u[q].x & 0xffff0000u);
        st2 = dc[q].z * st2 + __uint_as_float(u[q].y << 16);
        st3 = dc[q].w * st3 + __uint_as_float(u[q].y & 0xffff0000u);
      }
    }
  }
}

template <int K, int MODE>
__device__ __forceinline__ void rec_pass3_item(const P& p, int item, unsigned char* smem) {
  constexpr int LDP = MODE == 0 ? EVEN_N : ODD_N;
  constexpr int KS = K + 8;
  constexpr int GOFF = MODE == 0 ? 3072 : 2048;
  constexpr int YOFF = MODE == 0 ? 512 : 0;
  const int h = item & 3, blk = (item >> 2) & 63, b = item >> 8;
  bf16* QI = (bf16*)smem;
  bf16* KI = QI + 64 * KS;
  bf16* VT = KI + 64 * KS;
  bf16* AI = VT + 128 * 72;
  float* CV = (float*)(AI + 64 * 72);
  float* SSQ = CV + K;
  bf16* LRB = (bf16*)(SSQ + 256);
  const bf16* proj = (const bf16*)(p.ws + WS_PROJ) + (size_t)(b * 4096 + blk * 64) * LDP;
  const bf16* ST = (const bf16*)(p.ws + WS_ST);
  bf16* yb = (bf16*)(p.ws + WS_H);
  const int tid = threadIdx.x, lane = tid & 63, wave = tid >> 6;
  constexpr int VOFF = MODE == 0 ? 2560 : 1536;
  constexpr int QOFF = MODE == 0 ? 2048 : 0;
  constexpr int NQ = K / 32;
  u32x4 rvt[4], rq[4], rz[2][4], rlr[2], stf[2][4][2];
  {
    const int j = tid & 63, cgp = tid >> 6;
#pragma unroll
    for (int cc = 0; cc < 4; ++cc) rvt[cc] = gload16_asm(proj + (size_t)j * LDP + VOFF + h * 128 + (cgp * 4 + cc) * 8);
  }
#pragma unroll
  for (int i = 0; i < NQ; ++i) {
    const int c = i * 256 + tid, ch = c % (K / 8), j = c / (K / 8);
    rq[i] = gload16_asm(proj + (size_t)j * LDP + QOFF + h * K + ch * 8);
    rz[0][i] = gload16_asm(proj + (size_t)j * LDP + (MODE == 0 ? 2304 : 512) + h * K + ch * 8);
  }
  if (MODE == 0) {
    const int ch = tid & 1, j = (tid >> 1) & 63;
    rlr[0] = gload16_asm(proj + (size_t)j * LDP + 3584 + ch * 8);
    rlr[1] = gload16_asm(proj + (size_t)j * LDP + 3600 + ch * 8);
  }
  {
    const bf16* stb = ST + (size_t)((((0 * 4 + b) * 4 + h) * 64 + blk)) * 128 * K;
#pragma unroll
    for (int ks = 0; ks < NQ; ++ks)
#pragma unroll
      for (int vv = 0; vv < 2; ++vv)
        stf[0][ks][vv] = gload16_asm(stb + (size_t)((wave * 2 + vv) * 16 + (lane & 15)) * K + ks * 32 + (lane >> 4) * 8);
  }
  if (MODE == 1) {
    asm volatile("s_waitcnt vmcnt(8)"
                 : "+v"(rvt[0]), "+v"(rvt[1]), "+v"(rvt[2]), "+v"(rvt[3]), "+v"(rq[0]), "+v"(rq[1]), "+v"(rq[2]), "+v"(rq[3]),
                   "+v"(rz[0][0]), "+v"(rz[0][1]), "+v"(rz[0][2]), "+v"(rz[0][3])
                 :: "memory");
  } else {
    asm volatile("s_waitcnt vmcnt(4)"
                 : "+v"(rvt[0]), "+v"(rvt[1]), "+v"(rvt[2]), "+v"(rvt[3]), "+v"(rq[0]), "+v"(rq[1]), "+v"(rz[0][0]), "+v"(rz[0][1]), "+v"(rlr[0]), "+v"(rlr[1])
                 :: "memory");
  }
  {
    const int j = tid & 63, cgp = tid >> 6;
#pragma unroll
    for (int cc = 0; cc < 4; ++cc) {
      const u32x4 u = rvt[cc];
      bf16* dst = VT + ((cgp * 4 + cc) * 8) * 72 + j;
      dst[0 * 72] = (bf16)(u[0] & 0xffffu); dst[1 * 72] = (bf16)(u[0] >> 16);
      dst[2 * 72] = (bf16)(u[1] & 0xffffu); dst[3 * 72] = (bf16)(u[1] >> 16);
      dst[4 * 72] = (bf16)(u[2] & 0xffffu); dst[5 * 72] = (bf16)(u[2] >> 16);
      dst[6 * 72] = (bf16)(u[3] & 0xffffu); dst[7 * 72] = (bf16)(u[3] >> 16);
    }
  }
  f32x4 o[2][4];
#pragma unroll
  for (int vv = 0; vv < 2; ++vv)
#pragma unroll
    for (int it = 0; it < 4; ++it) o[vv][it] = (f32x4){0.f, 0.f, 0.f, 0.f};
#pragma unroll
  for (int d = 0; d < 2; ++d) {
    if (d) __syncthreads();
    if (MODE == 1 && d == 1) {
      asm volatile("s_waitcnt vmcnt(0)" : "+v"(rz[1][0]), "+v"(rz[1][1]), "+v"(rz[1][2]), "+v"(rz[1][3]) :: "memory");
    }
#pragma unroll
    for (int i = 0; i < NQ; ++i) {
      const int c = i * 256 + tid, ch = c % (K / 8), j = c / (K / 8);
      *(u32x4*)(QI + j * KS + ch * 8) = rq[i];
      *(u32x4*)(KI + j * KS + ch * 8) = rz[MODE == 1 ? d : 0][i];
    }
    if (d == 1) {
      const bf16* stb = ST + (size_t)((((1 * 4 + b) * 4 + h) * 64 + blk)) * 128 * K;
#pragma unroll
      for (int ks = 0; ks < NQ; ++ks)
#pragma unroll
        for (int vv = 0; vv < 2; ++vv)
          stf[1][ks][vv] = gload16_asm(stb + (size_t)((wave * 2 + vv) * 16 + (lane & 15)) * K + ks * 32 + (lane >> 4) * 8);
    }
    if (MODE == 1 && d == 0) {
#pragma unroll
      for (int i = 0; i < NQ; ++i) {
        const int c = i * 256 + tid, ch = c % (K / 8), j = c / (K / 8);
        rz[1][i] = gload16_asm(proj + (size_t)j * LDP + 1024 + h * K + ch * 8);
      }
    }
    if (MODE == 0 && tid < 128) {
      const int ch = tid & 1, j = tid >> 1;
      *(u32x4*)(LRB + j * 16 + ch * 8) = rlr[d];
    }
    __syncthreads();
    if (tid < 2 * K) {
      const int k = tid % K, half = tid / K;
      GateC<K, MODE> gc;
      gc.init(p, d, h, k);
      float run = 0.f;
      if (half) {
#pragma unroll 4
        for (int i = 32; i < 64; ++i) {
          const int j = d ? 63 - i : i;
          float g, kv, qv;
          gc.eval_vals(QI[j * KS + k], KI[j * KS + k], LRB + j * 16, g, kv, qv);
          run += g;
          QI[j * KS + k] = f2bf(qv * __expf(run));
          KI[j * KS + k] = f2bf(kv * __expf(-run));
        }
      } else {
#pragma unroll 4
        for (int i = 31; i >= 0; --i) {
          const int j = d ? 63 - i : i;
          float g, kv, qv;
          gc.eval_vals(QI[j * KS + k], KI[j * KS + k], LRB + j * 16, g, kv, qv);
          QI[j * KS + k] = f2bf(qv * __expf(-run));
          KI[j * KS + k] = f2bf(kv * __expf(run));
          run += g;
        }
        CV[k] = __expf(run);
      }
    }
    __syncthreads();
    {
      f32x4 a[4];
#pragma unroll
      for (int jt = 0; jt < 4; ++jt) a[jt] = (f32x4){0.f, 0.f, 0.f, 0.f};
#pragma unroll
      for (int ks = 0; ks < K / 32; ++ks) {
        bf16x8 qf = *(const bf16x8*)(QI + (wave * 16 + (lane & 15)) * KS + ks * 32 + (lane >> 4) * 8);
#pragma unroll
        for (int jt = 0; jt < 4; ++jt) {
          bf16x8 kf = *(const bf16x8*)(KI + (jt * 16 + (lane & 15)) * KS + ks * 32 + (lane >> 4) * 8);
          a[jt] = __builtin_amdgcn_mfma_f32_16x16x32_bf16(kf, qf, a[jt], 0, 0, 0);
        }
      }
      const int i = wave * 16 + (lane & 15);
#pragma unroll
      for (int jt = 0; jt < 4; ++jt) {
        const int j0 = jt * 16 + (lane >> 4) * 4;
        f32x4 m;
#pragma unroll
        for (int r = 0; r < 4; ++r) {
          const int j = j0 + r;
          const bool valid = d ? (j >= i) : (j <= i);
          m[r] = valid ? a[jt][r] : 0.f;
        }
        *(uint2*)(AI + i * 72 + j0) = pack4(m);
      }
    }
    __syncthreads();
#pragma unroll
    for (int ks = 0; ks < 2; ++ks) {
      bf16x8 vf0 = *(const bf16x8*)(VT + ((wave * 2 + 0) * 16 + (lane & 15)) * 72 + ks * 32 + (lane >> 4) * 8);
      bf16x8 vf1 = *(const bf16x8*)(VT + ((wave * 2 + 1) * 16 + (lane & 15)) * 72 + ks * 32 + (lane >> 4) * 8);
#pragma unroll
      for (int it = 0; it < 4; ++it) {
        bf16x8 af = *(const bf16x8*)(AI + (it * 16 + (lane & 15)) * 72 + ks * 32 + (lane >> 4) * 8);
        o[0][it] = __builtin_amdgcn_mfma_f32_16x16x32_bf16(vf0, af, o[0][it], 0, 0, 0);
        o[1][it] = __builtin_amdgcn_mfma_f32_16x16x32_bf16(vf1, af, o[1][it], 0, 0, 0);
      }
    }
    if (d == 0) {
      if (K == 128) {
        asm volatile("s_waitcnt vmcnt(4)"
                     : "+v"(stf[0][0][0]), "+v"(stf[0][0][1]), "+v"(stf[0][1][0]), "+v"(stf[0][1][1]), "+v"(stf[0][2][0]), "+v"(stf[0][2][1]), "+v"(stf[0][3][0]), "+v"(stf[0][3][1])
                     :: "memory");
      } else {
        asm volatile("s_waitcnt vmcnt(0)" : "+v"(stf[0][0][0]), "+v"(stf[0][0][1]), "+v"(stf[0][1][0]), "+v"(stf[0][1][1]) :: "memory");
      }
    } else {
      if (K == 128) {
        asm volatile("s_waitcnt vmcnt(0)"
                     : "+v"(stf[1][0][0]), "+v"(stf[1][0][1]), "+v"(stf[1][1][0]), "+v"(stf[1][1][1]), "+v"(stf[1][2][0]), "+v"(stf[1][2][1]), "+v"(stf[1][3][0]), "+v"(stf[1][3][1])
                     :: "memory");
      } else {
        asm volatile("s_waitcnt vmcnt(0)" : "+v"(stf[1][0][0]), "+v"(stf[1][0][1]), "+v"(stf[1][1][0]), "+v"(stf[1][1][1]) :: "memory");
      }
    }
#pragma unroll
    for (int ks = 0; ks < K / 32; ++ks) {
      const int kk = ks * 32 + (lane >> 4) * 8;
      bf16x8 sf[2];
      sf[0] = *(bf16x8*)&stf[d][ks][0];
      sf[1] = *(bf16x8*)&stf[d][ks][1];
#pragma unroll
      for (int it = 0; it < 4; ++it) {
        bf16x8 qf = *(const bf16x8*)(QI + (it * 16 + (lane & 15)) * KS + kk);
        o[0][it] = __builtin_amdgcn_mfma_f32_16x16x32_bf16(sf[0], qf, o[0][it], 0, 0, 0);
        o[1][it] = __builtin_amdgcn_mfma_f32_16x16x32_bf16(sf[1], qf, o[1][it], 0, 0, 0);
      }
    }
  }
  {
    float ss[4];
#pragma unroll
    for (int it = 0; it < 4; ++it) {
      float s = 0.f;
#pragma unroll
      for (int vv = 0; vv < 2; ++vv)
#pragma unroll
        for (int r = 0; r < 4; ++r) s += o[vv][it][r] * o[vv][it][r];
      s += __shfl_xor(s, 16, 64);
      s += __shfl_xor(s, 32, 64);
      ss[it] = s;
    }
    if (lane < 16) {
#pragma unroll
      for (int it = 0; it < 4; ++it) SSQ[wave * 64 + it * 16 + lane] = ss[it];
    }
    __syncthreads();
    const float* gn = MODE == 0 ? p.gla_g : p.hgrn_g;
#pragma unroll
    for (int it = 0; it < 4; ++it) {
      const int i = it * 16 + (lane & 15);
      const float tot = SSQ[i] + SSQ[64 + i] + SSQ[128 + i] + SSQ[192 + i];
      const float rs = rsqrtf(tot * (1.f / 128.f) + 1e-6f);
#pragma unroll
      for (int vv = 0; vv < 2; ++vv) {
        const int v0 = (wave * 2 + vv) * 16 + (lane >> 4) * 4;
        uint2 gu = *(const uint2*)(proj + (size_t)i * LDP + GOFF + h * 128 + v0);
        float4 gg = *(const float4*)(gn + v0);
        f32x4 y;
        y[0] = o[vv][it][0] * rs * gg.x * silu_f(__uint_as_float(gu.x << 16));
        y[1] = o[vv][it][1] * rs * gg.y * silu_f(__uint_as_float(gu.x & 0xffff0000u));
        y[2] = o[vv][it][2] * rs * gg.z * silu_f(__uint_as_float(gu.y << 16));
        y[3] = o[vv][it][3] * rs * gg.w * silu_f(__uint_as_float(gu.y & 0xffff0000u));
        if (MODE == 1) *(uint2*)((bf16*)proj + (size_t)i * LDP + GOFF + h * 128 + v0) = pack4(y);
        else *(uint2*)(yb + (size_t)(b * 4096 + blk * 64 + i) * 1024 + YOFF + h * 128 + v0) = pack4(y);
      }
    }
  }
}

__device__ __forceinline__ void conv8(const P& p, const bf16* projb, int t, int c0, float* o8) {
  c0 = __builtin_amdgcn_readfirstlane(c0);
  float4 b0 = *(const float4*)(p.conv_b + c0), b1 = *(const float4*)(p.conv_b + c0 + 4);
  float a[8] = {b0.x, b0.y, b0.z, b0.w, b1.x, b1.y, b1.z, b1.w};
#pragma unroll
  for (int jt = 0; jt < 4; ++jt) {
    const int tt = t + jt - 2;
    if (tt >= 0 && tt < 4096) {
      uint4 u = *(const uint4*)(projb + (size_t)tt * ODD_N + 3072 + c0);
      float4 w0 = *(const float4*)(p.conv_w + jt * 1024 + c0), w1 = *(const float4*)(p.conv_w + jt * 1024 + c0 + 4);
      a[0] += w0.x * __uint_as_float(u.x << 16); a[1] += w0.y * __uint_as_float(u.x & 0xffff0000u);
      a[2] += w0.z * __uint_as_float(u.y << 16); a[3] += w0.w * __uint_as_float(u.y & 0xffff0000u);
      a[4] += w1.x * __uint_as_float(u.z << 16); a[5] += w1.y * __uint_as_float(u.z & 0xffff0000u);
      a[6] += w1.z * __uint_as_float(u.w << 16); a[7] += w1.w * __uint_as_float(u.w & 0xffff0000u);
    }
  }
#pragma unroll
  for (int e = 0; e < 8; ++e) o8[e] = silu_f(a[e]);
}

__device__ __forceinline__ void ssd_prep_acum(const P& p, const bf16* projb, int blk, int g, float* ACUM, float* DTV, float* TOT) {
  const int lane = threadIdx.x & 63, wave = threadIdx.x >> 6;
#pragma unroll
  for (int q = 0; q < 2; ++q) {
    const int c = wave * 2 + q, dir = c >> 2, rp = c & 3, head = g * 4 + rp;
    const int j = dir ? 63 - lane : lane;
    const int t = blk * 64 + j;
    const float dt = softplus_f(bf2f(projb[(size_t)t * ODD_N + 4096 + dir * 8 + head]) + p.dt_bias[dir * 8 + head]);
    float v = -__expf(p.a_log[dir * 8 + head]) * dt;
#pragma unroll
    for (int off = 1; off < 64; off <<= 1) {
      float tmp = __shfl_up(v, off, 64);
      if (lane >= off) v += tmp;
    }
    ACUM[c * 64 + j] = v;
    DTV[c * 64 + j] = dt;
    if (lane == 63) TOT[c] = v;
  }
}

__device__ __forceinline__ bf16* ssd_st(const P& p, int s) {
  return s < 32 ? (bf16*)(p.ws + WS_H) + (size_t)s * 524288 : (bf16*)((unsigned char*)p.out + 33554432) + (size_t)(s - 32) * 524288;
}
__device__ __forceinline__ void ssd_pass1_item(const P& p, int item, unsigned char* smem) {
  const int g = item & 1, blk = (item >> 1) & 63, b = item >> 7;
  bf16* BT = (bf16*)smem;
  bf16* XT = BT + 128 * 72;
  float* ACUM = (float*)(XT + 256 * 72);
  float* DTV = ACUM + 512;
  float* TOT = DTV + 512;
  const bf16* projb = (const bf16*)(p.ws + WS_PROJ) + (size_t)b * 4096 * ODD_N;
  float* DEC = (float*)(p.ws + WS_DECS);
  const int tid = threadIdx.x, lane = tid & 63, wave = tid >> 6;
  const int t = blk * 64 + lane;
  ssd_prep_acum(p, projb, blk, g, ACUM, DTV, TOT);
#pragma unroll 2
  for (int q = 0; q < 4; ++q) {
    const int cc = wave + 4 * q;
    float v8[8];
    conv8(p, projb, t, 512 + g * 128 + cc * 8, v8);
#pragma unroll
    for (int e = 0; e < 8; ++e) BT[(cc * 8 + e) * 72 + lane] = f2bf(v8[e]);
  }
  float xs[8][8];
#pragma unroll
  for (int q = 0; q < 8; ++q) conv8(p, projb, t, g * 256 + (wave * 8 + q) * 8, xs[q]);
  __syncthreads();
  if (tid < 8) {
    const int dir = tid >> 2, head = g * 4 + (tid & 3);
    DEC[(size_t)((dir * 4 + b) * 8 + head) * 64 + blk] = __expf(TOT[tid]);
  }
#pragma unroll 1
  for (int dir = 0; dir < 2; ++dir) {
    if (dir) __syncthreads();
    const int c = dir * 4 + wave;
    const float fac = DTV[c * 64 + lane] * __expf(TOT[c] - ACUM[c * 64 + lane]);
#pragma unroll
    for (int q = 0; q < 8; ++q)
#pragma unroll
      for (int e = 0; e < 8; ++e) XT[((wave * 8 + q) * 8 + e) * 72 + lane] = f2bf(xs[q][e] * fac);
    __syncthreads();
    const int head = g * 4 + wave;
    bf16* stb = ssd_st(p, (dir * 4 + b) * 8 + head) + (size_t)blk * 8192;
#pragma unroll 1
    for (int nh = 0; nh < 4; ++nh) {
      f32x4 acc[2][4];
#pragma unroll
      for (int nt = 0; nt < 2; ++nt)
#pragma unroll
        for (int pt = 0; pt < 4; ++pt) acc[nt][pt] = (f32x4){0.f, 0.f, 0.f, 0.f};
#pragma unroll
      for (int ks = 0; ks < 2; ++ks) {
        bf16x8 xf[4];
#pragma unroll
        for (int pt = 0; pt < 4; ++pt) xf[pt] = *(const bf16x8*)(XT + (wave * 64 + pt * 16 + (lane & 15)) * 72 + ks * 32 + (lane >> 4) * 8);
#pragma unroll
        for (int nt = 0; nt < 2; ++nt) {
          bf16x8 bfv = *(const bf16x8*)(BT + ((nh * 2 + nt) * 16 + (lane & 15)) * 72 + ks * 32 + (lane >> 4) * 8);
#pragma unroll
          for (int pt = 0; pt < 4; ++pt) acc[nt][pt] = __builtin_amdgcn_mfma_f32_16x16x32_bf16(bfv, xf[pt], acc[nt][pt], 0, 0, 0);
        }
      }
#pragma unroll
      for (int nt = 0; nt < 2; ++nt)
#pragma unroll
        for (int pt = 0; pt < 4; ++pt) {
          const int pp = pt * 16 + (lane & 15);
          const int n0 = (nh * 2 + nt) * 16 + (lane >> 4) * 4;
          *(uint2*)(stb + (size_t)pp * 128 + n0) = pack4(acc[nt][pt]);
        }
    }
  }
}

__device__ __forceinline__ void phase_ssd_scan(const P& p) {
  const float* DEC = (const float*)(p.ws + WS_DECS);
  const int total = 64 * 2048;
  for (int idx = blockIdx.x * 256 + threadIdx.x; idx < total; idx += gridDim.x * 256) {
    const int e4 = idx & 2047, s = idx >> 11;
    const int d = s >> 5;
    bf16* ST = ssd_st(p, s);
    float st0 = 0.f, st1 = 0.f, st2 = 0.f, st3 = 0.f;
#pragma unroll 1
    for (int n0 = 0; n0 < 64; n0 += 8) {
      uint2 u[8];
      float dc[8];
#pragma unroll
      for (int q = 0; q < 8; ++q) {
        const int blk = d ? 63 - (n0 + q) : (n0 + q);
        u[q] = *(const uint2*)(ST + (size_t)blk * 8192 + e4 * 4);
        dc[q] = DEC[s * 64 + blk];
      }
#pragma unroll
      for (int q = 0; q < 8; ++q) {
        const int blk = d ? 63 - (n0 + q) : (n0 + q);
        uint2 o;
        o.x = (unsigned)f2bf(st0) | ((unsigned)f2bf(st1) << 16);
        o.y = (unsigned)f2bf(st2) | ((unsigned)f2bf(st3) << 16);
        *(uint2*)(ST + (size_t)blk * 8192 + e4 * 4) = o;
        st0 = dc[q] * st0 + __uint_as_float(u[q].x << 16);
        st1 = dc[q] * st1 + __uint_as_float(u[q].x & 0xffff0000u);
        st2 = dc[q] * st2 + __uint_as_float(u[q].y << 16);
        st3 = dc[q] * st3 + __uint_as_float(u[q].y & 0xffff0000u);
      }
    }
  }
}

__device__ __forceinline__ void ssd_pass3_item(const P& p, int item, unsigned char* smem) {
  const int g = item & 1, blk = (item >> 1) & 63, b = item >> 7;
  bf16* CI = (bf16*)smem;
  bf16* BI = CI + 64 * 136;
  bf16* AI = BI;
  bf16* XT = BI + 64 * 136;
  float* ACUM = (float*)(XT + 64 * 72);
  float* DTV = ACUM + 512;
  float* TOT = DTV + 512;
  float* SSQ = TOT + 8;
  bf16* projb = (bf16*)(p.ws + WS_PROJ) + (size_t)b * 4096 * ODD_N;
  const int tid = threadIdx.x, lane = tid & 63, wave = tid >> 6;
  const int t = blk * 64 + lane;
  ssd_prep_acum(p, projb, blk, g, ACUM, DTV, TOT);
#pragma unroll 4
  for (int q = 0; q < 8; ++q) {
    const int cc = wave * 8 + q, which = cc >> 4, ch = (cc & 15) * 8;
    float v8[8];
    conv8(p, projb, t, 512 + which * 256 + g * 128 + ch, v8);
    uint4 w;
    w.x = (unsigned)f2bf(v8[0]) | ((unsigned)f2bf(v8[1]) << 16);
    w.y = (unsigned)f2bf(v8[2]) | ((unsigned)f2bf(v8[3]) << 16);
    w.z = (unsigned)f2bf(v8[4]) | ((unsigned)f2bf(v8[5]) << 16);
    w.w = (unsigned)f2bf(v8[6]) | ((unsigned)f2bf(v8[7]) << 16);
    *(uint4*)((which ? CI : BI) + lane * 136 + ch) = w;
  }
  __syncthreads();
  f32x4 gt[4];
#pragma unroll
  for (int jt = 0; jt < 4; ++jt) gt[jt] = (f32x4){0.f, 0.f, 0.f, 0.f};
#pragma unroll
  for (int ks = 0; ks < 4; ++ks) {
    bf16x8 cf = *(const bf16x8*)(CI + (wave * 16 + (lane & 15)) * 136 + ks * 32 + (lane >> 4) * 8);
#pragma unroll
    for (int jt = 0; jt < 4; ++jt) {
      bf16x8 bfv = *(const bf16x8*)(BI + (jt * 16 + (lane & 15)) * 136 + ks * 32 + (lane >> 4) * 8);
      gt[jt] = __builtin_amdgcn_mfma_f32_16x16x32_bf16(bfv, cf, gt[jt], 0, 0, 0);
    }
  }
  __syncthreads();
  float ssq_acc[4] = {0.f, 0.f, 0.f, 0.f};
#pragma unroll 1
  for (int rp = 0; rp < 4; ++rp) {
    const int head = g * 4 + rp;
#pragma unroll 2
    for (int q = 0; q < 2; ++q) {
      const int cc = wave * 2 + q;
      float v8[8];
      conv8(p, projb, t, head * 64 + cc * 8, v8);
#pragma unroll
      for (int e = 0; e < 8; ++e) XT[(cc * 8 + e) * 72 + lane] = f2bf(v8[e]);
    }
    f32x4 o[4];
#pragma unroll
    for (int it = 0; it < 4; ++it) o[it] = (f32x4){0.f, 0.f, 0.f, 0.f};
#pragma unroll 1
    for (int dir = 0; dir < 2; ++dir) {
      const int c = dir * 4 + rp;
      const bf16* stb = ssd_st(p, (dir * 4 + b) * 8 + head) + (size_t)blk * 8192;
      u32x4 stf[4];
#pragma unroll
      for (int ks = 0; ks < 4; ++ks) stf[ks] = gload16_asm(stb + (size_t)(wave * 16 + (lane & 15)) * 128 + ks * 32 + (lane >> 4) * 8);
      {
        const int i = wave * 16 + (lane & 15);
        const float aci = ACUM[c * 64 + i];
#pragma unroll
        for (int jt = 0; jt < 4; ++jt) {
          const int j0 = jt * 16 + (lane >> 4) * 4;
          f32x4 m;
#pragma unroll
          for (int r = 0; r < 4; ++r) {
            const int j = j0 + r;
            const bool valid = dir ? (j >= i) : (j <= i);
            const float arg = fminf(aci - ACUM[c * 64 + j], 0.f);
            m[r] = valid ? gt[jt][r] * __expf(arg) * DTV[c * 64 + j] : 0.f;
          }
          *(uint2*)(AI + i * 72 + j0) = pack4(m);
        }
      }
      __syncthreads();
#pragma unroll
      for (int ks = 0; ks < 2; ++ks) {
        bf16x8 xf = *(const bf16x8*)(XT + (wave * 16 + (lane & 15)) * 72 + ks * 32 + (lane >> 4) * 8);
#pragma unroll
        for (int it = 0; it < 4; ++it) {
          bf16x8 af = *(const bf16x8*)(AI + (it * 16 + (lane & 15)) * 72 + ks * 32 + (lane >> 4) * 8);
          o[it] = __builtin_amdgcn_mfma_f32_16x16x32_bf16(xf, af, o[it], 0, 0, 0);
        }
      }
      f32x4 tI[4];
#pragma unroll
      for (int it = 0; it < 4; ++it) tI[it] = (f32x4){0.f, 0.f, 0.f, 0.f};
      asm volatile("s_waitcnt vmcnt(0)" : "+v"(stf[0]), "+v"(stf[1]), "+v"(stf[2]), "+v"(stf[3]) :: "memory");
#pragma unroll
      for (int ks = 0; ks < 4; ++ks) {
        bf16x8 sf = *(bf16x8*)&stf[ks];
#pragma unroll
        for (int it = 0; it < 4; ++it) {
          bf16x8 cf = *(const bf16x8*)(CI + (it * 16 + (lane & 15)) * 136 + ks * 32 + (lane >> 4) * 8);
          tI[it] = __builtin_amdgcn_mfma_f32_16x16x32_bf16(sf, cf, tI[it], 0, 0, 0);
        }
      }
#pragma unroll
      for (int it = 0; it < 4; ++it) {
        const float ea = __expf(ACUM[c * 64 + it * 16 + (lane & 15)]);
#pragma unroll
        for (int r = 0; r < 4; ++r) o[it][r] += ea * tI[it][r];
      }
      __syncthreads();
    }
    {
      const float dsk = p.d_skip[head];
      const int p0 = wave * 16 + (lane >> 4) * 4;
      float4 gg = *(const float4*)(p.ssm_g + head * 64 + p0);
#pragma unroll
      for (int it = 0; it < 4; ++it) {
        const int i = it * 16 + (lane & 15);
        uint2 zu = *(const uint2*)(projb + (size_t)(blk * 64 + i) * ODD_N + 2560 + head * 64 + p0);
        f32x4 y;
        y[0] = (o[it][0] + dsk * bf2f(XT[(p0 + 0) * 72 + i])) * silu_f(__uint_as_float(zu.x << 16));
        y[1] = (o[it][1] + dsk * bf2f(XT[(p0 + 1) * 72 + i])) * silu_f(__uint_as_float(zu.x & 0xffff0000u));
        y[2] = (o[it][2] + dsk * bf2f(XT[(p0 + 2) * 72 + i])) * silu_f(__uint_as_float(zu.y << 16));
        y[3] = (o[it][3] + dsk * bf2f(XT[(p0 + 3) * 72 + i])) * silu_f(__uint_as_float(zu.y & 0xffff0000u));
        ssq_acc[it] += y[0] * y[0] + y[1] * y[1] + y[2] * y[2] + y[3] * y[3];
        y[0] *= gg.x; y[1] *= gg.y; y[2] *= gg.z; y[3] *= gg.w;
        *(uint2*)(projb + (size_t)(blk * 64 + i) * ODD_N + 2560 + head * 64 + p0) = pack4(y);
      }
    }
    __syncthreads();
  }
#pragma unroll
  for (int it = 0; it < 4; ++it) {
    float s = ssq_acc[it];
    s += __shfl_xor(s, 16, 64);
    s += __shfl_xor(s, 32, 64);
    if (lane < 16) SSQ[wave * 64 + it * 16 + lane] = s;
  }
  __syncthreads();
  if (tid < 64) {
    float* ssqp = (float*)(p.ws + WS_SSQ);
    ssqp[(size_t)g * M_TOK + (size_t)b * 4096 + blk * 64 + tid] = SSQ[tid] + SSQ[64 + tid] + SSQ[128 + tid] + SSQ[192 + tid];
  }
}

__device__ __forceinline__ void phase_ssd_norm(const P& p) {
  const float* ssqp = (const float*)(p.ws + WS_SSQ);
  bf16* yb = (bf16*)(p.ws + WS_H);
  const int total = M_TOK * 64;
  for (int idx = blockIdx.x * 256 + threadIdx.x; idx < total; idx += gridDim.x * 256) {
    const int tok = idx >> 6, c8 = (idx & 63) * 8;
    const float rs = rsqrtf((ssqp[tok] + ssqp[M_TOK + tok]) * (1.f / 512.f) + 1e-6f);
    uint4* ptr = (uint4*)(yb + (size_t)tok * 1024 + 512 + c8);
    uint4 u = *ptr, w;
    w.x = (unsigned)f2bf(__uint_as_float(u.x << 16) * rs) | ((unsigned)f2bf(__uint_as_float(u.x & 0xffff0000u) * rs) << 16);
    w.y = (unsigned)f2bf(__uint_as_float(u.y << 16) * rs) | ((unsigned)f2bf(__uint_as_float(u.y & 0xffff0000u) * rs) << 16);
    w.z = (unsigned)f2bf(__uint_as_float(u.z << 16) * rs) | ((unsigned)f2bf(__uint_as_float(u.z & 0xffff0000u) * rs) << 16);
    w.w = (unsigned)f2bf(__uint_as_float(u.w << 16) * rs) | ((unsigned)f2bf(__uint_as_float(u.w & 0xffff0000u) * rs) << 16);
    *ptr = w;
  }
}


#define XB_TMO      128
#define XB_XCNT(j)  (256  + 64 * (j))
#define XB_XSUB(j)  (1280 + 64 * (j))
#define XB_XGEN(j)  (2304 + 64 * (j))
#define XB_TOP      3328
#define XB_TOPGEN   3392
#define XCD_BAR_WORDS 3456
#define XB_SPIN_CAP (1u << 18)
#define LAS __attribute__((address_space(3)))
__device__ __forceinline__ unsigned xb_ld(unsigned* p) { return __hip_atomic_load(p, __ATOMIC_RELAXED, __HIP_MEMORY_SCOPE_AGENT); }
__device__ __forceinline__ unsigned xb_add(unsigned* p, unsigned v) { return __hip_atomic_fetch_add(p, v, __ATOMIC_RELAXED, __HIP_MEMORY_SCOPE_AGENT); }
__device__ __forceinline__ unsigned xb_xcc_id() { return (unsigned)__builtin_amdgcn_s_getreg((3 << 11) | 20) & 0xFu; }
#define XB_SPIN(cond, bar) do { unsigned _sp = 0; while (cond) { __builtin_amdgcn_s_sleep(1); \
    if ((++_sp & 255u) == 0u) { if (xb_ld(&(bar)[XB_TMO])) break; if (_sp > XB_SPIN_CAP) { atomicAdd(&(bar)[XB_TMO], 1u); break; } } } } while (0)
struct XcdBarrier { unsigned* bar; unsigned x; volatile LAS unsigned* st; };
__device__ __forceinline__ XcdBarrier xcd_barrier_post(unsigned* bar, volatile LAS unsigned* st) {
  XcdBarrier b; b.bar = bar; b.x = xb_xcc_id(); b.st = st;
  if (threadIdx.x == 0) (void)xb_add(&bar[XB_XCNT(b.x)], 1u);
  return b;
}
__device__ __forceinline__ void xcd_barrier_complete(unsigned* bar, unsigned x, unsigned& nloc, unsigned& nx) {
  const unsigned G = gridDim.x * gridDim.y * gridDim.z;
  unsigned sum, cnt, mine, sp = 0u;
  for (;;) {
    sum = 0u; cnt = 0u; mine = 0u;
#pragma unroll
    for (unsigned j = 0; j < 16; ++j) { const unsigned c = xb_ld(&bar[XB_XCNT(j)]); sum += c; cnt += (c > 0u) ? 1u : 0u; mine = (j == x) ? c : mine; }
    if (sum == G) break;
    __builtin_amdgcn_s_sleep(1);
    if ((++sp & 255u) == 0u) { if (xb_ld(&bar[XB_TMO])) break; if (sp > XB_SPIN_CAP) { atomicAdd(&bar[XB_TMO], 1u); break; } }
  }
  nloc = mine > 0u ? mine : 1u; nx = cnt > 0u ? cnt : 1u;
}
__device__ __forceinline__ void xcd_barrier(const XcdBarrier& b) {
  asm volatile("s_waitcnt vmcnt(0)" ::: "memory");
  __syncthreads();
  if (threadIdx.x == 0) {
    unsigned* bar = b.bar;
    __builtin_amdgcn_s_waitcnt(0);
    unsigned nloc = b.st[0], nx = b.st[1];
    if (nloc == 0u) { xcd_barrier_complete(bar, b.x, nloc, nx); b.st[0] = nloc; b.st[1] = nx; }
    const unsigned old = xb_add(&bar[XB_XSUB(b.x)], 1u);
    const unsigned gen = old / nloc;
    if (old + 1u == (gen + 1u) * nloc) {
      __builtin_amdgcn_fence(__ATOMIC_RELEASE, "agent");
      asm volatile("s_waitcnt vmcnt(0)" ::: "memory");
      const unsigned og = xb_add(&bar[XB_TOP], 1u);
      const unsigned tg = og / nx;
      if (og + 1u == (tg + 1u) * nx) xb_add(&bar[XB_TOPGEN], 1u);
      else XB_SPIN(xb_ld(&bar[XB_TOPGEN]) == tg, bar);
      __builtin_amdgcn_fence(__ATOMIC_ACQUIRE, "agent");
      xb_add(&bar[XB_XGEN(b.x)], 1u);
      asm volatile("s_waitcnt vmcnt(0)" ::: "memory");
    } else {
      XB_SPIN(xb_ld(&bar[XB_XGEN(b.x)]) == gen, bar);
      __builtin_amdgcn_fence(__ATOMIC_ACQUIRE, "agent");
      asm volatile("s_waitcnt vmcnt(0)" ::: "memory");
    }
  }
  __syncthreads();
}

#define NPHASE 14
__global__ void __launch_bounds__(256, 2) mega(P p, int ph_lo, int ph_hi) {
  __shared__ __align__(16) unsigned char smem[73728 + 16 + (PROBE_PH >= 0 ? 256 : 0)];
  cg::grid_group grid = cg::this_grid();
  if (ph_lo < 0) grid.sync();
  if (threadIdx.x == 0) *(uint4*)(smem + 73728) = make_uint4(0u, 0u, 0u, 0u);
  __syncthreads();
  XcdBarrier xb = xcd_barrier_post((unsigned*)(p.ws + WS_BAR), (volatile LAS unsigned*)(smem + 73728));
  const float* mod = (const float*)(p.ws + WS_MOD);
#define IN(k) (ph_lo <= (k) && (k) < ph_hi)
#define SYNC(k) if (IN(k) && (k) + 1 < ph_hi) { xcd_barrier(xb); if (PROBE_PH >= 0 && blockIdx.x == 0 && threadIdx.x == 0) ((long long*)(smem + 73744))[(k) + 1] = __builtin_amdgcn_s_memrealtime(); }
  if (PROBE_PH >= 0 && blockIdx.x == 0 && threadIdx.x == 0) ((long long*)(smem + 73744))[0] = __builtin_amdgcn_s_memrealtime();
  if (IN(0)) phase_setup(p, smem);
  SYNC(0)
  if (IN(1)) phase_h0(p);
  SYNC(1)
  if (IN(2))
    phase_gemm<0>((const bf16*)(p.ws + WS_H), 1024, (const bf16*)(p.ws + WS_WEI), EVEN_NP / 128, smem,
                  (bf16*)(p.ws + WS_PROJ), EVEN_N, EVEN_N, nullptr, nullptr, nullptr, (unsigned*)(p.ws + WS_BAR), 0);
  SYNC(2)
  if (IN(3)) {
    for (int it = blockIdx.x; it < 1024; it += gridDim.x) { rec_pass1_item<64, 0>(p, it, smem); __syncthreads(); }
  }
  SYNC(3)
  if (IN(4)) {
    phase_rec_scan<64>(p);
    for (int it = blockIdx.x; it < 2048 * REPN + 16 * 66 + 256; it += gridDim.x) {
      if (it < 2048 * REPN) na_item(p, it & 2047, smem);
      else if (it < 2048 * REPN + 16 * 66) transpose_item(p.o_w_in, ODD_N, (bf16*)(p.ws + WS_WOI), it - 2048 * REPN, smem);
      else transpose_item(p.o_w_out, 1024, (bf16*)(p.ws + WS_WOO), it - 2048 * REPN - 16 * 66, smem);
      __syncthreads();
    }
  }
  SYNC(4)
  if (IN(5)) {
    for (int it = blockIdx.x; it < 1024 * REPR; it += gridDim.x) { rec_pass3_item<64, 0>(p, it & 1023, smem); __syncthreads(); }
  }
  SYNC(5)
  if (IN(6))
    phase_gemm<1>((const bf16*)(p.ws + WS_H), 1024, (const bf16*)(p.ws + WS_WEO), 8, smem, nullptr, 0, 0, p.x, (float*)(p.ws + WS_ST),
                  mod + 2048, (unsigned*)(p.ws + WS_BAR), 1);
  SYNC(6)
  if (IN(7)) phase_ln(p, 0, true);
  SYNC(7)
  if (IN(8))
    phase_gemm<0>((const bf16*)(p.ws + WS_H), 1024, (const bf16*)(p.ws + WS_WOI), ODD_NP / 128, smem,
                  (bf16*)(p.ws + WS_PROJ), ODD_N, ODD_N, nullptr, nullptr, nullptr, (unsigned*)(p.ws + WS_BAR), 2);
  SYNC(8)
  if (IN(9)) {
    for (int it = blockIdx.x; it < 512 + 1024; it += gridDim.x) {
      if (it < 512) ssd_pass1_item(p, it, smem); else rec_pass1_item<128, 1>(p, it - 512, smem);
      __syncthreads();
    }
  }
  SYNC(9)
  if (IN(10)) { phase_rec_scan<128>(p); phase_ssd_scan(p); }
  SYNC(10)
  if (IN(11)) {
    for (int it = blockIdx.x; it < 512 + 1024; it += gridDim.x) {
      if (it < 512) ssd_pass3_item(p, it, smem); else rec_pass3_item<128, 1>(p, it - 512, smem);
      __syncthreads();
    }
  }
  SYNC(11)
  if (IN(12))
    phase_gemm<2>((const bf16*)(p.ws + WS_PROJ) + 2048, ODD_N, (const bf16*)(p.ws + WS_WOO), 8, smem, nullptr, 0, 0,
                  (const float*)p.out, (float*)(p.ws + WS_ST), mod + 4 * 3072 + 2048, (unsigned*)(p.ws + WS_BAR), 3,
                  (const float*)(p.ws + WS_SSQ));
  SYNC(12)
  if (IN(13)) phase_ln(p, 1, false, smem + 73744);
}

extern "C" void kernel_launch(void* const* d_in, const int* in_sizes, int n_in, void* d_out, int out_size, void* d_ws,
                              size_t ws_size, hipStream_t stream) {
  static int grid_blocks = 0;
  if (!grid_blocks) {
    int dev = 0, cus = 0, per_cu = 0;
    hipGetDevice(&dev);
    hipDeviceGetAttribute(&cus, hipDeviceAttributeMultiprocessorCount, dev);
    hipOccupancyMaxActiveBlocksPerMultiprocessor(&per_cu, mega, 256, 0);
    if (per_cu < 1) per_cu = 1;
    if (per_cu > 2) per_cu = 2;
    grid_blocks = cus * per_cu;
    if (n_in != 22 || ws_size < WS_END) {
      fprintf(stderr, "kernel_launch: unexpected n_in %d / ws_size %zu (need %llu)\n", n_in, ws_size, (unsigned long long)WS_END);
      grid_blocks = -1;
    }
  }
  if (grid_blocks < 0) return;
  P p{};
  const float** f = (const float**)&p;
  for (int i = 0; i < 22; ++i) f[i] = (const float*)d_in[i];
  p.out = (float*)d_out;
  p.ws = (unsigned char*)d_ws;
#if 1
  if (hipMemsetAsync((char*)d_ws + WS_BAR, 0, 16384, stream) != hipSuccess) { fprintf(stderr, "memset of barrier words failed\n"); return; }
  int lo = 0, hi = NPHASE;
  void* args[] = {&p, &lo, &hi};
  hipError_t e = hipLaunchCooperativeKernel((void*)mega, dim3(grid_blocks), dim3(256), args, 0, stream);
  if (e != hipSuccess) fprintf(stderr, "cooperative launch failed: %s (grid %d)\n", hipGetErrorString(e), grid_blocks);
#else
  for (int ph = 0; ph < NPHASE; ++ph) hipLaunchKernelGGL(mega, dim3(grid_blocks), dim3(256), 0, stream, p, ph, ph + 1);
#endif
}
```

```cpp
#include <hip/hip_runtime.h>
#include <hip/hip_cooperative_groups.h>
#include <cstdio>
namespace cg = cooperative_groups;

typedef unsigned short bf16;
using bf16x8 = __attribute__((ext_vector_type(8))) short;
using f32x4 = __attribute__((ext_vector_type(4))) float;

#define M_TOK 16384
#define DM 1024
#define SEQ 4096
#define EVEN_N 3616
#define EVEN_NP 3712
#define ODD_N 4112
#define ODD_NP 4224
#define ALPHA 1.4142135623730951f
#ifndef PROBE_PH
#define PROBE_PH -1
#endif
#ifndef REPG
#define REPG 1
#endif
#ifndef REPN
#define REPN 1
#endif
#ifndef REP3
#define REP3 1
#endif
#ifndef REPS
#define REPS 1
#endif
#ifndef REP0
#define REP0 1
#endif
#ifndef REPR
#define REPR 1
#endif

#define WS_MOD 0ull
#define WS_LB (WS_MOD + 98304ull)
#define WS_WEI (WS_LB + 2048ull)
#define WS_WEO (WS_WEI + 3712ull * 2048)
#define WS_WOI (WS_WEO + 1024ull * 2048)
#define WS_WOO (WS_WOI + 4224ull * 2048)
#define WS_H (WS_WOO + 1024ull * 2048)
#define WS_PROJ (WS_H + 16384ull * 2048)
#define WS_O (WS_PROJ + 16384ull * 4112 * 2)
#define WS_ST WS_O
#define WS_DEC (WS_O + 2ull * 16384 * 512 * 4)
#define WS_SSQ (WS_DEC + 2ull * 16 * 64 * 128 * 4)
#define WS_BAR (WS_SSQ + 2ull * 16384 * 4)
#define WS_CMID (WS_BAR + 16384ull)
#define WS_DECS (WS_CMID + 2ull * 16 * 64 * 128 * 4)
#define WS_END (WS_DECS + 16384ull)

struct P {
  const float *x, *c, *ada_w, *ada_b, *ln_g, *ln_b, *e_w_in, *e_rpb, *gla_w_up, *gla_b, *gla_g, *e_w_out;
  const float *o_w_in, *hgrn_lb, *hgrn_g, *conv_w, *conv_b, *dt_bias, *a_log, *d_skip, *ssm_g, *o_w_out;
  float* out;
  unsigned char* ws;
};

__device__ __forceinline__ bf16 f2bf(float f) {
  __bf16 h = (__bf16)f;
  return *(bf16*)&h;
}
using u32x4 = __attribute__((ext_vector_type(4))) unsigned;
__device__ __forceinline__ u32x4 gload16_asm(const void* ptr) {
  u32x4 r;
  asm volatile("global_load_dwordx4 %0, %1, off" : "=v"(r) : "v"(ptr));
  return r;
}
using u32x2 = __attribute__((ext_vector_type(2))) unsigned;
__device__ __forceinline__ u32x2 gload8_asm(const void* ptr) {
  u32x2 r;
  asm volatile("global_load_dwordx2 %0, %1, off" : "=v"(r) : "v"(ptr));
  return r;
}
__device__ __forceinline__ float bf2f(bf16 h) { return __uint_as_float(((unsigned)h) << 16); }
__device__ __forceinline__ float frcp(float x) { return __builtin_amdgcn_rcpf(x); }
__device__ __forceinline__ float silu_f(float v) { return v * frcp(1.f + __expf(-v)); }
__device__ __forceinline__ float sigmoid_f(float v) { return frcp(1.f + __expf(-v)); }
__device__ __forceinline__ float flog(float x) { return __builtin_amdgcn_logf(x) * 0.6931471805599453f; }
__device__ __forceinline__ float log_sigmoid_f(float z) { return fminf(z, 0.f) - flog(1.f + __expf(-fabsf(z))); }
__device__ __forceinline__ float softplus_f(float z) { return fmaxf(z, 0.f) + log1pf(__expf(-fabsf(z))); }
__device__ __forceinline__ float wave_sum(float v) {
#pragma unroll
  for (int o = 32; o > 0; o >>= 1) v += __shfl_xor(v, o, 64);
  return v;
}

__device__ __forceinline__ void transpose_item(const float* __restrict__ src, int N, bf16* __restrict__ dst, int li, unsigned char* smem) {
  float* tile = (float*)smem;
  const int tid = threadIdx.x;
  const int kt = li & 15, ntile = li >> 4;
#pragma unroll
  for (int i = 0; i < 16; ++i) {
    int row = i * 4 + (tid >> 6), col = tid & 63;
    int n = ntile * 64 + col;
    float v = (n < N) ? src[(size_t)(kt * 64 + row) * N + n] : 0.f;
    tile[row * 65 + col] = v;
  }
  __syncthreads();
#pragma unroll
  for (int i = 0; i < 16; ++i) {
    int r = i * 4 + (tid >> 6), cc = tid & 63;
    dst[(size_t)(ntile * 64 + r) * 1024 + kt * 64 + cc] = f2bf(tile[cc * 65 + r]);
  }
}

__device__ __forceinline__ void mod_item(const P& p, int idx, unsigned char* smem) {
  float* cond = (float*)smem;
  float* red = cond + 4096;
  const int tid = threadIdx.x;
  const int l = idx / 192, nc = idx % 192;
  for (int e = tid; e < 4096; e += 256) cond[e] = silu_f(p.c[e]);
  __syncthreads();
  const int kg = tid >> 4, col = tid & 15, n = nc * 16 + col;
  float a0 = 0.f, a1 = 0.f, a2 = 0.f, a3 = 0.f;
  const float* w = p.ada_w + (size_t)l * 1024 * 3072 + n;
#pragma unroll 16
  for (int k = kg * 64; k < kg * 64 + 64; ++k) {
    float wv = w[(size_t)k * 3072];
    a0 += cond[k] * wv; a1 += cond[1024 + k] * wv; a2 += cond[2048 + k] * wv; a3 += cond[3072 + k] * wv;
  }
  red[(kg * 4 + 0) * 16 + col] = a0; red[(kg * 4 + 1) * 16 + col] = a1;
  red[(kg * 4 + 2) * 16 + col] = a2; red[(kg * 4 + 3) * 16 + col] = a3;
  __syncthreads();
  if (tid < 64) {
    const int b = tid >> 4;
    float sum = 0.f;
#pragma unroll
    for (int q = 0; q < 16; ++q) sum += red[(q * 4 + b) * 16 + col];
    float* mod = (float*)(p.ws + WS_MOD);
    mod[(size_t)(l * 4 + b) * 3072 + n] = sum + p.ada_b[l * 3072 + n];
  }
}

__device__ __forceinline__ void phase_setup(const P& p, unsigned char* smem) {
  const int M0 = 384, T0 = M0 + 16 * 58, T1 = T0 + 256, T5 = T1 + 1;
  for (int rep = 0; rep < REP0; ++rep)
  for (int it = blockIdx.x; it < T5; it += gridDim.x) {
    if (it < M0) mod_item(p, it, smem);
    else if (it < T0) transpose_item(p.e_w_in, EVEN_N, (bf16*)(p.ws + WS_WEI), it - M0, smem);
    else if (it < T1) transpose_item(p.e_w_out, 1024, (bf16*)(p.ws + WS_WEO), it - T0, smem);
    else {
      float* lbv = (float*)(p.ws + WS_LB);
      for (int j = threadIdx.x; j < 512; j += 256) {
        float a = p.hgrn_lb[j], bb = p.hgrn_lb[512 + j];
        lbv[j] = 1.f / (1.f + __expf(a - bb));
      }
    }
    __syncthreads();
  }
}

__device__ __forceinline__ void phase_h0(const P& p) {
  const float* mod = (const float*)(p.ws + WS_MOD);
  bf16* hb = (bf16*)(p.ws + WS_H);
  const size_t total = (size_t)M_TOK * 128;
  for (size_t i = (size_t)blockIdx.x * 256 + threadIdx.x; i < total; i += (size_t)gridDim.x * 256) {
    int m = (int)(i >> 7), n = (int)(i & 127) * 8, b = m >> 12;
    const float4* xp = (const float4*)(p.x + (size_t)m * 1024 + n);
    const float4* sh = (const float4*)(mod + (size_t)b * 3072 + n);
    const float4* sc = (const float4*)(mod + (size_t)b * 3072 + 1024 + n);
    float4 x0 = xp[0], x1 = xp[1], s0 = sh[0], s1 = sh[1], c0 = sc[0], c1 = sc[1];
    uint4 o;
    o.x = (unsigned)f2bf(x0.x * (1.f + c0.x) + s0.x) | ((unsigned)f2bf(x0.y * (1.f + c0.y) + s0.y) << 16);
    o.y = (unsigned)f2bf(x0.z * (1.f + c0.z) + s0.z) | ((unsigned)f2bf(x0.w * (1.f + c0.w) + s0.w) << 16);
    o.z = (unsigned)f2bf(x1.x * (1.f + c1.x) + s1.x) | ((unsigned)f2bf(x1.y * (1.f + c1.y) + s1.y) << 16);
    o.w = (unsigned)f2bf(x1.z * (1.f + c1.z) + s1.z) | ((unsigned)f2bf(x1.w * (1.f + c1.w) + s1.w) << 16);
    *(uint4*)(hb + (size_t)m * 1024 + n) = o;
  }
}

#ifndef GEMM_NST
#define GEMM_NST 2
#endif
#define LSTR 64
__device__ __forceinline__ void gemm_issue(const bf16* __restrict__ A, int lda, const bf16* __restrict__ Bt, int m0, int n0,
                                           u32x4 (&ra)[GEMM_NST][4], u32x4 (&rb)[GEMM_NST][4]) {
  const int tid = threadIdx.x, lrow = tid >> 3, lkc = tid & 7;
  const bf16* Ag = A + (size_t)(m0 + lrow) * lda + lkc * 8;
  const bf16* Bg = Bt + (size_t)(n0 + lrow) * 1024 + lkc * 8;
#pragma unroll
  for (int t = 0; t < GEMM_NST; ++t)
#pragma unroll
    for (int i = 0; i < 4; ++i) {
      ra[t][i] = gload16_asm(Ag + (size_t)i * 32 * lda + t * 64);
      rb[t][i] = gload16_asm(Bg + (size_t)i * 32 * 1024 + t * 64);
    }
}

template <int EPI, typename NextFn>
__device__ __forceinline__ void gemm_tile(const bf16* __restrict__ A, int lda, const bf16* __restrict__ Bt, int m0, int n0,
                                          unsigned char* smem, bf16* __restrict__ C, int ldc, int nreal,
                                          const float* __restrict__ X, float* __restrict__ R, const float* __restrict__ gate,
                                          const float* __restrict__ ssqp, u32x4 (&ra)[GEMM_NST][4], u32x4 (&rb)[GEMM_NST][4],
                                          NextFn&& next_issue) {
  bf16* As = (bf16*)smem;
  bf16* Bs = As + 2 * 128 * LSTR;
  const int tid = threadIdx.x, lane = tid & 63, wave = tid >> 6;
  const int wm = wave >> 1, wn = wave & 1;
  f32x4 acc[4][4];
#pragma unroll
  for (int i = 0; i < 4; ++i)
#pragma unroll
    for (int j = 0; j < 4; ++j) acc[i][j] = (f32x4){0.f, 0.f, 0.f, 0.f};
  float rsv[4] = {1.f, 1.f, 1.f, 1.f};
  if (EPI == 2) {
#pragma unroll
    for (int j = 0; j < 4; ++j) {
      const int m = m0 + wm * 64 + j * 16 + (lane & 15);
      rsv[j] = rsqrtf((ssqp[m] + ssqp[M_TOK + m]) * (1.f / 512.f) + 1e-6f);
    }
  }
  const int lrow = tid >> 3, lkc = tid & 7;
  const int lsw = (lkc ^ (lrow & 7)) * 8;
  const bf16* Ag = A + (size_t)(m0 + lrow) * lda + lkc * 8;
  const bf16* Bg = Bt + (size_t)(n0 + lrow) * 1024 + lkc * 8;
  if (GEMM_NST == 3) {
    asm volatile("s_waitcnt vmcnt(16)"
                 : "+v"(ra[0][0]), "+v"(ra[0][1]), "+v"(ra[0][2]), "+v"(ra[0][3]), "+v"(rb[0][0]), "+v"(rb[0][1]), "+v"(rb[0][2]), "+v"(rb[0][3])
                 :: "memory");
  } else {
    asm volatile("s_waitcnt vmcnt(8)"
                 : "+v"(ra[0][0]), "+v"(ra[0][1]), "+v"(ra[0][2]), "+v"(ra[0][3]), "+v"(rb[0][0]), "+v"(rb[0][1]), "+v"(rb[0][2]), "+v"(rb[0][3])
                 :: "memory");
  }
#pragma unroll
  for (int i = 0; i < 4; ++i) {
    *(u32x4*)(As + (lrow + i * 32) * LSTR + lsw) = ra[0][i];
    *(u32x4*)(Bs + (lrow + i * 32) * LSTR + lsw) = rb[0][i];
  }
  __syncthreads();
#pragma unroll
  for (int kt = 0; kt < 16; ++kt) {
    const int buf = kt & 1;
    if (kt + 1 < 16) {
      const int sn = (kt + 1) % GEMM_NST;
      if (GEMM_NST == 3 && kt + 2 < 16) {
        asm volatile("s_waitcnt vmcnt(8)"
                     : "+v"(ra[sn][0]), "+v"(ra[sn][1]), "+v"(ra[sn][2]), "+v"(ra[sn][3]), "+v"(rb[sn][0]), "+v"(rb[sn][1]), "+v"(rb[sn][2]), "+v"(rb[sn][3])
                     :: "memory");
      } else {
        asm volatile("s_waitcnt vmcnt(0)"
                     : "+v"(ra[sn][0]), "+v"(ra[sn][1]), "+v"(ra[sn][2]), "+v"(ra[sn][3]), "+v"(rb[sn][0]), "+v"(rb[sn][1]), "+v"(rb[sn][2]), "+v"(rb[sn][3])
                     :: "memory");
      }
      bf16* Aw = As + (buf ^ 1) * 128 * LSTR;
      bf16* Bw = Bs + (buf ^ 1) * 128 * LSTR;
#pragma unroll
      for (int i = 0; i < 4; ++i) {
        *(u32x4*)(Aw + (lrow + i * 32) * LSTR + lsw) = ra[sn][i];
        *(u32x4*)(Bw + (lrow + i * 32) * LSTR + lsw) = rb[sn][i];
      }
    }
    if (kt + GEMM_NST < 16) {
#pragma unroll
      for (int i = 0; i < 4; ++i) {
        ra[kt % GEMM_NST][i] = gload16_asm(Ag + (size_t)i * 32 * lda + (kt + GEMM_NST) * 64);
        rb[kt % GEMM_NST][i] = gload16_asm(Bg + (size_t)i * 32 * 1024 + (kt + GEMM_NST) * 64);
      }
    }
    const bf16* Ab = As + buf * 128 * LSTR;
    const bf16* Bb = Bs + buf * 128 * LSTR;
    if (EPI == 2 && kt == 8) {
#pragma unroll
      for (int j = 0; j < 4; ++j) {
        const float inv = frcp(rsv[j]);
#pragma unroll
        for (int i = 0; i < 4; ++i) { acc[i][j][0] *= inv; acc[i][j][1] *= inv; acc[i][j][2] *= inv; acc[i][j][3] *= inv; }
      }
    }
#pragma unroll
    for (int s = 0; s < 2; ++s) {
      bf16x8 wf[4], xf[4];
#pragma unroll
      for (int i = 0; i < 4; ++i) {
        wf[i] = *(const bf16x8*)(Bb + (wn * 64 + i * 16 + (lane & 15)) * LSTR + (((s * 4 + (lane >> 4)) ^ (lane & 7)) * 8));
        xf[i] = *(const bf16x8*)(Ab + (wm * 64 + i * 16 + (lane & 15)) * LSTR + (((s * 4 + (lane >> 4)) ^ (lane & 7)) * 8));
      }
#pragma unroll
      for (int i = 0; i < 4; ++i)
#pragma unroll
        for (int j = 0; j < 4; ++j) acc[i][j] = __builtin_amdgcn_mfma_f32_16x16x32_bf16(wf[i], xf[j], acc[i][j], 0, 0, 0);
    }
    __syncthreads();
  }
  next_issue();
#pragma unroll
  for (int i = 0; i < 4; ++i) {
    const int n = n0 + wn * 64 + i * 16 + (lane >> 4) * 4;
#pragma unroll
    for (int j = 0; j < 4; ++j) {
      const int m = m0 + wm * 64 + j * 16 + (lane & 15);
      f32x4 a = acc[i][j];
      if (EPI == 2) { a[0] *= rsv[j]; a[1] *= rsv[j]; a[2] *= rsv[j]; a[3] *= rsv[j]; }
      if (EPI == 0) {
        if (n < nreal) {
          uint2 o;
          o.x = (unsigned)f2bf(a[0]) | ((unsigned)f2bf(a[1]) << 16);
          o.y = (unsigned)f2bf(a[2]) | ((unsigned)f2bf(a[3]) << 16);
          *(uint2*)(C + (size_t)m * ldc + n) = o;
        }
      } else {
        const int b = m >> 12;
        float4 xv;
        if (EPI == 2) {
          uint2 xu = *(const uint2*)((const bf16*)X + (size_t)m * 1024 + n);
          xv.x = __uint_as_float(xu.x << 16); xv.y = __uint_as_float(xu.x & 0xffff0000u);
          xv.z = __uint_as_float(xu.y << 16); xv.w = __uint_as_float(xu.y & 0xffff0000u);
        } else xv = *(const float4*)(X + (size_t)m * 1024 + n);
        float4 g = *(const float4*)(gate + (size_t)b * 3072 + n);
        float4 o;
        o.x = ALPHA * xv.x + g.x * a[0];
        o.y = ALPHA * xv.y + g.y * a[1];
        o.z = ALPHA * xv.z + g.z * a[2];
        o.w = ALPHA * xv.w + g.w * a[3];
        *(float4*)(R + (size_t)m * 1024 + n) = o;
      }
    }
  }
}

template <int EPI>
__device__ __forceinline__ void phase_gemm(const bf16* A, int lda, const bf16* Bt, int ntn, unsigned char* smem, bf16* C, int ldc, int nreal,
                           const float* X, float* R, const float* gate, unsigned* bar, int gidx, const float* ssqp = nullptr) {
  volatile unsigned* stw = (volatile unsigned*)(smem + 73728);
  const unsigned xid = (unsigned)__builtin_amdgcn_s_getreg((3 << 11) | 20) & 0xFu;
  int xidx = 0, nx = 0;
#pragma unroll
  for (int j = 0; j < 16; ++j) {
    const unsigned c = __hip_atomic_load(&bar[256 + 64 * j], __ATOMIC_RELAXED, __HIP_MEMORY_SCOPE_AGENT);
    if (c > 0u) { nx++; if ((unsigned)j < xid) xidx++; }
  }
  const int mt_lo = (xidx * 128) / nx, mt_hi = ((xidx + 1) * 128) / nx;
  const int total = (mt_hi - mt_lo) * ntn;
  unsigned* qc = bar + 3456 + (gidx * 16 + xidx) * 8;
  u32x4 ra[GEMM_NST][4], rb[GEMM_NST][4];
  int mt = 0, nt = 0;
  bool valid = false;
  auto fetch = [&](int& mt_o, int& nt_o) -> bool {
    __syncthreads();
    if (threadIdx.x == 0) stw[2] = __hip_atomic_fetch_add(qc, 1u, __ATOMIC_RELAXED, __HIP_MEMORY_SCOPE_AGENT);
    __syncthreads();
    const int t = (int)stw[2];
    if (t >= total) return false;
    const int g8 = t / (8 * ntn), r = t - g8 * 8 * ntn;
    const int rows = mt_hi - mt_lo - g8 * 8;
    const int gm = rows < 8 ? rows : 8;
    nt_o = r / gm; mt_o = mt_lo + g8 * 8 + (r - nt_o * gm);
    return true;
  };
  valid = fetch(mt, nt);
  if (valid) gemm_issue(A, lda, Bt, mt * 128, nt * 128, ra, rb);
  while (valid) {
    int mt2 = 0, nt2 = 0;
    bool valid2 = false;
    gemm_tile<EPI>(A, lda, Bt, mt * 128, nt * 128, smem, C, ldc, nreal, X, R, gate, ssqp, ra, rb, [&]() {
      valid2 = fetch(mt2, nt2);
      if (valid2) gemm_issue(A, lda, Bt, mt2 * 128, nt2 * 128, ra, rb);
    });
    mt = mt2; nt = nt2; valid = valid2;
  }
}

__device__ __forceinline__ void phase_ln(const P& p, int l, bool write_h, const unsigned char* probe_ts = nullptr) {
  const float* mod = (const float*)(p.ws + WS_MOD);
  bf16* hb = (bf16*)(p.ws + WS_H);
  const int lane = threadIdx.x & 63, wave = threadIdx.x >> 6;
  const float* g = p.ln_g + l * 1024;
  const float* bb = p.ln_b + l * 1024;
  constexpr int NR = 4;
  for (int grp = blockIdx.x * 4 + wave; grp < M_TOK / NR; grp += gridDim.x * 4) {
    float4 v[NR][4];
    float s[NR];
#pragma unroll
    for (int r = 0; r < NR; ++r) {
      const float* rp = (const float*)(p.ws + WS_ST) + (size_t)(grp * NR + r) * 1024;
#pragma unroll
      for (int q = 0; q < 4; ++q) v[r][q] = *(const float4*)(rp + (lane + 64 * q) * 4);
    }
#pragma unroll
    for (int r = 0; r < NR; ++r) {
      s[r] = 0.f;
#pragma unroll
      for (int q = 0; q < 4; ++q) s[r] += v[r][q].x + v[r][q].y + v[r][q].z + v[r][q].w;
    }
#pragma unroll
    for (int o = 32; o > 0; o >>= 1)
#pragma unroll
      for (int r = 0; r < NR; ++r) s[r] += __shfl_xor(s[r], o, 64);
    float mu[NR], s2[NR];
#pragma unroll
    for (int r = 0; r < NR; ++r) {
      mu[r] = s[r] * (1.f / 1024.f);
      s2[r] = 0.f;
#pragma unroll
      for (int q = 0; q < 4; ++q) {
        float a = v[r][q].x - mu[r], b2 = v[r][q].y - mu[r], c2 = v[r][q].z - mu[r], d2 = v[r][q].w - mu[r];
        s2[r] += a * a + b2 * b2 + c2 * c2 + d2 * d2;
      }
    }
#pragma unroll
    for (int o = 32; o > 0; o >>= 1)
#pragma unroll
      for (int r = 0; r < NR; ++r) s2[r] += __shfl_xor(s2[r], o, 64);
#pragma unroll
    for (int q = 0; q < 4; ++q) {
      const int n = (lane + 64 * q) * 4;
      const float4 gg = *(const float4*)(g + n), be = *(const float4*)(bb + n);
#pragma unroll
      for (int r = 0; r < NR; ++r) {
        const int row = grp * NR + r;
        const float rstd = rsqrtf(s2[r] * (1.f / 1024.f) + 1e-5f);
        float4 o;
        o.x = (v[r][q].x - mu[r]) * rstd * gg.x + be.x;
        o.y = (v[r][q].y - mu[r]) * rstd * gg.y + be.y;
        o.z = (v[r][q].z - mu[r]) * rstd * gg.z + be.z;
        o.w = (v[r][q].w - mu[r]) * rstd * gg.w + be.w;
        if (PROBE_PH >= 0 && l == 1 && row == 0) {
          const long long* ts = (const long long*)(probe_ts);
          const int kus = (int)((ts[PROBE_PH + 1] - ts[PROBE_PH]) / 100);
          if (n + 0 < kus) o.x += 0.125f;
          if (n + 1 < kus) o.y += 0.125f;
          if (n + 2 < kus) o.z += 0.125f;
          if (n + 3 < kus) o.w += 0.125f;
        }
        if (!write_h) *(float4*)(p.out + (size_t)row * 1024 + n) = o;
        if (write_h) {
          const int b = row >> 12;
          uint2 xb16;
          xb16.x = (unsigned)f2bf(o.x) | ((unsigned)f2bf(o.y) << 16);
          xb16.y = (unsigned)f2bf(o.z) | ((unsigned)f2bf(o.w) << 16);
          *(uint2*)((bf16*)p.out + (size_t)row * 1024 + n) = xb16;
          const float* md = mod + (size_t)(4 + b) * 3072;
          float4 sh = *(const float4*)(md + n), sc = *(const float4*)(md + 1024 + n);
          uint2 hh;
          hh.x = (unsigned)f2bf(o.x * (1.f + sc.x) + sh.x) | ((unsigned)f2bf(o.y * (1.f + sc.y) + sh.y) << 16);
          hh.y = (unsigned)f2bf(o.z * (1.f + sc.z) + sh.z) | ((unsigned)f2bf(o.w * (1.f + sc.w) + sh.w) << 16);
          *(uint2*)(hb + (size_t)row * 1024 + n) = hh;
        }
      }
    }
  }
}

__device__ __forceinline__ void na_item(const P& p, int item, unsigned char* smem) {
  const int h = item & 7, r = (item >> 3) & 63, b = item >> 9;
  bf16* VT = (bf16*)smem;
  float* RPB = (float*)(VT + 64 * 520);
  const bf16* projb = (const bf16*)(p.ws + WS_PROJ) + (size_t)b * 4096 * EVEN_N;
  bf16* yb = (bf16*)(p.ws + WS_H);
  const int tid = threadIdx.x, lane = tid & 63, n = tid >> 6;
  const int q = lane & 15, g4 = lane >> 4;
  int rs = r - 4; rs = rs < 0 ? 0 : (rs > 56 ? 56 : rs);
#pragma unroll 8
  for (int i = 0; i < 16; ++i) {
    const int key = (i >> 3) * 256 + tid, ch = i & 7;
    const int tok = (rs + (key >> 6)) * 64 + (key & 63);
    uint4 u = *(const uint4*)(projb + (size_t)tok * EVEN_N + 1024 + h * 64 + ch * 8);
    bf16* dst = VT + (ch * 8) * 520 + key;
    dst[0 * 520] = (bf16)(u.x & 0xffffu); dst[1 * 520] = (bf16)(u.x >> 16);
    dst[2 * 520] = (bf16)(u.y & 0xffffu); dst[3 * 520] = (bf16)(u.y >> 16);
    dst[4 * 520] = (bf16)(u.z & 0xffffu); dst[5 * 520] = (bf16)(u.z >> 16);
    dst[6 * 520] = (bf16)(u.w & 0xffffu); dst[7 * 520] = (bf16)(u.w >> 16);
  }
  for (int i = tid; i < 465; i += 256) RPB[i] = p.e_rpb[h * 465 + i];
  const int qcol = n * 16 + q;
  const int qtok = r * 64 + qcol;
  const int bs = n == 0 ? 0 : (n == 1 ? 8 : (n == 2 ? 24 : 32));
  const bf16x8 qf0 = *(const bf16x8*)(projb + (size_t)qtok * EVEN_N + h * 64 + g4 * 8);
  const bf16x8 qf1 = *(const bf16x8*)(projb + (size_t)qtok * EVEN_N + h * 64 + 32 + g4 * 8);
  f32x4 st[16];
#pragma unroll
  for (int tt = 0; tt < 16; ++tt) {
    const int ktok = (rs + (tt >> 1)) * 64 + bs + (tt & 1) * 16 + q;
    const bf16* kp = projb + (size_t)ktok * EVEN_N + 512 + h * 64 + g4 * 8;
    bf16x8 kf0 = *(const bf16x8*)kp, kf1 = *(const bf16x8*)(kp + 32);
    f32x4 z = (f32x4){0.f, 0.f, 0.f, 0.f};
    z = __builtin_amdgcn_mfma_f32_16x16x32_bf16(kf0, qf0, z, 0, 0, 0);
    st[tt] = __builtin_amdgcn_mfma_f32_16x16x32_bf16(kf1, qf1, z, 0, 0, 0);
  }
  __syncthreads();
  int cs = qcol - 8; cs = cs < 0 ? 0 : (cs > 48 ? 48 : cs);
  float mx = -1e30f;
#pragma unroll
  for (int tt = 0; tt < 16; ++tt) {
    const float* brow = RPB + (rs + (tt >> 1) - r + 7) * 31;
#pragma unroll
    for (int rr = 0; rr < 4; ++rr) {
      const int kcol = bs + (tt & 1) * 16 + g4 * 4 + rr;
      const bool valid = (kcol >= cs) && (kcol < cs + 16);
      int dc = kcol - qcol + 15; dc = dc < 0 ? 0 : (dc > 30 ? 30 : dc);
      const float sc = valid ? st[tt][rr] * 0.125f + brow[dc] : -1e30f;
      st[tt][rr] = sc;
      mx = fmaxf(mx, sc);
    }
  }
  mx = fmaxf(mx, __shfl_xor(mx, 16, 64));
  mx = fmaxf(mx, __shfl_xor(mx, 32, 64));
  float lsum = 0.f;
#pragma unroll
  for (int tt = 0; tt < 16; ++tt)
#pragma unroll
    for (int rr = 0; rr < 4; ++rr) {
      const float pe = __expf(st[tt][rr] - mx);
      st[tt][rr] = pe;
      lsum += pe;
    }
  lsum += __shfl_xor(lsum, 16, 64);
  lsum += __shfl_xor(lsum, 32, 64);
  f32x4 ot[4];
#pragma unroll
  for (int dt = 0; dt < 4; ++dt) ot[dt] = (f32x4){0.f, 0.f, 0.f, 0.f};
#pragma unroll
  for (int kr = 0; kr < 8; ++kr) {
    uint4 pw;
    pw.x = (unsigned)f2bf(st[2 * kr][0]) | ((unsigned)f2bf(st[2 * kr][1]) << 16);
    pw.y = (unsigned)f2bf(st[2 * kr][2]) | ((unsigned)f2bf(st[2 * kr][3]) << 16);
    pw.z = (unsigned)f2bf(st[2 * kr + 1][0]) | ((unsigned)f2bf(st[2 * kr + 1][1]) << 16);
    pw.w = (unsigned)f2bf(st[2 * kr + 1][2]) | ((unsigned)f2bf(st[2 * kr + 1][3]) << 16);
    const bf16x8 pf = *(bf16x8*)&pw;
#pragma unroll
    for (int dt = 0; dt < 4; ++dt) {
      const bf16* vp = VT + (dt * 16 + q) * 520 + kr * 64 + bs + g4 * 4;
      uint2 lo = *(const uint2*)vp, hi = *(const uint2*)(vp + 16);
      uint4 vw; vw.x = lo.x; vw.y = lo.y; vw.z = hi.x; vw.w = hi.y;
      ot[dt] = __builtin_amdgcn_mfma_f32_16x16x32_bf16(*(bf16x8*)&vw, pf, ot[dt], 0, 0, 0);
    }
  }
  const float inv = frcp(lsum);
#pragma unroll
  for (int dt = 0; dt < 4; ++dt) {
    const int d0 = dt * 16 + g4 * 4;
    uint2 gu = *(const uint2*)(projb + (size_t)qtok * EVEN_N + 1536 + h * 64 + d0);
    f32x4 y;
    y[0] = ot[dt][0] * inv * silu_f(__uint_as_float(gu.x << 16));
    y[1] = ot[dt][1] * inv * silu_f(__uint_as_float(gu.x & 0xffff0000u));
    y[2] = ot[dt][2] * inv * silu_f(__uint_as_float(gu.y << 16));
    y[3] = ot[dt][3] * inv * silu_f(__uint_as_float(gu.y & 0xffff0000u));
    uint2 o;
    o.x = (unsigned)f2bf(y[0]) | ((unsigned)f2bf(y[1]) << 16);
    o.y = (unsigned)f2bf(y[2]) | ((unsigned)f2bf(y[3]) << 16);
    *(uint2*)(yb + ((size_t)b * 4096 + qtok) * 1024 + h * 64 + d0) = o;
  }
}

template <int K, int MODE>
struct GateC {
  float w[16];
  float bias, lb;
  int d, ch;
  __device__ __forceinline__ void init(const P& p, int d_, int h, int k) {
    d = d_; ch = h * K + k;
    if (MODE == 0) {
#pragma unroll
      for (int r = 0; r < 16; ++r) w[r] = p.gla_w_up[(d * 16 + r) * 256 + ch];
      bias = p.gla_b[d * 256 + ch];
      lb = 0.f;
    } else {
      lb = ((const float*)(p.ws + WS_LB))[ch];
      bias = 0.f;
    }
  }
  __device__ __forceinline__ void eval_vals(bf16 a, bf16 bz, const bf16* lr, float& g, float& kval, float& qval) const {
    if (MODE == 0) {
      uint4 u0 = *(const uint4*)(lr);
      uint4 u1 = *(const uint4*)(lr + 8);
      float z = bias;
      z += w[0] * __uint_as_float(u0.x << 16) + w[1] * __uint_as_float(u0.x & 0xffff0000u);
      z += w[2] * __uint_as_float(u0.y << 16) + w[3] * __uint_as_float(u0.y & 0xffff0000u);
      z += w[4] * __uint_as_float(u0.z << 16) + w[5] * __uint_as_float(u0.z & 0xffff0000u);
      z += w[6] * __uint_as_float(u0.w << 16) + w[7] * __uint_as_float(u0.w & 0xffff0000u);
      z += w[8] * __uint_as_float(u1.x << 16) + w[9] * __uint_as_float(u1.x & 0xffff0000u);
      z += w[10] * __uint_as_float(u1.y << 16) + w[11] * __uint_as_float(u1.y & 0xffff0000u);
      z += w[12] * __uint_as_float(u1.z << 16) + w[13] * __uint_as_float(u1.z & 0xffff0000u);
      z += w[14] * __uint_as_float(u1.w << 16) + w[15] * __uint_as_float(u1.w & 0xffff0000u);
      g = log_sigmoid_f(z) * (1.f / 16.f);
      kval = bf2f(bz);
      qval = bf2f(a) * 0.125f;
    } else {
      const float z = bf2f(bz);
      const float e = __expf(-z);
      const float sg = frcp(1.f + e);
      kval = (1.f - lb) * e * sg;
      g = flog(1.f - kval);
      qval = bf2f(a) * 0.08838834764831845f;
    }
  }
  __device__ __forceinline__ void eval(const bf16* row, float& g, float& kval, float& qval) const {
    if (MODE == 0) {
      uint4 u0 = *(const uint4*)(row + 3584 + d * 16);
      uint4 u1 = *(const uint4*)(row + 3584 + d * 16 + 8);
      float z = bias;
      z += w[0] * __uint_as_float(u0.x << 16) + w[1] * __uint_as_float(u0.x & 0xffff0000u);
      z += w[2] * __uint_as_float(u0.y << 16) + w[3] * __uint_as_float(u0.y & 0xffff0000u);
      z += w[4] * __uint_as_float(u0.z << 16) + w[5] * __uint_as_float(u0.z & 0xffff0000u);
      z += w[6] * __uint_as_float(u0.w << 16) + w[7] * __uint_as_float(u0.w & 0xffff0000u);
      z += w[8] * __uint_as_float(u1.x << 16) + w[9] * __uint_as_float(u1.x & 0xffff0000u);
      z += w[10] * __uint_as_float(u1.y << 16) + w[11] * __uint_as_float(u1.y & 0xffff0000u);
      z += w[12] * __uint_as_float(u1.z << 16) + w[13] * __uint_as_float(u1.z & 0xffff0000u);
      z += w[14] * __uint_as_float(u1.w << 16) + w[15] * __uint_as_float(u1.w & 0xffff0000u);
      g = log_sigmoid_f(z) * (1.f / 16.f);
      kval = bf2f(row[2304 + ch]);
      qval = bf2f(row[2048 + ch]) * 0.125f;
    } else {
      const float z = bf2f(row[512 + d * 512 + ch]);
      const float e = __expf(-z);
      const float sg = frcp(1.f + e);
      kval = (1.f - lb) * e * sg;
      g = flog(1.f - kval);
      qval = bf2f(row[ch]) * 0.08838834764831845f;
    }
  }
};

template <int MODE>
__device__ __forceinline__ void stage_vt(const bf16* proj, int h, bf16* VT) {
  constexpr int LDP = MODE == 0 ? EVEN_N : ODD_N;
  constexpr int VOFF = MODE == 0 ? 2560 : 1536;
  const int j = threadIdx.x & 63, cgp = threadIdx.x >> 6;
#pragma unroll
  for (int cc = 0; cc < 4; ++cc) {
    const int c = cgp * 4 + cc;
    uint4 u = *(const uint4*)(proj + (size_t)j * LDP + VOFF + h * 128 + c * 8);
    bf16* dst = VT + (c * 8) * 72 + j;
    dst[0 * 72] = (bf16)(u.x & 0xffffu); dst[1 * 72] = (bf16)(u.x >> 16);
    dst[2 * 72] = (bf16)(u.y & 0xffffu); dst[3 * 72] = (bf16)(u.y >> 16);
    dst[4 * 72] = (bf16)(u.z & 0xffffu); dst[5 * 72] = (bf16)(u.z >> 16);
    dst[6 * 72] = (bf16)(u.w & 0xffffu); dst[7 * 72] = (bf16)(u.w >> 16);
  }
}

__device__ __forceinline__ uint2 pack4(f32x4 a) {
  uint2 o;
  o.x = (unsigned)f2bf(a[0]) | ((unsigned)f2bf(a[1]) << 16);
  o.y = (unsigned)f2bf(a[2]) | ((unsigned)f2bf(a[3]) << 16);
  return o;
}

template <int K, int MODE>
__device__ __forceinline__ void rec_pass1_item(const P& p, int item, unsigned char* smem) {
  constexpr int LDP = MODE == 0 ? EVEN_N : ODD_N;
  const int h = item & 3, blk = (item >> 2) & 63, b = item >> 8;
  bf16* KT = (bf16*)smem;
  bf16* VT = KT + 2 * K * 72;
  const bf16* proj = (const bf16*)(p.ws + WS_PROJ) + (size_t)(b * 4096 + blk * 64) * LDP;
  bf16* ST = (bf16*)(p.ws + WS_ST);
  float* DEC = (float*)(p.ws + WS_DEC);
  const int tid = threadIdx.x, lane = tid & 63, wave = tid >> 6;
  bf16* TMP = VT;
  if (MODE == 1) {
#pragma unroll
    for (int i = 0; i < 8; ++i) {
      const int c = i * 256 + tid;
      const int ch = c & 15, j = (c >> 4) & 63, d = c >> 10;
      *(uint4*)(TMP + (d * 64 + j) * 128 + ch * 8) = *(const uint4*)(proj + (size_t)j * LDP + 512 + d * 512 + h * 128 + ch * 8);
    }
  } else {
#pragma unroll
    for (int i = 0; i < 2; ++i) {
      const int c = i * 256 + tid;
      const int ch = c & 7, j = c >> 3;
      *(uint4*)(TMP + j * 64 + ch * 8) = *(const uint4*)(proj + (size_t)j * LDP + 2304 + h * 64 + ch * 8);
    }
    {
      const int ch = tid & 3, j = tid >> 2;
      *(uint4*)(TMP + 4096 + j * 32 + ch * 8) = *(const uint4*)(proj + (size_t)j * LDP + 3584 + ch * 8);
    }
  }
  __syncthreads();
  if (tid < 2 * K) {
    const int d = tid / K, k = tid % K;
    GateC<K, MODE> gc;
    gc.init(p, d, h, k);
    bf16* row = KT + (d * K + k) * 72;
    float r = 0.f, rhi = 0.f;
#pragma unroll 4
    for (int i = 63; i >= 0; --i) {
      const int j = d ? 63 - i : i;
      float g, kv, qv;
      if (MODE == 1) gc.eval_vals(0, TMP[(d * 64 + j) * 128 + k], nullptr, g, kv, qv);
      else gc.eval_vals(0, TMP[j * 64 + k], TMP + 4096 + j * 32 + d * 16, g, kv, qv);
      row[j] = f2bf(kv * __expf(r));
      r += g;
      if (i == 32) rhi = r;
    }
    DEC[(size_t)((((d * 4 + b) * 4 + h) * 64 + blk)) * K + k] = __expf(r);
    ((float*)(p.ws + WS_CMID))[(size_t)((((d * 4 + b) * 4 + h) * 64 + blk)) * K + k] = __expf(r - rhi);
  }
  __syncthreads();
  stage_vt<MODE>(proj, h, VT);
  __syncthreads();
#pragma unroll 1
  for (int d = 0; d < 2; ++d) {
    f32x4 acc[K / 16][2];
#pragma unroll
    for (int kt = 0; kt < K / 16; ++kt) { acc[kt][0] = (f32x4){0.f, 0.f, 0.f, 0.f}; acc[kt][1] = (f32x4){0.f, 0.f, 0.f, 0.f}; }
#pragma unroll
    for (int ks = 0; ks < 2; ++ks) {
      bf16x8 vf0 = *(const bf16x8*)(VT + ((wave * 2 + 0) * 16 + (lane & 15)) * 72 + ks * 32 + (lane >> 4) * 8);
      bf16x8 vf1 = *(const bf16x8*)(VT + ((wave * 2 + 1) * 16 + (lane & 15)) * 72 + ks * 32 + (lane >> 4) * 8);
#pragma unroll
      for (int kt = 0; kt < K / 16; ++kt) {
        bf16x8 kf = *(const bf16x8*)(KT + (d * K + kt * 16 + (lane & 15)) * 72 + ks * 32 + (lane >> 4) * 8);
        acc[kt][0] = __builtin_amdgcn_mfma_f32_16x16x32_bf16(kf, vf0, acc[kt][0], 0, 0, 0);
        acc[kt][1] = __builtin_amdgcn_mfma_f32_16x16x32_bf16(kf, vf1, acc[kt][1], 0, 0, 0);
      }
    }
    bf16* stb = ST + (size_t)((((d * 4 + b) * 4 + h) * 64 + blk)) * 128 * K;
#pragma unroll
    for (int kt = 0; kt < K / 16; ++kt)
#pragma unroll
      for (int vv = 0; vv < 2; ++vv) {
        const int v = (wave * 2 + vv) * 16 + (lane & 15);
        const int k0 = kt * 16 + (lane >> 4) * 4;
        *(uint2*)(stb + (size_t)v * K + k0) = pack4(acc[kt][vv]);
      }
  }
}

template <int K>
__device__ __forceinline__ void phase_rec_scan(const P& p) {
  bf16* ST = (bf16*)(p.ws + WS_ST);
  const float* DEC = (const float*)(p.ws + WS_DEC);
  const float* CMID = (const float*)(p.ws + WS_CMID);
  constexpr int KV = K / 4;
  const int total = 32 * 128 * KV;
  for (int idx = blockIdx.x * 256 + threadIdx.x; idx < total; idx += gridDim.x * 256) {
    const int kq = idx % KV, v = (idx / KV) & 127, s = idx / (KV * 128);
    const int d = s >> 4;
    float st0 = 0.f, st1 = 0.f, st2 = 0.f, st3 = 0.f;
#pragma unroll 1
    for (int n0 = 0; n0 < 64; n0 += 8) {
      uint2 u[8];
      float4 dc[8], cm[8];
#pragma unroll
      for (int q = 0; q < 8; ++q) {
        const int blk = d ? 63 - (n0 + q) : (n0 + q);
        u[q] = *(const uint2*)(ST + ((size_t)(s * 64 + blk) * 128 + v) * K + kq * 4);
        dc[q] = *(const float4*)(DEC + (size_t)(s * 64 + blk) * K + kq * 4);
        cm[q] = *(const float4*)(CMID + (size_t)(s * 64 + blk) * K + kq * 4);
      }
#pragma unroll
      for (int q = 0; q < 8; ++q) {
        const int blk = d ? 63 - (n0 + q) : (n0 + q);
        uint2 o;
        o.x = (unsigned)f2bf(st0 * cm[q].x) | ((unsigned)f2bf(st1 * cm[q].y) << 16);
        o.y = (unsigned)f2bf(st2 * cm[q].z) | ((unsigned)f2bf(st3 * cm[q].w) << 16);
        *(uint2*)(ST + ((size_t)(s * 64 + blk) * 128 + v) * K + kq * 4) = o;
        st0 = dc[q].x * st0 + __uint_as_float(u[q].x << 16);
        st1 = dc[q].y * st1 + __uint_as_float(u[q].x & 0xffff0000u);
        st2 = dc[q].z * st2 + __uint_as_float(u[q].y << 16);
        st3 = dc[q].w * st3 + __uint_as_float(u[q].y & 0xffff0000u);
      }
    }
  }
}

template <int K, int MODE>
__device__ __forceinline__ void rec_pass3_item(const P& p, int item, unsigned char* smem) {
  constexpr int LDP = MODE == 0 ? EVEN_N : ODD_N;
  constexpr int KS = K + 8;
  constexpr int GOFF = MODE == 0 ? 3072 : 2048;
  constexpr int YOFF = MODE == 0 ? 512 : 0;
  const int h = item & 3, blk = (item >> 2) & 63, b = item >> 8;
  bf16* QI = (bf16*)smem;
  bf16* KI = QI + 64 * KS;
  bf16* VT = KI + 64 * KS;
  bf16* AI = VT + 128 * 72;
  float* CV = (float*)(AI + 64 * 72);
  float* SSQ = CV + K;
  bf16* LRB = (bf16*)(SSQ + 256);
  const bf16* proj = (const bf16*)(p.ws + WS_PROJ) + (size_t)(b * 4096 + blk * 64) * LDP;
  const bf16* ST = (const bf16*)(p.ws + WS_ST);
  bf16* yb = (bf16*)(p.ws + WS_H);
  const int tid = threadIdx.x, lane = tid & 63, wave = tid >> 6;
  constexpr int VOFF = MODE == 0 ? 2560 : 1536;
  constexpr int QOFF = MODE == 0 ? 2048 : 0;
  constexpr int NQ = K / 32;
  u32x4 rvt[4], rq[4], rz[2][4], rlr[2], stf[2][4][2];
  {
    const int j = tid & 63, cgp = tid >> 6;
#pragma unroll
    for (int cc = 0; cc < 4; ++cc) rvt[cc] = gload16_asm(proj + (size_t)j * LDP + VOFF + h * 128 + (cgp * 4 + cc) * 8);
  }
#pragma unroll
  for (int i = 0; i < NQ; ++i) {
    const int c = i * 256 + tid, ch = c % (K / 8), j = c / (K / 8);
    rq[i] = gload16_asm(proj + (size_t)j * LDP + QOFF + h * K + ch * 8);
    rz[0][i] = gload16_asm(proj + (size_t)j * LDP + (MODE == 0 ? 2304 : 512) + h * K + ch * 8);
  }
  if (MODE == 0) {
    const int ch = tid & 1, j = (tid >> 1) & 63;
    rlr[0] = gload16_asm(proj + (size_t)j * LDP + 3584 + ch * 8);
    rlr[1] = gload16_asm(proj + (size_t)j * LDP + 3600 + ch * 8);
  }
  {
    const bf16* stb = ST + (size_t)((((0 * 4 + b) * 4 + h) * 64 + blk)) * 128 * K;
#pragma unroll
    for (int ks = 0; ks < NQ; ++ks)
#pragma unroll
      for (int vv = 0; vv < 2; ++vv)
        stf[0][ks][vv] = gload16_asm(stb + (size_t)((wave * 2 + vv) * 16 + (lane & 15)) * K + ks * 32 + (lane >> 4) * 8);
  }
  if (MODE == 1) {
    asm volatile("s_waitcnt vmcnt(8)"
                 : "+v"(rvt[0]), "+v"(rvt[1]), "+v"(rvt[2]), "+v"(rvt[3]), "+v"(rq[0]), "+v"(rq[1]), "+v"(rq[2]), "+v"(rq[3]),
                   "+v"(rz[0][0]), "+v"(rz[0][1]), "+v"(rz[0][2]), "+v"(rz[0][3])
                 :: "memory");
  } else {
    asm volatile("s_waitcnt vmcnt(4)"
                 : "+v"(rvt[0]), "+v"(rvt[1]), "+v"(rvt[2]), "+v"(rvt[3]), "+v"(rq[0]), "+v"(rq[1]), "+v"(rz[0][0]), "+v"(rz[0][1]), "+v"(rlr[0]), "+v"(rlr[1])
                 :: "memory");
  }
  {
    const int j = tid & 63, cgp = tid >> 6;
#pragma unroll
    for (int cc = 0; cc < 4; ++cc) {
      const u32x4 u = rvt[cc];
      bf16* dst = VT + ((cgp * 4 + cc) * 8) * 72 + j;
      dst[0 * 72] = (bf16)(u[0] & 0xffffu); dst[1 * 72] = (bf16)(u[0] >> 16);
      dst[2 * 72] = (bf16)(u[1] & 0xffffu); dst[3 * 72] = (bf16)(u[1] >> 16);
      dst[4 * 72] = (bf16)(u[2] & 0xffffu); dst[5 * 72] = (bf16)(u[2] >> 16);
      dst[6 * 72] = (bf16)(u[3] & 0xffffu); dst[7 * 72] = (bf16)(u[3] >> 16);
    }
  }
  f32x4 o[2][4];
#pragma unroll
  for (int vv = 0; vv < 2; ++vv)
#pragma unroll
    for (int it = 0; it < 4; ++it) o[vv][it] = (f32x4){0.f, 0.f, 0.f, 0.f};
#pragma unroll
  for (int d = 0; d < 2; ++d) {
    if (d) __syncthreads();
    if (MODE == 1 && d == 1) {
      asm volatile("s_waitcnt vmcnt(0)" : "+v"(rz[1][0]), "+v"(rz[1][1]), "+v"(rz[1][2]), "+v"(rz[1][3]) :: "memory");
    }
#pragma unroll
    for (int i = 0; i < NQ; ++i) {
      const int c = i * 256 + tid, ch = c % (K / 8), j = c / (K / 8);
      *(u32x4*)(QI + j * KS + ch * 8) = rq[i];
      *(u32x4*)(KI + j * KS + ch * 8) = rz[MODE == 1 ? d : 0][i];
    }
    if (d == 1) {
      const bf16* stb = ST + (size_t)((((1 * 4 + b) * 4 + h) * 64 + blk)) * 128 * K;
#pragma unroll
      for (int ks = 0; ks < NQ; ++ks)
#pragma unroll
        for (int vv = 0; vv < 2; ++vv)
          stf[1][ks][vv] = gload16_asm(stb + (size_t)((wave * 2 + vv) * 16 + (lane & 15)) * K + ks * 32 + (lane >> 4) * 8);
    }
    if (MODE == 1 && d == 0) {
#pragma unroll
      for (int i = 0; i < NQ; ++i) {
        const int c = i * 256 + tid, ch = c % (K / 8), j = c / (K / 8);
        rz[1][i] = gload16_asm(proj + (size_t)j * LDP + 1024 + h * K + ch * 8);
      }
    }
    if (MODE == 0 && tid < 128) {
      const int ch = tid & 1, j = tid >> 1;
      *(u32x4*)(LRB + j * 16 + ch * 8) = rlr[d];
    }
    __syncthreads();
    if (tid < 2 * K) {
      const int k = tid % K, half = tid / K;
      GateC<K, MODE> gc;
      gc.init(p, d, h, k);
      float run = 0.f;
      if (half) {
#pragma unroll 4
        for (int i = 32; i < 64; ++i) {
          const int j = d ? 63 - i : i;
          float g, kv, qv;
          gc.eval_vals(QI[j * KS + k], KI[j * KS + k], LRB + j * 16, g, kv, qv);
          run += g;
          QI[j * KS + k] = f2bf(qv * __expf(run));
          KI[j * KS + k] = f2bf(kv * __expf(-run));
        }
      } else {
#pragma unroll 4
        for (int i = 31; i >= 0; --i) {
          const int j = d ? 63 - i : i;
          float g, kv, qv;
          gc.eval_vals(QI[j * KS + k], KI[j * KS + k], LRB + j * 16, g, kv, qv);
          QI[j * KS + k] = f2bf(qv * __expf(-run));
          KI[j * KS + k] = f2bf(kv * __expf(run));
          run += g;
        }
        CV[k] = __expf(run);
      }
    }
    __syncthreads();
    {
      f32x4 a[4];
#pragma unroll
      for (int jt = 0; jt < 4; ++jt) a[jt] = (f32x4){0.f, 0.f, 0.f, 0.f};
#pragma unroll
      for (int ks = 0; ks < K / 32; ++ks) {
        bf16x8 qf = *(const bf16x8*)(QI + (wave * 16 + (lane & 15)) * KS + ks * 32 + (lane >> 4) * 8);
#pragma unroll
        for (int jt = 0; jt < 4; ++jt) {
          bf16x8 kf = *(const bf16x8*)(KI + (jt * 16 + (lane & 15)) * KS + ks * 32 + (lane >> 4) * 8);
          a[jt] = __builtin_amdgcn_mfma_f32_16x16x32_bf16(kf, qf, a[jt], 0, 0, 0);
        }
      }
      const int i = wave * 16 + (lane & 15);
#pragma unroll
      for (int jt = 0; jt < 4; ++jt) {
        const int j0 = jt * 16 + (lane >> 4) * 4;
        f32x4 m;
#pragma unroll
        for (int r = 0; r < 4; ++r) {
          const int j = j0 + r;
          const bool valid = d ? (j >= i) : (j <= i);
          m[r] = valid ? a[jt][r] : 0.f;
        }
        *(uint2*)(AI + i * 72 + j0) = pack4(m);
      }
    }
    __syncthreads();
#pragma unroll
    for (int ks = 0; ks < 2; ++ks) {
      bf16x8 vf0 = *(const bf16x8*)(VT + ((wave * 2 + 0) * 16 + (lane & 15)) * 72 + ks * 32 + (lane >> 4) * 8);
      bf16x8 vf1 = *(const bf16x8*)(VT + ((wave * 2 + 1) * 16 + (lane & 15)) * 72 + ks * 32 + (lane >> 4) * 8);
#pragma unroll
      for (int it = 0; it < 4; ++it) {
        bf16x8 af = *(const bf16x8*)(AI + (it * 16 + (lane & 15)) * 72 + ks * 32 + (lane >> 4) * 8);
        o[0][it] = __builtin_amdgcn_mfma_f32_16x16x32_bf16(vf0, af, o[0][it], 0, 0, 0);
        o[1][it] = __builtin_amdgcn_mfma_f32_16x16x32_bf16(vf1, af, o[1][it], 0, 0, 0);
      }
    }
    if (d == 0) {
      if (K == 128) {
        asm volatile("s_waitcnt vmcnt(4)"
                     : "+v"(stf[0][0][0]), "+v"(stf[0][0][1]), "+v"(stf[0][1][0]), "+v"(stf[0][1][1]), "+v"(stf[0][2][0]), "+v"(stf[0][2][1]), "+v"(stf[0][3][0]), "+v"(stf[0][3][1])
                     :: "memory");
      } else {
        asm volatile("s_waitcnt vmcnt(0)" : "+v"(stf[0][0][0]), "+v"(stf[0][0][1]), "+v"(stf[0][1][0]), "+v"(stf[0][1][1]) :: "memory");
      }
    } else {
      if (K == 128) {
        asm volatile("s_waitcnt vmcnt(0)"
                     : "+v"(stf[1][0][0]), "+v"(stf[1][0][1]), "+v"(stf[1][1][0]), "+v"(stf[1][1][1]), "+v"(stf[1][2][0]), "+v"(stf[1][2][1]), "+v"(stf[1][3][0]), "+v"(stf[1][3][1])
                     :: "memory");
      } else {
        asm volatile("s_waitcnt vmcnt(0)" : "+v"(stf[1][0][0]), "+v"(stf[1][0][1]), "+v"(stf[1][1][0]), "+v"(stf[1][1][1]) :: "memory");
      }
    }
#pragma unroll
    for (int ks = 0; ks < K / 32; ++ks) {
      const int kk = ks * 32 + (lane >> 4) * 8;
      bf16x8 sf[2];
      sf[0] = *(bf16x8*)&stf[d][ks][0];
      sf[1] = *(bf16x8*)&stf[d][ks][1];
#pragma unroll
      for (int it = 0; it < 4; ++it) {
        bf16x8 qf = *(const bf16x8*)(QI + (it * 16 + (lane & 15)) * KS + kk);
        o[0][it] = __builtin_amdgcn_mfma_f32_16x16x32_bf16(sf[0], qf, o[0][it], 0, 0, 0);
        o[1][it] = __builtin_amdgcn_mfma_f32_16x16x32_bf16(sf[1], qf, o[1][it], 0, 0, 0);
      }
    }
  }
  {
    float ss[4];
#pragma unroll
    for (int it = 0; it < 4; ++it) {
      float s = 0.f;
#pragma unroll
      for (int vv = 0; vv < 2; ++vv)
#pragma unroll
        for (int r = 0; r < 4; ++r) s += o[vv][it][r] * o[vv][it][r];
      s += __shfl_xor(s, 16, 64);
      s += __shfl_xor(s, 32, 64);
      ss[it] = s;
    }
    if (lane < 16) {
#pragma unroll
      for (int it = 0; it < 4; ++it) SSQ[wave * 64 + it * 16 + lane] = ss[it];
    }
    __syncthreads();
    const float* gn = MODE == 0 ? p.gla_g : p.hgrn_g;
#pragma unroll
    for (int it = 0; it < 4; ++it) {
      const int i = it * 16 + (lane & 15);
      const float tot = SSQ[i] + SSQ[64 + i] + SSQ[128 + i] + SSQ[192 + i];
      const float rs = rsqrtf(tot * (1.f / 128.f) + 1e-6f);
#pragma unroll
      for (int vv = 0; vv < 2; ++vv) {
        const int v0 = (wave * 2 + vv) * 16 + (lane >> 4) * 4;
        uint2 gu = *(const uint2*)(proj + (size_t)i * LDP + GOFF + h * 128 + v0);
        float4 gg = *(const float4*)(gn + v0);
        f32x4 y;
        y[0] = o[vv][it][0] * rs * gg.x * silu_f(__uint_as_float(gu.x << 16));
        y[1] = o[vv][it][1] * rs * gg.y * silu_f(__uint_as_float(gu.x & 0xffff0000u));
        y[2] = o[vv][it][2] * rs * gg.z * silu_f(__uint_as_float(gu.y << 16));
        y[3] = o[vv][it][3] * rs * gg.w * silu_f(__uint_as_float(gu.y & 0xffff0000u));
        if (MODE == 1) *(uint2*)((bf16*)proj + (size_t)i * LDP + GOFF + h * 128 + v0) = pack4(y);
        else *(uint2*)(yb + (size_t)(b * 4096 + blk * 64 + i) * 1024 + YOFF + h * 128 + v0) = pack4(y);
      }
    }
  }
}

__device__ __forceinline__ void conv8(const P& p, const bf16* projb, int t, int c0, float* o8) {
  c0 = __builtin_amdgcn_readfirstlane(c0);
  float4 b0 = *(const float4*)(p.conv_b + c0), b1 = *(const float4*)(p.conv_b + c0 + 4);
  float a[8] = {b0.x, b0.y, b0.z, b0.w, b1.x, b1.y, b1.z, b1.w};
#pragma unroll
  for (int jt = 0; jt < 4; ++jt) {
    const int tt = t + jt - 2;
    if (tt >= 0 && tt < 4096) {
      uint4 u = *(const uint4*)(projb + (size_t)tt * ODD_N + 3072 + c0);
      float4 w0 = *(const float4*)(p.conv_w + jt * 1024 + c0), w1 = *(const float4*)(p.conv_w + jt * 1024 + c0 + 4);
      a[0] += w0.x * __uint_as_float(u.x << 16); a[1] += w0.y * __uint_as_float(u.x & 0xffff0000u);
      a[2] += w0.z * __uint_as_float(u.y << 16); a[3] += w0.w * __uint_as_float(u.y & 0xffff0000u);
      a[4] += w1.x * __uint_as_float(u.z << 16); a[5] += w1.y * __uint_as_float(u.z & 0xffff0000u);
      a[6] += w1.z * __uint_as_float(u.w << 16); a[7] += w1.w * __uint_as_float(u.w & 0xffff0000u);
    }
  }
#pragma unroll
  for (int e = 0; e < 8; ++e) o8[e] = silu_f(a[e]);
}

__device__ __forceinline__ void conv8u(const P& p, const bf16* projb, int t, int c0, float* o8) {
  c0 = __builtin_amdgcn_readfirstlane(c0);
  float4 b0 = *(const float4*)(p.conv_b + c0), b1 = *(const float4*)(p.conv_b + c0 + 4);
  float a[8] = {b0.x, b0.y, b0.z, b0.w, b1.x, b1.y, b1.z, b1.w};
  uint4 u[4];
#pragma unroll
  for (int jt = 0; jt < 4; ++jt) {
    int tt = t + jt - 2;
    tt = tt < 0 ? 0 : (tt > 4095 ? 4095 : tt);
    u[jt] = *(const uint4*)(projb + (size_t)tt * ODD_N + 3072 + c0);
  }
#pragma unroll
  for (int jt = 0; jt < 4; ++jt) {
    const int tt = t + jt - 2;
    const float ok = (tt >= 0 && tt < 4096) ? 1.f : 0.f;
    float4 w0 = *(const float4*)(p.conv_w + jt * 1024 + c0), w1 = *(const float4*)(p.conv_w + jt * 1024 + c0 + 4);
    a[0] += ok * w0.x * __uint_as_float(u[jt].x << 16); a[1] += ok * w0.y * __uint_as_float(u[jt].x & 0xffff0000u);
    a[2] += ok * w0.z * __uint_as_float(u[jt].y << 16); a[3] += ok * w0.w * __uint_as_float(u[jt].y & 0xffff0000u);
    a[4] += ok * w1.x * __uint_as_float(u[jt].z << 16); a[5] += ok * w1.y * __uint_as_float(u[jt].z & 0xffff0000u);
    a[6] += ok * w1.z * __uint_as_float(u[jt].w << 16); a[7] += ok * w1.w * __uint_as_float(u[jt].w & 0xffff0000u);
  }
#pragma unroll
  for (int e = 0; e < 8; ++e) o8[e] = silu_f(a[e]);
}

__device__ __forceinline__ void ssd_prep_acum(const P& p, const bf16* projb, int blk, int g, float* ACUM, float* DTV, float* TOT) {
  const int lane = threadIdx.x & 63, wave = threadIdx.x >> 6;
#pragma unroll
  for (int q = 0; q < 2; ++q) {
    const int c = wave * 2 + q, dir = c >> 2, rp = c & 3, head = g * 4 + rp;
    const int j = dir ? 63 - lane : lane;
    const int t = blk * 64 + j;
    const float dt = softplus_f(bf2f(projb[(size_t)t * ODD_N + 4096 + dir * 8 + head]) + p.dt_bias[dir * 8 + head]);
    float v = -__expf(p.a_log[dir * 8 + head]) * dt;
#pragma unroll
    for (int off = 1; off < 64; off <<= 1) {
      float tmp = __shfl_up(v, off, 64);
      if (lane >= off) v += tmp;
    }
    ACUM[c * 64 + j] = v;
    DTV[c * 64 + j] = dt;
    if (lane == 63) TOT[c] = v;
  }
}

__device__ __forceinline__ bf16* ssd_st(const P& p, int s) {
  return s < 32 ? (bf16*)(p.ws + WS_H) + (size_t)s * 524288 : (bf16*)((unsigned char*)p.out + 33554432) + (size_t)(s - 32) * 524288;
}
__device__ __forceinline__ void ssd_pass1_item(const P& p, int item, unsigned char* smem) {
  const int g = item & 1, blk = (item >> 1) & 63, b = item >> 7;
  bf16* BT = (bf16*)smem;
  bf16* XT = BT + 128 * 72;
  float* ACUM = (float*)(XT + 256 * 72);
  float* DTV = ACUM + 512;
  float* TOT = DTV + 512;
  const bf16* projb = (const bf16*)(p.ws + WS_PROJ) + (size_t)b * 4096 * ODD_N;
  float* DEC = (float*)(p.ws + WS_DECS);
  const int tid = threadIdx.x, lane = tid & 63, wave = tid >> 6;
  const int t = blk * 64 + lane;
  ssd_prep_acum(p, projb, blk, g, ACUM, DTV, TOT);
#pragma unroll 2
  for (int q = 0; q < 4; ++q) {
    const int cc = wave + 4 * q;
    float v8[8];
    conv8(p, projb, t, 512 + g * 128 + cc * 8, v8);
#pragma unroll
    for (int e = 0; e < 8; ++e) BT[(cc * 8 + e) * 72 + lane] = f2bf(v8[e]);
  }
  float xs[8][8];
#pragma unroll
  for (int q = 0; q < 8; ++q) conv8(p, projb, t, g * 256 + (wave * 8 + q) * 8, xs[q]);
  __syncthreads();
  if (tid < 8) {
    const int dir = tid >> 2, head = g * 4 + (tid & 3);
    DEC[(size_t)((dir * 4 + b) * 8 + head) * 64 + blk] = __expf(TOT[tid]);
  }
#pragma unroll 1
  for (int dir = 0; dir < 2; ++dir) {
    if (dir) __syncthreads();
    const int c = dir * 4 + wave;
    const float fac = DTV[c * 64 + lane] * __expf(TOT[c] - ACUM[c * 64 + lane]);
#pragma unroll
    for (int q = 0; q < 8; ++q)
#pragma unroll
      for (int e = 0; e < 8; ++e) XT[((wave * 8 + q) * 8 + e) * 72 + lane] = f2bf(xs[q][e] * fac);
    __syncthreads();
    const int head = g * 4 + wave;
    bf16* stb = ssd_st(p, (dir * 4 + b) * 8 + head) + (size_t)blk * 8192;
#pragma unroll 1
    for (int nh = 0; nh < 4; ++nh) {
      f32x4 acc[2][4];
#pragma unroll
      for (int nt = 0; nt < 2; ++nt)
#pragma unroll
        for (int pt = 0; pt < 4; ++pt) acc[nt][pt] = (f32x4){0.f, 0.f, 0.f, 0.f};
#pragma unroll
      for (int ks = 0; ks < 2; ++ks) {
        bf16x8 xf[4];
#pragma unroll
        for (int pt = 0; pt < 4; ++pt) xf[pt] = *(const bf16x8*)(XT + (wave * 64 + pt * 16 + (lane & 15)) * 72 + ks * 32 + (lane >> 4) * 8);
#pragma unroll
        for (int nt = 0; nt < 2; ++nt) {
          bf16x8 bfv = *(const bf16x8*)(BT + ((nh * 2 + nt) * 16 + (lane & 15)) * 72 + ks * 32 + (lane >> 4) * 8);
#pragma unroll
          for (int pt = 0; pt < 4; ++pt) acc[nt][pt] = __builtin_amdgcn_mfma_f32_16x16x32_bf16(bfv, xf[pt], acc[nt][pt], 0, 0, 0);
        }
      }
#pragma unroll
      for (int nt = 0; nt < 2; ++nt)
#pragma unroll
        for (int pt = 0; pt < 4; ++pt) {
          const int pp = pt * 16 + (lane & 15);
          const int n0 = (nh * 2 + nt) * 16 + (lane >> 4) * 4;
          *(uint2*)(stb + (size_t)pp * 128 + n0) = pack4(acc[nt][pt]);
        }
    }
  }
}

__device__ __forceinline__ void phase_ssd_scan(const P& p) {
  const float* DEC = (const float*)(p.ws + WS_DECS);
  const int total = 64 * 2048;
  for (int idx = blockIdx.x * 256 + threadIdx.x; idx < total; idx += gridDim.x * 256) {
    const int e4 = idx & 2047, s = idx >> 11;
    const int d = s >> 5;
    bf16* ST = ssd_st(p, s);
    float st0 = 0.f, st1 = 0.f, st2 = 0.f, st3 = 0.f;
#pragma unroll 1
    for (int n0 = 0; n0 < 64; n0 += 8) {
      uint2 u[8];
      float dc[8];
#pragma unroll
      for (int q = 0; q < 8; ++q) {
        const int blk = d ? 63 - (n0 + q) : (n0 + q);
        u[q] = *(const uint2*)(ST + (size_t)blk * 8192 + e4 * 4);
        dc[q] = DEC[s * 64 + blk];
      }
#pragma unroll
      for (int q = 0; q < 8; ++q) {
        const int blk = d ? 63 - (n0 + q) : (n0 + q);
        uint2 o;
        o.x = (unsigned)f2bf(st0) | ((unsigned)f2bf(st1) << 16);
        o.y = (unsigned)f2bf(st2) | ((unsigned)f2bf(st3) << 16);
        *(uint2*)(ST + (size_t)blk * 8192 + e4 * 4) = o;
        st0 = dc[q] * st0 + __uint_as_float(u[q].x << 16);
        st1 = dc[q] * st1 + __uint_as_float(u[q].x & 0xffff0000u);
        st2 = dc[q] * st2 + __uint_as_float(u[q].y << 16);
        st3 = dc[q] * st3 + __uint_as_float(u[q].y & 0xffff0000u);
      }
    }
  }
}

__device__ __forceinline__ void ssd_pass3_item(const P& p, int item, unsigned char* smem) {
  const int g = item & 1, blk = (item >> 1) & 63, b = item >> 7;
  bf16* CI = (bf16*)smem;
  bf16* BI = CI + 64 * 136;
  bf16* AI = BI;
  bf16* XT = BI + 64 * 136;
  float* ACUM = (float*)(XT + 64 * 72);
  float* DTV = ACUM + 512;
  float* TOT = DTV + 512;
  float* SSQ = TOT + 8;
  bf16* projb = (bf16*)(p.ws + WS_PROJ) + (size_t)b * 4096 * ODD_N;
  const int tid = threadIdx.x, lane = tid & 63, wave = tid >> 6;
  const int t = blk * 64 + lane;
  ssd_prep_acum(p, projb, blk, g, ACUM, DTV, TOT);
#pragma unroll 4
  for (int q = 0; q < 8; ++q) {
    const int cc = wave * 8 + q, which = cc >> 4, ch = (cc & 15) * 8;
    float v8[8];
    conv8u(p, projb, t, 512 + which * 256 + g * 128 + ch, v8);
    uint4 w;
    w.x = (unsigned)f2bf(v8[0]) | ((unsigned)f2bf(v8[1]) << 16);
    w.y = (unsigned)f2bf(v8[2]) | ((unsigned)f2bf(v8[3]) << 16);
    w.z = (unsigned)f2bf(v8[4]) | ((unsigned)f2bf(v8[5]) << 16);
    w.w = (unsigned)f2bf(v8[6]) | ((unsigned)f2bf(v8[7]) << 16);
    *(uint4*)((which ? CI : BI) + lane * 136 + ch) = w;
  }
  __syncthreads();
  f32x4 gt[4];
#pragma unroll
  for (int jt = 0; jt < 4; ++jt) gt[jt] = (f32x4){0.f, 0.f, 0.f, 0.f};
#pragma unroll
  for (int ks = 0; ks < 4; ++ks) {
    bf16x8 cf = *(const bf16x8*)(CI + (wave * 16 + (lane & 15)) * 136 + ks * 32 + (lane >> 4) * 8);
#pragma unroll
    for (int jt = 0; jt < 4; ++jt) {
      bf16x8 bfv = *(const bf16x8*)(BI + (jt * 16 + (lane & 15)) * 136 + ks * 32 + (lane >> 4) * 8);
      gt[jt] = __builtin_amdgcn_mfma_f32_16x16x32_bf16(bfv, cf, gt[jt], 0, 0, 0);
    }
  }
  __syncthreads();
  float ssq_acc[4] = {0.f, 0.f, 0.f, 0.f};
#pragma unroll 1
  for (int rp = 0; rp < 4; ++rp) {
    const int head = g * 4 + rp;
    u32x4 stf[2][4];
    u32x2 zur[4];
#pragma unroll
    for (int dir = 0; dir < 2; ++dir) {
      const bf16* stb = ssd_st(p, (dir * 4 + b) * 8 + head) + (size_t)blk * 8192;
#pragma unroll
      for (int ks = 0; ks < 4; ++ks) stf[dir][ks] = gload16_asm(stb + (size_t)(wave * 16 + (lane & 15)) * 128 + ks * 32 + (lane >> 4) * 8);
    }
#pragma unroll
    for (int it = 0; it < 4; ++it)
      zur[it] = gload8_asm(projb + (size_t)(blk * 64 + it * 16 + (lane & 15)) * ODD_N + 2560 + head * 64 + wave * 16 + (lane >> 4) * 4);
#pragma unroll 2
    for (int q = 0; q < 2; ++q) {
      const int cc = wave * 2 + q;
      float v8[8];
      conv8u(p, projb, t, head * 64 + cc * 8, v8);
#pragma unroll
      for (int e = 0; e < 8; ++e) XT[(cc * 8 + e) * 72 + lane] = f2bf(v8[e]);
    }
    f32x4 o[4];
#pragma unroll
    for (int it = 0; it < 4; ++it) o[it] = (f32x4){0.f, 0.f, 0.f, 0.f};
#pragma unroll
    for (int dir = 0; dir < 2; ++dir) {
      const int c = dir * 4 + rp;
      {
        const int i = wave * 16 + (lane & 15);
        const float aci = ACUM[c * 64 + i];
#pragma unroll
        for (int jt = 0; jt < 4; ++jt) {
          const int j0 = jt * 16 + (lane >> 4) * 4;
          f32x4 m;
#pragma unroll
          for (int r = 0; r < 4; ++r) {
            const int j = j0 + r;
            const bool valid = dir ? (j >= i) : (j <= i);
            const float arg = fminf(aci - ACUM[c * 64 + j], 0.f);
            m[r] = valid ? gt[jt][r] * __expf(arg) * DTV[c * 64 + j] : 0.f;
          }
          *(uint2*)(AI + i * 72 + j0) = pack4(m);
        }
      }
      __syncthreads();
#pragma unroll
      for (int ks = 0; ks < 2; ++ks) {
        bf16x8 xf = *(const bf16x8*)(XT + (wave * 16 + (lane & 15)) * 72 + ks * 32 + (lane >> 4) * 8);
#pragma unroll
        for (int it = 0; it < 4; ++it) {
          bf16x8 af = *(const bf16x8*)(AI + (it * 16 + (lane & 15)) * 72 + ks * 32 + (lane >> 4) * 8);
          o[it] = __builtin_amdgcn_mfma_f32_16x16x32_bf16(xf, af, o[it], 0, 0, 0);
        }
      }
      f32x4 tI[4];
#pragma unroll
      for (int it = 0; it < 4; ++it) tI[it] = (f32x4){0.f, 0.f, 0.f, 0.f};
      asm volatile("s_waitcnt vmcnt(0)" : "+v"(stf[dir][0]), "+v"(stf[dir][1]), "+v"(stf[dir][2]), "+v"(stf[dir][3]) :: "memory");
#pragma unroll
      for (int ks = 0; ks < 4; ++ks) {
        bf16x8 sf = *(bf16x8*)&stf[dir][ks];
#pragma unroll
        for (int it = 0; it < 4; ++it) {
          bf16x8 cf = *(const bf16x8*)(CI + (it * 16 + (lane & 15)) * 136 + ks * 32 + (lane >> 4) * 8);
          tI[it] = __builtin_amdgcn_mfma_f32_16x16x32_bf16(sf, cf, tI[it], 0, 0, 0);
        }
      }
#pragma unroll
      for (int it = 0; it < 4; ++it) {
        const float ea = __expf(ACUM[c * 64 + it * 16 + (lane & 15)]);
#pragma unroll
        for (int r = 0; r < 4; ++r) o[it][r] += ea * tI[it][r];
      }
      __syncthreads();
    }
    {
      asm volatile("s_waitcnt vmcnt(0)" : "+v"(zur[0]), "+v"(zur[1]), "+v"(zur[2]), "+v"(zur[3]) :: "memory");
      const float dsk = p.d_skip[head];
      const int p0 = wave * 16 + (lane >> 4) * 4;
      float4 gg = *(const float4*)(p.ssm_g + head * 64 + p0);
#pragma unroll
      for (int it = 0; it < 4; ++it) {
        const int i = it * 16 + (lane & 15);
        uint2 zu; zu.x = zur[it][0]; zu.y = zur[it][1];
        f32x4 y;
        y[0] = (o[it][0] + dsk * bf2f(XT[(p0 + 0) * 72 + i])) * silu_f(__uint_as_float(zu.x << 16));
        y[1] = (o[it][1] + dsk * bf2f(XT[(p0 + 1) * 72 + i])) * silu_f(__uint_as_float(zu.x & 0xffff0000u));
        y[2] = (o[it][2] + dsk * bf2f(XT[(p0 + 2) * 72 + i])) * silu_f(__uint_as_float(zu.y << 16));
        y[3] = (o[it][3] + dsk * bf2f(XT[(p0 + 3) * 72 + i])) * silu_f(__uint_as_float(zu.y & 0xffff0000u));
        ssq_acc[it] += y[0] * y[0] + y[1] * y[1] + y[2] * y[2] + y[3] * y[3];
        y[0] *= gg.x; y[1] *= gg.y; y[2] *= gg.z; y[3] *= gg.w;
        *(uint2*)(projb + (size_t)(blk * 64 + i) * ODD_N + 2560 + head * 64 + p0) = pack4(y);
      }
    }
    __syncthreads();
  }
#pragma unroll
  for (int it = 0; it < 4; ++it) {
    float s = ssq_acc[it];
    s += __shfl_xor(s, 16, 64);
    s += __shfl_xor(s, 32, 64);
    if (lane < 16) SSQ[wave * 64 + it * 16 + lane] = s;
  }
  __syncthreads();
  if (tid < 64) {
    float* ssqp = (float*)(p.ws + WS_SSQ);
    ssqp[(size_t)g * M_TOK + (size_t)b * 4096 + blk * 64 + tid] = SSQ[tid] + SSQ[64 + tid] + SSQ[128 + tid] + SSQ[192 + tid];
  }
}

__device__ __forceinline__ void phase_ssd_norm(const P& p) {
  const float* ssqp = (const float*)(p.ws + WS_SSQ);
  bf16* yb = (bf16*)(p.ws + WS_H);
  const int total = M_TOK * 64;
  for (int idx = blockIdx.x * 256 + threadIdx.x; idx < total; idx += gridDim.x * 256) {
    const int tok = idx >> 6, c8 = (idx & 63) * 8;
    const float rs = rsqrtf((ssqp[tok] + ssqp[M_TOK + tok]) * (1.f / 512.f) + 1e-6f);
    uint4* ptr = (uint4*)(yb + (size_t)tok * 1024 + 512 + c8);
    uint4 u = *ptr, w;
    w.x = (unsigned)f2bf(__uint_as_float(u.x << 16) * rs) | ((unsigned)f2bf(__uint_as_float(u.x & 0xffff0000u) * rs) << 16);
    w.y = (unsigned)f2bf(__uint_as_float(u.y << 16) * rs) | ((unsigned)f2bf(__uint_as_float(u.y & 0xffff0000u) * rs) << 16);
    w.z = (unsigned)f2bf(__uint_as_float(u.z << 16) * rs) | ((unsigned)f2bf(__uint_as_float(u.z & 0xffff0000u) * rs) << 16);
    w.w = (unsigned)f2bf(__uint_as_float(u.w << 16) * rs) | ((unsigned)f2bf(__uint_as_float(u.w & 0xffff0000u) * rs) << 16);
    *ptr = w;
  }
}


#define XB_TMO      128
#define XB_XCNT(j)  (256  + 64 * (j))
#define XB_XSUB(j)  (1280 + 64 * (j))
#define XB_XGEN(j)  (2304 + 64 * (j))
#define XB_TOP      3328
#define XB_TOPGEN   3392
#define XCD_BAR_WORDS 3456
#define XB_SPIN_CAP (1u << 18)
#define LAS __attribute__((address_space(3)))
__device__ __forceinline__ unsigned xb_ld(unsigned* p) { return __hip_atomic_load(p, __ATOMIC_RELAXED, __HIP_MEMORY_SCOPE_AGENT); }
__device__ __forceinline__ unsigned xb_add(unsigned* p, unsigned v) { return __hip_atomic_fetch_add(p, v, __ATOMIC_RELAXED, __HIP_MEMORY_SCOPE_AGENT); }
__device__ __forceinline__ unsigned xb_xcc_id() { return (unsigned)__builtin_amdgcn_s_getreg((3 << 11) | 20) & 0xFu; }
#define XB_SPIN(cond, bar) do { unsigned _sp = 0; while (cond) { __builtin_amdgcn_s_sleep(1); \
    if ((++_sp & 255u) == 0u) { if (xb_ld(&(bar)[XB_TMO])) break; if (_sp > XB_SPIN_CAP) { atomicAdd(&(bar)[XB_TMO], 1u); break; } } } } while (0)
struct XcdBarrier { unsigned* bar; unsigned x; volatile LAS unsigned* st; };
__device__ __forceinline__ XcdBarrier xcd_barrier_post(unsigned* bar, volatile LAS unsigned* st) {
  XcdBarrier b; b.bar = bar; b.x = xb_xcc_id(); b.st = st;
  if (threadIdx.x == 0) (void)xb_add(&bar[XB_XCNT(b.x)], 1u);
  return b;
}
__device__ __forceinline__ void xcd_barrier_complete(unsigned* bar, unsigned x, unsigned& nloc, unsigned& nx) {
  const unsigned G = gridDim.x * gridDim.y * gridDim.z;
  unsigned sum, cnt, mine, sp = 0u;
  for (;;) {
    sum = 0u; cnt = 0u; mine = 0u;
#pragma unroll
    for (unsigned j = 0; j < 16; ++j) { const unsigned c = xb_ld(&bar[XB_XCNT(j)]); sum += c; cnt += (c > 0u) ? 1u : 0u; mine = (j == x) ? c : mine; }
    if (sum == G) break;
    __builtin_amdgcn_s_sleep(1);
    if ((++sp & 255u) == 0u) { if (xb_ld(&bar[XB_TMO])) break; if (sp > XB_SPIN_CAP) { atomicAdd(&bar[XB_TMO], 1u); break; } }
  }
  nloc = mine > 0u ? mine : 1u; nx = cnt > 0u ? cnt : 1u;
}
__device__ __forceinline__ void xcd_barrier(const XcdBarrier& b) {
  asm volatile("s_waitcnt vmcnt(0)" ::: "memory");
  __syncthreads();
  if (threadIdx.x == 0) {
    unsigned* bar = b.bar;
    __builtin_amdgcn_s_waitcnt(0);
    unsigned nloc = b.st[0], nx = b.st[1];
    if (nloc == 0u) { xcd_barrier_complete(bar, b.x, nloc, nx); b.st[0] = nloc; b.st[1] = nx; }
    const unsigned old = xb_add(&bar[XB_XSUB(b.x)], 1u);
    const unsigned gen = old / nloc;
    if (old + 1u == (gen + 1u) * nloc) {
      __builtin_amdgcn_fence(__ATOMIC_RELEASE, "agent");
      asm volatile("s_waitcnt vmcnt(0)" ::: "memory");
      const unsigned og = xb_add(&bar[XB_TOP], 1u);
      const unsigned tg = og / nx;
      if (og + 1u == (tg + 1u) * nx) xb_add(&bar[XB_TOPGEN], 1u);
      else XB_SPIN(xb_ld(&bar[XB_TOPGEN]) == tg, bar);
      __builtin_amdgcn_fence(__ATOMIC_ACQUIRE, "agent");
      xb_add(&bar[XB_XGEN(b.x)], 1u);
      asm volatile("s_waitcnt vmcnt(0)" ::: "memory");
    } else {
      XB_SPIN(xb_ld(&bar[XB_XGEN(b.x)]) == gen, bar);
      __builtin_amdgcn_fence(__ATOMIC_ACQUIRE, "agent");
      asm volatile("s_waitcnt vmcnt(0)" ::: "memory");
    }
  }
  __syncthreads();
}

#define NPHASE 14
__global__ void __launch_bounds__(256, 2) mega(P p, int ph_lo, int ph_hi) {
  __shared__ __align__(16) unsigned char smem[73728 + 16 + (PROBE_PH >= 0 ? 256 : 0)];
  cg::grid_group grid = cg::this_grid();
  if (ph_lo < 0) grid.sync();
  if (threadIdx.x == 0) *(uint4*)(smem + 73728) = make_uint4(0u, 0u, 0u, 0u);
  __syncthreads();
  XcdBarrier xb = xcd_barrier_post((unsigned*)(p.ws + WS_BAR), (volatile LAS unsigned*)(smem + 73728));
  const float* mod = (const float*)(p.ws + WS_MOD);
#define IN(k) (ph_lo <= (k) && (k) < ph_hi)
#define SYNC(k) if (IN(k) && (k) + 1 < ph_hi) { xcd_barrier(xb); if (PROBE_PH >= 0 && blockIdx.x == 0 && threadIdx.x == 0) ((long long*)(smem + 73744))[(k) + 1] = __builtin_amdgcn_s_memrealtime(); }
  if (PROBE_PH >= 0 && blockIdx.x == 0 && threadIdx.x == 0) ((long long*)(smem + 73744))[0] = __builtin_amdgcn_s_memrealtime();
  if (IN(0)) phase_setup(p, smem);
  SYNC(0)
  if (IN(1)) phase_h0(p);
  SYNC(1)
  if (IN(2))
    phase_gemm<0>((const bf16*)(p.ws + WS_H), 1024, (const bf16*)(p.ws + WS_WEI), EVEN_NP / 128, smem,
                  (bf16*)(p.ws + WS_PROJ), EVEN_N, EVEN_N, nullptr, nullptr, nullptr, (unsigned*)(p.ws + WS_BAR), 0);
  SYNC(2)
  if (IN(3)) {
    for (int it = blockIdx.x; it < 1024; it += gridDim.x) { rec_pass1_item<64, 0>(p, it, smem); __syncthreads(); }
  }
  SYNC(3)
  if (IN(4)) {
    phase_rec_scan<64>(p);
    for (int it = blockIdx.x; it < 2048 * REPN + 16 * 66 + 256; it += gridDim.x) {
      if (it < 2048 * REPN) na_item(p, it & 2047, smem);
      else if (it < 2048 * REPN + 16 * 66) transpose_item(p.o_w_in, ODD_N, (bf16*)(p.ws + WS_WOI), it - 2048 * REPN, smem);
      else transpose_item(p.o_w_out, 1024, (bf16*)(p.ws + WS_WOO), it - 2048 * REPN - 16 * 66, smem);
      __syncthreads();
    }
  }
  SYNC(4)
  if (IN(5)) {
    for (int it = blockIdx.x; it < 1024 * REPR; it += gridDim.x) { rec_pass3_item<64, 0>(p, it & 1023, smem); __syncthreads(); }
  }
  SYNC(5)
  if (IN(6))
    phase_gemm<1>((const bf16*)(p.ws + WS_H), 1024, (const bf16*)(p.ws + WS_WEO), 8, smem, nullptr, 0, 0, p.x, (float*)(p.ws + WS_ST),
                  mod + 2048, (unsigned*)(p.ws + WS_BAR), 1);
  SYNC(6)
  if (IN(7)) phase_ln(p, 0, true);
  SYNC(7)
  if (IN(8))
    phase_gemm<0>((const bf16*)(p.ws + WS_H), 1024, (const bf16*)(p.ws + WS_WOI), ODD_NP / 128, smem,
                  (bf16*)(p.ws + WS_PROJ), ODD_N, ODD_N, nullptr, nullptr, nullptr, (unsigned*)(p.ws + WS_BAR), 2);
  SYNC(8)
  if (IN(9)) {
    for (int it = blockIdx.x; it < 512 + 1024; it += gridDim.x) {
      if (it < 512) ssd_pass1_item(p, it, smem); else rec_pass1_item<128, 1>(p, it - 512, smem);
      __syncthreads();
    }
  }
  SYNC(9)
  if (IN(10)) { phase_rec_scan<128>(p); phase_ssd_scan(p); }
  SYNC(10)
  if (IN(11)) {
    for (int it = blockIdx.x; it < 512 + 1024; it += gridDim.x) {
      if (it < 512) ssd_pass3_item(p, it, smem); else rec_pass3_item<128, 1>(p, it - 512, smem);
      __syncthreads();
    }
  }
  SYNC(11)
  if (IN(12))
    phase_gemm<2>((const bf16*)(p.ws + WS_PROJ) + 2048, ODD_N, (const bf16*)(p.ws + WS_WOO), 8, smem, nullptr, 0, 0,
                  (const float*)p.out, (float*)(p.ws + WS_ST), mod + 4 * 3072 + 2048, (unsigned*)(p.ws + WS_BAR), 3,
                  (const float*)(p.ws + WS_SSQ));
  SYNC(12)
  if (IN(13)) phase_ln(p, 1, false, smem + 73744);
}

extern "C" void kernel_launch(void* const* d_in, const int* in_sizes, int n_in, void* d_out, int out_size, void* d_ws,
                              size_t ws_size, hipStream_t stream) {
  static int grid_blocks = 0;
  if (!grid_blocks) {
    int dev = 0, cus = 0, per_cu = 0;
    hipGetDevice(&dev);
    hipDeviceGetAttribute(&cus, hipDeviceAttributeMultiprocessorCount, dev);
    hipOccupancyMaxActiveBlocksPerMultiprocessor(&per_cu, mega, 256, 0);
    if (per_cu < 1) per_cu = 1;
    if (per_cu > 2) per_cu = 2;
    grid_blocks = cus * per_cu;
    if (n_in != 22 || ws_size < WS_END) {
      fprintf(stderr, "kernel_launch: unexpected n_in %d / ws_size %zu (need %llu)\n", n_in, ws_size, (unsigned long long)WS_END);
      grid_blocks = -1;
    }
  }
  if (grid_blocks < 0) return;
  P p{};
  const float** f = (const float**)&p;
  for (int i = 0; i < 22; ++i) f[i] = (const float*)d_in[i];
  p.out = (float*)d_out;
  p.ws = (unsigned char*)d_ws;
#if 1
  if (hipMemsetAsync((char*)d_ws + WS_BAR, 0, 16384, stream) != hipSuccess) { fprintf(stderr, "memset of barrier words failed\n"); return; }
  int lo = 0, hi = NPHASE;
  void* args[] = {&p, &lo, &hi};
  hipError_t e = hipLaunchCooperativeKernel((void*)mega, dim3(grid_blocks), dim3(256), args, 0, stream);
  if (e != hipSuccess) fprintf(stderr, "cooperative launch failed: %s (grid %d)\n", hipGetErrorString(e), grid_blocks);
#else
  for (int ph = 0; ph < NPHASE; ++ph) hipLaunchKernelGGL(mega, dim3(grid_blocks), dim3(256), 0, stream, p, ph, ph + 1);
#endif
}
```

```cpp
#include <hip/hip_runtime.h>
#include <hip/hip_cooperative_groups.h>
#include <cstdio>
namespace cg = cooperative_groups;

typedef unsigned short bf16;
using bf16x8 = __attribute__((ext_vector_type(8))) short;
using f32x4 = __attribute__((ext_vector_type(4))) float;

#define M_TOK 16384
#define DM 1024
#define SEQ 4096
#define EVEN_N 3616
#define EVEN_NP 3712
#define ODD_N 4112
#define ODD_NP 4224
#define ALPHA 1.4142135623730951f
#ifndef PROBE_PH
#define PROBE_PH -1
#endif
#ifndef REPG
#define REPG 1
#endif
#ifndef REPN
#define REPN 1
#endif
#ifndef REP3
#define REP3 1
#endif
#ifndef REPS
#define REPS 1
#endif
#ifndef REP0
#define REP0 1
#endif
#ifndef REPR
#define REPR 1
#endif

#define WS_MOD 0ull
#define WS_LB (WS_MOD + 98304ull)
#define WS_WEI (WS_LB + 2048ull)
#define WS_WEO (WS_WEI + 3712ull * 2048)
#define WS_WOI (WS_WEO + 1024ull * 2048)
#define WS_WOO (WS_WOI + 4224ull * 2048)
#define WS_H (WS_WOO + 1024ull * 2048)
#define WS_PROJ (WS_H + 16384ull * 2048)
#define WS_O (WS_PROJ + 16384ull * 4112 * 2)
#define WS_ST WS_O
#define WS_DEC (WS_O + 2ull * 16384 * 512 * 4)
#define WS_SSQ (WS_DEC + 2ull * 16 * 64 * 128 * 4)
#define WS_BAR (WS_SSQ + 2ull * 16384 * 4)
#define WS_CMID (WS_BAR + 16384ull)
#define WS_DECS (WS_CMID + 2ull * 16 * 64 * 128 * 4)
#define WS_END (WS_DECS + 16384ull)

struct P {
  const float *x, *c, *ada_w, *ada_b, *ln_g, *ln_b, *e_w_in, *e_rpb, *gla_w_up, *gla_b, *gla_g, *e_w_out;
  const float *o_w_in, *hgrn_lb, *hgrn_g, *conv_w, *conv_b, *dt_bias, *a_log, *d_skip, *ssm_g, *o_w_out;
  float* out;
  unsigned char* ws;
};

__device__ __forceinline__ bf16 f2bf(float f) {
  __bf16 h = (__bf16)f;
  return *(bf16*)&h;
}
using u32x4 = __attribute__((ext_vector_type(4))) unsigned;
__device__ __forceinline__ u32x4 gload16_asm(const void* ptr) {
  u32x4 r;
  asm volatile("global_load_dwordx4 %0, %1, off" : "=v"(r) : "v"(ptr));
  return r;
}
using u32x2 = __attribute__((ext_vector_type(2))) unsigned;
__device__ __forceinline__ u32x2 gload8_asm(const void* ptr) {
  u32x2 r;
  asm volatile("global_load_dwordx2 %0, %1, off" : "=v"(r) : "v"(ptr));
  return r;
}
__device__ __forceinline__ float bf2f(bf16 h) { return __uint_as_float(((unsigned)h) << 16); }
__device__ __forceinline__ float frcp(float x) { return __builtin_amdgcn_rcpf(x); }
__device__ __forceinline__ float silu_f(float v) { return v * frcp(1.f + __expf(-v)); }
__device__ __forceinline__ float sigmoid_f(float v) { return frcp(1.f + __expf(-v)); }
__device__ __forceinline__ float flog(float x) { return __builtin_amdgcn_logf(x) * 0.6931471805599453f; }
__device__ __forceinline__ float log_sigmoid_f(float z) { return fminf(z, 0.f) - flog(1.f + __expf(-fabsf(z))); }
__device__ __forceinline__ float softplus_f(float z) { return fmaxf(z, 0.f) + log1pf(__expf(-fabsf(z))); }
__device__ __forceinline__ float wave_sum(float v) {
#pragma unroll
  for (int o = 32; o > 0; o >>= 1) v += __shfl_xor(v, o, 64);
  return v;
}

__device__ __forceinline__ void transpose_item(const float* __restrict__ src, int N, bf16* __restrict__ dst, int li, unsigned char* smem) {
  float* tile = (float*)smem;
  const int tid = threadIdx.x;
  const int kt = li & 15, ntile = li >> 4;
#pragma unroll
  for (int i = 0; i < 16; ++i) {
    int row = i * 4 + (tid >> 6), col = tid & 63;
    int n = ntile * 64 + col;
    float v = (n < N) ? src[(size_t)(kt * 64 + row) * N + n] : 0.f;
    tile[row * 65 + col] = v;
  }
  __syncthreads();
#pragma unroll
  for (int i = 0; i < 16; ++i) {
    int r = i * 4 + (tid >> 6), cc = tid & 63;
    dst[(size_t)(ntile * 64 + r) * 1024 + kt * 64 + cc] = f2bf(tile[cc * 65 + r]);
  }
}

__device__ __forceinline__ void mod_item(const P& p, int idx, unsigned char* smem) {
  float* cond = (float*)smem;
  float* red = cond + 4096;
  const int tid = threadIdx.x;
  const int l = idx / 192, nc = idx % 192;
  for (int e = tid; e < 4096; e += 256) cond[e] = silu_f(p.c[e]);
  __syncthreads();
  const int kg = tid >> 4, col = tid & 15, n = nc * 16 + col;
  float a0 = 0.f, a1 = 0.f, a2 = 0.f, a3 = 0.f;
  const float* w = p.ada_w + (size_t)l * 1024 * 3072 + n;
#pragma unroll 16
  for (int k = kg * 64; k < kg * 64 + 64; ++k) {
    float wv = w[(size_t)k * 3072];
    a0 += cond[k] * wv; a1 += cond[1024 + k] * wv; a2 += cond[2048 + k] * wv; a3 += cond[3072 + k] * wv;
  }
  red[(kg * 4 + 0) * 16 + col] = a0; red[(kg * 4 + 1) * 16 + col] = a1;
  red[(kg * 4 + 2) * 16 + col] = a2; red[(kg * 4 + 3) * 16 + col] = a3;
  __syncthreads();
  if (tid < 64) {
    const int b = tid >> 4;
    float sum = 0.f;
#pragma unroll
    for (int q = 0; q < 16; ++q) sum += red[(q * 4 + b) * 16 + col];
    float* mod = (float*)(p.ws + WS_MOD);
    mod[(size_t)(l * 4 + b) * 3072 + n] = sum + p.ada_b[l * 3072 + n];
  }
}

__device__ __forceinline__ void phase_setup(const P& p, unsigned char* smem) {
  const int M0 = 384, T0 = M0 + 16 * 58, T1 = T0 + 256, T5 = T1 + 1;
  for (int rep = 0; rep < REP0; ++rep)
  for (int it = blockIdx.x; it < T5; it += gridDim.x) {
    if (it < M0) mod_item(p, it, smem);
    else if (it < T0) transpose_item(p.e_w_in, EVEN_N, (bf16*)(p.ws + WS_WEI), it - M0, smem);
    else if (it < T1) transpose_item(p.e_w_out, 1024, (bf16*)(p.ws + WS_WEO), it - T0, smem);
    else {
      float* lbv = (float*)(p.ws + WS_LB);
      for (int j = threadIdx.x; j < 512; j += 256) {
        float a = p.hgrn_lb[j], bb = p.hgrn_lb[512 + j];
        lbv[j] = 1.f / (1.f + __expf(a - bb));
      }
    }
    __syncthreads();
  }
}

__device__ __forceinline__ void phase_h0(const P& p) {
  const float* mod = (const float*)(p.ws + WS_MOD);
  bf16* hb = (bf16*)(p.ws + WS_H);
  const size_t total = (size_t)M_TOK * 128;
  for (size_t i = (size_t)blockIdx.x * 256 + threadIdx.x; i < total; i += (size_t)gridDim.x * 256) {
    int m = (int)(i >> 7), n = (int)(i & 127) * 8, b = m >> 12;
    const float4* xp = (const float4*)(p.x + (size_t)m * 1024 + n);
    const float4* sh = (const float4*)(mod + (size_t)b * 3072 + n);
    const float4* sc = (const float4*)(mod + (size_t)b * 3072 + 1024 + n);
    float4 x0 = xp[0], x1 = xp[1], s0 = sh[0], s1 = sh[1], c0 = sc[0], c1 = sc[1];
    uint4 o;
    o.x = (unsigned)f2bf(x0.x * (1.f + c0.x) + s0.x) | ((unsigned)f2bf(x0.y * (1.f + c0.y) + s0.y) << 16);
    o.y = (unsigned)f2bf(x0.z * (1.f + c0.z) + s0.z) | ((unsigned)f2bf(x0.w * (1.f + c0.w) + s0.w) << 16);
    o.z = (unsigned)f2bf(x1.x * (1.f + c1.x) + s1.x) | ((unsigned)f2bf(x1.y * (1.f + c1.y) + s1.y) << 16);
    o.w = (unsigned)f2bf(x1.z * (1.f + c1.z) + s1.z) | ((unsigned)f2bf(x1.w * (1.f + c1.w) + s1.w) << 16);
    *(uint4*)(hb + (size_t)m * 1024 + n) = o;
  }
}

#ifndef GEMM_NST
#define GEMM_NST 2
#endif
#define LSTR 64
__device__ __forceinline__ void gemm_issue(const bf16* __restrict__ A, int lda, const bf16* __restrict__ Bt, int m0, int n0,
                                           u32x4 (&ra)[GEMM_NST][4], u32x4 (&rb)[GEMM_NST][4]) {
  const int tid = threadIdx.x, lrow = tid >> 3, lkc = tid & 7;
  const bf16* Ag = A + (size_t)(m0 + lrow) * lda + lkc * 8;
  const bf16* Bg = Bt + (size_t)(n0 + lrow) * 1024 + lkc * 8;
#pragma unroll
  for (int t = 0; t < GEMM_NST; ++t)
#pragma unroll
    for (int i = 0; i < 4; ++i) {
      ra[t][i] = gload16_asm(Ag + (size_t)i * 32 * lda + t * 64);
      rb[t][i] = gload16_asm(Bg + (size_t)i * 32 * 1024 + t * 64);
    }
}

template <int EPI, typename NextFn>
__device__ __forceinline__ void gemm_tile(const bf16* __restrict__ A, int lda, const bf16* __restrict__ Bt, int m0, int n0,
                                          unsigned char* smem, bf16* __restrict__ C, int ldc, int nreal,
                                          const float* __restrict__ X, float* __restrict__ R, const float* __restrict__ gate,
                                          const float* __restrict__ ssqp, u32x4 (&ra)[GEMM_NST][4], u32x4 (&rb)[GEMM_NST][4],
                                          NextFn&& next_issue) {
  bf16* As = (bf16*)smem;
  bf16* Bs = As + 2 * 128 * LSTR;
  const int tid = threadIdx.x, lane = tid & 63, wave = tid >> 6;
  const int wm = wave >> 1, wn = wave & 1;
  f32x4 acc[4][4];
#pragma unroll
  for (int i = 0; i < 4; ++i)
#pragma unroll
    for (int j = 0; j < 4; ++j) acc[i][j] = (f32x4){0.f, 0.f, 0.f, 0.f};
  float rsv[4] = {1.f, 1.f, 1.f, 1.f};
  if (EPI == 2) {
#pragma unroll
    for (int j = 0; j < 4; ++j) {
      const int m = m0 + wm * 64 + j * 16 + (lane & 15);
      rsv[j] = rsqrtf((ssqp[m] + ssqp[M_TOK + m]) * (1.f / 512.f) + 1e-6f);
    }
  }
  const int lrow = tid >> 3, lkc = tid & 7;
  const int lsw = (lkc ^ (lrow & 7)) * 8;
  const bf16* Ag = A + (size_t)(m0 + lrow) * lda + lkc * 8;
  const bf16* Bg = Bt + (size_t)(n0 + lrow) * 1024 + lkc * 8;
  if (GEMM_NST == 3) {
    asm volatile("s_waitcnt vmcnt(16)"
                 : "+v"(ra[0][0]), "+v"(ra[0][1]), "+v"(ra[0][2]), "+v"(ra[0][3]), "+v"(rb[0][0]), "+v"(rb[0][1]), "+v"(rb[0][2]), "+v"(rb[0][3])
                 :: "memory");
  } else {
    asm volatile("s_waitcnt vmcnt(8)"
                 : "+v"(ra[0][0]), "+v"(ra[0][1]), "+v"(ra[0][2]), "+v"(ra[0][3]), "+v"(rb[0][0]), "+v"(rb[0][1]), "+v"(rb[0][2]), "+v"(rb[0][3])
                 :: "memory");
  }
#pragma unroll
  for (int i = 0; i < 4; ++i) {
    *(u32x4*)(As + (lrow + i * 32) * LSTR + lsw) = ra[0][i];
    *(u32x4*)(Bs + (lrow + i * 32) * LSTR + lsw) = rb[0][i];
  }
  __syncthreads();
#pragma unroll
  for (int kt = 0; kt < 16; ++kt) {
    const int buf = kt & 1;
    if (kt + 1 < 16) {
      const int sn = (kt + 1) % GEMM_NST;
      if (GEMM_NST == 3 && kt + 2 < 16) {
        asm volatile("s_waitcnt vmcnt(8)"
                     : "+v"(ra[sn][0]), "+v"(ra[sn][1]), "+v"(ra[sn][2]), "+v"(ra[sn][3]), "+v"(rb[sn][0]), "+v"(rb[sn][1]), "+v"(rb[sn][2]), "+v"(rb[sn][3])
                     :: "memory");
      } else {
        asm volatile("s_waitcnt vmcnt(0)"
                     : "+v"(ra[sn][0]), "+v"(ra[sn][1]), "+v"(ra[sn][2]), "+v"(ra[sn][3]), "+v"(rb[sn][0]), "+v"(rb[sn][1]), "+v"(rb[sn][2]), "+v"(rb[sn][3])
                     :: "memory");
      }
      bf16* Aw = As + (buf ^ 1) * 128 * LSTR;
      bf16* Bw = Bs + (buf ^ 1) * 128 * LSTR;
#pragma unroll
      for (int i = 0; i < 4; ++i) {
        *(u32x4*)(Aw + (lrow + i * 32) * LSTR + lsw) = ra[sn][i];
        *(u32x4*)(Bw + (lrow + i * 32) * LSTR + lsw) = rb[sn][i];
      }
    }
    if (kt + GEMM_NST < 16) {
#pragma unroll
      for (int i = 0; i < 4; ++i) {
        ra[kt % GEMM_NST][i] = gload16_asm(Ag + (size_t)i * 32 * lda + (kt + GEMM_NST) * 64);
        rb[kt % GEMM_NST][i] = gload16_asm(Bg + (size_t)i * 32 * 1024 + (kt + GEMM_NST) * 64);
      }
    }
    const bf16* Ab = As + buf * 128 * LSTR;
    const bf16* Bb = Bs + buf * 128 * LSTR;
    if (EPI == 2 && kt == 8) {
#pragma unroll
      for (int j = 0; j < 4; ++j) {
        const float inv = frcp(rsv[j]);
#pragma unroll
        for (int i = 0; i < 4; ++i) { acc[i][j][0] *= inv; acc[i][j][1] *= inv; acc[i][j][2] *= inv; acc[i][j][3] *= inv; }
      }
    }
#pragma unroll
    for (int s = 0; s < 2; ++s) {
      bf16x8 wf[4], xf[4];
#pragma unroll
      for (int i = 0; i < 4; ++i) {
        wf[i] = *(const bf16x8*)(Bb + (wn * 64 + i * 16 + (lane & 15)) * LSTR + (((s * 4 + (lane >> 4)) ^ (lane & 7)) * 8));
        xf[i] = *(const bf16x8*)(Ab + (wm * 64 + i * 16 + (lane & 15)) * LSTR + (((s * 4 + (lane >> 4)) ^ (lane & 7)) * 8));
      }
#pragma unroll
      for (int i = 0; i < 4; ++i)
#pragma unroll
        for (int j = 0; j < 4; ++j) acc[i][j] = __builtin_amdgcn_mfma_f32_16x16x32_bf16(wf[i], xf[j], acc[i][j], 0, 0, 0);
    }
    __syncthreads();
  }
  next_issue();
#pragma unroll
  for (int i = 0; i < 4; ++i) {
    const int n = n0 + wn * 64 + i * 16 + (lane >> 4) * 4;
#pragma unroll
    for (int j = 0; j < 4; ++j) {
      const int m = m0 + wm * 64 + j * 16 + (lane & 15);
      f32x4 a = acc[i][j];
      if (EPI == 2) { a[0] *= rsv[j]; a[1] *= rsv[j]; a[2] *= rsv[j]; a[3] *= rsv[j]; }
      if (EPI == 0) {
        if (n < nreal) {
          uint2 o;
          o.x = (unsigned)f2bf(a[0]) | ((unsigned)f2bf(a[1]) << 16);
          o.y = (unsigned)f2bf(a[2]) | ((unsigned)f2bf(a[3]) << 16);
          *(uint2*)(C + (size_t)m * ldc + n) = o;
        }
      } else {
        const int b = m >> 12;
        float4 xv;
        if (EPI == 2) {
          uint2 xu = *(const uint2*)((const bf16*)X + (size_t)m * 1024 + n);
          xv.x = __uint_as_float(xu.x << 16); xv.y = __uint_as_float(xu.x & 0xffff0000u);
          xv.z = __uint_as_float(xu.y << 16); xv.w = __uint_as_float(xu.y & 0xffff0000u);
        } else xv = *(const float4*)(X + (size_t)m * 1024 + n);
        float4 g = *(const float4*)(gate + (size_t)b * 3072 + n);
        float4 o;
        o.x = ALPHA * xv.x + g.x * a[0];
        o.y = ALPHA * xv.y + g.y * a[1];
        o.z = ALPHA * xv.z + g.z * a[2];
        o.w = ALPHA * xv.w + g.w * a[3];
        *(float4*)(R + (size_t)m * 1024 + n) = o;
      }
    }
  }
}

template <int EPI>
__device__ __forceinline__ void phase_gemm(const bf16* A, int lda, const bf16* Bt, int ntn, unsigned char* smem, bf16* C, int ldc, int nreal,
                           const float* X, float* R, const float* gate, unsigned* bar, int gidx, const float* ssqp = nullptr) {
  volatile unsigned* stw = (volatile unsigned*)(smem + 73728);
  const unsigned xid = (unsigned)__builtin_amdgcn_s_getreg((3 << 11) | 20) & 0xFu;
  int xidx = 0, nx = 0;
#pragma unroll
  for (int j = 0; j < 16; ++j) {
    const unsigned c = __hip_atomic_load(&bar[256 + 64 * j], __ATOMIC_RELAXED, __HIP_MEMORY_SCOPE_AGENT);
    if (c > 0u) { nx++; if ((unsigned)j < xid) xidx++; }
  }
  const int mt_lo = (xidx * 128) / nx, mt_hi = ((xidx + 1) * 128) / nx;
  const int total = (mt_hi - mt_lo) * ntn;
  unsigned* qc = bar + 3456 + (gidx * 16 + xidx) * 8;
  u32x4 ra[GEMM_NST][4], rb[GEMM_NST][4];
  int mt = 0, nt = 0;
  bool valid = false;
  auto fetch = [&](int& mt_o, int& nt_o) -> bool {
    __syncthreads();
    if (threadIdx.x == 0) stw[2] = __hip_atomic_fetch_add(qc, 1u, __ATOMIC_RELAXED, __HIP_MEMORY_SCOPE_AGENT);
    __syncthreads();
    const int t = (int)stw[2];
    if (t >= total) return false;
    const int g8 = t / (8 * ntn), r = t - g8 * 8 * ntn;
    const int rows = mt_hi - mt_lo - g8 * 8;
    const int gm = rows < 8 ? rows : 8;
    nt_o = r / gm; mt_o = mt_lo + g8 * 8 + (r - nt_o * gm);
    return true;
  };
  valid = fetch(mt, nt);
  if (valid) gemm_issue(A, lda, Bt, mt * 128, nt * 128, ra, rb);
  while (valid) {
    int mt2 = 0, nt2 = 0;
    bool valid2 = false;
    gemm_tile<EPI>(A, lda, Bt, mt * 128, nt * 128, smem, C, ldc, nreal, X, R, gate, ssqp, ra, rb, [&]() {
      valid2 = fetch(mt2, nt2);
      if (valid2) gemm_issue(A, lda, Bt, mt2 * 128, nt2 * 128, ra, rb);
    });
    mt = mt2; nt = nt2; valid = valid2;
  }
}

__device__ __forceinline__ void phase_ln(const P& p, int l, bool write_h, const unsigned char* probe_ts = nullptr) {
  const float* mod = (const float*)(p.ws + WS_MOD);
  bf16* hb = (bf16*)(p.ws + WS_H);
  const int lane = threadIdx.x & 63, wave = threadIdx.x >> 6;
  const float* g = p.ln_g + l * 1024;
  const float* bb = p.ln_b + l * 1024;
  constexpr int NR = 4;
  for (int grp = blockIdx.x * 4 + wave; grp < M_TOK / NR; grp += gridDim.x * 4) {
    float4 v[NR][4];
    float s[NR];
#pragma unroll
    for (int r = 0; r < NR; ++r) {
      const float* rp = (const float*)(p.ws + WS_ST) + (size_t)(grp * NR + r) * 1024;
#pragma unroll
      for (int q = 0; q < 4; ++q) v[r][q] = *(const float4*)(rp + (lane + 64 * q) * 4);
    }
#pragma unroll
    for (int r = 0; r < NR; ++r) {
      s[r] = 0.f;
#pragma unroll
      for (int q = 0; q < 4; ++q) s[r] += v[r][q].x + v[r][q].y + v[r][q].z + v[r][q].w;
    }
#pragma unroll
    for (int o = 32; o > 0; o >>= 1)
#pragma unroll
      for (int r = 0; r < NR; ++r) s[r] += __shfl_xor(s[r], o, 64);
    float mu[NR], s2[NR];
#pragma unroll
    for (int r = 0; r < NR; ++r) {
      mu[r] = s[r] * (1.f / 1024.f);
      s2[r] = 0.f;
#pragma unroll
      for (int q = 0; q < 4; ++q) {
        float a = v[r][q].x - mu[r], b2 = v[r][q].y - mu[r], c2 = v[r][q].z - mu[r], d2 = v[r][q].w - mu[r];
        s2[r] += a * a + b2 * b2 + c2 * c2 + d2 * d2;
      }
    }
#pragma unroll
    for (int o = 32; o > 0; o >>= 1)
#pragma unroll
      for (int r = 0; r < NR; ++r) s2[r] += __shfl_xor(s2[r], o, 64);
#pragma unroll
    for (int q = 0; q < 4; ++q) {
      const int n = (lane + 64 * q) * 4;
      const float4 gg = *(const float4*)(g + n), be = *(const float4*)(bb + n);
#pragma unroll
      for (int r = 0; r < NR; ++r) {
        const int row = grp * NR + r;
        const float rstd = rsqrtf(s2[r] * (1.f / 1024.f) + 1e-5f);
        float4 o;
        o.x = (v[r][q].x - mu[r]) * rstd * gg.x + be.x;
        o.y = (v[r][q].y - mu[r]) * rstd * gg.y + be.y;
        o.z = (v[r][q].z - mu[r]) * rstd * gg.z + be.z;
        o.w = (v[r][q].w - mu[r]) * rstd * gg.w + be.w;
        if (PROBE_PH >= 0 && l == 1 && row == 0) {
          const long long* ts = (const long long*)(probe_ts);
          const int kus = (int)((ts[PROBE_PH + 1] - ts[PROBE_PH]) / 100);
          if (n + 0 < kus) o.x += 0.125f;
          if (n + 1 < kus) o.y += 0.125f;
          if (n + 2 < kus) o.z += 0.125f;
          if (n + 3 < kus) o.w += 0.125f;
        }
        if (!write_h) *(float4*)(p.out + (size_t)row * 1024 + n) = o;
        if (write_h) {
          const int b = row >> 12;
          uint2 xb16;
          xb16.x = (unsigned)f2bf(o.x) | ((unsigned)f2bf(o.y) << 16);
          xb16.y = (unsigned)f2bf(o.z) | ((unsigned)f2bf(o.w) << 16);
          *(uint2*)((bf16*)p.out + (size_t)row * 1024 + n) = xb16;
          const float* md = mod + (size_t)(4 + b) * 3072;
          float4 sh = *(const float4*)(md + n), sc = *(const float4*)(md + 1024 + n);
          uint2 hh;
          hh.x = (unsigned)f2bf(o.x * (1.f + sc.x) + sh.x) | ((unsigned)f2bf(o.y * (1.f + sc.y) + sh.y) << 16);
          hh.y = (unsigned)f2bf(o.z * (1.f + sc.z) + sh.z) | ((unsigned)f2bf(o.w * (1.f + sc.w) + sh.w) << 16);
          *(uint2*)(hb + (size_t)row * 1024 + n) = hh;
        }
      }
    }
  }
}

__device__ __forceinline__ void na_item(const P& p, int item, unsigned char* smem) {
  const int h = item & 7, r = (item >> 3) & 63, b = item >> 9;
  bf16* VT = (bf16*)smem;
  float* RPB = (float*)(VT + 64 * 520);
  const bf16* projb = (const bf16*)(p.ws + WS_PROJ) + (size_t)b * 4096 * EVEN_N;
  bf16* yb = (bf16*)(p.ws + WS_H);
  const int tid = threadIdx.x, lane = tid & 63, n = tid >> 6;
  const int q = lane & 15, g4 = lane >> 4;
  int rs = r - 4; rs = rs < 0 ? 0 : (rs > 56 ? 56 : rs);
#pragma unroll 8
  for (int i = 0; i < 16; ++i) {
    const int key = (i >> 3) * 256 + tid, ch = i & 7;
    const int tok = (rs + (key >> 6)) * 64 + (key & 63);
    uint4 u = *(const uint4*)(projb + (size_t)tok * EVEN_N + 1024 + h * 64 + ch * 8);
    bf16* dst = VT + (ch * 8) * 520 + key;
    dst[0 * 520] = (bf16)(u.x & 0xffffu); dst[1 * 520] = (bf16)(u.x >> 16);
    dst[2 * 520] = (bf16)(u.y & 0xffffu); dst[3 * 520] = (bf16)(u.y >> 16);
    dst[4 * 520] = (bf16)(u.z & 0xffffu); dst[5 * 520] = (bf16)(u.z >> 16);
    dst[6 * 520] = (bf16)(u.w & 0xffffu); dst[7 * 520] = (bf16)(u.w >> 16);
  }
  for (int i = tid; i < 465; i += 256) RPB[i] = p.e_rpb[h * 465 + i];
  const int qcol = n * 16 + q;
  const int qtok = r * 64 + qcol;
  const int bs = n == 0 ? 0 : (n == 1 ? 8 : (n == 2 ? 24 : 32));
  const bf16x8 qf0 = *(const bf16x8*)(projb + (size_t)qtok * EVEN_N + h * 64 + g4 * 8);
  const bf16x8 qf1 = *(const bf16x8*)(projb + (size_t)qtok * EVEN_N + h * 64 + 32 + g4 * 8);
  f32x4 st[16];
#pragma unroll
  for (int tt = 0; tt < 16; ++tt) {
    const int ktok = (rs + (tt >> 1)) * 64 + bs + (tt & 1) * 16 + q;
    const bf16* kp = projb + (size_t)ktok * EVEN_N + 512 + h * 64 + g4 * 8;
    bf16x8 kf0 = *(const bf16x8*)kp, kf1 = *(const bf16x8*)(kp + 32);
    f32x4 z = (f32x4){0.f, 0.f, 0.f, 0.f};
    z = __builtin_amdgcn_mfma_f32_16x16x32_bf16(kf0, qf0, z, 0, 0, 0);
    st[tt] = __builtin_amdgcn_mfma_f32_16x16x32_bf16(kf1, qf1, z, 0, 0, 0);
  }
  __syncthreads();
  int cs = qcol - 8; cs = cs < 0 ? 0 : (cs > 48 ? 48 : cs);
  float mx = -1e30f;
#pragma unroll
  for (int tt = 0; tt < 16; ++tt) {
    const float* brow = RPB + (rs + (tt >> 1) - r + 7) * 31;
#pragma unroll
    for (int rr = 0; rr < 4; ++rr) {
      const int kcol = bs + (tt & 1) * 16 + g4 * 4 + rr;
      const bool valid = (kcol >= cs) && (kcol < cs + 16);
      int dc = kcol - qcol + 15; dc = dc < 0 ? 0 : (dc > 30 ? 30 : dc);
      const float sc = valid ? st[tt][rr] * 0.125f + brow[dc] : -1e30f;
      st[tt][rr] = sc;
      mx = fmaxf(mx, sc);
    }
  }
  mx = fmaxf(mx, __shfl_xor(mx, 16, 64));
  mx = fmaxf(mx, __shfl_xor(mx, 32, 64));
  float lsum = 0.f;
#pragma unroll
  for (int tt = 0; tt < 16; ++tt)
#pragma unroll
    for (int rr = 0; rr < 4; ++rr) {
      const float pe = __expf(st[tt][rr] - mx);
      st[tt][rr] = pe;
      lsum += pe;
    }
  lsum += __shfl_xor(lsum, 16, 64);
  lsum += __shfl_xor(lsum, 32, 64);
  f32x4 ot[4];
#pragma unroll
  for (int dt = 0; dt < 4; ++dt) ot[dt] = (f32x4){0.f, 0.f, 0.f, 0.f};
#pragma unroll
  for (int kr = 0; kr < 8; ++kr) {
    uint4 pw;
    pw.x = (unsigned)f2bf(st[2 * kr][0]) | ((unsigned)f2bf(st[2 * kr][1]) << 16);
    pw.y = (unsigned)f2bf(st[2 * kr][2]) | ((unsigned)f2bf(st[2 * kr][3]) << 16);
    pw.z = (unsigned)f2bf(st[2 * kr + 1][0]) | ((unsigned)f2bf(st[2 * kr + 1][1]) << 16);
    pw.w = (unsigned)f2bf(st[2 * kr + 1][2]) | ((unsigned)f2bf(st[2 * kr + 1][3]) << 16);
    const bf16x8 pf = *(bf16x8*)&pw;
#pragma unroll
    for (int dt = 0; dt < 4; ++dt) {
      const bf16* vp = VT + (dt * 16 + q) * 520 + kr * 64 + bs + g4 * 4;
      uint2 lo = *(const uint2*)vp, hi = *(const uint2*)(vp + 16);
      uint4 vw; vw.x = lo.x; vw.y = lo.y; vw.z = hi.x; vw.w = hi.y;
      ot[dt] = __builtin_amdgcn_mfma_f32_16x16x32_bf16(*(bf16x8*)&vw, pf, ot[dt], 0, 0, 0);
    }
  }
  const float inv = frcp(lsum);
#pragma unroll
  for (int dt = 0; dt < 4; ++dt) {
    const int d0 = dt * 16 + g4 * 4;
    uint2 gu = *(const uint2*)(projb + (size_t)qtok * EVEN_N + 1536 + h * 64 + d0);
    f32x4 y;
    y[0] = ot[dt][0] * inv * silu_f(__uint_as_float(gu.x << 16));
    y[1] = ot[dt][1] * inv * silu_f(__uint_as_float(gu.x & 0xffff0000u));
    y[2] = ot[dt][2] * inv * silu_f(__uint_as_float(gu.y << 16));
    y[3] = ot[dt][3] * inv * silu_f(__uint_as_float(gu.y & 0xffff0000u));
    uint2 o;
    o.x = (unsigned)f2bf(y[0]) | ((unsigned)f2bf(y[1]) << 16);
    o.y = (unsigned)f2bf(y[2]) | ((unsigned)f2bf(y[3]) << 16);
    *(uint2*)(yb + ((size_t)b * 4096 + qtok) * 1024 + h * 64 + d0) = o;
  }
}

template <int K, int MODE>
struct GateC {
  float w[16];
  float bias, lb;
  int d, ch;
  __device__ __forceinline__ void init(const P& p, int d_, int h, int k) {
    d = d_; ch = h * K + k;
    if (MODE == 0) {
#pragma unroll
      for (int r = 0; r < 16; ++r) w[r] = p.gla_w_up[(d * 16 + r) * 256 + ch];
      bias = p.gla_b[d * 256 + ch];
      lb = 0.f;
    } else {
      lb = ((const float*)(p.ws + WS_LB))[ch];
      bias = 0.f;
    }
  }
  __device__ __forceinline__ void eval_vals(bf16 a, bf16 bz, const bf16* lr, float& g, float& kval, float& qval) const {
    if (MODE == 0) {
      uint4 u0 = *(const uint4*)(lr);
      uint4 u1 = *(const uint4*)(lr + 8);
      float z = bias;
      z += w[0] * __uint_as_float(u0.x << 16) + w[1] * __uint_as_float(u0.x & 0xffff0000u);
      z += w[2] * __uint_as_float(u0.y << 16) + w[3] * __uint_as_float(u0.y & 0xffff0000u);
      z += w[4] * __uint_as_float(u0.z << 16) + w[5] * __uint_as_float(u0.z & 0xffff0000u);
      z += w[6] * __uint_as_float(u0.w << 16) + w[7] * __uint_as_float(u0.w & 0xffff0000u);
      z += w[8] * __uint_as_float(u1.x << 16) + w[9] * __uint_as_float(u1.x & 0xffff0000u);
      z += w[10] * __uint_as_float(u1.y << 16) + w[11] * __uint_as_float(u1.y & 0xffff0000u);
      z += w[12] * __uint_as_float(u1.z << 16) + w[13] * __uint_as_float(u1.z & 0xffff0000u);
      z += w[14] * __uint_as_float(u1.w << 16) + w[15] * __uint_as_float(u1.w & 0xffff0000u);
      g = log_sigmoid_f(z) * (1.f / 16.f);
      kval = bf2f(bz);
      qval = bf2f(a) * 0.125f;
    } else {
      const float z = bf2f(bz);
      const float e = __expf(-z);
      const float sg = frcp(1.f + e);
      kval = (1.f - lb) * e * sg;
      g = 1.f - kval;
      qval = bf2f(a) * 0.08838834764831845f;
    }
  }
  __device__ __forceinline__ void eval(const bf16* row, float& g, float& kval, float& qval) const {
    if (MODE == 0) {
      uint4 u0 = *(const uint4*)(row + 3584 + d * 16);
      uint4 u1 = *(const uint4*)(row + 3584 + d * 16 + 8);
      float z = bias;
      z += w[0] * __uint_as_float(u0.x << 16) + w[1] * __uint_as_float(u0.x & 0xffff0000u);
      z += w[2] * __uint_as_float(u0.y << 16) + w[3] * __uint_as_float(u0.y & 0xffff0000u);
      z += w[4] * __uint_as_float(u0.z << 16) + w[5] * __uint_as_float(u0.z & 0xffff0000u);
      z += w[6] * __uint_as_float(u0.w << 16) + w[7] * __uint_as_float(u0.w & 0xffff0000u);
      z += w[8] * __uint_as_float(u1.x << 16) + w[9] * __uint_as_float(u1.x & 0xffff0000u);
      z += w[10] * __uint_as_float(u1.y << 16) + w[11] * __uint_as_float(u1.y & 0xffff0000u);
      z += w[12] * __uint_as_float(u1.z << 16) + w[13] * __uint_as_float(u1.z & 0xffff0000u);
      z += w[14] * __uint_as_float(u1.w << 16) + w[15] * __uint_as_float(u1.w & 0xffff0000u);
      g = log_sigmoid_f(z) * (1.f / 16.f);
      kval = bf2f(row[2304 + ch]);
      qval = bf2f(row[2048 + ch]) * 0.125f;
    } else {
      const float z = bf2f(row[512 + d * 512 + ch]);
      const float e = __expf(-z);
      const float sg = frcp(1.f + e);
      kval = (1.f - lb) * e * sg;
      g = flog(1.f - kval);
      qval = bf2f(row[ch]) * 0.08838834764831845f;
    }
  }
};

template <int MODE>
__device__ __forceinline__ void stage_vt(const bf16* proj, int h, bf16* VT) {
  constexpr int LDP = MODE == 0 ? EVEN_N : ODD_N;
  constexpr int VOFF = MODE == 0 ? 2560 : 1536;
  const int j = threadIdx.x & 63, cgp = threadIdx.x >> 6;
#pragma unroll
  for (int cc = 0; cc < 4; ++cc) {
    const int c = cgp * 4 + cc;
    uint4 u = *(const uint4*)(proj + (size_t)j * LDP + VOFF + h * 128 + c * 8);
    bf16* dst = VT + (c * 8) * 72 + j;
    dst[0 * 72] = (bf16)(u.x & 0xffffu); dst[1 * 72] = (bf16)(u.x >> 16);
    dst[2 * 72] = (bf16)(u.y & 0xffffu); dst[3 * 72] = (bf16)(u.y >> 16);
    dst[4 * 72] = (bf16)(u.z & 0xffffu); dst[5 * 72] = (bf16)(u.z >> 16);
    dst[6 * 72] = (bf16)(u.w & 0xffffu); dst[7 * 72] = (bf16)(u.w >> 16);
  }
}

__device__ __forceinline__ uint2 pack4(f32x4 a) {
  uint2 o;
  o.x = (unsigned)f2bf(a[0]) | ((unsigned)f2bf(a[1]) << 16);
  o.y = (unsigned)f2bf(a[2]) | ((unsigned)f2bf(a[3]) << 16);
  return o;
}

template <int K, int MODE>
__device__ __forceinline__ void rec_pass1_item(const P& p, int item, unsigned char* smem) {
  constexpr int LDP = MODE == 0 ? EVEN_N : ODD_N;
  const int h = item & 3, blk = (item >> 2) & 63, b = item >> 8;
  bf16* KT = (bf16*)smem;
  bf16* VT = KT + 2 * K * 72;
  const bf16* proj = (const bf16*)(p.ws + WS_PROJ) + (size_t)(b * 4096 + blk * 64) * LDP;
  bf16* ST = (bf16*)(p.ws + WS_ST);
  float* DEC = (float*)(p.ws + WS_DEC);
  const int tid = threadIdx.x, lane = tid & 63, wave = tid >> 6;
  bf16* TMP = VT;
  if (MODE == 1) {
#pragma unroll
    for (int i = 0; i < 8; ++i) {
      const int c = i * 256 + tid;
      const int ch = c & 15, j = (c >> 4) & 63, d = c >> 10;
      *(uint4*)(TMP + (d * 64 + j) * 128 + ch * 8) = *(const uint4*)(proj + (size_t)j * LDP + 512 + d * 512 + h * 128 + ch * 8);
    }
  } else {
#pragma unroll
    for (int i = 0; i < 2; ++i) {
      const int c = i * 256 + tid;
      const int ch = c & 7, j = c >> 3;
      *(uint4*)(TMP + j * 64 + ch * 8) = *(const uint4*)(proj + (size_t)j * LDP + 2304 + h * 64 + ch * 8);
    }
    {
      const int ch = tid & 3, j = tid >> 2;
      *(uint4*)(TMP + 4096 + j * 32 + ch * 8) = *(const uint4*)(proj + (size_t)j * LDP + 3584 + ch * 8);
    }
  }
  __syncthreads();
  if (tid < 2 * K) {
    const int d = tid / K, k = tid % K;
    GateC<K, MODE> gc;
    gc.init(p, d, h, k);
    bf16* row = KT + (d * K + k) * 72;
    float r = MODE == 1 ? 1.f : 0.f, rhi = r;
#pragma unroll 4
    for (int i = 63; i >= 0; --i) {
      const int j = d ? 63 - i : i;
      float g, kv, qv;
      if (MODE == 1) {
        gc.eval_vals(0, TMP[(d * 64 + j) * 128 + k], nullptr, g, kv, qv);
        row[j] = f2bf(kv * r);
        r *= g;
      } else {
        gc.eval_vals(0, TMP[j * 64 + k], TMP + 4096 + j * 32 + d * 16, g, kv, qv);
        row[j] = f2bf(kv * __expf(r));
        r += g;
      }
      if (i == 32) rhi = r;
    }
    DEC[(size_t)((((d * 4 + b) * 4 + h) * 64 + blk)) * K + k] = MODE == 1 ? r : __expf(r);
    ((float*)(p.ws + WS_CMID))[(size_t)((((d * 4 + b) * 4 + h) * 64 + blk)) * K + k] = MODE == 1 ? r * frcp(rhi) : __expf(r - rhi);
  }
  __syncthreads();
  stage_vt<MODE>(proj, h, VT);
  __syncthreads();
#pragma unroll 1
  for (int d = 0; d < 2; ++d) {
    f32x4 acc[K / 16][2];
#pragma unroll
    for (int kt = 0; kt < K / 16; ++kt) { acc[kt][0] = (f32x4){0.f, 0.f, 0.f, 0.f}; acc[kt][1] = (f32x4){0.f, 0.f, 0.f, 0.f}; }
#pragma unroll
    for (int ks = 0; ks < 2; ++ks) {
      bf16x8 vf0 = *(const bf16x8*)(VT + ((wave * 2 + 0) * 16 + (lane & 15)) * 72 + ks * 32 + (lane >> 4) * 8);
      bf16x8 vf1 = *(const bf16x8*)(VT + ((wave * 2 + 1) * 16 + (lane & 15)) * 72 + ks * 32 + (lane >> 4) * 8);
#pragma unroll
      for (int kt = 0; kt < K / 16; ++kt) {
        bf16x8 kf = *(const bf16x8*)(KT + (d * K + kt * 16 + (lane & 15)) * 72 + ks * 32 + (lane >> 4) * 8);
        acc[kt][0] = __builtin_amdgcn_mfma_f32_16x16x32_bf16(kf, vf0, acc[kt][0], 0, 0, 0);
        acc[kt][1] = __builtin_amdgcn_mfma_f32_16x16x32_bf16(kf, vf1, acc[kt][1], 0, 0, 0);
      }
    }
    bf16* stb = ST + (size_t)((((d * 4 + b) * 4 + h) * 64 + blk)) * 128 * K;
#pragma unroll
    for (int kt = 0; kt < K / 16; ++kt)
#pragma unroll
      for (int vv = 0; vv < 2; ++vv) {
        const int v = (wave * 2 + vv) * 16 + (lane & 15);
        const int k0 = kt * 16 + (lane >> 4) * 4;
        *(uint2*)(stb + (size_t)v * K + k0) = pack4(acc[kt][vv]);
      }
  }
}

template <int K>
__device__ __forceinline__ void phase_rec_scan(const P& p) {
  bf16* ST = (bf16*)(p.ws + WS_ST);
  const float* DEC = (const float*)(p.ws + WS_DEC);
  const float* CMID = (const float*)(p.ws + WS_CMID);
  constexpr int KV = K / 4;
  const int total = 32 * 128 * KV;
  for (int idx = blockIdx.x * 256 + threadIdx.x; idx < total; idx += gridDim.x * 256) {
    const int kq = idx % KV, v = (idx / KV) & 127, s = idx / (KV * 128);
    const int d = s >> 4;
    float st0 = 0.f, st1 = 0.f, st2 = 0.f, st3 = 0.f;
#pragma unroll 1
    for (int n0 = 0; n0 < 64; n0 += 8) {
      uint2 u[8];
      float4 dc[8], cm[8];
#pragma unroll
      for (int q = 0; q < 8; ++q) {
        const int blk = d ? 63 - (n0 + q) : (n0 + q);
        u[q] = *(const uint2*)(ST + ((size_t)(s * 64 + blk) * 128 + v) * K + kq * 4);
        dc[q] = *(const float4*)(DEC + (size_t)(s * 64 + blk) * K + kq * 4);
        cm[q] = *(const float4*)(CMID + (size_t)(s * 64 + blk) * K + kq * 4);
      }
#pragma unroll
      for (int q = 0; q < 8; ++q) {
        const int blk = d ? 63 - (n0 + q) : (n0 + q);
        uint2 o;
        o.x = (unsigned)f2bf(st0 * cm[q].x) | ((unsigned)f2bf(st1 * cm[q].y) << 16);
        o.y = (unsigned)f2bf(st2 * cm[q].z) | ((unsigned)f2bf(st3 * cm[q].w) << 16);
        *(uint2*)(ST + ((size_t)(s * 64 + blk) * 128 + v) * K + kq * 4) = o;
        st0 = dc[q].x * st0 + __uint_as_float(u[q].x << 16);
        st1 = dc[q].y * st1 + __uint_as_float(u[q].x & 0xffff0000u);
        st2 = dc[q].z * st2 + __uint_as_float(u[q].y << 16);
        st3 = dc[q].w * st3 + __uint_as_float(u[q].y & 0xffff0000u);
      }
    }
  }
}

template <int K, int MODE>
__device__ __forceinline__ void rec_pass3_item(const P& p, int item, unsigned char* smem) {
  constexpr int LDP = MODE == 0 ? EVEN_N : ODD_N;
  constexpr int KS = K + 8;
  constexpr int GOFF = MODE == 0 ? 3072 : 2048;
  constexpr int YOFF = MODE == 0 ? 512 : 0;
  const int h = item & 3, blk = (item >> 2) & 63, b = item >> 8;
  bf16* QI = (bf16*)smem;
  bf16* KI = QI + 64 * KS;
  bf16* VT = KI + 64 * KS;
  bf16* AI = VT + 128 * 72;
  float* CV = (float*)(AI + 64 * 72);
  float* SSQ = CV + K;
  bf16* LRB = (bf16*)(SSQ + 256);
  const bf16* proj = (const bf16*)(p.ws + WS_PROJ) + (size_t)(b * 4096 + blk * 64) * LDP;
  const bf16* ST = (const bf16*)(p.ws + WS_ST);
  bf16* yb = (bf16*)(p.ws + WS_H);
  const int tid = threadIdx.x, lane = tid & 63, wave = tid >> 6;
  constexpr int VOFF = MODE == 0 ? 2560 : 1536;
  constexpr int QOFF = MODE == 0 ? 2048 : 0;
  constexpr int NQ = K / 32;
  u32x4 rvt[4], rq[4], rz[2][4], rlr[2], stf[2][4][2];
  {
    const int j = tid & 63, cgp = tid >> 6;
#pragma unroll
    for (int cc = 0; cc < 4; ++cc) rvt[cc] = gload16_asm(proj + (size_t)j * LDP + VOFF + h * 128 + (cgp * 4 + cc) * 8);
  }
#pragma unroll
  for (int i = 0; i < NQ; ++i) {
    const int c = i * 256 + tid, ch = c % (K / 8), j = c / (K / 8);
    rq[i] = gload16_asm(proj + (size_t)j * LDP + QOFF + h * K + ch * 8);
    rz[0][i] = gload16_asm(proj + (size_t)j * LDP + (MODE == 0 ? 2304 : 512) + h * K + ch * 8);
  }
  if (MODE == 0) {
    const int ch = tid & 1, j = (tid >> 1) & 63;
    rlr[0] = gload16_asm(proj + (size_t)j * LDP + 3584 + ch * 8);
    rlr[1] = gload16_asm(proj + (size_t)j * LDP + 3600 + ch * 8);
  }
  {
    const bf16* stb = ST + (size_t)((((0 * 4 + b) * 4 + h) * 64 + blk)) * 128 * K;
#pragma unroll
    for (int ks = 0; ks < NQ; ++ks)
#pragma unroll
      for (int vv = 0; vv < 2; ++vv)
        stf[0][ks][vv] = gload16_asm(stb + (size_t)((wave * 2 + vv) * 16 + (lane & 15)) * K + ks * 32 + (lane >> 4) * 8);
  }
  if (MODE == 1) {
    asm volatile("s_waitcnt vmcnt(8)"
                 : "+v"(rvt[0]), "+v"(rvt[1]), "+v"(rvt[2]), "+v"(rvt[3]), "+v"(rq[0]), "+v"(rq[1]), "+v"(rq[2]), "+v"(rq[3]),
                   "+v"(rz[0][0]), "+v"(rz[0][1]), "+v"(rz[0][2]), "+v"(rz[0][3])
                 :: "memory");
  } else {
    asm volatile("s_waitcnt vmcnt(4)"
                 : "+v"(rvt[0]), "+v"(rvt[1]), "+v"(rvt[2]), "+v"(rvt[3]), "+v"(rq[0]), "+v"(rq[1]), "+v"(rz[0][0]), "+v"(rz[0][1]), "+v"(rlr[0]), "+v"(rlr[1])
                 :: "memory");
  }
  {
    const int j = tid & 63, cgp = tid >> 6;
#pragma unroll
    for (int cc = 0; cc < 4; ++cc) {
      const u32x4 u = rvt[cc];
      bf16* dst = VT + ((cgp * 4 + cc) * 8) * 72 + j;
      dst[0 * 72] = (bf16)(u[0] & 0xffffu); dst[1 * 72] = (bf16)(u[0] >> 16);
      dst[2 * 72] = (bf16)(u[1] & 0xffffu); dst[3 * 72] = (bf16)(u[1] >> 16);
      dst[4 * 72] = (bf16)(u[2] & 0xffffu); dst[5 * 72] = (bf16)(u[2] >> 16);
      dst[6 * 72] = (bf16)(u[3] & 0xffffu); dst[7 * 72] = (bf16)(u[3] >> 16);
    }
  }
  f32x4 o[2][4];
#pragma unroll
  for (int vv = 0; vv < 2; ++vv)
#pragma unroll
    for (int it = 0; it < 4; ++it) o[vv][it] = (f32x4){0.f, 0.f, 0.f, 0.f};
#pragma unroll
  for (int d = 0; d < 2; ++d) {
    if (d) __syncthreads();
    if (MODE == 1 && d == 1) {
      asm volatile("s_waitcnt vmcnt(0)" : "+v"(rz[1][0]), "+v"(rz[1][1]), "+v"(rz[1][2]), "+v"(rz[1][3]) :: "memory");
    }
#pragma unroll
    for (int i = 0; i < NQ; ++i) {
      const int c = i * 256 + tid, ch = c % (K / 8), j = c / (K / 8);
      *(u32x4*)(QI + j * KS + ch * 8) = rq[i];
      *(u32x4*)(KI + j * KS + ch * 8) = rz[MODE == 1 ? d : 0][i];
    }
    if (d == 1) {
      const bf16* stb = ST + (size_t)((((1 * 4 + b) * 4 + h) * 64 + blk)) * 128 * K;
#pragma unroll
      for (int ks = 0; ks < NQ; ++ks)
#pragma unroll
        for (int vv = 0; vv < 2; ++vv)
          stf[1][ks][vv] = gload16_asm(stb + (size_t)((wave * 2 + vv) * 16 + (lane & 15)) * K + ks * 32 + (lane >> 4) * 8);
    }
    if (MODE == 1 && d == 0) {
#pragma unroll
      for (int i = 0; i < NQ; ++i) {
        const int c = i * 256 + tid, ch = c % (K / 8), j = c / (K / 8);
        rz[1][i] = gload16_asm(proj + (size_t)j * LDP + 1024 + h * K + ch * 8);
      }
    }
    if (MODE == 0 && tid < 128) {
      const int ch = tid & 1, j = tid >> 1;
      *(u32x4*)(LRB + j * 16 + ch * 8) = rlr[d];
    }
    __syncthreads();
    if (tid < 2 * K) {
      const int k = tid % K, half = tid / K;
      GateC<K, MODE> gc;
      gc.init(p, d, h, k);
      float run = MODE == 1 ? 1.f : 0.f;
      if (half) {
#pragma unroll 4
        for (int i = 32; i < 64; ++i) {
          const int j = d ? 63 - i : i;
          float g, kv, qv;
          gc.eval_vals(QI[j * KS + k], KI[j * KS + k], LRB + j * 16, g, kv, qv);
          if (MODE == 1) {
            run *= g;
            QI[j * KS + k] = f2bf(qv * run);
            KI[j * KS + k] = f2bf(kv * frcp(run));
          } else {
            run += g;
            QI[j * KS + k] = f2bf(qv * __expf(run));
            KI[j * KS + k] = f2bf(kv * __expf(-run));
          }
        }
      } else {
#pragma unroll 4
        for (int i = 31; i >= 0; --i) {
          const int j = d ? 63 - i : i;
          float g, kv, qv;
          gc.eval_vals(QI[j * KS + k], KI[j * KS + k], LRB + j * 16, g, kv, qv);
          if (MODE == 1) {
            QI[j * KS + k] = f2bf(qv * frcp(run));
            KI[j * KS + k] = f2bf(kv * run);
            run *= g;
          } else {
            QI[j * KS + k] = f2bf(qv * __expf(-run));
            KI[j * KS + k] = f2bf(kv * __expf(run));
            run += g;
          }
        }
        CV[k] = MODE == 1 ? run : __expf(run);
      }
    }
    __syncthreads();
    {
      f32x4 a[4];
#pragma unroll
      for (int jt = 0; jt < 4; ++jt) a[jt] = (f32x4){0.f, 0.f, 0.f, 0.f};
#pragma unroll
      for (int ks = 0; ks < K / 32; ++ks) {
        bf16x8 qf = *(const bf16x8*)(QI + (wave * 16 + (lane & 15)) * KS + ks * 32 + (lane >> 4) * 8);
#pragma unroll
        for (int jt = 0; jt < 4; ++jt) {
          bf16x8 kf = *(const bf16x8*)(KI + (jt * 16 + (lane & 15)) * KS + ks * 32 + (lane >> 4) * 8);
          a[jt] = __builtin_amdgcn_mfma_f32_16x16x32_bf16(kf, qf, a[jt], 0, 0, 0);
        }
      }
      const int i = wave * 16 + (lane & 15);
#pragma unroll
      for (int jt = 0; jt < 4; ++jt) {
        const int j0 = jt * 16 + (lane >> 4) * 4;
        f32x4 m;
#pragma unroll
        for (int r = 0; r < 4; ++r) {
          const int j = j0 + r;
          const bool valid = d ? (j >= i) : (j <= i);
          m[r] = valid ? a[jt][r] : 0.f;
        }
        *(uint2*)(AI + i * 72 + j0) = pack4(m);
      }
    }
    __syncthreads();
#pragma unroll
    for (int ks = 0; ks < 2; ++ks) {
      bf16x8 vf0 = *(const bf16x8*)(VT + ((wave * 2 + 0) * 16 + (lane & 15)) * 72 + ks * 32 + (lane >> 4) * 8);
      bf16x8 vf1 = *(const bf16x8*)(VT + ((wave * 2 + 1) * 16 + (lane & 15)) * 72 + ks * 32 + (lane >> 4) * 8);
#pragma unroll
      for (int it = 0; it < 4; ++it) {
        bf16x8 af = *(const bf16x8*)(AI + (it * 16 + (lane & 15)) * 72 + ks * 32 + (lane >> 4) * 8);
        o[0][it] = __builtin_amdgcn_mfma_f32_16x16x32_bf16(vf0, af, o[0][it], 0, 0, 0);
        o[1][it] = __builtin_amdgcn_mfma_f32_16x16x32_bf16(vf1, af, o[1][it], 0, 0, 0);
      }
    }
    if (d == 0) {
      if (K == 128) {
        asm volatile("s_waitcnt vmcnt(4)"
                     : "+v"(stf[0][0][0]), "+v"(stf[0][0][1]), "+v"(stf[0][1][0]), "+v"(stf[0][1][1]), "+v"(stf[0][2][0]), "+v"(stf[0][2][1]), "+v"(stf[0][3][0]), "+v"(stf[0][3][1])
                     :: "memory");
      } else {
        asm volatile("s_waitcnt vmcnt(0)" : "+v"(stf[0][0][0]), "+v"(stf[0][0][1]), "+v"(stf[0][1][0]), "+v"(stf[0][1][1]) :: "memory");
      }
    } else {
      if (K == 128) {
        asm volatile("s_waitcnt vmcnt(0)"
                     : "+v"(stf[1][0][0]), "+v"(stf[1][0][1]), "+v"(stf[1][1][0]), "+v"(stf[1][1][1]), "+v"(stf[1][2][0]), "+v"(stf[1][2][1]), "+v"(stf[1][3][0]), "+v"(stf[1][3][1])
                     :: "memory");
      } else {
        asm volatile("s_waitcnt vmcnt(0)" : "+v"(stf[1][0][0]), "+v"(stf[1][0][1]), "+v"(stf[1][1][0]), "+v"(stf[1][1][1]) :: "memory");
      }
    }
#pragma unroll
    for (int ks = 0; ks < K / 32; ++ks) {
      const int kk = ks * 32 + (lane >> 4) * 8;
      bf16x8 sf[2];
      sf[0] = *(bf16x8*)&stf[d][ks][0];
      sf[1] = *(bf16x8*)&stf[d][ks][1];
#pragma unroll
      for (int it = 0; it < 4; ++it) {
        bf16x8 qf = *(const bf16x8*)(QI + (it * 16 + (lane & 15)) * KS + kk);
        o[0][it] = __builtin_amdgcn_mfma_f32_16x16x32_bf16(sf[0], qf, o[0][it], 0, 0, 0);
        o[1][it] = __builtin_amdgcn_mfma_f32_16x16x32_bf16(sf[1], qf, o[1][it], 0, 0, 0);
      }
    }
  }
  {
    float ss[4];
#pragma unroll
    for (int it = 0; it < 4; ++it) {
      float s = 0.f;
#pragma unroll
      for (int vv = 0; vv < 2; ++vv)
#pragma unroll
        for (int r = 0; r < 4; ++r) s += o[vv][it][r] * o[vv][it][r];
      s += __shfl_xor(s, 16, 64);
      s += __shfl_xor(s, 32, 64);
      ss[it] = s;
    }
    if (lane < 16) {
#pragma unroll
      for (int it = 0; it < 4; ++it) SSQ[wave * 64 + it * 16 + lane] = ss[it];
    }
    __syncthreads();
    const float* gn = MODE == 0 ? p.gla_g : p.hgrn_g;
#pragma unroll
    for (int it = 0; it < 4; ++it) {
      const int i = it * 16 + (lane & 15);
      const float tot = SSQ[i] + SSQ[64 + i] + SSQ[128 + i] + SSQ[192 + i];
      const float rs = rsqrtf(tot * (1.f / 128.f) + 1e-6f);
#pragma unroll
      for (int vv = 0; vv < 2; ++vv) {
        const int v0 = (wave * 2 + vv) * 16 + (lane >> 4) * 4;
        uint2 gu = *(const uint2*)(proj + (size_t)i * LDP + GOFF + h * 128 + v0);
        float4 gg = *(const float4*)(gn + v0);
        f32x4 y;
        y[0] = o[vv][it][0] * rs * gg.x * silu_f(__uint_as_float(gu.x << 16));
        y[1] = o[vv][it][1] * rs * gg.y * silu_f(__uint_as_float(gu.x & 0xffff0000u));
        y[2] = o[vv][it][2] * rs * gg.z * silu_f(__uint_as_float(gu.y << 16));
        y[3] = o[vv][it][3] * rs * gg.w * silu_f(__uint_as_float(gu.y & 0xffff0000u));
        if (MODE == 1) *(uint2*)((bf16*)proj + (size_t)i * LDP + GOFF + h * 128 + v0) = pack4(y);
        else *(uint2*)(yb + (size_t)(b * 4096 + blk * 64 + i) * 1024 + YOFF + h * 128 + v0) = pack4(y);
      }
    }
  }
}

__device__ __forceinline__ void conv8(const P& p, const bf16* projb, int t, int c0, float* o8) {
  c0 = __builtin_amdgcn_readfirstlane(c0);
  float4 b0 = *(const float4*)(p.conv_b + c0), b1 = *(const float4*)(p.conv_b + c0 + 4);
  float a[8] = {b0.x, b0.y, b0.z, b0.w, b1.x, b1.y, b1.z, b1.w};
#pragma unroll
  for (int jt = 0; jt < 4; ++jt) {
    const int tt = t + jt - 2;
    if (tt >= 0 && tt < 4096) {
      uint4 u = *(const uint4*)(projb + (size_t)tt * ODD_N + 3072 + c0);
      float4 w0 = *(const float4*)(p.conv_w + jt * 1024 + c0), w1 = *(const float4*)(p.conv_w + jt * 1024 + c0 + 4);
      a[0] += w0.x * __uint_as_float(u.x << 16); a[1] += w0.y * __uint_as_float(u.x & 0xffff0000u);
      a[2] += w0.z * __uint_as_float(u.y << 16); a[3] += w0.w * __uint_as_float(u.y & 0xffff0000u);
      a[4] += w1.x * __uint_as_float(u.z << 16); a[5] += w1.y * __uint_as_float(u.z & 0xffff0000u);
      a[6] += w1.z * __uint_as_float(u.w << 16); a[7] += w1.w * __uint_as_float(u.w & 0xffff0000u);
    }
  }
#pragma unroll
  for (int e = 0; e < 8; ++e) o8[e] = silu_f(a[e]);
}

__device__ __forceinline__ void conv8u(const P& p, const bf16* projb, int t, int c0, float* o8) {
  c0 = __builtin_amdgcn_readfirstlane(c0);
  float4 b0 = *(const float4*)(p.conv_b + c0), b1 = *(const float4*)(p.conv_b + c0 + 4);
  float a[8] = {b0.x, b0.y, b0.z, b0.w, b1.x, b1.y, b1.z, b1.w};
  uint4 u[4];
#pragma unroll
  for (int jt = 0; jt < 4; ++jt) {
    int tt = t + jt - 2;
    tt = tt < 0 ? 0 : (tt > 4095 ? 4095 : tt);
    u[jt] = *(const uint4*)(projb + (size_t)tt * ODD_N + 3072 + c0);
  }
#pragma unroll
  for (int jt = 0; jt < 4; ++jt) {
    const int tt = t + jt - 2;
    const float ok = (tt >= 0 && tt < 4096) ? 1.f : 0.f;
    float4 w0 = *(const float4*)(p.conv_w + jt * 1024 + c0), w1 = *(const float4*)(p.conv_w + jt * 1024 + c0 + 4);
    a[0] += ok * w0.x * __uint_as_float(u[jt].x << 16); a[1] += ok * w0.y * __uint_as_float(u[jt].x & 0xffff0000u);
    a[2] += ok * w0.z * __uint_as_float(u[jt].y << 16); a[3] += ok * w0.w * __uint_as_float(u[jt].y & 0xffff0000u);
    a[4] += ok * w1.x * __uint_as_float(u[jt].z << 16); a[5] += ok * w1.y * __uint_as_float(u[jt].z & 0xffff0000u);
    a[6] += ok * w1.z * __uint_as_float(u[jt].w << 16); a[7] += ok * w1.w * __uint_as_float(u[jt].w & 0xffff0000u);
  }
#pragma unroll
  for (int e = 0; e < 8; ++e) o8[e] = silu_f(a[e]);
}

__device__ __forceinline__ void ssd_prep_acum(const P& p, const bf16* projb, int blk, int g, float* ACUM, float* DTV, float* TOT) {
  const int lane = threadIdx.x & 63, wave = threadIdx.x >> 6;
#pragma unroll
  for (int q = 0; q < 2; ++q) {
    const int c = wave * 2 + q, dir = c >> 2, rp = c & 3, head = g * 4 + rp;
    const int j = dir ? 63 - lane : lane;
    const int t = blk * 64 + j;
    const float dt = softplus_f(bf2f(projb[(size_t)t * ODD_N + 4096 + dir * 8 + head]) + p.dt_bias[dir * 8 + head]);
    float v = -__expf(p.a_log[dir * 8 + head]) * dt;
#pragma unroll
    for (int off = 1; off < 64; off <<= 1) {
      float tmp = __shfl_up(v, off, 64);
      if (lane >= off) v += tmp;
    }
    ACUM[c * 64 + j] = v;
    DTV[c * 64 + j] = dt;
    if (lane == 63) TOT[c] = v;
  }
}

__device__ __forceinline__ bf16* ssd_st(const P& p, int s) {
  return s < 32 ? (bf16*)(p.ws + WS_H) + (size_t)s * 524288 : (bf16*)((unsigned char*)p.out + 33554432) + (size_t)(s - 32) * 524288;
}
__device__ __forceinline__ void ssd_pass1_item(const P& p, int item, unsigned char* smem) {
  const int g = item & 1, blk = (item >> 1) & 63, b = item >> 7;
  bf16* BT = (bf16*)smem;
  bf16* XT = BT + 128 * 72;
  float* ACUM = (float*)(XT + 256 * 72);
  float* DTV = ACUM + 512;
  float* TOT = DTV + 512;
  const bf16* projb = (const bf16*)(p.ws + WS_PROJ) + (size_t)b * 4096 * ODD_N;
  float* DEC = (float*)(p.ws + WS_DECS);
  const int tid = threadIdx.x, lane = tid & 63, wave = tid >> 6;
  const int t = blk * 64 + lane;
  ssd_prep_acum(p, projb, blk, g, ACUM, DTV, TOT);
#pragma unroll 2
  for (int q = 0; q < 4; ++q) {
    const int cc = wave + 4 * q;
    float v8[8];
    conv8(p, projb, t, 512 + g * 128 + cc * 8, v8);
#pragma unroll
    for (int e = 0; e < 8; ++e) BT[(cc * 8 + e) * 72 + lane] = f2bf(v8[e]);
  }
  float xs[8][8];
#pragma unroll
  for (int q = 0; q < 8; ++q) conv8(p, projb, t, g * 256 + (wave * 8 + q) * 8, xs[q]);
  __syncthreads();
  if (tid < 8) {
    const int dir = tid >> 2, head = g * 4 + (tid & 3);
    DEC[(size_t)((dir * 4 + b) * 8 + head) * 64 + blk] = __expf(TOT[tid]);
  }
#pragma unroll 1
  for (int dir = 0; dir < 2; ++dir) {
    if (dir) __syncthreads();
    const int c = dir * 4 + wave;
    const float fac = DTV[c * 64 + lane] * __expf(TOT[c] - ACUM[c * 64 + lane]);
#pragma unroll
    for (int q = 0; q < 8; ++q)
#pragma unroll
      for (int e = 0; e < 8; ++e) XT[((wave * 8 + q) * 8 + e) * 72 + lane] = f2bf(xs[q][e] * fac);
    __syncthreads();
    const int head = g * 4 + wave;
    bf16* stb = ssd_st(p, (dir * 4 + b) * 8 + head) + (size_t)blk * 8192;
#pragma unroll 1
    for (int nh = 0; nh < 4; ++nh) {
      f32x4 acc[2][4];
#pragma unroll
      for (int nt = 0; nt < 2; ++nt)
#pragma unroll
        for (int pt = 0; pt < 4; ++pt) acc[nt][pt] = (f32x4){0.f, 0.f, 0.f, 0.f};
#pragma unroll
      for (int ks = 0; ks < 2; ++ks) {
        bf16x8 xf[4];
#pragma unroll
        for (int pt = 0; pt < 4; ++pt) xf[pt] = *(const bf16x8*)(XT + (wave * 64 + pt * 16 + (lane & 15)) * 72 + ks * 32 + (lane >> 4) * 8);
#pragma unroll
        for (int nt = 0; nt < 2; ++nt) {
          bf16x8 bfv = *(const bf16x8*)(BT + ((nh * 2 + nt) * 16 + (lane & 15)) * 72 + ks * 32 + (lane >> 4) * 8);
#pragma unroll
          for (int pt = 0; pt < 4; ++pt) acc[nt][pt] = __builtin_amdgcn_mfma_f32_16x16x32_bf16(bfv, xf[pt], acc[nt][pt], 0, 0, 0);
        }
      }
#pragma unroll
      for (int nt = 0; nt < 2; ++nt)
#pragma unroll
        for (int pt = 0; pt < 4; ++pt) {
          const int pp = pt * 16 + (lane & 15);
          const int n0 = (nh * 2 + nt) * 16 + (lane >> 4) * 4;
          *(uint2*)(stb + (size_t)pp * 128 + n0) = pack4(acc[nt][pt]);
        }
    }
  }
}

__device__ __forceinline__ void phase_ssd_scan(const P& p) {
  const float* DEC = (const float*)(p.ws + WS_DECS);
  const int total = 64 * 2048;
  for (int idx = blockIdx.x * 256 + threadIdx.x; idx < total; idx += gridDim.x * 256) {
    const int e4 = idx & 2047, s = idx >> 11;
    const int d = s >> 5;
    bf16* ST = ssd_st(p, s);
    float st0 = 0.f, st1 = 0.f, st2 = 0.f, st3 = 0.f;
#pragma unroll 1
    for (int n0 = 0; n0 < 64; n0 += 8) {
      uint2 u[8];
      float dc[8];
#pragma unroll
      for (int q = 0; q < 8; ++q) {
        const int blk = d ? 63 - (n0 + q) : (n0 + q);
        u[q] = *(const uint2*)(ST + (size_t)blk * 8192 + e4 * 4);
        dc[q] = DEC[s * 64 + blk];
      }
#pragma unroll
      for (int q = 0; q < 8; ++q) {
        const int blk = d ? 63 - (n0 + q) : (n0 + q);
        uint2 o;
        o.x = (unsigned)f2bf(st0) | ((unsigned)f2bf(st1) << 16);
        o.y = (unsigned)f2bf(st2) | ((unsigned)f2bf(st3) << 16);
        *(uint2*)(ST + (size_t)blk * 8192 + e4 * 4) = o;
        st0 = dc[q] * st0 + __uint_as_float(u[q].x << 16);
        st1 = dc[q] * st1 + __uint_as_float(u[q].x & 0xffff0000u);
        st2 = dc[q] * st2 + __uint_as_float(u[q].y << 16);
        st3 = dc[q] * st3 + __uint_as_float(u[q].y & 0xffff0000u);
      }
    }
  }
}

__device__ __forceinline__ void ssd_pass3_item(const P& p, int item, unsigned char* smem) {
  const int g = item & 1, blk = (item >> 1) & 63, b = item >> 7;
  bf16* CI = (bf16*)smem;
  bf16* BI = CI + 64 * 136;
  bf16* AI = BI;
  bf16* XT = BI + 64 * 136;
  float* ACUM = (float*)(XT + 64 * 72);
  float* DTV = ACUM + 512;
  float* TOT = DTV + 512;
  float* SSQ = TOT + 8;
  bf16* projb = (bf16*)(p.ws + WS_PROJ) + (size_t)b * 4096 * ODD_N;
  const int tid = threadIdx.x, lane = tid & 63, wave = tid >> 6;
  const int t = blk * 64 + lane;
  ssd_prep_acum(p, projb, blk, g, ACUM, DTV, TOT);
#pragma unroll 4
  for (int q = 0; q < 8; ++q) {
    const int cc = wave * 8 + q, which = cc >> 4, ch = (cc & 15) * 8;
    float v8[8];
    conv8u(p, projb, t, 512 + which * 256 + g * 128 + ch, v8);
    uint4 w;
    w.x = (unsigned)f2bf(v8[0]) | ((unsigned)f2bf(v8[1]) << 16);
    w.y = (unsigned)f2bf(v8[2]) | ((unsigned)f2bf(v8[3]) << 16);
    w.z = (unsigned)f2bf(v8[4]) | ((unsigned)f2bf(v8[5]) << 16);
    w.w = (unsigned)f2bf(v8[6]) | ((unsigned)f2bf(v8[7]) << 16);
    *(uint4*)((which ? CI : BI) + lane * 136 + ch) = w;
  }
  __syncthreads();
  f32x4 gt[4];
#pragma unroll
  for (int jt = 0; jt < 4; ++jt) gt[jt] = (f32x4){0.f, 0.f, 0.f, 0.f};
#pragma unroll
  for (int ks = 0; ks < 4; ++ks) {
    bf16x8 cf = *(const bf16x8*)(CI + (wave * 16 + (lane & 15)) * 136 + ks * 32 + (lane >> 4) * 8);
#pragma unroll
    for (int jt = 0; jt < 4; ++jt) {
      bf16x8 bfv = *(const bf16x8*)(BI + (jt * 16 + (lane & 15)) * 136 + ks * 32 + (lane >> 4) * 8);
      gt[jt] = __builtin_amdgcn_mfma_f32_16x16x32_bf16(bfv, cf, gt[jt], 0, 0, 0);
    }
  }
  __syncthreads();
  float ssq_acc[4] = {0.f, 0.f, 0.f, 0.f};
#pragma unroll 1
  for (int rp = 0; rp < 4; ++rp) {
    const int head = g * 4 + rp;
    u32x4 stf[2][4];
    u32x2 zur[4];
#pragma unroll
    for (int dir = 0; dir < 2; ++dir) {
      const bf16* stb = ssd_st(p, (dir * 4 + b) * 8 + head) + (size_t)blk * 8192;
#pragma unroll
      for (int ks = 0; ks < 4; ++ks) stf[dir][ks] = gload16_asm(stb + (size_t)(wave * 16 + (lane & 15)) * 128 + ks * 32 + (lane >> 4) * 8);
    }
#pragma unroll
    for (int it = 0; it < 4; ++it)
      zur[it] = gload8_asm(projb + (size_t)(blk * 64 + it * 16 + (lane & 15)) * ODD_N + 2560 + head * 64 + wave * 16 + (lane >> 4) * 4);
#pragma unroll 2
    for (int q = 0; q < 2; ++q) {
      const int cc = wave * 2 + q;
      float v8[8];
      conv8u(p, projb, t, head * 64 + cc * 8, v8);
#pragma unroll
      for (int e = 0; e < 8; ++e) XT[(cc * 8 + e) * 72 + lane] = f2bf(v8[e]);
    }
    f32x4 o[4];
#pragma unroll
    for (int it = 0; it < 4; ++it) o[it] = (f32x4){0.f, 0.f, 0.f, 0.f};
#pragma unroll
    for (int dir = 0; dir < 2; ++dir) {
      const int c = dir * 4 + rp;
      {
        const int i = wave * 16 + (lane & 15);
        const float aci = ACUM[c * 64 + i];
#pragma unroll
        for (int jt = 0; jt < 4; ++jt) {
          const int j0 = jt * 16 + (lane >> 4) * 4;
          f32x4 m;
#pragma unroll
          for (int r = 0; r < 4; ++r) {
            const int j = j0 + r;
            const bool valid = dir ? (j >= i) : (j <= i);
            const float arg = fminf(aci - ACUM[c * 64 + j], 0.f);
            m[r] = valid ? gt[jt][r] * __expf(arg) * DTV[c * 64 + j] : 0.f;
          }
          *(uint2*)(AI + i * 72 + j0) = pack4(m);
        }
      }
      __syncthreads();
#pragma unroll
      for (int ks = 0; ks < 2; ++ks) {
        bf16x8 xf = *(const bf16x8*)(XT + (wave * 16 + (lane & 15)) * 72 + ks * 32 + (lane >> 4) * 8);
#pragma unroll
        for (int it = 0; it < 4; ++it) {
          bf16x8 af = *(const bf16x8*)(AI + (it * 16 + (lane & 15)) * 72 + ks * 32 + (lane >> 4) * 8);
          o[it] = __builtin_amdgcn_mfma_f32_16x16x32_bf16(xf, af, o[it], 0, 0, 0);
        }
      }
      f32x4 tI[4];
#pragma unroll
      for (int it = 0; it < 4; ++it) tI[it] = (f32x4){0.f, 0.f, 0.f, 0.f};
      asm volatile("s_waitcnt vmcnt(0)" : "+v"(stf[dir][0]), "+v"(stf[dir][1]), "+v"(stf[dir][2]), "+v"(stf[dir][3]) :: "memory");
#pragma unroll
      for (int ks = 0; ks < 4; ++ks) {
        bf16x8 sf = *(bf16x8*)&stf[dir][ks];
#pragma unroll
        for (int it = 0; it < 4; ++it) {
          bf16x8 cf = *(const bf16x8*)(CI + (it * 16 + (lane & 15)) * 136 + ks * 32 + (lane >> 4) * 8);
          tI[it] = __builtin_amdgcn_mfma_f32_16x16x32_bf16(sf, cf, tI[it], 0, 0, 0);
        }
      }
#pragma unroll
      for (int it = 0; it < 4; ++it) {
        const float ea = __expf(ACUM[c * 64 + it * 16 + (lane & 15)]);
#pragma unroll
        for (int r = 0; r < 4; ++r) o[it][r] += ea * tI[it][r];
      }
      __syncthreads();
    }
    {
      asm volatile("s_waitcnt vmcnt(0)" : "+v"(zur[0]), "+v"(zur[1]), "+v"(zur[2]), "+v"(zur[3]) :: "memory");
      const float dsk = p.d_skip[head];
      const int p0 = wave * 16 + (lane >> 4) * 4;
      float4 gg = *(const float4*)(p.ssm_g + head * 64 + p0);
#pragma unroll
      for (int it = 0; it < 4; ++it) {
        const int i = it * 16 + (lane & 15);
        uint2 zu; zu.x = zur[it][0]; zu.y = zur[it][1];
        f32x4 y;
        y[0] = (o[it][0] + dsk * bf2f(XT[(p0 + 0) * 72 + i])) * silu_f(__uint_as_float(zu.x << 16));
        y[1] = (o[it][1] + dsk * bf2f(XT[(p0 + 1) * 72 + i])) * silu_f(__uint_as_float(zu.x & 0xffff0000u));
        y[2] = (o[it][2] + dsk * bf2f(XT[(p0 + 2) * 72 + i])) * silu_f(__uint_as_float(zu.y << 16));
        y[3] = (o[it][3] + dsk * bf2f(XT[(p0 + 3) * 72 + i])) * silu_f(__uint_as_float(zu.y & 0xffff0000u));
        ssq_acc[it] += y[0] * y[0] + y[1] * y[1] + y[2] * y[2] + y[3] * y[3];
        y[0] *= gg.x; y[1] *= gg.y; y[2] *= gg.z; y[3] *= gg.w;
        *(uint2*)(projb + (size_t)(blk * 64 + i) * ODD_N + 2560 + head * 64 + p0) = pack4(y);
      }
    }
    __syncthreads();
  }
#pragma unroll
  for (int it = 0; it < 4; ++it) {
    float s = ssq_acc[it];
    s += __shfl_xor(s, 16, 64);
    s += __shfl_xor(s, 32, 64);
    if (lane < 16) SSQ[wave * 64 + it * 16 + lane] = s;
  }
  __syncthreads();
  if (tid < 64) {
    float* ssqp = (float*)(p.ws + WS_SSQ);
    ssqp[(size_t)g * M_TOK + (size_t)b * 4096 + blk * 64 + tid] = SSQ[tid] + SSQ[64 + tid] + SSQ[128 + tid] + SSQ[192 + tid];
  }
}

__device__ __forceinline__ void phase_ssd_norm(const P& p) {
  const float* ssqp = (const float*)(p.ws + WS_SSQ);
  bf16* yb = (bf16*)(p.ws + WS_H);
  const int total = M_TOK * 64;
  for (int idx = blockIdx.x * 256 + threadIdx.x; idx < total; idx += gridDim.x * 256) {
    const int tok = idx >> 6, c8 = (idx & 63) * 8;
    const float rs = rsqrtf((ssqp[tok] + ssqp[M_TOK + tok]) * (1.f / 512.f) + 1e-6f);
    uint4* ptr = (uint4*)(yb + (size_t)tok * 1024 + 512 + c8);
    uint4 u = *ptr, w;
    w.x = (unsigned)f2bf(__uint_as_float(u.x << 16) * rs) | ((unsigned)f2bf(__uint_as_float(u.x & 0xffff0000u) * rs) << 16);
    w.y = (unsigned)f2bf(__uint_as_float(u.y << 16) * rs) | ((unsigned)f2bf(__uint_as_float(u.y & 0xffff0000u) * rs) << 16);
    w.z = (unsigned)f2bf(__uint_as_float(u.z << 16) * rs) | ((unsigned)f2bf(__uint_as_float(u.z & 0xffff0000u) * rs) << 16);
    w.w = (unsigned)f2bf(__uint_as_float(u.w << 16) * rs) | ((unsigned)f2bf(__uint_as_float(u.w & 0xffff0000u) * rs) << 16);
    *ptr = w;
  }
}


#define XB_TMO      128
#define XB_XCNT(j)  (256  + 64 * (j))
#define XB_XSUB(j)  (1280 + 64 * (j))
#define XB_XGEN(j)  (2304 + 64 * (j))
#define XB_TOP      3328
#define XB_TOPGEN   3392
#define XCD_BAR_WORDS 3456
#define XB_SPIN_CAP (1u << 18)
#define LAS __attribute__((address_space(3)))
__device__ __forceinline__ unsigned xb_ld(unsigned* p) { return __hip_atomic_load(p, __ATOMIC_RELAXED, __HIP_MEMORY_SCOPE_AGENT); }
__device__ __forceinline__ unsigned xb_add(unsigned* p, unsigned v) { return __hip_atomic_fetch_add(p, v, __ATOMIC_RELAXED, __HIP_MEMORY_SCOPE_AGENT); }
__device__ __forceinline__ unsigned xb_xcc_id() { return (unsigned)__builtin_amdgcn_s_getreg((3 << 11) | 20) & 0xFu; }
#define XB_SPIN(cond, bar) do { unsigned _sp = 0; while (cond) { __builtin_amdgcn_s_sleep(1); \
    if ((++_sp & 255u) == 0u) { if (xb_ld(&(bar)[XB_TMO])) break; if (_sp > XB_SPIN_CAP) { atomicAdd(&(bar)[XB_TMO], 1u); break; } } } } while (0)
struct XcdBarrier { unsigned* bar; unsigned x; volatile LAS unsigned* st; };
__device__ __forceinline__ XcdBarrier xcd_barrier_post(unsigned* bar, volatile LAS unsigned* st) {
  XcdBarrier b; b.bar = bar; b.x = xb_xcc_id(); b.st = st;
  if (threadIdx.x == 0) (void)xb_add(&bar[XB_XCNT(b.x)], 1u);
  return b;
}
__device__ __forceinline__ void xcd_barrier_complete(unsigned* bar, unsigned x, unsigned& nloc, unsigned& nx) {
  const unsigned G = gridDim.x * gridDim.y * gridDim.z;
  unsigned sum, cnt, mine, sp = 0u;
  for (;;) {
    sum = 0u; cnt = 0u; mine = 0u;
#pragma unroll
    for (unsigned j = 0; j < 16; ++j) { const unsigned c = xb_ld(&bar[XB_XCNT(j)]); sum += c; cnt += (c > 0u) ? 1u : 0u; mine = (j == x) ? c : mine; }
    if (sum == G) break;
    __builtin_amdgcn_s_sleep(1);
    if ((++sp & 255u) == 0u) { if (xb_ld(&bar[XB_TMO])) break; if (sp > XB_SPIN_CAP) { atomicAdd(&bar[XB_TMO], 1u); break; } }
  }
  nloc = mine > 0u ? mine : 1u; nx = cnt > 0u ? cnt : 1u;
}
__device__ __forceinline__ void xcd_barrier(const XcdBarrier& b) {
  asm volatile("s_waitcnt vmcnt(0)" ::: "memory");
  __syncthreads();
  if (threadIdx.x == 0) {
    unsigned* bar = b.bar;
    __builtin_amdgcn_s_waitcnt(0);
    unsigned nloc = b.st[0], nx = b.st[1];
    if (nloc == 0u) { xcd_barrier_complete(bar, b.x, nloc, nx); b.st[0] = nloc; b.st[1] = nx; }
    const unsigned old = xb_add(&bar[XB_XSUB(b.x)], 1u);
    const unsigned gen = old / nloc;
    if (old + 1u == (gen + 1u) * nloc) {
      __builtin_amdgcn_fence(__ATOMIC_RELEASE, "agent");
      asm volatile("s_waitcnt vmcnt(0)" ::: "memory");
      const unsigned og = xb_add(&bar[XB_TOP], 1u);
      const unsigned tg = og / nx;
      if (og + 1u == (tg + 1u) * nx) xb_add(&bar[XB_TOPGEN], 1u);
      else XB_SPIN(xb_ld(&bar[XB_TOPGEN]) == tg, bar);
      __builtin_amdgcn_fence(__ATOMIC_ACQUIRE, "agent");
      xb_add(&bar[XB_XGEN(b.x)], 1u);
      asm volatile("s_waitcnt vmcnt(0)" ::: "memory");
    } else {
      XB_SPIN(xb_ld(&bar[XB_XGEN(b.x)]) == gen, bar);
      __builtin_amdgcn_fence(__ATOMIC_ACQUIRE, "agent");
      asm volatile("s_waitcnt vmcnt(0)" ::: "memory");
    }
  }
  __syncthreads();
}

#define NPHASE 14
__global__ void __launch_bounds__(256, 2) mega(P p, int ph_lo, int ph_hi) {
  __shared__ __align__(16) unsigned char smem[73728 + 16 + (PROBE_PH >= 0 ? 256 : 0)];
  cg::grid_group grid = cg::this_grid();
  if (ph_lo < 0) grid.sync();
  if (threadIdx.x == 0) *(uint4*)(smem + 73728) = make_uint4(0u, 0u, 0u, 0u);
  __syncthreads();
  XcdBarrier xb = xcd_barrier_post((unsigned*)(p.ws + WS_BAR), (volatile LAS unsigned*)(smem + 73728));
  const float* mod = (const float*)(p.ws + WS_MOD);
#define IN(k) (ph_lo <= (k) && (k) < ph_hi)
#define SYNC(k) if (IN(k) && (k) + 1 < ph_hi) { xcd_barrier(xb); if (PROBE_PH >= 0 && blockIdx.x == 0 && threadIdx.x == 0) ((long long*)(smem + 73744))[(k) + 1] = __builtin_amdgcn_s_memrealtime(); }
  if (PROBE_PH >= 0 && blockIdx.x == 0 && threadIdx.x == 0) ((long long*)(smem + 73744))[0] = __builtin_amdgcn_s_memrealtime();
  if (IN(0)) phase_setup(p, smem);
  SYNC(0)
  if (IN(1)) phase_h0(p);
  SYNC(1)
  if (IN(2))
    phase_gemm<0>((const bf16*)(p.ws + WS_H), 1024, (const bf16*)(p.ws + WS_WEI), EVEN_NP / 128, smem,
                  (bf16*)(p.ws + WS_PROJ), EVEN_N, EVEN_N, nullptr, nullptr, nullptr, (unsigned*)(p.ws + WS_BAR), 0);
  SYNC(2)
  if (IN(3)) {
    for (int it = blockIdx.x; it < 1024; it += gridDim.x) { rec_pass1_item<64, 0>(p, it, smem); __syncthreads(); }
  }
  SYNC(3)
  if (IN(4)) {
    phase_rec_scan<64>(p);
    for (int it = blockIdx.x; it < 2048 * REPN + 16 * 66 + 256; it += gridDim.x) {
      if (it < 2048 * REPN) na_item(p, it & 2047, smem);
      else if (it < 2048 * REPN + 16 * 66) transpose_item(p.o_w_in, ODD_N, (bf16*)(p.ws + WS_WOI), it - 2048 * REPN, smem);
      else transpose_item(p.o_w_out, 1024, (bf16*)(p.ws + WS_WOO), it - 2048 * REPN - 16 * 66, smem);
      __syncthreads();
    }
  }
  SYNC(4)
  if (IN(5)) {
    for (int it = blockIdx.x; it < 1024 * REPR; it += gridDim.x) { rec_pass3_item<64, 0>(p, it & 1023, smem); __syncthreads(); }
  }
  SYNC(5)
  if (IN(6))
    phase_gemm<1>((const bf16*)(p.ws + WS_H), 1024, (const bf16*)(p.ws + WS_WEO), 8, smem, nullptr, 0, 0, p.x, (float*)(p.ws + WS_ST),
                  mod + 2048, (unsigned*)(p.ws + WS_BAR), 1);
  SYNC(6)
  if (IN(7)) phase_ln(p, 0, true);
  SYNC(7)
  if (IN(8))
    phase_gemm<0>((const bf16*)(p.ws + WS_H), 1024, (const bf16*)(p.ws + WS_WOI), ODD_NP / 128, smem,
                  (bf16*)(p.ws + WS_PROJ), ODD_N, ODD_N, nullptr, nullptr, nullptr, (unsigned*)(p.ws + WS_BAR), 2);
  SYNC(8)
  if (IN(9)) {
    for (int it = blockIdx.x; it < 512 + 1024; it += gridDim.x) {
      if (it < 512) ssd_pass1_item(p, it, smem); else rec_pass1_item<128, 1>(p, it - 512, smem);
      __syncthreads();
    }
  }
  SYNC(9)
  if (IN(10)) { phase_rec_scan<128>(p); phase_ssd_scan(p); }
  SYNC(10)
  if (IN(11)) {
    for (int it = blockIdx.x; it < 512 + 1024; it += gridDim.x) {
      if (it < 512) ssd_pass3_item(p, it, smem); else rec_pass3_item<128, 1>(p, it - 512, smem);
      __syncthreads();
    }
  }
  SYNC(11)
  if (IN(12))
    phase_gemm<2>((const bf16*)(p.ws + WS_PROJ) + 2048, ODD_N, (const bf16*)(p.ws + WS_WOO), 8, smem, nullptr, 0, 0,
                  (const float*)p.out, (float*)(p.ws + WS_ST), mod + 4 * 3072 + 2048, (unsigned*)(p.ws + WS_BAR), 3,
                  (const float*)(p.ws + WS_SSQ));
  SYNC(12)
  if (IN(13)) phase_ln(p, 1, false, smem + 73744);
}

extern "C" void kernel_launch(void* const* d_in, const int* in_sizes, int n_in, void* d_out, int out_size, void* d_ws,
                              size_t ws_size, hipStream_t stream) {
  static int grid_blocks = 0;
  if (!grid_blocks) {
    int dev = 0, cus = 0, per_cu = 0;
    hipGetDevice(&dev);
    hipDeviceGetAttribute(&cus, hipDeviceAttributeMultiprocessorCount, dev);
    hipOccupancyMaxActiveBlocksPerMultiprocessor(&per_cu, mega, 256, 0);
    if (per_cu < 1) per_cu = 1;
    if (per_cu > 2) per_cu = 2;
    grid_blocks = cus * per_cu;
    if (n_in != 22 || ws_size < WS_END) {
      fprintf(stderr, "kernel_launch: unexpected n_in %d / ws_size %zu (need %llu)\n", n_in, ws_size, (unsigned long long)WS_END);
      grid_blocks = -1;
    }
  }
  if (grid_blocks < 0) return;
  P p{};
  const float** f = (const float**)&p;
  for (int i = 0; i < 22; ++i) f[i] = (const float*)d_in[i];
  p.out = (float*)d_out;
  p.ws = (unsigned char*)d_ws;
#if 1
  if (hipMemsetAsync((char*)d_ws + WS_BAR, 0, 16384, stream) != hipSuccess) { fprintf(stderr, "memset of barrier words failed\n"); return; }
  int lo = 0, hi = NPHASE;
  void* args[] = {&p, &lo, &hi};
  hipError_t e = hipLaunchCooperativeKernel((void*)mega, dim3(grid_blocks), dim3(256), args, 0, stream);
  if (e != hipSuccess) fprintf(stderr, "cooperative launch failed: %s (grid %d)\n", hipGetErrorString(e), grid_blocks);
#else
  for (int ph = 0; ph < NPHASE; ++ph) hipLaunchKernelGGL(mega, dim3(grid_blocks), dim3(256), 0, stream, p, ph, ph + 1);
#endif
}
```

```cpp
#include <hip/hip_runtime.h>
#include <hip/hip_cooperative_groups.h>
#include <cstdio>
namespace cg = cooperative_groups;

typedef unsigned short bf16;
using bf16x8 = __attribute__((ext_vector_type(8))) short;
using f32x4 = __attribute__((ext_vector_type(4))) float;

#define M_TOK 16384
#define DM 1024
#define SEQ 4096
#define EVEN_N 3616
#define EVEN_NP 3712
#define ODD_N 4112
#define ODD_NP 4224
#define ALPHA 1.4142135623730951f
#ifndef PROBE_PH
#define PROBE_PH -1
#endif
#ifndef REPG
#define REPG 1
#endif
#ifndef REPN
#define REPN 1
#endif
#ifndef REP3
#define REP3 1
#endif
#ifndef REPS
#define REPS 1
#endif
#ifndef REP0
#define REP0 1
#endif
#ifndef REPR
#define REPR 1
#endif

#define WS_MOD 0ull
#define WS_LB (WS_MOD + 98304ull)
#define WS_WEI (WS_LB + 2048ull)
#define WS_WEO (WS_WEI + 3712ull * 2048)
#define WS_WOI (WS_WEO + 1024ull * 2048)
#define WS_WOO (WS_WOI + 4224ull * 2048)
#define WS_H (WS_WOO + 1024ull * 2048)
#define WS_PROJ (WS_H + 16384ull * 2048)
#define WS_O (WS_PROJ + 16384ull * 4112 * 2)
#define WS_ST WS_O
#define WS_DEC (WS_O + 2ull * 16384 * 512 * 4)
#define WS_SSQ (WS_DEC + 2ull * 16 * 64 * 128 * 4)
#define WS_BAR (WS_SSQ + 2ull * 16384 * 4)
#define WS_CMID (WS_BAR + 16384ull)
#define WS_DECS (WS_CMID + 2ull * 16 * 64 * 128 * 4)
#define WS_END (WS_DECS + 16384ull)

struct P {
  const float *x, *c, *ada_w, *ada_b, *ln_g, *ln_b, *e_w_in, *e_rpb, *gla_w_up, *gla_b, *gla_g, *e_w_out;
  const float *o_w_in, *hgrn_lb, *hgrn_g, *conv_w, *conv_b, *dt_bias, *a_log, *d_skip, *ssm_g, *o_w_out;
  float* out;
  unsigned char* ws;
};

__device__ __forceinline__ bf16 f2bf(float f) {
  __bf16 h = (__bf16)f;
  return *(bf16*)&h;
}
using u32x4 = __attribute__((ext_vector_type(4))) unsigned;
__device__ __forceinline__ u32x4 gload16_asm(const void* ptr) {
  u32x4 r;
  asm volatile("global_load_dwordx4 %0, %1, off" : "=v"(r) : "v"(ptr));
  return r;
}
using u32x2 = __attribute__((ext_vector_type(2))) unsigned;
__device__ __forceinline__ u32x2 gload8_asm(const void* ptr) {
  u32x2 r;
  asm volatile("global_load_dwordx2 %0, %1, off" : "=v"(r) : "v"(ptr));
  return r;
}
__device__ __forceinline__ float bf2f(bf16 h) { return __uint_as_float(((unsigned)h) << 16); }
__device__ __forceinline__ float frcp(float x) { return __builtin_amdgcn_rcpf(x); }
__device__ __forceinline__ float silu_f(float v) { return v * frcp(1.f + __expf(-v)); }
__device__ __forceinline__ float sigmoid_f(float v) { return frcp(1.f + __expf(-v)); }
__device__ __forceinline__ float flog(float x) { return __builtin_amdgcn_logf(x) * 0.6931471805599453f; }
__device__ __forceinline__ float log_sigmoid_f(float z) { return fminf(z, 0.f) - flog(1.f + __expf(-fabsf(z))); }
__device__ __forceinline__ float softplus_f(float z) { return fmaxf(z, 0.f) + log1pf(__expf(-fabsf(z))); }
__device__ __forceinline__ float wave_sum(float v) {
#pragma unroll
  for (int o = 32; o > 0; o >>= 1) v += __shfl_xor(v, o, 64);
  return v;
}

__device__ __forceinline__ void transpose_item(const float* __restrict__ src, int N, bf16* __restrict__ dst, int li, unsigned char* smem) {
  float* tile = (float*)smem;
  const int tid = threadIdx.x;
  const int kt = li & 15, ntile = li >> 4;
#pragma unroll
  for (int i = 0; i < 16; ++i) {
    int row = i * 4 + (tid >> 6), col = tid & 63;
    int n = ntile * 64 + col;
    float v = (n < N) ? src[(size_t)(kt * 64 + row) * N + n] : 0.f;
    tile[row * 65 + col] = v;
  }
  __syncthreads();
#pragma unroll
  for (int i = 0; i < 16; ++i) {
    int r = i * 4 + (tid >> 6), cc = tid & 63;
    dst[(size_t)(ntile * 64 + r) * 1024 + kt * 64 + cc] = f2bf(tile[cc * 65 + r]);
  }
}

__device__ __forceinline__ void mod_item(const P& p, int idx, unsigned char* smem) {
  float* cond = (float*)smem;
  float* red = cond + 4096;
  const int tid = threadIdx.x;
  const int l = idx / 192, nc = idx % 192;
  for (int e = tid; e < 4096; e += 256) cond[e] = silu_f(p.c[e]);
  __syncthreads();
  const int kg = tid >> 4, col = tid & 15, n = nc * 16 + col;
  float a0 = 0.f, a1 = 0.f, a2 = 0.f, a3 = 0.f;
  const float* w = p.ada_w + (size_t)l * 1024 * 3072 + n;
#pragma unroll 16
  for (int k = kg * 64; k < kg * 64 + 64; ++k) {
    float wv = w[(size_t)k * 3072];
    a0 += cond[k] * wv; a1 += cond[1024 + k] * wv; a2 += cond[2048 + k] * wv; a3 += cond[3072 + k] * wv;
  }
  red[(kg * 4 + 0) * 16 + col] = a0; red[(kg * 4 + 1) * 16 + col] = a1;
  red[(kg * 4 + 2) * 16 + col] = a2; red[(kg * 4 + 3) * 16 + col] = a3;
  __syncthreads();
  if (tid < 64) {
    const int b = tid >> 4;
    float sum = 0.f;
#pragma unroll
    for (int q = 0; q < 16; ++q) sum += red[(q * 4 + b) * 16 + col];
    float* mod = (float*)(p.ws + WS_MOD);
    mod[(size_t)(l * 4 + b) * 3072 + n] = sum + p.ada_b[l * 3072 + n];
  }
}

__device__ __forceinline__ void phase_setup(const P& p, unsigned char* smem) {
  const int M0 = 384, T0 = M0 + 16 * 58, T1 = T0 + 256, T5 = T1 + 1;
  for (int rep = 0; rep < REP0; ++rep)
  for (int it = blockIdx.x; it < T5; it += gridDim.x) {
    if (it < M0) mod_item(p, it, smem);
    else if (it < T0) transpose_item(p.e_w_in, EVEN_N, (bf16*)(p.ws + WS_WEI), it - M0, smem);
    else if (it < T1) transpose_item(p.e_w_out, 1024, (bf16*)(p.ws + WS_WEO), it - T0, smem);
    else {
      float* lbv = (float*)(p.ws + WS_LB);
      for (int j = threadIdx.x; j < 512; j += 256) {
        float a = p.hgrn_lb[j], bb = p.hgrn_lb[512 + j];
        lbv[j] = 1.f / (1.f + __expf(a - bb));
      }
    }
    __syncthreads();
  }
}

__device__ __forceinline__ void phase_h0(const P& p) {
  const float* mod = (const float*)(p.ws + WS_MOD);
  bf16* hb = (bf16*)(p.ws + WS_H);
  const size_t total = (size_t)M_TOK * 128;
  for (size_t i = (size_t)blockIdx.x * 256 + threadIdx.x; i < total; i += (size_t)gridDim.x * 256) {
    int m = (int)(i >> 7), n = (int)(i & 127) * 8, b = m >> 12;
    const float4* xp = (const float4*)(p.x + (size_t)m * 1024 + n);
    const float4* sh = (const float4*)(mod + (size_t)b * 3072 + n);
    const float4* sc = (const float4*)(mod + (size_t)b * 3072 + 1024 + n);
    float4 x0 = xp[0], x1 = xp[1], s0 = sh[0], s1 = sh[1], c0 = sc[0], c1 = sc[1];
    uint4 o;
    o.x = (unsigned)f2bf(x0.x * (1.f + c0.x) + s0.x) | ((unsigned)f2bf(x0.y * (1.f + c0.y) + s0.y) << 16);
    o.y = (unsigned)f2bf(x0.z * (1.f + c0.z) + s0.z) | ((unsigned)f2bf(x0.w * (1.f + c0.w) + s0.w) << 16);
    o.z = (unsigned)f2bf(x1.x * (1.f + c1.x) + s1.x) | ((unsigned)f2bf(x1.y * (1.f + c1.y) + s1.y) << 16);
    o.w = (unsigned)f2bf(x1.z * (1.f + c1.z) + s1.z) | ((unsigned)f2bf(x1.w * (1.f + c1.w) + s1.w) << 16);
    *(uint4*)(hb + (size_t)m * 1024 + n) = o;
  }
}

#ifndef GEMM_NST
#define GEMM_NST 2
#endif
#define LSTR 64
__device__ __forceinline__ void gemm_issue(const bf16* __restrict__ A, int lda, const bf16* __restrict__ Bt, int m0, int n0,
                                           u32x4 (&ra)[GEMM_NST][4], u32x4 (&rb)[GEMM_NST][4]) {
  const int tid = threadIdx.x, lrow = tid >> 3, lkc = tid & 7;
  const bf16* Ag = A + (size_t)(m0 + lrow) * lda + lkc * 8;
  const bf16* Bg = Bt + (size_t)(n0 + lrow) * 1024 + lkc * 8;
#pragma unroll
  for (int t = 0; t < GEMM_NST; ++t)
#pragma unroll
    for (int i = 0; i < 4; ++i) {
      ra[t][i] = gload16_asm(Ag + (size_t)i * 32 * lda + t * 64);
      rb[t][i] = gload16_asm(Bg + (size_t)i * 32 * 1024 + t * 64);
    }
}

template <int EPI, typename NextFn>
__device__ __forceinline__ void gemm_tile(const bf16* __restrict__ A, int lda, const bf16* __restrict__ Bt, int m0, int n0,
                                          unsigned char* smem, bf16* __restrict__ C, int ldc, int nreal,
                                          const float* __restrict__ X, float* __restrict__ R, const float* __restrict__ gate,
                                          const float* __restrict__ ssqp, u32x4 (&ra)[GEMM_NST][4], u32x4 (&rb)[GEMM_NST][4],
                                          NextFn&& next_issue) {
  bf16* As = (bf16*)smem;
  bf16* Bs = As + 2 * 128 * LSTR;
  const int tid = threadIdx.x, lane = tid & 63, wave = tid >> 6;
  const int wm = wave >> 1, wn = wave & 1;
  f32x4 acc[4][4];
#pragma unroll
  for (int i = 0; i < 4; ++i)
#pragma unroll
    for (int j = 0; j < 4; ++j) acc[i][j] = (f32x4){0.f, 0.f, 0.f, 0.f};
  float rsv[4] = {1.f, 1.f, 1.f, 1.f};
  if (EPI == 2) {
#pragma unroll
    for (int j = 0; j < 4; ++j) {
      const int m = m0 + wm * 64 + j * 16 + (lane & 15);
      rsv[j] = rsqrtf((ssqp[m] + ssqp[M_TOK + m]) * (1.f / 512.f) + 1e-6f);
    }
  }
  const int lrow = tid >> 3, lkc = tid & 7;
  const int lsw = (lkc ^ (lrow & 7)) * 8;
  const bf16* Ag = A + (size_t)(m0 + lrow) * lda + lkc * 8;
  const bf16* Bg = Bt + (size_t)(n0 + lrow) * 1024 + lkc * 8;
  if (GEMM_NST == 3) {
    asm volatile("s_waitcnt vmcnt(16)"
                 : "+v"(ra[0][0]), "+v"(ra[0][1]), "+v"(ra[0][2]), "+v"(ra[0][3]), "+v"(rb[0][0]), "+v"(rb[0][1]), "+v"(rb[0][2]), "+v"(rb[0][3])
                 :: "memory");
  } else {
    asm volatile("s_waitcnt vmcnt(8)"
                 : "+v"(ra[0][0]), "+v"(ra[0][1]), "+v"(ra[0][2]), "+v"(ra[0][3]), "+v"(rb[0][0]), "+v"(rb[0][1]), "+v"(rb[0][2]), "+v"(rb[0][3])
                 :: "memory");
  }
#pragma unroll
  for (int i = 0; i < 4; ++i) {
    *(u32x4*)(As + (lrow + i * 32) * LSTR + lsw) = ra[0][i];
    *(u32x4*)(Bs + (lrow + i * 32) * LSTR + lsw) = rb[0][i];
  }
  __syncthreads();
#pragma unroll
  for (int kt = 0; kt < 16; ++kt) {
    const int buf = kt & 1;
    if (kt + 1 < 16) {
      const int sn = (kt + 1) % GEMM_NST;
      if (GEMM_NST == 3 && kt + 2 < 16) {
        asm volatile("s_waitcnt vmcnt(8)"
                     : "+v"(ra[sn][0]), "+v"(ra[sn][1]), "+v"(ra[sn][2]), "+v"(ra[sn][3]), "+v"(rb[sn][0]), "+v"(rb[sn][1]), "+v"(rb[sn][2]), "+v"(rb[sn][3])
                     :: "memory");
      } else {
        asm volatile("s_waitcnt vmcnt(0)"
                     : "+v"(ra[sn][0]), "+v"(ra[sn][1]), "+v"(ra[sn][2]), "+v"(ra[sn][3]), "+v"(rb[sn][0]), "+v"(rb[sn][1]), "+v"(rb[sn][2]), "+v"(rb[sn][3])
                     :: "memory");
      }
      bf16* Aw = As + (buf ^ 1) * 128 * LSTR;
      bf16* Bw = Bs + (buf ^ 1) * 128 * LSTR;
#pragma unroll
      for (int i = 0; i < 4; ++i) {
        *(u32x4*)(Aw + (lrow + i * 32) * LSTR + lsw) = ra[sn][i];
        *(u32x4*)(Bw + (lrow + i * 32) * LSTR + lsw) = rb[sn][i];
      }
    }
    if (kt + GEMM_NST < 16) {
#pragma unroll
      for (int i = 0; i < 4; ++i) {
        ra[kt % GEMM_NST][i] = gload16_asm(Ag + (size_t)i * 32 * lda + (kt + GEMM_NST) * 64);
        rb[kt % GEMM_NST][i] = gload16_asm(Bg + (size_t)i * 32 * 1024 + (kt + GEMM_NST) * 64);
      }
    }
    const bf16* Ab = As + buf * 128 * LSTR;
    const bf16* Bb = Bs + buf * 128 * LSTR;
    if (EPI == 2 && kt == 8) {
#pragma unroll
      for (int j = 0; j < 4; ++j) {
        const float inv = frcp(rsv[j]);
#pragma unroll
        for (int i = 0; i < 4; ++i) { acc[i][j][0] *= inv; acc[i][j][1] *= inv; acc[i][j][2] *= inv; acc[i][j][3] *= inv; }
      }
    }
#pragma unroll
    for (int s = 0; s < 2; ++s) {
      bf16x8 wf[4], xf[4];
#pragma unroll
      for (int i = 0; i < 4; ++i) {
        wf[i] = *(const bf16x8*)(Bb + (wn * 64 + i * 16 + (lane & 15)) * LSTR + (((s * 4 + (lane >> 4)) ^ (lane & 7)) * 8));
        xf[i] = *(const bf16x8*)(Ab + (wm * 64 + i * 16 + (lane & 15)) * LSTR + (((s * 4 + (lane >> 4)) ^ (lane & 7)) * 8));
      }
#pragma unroll
      for (int i = 0; i < 4; ++i)
#pragma unroll
        for (int j = 0; j < 4; ++j) acc[i][j] = __builtin_amdgcn_mfma_f32_16x16x32_bf16(wf[i], xf[j], acc[i][j], 0, 0, 0);
    }
    __syncthreads();
  }
  next_issue();
#pragma unroll
  for (int i = 0; i < 4; ++i) {
    const int n = n0 + wn * 64 + i * 16 + (lane >> 4) * 4;
#pragma unroll
    for (int j = 0; j < 4; ++j) {
      const int m = m0 + wm * 64 + j * 16 + (lane & 15);
      f32x4 a = acc[i][j];
      if (EPI == 2) { a[0] *= rsv[j]; a[1] *= rsv[j]; a[2] *= rsv[j]; a[3] *= rsv[j]; }
      if (EPI == 0) {
        uint2 o;
        o.x = (unsigned)f2bf(a[0]) | ((unsigned)f2bf(a[1]) << 16);
        o.y = (unsigned)f2bf(a[2]) | ((unsigned)f2bf(a[3]) << 16);
        *(uint2*)((bf16*)smem + (wm * 64 + j * 16 + (lane & 15)) * 136 + wn * 64 + i * 16 + (lane >> 4) * 4) = o;
      } else {
        *(f32x4*)((float*)smem + (wm * 64 + j * 16 + (lane & 15)) * 132 + wn * 64 + i * 16 + (lane >> 4) * 4) = a;
      }
    }
  }
  if (EPI == 0) {
    __syncthreads();
#pragma unroll
    for (int q = 0; q < 8; ++q) {
      const int c = q * 256 + tid, row = c >> 4, c16 = c & 15;
      const int n = n0 + c16 * 8;
      if (n < nreal) *(u32x4*)(C + (size_t)(m0 + row) * ldc + n) = *(const u32x4*)((const bf16*)smem + row * 136 + c16 * 8);
    }
    __syncthreads();
  } else {
    __syncthreads();
#pragma unroll 4
    for (int q = 0; q < 16; ++q) {
      const int c = q * 256 + tid, row = c >> 5, c4 = c & 31;
      const int m = m0 + row, n = n0 + c4 * 4, b = m >> 12;
      const f32x4 a = *(const f32x4*)((const float*)smem + row * 132 + c4 * 4);
      float4 xv;
      if (EPI == 2) {
        uint2 xu = *(const uint2*)((const bf16*)X + (size_t)m * 1024 + n);
        xv.x = __uint_as_float(xu.x << 16); xv.y = __uint_as_float(xu.x & 0xffff0000u);
        xv.z = __uint_as_float(xu.y << 16); xv.w = __uint_as_float(xu.y & 0xffff0000u);
      } else xv = *(const float4*)(X + (size_t)m * 1024 + n);
      const float4 g = *(const float4*)(gate + (size_t)b * 3072 + n);
      float4 o;
      o.x = ALPHA * xv.x + g.x * a[0];
      o.y = ALPHA * xv.y + g.y * a[1];
      o.z = ALPHA * xv.z + g.z * a[2];
      o.w = ALPHA * xv.w + g.w * a[3];
      *(float4*)(R + (size_t)m * 1024 + n) = o;
    }
    __syncthreads();
  }
}

template <int EPI>
__device__ __forceinline__ void phase_gemm(const bf16* A, int lda, const bf16* Bt, int ntn, unsigned char* smem, bf16* C, int ldc, int nreal,
                           const float* X, float* R, const float* gate, unsigned* bar, int gidx, const float* ssqp = nullptr) {
  volatile unsigned* stw = (volatile unsigned*)(smem + 73728);
  const unsigned xid = (unsigned)__builtin_amdgcn_s_getreg((3 << 11) | 20) & 0xFu;
  int xidx = 0, nx = 0;
#pragma unroll
  for (int j = 0; j < 16; ++j) {
    const unsigned c = __hip_atomic_load(&bar[256 + 64 * j], __ATOMIC_RELAXED, __HIP_MEMORY_SCOPE_AGENT);
    if (c > 0u) { nx++; if ((unsigned)j < xid) xidx++; }
  }
  const int mt_lo = (xidx * 128) / nx, mt_hi = ((xidx + 1) * 128) / nx;
  const int total = (mt_hi - mt_lo) * ntn;
  unsigned* qc = bar + 3456 + (gidx * 16 + xidx) * 8;
  u32x4 ra[GEMM_NST][4], rb[GEMM_NST][4];
  int mt = 0, nt = 0;
  bool valid = false;
  auto fetch = [&](int& mt_o, int& nt_o) -> bool {
    __syncthreads();
    if (threadIdx.x == 0) stw[2] = __hip_atomic_fetch_add(qc, 1u, __ATOMIC_RELAXED, __HIP_MEMORY_SCOPE_AGENT);
    __syncthreads();
    const int t = (int)stw[2];
    if (t >= total) return false;
    const int g8 = t / (8 * ntn), r = t - g8 * 8 * ntn;
    const int rows = mt_hi - mt_lo - g8 * 8;
    const int gm = rows < 8 ? rows : 8;
    nt_o = r / gm; mt_o = mt_lo + g8 * 8 + (r - nt_o * gm);
    return true;
  };
  valid = fetch(mt, nt);
  if (valid) gemm_issue(A, lda, Bt, mt * 128, nt * 128, ra, rb);
  while (valid) {
    int mt2 = 0, nt2 = 0;
    bool valid2 = false;
    gemm_tile<EPI>(A, lda, Bt, mt * 128, nt * 128, smem, C, ldc, nreal, X, R, gate, ssqp, ra, rb, [&]() {
      valid2 = fetch(mt2, nt2);
      if (valid2) gemm_issue(A, lda, Bt, mt2 * 128, nt2 * 128, ra, rb);
    });
    mt = mt2; nt = nt2; valid = valid2;
  }
}

__device__ __forceinline__ void phase_ln(const P& p, int l, bool write_h, const unsigned char* probe_ts = nullptr) {
  const float* mod = (const float*)(p.ws + WS_MOD);
  bf16* hb = (bf16*)(p.ws + WS_H);
  const int lane = threadIdx.x & 63, wave = threadIdx.x >> 6;
  const float* g = p.ln_g + l * 1024;
  const float* bb = p.ln_b + l * 1024;
  constexpr int NR = 4;
  for (int grp = blockIdx.x * 4 + wave; grp < M_TOK / NR; grp += gridDim.x * 4) {
    float4 v[NR][4];
    float s[NR];
#pragma unroll
    for (int r = 0; r < NR; ++r) {
      const float* rp = (const float*)(p.ws + WS_ST) + (size_t)(grp * NR + r) * 1024;
#pragma unroll
      for (int q = 0; q < 4; ++q) v[r][q] = *(const float4*)(rp + (lane + 64 * q) * 4);
    }
#pragma unroll
    for (int r = 0; r < NR; ++r) {
      s[r] = 0.f;
#pragma unroll
      for (int q = 0; q < 4; ++q) s[r] += v[r][q].x + v[r][q].y + v[r][q].z + v[r][q].w;
    }
#pragma unroll
    for (int o = 32; o > 0; o >>= 1)
#pragma unroll
      for (int r = 0; r < NR; ++r) s[r] += __shfl_xor(s[r], o, 64);
    float mu[NR], s2[NR];
#pragma unroll
    for (int r = 0; r < NR; ++r) {
      mu[r] = s[r] * (1.f / 1024.f);
      s2[r] = 0.f;
#pragma unroll
      for (int q = 0; q < 4; ++q) {
        float a = v[r][q].x - mu[r], b2 = v[r][q].y - mu[r], c2 = v[r][q].z - mu[r], d2 = v[r][q].w - mu[r];
        s2[r] += a * a + b2 * b2 + c2 * c2 + d2 * d2;
      }
    }
#pragma unroll
    for (int o = 32; o > 0; o >>= 1)
#pragma unroll
      for (int r = 0; r < NR; ++r) s2[r] += __shfl_xor(s2[r], o, 64);
#pragma unroll
    for (int q = 0; q < 4; ++q) {
      const int n = (lane + 64 * q) * 4;
      const float4 gg = *(const float4*)(g + n), be = *(const float4*)(bb + n);
#pragma unroll
      for (int r = 0; r < NR; ++r) {
        const int row = grp * NR + r;
        const float rstd = rsqrtf(s2[r] * (1.f / 1024.f) + 1e-5f);
        float4 o;
        o.x = (v[r][q].x - mu[r]) * rstd * gg.x + be.x;
        o.y = (v[r][q].y - mu[r]) * rstd * gg.y + be.y;
        o.z = (v[r][q].z - mu[r]) * rstd * gg.z + be.z;
        o.w = (v[r][q].w - mu[r]) * rstd * gg.w + be.w;
        if (PROBE_PH >= 0 && l == 1 && row == 0) {
          const long long* ts = (const long long*)(probe_ts);
          const int kus = (int)((ts[PROBE_PH + 1] - ts[PROBE_PH]) / 100);
          if (n + 0 < kus) o.x += 0.125f;
          if (n + 1 < kus) o.y += 0.125f;
          if (n + 2 < kus) o.z += 0.125f;
          if (n + 3 < kus) o.w += 0.125f;
        }
        if (!write_h) *(float4*)(p.out + (size_t)row * 1024 + n) = o;
        if (write_h) {
          const int b = row >> 12;
          uint2 xb16;
          xb16.x = (unsigned)f2bf(o.x) | ((unsigned)f2bf(o.y) << 16);
          xb16.y = (unsigned)f2bf(o.z) | ((unsigned)f2bf(o.w) << 16);
          *(uint2*)((bf16*)p.out + (size_t)row * 1024 + n) = xb16;
          const float* md = mod + (size_t)(4 + b) * 3072;
          float4 sh = *(const float4*)(md + n), sc = *(const float4*)(md + 1024 + n);
          uint2 hh;
          hh.x = (unsigned)f2bf(o.x * (1.f + sc.x) + sh.x) | ((unsigned)f2bf(o.y * (1.f + sc.y) + sh.y) << 16);
          hh.y = (unsigned)f2bf(o.z * (1.f + sc.z) + sh.z) | ((unsigned)f2bf(o.w * (1.f + sc.w) + sh.w) << 16);
          *(uint2*)(hb + (size_t)row * 1024 + n) = hh;
        }
      }
    }
  }
}

__device__ __forceinline__ void na_item(const P& p, int item, unsigned char* smem) {
  const int h = item & 7, r = (item >> 3) & 63, b = item >> 9;
  bf16* VT = (bf16*)smem;
  float* RPB = (float*)(VT + 64 * 520);
  const bf16* projb = (const bf16*)(p.ws + WS_PROJ) + (size_t)b * 4096 * EVEN_N;
  bf16* yb = (bf16*)(p.ws + WS_H);
  const int tid = threadIdx.x, lane = tid & 63, n = tid >> 6;
  const int q = lane & 15, g4 = lane >> 4;
  int rs = r - 4; rs = rs < 0 ? 0 : (rs > 56 ? 56 : rs);
#pragma unroll 8
  for (int i = 0; i < 16; ++i) {
    const int key = (i >> 3) * 256 + tid, ch = i & 7;
    const int tok = (rs + (key >> 6)) * 64 + (key & 63);
    uint4 u = *(const uint4*)(projb + (size_t)tok * EVEN_N + 1024 + h * 64 + ch * 8);
    bf16* dst = VT + (ch * 8) * 520 + key;
    dst[0 * 520] = (bf16)(u.x & 0xffffu); dst[1 * 520] = (bf16)(u.x >> 16);
    dst[2 * 520] = (bf16)(u.y & 0xffffu); dst[3 * 520] = (bf16)(u.y >> 16);
    dst[4 * 520] = (bf16)(u.z & 0xffffu); dst[5 * 520] = (bf16)(u.z >> 16);
    dst[6 * 520] = (bf16)(u.w & 0xffffu); dst[7 * 520] = (bf16)(u.w >> 16);
  }
  for (int i = tid; i < 465; i += 256) RPB[i] = p.e_rpb[h * 465 + i];
  const int qcol = n * 16 + q;
  const int qtok = r * 64 + qcol;
  const int bs = n == 0 ? 0 : (n == 1 ? 8 : (n == 2 ? 24 : 32));
  const bf16x8 qf0 = *(const bf16x8*)(projb + (size_t)qtok * EVEN_N + h * 64 + g4 * 8);
  const bf16x8 qf1 = *(const bf16x8*)(projb + (size_t)qtok * EVEN_N + h * 64 + 32 + g4 * 8);
  f32x4 st[16];
#pragma unroll
  for (int tt = 0; tt < 16; ++tt) {
    const int ktok = (rs + (tt >> 1)) * 64 + bs + (tt & 1) * 16 + q;
    const bf16* kp = projb + (size_t)ktok * EVEN_N + 512 + h * 64 + g4 * 8;
    bf16x8 kf0 = *(const bf16x8*)kp, kf1 = *(const bf16x8*)(kp + 32);
    f32x4 z = (f32x4){0.f, 0.f, 0.f, 0.f};
    z = __builtin_amdgcn_mfma_f32_16x16x32_bf16(kf0, qf0, z, 0, 0, 0);
    st[tt] = __builtin_amdgcn_mfma_f32_16x16x32_bf16(kf1, qf1, z, 0, 0, 0);
  }
  __syncthreads();
  int cs = qcol - 8; cs = cs < 0 ? 0 : (cs > 48 ? 48 : cs);
  float mx = -1e30f;
#pragma unroll
  for (int tt = 0; tt < 16; ++tt) {
    const float* brow = RPB + (rs + (tt >> 1) - r + 7) * 31;
#pragma unroll
    for (int rr = 0; rr < 4; ++rr) {
      const int kcol = bs + (tt & 1) * 16 + g4 * 4 + rr;
      const bool valid = (kcol >= cs) && (kcol < cs + 16);
      int dc = kcol - qcol + 15; dc = dc < 0 ? 0 : (dc > 30 ? 30 : dc);
      const float sc = valid ? st[tt][rr] * 0.125f + brow[dc] : -1e30f;
      st[tt][rr] = sc;
      mx = fmaxf(mx, sc);
    }
  }
  mx = fmaxf(mx, __shfl_xor(mx, 16, 64));
  mx = fmaxf(mx, __shfl_xor(mx, 32, 64));
  float lsum = 0.f;
#pragma unroll
  for (int tt = 0; tt < 16; ++tt)
#pragma unroll
    for (int rr = 0; rr < 4; ++rr) {
      const float pe = __expf(st[tt][rr] - mx);
      st[tt][rr] = pe;
      lsum += pe;
    }
  lsum += __shfl_xor(lsum, 16, 64);
  lsum += __shfl_xor(lsum, 32, 64);
  f32x4 ot[4];
#pragma unroll
  for (int dt = 0; dt < 4; ++dt) ot[dt] = (f32x4){0.f, 0.f, 0.f, 0.f};
#pragma unroll
  for (int kr = 0; kr < 8; ++kr) {
    uint4 pw;
    pw.x = (unsigned)f2bf(st[2 * kr][0]) | ((unsigned)f2bf(st[2 * kr][1]) << 16);
    pw.y = (unsigned)f2bf(st[2 * kr][2]) | ((unsigned)f2bf(st[2 * kr][3]) << 16);
    pw.z = (unsigned)f2bf(st[2 * kr + 1][0]) | ((unsigned)f2bf(st[2 * kr + 1][1]) << 16);
    pw.w = (unsigned)f2bf(st[2 * kr + 1][2]) | ((unsigned)f2bf(st[2 * kr + 1][3]) << 16);
    const bf16x8 pf = *(bf16x8*)&pw;
#pragma unroll
    for (int dt = 0; dt < 4; ++dt) {
      const bf16* vp = VT + (dt * 16 + q) * 520 + kr * 64 + bs + g4 * 4;
      uint2 lo = *(const uint2*)vp, hi = *(const uint2*)(vp + 16);
      uint4 vw; vw.x = lo.x; vw.y = lo.y; vw.z = hi.x; vw.w = hi.y;
      ot[dt] = __builtin_amdgcn_mfma_f32_16x16x32_bf16(*(bf16x8*)&vw, pf, ot[dt], 0, 0, 0);
    }
  }
  const float inv = frcp(lsum);
#pragma unroll
  for (int dt = 0; dt < 4; ++dt) {
    const int d0 = dt * 16 + g4 * 4;
    uint2 gu = *(const uint2*)(projb + (size_t)qtok * EVEN_N + 1536 + h * 64 + d0);
    f32x4 y;
    y[0] = ot[dt][0] * inv * silu_f(__uint_as_float(gu.x << 16));
    y[1] = ot[dt][1] * inv * silu_f(__uint_as_float(gu.x & 0xffff0000u));
    y[2] = ot[dt][2] * inv * silu_f(__uint_as_float(gu.y << 16));
    y[3] = ot[dt][3] * inv * silu_f(__uint_as_float(gu.y & 0xffff0000u));
    uint2 o;
    o.x = (unsigned)f2bf(y[0]) | ((unsigned)f2bf(y[1]) << 16);
    o.y = (unsigned)f2bf(y[2]) | ((unsigned)f2bf(y[3]) << 16);
    *(uint2*)(yb + ((size_t)b * 4096 + qtok) * 1024 + h * 64 + d0) = o;
  }
}

template <int K, int MODE>
struct GateC {
  float w[16];
  float bias, lb;
  int d, ch;
  __device__ __forceinline__ void init(const P& p, int d_, int h, int k) {
    d = d_; ch = h * K + k;
    if (MODE == 0) {
#pragma unroll
      for (int r = 0; r < 16; ++r) w[r] = p.gla_w_up[(d * 16 + r) * 256 + ch];
      bias = p.gla_b[d * 256 + ch];
      lb = 0.f;
    } else {
      lb = ((const float*)(p.ws + WS_LB))[ch];
      bias = 0.f;
    }
  }
  __device__ __forceinline__ void eval_vals(bf16 a, bf16 bz, const bf16* lr, float& g, float& kval, float& qval) const {
    if (MODE == 0) {
      uint4 u0 = *(const uint4*)(lr);
      uint4 u1 = *(const uint4*)(lr + 8);
      float z = bias;
      z += w[0] * __uint_as_float(u0.x << 16) + w[1] * __uint_as_float(u0.x & 0xffff0000u);
      z += w[2] * __uint_as_float(u0.y << 16) + w[3] * __uint_as_float(u0.y & 0xffff0000u);
      z += w[4] * __uint_as_float(u0.z << 16) + w[5] * __uint_as_float(u0.z & 0xffff0000u);
      z += w[6] * __uint_as_float(u0.w << 16) + w[7] * __uint_as_float(u0.w & 0xffff0000u);
      z += w[8] * __uint_as_float(u1.x << 16) + w[9] * __uint_as_float(u1.x & 0xffff0000u);
      z += w[10] * __uint_as_float(u1.y << 16) + w[11] * __uint_as_float(u1.y & 0xffff0000u);
      z += w[12] * __uint_as_float(u1.z << 16) + w[13] * __uint_as_float(u1.z & 0xffff0000u);
      z += w[14] * __uint_as_float(u1.w << 16) + w[15] * __uint_as_float(u1.w & 0xffff0000u);
      g = log_sigmoid_f(z) * (1.f / 16.f);
      kval = bf2f(bz);
      qval = bf2f(a) * 0.125f;
    } else {
      const float z = bf2f(bz);
      const float e = __expf(-z);
      const float sg = frcp(1.f + e);
      kval = (1.f - lb) * e * sg;
      g = 1.f - kval;
      qval = bf2f(a) * 0.08838834764831845f;
    }
  }
  __device__ __forceinline__ void eval(const bf16* row, float& g, float& kval, float& qval) const {
    if (MODE == 0) {
      uint4 u0 = *(const uint4*)(row + 3584 + d * 16);
      uint4 u1 = *(const uint4*)(row + 3584 + d * 16 + 8);
      float z = bias;
      z += w[0] * __uint_as_float(u0.x << 16) + w[1] * __uint_as_float(u0.x & 0xffff0000u);
      z += w[2] * __uint_as_float(u0.y << 16) + w[3] * __uint_as_float(u0.y & 0xffff0000u);
      z += w[4] * __uint_as_float(u0.z << 16) + w[5] * __uint_as_float(u0.z & 0xffff0000u);
      z += w[6] * __uint_as_float(u0.w << 16) + w[7] * __uint_as_float(u0.w & 0xffff0000u);
      z += w[8] * __uint_as_float(u1.x << 16) + w[9] * __uint_as_float(u1.x & 0xffff0000u);
      z += w[10] * __uint_as_float(u1.y << 16) + w[11] * __uint_as_float(u1.y & 0xffff0000u);
      z += w[12] * __uint_as_float(u1.z << 16) + w[13] * __uint_as_float(u1.z & 0xffff0000u);
      z += w[14] * __uint_as_float(u1.w << 16) + w[15] * __uint_as_float(u1.w & 0xffff0000u);
      g = log_sigmoid_f(z) * (1.f / 16.f);
      kval = bf2f(row[2304 + ch]);
      qval = bf2f(row[2048 + ch]) * 0.125f;
    } else {
      const float z = bf2f(row[512 + d * 512 + ch]);
      const float e = __expf(-z);
      const float sg = frcp(1.f + e);
      kval = (1.f - lb) * e * sg;
      g = flog(1.f - kval);
      qval = bf2f(row[ch]) * 0.08838834764831845f;
    }
  }
};

template <int MODE>
__device__ __forceinline__ void stage_vt(const bf16* proj, int h, bf16* VT) {
  constexpr int LDP = MODE == 0 ? EVEN_N : ODD_N;
  constexpr int VOFF = MODE == 0 ? 2560 : 1536;
  const int j = threadIdx.x & 63, cgp = threadIdx.x >> 6;
#pragma unroll
  for (int cc = 0; cc < 4; ++cc) {
    const int c = cgp * 4 + cc;
    uint4 u = *(const uint4*)(proj + (size_t)j * LDP + VOFF + h * 128 + c * 8);
    bf16* dst = VT + (c * 8) * 72 + j;
    dst[0 * 72] = (bf16)(u.x & 0xffffu); dst[1 * 72] = (bf16)(u.x >> 16);
    dst[2 * 72] = (bf16)(u.y & 0xffffu); dst[3 * 72] = (bf16)(u.y >> 16);
    dst[4 * 72] = (bf16)(u.z & 0xffffu); dst[5 * 72] = (bf16)(u.z >> 16);
    dst[6 * 72] = (bf16)(u.w & 0xffffu); dst[7 * 72] = (bf16)(u.w >> 16);
  }
}

__device__ __forceinline__ uint2 pack4(f32x4 a) {
  uint2 o;
  o.x = (unsigned)f2bf(a[0]) | ((unsigned)f2bf(a[1]) << 16);
  o.y = (unsigned)f2bf(a[2]) | ((unsigned)f2bf(a[3]) << 16);
  return o;
}

template <int K, int MODE>
__device__ __forceinline__ void rec_pass1_item(const P& p, int item, unsigned char* smem) {
  constexpr int LDP = MODE == 0 ? EVEN_N : ODD_N;
  const int h = item & 3, blk = (item >> 2) & 63, b = item >> 8;
  bf16* KT = (bf16*)smem;
  bf16* VT = KT + 2 * K * 72;
  const bf16* proj = (const bf16*)(p.ws + WS_PROJ) + (size_t)(b * 4096 + blk * 64) * LDP;
  bf16* ST = (bf16*)(p.ws + WS_ST);
  float* DEC = (float*)(p.ws + WS_DEC);
  const int tid = threadIdx.x, lane = tid & 63, wave = tid >> 6;
  bf16* TMP = VT;
  if (MODE == 1) {
#pragma unroll
    for (int i = 0; i < 8; ++i) {
      const int c = i * 256 + tid;
      const int ch = c & 15, j = (c >> 4) & 63, d = c >> 10;
      *(uint4*)(TMP + (d * 64 + j) * 128 + ch * 8) = *(const uint4*)(proj + (size_t)j * LDP + 512 + d * 512 + h * 128 + ch * 8);
    }
  } else {
#pragma unroll
    for (int i = 0; i < 2; ++i) {
      const int c = i * 256 + tid;
      const int ch = c & 7, j = c >> 3;
      *(uint4*)(TMP + j * 64 + ch * 8) = *(const uint4*)(proj + (size_t)j * LDP + 2304 + h * 64 + ch * 8);
    }
    {
      const int ch = tid & 3, j = tid >> 2;
      *(uint4*)(TMP + 4096 + j * 32 + ch * 8) = *(const uint4*)(proj + (size_t)j * LDP + 3584 + ch * 8);
    }
  }
  __syncthreads();
  if (tid < 2 * K) {
    const int d = tid / K, k = tid % K;
    GateC<K, MODE> gc;
    gc.init(p, d, h, k);
    bf16* row = KT + (d * K + k) * 72;
    float r = MODE == 1 ? 1.f : 0.f, rhi = r;
#pragma unroll 4
    for (int i = 63; i >= 0; --i) {
      const int j = d ? 63 - i : i;
      float g, kv, qv;
      if (MODE == 1) {
        gc.eval_vals(0, TMP[(d * 64 + j) * 128 + k], nullptr, g, kv, qv);
        row[j] = f2bf(kv * r);
        r *= g;
      } else {
        gc.eval_vals(0, TMP[j * 64 + k], TMP + 4096 + j * 32 + d * 16, g, kv, qv);
        row[j] = f2bf(kv * __expf(r));
        r += g;
      }
      if (i == 32) rhi = r;
    }
    DEC[(size_t)((((d * 4 + b) * 4 + h) * 64 + blk)) * K + k] = MODE == 1 ? r : __expf(r);
    ((float*)(p.ws + WS_CMID))[(size_t)((((d * 4 + b) * 4 + h) * 64 + blk)) * K + k] = MODE == 1 ? r * frcp(rhi) : __expf(r - rhi);
  }
  __syncthreads();
  stage_vt<MODE>(proj, h, VT);
  __syncthreads();
#pragma unroll 1
  for (int d = 0; d < 2; ++d) {
    f32x4 acc[K / 16][2];
#pragma unroll
    for (int kt = 0; kt < K / 16; ++kt) { acc[kt][0] = (f32x4){0.f, 0.f, 0.f, 0.f}; acc[kt][1] = (f32x4){0.f, 0.f, 0.f, 0.f}; }
#pragma unroll
    for (int ks = 0; ks < 2; ++ks) {
      bf16x8 vf0 = *(const bf16x8*)(VT + ((wave * 2 + 0) * 16 + (lane & 15)) * 72 + ks * 32 + (lane >> 4) * 8);
      bf16x8 vf1 = *(const bf16x8*)(VT + ((wave * 2 + 1) * 16 + (lane & 15)) * 72 + ks * 32 + (lane >> 4) * 8);
#pragma unroll
      for (int kt = 0; kt < K / 16; ++kt) {
        bf16x8 kf = *(const bf16x8*)(KT + (d * K + kt * 16 + (lane & 15)) * 72 + ks * 32 + (lane >> 4) * 8);
        acc[kt][0] = __builtin_amdgcn_mfma_f32_16x16x32_bf16(kf, vf0, acc[kt][0], 0, 0, 0);
        acc[kt][1] = __builtin_amdgcn_mfma_f32_16x16x32_bf16(kf, vf1, acc[kt][1], 0, 0, 0);
      }
    }
    bf16* stb = ST + (size_t)((((d * 4 + b) * 4 + h) * 64 + blk)) * 128 * K;
#pragma unroll
    for (int kt = 0; kt < K / 16; ++kt)
#pragma unroll
      for (int vv = 0; vv < 2; ++vv) {
        const int v = (wave * 2 + vv) * 16 + (lane & 15);
        const int k0 = kt * 16 + (lane >> 4) * 4;
        *(uint2*)(stb + (size_t)v * K + k0) = pack4(acc[kt][vv]);
      }
  }
}

template <int K>
__device__ __forceinline__ void phase_rec_scan(const P& p) {
  bf16* ST = (bf16*)(p.ws + WS_ST);
  const float* DEC = (const float*)(p.ws + WS_DEC);
  const float* CMID = (const float*)(p.ws + WS_CMID);
  constexpr int KV = K / 4;
  const int total = 32 * 128 * KV;
  for (int idx = blockIdx.x * 256 + threadIdx.x; idx < total; idx += gridDim.x * 256) {
    const int kq = idx % KV, v = (idx / KV) & 127, s = idx / (KV * 128);
    const int d = s >> 4;
    float st0 = 0.f, st1 = 0.f, st2 = 0.f, st3 = 0.f;
#pragma unroll 1
    for (int n0 = 0; n0 < 64; n0 += 8) {
      uint2 u[8];
      float4 dc[8], cm[8];
#pragma unroll
      for (int q = 0; q < 8; ++q) {
        const int blk = d ? 63 - (n0 + q) : (n0 + q);
        u[q] = *(const uint2*)(ST + ((size_t)(s * 64 + blk) * 128 + v) * K + kq * 4);
        dc[q] = *(const float4*)(DEC + (size_t)(s * 64 + blk) * K + kq * 4);
        cm[q] = *(const float4*)(CMID + (size_t)(s * 64 + blk) * K + kq * 4);
      }
#pragma unroll
      for (int q = 0; q < 8; ++q) {
        const int blk = d ? 63 - (n0 + q) : (n0 + q);
        uint2 o;
        o.x = (unsigned)f2bf(st0 * cm[q].x) | ((unsigned)f2bf(st1 * cm[q].y) << 16);
        o.y = (unsigned)f2bf(st2 * cm[q].z) | ((unsigned)f2bf(st3 * cm[q].w) << 16);
        *(uint2*)(ST + ((size_t)(s * 64 + blk) * 128 + v) * K + kq * 4) = o;
        st0 = dc[q].x * st0 + __uint_as_float(u[q].x << 16);
        st1 = dc[q].y * st1 + __uint_as_float(u[q].x & 0xffff0000u);
        st2 = dc[q].z * st2 + __uint_as_float(u[q].y << 16);
        st3 = dc[q].w * st3 + __uint_as_float(u[q].y & 0xffff0000u);
      }
    }
  }
}

template <int K, int MODE>
__device__ __forceinline__ void rec_pass3_item(const P& p, int item, unsigned char* smem) {
  constexpr int LDP = MODE == 0 ? EVEN_N : ODD_N;
  constexpr int KS = K + 8;
  constexpr int GOFF = MODE == 0 ? 3072 : 2048;
  constexpr int YOFF = MODE == 0 ? 512 : 0;
  const int h = item & 3, blk = (item >> 2) & 63, b = item >> 8;
  bf16* QI = (bf16*)smem;
  bf16* KI = QI + 64 * KS;
  bf16* VT = KI + 64 * KS;
  bf16* AI = VT + 128 * 72;
  float* CV = (float*)(AI + 64 * 72);
  float* SSQ = CV + K;
  bf16* LRB = (bf16*)(SSQ + 256);
  const bf16* proj = (const bf16*)(p.ws + WS_PROJ) + (size_t)(b * 4096 + blk * 64) * LDP;
  const bf16* ST = (const bf16*)(p.ws + WS_ST);
  bf16* yb = (bf16*)(p.ws + WS_H);
  const int tid = threadIdx.x, lane = tid & 63, wave = tid >> 6;
  constexpr int VOFF = MODE == 0 ? 2560 : 1536;
  constexpr int QOFF = MODE == 0 ? 2048 : 0;
  constexpr int NQ = K / 32;
  u32x4 rvt[4], rq[4], rz[2][4], rlr[2], stf[2][4][2];
  {
    const int j = tid & 63, cgp = tid >> 6;
#pragma unroll
    for (int cc = 0; cc < 4; ++cc) rvt[cc] = gload16_asm(proj + (size_t)j * LDP + VOFF + h * 128 + (cgp * 4 + cc) * 8);
  }
#pragma unroll
  for (int i = 0; i < NQ; ++i) {
    const int c = i * 256 + tid, ch = c % (K / 8), j = c / (K / 8);
    rq[i] = gload16_asm(proj + (size_t)j * LDP + QOFF + h * K + ch * 8);
    rz[0][i] = gload16_asm(proj + (size_t)j * LDP + (MODE == 0 ? 2304 : 512) + h * K + ch * 8);
  }
  if (MODE == 0) {
    const int ch = tid & 1, j = (tid >> 1) & 63;
    rlr[0] = gload16_asm(proj + (size_t)j * LDP + 3584 + ch * 8);
    rlr[1] = gload16_asm(proj + (size_t)j * LDP + 3600 + ch * 8);
  }
  {
    const bf16* stb = ST + (size_t)((((0 * 4 + b) * 4 + h) * 64 + blk)) * 128 * K;
#pragma unroll
    for (int ks = 0; ks < NQ; ++ks)
#pragma unroll
      for (int vv = 0; vv < 2; ++vv)
        stf[0][ks][vv] = gload16_asm(stb + (size_t)((wave * 2 + vv) * 16 + (lane & 15)) * K + ks * 32 + (lane >> 4) * 8);
  }
  if (MODE == 1) {
    asm volatile("s_waitcnt vmcnt(8)"
                 : "+v"(rvt[0]), "+v"(rvt[1]), "+v"(rvt[2]), "+v"(rvt[3]), "+v"(rq[0]), "+v"(rq[1]), "+v"(rq[2]), "+v"(rq[3]),
                   "+v"(rz[0][0]), "+v"(rz[0][1]), "+v"(rz[0][2]), "+v"(rz[0][3])
                 :: "memory");
  } else {
    asm volatile("s_waitcnt vmcnt(4)"
                 : "+v"(rvt[0]), "+v"(rvt[1]), "+v"(rvt[2]), "+v"(rvt[3]), "+v"(rq[0]), "+v"(rq[1]), "+v"(rz[0][0]), "+v"(rz[0][1]), "+v"(rlr[0]), "+v"(rlr[1])
                 :: "memory");
  }
  {
    const int j = tid & 63, cgp = tid >> 6;
#pragma unroll
    for (int cc = 0; cc < 4; ++cc) {
      const u32x4 u = rvt[cc];
      bf16* dst = VT + ((cgp * 4 + cc) * 8) * 72 + j;
      dst[0 * 72] = (bf16)(u[0] & 0xffffu); dst[1 * 72] = (bf16)(u[0] >> 16);
      dst[2 * 72] = (bf16)(u[1] & 0xffffu); dst[3 * 72] = (bf16)(u[1] >> 16);
      dst[4 * 72] = (bf16)(u[2] & 0xffffu); dst[5 * 72] = (bf16)(u[2] >> 16);
      dst[6 * 72] = (bf16)(u[3] & 0xffffu); dst[7 * 72] = (bf16)(u[3] >> 16);
    }
  }
  f32x4 o[2][4];
#pragma unroll
  for (int vv = 0; vv < 2; ++vv)
#pragma unroll
    for (int it = 0; it < 4; ++it) o[vv][it] = (f32x4){0.f, 0.f, 0.f, 0.f};
#pragma unroll
  for (int d = 0; d < 2; ++d) {
    if (d) __syncthreads();
    if (MODE == 1 && d == 1) {
      asm volatile("s_waitcnt vmcnt(0)" : "+v"(rz[1][0]), "+v"(rz[1][1]), "+v"(rz[1][2]), "+v"(rz[1][3]) :: "memory");
    }
#pragma unroll
    for (int i = 0; i < NQ; ++i) {
      const int c = i * 256 + tid, ch = c % (K / 8), j = c / (K / 8);
      *(u32x4*)(QI + j * KS + ch * 8) = rq[i];
      *(u32x4*)(KI + j * KS + ch * 8) = rz[MODE == 1 ? d : 0][i];
    }
    if (d == 1) {
      const bf16* stb = ST + (size_t)((((1 * 4 + b) * 4 + h) * 64 + blk)) * 128 * K;
#pragma unroll
      for (int ks = 0; ks < NQ; ++ks)
#pragma unroll
        for (int vv = 0; vv < 2; ++vv)
          stf[1][ks][vv] = gload16_asm(stb + (size_t)((wave * 2 + vv) * 16 + (lane & 15)) * K + ks * 32 + (lane >> 4) * 8);
    }
    if (MODE == 1 && d == 0) {
#pragma unroll
      for (int i = 0; i < NQ; ++i) {
        const int c = i * 256 + tid, ch = c % (K / 8), j = c / (K / 8);
        rz[1][i] = gload16_asm(proj + (size_t)j * LDP + 1024 + h * K + ch * 8);
      }
    }
    if (MODE == 0 && tid < 128) {
      const int ch = tid & 1, j = tid >> 1;
      *(u32x4*)(LRB + j * 16 + ch * 8) = rlr[d];
    }
    __syncthreads();
    if (tid < 2 * K) {
      const int k = tid % K, half = tid / K;
      GateC<K, MODE> gc;
      gc.init(p, d, h, k);
      float run = MODE == 1 ? 1.f : 0.f;
      if (half) {
#pragma unroll 4
        for (int i = 32; i < 64; ++i) {
          const int j = d ? 63 - i : i;
          float g, kv, qv;
          gc.eval_vals(QI[j * KS + k], KI[j * KS + k], LRB + j * 16, g, kv, qv);
          if (MODE == 1) {
            run *= g;
            QI[j * KS + k] = f2bf(qv * run);
            KI[j * KS + k] = f2bf(kv * frcp(run));
          } else {
            run += g;
            QI[j * KS + k] = f2bf(qv * __expf(run));
            KI[j * KS + k] = f2bf(kv * __expf(-run));
          }
        }
      } else {
#pragma unroll 4
        for (int i = 31; i >= 0; --i) {
          const int j = d ? 63 - i : i;
          float g, kv, qv;
          gc.eval_vals(QI[j * KS + k], KI[j * KS + k], LRB + j * 16, g, kv, qv);
          if (MODE == 1) {
            QI[j * KS + k] = f2bf(qv * frcp(run));
            KI[j * KS + k] = f2bf(kv * run);
            run *= g;
          } else {
            QI[j * KS + k] = f2bf(qv * __expf(-run));
            KI[j * KS + k] = f2bf(kv * __expf(run));
            run += g;
          }
        }
        CV[k] = MODE == 1 ? run : __expf(run);
      }
    }
    __syncthreads();
    {
      f32x4 a[4];
#pragma unroll
      for (int jt = 0; jt < 4; ++jt) a[jt] = (f32x4){0.f, 0.f, 0.f, 0.f};
#pragma unroll
      for (int ks = 0; ks < K / 32; ++ks) {
        bf16x8 qf = *(const bf16x8*)(QI + (wave * 16 + (lane & 15)) * KS + ks * 32 + (lane >> 4) * 8);
#pragma unroll
        for (int jt = 0; jt < 4; ++jt) {
          bf16x8 kf = *(const bf16x8*)(KI + (jt * 16 + (lane & 15)) * KS + ks * 32 + (lane >> 4) * 8);
          a[jt] = __builtin_amdgcn_mfma_f32_16x16x32_bf16(kf, qf, a[jt], 0, 0, 0);
        }
      }
      const int i = wave * 16 + (lane & 15);
#pragma unroll
      for (int jt = 0; jt < 4; ++jt) {
        const int j0 = jt * 16 + (lane >> 4) * 4;
        f32x4 m;
#pragma unroll
        for (int r = 0; r < 4; ++r) {
          const int j = j0 + r;
          const bool valid = d ? (j >= i) : (j <= i);
          m[r] = valid ? a[jt][r] : 0.f;
        }
        *(uint2*)(AI + i * 72 + j0) = pack4(m);
      }
    }
    __syncthreads();
#pragma unroll
    for (int ks = 0; ks < 2; ++ks) {
      bf16x8 vf0 = *(const bf16x8*)(VT + ((wave * 2 + 0) * 16 + (lane & 15)) * 72 + ks * 32 + (lane >> 4) * 8);
      bf16x8 vf1 = *(const bf16x8*)(VT + ((wave * 2 + 1) * 16 + (lane & 15)) * 72 + ks * 32 + (lane >> 4) * 8);
#pragma unroll
      for (int it = 0; it < 4; ++it) {
        bf16x8 af = *(const bf16x8*)(AI + (it * 16 + (lane & 15)) * 72 + ks * 32 + (lane >> 4) * 8);
        o[0][it] = __builtin_amdgcn_mfma_f32_16x16x32_bf16(vf0, af, o[0][it], 0, 0, 0);
        o[1][it] = __builtin_amdgcn_mfma_f32_16x16x32_bf16(vf1, af, o[1][it], 0, 0, 0);
      }
    }
    if (d == 0) {
      if (K == 128) {
        asm volatile("s_waitcnt vmcnt(4)"
                     : "+v"(stf[0][0][0]), "+v"(stf[0][0][1]), "+v"(stf[0][1][0]), "+v"(stf[0][1][1]), "+v"(stf[0][2][0]), "+v"(stf[0][2][1]), "+v"(stf[0][3][0]), "+v"(stf[0][3][1])
                     :: "memory");
      } else {
        asm volatile("s_waitcnt vmcnt(0)" : "+v"(stf[0][0][0]), "+v"(stf[0][0][1]), "+v"(stf[0][1][0]), "+v"(stf[0][1][1]) :: "memory");
      }
    } else {
      if (K == 128) {
        asm volatile("s_waitcnt vmcnt(0)"
                     : "+v"(stf[1][0][0]), "+v"(stf[1][0][1]), "+v"(stf[1][1][0]), "+v"(stf[1][1][1]), "+v"(stf[1][2][0]), "+v"(stf[1][2][1]), "+v"(stf[1][3][0]), "+v"(stf[1][3][1])
                     :: "memory");
      } else {
        asm volatile("s_waitcnt vmcnt(0)" : "+v"(stf[1][0][0]), "+v"(stf[1][0][1]), "+v"(stf[1][1][0]), "+v"(stf[1][1][1]) :: "memory");
      }
    }
#pragma unroll
    for (int ks = 0; ks < K / 32; ++ks) {
      const int kk = ks * 32 + (lane >> 4) * 8;
      bf16x8 sf[2];
      sf[0] = *(bf16x8*)&stf[d][ks][0];
      sf[1] = *(bf16x8*)&stf[d][ks][1];
#pragma unroll
      for (int it = 0; it < 4; ++it) {
        bf16x8 qf = *(const bf16x8*)(QI + (it * 16 + (lane & 15)) * KS + kk);
        o[0][it] = __builtin_amdgcn_mfma_f32_16x16x32_bf16(sf[0], qf, o[0][it], 0, 0, 0);
        o[1][it] = __builtin_amdgcn_mfma_f32_16x16x32_bf16(sf[1], qf, o[1][it], 0, 0, 0);
      }
    }
  }
  {
    float ss[4];
#pragma unroll
    for (int it = 0; it < 4; ++it) {
      float s = 0.f;
#pragma unroll
      for (int vv = 0; vv < 2; ++vv)
#pragma unroll
        for (int r = 0; r < 4; ++r) s += o[vv][it][r] * o[vv][it][r];
      s += __shfl_xor(s, 16, 64);
      s += __shfl_xor(s, 32, 64);
      ss[it] = s;
    }
    if (lane < 16) {
#pragma unroll
      for (int it = 0; it < 4; ++it) SSQ[wave * 64 + it * 16 + lane] = ss[it];
    }
    __syncthreads();
    const float* gn = MODE == 0 ? p.gla_g : p.hgrn_g;
#pragma unroll
    for (int it = 0; it < 4; ++it) {
      const int i = it * 16 + (lane & 15);
      const float tot = SSQ[i] + SSQ[64 + i] + SSQ[128 + i] + SSQ[192 + i];
      const float rs = rsqrtf(tot * (1.f / 128.f) + 1e-6f);
#pragma unroll
      for (int vv = 0; vv < 2; ++vv) {
        const int v0 = (wave * 2 + vv) * 16 + (lane >> 4) * 4;
        uint2 gu = *(const uint2*)(proj + (size_t)i * LDP + GOFF + h * 128 + v0);
        float4 gg = *(const float4*)(gn + v0);
        f32x4 y;
        y[0] = o[vv][it][0] * rs * gg.x * silu_f(__uint_as_float(gu.x << 16));
        y[1] = o[vv][it][1] * rs * gg.y * silu_f(__uint_as_float(gu.x & 0xffff0000u));
        y[2] = o[vv][it][2] * rs * gg.z * silu_f(__uint_as_float(gu.y << 16));
        y[3] = o[vv][it][3] * rs * gg.w * silu_f(__uint_as_float(gu.y & 0xffff0000u));
        if (MODE == 1) *(uint2*)((bf16*)proj + (size_t)i * LDP + GOFF + h * 128 + v0) = pack4(y);
        else *(uint2*)(yb + (size_t)(b * 4096 + blk * 64 + i) * 1024 + YOFF + h * 128 + v0) = pack4(y);
      }
    }
  }
}

__device__ __forceinline__ void conv8(const P& p, const bf16* projb, int t, int c0, float* o8) {
  c0 = __builtin_amdgcn_readfirstlane(c0);
  float4 b0 = *(const float4*)(p.conv_b + c0), b1 = *(const float4*)(p.conv_b + c0 + 4);
  float a[8] = {b0.x, b0.y, b0.z, b0.w, b1.x, b1.y, b1.z, b1.w};
#pragma unroll
  for (int jt = 0; jt < 4; ++jt) {
    const int tt = t + jt - 2;
    if (tt >= 0 && tt < 4096) {
      uint4 u = *(const uint4*)(projb + (size_t)tt * ODD_N + 3072 + c0);
      float4 w0 = *(const float4*)(p.conv_w + jt * 1024 + c0), w1 = *(const float4*)(p.conv_w + jt * 1024 + c0 + 4);
      a[0] += w0.x * __uint_as_float(u.x << 16); a[1] += w0.y * __uint_as_float(u.x & 0xffff0000u);
      a[2] += w0.z * __uint_as_float(u.y << 16); a[3] += w0.w * __uint_as_float(u.y & 0xffff0000u);
      a[4] += w1.x * __uint_as_float(u.z << 16); a[5] += w1.y * __uint_as_float(u.z & 0xffff0000u);
      a[6] += w1.z * __uint_as_float(u.w << 16); a[7] += w1.w * __uint_as_float(u.w & 0xffff0000u);
    }
  }
#pragma unroll
  for (int e = 0; e < 8; ++e) o8[e] = silu_f(a[e]);
}

__device__ __forceinline__ void conv8u(const P& p, const bf16* projb, int t, int c0, float* o8) {
  c0 = __builtin_amdgcn_readfirstlane(c0);
  float4 b0 = *(const float4*)(p.conv_b + c0), b1 = *(const float4*)(p.conv_b + c0 + 4);
  float a[8] = {b0.x, b0.y, b0.z, b0.w, b1.x, b1.y, b1.z, b1.w};
  uint4 u[4];
#pragma unroll
  for (int jt = 0; jt < 4; ++jt) {
    int tt = t + jt - 2;
    tt = tt < 0 ? 0 : (tt > 4095 ? 4095 : tt);
    u[jt] = *(const uint4*)(projb + (size_t)tt * ODD_N + 3072 + c0);
  }
#pragma unroll
  for (int jt = 0; jt < 4; ++jt) {
    const int tt = t + jt - 2;
    const float ok = (tt >= 0 && tt < 4096) ? 1.f : 0.f;
    float4 w0 = *(const float4*)(p.conv_w + jt * 1024 + c0), w1 = *(const float4*)(p.conv_w + jt * 1024 + c0 + 4);
    a[0] += ok * w0.x * __uint_as_float(u[jt].x << 16); a[1] += ok * w0.y * __uint_as_float(u[jt].x & 0xffff0000u);
    a[2] += ok * w0.z * __uint_as_float(u[jt].y << 16); a[3] += ok * w0.w * __uint_as_float(u[jt].y & 0xffff0000u);
    a[4] += ok * w1.x * __uint_as_float(u[jt].z << 16); a[5] += ok * w1.y * __uint_as_float(u[jt].z & 0xffff0000u);
    a[6] += ok * w1.z * __uint_as_float(u[jt].w << 16); a[7] += ok * w1.w * __uint_as_float(u[jt].w & 0xffff0000u);
  }
#pragma unroll
  for (int e = 0; e < 8; ++e) o8[e] = silu_f(a[e]);
}

__device__ __forceinline__ void ssd_prep_acum(const P& p, const bf16* projb, int blk, int g, float* ACUM, float* DTV, float* TOT) {
  const int lane = threadIdx.x & 63, wave = threadIdx.x >> 6;
#pragma unroll
  for (int q = 0; q < 2; ++q) {
    const int c = wave * 2 + q, dir = c >> 2, rp = c & 3, head = g * 4 + rp;
    const int j = dir ? 63 - lane : lane;
    const int t = blk * 64 + j;
    const float dt = softplus_f(bf2f(projb[(size_t)t * ODD_N + 4096 + dir * 8 + head]) + p.dt_bias[dir * 8 + head]);
    float v = -__expf(p.a_log[dir * 8 + head]) * dt;
#pragma unroll
    for (int off = 1; off < 64; off <<= 1) {
      float tmp = __shfl_up(v, off, 64);
      if (lane >= off) v += tmp;
    }
    ACUM[c * 64 + j] = v;
    DTV[c * 64 + j] = dt;
    if (lane == 63) TOT[c] = v;
  }
}

__device__ __forceinline__ bf16* ssd_st(const P& p, int s) {
  return s < 32 ? (bf16*)(p.ws + WS_H) + (size_t)s * 524288 : (bf16*)((unsigned char*)p.out + 33554432) + (size_t)(s - 32) * 524288;
}
__device__ __forceinline__ void ssd_pass1_item(const P& p, int item, unsigned char* smem) {
  const int g = item & 1, blk = (item >> 1) & 63, b = item >> 7;
  bf16* BT = (bf16*)smem;
  bf16* XT = BT + 128 * 72;
  float* ACUM = (float*)(XT + 256 * 72);
  float* DTV = ACUM + 512;
  float* TOT = DTV + 512;
  const bf16* projb = (const bf16*)(p.ws + WS_PROJ) + (size_t)b * 4096 * ODD_N;
  float* DEC = (float*)(p.ws + WS_DECS);
  const int tid = threadIdx.x, lane = tid & 63, wave = tid >> 6;
  const int t = blk * 64 + lane;
  ssd_prep_acum(p, projb, blk, g, ACUM, DTV, TOT);
#pragma unroll 2
  for (int q = 0; q < 4; ++q) {
    const int cc = wave + 4 * q;
    float v8[8];
    conv8(p, projb, t, 512 + g * 128 + cc * 8, v8);
#pragma unroll
    for (int e = 0; e < 8; ++e) BT[(cc * 8 + e) * 72 + lane] = f2bf(v8[e]);
  }
  float xs[8][8];
#pragma unroll
  for (int q = 0; q < 8; ++q) conv8(p, projb, t, g * 256 + (wave * 8 + q) * 8, xs[q]);
  __syncthreads();
  if (tid < 8) {
    const int dir = tid >> 2, head = g * 4 + (tid & 3);
    DEC[(size_t)((dir * 4 + b) * 8 + head) * 64 + blk] = __expf(TOT[tid]);
  }
#pragma unroll 1
  for (int dir = 0; dir < 2; ++dir) {
    if (dir) __syncthreads();
    const int c = dir * 4 + wave;
    const float fac = DTV[c * 64 + lane] * __expf(TOT[c] - ACUM[c * 64 + lane]);
#pragma unroll
    for (int q = 0; q < 8; ++q)
#pragma unroll
      for (int e = 0; e < 8; ++e) XT[((wave * 8 + q) * 8 + e) * 72 + lane] = f2bf(xs[q][e] * fac);
    __syncthreads();
    const int head = g * 4 + wave;
    bf16* stb = ssd_st(p, (dir * 4 + b) * 8 + head) + (size_t)blk * 8192;
#pragma unroll 1
    for (int nh = 0; nh < 4; ++nh) {
      f32x4 acc[2][4];
#pragma unroll
      for (int nt = 0; nt < 2; ++nt)
#pragma unroll
        for (int pt = 0; pt < 4; ++pt) acc[nt][pt] = (f32x4){0.f, 0.f, 0.f, 0.f};
#pragma unroll
      for (int ks = 0; ks < 2; ++ks) {
        bf16x8 xf[4];
#pragma unroll
        for (int pt = 0; pt < 4; ++pt) xf[pt] = *(const bf16x8*)(XT + (wave * 64 + pt * 16 + (lane & 15)) * 72 + ks * 32 + (lane >> 4) * 8);
#pragma unroll
        for (int nt = 0; nt < 2; ++nt) {
          bf16x8 bfv = *(const bf16x8*)(BT + ((nh * 2 + nt) * 16 + (lane & 15)) * 72 + ks * 32 + (lane >> 4) * 8);
#pragma unroll
          for (int pt = 0; pt < 4; ++pt) acc[nt][pt] = __builtin_amdgcn_mfma_f32_16x16x32_bf16(bfv, xf[pt], acc[nt][pt], 0, 0, 0);
        }
      }
#pragma unroll
      for (int nt = 0; nt < 2; ++nt)
#pragma unroll
        for (int pt = 0; pt < 4; ++pt) {
          const int pp = pt * 16 + (lane & 15);
          const int n0 = (nh * 2 + nt) * 16 + (lane >> 4) * 4;
          *(uint2*)(stb + (size_t)pp * 128 + n0) = pack4(acc[nt][pt]);
        }
    }
  }
}

__device__ __forceinline__ void phase_ssd_scan(const P& p) {
  const float* DEC = (const float*)(p.ws + WS_DECS);
  const int total = 64 * 2048;
  for (int idx = blockIdx.x * 256 + threadIdx.x; idx < total; idx += gridDim.x * 256) {
    const int e4 = idx & 2047, s = idx >> 11;
    const int d = s >> 5;
    bf16* ST = ssd_st(p, s);
    float st0 = 0.f, st1 = 0.f, st2 = 0.f, st3 = 0.f;
#pragma unroll 1
    for (int n0 = 0; n0 < 64; n0 += 8) {
      uint2 u[8];
      float dc[8];
#pragma unroll
      for (int q = 0; q < 8; ++q) {
        const int blk = d ? 63 - (n0 + q) : (n0 + q);
        u[q] = *(const uint2*)(ST + (size_t)blk * 8192 + e4 * 4);
        dc[q] = DEC[s * 64 + blk];
      }
#pragma unroll
      for (int q = 0; q < 8; ++q) {
        const int blk = d ? 63 - (n0 + q) : (n0 + q);
        uint2 o;
        o.x = (unsigned)f2bf(st0) | ((unsigned)f2bf(st1) << 16);
        o.y = (unsigned)f2bf(st2) | ((unsigned)f2bf(st3) << 16);
        *(uint2*)(ST + (size_t)blk * 8192 + e4 * 4) = o;
        st0 = dc[q] * st0 + __uint_as_float(u[q].x << 16);
        st1 = dc[q] * st1 + __uint_as_float(u[q].x & 0xffff0000u);
        st2 = dc[q] * st2 + __uint_as_float(u[q].y << 16);
        st3 = dc[q] * st3 + __uint_as_float(u[q].y & 0xffff0000u);
      }
    }
  }
}

__device__ __forceinline__ void ssd_pass3_item(const P& p, int item, unsigned char* smem) {
  const int g = item & 1, blk = (item >> 1) & 63, b = item >> 7;
  bf16* CI = (bf16*)smem;
  bf16* BI = CI + 64 * 136;
  bf16* AI = BI;
  bf16* XT = BI + 64 * 136;
  float* ACUM = (float*)(XT + 64 * 72);
  float* DTV = ACUM + 512;
  float* TOT = DTV + 512;
  float* SSQ = TOT + 8;
  bf16* projb = (bf16*)(p.ws + WS_PROJ) + (size_t)b * 4096 * ODD_N;
  const int tid = threadIdx.x, lane = tid & 63, wave = tid >> 6;
  const int t = blk * 64 + lane;
  ssd_prep_acum(p, projb, blk, g, ACUM, DTV, TOT);
#pragma unroll 4
  for (int q = 0; q < 8; ++q) {
    const int cc = wave * 8 + q, which = cc >> 4, ch = (cc & 15) * 8;
    float v8[8];
    conv8u(p, projb, t, 512 + which * 256 + g * 128 + ch, v8);
    uint4 w;
    w.x = (unsigned)f2bf(v8[0]) | ((unsigned)f2bf(v8[1]) << 16);
    w.y = (unsigned)f2bf(v8[2]) | ((unsigned)f2bf(v8[3]) << 16);
    w.z = (unsigned)f2bf(v8[4]) | ((unsigned)f2bf(v8[5]) << 16);
    w.w = (unsigned)f2bf(v8[6]) | ((unsigned)f2bf(v8[7]) << 16);
    *(uint4*)((which ? CI : BI) + lane * 136 + ch) = w;
  }
  __syncthreads();
  f32x4 gt[4];
#pragma unroll
  for (int jt = 0; jt < 4; ++jt) gt[jt] = (f32x4){0.f, 0.f, 0.f, 0.f};
#pragma unroll
  for (int ks = 0; ks < 4; ++ks) {
    bf16x8 cf = *(const bf16x8*)(CI + (wave * 16 + (lane & 15)) * 136 + ks * 32 + (lane >> 4) * 8);
#pragma unroll
    for (int jt = 0; jt < 4; ++jt) {
      bf16x8 bfv = *(const bf16x8*)(BI + (jt * 16 + (lane & 15)) * 136 + ks * 32 + (lane >> 4) * 8);
      gt[jt] = __builtin_amdgcn_mfma_f32_16x16x32_bf16(bfv, cf, gt[jt], 0, 0, 0);
    }
  }
  __syncthreads();
  float ssq_acc[4] = {0.f, 0.f, 0.f, 0.f};
#pragma unroll 1
  for (int rp = 0; rp < 4; ++rp) {
    const int head = g * 4 + rp;
    u32x4 stf[2][4];
    u32x2 zur[4];
#pragma unroll
    for (int dir = 0; dir < 2; ++dir) {
      const bf16* stb = ssd_st(p, (dir * 4 + b) * 8 + head) + (size_t)blk * 8192;
#pragma unroll
      for (int ks = 0; ks < 4; ++ks) stf[dir][ks] = gload16_asm(stb + (size_t)(wave * 16 + (lane & 15)) * 128 + ks * 32 + (lane >> 4) * 8);
    }
#pragma unroll
    for (int it = 0; it < 4; ++it)
      zur[it] = gload8_asm(projb + (size_t)(blk * 64 + it * 16 + (lane & 15)) * ODD_N + 2560 + head * 64 + wave * 16 + (lane >> 4) * 4);
#pragma unroll 2
    for (int q = 0; q < 2; ++q) {
      const int cc = wave * 2 + q;
      float v8[8];
      conv8u(p, projb, t, head * 64 + cc * 8, v8);
#pragma unroll
      for (int e = 0; e < 8; ++e) XT[(cc * 8 + e) * 72 + lane] = f2bf(v8[e]);
    }
    f32x4 o[4];
#pragma unroll
    for (int it = 0; it < 4; ++it) o[it] = (f32x4){0.f, 0.f, 0.f, 0.f};
#pragma unroll
    for (int dir = 0; dir < 2; ++dir) {
      const int c = dir * 4 + rp;
      {
        const int i = wave * 16 + (lane & 15);
        const float aci = ACUM[c * 64 + i];
#pragma unroll
        for (int jt = 0; jt < 4; ++jt) {
          const int j0 = jt * 16 + (lane >> 4) * 4;
          f32x4 m;
#pragma unroll
          for (int r = 0; r < 4; ++r) {
            const int j = j0 + r;
            const bool valid = dir ? (j >= i) : (j <= i);
            const float arg = fminf(aci - ACUM[c * 64 + j], 0.f);
            m[r] = valid ? gt[jt][r] * __expf(arg) * DTV[c * 64 + j] : 0.f;
          }
          *(uint2*)(AI + i * 72 + j0) = pack4(m);
        }
      }
      __syncthreads();
#pragma unroll
      for (int ks = 0; ks < 2; ++ks) {
        bf16x8 xf = *(const bf16x8*)(XT + (wave * 16 + (lane & 15)) * 72 + ks * 32 + (lane >> 4) * 8);
#pragma unroll
        for (int it = 0; it < 4; ++it) {
          bf16x8 af = *(const bf16x8*)(AI + (it * 16 + (lane & 15)) * 72 + ks * 32 + (lane >> 4) * 8);
          o[it] = __builtin_amdgcn_mfma_f32_16x16x32_bf16(xf, af, o[it], 0, 0, 0);
        }
      }
      f32x4 tI[4];
#pragma unroll
      for (int it = 0; it < 4; ++it) tI[it] = (f32x4){0.f, 0.f, 0.f, 0.f};
      asm volatile("s_waitcnt vmcnt(0)" : "+v"(stf[dir][0]), "+v"(stf[dir][1]), "+v"(stf[dir][2]), "+v"(stf[dir][3]) :: "memory");
#pragma unroll
      for (int ks = 0; ks < 4; ++ks) {
        bf16x8 sf = *(bf16x8*)&stf[dir][ks];
#pragma unroll
        for (int it = 0; it < 4; ++it) {
          bf16x8 cf = *(const bf16x8*)(CI + (it * 16 + (lane & 15)) * 136 + ks * 32 + (lane >> 4) * 8);
          tI[it] = __builtin_amdgcn_mfma_f32_16x16x32_bf16(sf, cf, tI[it], 0, 0, 0);
        }
      }
#pragma unroll
      for (int it = 0; it < 4; ++it) {
        const float ea = __expf(ACUM[c * 64 + it * 16 + (lane & 15)]);
#pragma unroll
        for (int r = 0; r < 4; ++r) o[it][r] += ea * tI[it][r];
      }
      __syncthreads();
    }
    {
      asm volatile("s_waitcnt vmcnt(0)" : "+v"(zur[0]), "+v"(zur[1]), "+v"(zur[2]), "+v"(zur[3]) :: "memory");
      const float dsk = p.d_skip[head];
      const int p0 = wave * 16 + (lane >> 4) * 4;
      float4 gg = *(const float4*)(p.ssm_g + head * 64 + p0);
#pragma unroll
      for (int it = 0; it < 4; ++it) {
        const int i = it * 16 + (lane & 15);
        uint2 zu; zu.x = zur[it][0]; zu.y = zur[it][1];
        f32x4 y;
        y[0] = (o[it][0] + dsk * bf2f(XT[(p0 + 0) * 72 + i])) * silu_f(__uint_as_float(zu.x << 16));
        y[1] = (o[it][1] + dsk * bf2f(XT[(p0 + 1) * 72 + i])) * silu_f(__uint_as_float(zu.x & 0xffff0000u));
        y[2] = (o[it][2] + dsk * bf2f(XT[(p0 + 2) * 72 + i])) * silu_f(__uint_as_float(zu.y << 16));
        y[3] = (o[it][3] + dsk * bf2f(XT[(p0 + 3) * 72 + i])) * silu_f(__uint_as_float(zu.y & 0xffff0000u));
        ssq_acc[it] += y[0] * y[0] + y[1] * y[1] + y[2] * y[2] + y[3] * y[3];
        y[0] *= gg.x; y[1] *= gg.y; y[2] *= gg.z; y[3] *= gg.w;
        *(uint2*)(projb + (size_t)(blk * 64 + i) * ODD_N + 2560 + head * 64 + p0) = pack4(y);
      }
    }
    __syncthreads();
  }
#pragma unroll
  for (int it = 0; it < 4; ++it) {
    float s = ssq_acc[it];
    s += __shfl_xor(s, 16, 64);
    s += __shfl_xor(s, 32, 64);
    if (lane < 16) SSQ[wave * 64 + it * 16 + lane] = s;
  }
  __syncthreads();
  if (tid < 64) {
    float* ssqp = (float*)(p.ws + WS_SSQ);
    ssqp[(size_t)g * M_TOK + (size_t)b * 4096 + blk * 64 + tid] = SSQ[tid] + SSQ[64 + tid] + SSQ[128 + tid] + SSQ[192 + tid];
  }
}

__device__ __forceinline__ void phase_ssd_norm(const P& p) {
  const float* ssqp = (const float*)(p.ws + WS_SSQ);
  bf16* yb = (bf16*)(p.ws + WS_H);
  const int total = M_TOK * 64;
  for (int idx = blockIdx.x * 256 + threadIdx.x; idx < total; idx += gridDim.x * 256) {
    const int tok = idx >> 6, c8 = (idx & 63) * 8;
    const float rs = rsqrtf((ssqp[tok] + ssqp[M_TOK + tok]) * (1.f / 512.f) + 1e-6f);
    uint4* ptr = (uint4*)(yb + (size_t)tok * 1024 + 512 + c8);
    uint4 u = *ptr, w;
    w.x = (unsigned)f2bf(__uint_as_float(u.x << 16) * rs) | ((unsigned)f2bf(__uint_as_float(u.x & 0xffff0000u) * rs) << 16);
    w.y = (unsigned)f2bf(__uint_as_float(u.y << 16) * rs) | ((unsigned)f2bf(__uint_as_float(u.y & 0xffff0000u) * rs) << 16);
    w.z = (unsigned)f2bf(__uint_as_float(u.z << 16) * rs) | ((unsigned)f2bf(__uint_as_float(u.z & 0xffff0000u) * rs) << 16);
    w.w = (unsigned)f2bf(__uint_as_float(u.w << 16) * rs) | ((unsigned)f2bf(__uint_as_float(u.w & 0xffff0000u) * rs) << 16);
    *ptr = w;
  }
}


#define XB_TMO      128
#define XB_XCNT(j)  (256  + 64 * (j))
#define XB_XSUB(j)  (1280 + 64 * (j))
#define XB_XGEN(j)  (2304 + 64 * (j))
#define XB_TOP      3328
#define XB_TOPGEN   3392
#define XCD_BAR_WORDS 3456
#define XB_SPIN_CAP (1u << 18)
#define LAS __attribute__((address_space(3)))
__device__ __forceinline__ unsigned xb_ld(unsigned* p) { return __hip_atomic_load(p, __ATOMIC_RELAXED, __HIP_MEMORY_SCOPE_AGENT); }
__device__ __forceinline__ unsigned xb_add(unsigned* p, unsigned v) { return __hip_atomic_fetch_add(p, v, __ATOMIC_RELAXED, __HIP_MEMORY_SCOPE_AGENT); }
__device__ __forceinline__ unsigned xb_xcc_id() { return (unsigned)__builtin_amdgcn_s_getreg((3 << 11) | 20) & 0xFu; }
#define XB_SPIN(cond, bar) do { unsigned _sp = 0; while (cond) { __builtin_amdgcn_s_sleep(1); \
    if ((++_sp & 255u) == 0u) { if (xb_ld(&(bar)[XB_TMO])) break; if (_sp > XB_SPIN_CAP) { atomicAdd(&(bar)[XB_TMO], 1u); break; } } } } while (0)
struct XcdBarrier { unsigned* bar; unsigned x; volatile LAS unsigned* st; };
__device__ __forceinline__ XcdBarrier xcd_barrier_post(unsigned* bar, volatile LAS unsigned* st) {
  XcdBarrier b; b.bar = bar; b.x = xb_xcc_id(); b.st = st;
  if (threadIdx.x == 0) (void)xb_add(&bar[XB_XCNT(b.x)], 1u);
  return b;
}
__device__ __forceinline__ void xcd_barrier_complete(unsigned* bar, unsigned x, unsigned& nloc, unsigned& nx) {
  const unsigned G = gridDim.x * gridDim.y * gridDim.z;
  unsigned sum, cnt, mine, sp = 0u;
  for (;;) {
    sum = 0u; cnt = 0u; mine = 0u;
#pragma unroll
    for (unsigned j = 0; j < 16; ++j) { const unsigned c = xb_ld(&bar[XB_XCNT(j)]); sum += c; cnt += (c > 0u) ? 1u : 0u; mine = (j == x) ? c : mine; }
    if (sum == G) break;
    __builtin_amdgcn_s_sleep(1);
    if ((++sp & 255u) == 0u) { if (xb_ld(&bar[XB_TMO])) break; if (sp > XB_SPIN_CAP) { atomicAdd(&bar[XB_TMO], 1u); break; } }
  }
  nloc = mine > 0u ? mine : 1u; nx = cnt > 0u ? cnt : 1u;
}
__device__ __forceinline__ void xcd_barrier(const XcdBarrier& b) {
  asm volatile("s_waitcnt vmcnt(0)" ::: "memory");
  __syncthreads();
  if (threadIdx.x == 0) {
    unsigned* bar = b.bar;
    __builtin_amdgcn_s_waitcnt(0);
    unsigned nloc = b.st[0], nx = b.st[1];
    if (nloc == 0u) { xcd_barrier_complete(bar, b.x, nloc, nx); b.st[0] = nloc; b.st[1] = nx; }
    const unsigned old = xb_add(&bar[XB_XSUB(b.x)], 1u);
    const unsigned gen = old / nloc;
    if (old + 1u == (gen + 1u) * nloc) {
      __builtin_amdgcn_fence(__ATOMIC_RELEASE, "agent");
      asm volatile("s_waitcnt vmcnt(0)" ::: "memory");
      const unsigned og = xb_add(&bar[XB_TOP], 1u);
      const unsigned tg = og / nx;
      if (og + 1u == (tg + 1u) * nx) xb_add(&bar[XB_TOPGEN], 1u);
      else XB_SPIN(xb_ld(&bar[XB_TOPGEN]) == tg, bar);
      __builtin_amdgcn_fence(__ATOMIC_ACQUIRE, "agent");
      xb_add(&bar[XB_XGEN(b.x)], 1u);
      asm volatile("s_waitcnt vmcnt(0)" ::: "memory");
    } else {
      XB_SPIN(xb_ld(&bar[XB_XGEN(b.x)]) == gen, bar);
      __builtin_amdgcn_fence(__ATOMIC_ACQUIRE, "agent");
      asm volatile("s_waitcnt vmcnt(0)" ::: "memory");
    }
  }
  __syncthreads();
}

#define NPHASE 14
__global__ void __launch_bounds__(256, 2) mega(P p, int ph_lo, int ph_hi) {
  __shared__ __align__(16) unsigned char smem[73728 + 16 + (PROBE_PH >= 0 ? 256 : 0)];
  cg::grid_group grid = cg::this_grid();
  if (ph_lo < 0) grid.sync();
  if (threadIdx.x == 0) *(uint4*)(smem + 73728) = make_uint4(0u, 0u, 0u, 0u);
  __syncthreads();
  XcdBarrier xb = xcd_barrier_post((unsigned*)(p.ws + WS_BAR), (volatile LAS unsigned*)(smem + 73728));
  const float* mod = (const float*)(p.ws + WS_MOD);
#define IN(k) (ph_lo <= (k) && (k) < ph_hi)
#define SYNC(k) if (IN(k) && (k) + 1 < ph_hi) { xcd_barrier(xb); if (PROBE_PH >= 0 && blockIdx.x == 0 && threadIdx.x == 0) ((long long*)(smem + 73744))[(k) + 1] = __builtin_amdgcn_s_memrealtime(); }
  if (PROBE_PH >= 0 && blockIdx.x == 0 && threadIdx.x == 0) ((long long*)(smem + 73744))[0] = __builtin_amdgcn_s_memrealtime();
  if (IN(0)) phase_setup(p, smem);
  SYNC(0)
  if (IN(1)) phase_h0(p);
  SYNC(1)
  if (IN(2))
    phase_gemm<0>((const bf16*)(p.ws + WS_H), 1024, (const bf16*)(p.ws + WS_WEI), EVEN_NP / 128, smem,
                  (bf16*)(p.ws + WS_PROJ), EVEN_N, EVEN_N, nullptr, nullptr, nullptr, (unsigned*)(p.ws + WS_BAR), 0);
  SYNC(2)
  if (IN(3)) {
    for (int it = blockIdx.x; it < 1024; it += gridDim.x) { rec_pass1_item<64, 0>(p, it, smem); __syncthreads(); }
  }
  SYNC(3)
  if (IN(4)) {
    phase_rec_scan<64>(p);
    for (int it = blockIdx.x; it < 2048 * REPN + 16 * 66 + 256; it += gridDim.x) {
      if (it < 2048 * REPN) na_item(p, it & 2047, smem);
      else if (it < 2048 * REPN + 16 * 66) transpose_item(p.o_w_in, ODD_N, (bf16*)(p.ws + WS_WOI), it - 2048 * REPN, smem);
      else transpose_item(p.o_w_out, 1024, (bf16*)(p.ws + WS_WOO), it - 2048 * REPN - 16 * 66, smem);
      __syncthreads();
    }
  }
  SYNC(4)
  if (IN(5)) {
    for (int it = blockIdx.x; it < 1024 * REPR; it += gridDim.x) { rec_pass3_item<64, 0>(p, it & 1023, smem); __syncthreads(); }
  }
  SYNC(5)
  if (IN(6))
    phase_gemm<1>((const bf16*)(p.ws + WS_H), 1024, (const bf16*)(p.ws + WS_WEO), 8, smem, nullptr, 0, 0, p.x, (float*)(p.ws + WS_ST),
                  mod + 2048, (unsigned*)(p.ws + WS_BAR), 1);
  SYNC(6)
  if (IN(7)) phase_ln(p, 0, true);
  SYNC(7)
  if (IN(8))
    phase_gemm<0>((const bf16*)(p.ws + WS_H), 1024, (const bf16*)(p.ws + WS_WOI), ODD_NP / 128, smem,
                  (bf16*)(p.ws + WS_PROJ), ODD_N, ODD_N, nullptr, nullptr, nullptr, (unsigned*)(p.ws + WS_BAR), 2);
  SYNC(8)
  if (IN(9)) {
    for (int it = blockIdx.x; it < 512 + 1024; it += gridDim.x) {
      if (it < 512) ssd_pass1_item(p, it, smem); else rec_pass1_item<128, 1>(p, it - 512, smem);
      __syncthreads();
    }
  }
  SYNC(9)
  if (IN(10)) { phase_rec_scan<128>(p); phase_ssd_scan(p); }
  SYNC(10)
  if (IN(11)) {
    for (int it = blockIdx.x; it < 512 + 1024; it += gridDim.x) {
      if (it < 512) ssd_pass3_item(p, it, smem); else rec_pass3_item<128, 1>(p, it - 512, smem);
      __syncthreads();
    }
  }
  SYNC(11)
  if (IN(12))
    phase_gemm<2>((const bf16*)(p.ws + WS_PROJ) + 2048, ODD_N, (const bf16*)(p.ws + WS_WOO), 8, smem, nullptr, 0, 0,
                  (const float*)p.out, (float*)(p.ws + WS_ST), mod + 4 * 3072 + 2048, (unsigned*)(p.ws + WS_BAR), 3,
                  (const float*)(p.ws + WS_SSQ));
  SYNC(12)
  if (IN(13)) phase_ln(p, 1, false, smem + 73744);
}

extern "C" void kernel_launch(void* const* d_in, const int* in_sizes, int n_in, void* d_out, int out_size, void* d_ws,
                              size_t ws_size, hipStream_t stream) {
  static int grid_blocks = 0;
  if (!grid_blocks) {
    int dev = 0, cus = 0, per_cu = 0;
    hipGetDevice(&dev);
    hipDeviceGetAttribute(&cus, hipDeviceAttributeMultiprocessorCount, dev);
    hipOccupancyMaxActiveBlocksPerMultiprocessor(&per_cu, mega, 256, 0);
    if (per_cu < 1) per_cu = 1;
    if (per_cu > 2) per_cu = 2;
    grid_blocks = cus * per_cu;
    if (n_in != 22 || ws_size < WS_END) {
      fprintf(stderr, "kernel_launch: unexpected n_in %d / ws_size %zu (need %llu)\n", n_in, ws_size, (unsigned long long)WS_END);
      grid_blocks = -1;
    }
  }
  if (grid_blocks < 0) return;
  P p{};
  const float** f = (const float**)&p;
  for (int i = 0; i < 22; ++i) f[i] = (const float*)d_in[i];
  p.out = (float*)d_out;
  p.ws = (unsigned char*)d_ws;
#if 1
  if (hipMemsetAsync((char*)d_ws + WS_BAR, 0, 16384, stream) != hipSuccess) { fprintf(stderr, "memset of barrier words failed\n"); return; }
  int lo = 0, hi = NPHASE;
  void* args[] = {&p, &lo, &hi};
  hipError_t e = hipLaunchCooperativeKernel((void*)mega, dim3(grid_blocks), dim3(256), args, 0, stream);
  if (e != hipSuccess) fprintf(stderr, "cooperative launch failed: %s (grid %d)\n", hipGetErrorString(e), grid_blocks);
#else
  for (int ph = 0; ph < NPHASE; ++ph) hipLaunchKernelGGL(mega, dim3(grid_blocks), dim3(256), 0, stream, p, ph, ph + 1);
#endif
}
```

```cpp
#include <hip/hip_runtime.h>
#include <hip/hip_cooperative_groups.h>
#include <cstdio>
namespace cg = cooperative_groups;

typedef unsigned short bf16;
using bf16x8 = __attribute__((ext_vector_type(8))) short;
using f32x4 = __attribute__((ext_vector_type(4))) float;

#define M_TOK 16384
#define DM 1024
#define SEQ 4096
#define EVEN_N 3616
#define EVEN_NP 3712
#define ODD_N 4112
#define ODD_NP 4224
#define ALPHA 1.4142135623730951f
#ifndef PROBE_PH
#define PROBE_PH -1
#endif
#ifndef REPG
#define REPG 1
#endif
#ifndef REPN
#define REPN 1
#endif
#ifndef REP3
#define REP3 1
#endif
#ifndef REPS
#define REPS 1
#endif
#ifndef REP0
#define REP0 1
#endif
#ifndef REPR
#define REPR 1
#endif

#define WS_MOD 0ull
#define WS_LB (WS_MOD + 98304ull)
#define WS_WEI (WS_LB + 2048ull)
#define WS_WEO (WS_WEI + 3712ull * 2048)
#define WS_WOI (WS_WEO + 1024ull * 2048)
#define WS_WOO (WS_WOI + 4224ull * 2048)
#define WS_H (WS_WOO + 1024ull * 2048)
#define WS_PROJ (WS_H + 16384ull * 2048)
#define WS_O (WS_PROJ + 16384ull * 4112 * 2)
#define WS_ST WS_O
#define WS_DEC (WS_O + 2ull * 16384 * 512 * 4)
#define WS_SSQ (WS_DEC + 2ull * 16 * 64 * 128 * 4)
#define WS_BAR (WS_SSQ + 2ull * 16384 * 4)
#define WS_CMID (WS_BAR + 16384ull)
#define WS_DECS (WS_CMID + 2ull * 16 * 64 * 128 * 4)
#define WS_END (WS_DECS + 16384ull)

struct P {
  const float *x, *c, *ada_w, *ada_b, *ln_g, *ln_b, *e_w_in, *e_rpb, *gla_w_up, *gla_b, *gla_g, *e_w_out;
  const float *o_w_in, *hgrn_lb, *hgrn_g, *conv_w, *conv_b, *dt_bias, *a_log, *d_skip, *ssm_g, *o_w_out;
  float* out;
  unsigned char* ws;
};

__device__ __forceinline__ bf16 f2bf(float f) {
  __bf16 h = (__bf16)f;
  return *(bf16*)&h;
}
using u32x4 = __attribute__((ext_vector_type(4))) unsigned;
__device__ __forceinline__ u32x4 gload16_asm(const void* ptr) {
  u32x4 r;
  asm volatile("global_load_dwordx4 %0, %1, off" : "=v"(r) : "v"(ptr));
  return r;
}
using u32x2 = __attribute__((ext_vector_type(2))) unsigned;
__device__ __forceinline__ u32x2 gload8_asm(const void* ptr) {
  u32x2 r;
  asm volatile("global_load_dwordx2 %0, %1, off" : "=v"(r) : "v"(ptr));
  return r;
}
__device__ __forceinline__ float bf2f(bf16 h) { return __uint_as_float(((unsigned)h) << 16); }
__device__ __forceinline__ float frcp(float x) { return __builtin_amdgcn_rcpf(x); }
__device__ __forceinline__ float silu_f(float v) { return v * frcp(1.f + __expf(-v)); }
__device__ __forceinline__ float sigmoid_f(float v) { return frcp(1.f + __expf(-v)); }
__device__ __forceinline__ float flog(float x) { return __builtin_amdgcn_logf(x) * 0.6931471805599453f; }
__device__ __forceinline__ float log_sigmoid_f(float z) { return fminf(z, 0.f) - flog(1.f + __expf(-fabsf(z))); }
__device__ __forceinline__ float softplus_f(float z) { return fmaxf(z, 0.f) + log1pf(__expf(-fabsf(z))); }
__device__ __forceinline__ float wave_sum(float v) {
#pragma unroll
  for (int o = 32; o > 0; o >>= 1) v += __shfl_xor(v, o, 64);
  return v;
}

__device__ __forceinline__ void transpose_item(const float* __restrict__ src, int N, bf16* __restrict__ dst, int li, unsigned char* smem) {
  float* tile = (float*)smem;
  const int tid = threadIdx.x;
  const int kt = li & 15, ntile = li >> 4;
#pragma unroll
  for (int i = 0; i < 16; ++i) {
    int row = i * 4 + (tid >> 6), col = tid & 63;
    int n = ntile * 64 + col;
    float v = (n < N) ? src[(size_t)(kt * 64 + row) * N + n] : 0.f;
    tile[row * 65 + col] = v;
  }
  __syncthreads();
#pragma unroll
  for (int i = 0; i < 16; ++i) {
    int r = i * 4 + (tid >> 6), cc = tid & 63;
    dst[(size_t)(ntile * 64 + r) * 1024 + kt * 64 + cc] = f2bf(tile[cc * 65 + r]);
  }
}

__device__ __forceinline__ void mod_item(const P& p, int idx, unsigned char* smem) {
  float* cond = (float*)smem;
  float* red = cond + 4096;
  const int tid = threadIdx.x;
  const int l = idx / 192, nc = idx % 192;
  for (int e = tid; e < 4096; e += 256) cond[e] = silu_f(p.c[e]);
  __syncthreads();
  const int kg = tid >> 4, col = tid & 15, n = nc * 16 + col;
  float a0 = 0.f, a1 = 0.f, a2 = 0.f, a3 = 0.f;
  const float* w = p.ada_w + (size_t)l * 1024 * 3072 + n;
#pragma unroll 16
  for (int k = kg * 64; k < kg * 64 + 64; ++k) {
    float wv = w[(size_t)k * 3072];
    a0 += cond[k] * wv; a1 += cond[1024 + k] * wv; a2 += cond[2048 + k] * wv; a3 += cond[3072 + k] * wv;
  }
  red[(kg * 4 + 0) * 16 + col] = a0; red[(kg * 4 + 1) * 16 + col] = a1;
  red[(kg * 4 + 2) * 16 + col] = a2; red[(kg * 4 + 3) * 16 + col] = a3;
  __syncthreads();
  if (tid < 64) {
    const int b = tid >> 4;
    float sum = 0.f;
#pragma unroll
    for (int q = 0; q < 16; ++q) sum += red[(q * 4 + b) * 16 + col];
    float* mod = (float*)(p.ws + WS_MOD);
    mod[(size_t)(l * 4 + b) * 3072 + n] = sum + p.ada_b[l * 3072 + n];
  }
}

__device__ __forceinline__ void phase_setup(const P& p, unsigned char* smem) {
  const int M0 = 384, T0 = M0 + 16 * 58, T1 = T0 + 256, T5 = T1 + 1;
  for (int rep = 0; rep < REP0; ++rep)
  for (int it = blockIdx.x; it < T5; it += gridDim.x) {
    if (it < M0) mod_item(p, it, smem);
    else if (it < T0) transpose_item(p.e_w_in, EVEN_N, (bf16*)(p.ws + WS_WEI), it - M0, smem);
    else if (it < T1) transpose_item(p.e_w_out, 1024, (bf16*)(p.ws + WS_WEO), it - T0, smem);
    else {
      float* lbv = (float*)(p.ws + WS_LB);
      for (int j = threadIdx.x; j < 512; j += 256) {
        float a = p.hgrn_lb[j], bb = p.hgrn_lb[512 + j];
        lbv[j] = 1.f / (1.f + __expf(a - bb));
      }
    }
    __syncthreads();
  }
}

__device__ __forceinline__ void phase_h0(const P& p) {
  const float* mod = (const float*)(p.ws + WS_MOD);
  bf16* hb = (bf16*)(p.ws + WS_H);
  const size_t total = (size_t)M_TOK * 128;
  for (size_t i = (size_t)blockIdx.x * 256 + threadIdx.x; i < total; i += (size_t)gridDim.x * 256) {
    int m = (int)(i >> 7), n = (int)(i & 127) * 8, b = m >> 12;
    const float4* xp = (const float4*)(p.x + (size_t)m * 1024 + n);
    const float4* sh = (const float4*)(mod + (size_t)b * 3072 + n);
    const float4* sc = (const float4*)(mod + (size_t)b * 3072 + 1024 + n);
    float4 x0 = xp[0], x1 = xp[1], s0 = sh[0], s1 = sh[1], c0 = sc[0], c1 = sc[1];
    uint4 o;
    o.x = (unsigned)f2bf(x0.x * (1.f + c0.x) + s0.x) | ((unsigned)f2bf(x0.y * (1.f + c0.y) + s0.y) << 16);
    o.y = (unsigned)f2bf(x0.z * (1.f + c0.z) + s0.z) | ((unsigned)f2bf(x0.w * (1.f + c0.w) + s0.w) << 16);
    o.z = (unsigned)f2bf(x1.x * (1.f + c1.x) + s1.x) | ((unsigned)f2bf(x1.y * (1.f + c1.y) + s1.y) << 16);
    o.w = (unsigned)f2bf(x1.z * (1.f + c1.z) + s1.z) | ((unsigned)f2bf(x1.w * (1.f + c1.w) + s1.w) << 16);
    *(uint4*)(hb + (size_t)m * 1024 + n) = o;
  }
}

#ifndef GEMM_NST
#define GEMM_NST 2
#endif
#define LSTR 64
__device__ __forceinline__ void gemm_issue(const bf16* __restrict__ A, int lda, const bf16* __restrict__ Bt, int m0, int n0,
                                           u32x4 (&ra)[GEMM_NST][4], u32x4 (&rb)[GEMM_NST][4]) {
  const int tid = threadIdx.x, lrow = tid >> 3, lkc = tid & 7;
  const bf16* Ag = A + (size_t)(m0 + lrow) * lda + lkc * 8;
  const bf16* Bg = Bt + (size_t)(n0 + lrow) * 1024 + lkc * 8;
#pragma unroll
  for (int t = 0; t < GEMM_NST; ++t)
#pragma unroll
    for (int i = 0; i < 4; ++i) {
      ra[t][i] = gload16_asm(Ag + (size_t)i * 32 * lda + t * 64);
      rb[t][i] = gload16_asm(Bg + (size_t)i * 32 * 1024 + t * 64);
    }
}

template <int EPI, typename NextFn>
__device__ __forceinline__ void gemm_tile(const bf16* __restrict__ A, int lda, const bf16* __restrict__ Bt, int m0, int n0,
                                          unsigned char* smem, bf16* __restrict__ C, int ldc, int nreal,
                                          const float* __restrict__ X, float* __restrict__ R, const float* __restrict__ gate,
                                          const float* __restrict__ ssqp, u32x4 (&ra)[GEMM_NST][4], u32x4 (&rb)[GEMM_NST][4],
                                          NextFn&& next_issue) {
  bf16* As = (bf16*)smem;
  bf16* Bs = As + 2 * 128 * LSTR;
  const int tid = threadIdx.x, lane = tid & 63, wave = tid >> 6;
  const int wm = wave >> 1, wn = wave & 1;
  f32x4 acc[4][4];
#pragma unroll
  for (int i = 0; i < 4; ++i)
#pragma unroll
    for (int j = 0; j < 4; ++j) acc[i][j] = (f32x4){0.f, 0.f, 0.f, 0.f};
  float rsv[4] = {1.f, 1.f, 1.f, 1.f};
  if (EPI == 2) {
#pragma unroll
    for (int j = 0; j < 4; ++j) {
      const int m = m0 + wm * 64 + j * 16 + (lane & 15);
      rsv[j] = rsqrtf((ssqp[m] + ssqp[M_TOK + m]) * (1.f / 512.f) + 1e-6f);
    }
  }
  const int lrow = tid >> 3, lkc = tid & 7;
  const int lsw = (lkc ^ (lrow & 7)) * 8;
  const bf16* Ag = A + (size_t)(m0 + lrow) * lda + lkc * 8;
  const bf16* Bg = Bt + (size_t)(n0 + lrow) * 1024 + lkc * 8;
  if (GEMM_NST == 3) {
    asm volatile("s_waitcnt vmcnt(16)"
                 : "+v"(ra[0][0]), "+v"(ra[0][1]), "+v"(ra[0][2]), "+v"(ra[0][3]), "+v"(rb[0][0]), "+v"(rb[0][1]), "+v"(rb[0][2]), "+v"(rb[0][3])
                 :: "memory");
  } else {
    asm volatile("s_waitcnt vmcnt(8)"
                 : "+v"(ra[0][0]), "+v"(ra[0][1]), "+v"(ra[0][2]), "+v"(ra[0][3]), "+v"(rb[0][0]), "+v"(rb[0][1]), "+v"(rb[0][2]), "+v"(rb[0][3])
                 :: "memory");
  }
#pragma unroll
  for (int i = 0; i < 4; ++i) {
    *(u32x4*)(As + (lrow + i * 32) * LSTR + lsw) = ra[0][i];
    *(u32x4*)(Bs + (lrow + i * 32) * LSTR + lsw) = rb[0][i];
  }
  __syncthreads();
#pragma unroll
  for (int kt = 0; kt < 16; ++kt) {
    const int buf = kt & 1;
    if (kt + 1 < 16) {
      const int sn = (kt + 1) % GEMM_NST;
      if (GEMM_NST == 3 && kt + 2 < 16) {
        asm volatile("s_waitcnt vmcnt(8)"
                     : "+v"(ra[sn][0]), "+v"(ra[sn][1]), "+v"(ra[sn][2]), "+v"(ra[sn][3]), "+v"(rb[sn][0]), "+v"(rb[sn][1]), "+v"(rb[sn][2]), "+v"(rb[sn][3])
                     :: "memory");
      } else {
        asm volatile("s_waitcnt vmcnt(0)"
                     : "+v"(ra[sn][0]), "+v"(ra[sn][1]), "+v"(ra[sn][2]), "+v"(ra[sn][3]), "+v"(rb[sn][0]), "+v"(rb[sn][1]), "+v"(rb[sn][2]), "+v"(rb[sn][3])
                     :: "memory");
      }
      bf16* Aw = As + (buf ^ 1) * 128 * LSTR;
      bf16* Bw = Bs + (buf ^ 1) * 128 * LSTR;
#pragma unroll
      for (int i = 0; i < 4; ++i) {
        *(u32x4*)(Aw + (lrow + i * 32) * LSTR + lsw) = ra[sn][i];
        *(u32x4*)(Bw + (lrow + i * 32) * LSTR + lsw) = rb[sn][i];
      }
    }
    if (kt + GEMM_NST < 16) {
#pragma unroll
      for (int i = 0; i < 4; ++i) {
        ra[kt % GEMM_NST][i] = gload16_asm(Ag + (size_t)i * 32 * lda + (kt + GEMM_NST) * 64);
        rb[kt % GEMM_NST][i] = gload16_asm(Bg + (size_t)i * 32 * 1024 + (kt + GEMM_NST) * 64);
      }
    }
    const bf16* Ab = As + buf * 128 * LSTR;
    const bf16* Bb = Bs + buf * 128 * LSTR;
    if (EPI == 2 && kt == 8) {
#pragma unroll
      for (int j = 0; j < 4; ++j) {
        const float inv = frcp(rsv[j]);
#pragma unroll
        for (int i = 0; i < 4; ++i) { acc[i][j][0] *= inv; acc[i][j][1] *= inv; acc[i][j][2] *= inv; acc[i][j][3] *= inv; }
      }
    }
#pragma unroll
    for (int s = 0; s < 2; ++s) {
      bf16x8 wf[4], xf[4];
#pragma unroll
      for (int i = 0; i < 4; ++i) {
        wf[i] = *(const bf16x8*)(Bb + (wn * 64 + i * 16 + (lane & 15)) * LSTR + (((s * 4 + (lane >> 4)) ^ (lane & 7)) * 8));
        xf[i] = *(const bf16x8*)(Ab + (wm * 64 + i * 16 + (lane & 15)) * LSTR + (((s * 4 + (lane >> 4)) ^ (lane & 7)) * 8));
      }
#pragma unroll
      for (int i = 0; i < 4; ++i)
#pragma unroll
        for (int j = 0; j < 4; ++j) acc[i][j] = __builtin_amdgcn_mfma_f32_16x16x32_bf16(wf[i], xf[j], acc[i][j], 0, 0, 0);
    }
    __syncthreads();
  }
  next_issue();
#pragma unroll
  for (int i = 0; i < 4; ++i) {
    const int n = n0 + wn * 64 + i * 16 + (lane >> 4) * 4;
#pragma unroll
    for (int j = 0; j < 4; ++j) {
      const int m = m0 + wm * 64 + j * 16 + (lane & 15);
      f32x4 a = acc[i][j];
      if (EPI == 2) { a[0] *= rsv[j]; a[1] *= rsv[j]; a[2] *= rsv[j]; a[3] *= rsv[j]; }
      if (EPI == 0) {
        uint2 o;
        o.x = (unsigned)f2bf(a[0]) | ((unsigned)f2bf(a[1]) << 16);
        o.y = (unsigned)f2bf(a[2]) | ((unsigned)f2bf(a[3]) << 16);
        *(uint2*)((bf16*)smem + (wm * 64 + j * 16 + (lane & 15)) * 136 + wn * 64 + i * 16 + (lane >> 4) * 4) = o;
      } else {
        *(f32x4*)((float*)smem + (wm * 64 + j * 16 + (lane & 15)) * 132 + wn * 64 + i * 16 + (lane >> 4) * 4) = a;
      }
    }
  }
  if (EPI == 0) {
    __syncthreads();
#pragma unroll
    for (int q = 0; q < 8; ++q) {
      const int c = q * 256 + tid, row = c >> 4, c16 = c & 15;
      const int n = n0 + c16 * 8;
      if (n < nreal) *(u32x4*)(C + (size_t)(m0 + row) * ldc + n) = *(const u32x4*)((const bf16*)smem + row * 136 + c16 * 8);
    }
    __syncthreads();
  } else {
    __syncthreads();
#pragma unroll 4
    for (int q = 0; q < 16; ++q) {
      const int c = q * 256 + tid, row = c >> 5, c4 = c & 31;
      const int m = m0 + row, n = n0 + c4 * 4, b = m >> 12;
      const f32x4 a = *(const f32x4*)((const float*)smem + row * 132 + c4 * 4);
      float4 xv;
      if (EPI == 2) {
        uint2 xu = *(const uint2*)((const bf16*)X + (size_t)m * 1024 + n);
        xv.x = __uint_as_float(xu.x << 16); xv.y = __uint_as_float(xu.x & 0xffff0000u);
        xv.z = __uint_as_float(xu.y << 16); xv.w = __uint_as_float(xu.y & 0xffff0000u);
      } else xv = *(const float4*)(X + (size_t)m * 1024 + n);
      const float4 g = *(const float4*)(gate + (size_t)b * 3072 + n);
      float4 o;
      o.x = ALPHA * xv.x + g.x * a[0];
      o.y = ALPHA * xv.y + g.y * a[1];
      o.z = ALPHA * xv.z + g.z * a[2];
      o.w = ALPHA * xv.w + g.w * a[3];
      *(float4*)(R + (size_t)m * 1024 + n) = o;
    }
    __syncthreads();
  }
}

template <int EPI>
__device__ __forceinline__ void phase_gemm(const bf16* A, int lda, const bf16* Bt, int ntn, unsigned char* smem, bf16* C, int ldc, int nreal,
                           const float* X, float* R, const float* gate, unsigned* bar, int gidx, const float* ssqp = nullptr) {
  volatile unsigned* stw = (volatile unsigned*)(smem + 73728);
  const unsigned xid = (unsigned)__builtin_amdgcn_s_getreg((3 << 11) | 20) & 0xFu;
  int xidx = 0, nx = 0;
#pragma unroll
  for (int j = 0; j < 16; ++j) {
    const unsigned c = __hip_atomic_load(&bar[256 + 64 * j], __ATOMIC_RELAXED, __HIP_MEMORY_SCOPE_AGENT);
    if (c > 0u) { nx++; if ((unsigned)j < xid) xidx++; }
  }
  const int mt_lo = (xidx * 128) / nx, mt_hi = ((xidx + 1) * 128) / nx;
  const int total = (mt_hi - mt_lo) * ntn;
  unsigned* qc = bar + 3456 + (gidx * 16 + xidx) * 8;
  u32x4 ra[GEMM_NST][4], rb[GEMM_NST][4];
  int mt = 0, nt = 0;
  bool valid = false;
  auto fetch = [&](int& mt_o, int& nt_o) -> bool {
    __syncthreads();
    if (threadIdx.x == 0) stw[2] = __hip_atomic_fetch_add(qc, 1u, __ATOMIC_RELAXED, __HIP_MEMORY_SCOPE_AGENT);
    __syncthreads();
    const int t = (int)stw[2];
    if (t >= total) return false;
    const int g8 = t / (8 * ntn), r = t - g8 * 8 * ntn;
    const int rows = mt_hi - mt_lo - g8 * 8;
    const int gm = rows < 8 ? rows : 8;
    nt_o = r / gm; mt_o = mt_lo + g8 * 8 + (r - nt_o * gm);
    return true;
  };
  valid = fetch(mt, nt);
  if (valid) gemm_issue(A, lda, Bt, mt * 128, nt * 128, ra, rb);
  while (valid) {
    int mt2 = 0, nt2 = 0;
    bool valid2 = false;
    gemm_tile<EPI>(A, lda, Bt, mt * 128, nt * 128, smem, C, ldc, nreal, X, R, gate, ssqp, ra, rb, [&]() {
      valid2 = fetch(mt2, nt2);
      if (valid2) gemm_issue(A, lda, Bt, mt2 * 128, nt2 * 128, ra, rb);
    });
    mt = mt2; nt = nt2; valid = valid2;
  }
}

__device__ __forceinline__ void phase_ln(const P& p, int l, bool write_h, const unsigned char* probe_ts = nullptr) {
  const float* mod = (const float*)(p.ws + WS_MOD);
  bf16* hb = (bf16*)(p.ws + WS_H);
  const int lane = threadIdx.x & 63, wave = threadIdx.x >> 6;
  const float* g = p.ln_g + l * 1024;
  const float* bb = p.ln_b + l * 1024;
  constexpr int NR = 4;
  for (int grp = blockIdx.x * 4 + wave; grp < M_TOK / NR; grp += gridDim.x * 4) {
    float4 v[NR][4];
    float s[NR];
#pragma unroll
    for (int r = 0; r < NR; ++r) {
      const float* rp = (const float*)(p.ws + WS_ST) + (size_t)(grp * NR + r) * 1024;
#pragma unroll
      for (int q = 0; q < 4; ++q) v[r][q] = *(const float4*)(rp + (lane + 64 * q) * 4);
    }
#pragma unroll
    for (int r = 0; r < NR; ++r) {
      s[r] = 0.f;
#pragma unroll
      for (int q = 0; q < 4; ++q) s[r] += v[r][q].x + v[r][q].y + v[r][q].z + v[r][q].w;
    }
#pragma unroll
    for (int o = 32; o > 0; o >>= 1)
#pragma unroll
      for (int r = 0; r < NR; ++r) s[r] += __shfl_xor(s[r], o, 64);
    float mu[NR], s2[NR];
#pragma unroll
    for (int r = 0; r < NR; ++r) {
      mu[r] = s[r] * (1.f / 1024.f);
      s2[r] = 0.f;
#pragma unroll
      for (int q = 0; q < 4; ++q) {
        float a = v[r][q].x - mu[r], b2 = v[r][q].y - mu[r], c2 = v[r][q].z - mu[r], d2 = v[r][q].w - mu[r];
        s2[r] += a * a + b2 * b2 + c2 * c2 + d2 * d2;
      }
    }
#pragma unroll
    for (int o = 32; o > 0; o >>= 1)
#pragma unroll
      for (int r = 0; r < NR; ++r) s2[r] += __shfl_xor(s2[r], o, 64);
#pragma unroll
    for (int q = 0; q < 4; ++q) {
      const int n = (lane + 64 * q) * 4;
      const float4 gg = *(const float4*)(g + n), be = *(const float4*)(bb + n);
#pragma unroll
      for (int r = 0; r < NR; ++r) {
        const int row = grp * NR + r;
        const float rstd = rsqrtf(s2[r] * (1.f / 1024.f) + 1e-5f);
        float4 o;
        o.x = (v[r][q].x - mu[r]) * rstd * gg.x + be.x;
        o.y = (v[r][q].y - mu[r]) * rstd * gg.y + be.y;
        o.z = (v[r][q].z - mu[r]) * rstd * gg.z + be.z;
        o.w = (v[r][q].w - mu[r]) * rstd * gg.w + be.w;
        if (PROBE_PH >= 0 && l == 1 && row == 0) {
          const long long* ts = (const long long*)(probe_ts);
          const int kus = (int)((ts[PROBE_PH + 1] - ts[PROBE_PH]) / 100);
          if (n + 0 < kus) o.x += 0.125f;
          if (n + 1 < kus) o.y += 0.125f;
          if (n + 2 < kus) o.z += 0.125f;
          if (n + 3 < kus) o.w += 0.125f;
        }
        if (!write_h) *(float4*)(p.out + (size_t)row * 1024 + n) = o;
        if (write_h) {
          const int b = row >> 12;
          uint2 xb16;
          xb16.x = (unsigned)f2bf(o.x) | ((unsigned)f2bf(o.y) << 16);
          xb16.y = (unsigned)f2bf(o.z) | ((unsigned)f2bf(o.w) << 16);
          *(uint2*)((bf16*)p.out + (size_t)row * 1024 + n) = xb16;
          const float* md = mod + (size_t)(4 + b) * 3072;
          float4 sh = *(const float4*)(md + n), sc = *(const float4*)(md + 1024 + n);
          uint2 hh;
          hh.x = (unsigned)f2bf(o.x * (1.f + sc.x) + sh.x) | ((unsigned)f2bf(o.y * (1.f + sc.y) + sh.y) << 16);
          hh.y = (unsigned)f2bf(o.z * (1.f + sc.z) + sh.z) | ((unsigned)f2bf(o.w * (1.f + sc.w) + sh.w) << 16);
          *(uint2*)(hb + (size_t)row * 1024 + n) = hh;
        }
      }
    }
  }
}

__device__ __forceinline__ void na_item(const P& p, int item, unsigned char* smem) {
  const int h = item & 7, r = (item >> 3) & 63, b = item >> 9;
  bf16* VT = (bf16*)smem;
  float* RPB = (float*)(VT + 64 * 520);
  const bf16* projb = (const bf16*)(p.ws + WS_PROJ) + (size_t)b * 4096 * EVEN_N;
  bf16* yb = (bf16*)(p.ws + WS_H);
  const int tid = threadIdx.x, lane = tid & 63, n = tid >> 6;
  const int q = lane & 15, g4 = lane >> 4;
  int rs = r - 4; rs = rs < 0 ? 0 : (rs > 56 ? 56 : rs);
  const int bs_pre = n == 0 ? 0 : (n == 1 ? 8 : (n == 2 ? 24 : 32));
  u32x4 kpre[8][2];
#pragma unroll
  for (int tt = 0; tt < 8; ++tt) {
    const int ktok = (rs + (tt >> 1)) * 64 + bs_pre + (tt & 1) * 16 + q;
    const bf16* kp = projb + (size_t)ktok * EVEN_N + 512 + h * 64 + g4 * 8;
    kpre[tt][0] = gload16_asm(kp);
    kpre[tt][1] = gload16_asm(kp + 32);
  }
#pragma unroll 8
  for (int i = 0; i < 16; ++i) {
    const int key = (i >> 3) * 256 + tid, ch = i & 7;
    const int tok = (rs + (key >> 6)) * 64 + (key & 63);
    uint4 u = *(const uint4*)(projb + (size_t)tok * EVEN_N + 1024 + h * 64 + ch * 8);
    bf16* dst = VT + (ch * 8) * 520 + key;
    dst[0 * 520] = (bf16)(u.x & 0xffffu); dst[1 * 520] = (bf16)(u.x >> 16);
    dst[2 * 520] = (bf16)(u.y & 0xffffu); dst[3 * 520] = (bf16)(u.y >> 16);
    dst[4 * 520] = (bf16)(u.z & 0xffffu); dst[5 * 520] = (bf16)(u.z >> 16);
    dst[6 * 520] = (bf16)(u.w & 0xffffu); dst[7 * 520] = (bf16)(u.w >> 16);
  }
  for (int i = tid; i < 465; i += 256) RPB[i] = p.e_rpb[h * 465 + i];
  const int qcol = n * 16 + q;
  const int qtok = r * 64 + qcol;
  const int bs = n == 0 ? 0 : (n == 1 ? 8 : (n == 2 ? 24 : 32));
  const bf16x8 qf0 = *(const bf16x8*)(projb + (size_t)qtok * EVEN_N + h * 64 + g4 * 8);
  const bf16x8 qf1 = *(const bf16x8*)(projb + (size_t)qtok * EVEN_N + h * 64 + 32 + g4 * 8);
  f32x4 st[16];
  asm volatile("s_waitcnt vmcnt(0)"
               : "+v"(kpre[0][0]), "+v"(kpre[0][1]), "+v"(kpre[1][0]), "+v"(kpre[1][1]), "+v"(kpre[2][0]), "+v"(kpre[2][1]), "+v"(kpre[3][0]), "+v"(kpre[3][1]),
                 "+v"(kpre[4][0]), "+v"(kpre[4][1]), "+v"(kpre[5][0]), "+v"(kpre[5][1]), "+v"(kpre[6][0]), "+v"(kpre[6][1]), "+v"(kpre[7][0]), "+v"(kpre[7][1])
               :: "memory");
  u32x4 kpre2[8][2];
#pragma unroll
  for (int tt = 0; tt < 8; ++tt) {
    const int ktok = (rs + 4 + (tt >> 1)) * 64 + bs + (tt & 1) * 16 + q;
    const bf16* kp = projb + (size_t)ktok * EVEN_N + 512 + h * 64 + g4 * 8;
    kpre2[tt][0] = gload16_asm(kp);
    kpre2[tt][1] = gload16_asm(kp + 32);
  }
#pragma unroll
  for (int tt = 0; tt < 16; ++tt) {
    if (tt == 8) {
      asm volatile("s_waitcnt vmcnt(0)"
                   : "+v"(kpre2[0][0]), "+v"(kpre2[0][1]), "+v"(kpre2[1][0]), "+v"(kpre2[1][1]), "+v"(kpre2[2][0]), "+v"(kpre2[2][1]), "+v"(kpre2[3][0]), "+v"(kpre2[3][1]),
                     "+v"(kpre2[4][0]), "+v"(kpre2[4][1]), "+v"(kpre2[5][0]), "+v"(kpre2[5][1]), "+v"(kpre2[6][0]), "+v"(kpre2[6][1]), "+v"(kpre2[7][0]), "+v"(kpre2[7][1])
                   :: "memory");
    }
    bf16x8 kf0, kf1;
    if (tt < 8) { kf0 = *(bf16x8*)&kpre[tt][0]; kf1 = *(bf16x8*)&kpre[tt][1]; }
    else { kf0 = *(bf16x8*)&kpre2[tt - 8][0]; kf1 = *(bf16x8*)&kpre2[tt - 8][1]; }
    f32x4 z = (f32x4){0.f, 0.f, 0.f, 0.f};
    z = __builtin_amdgcn_mfma_f32_16x16x32_bf16(kf0, qf0, z, 0, 0, 0);
    st[tt] = __builtin_amdgcn_mfma_f32_16x16x32_bf16(kf1, qf1, z, 0, 0, 0);
  }
  __syncthreads();
  int cs = qcol - 8; cs = cs < 0 ? 0 : (cs > 48 ? 48 : cs);
  float mx = -1e30f;
#pragma unroll
  for (int tt = 0; tt < 16; ++tt) {
    const float* brow = RPB + (rs + (tt >> 1) - r + 7) * 31;
#pragma unroll
    for (int rr = 0; rr < 4; ++rr) {
      const int kcol = bs + (tt & 1) * 16 + g4 * 4 + rr;
      const bool valid = (kcol >= cs) && (kcol < cs + 16);
      int dc = kcol - qcol + 15; dc = dc < 0 ? 0 : (dc > 30 ? 30 : dc);
      const float sc = valid ? st[tt][rr] * 0.125f + brow[dc] : -1e30f;
      st[tt][rr] = sc;
      mx = fmaxf(mx, sc);
    }
  }
  mx = fmaxf(mx, __shfl_xor(mx, 16, 64));
  mx = fmaxf(mx, __shfl_xor(mx, 32, 64));
  float lsum = 0.f;
#pragma unroll
  for (int tt = 0; tt < 16; ++tt)
#pragma unroll
    for (int rr = 0; rr < 4; ++rr) {
      const float pe = __expf(st[tt][rr] - mx);
      st[tt][rr] = pe;
      lsum += pe;
    }
  lsum += __shfl_xor(lsum, 16, 64);
  lsum += __shfl_xor(lsum, 32, 64);
  f32x4 ot[4];
#pragma unroll
  for (int dt = 0; dt < 4; ++dt) ot[dt] = (f32x4){0.f, 0.f, 0.f, 0.f};
#pragma unroll
  for (int kr = 0; kr < 8; ++kr) {
    uint4 pw;
    pw.x = (unsigned)f2bf(st[2 * kr][0]) | ((unsigned)f2bf(st[2 * kr][1]) << 16);
    pw.y = (unsigned)f2bf(st[2 * kr][2]) | ((unsigned)f2bf(st[2 * kr][3]) << 16);
    pw.z = (unsigned)f2bf(st[2 * kr + 1][0]) | ((unsigned)f2bf(st[2 * kr + 1][1]) << 16);
    pw.w = (unsigned)f2bf(st[2 * kr + 1][2]) | ((unsigned)f2bf(st[2 * kr + 1][3]) << 16);
    const bf16x8 pf = *(bf16x8*)&pw;
#pragma unroll
    for (int dt = 0; dt < 4; ++dt) {
      const bf16* vp = VT + (dt * 16 + q) * 520 + kr * 64 + bs + g4 * 4;
      uint2 lo = *(const uint2*)vp, hi = *(const uint2*)(vp + 16);
      uint4 vw; vw.x = lo.x; vw.y = lo.y; vw.z = hi.x; vw.w = hi.y;
      ot[dt] = __builtin_amdgcn_mfma_f32_16x16x32_bf16(*(bf16x8*)&vw, pf, ot[dt], 0, 0, 0);
    }
  }
  const float inv = frcp(lsum);
#pragma unroll
  for (int dt = 0; dt < 4; ++dt) {
    const int d0 = dt * 16 + g4 * 4;
    uint2 gu = *(const uint2*)(projb + (size_t)qtok * EVEN_N + 1536 + h * 64 + d0);
    f32x4 y;
    y[0] = ot[dt][0] * inv * silu_f(__uint_as_float(gu.x << 16));
    y[1] = ot[dt][1] * inv * silu_f(__uint_as_float(gu.x & 0xffff0000u));
    y[2] = ot[dt][2] * inv * silu_f(__uint_as_float(gu.y << 16));
    y[3] = ot[dt][3] * inv * silu_f(__uint_as_float(gu.y & 0xffff0000u));
    uint2 o;
    o.x = (unsigned)f2bf(y[0]) | ((unsigned)f2bf(y[1]) << 16);
    o.y = (unsigned)f2bf(y[2]) | ((unsigned)f2bf(y[3]) << 16);
    *(uint2*)(yb + ((size_t)b * 4096 + qtok) * 1024 + h * 64 + d0) = o;
  }
}

template <int K, int MODE>
struct GateC {
  float w[16];
  float bias, lb;
  int d, ch;
  __device__ __forceinline__ void init(const P& p, int d_, int h, int k) {
    d = d_; ch = h * K + k;
    if (MODE == 0) {
#pragma unroll
      for (int r = 0; r < 16; ++r) w[r] = p.gla_w_up[(d * 16 + r) * 256 + ch];
      bias = p.gla_b[d * 256 + ch];
      lb = 0.f;
    } else {
      lb = ((const float*)(p.ws + WS_LB))[ch];
      bias = 0.f;
    }
  }
  __device__ __forceinline__ void eval_vals(bf16 a, bf16 bz, const bf16* lr, float& g, float& kval, float& qval) const {
    if (MODE == 0) {
      uint4 u0 = *(const uint4*)(lr);
      uint4 u1 = *(const uint4*)(lr + 8);
      float z = bias;
      z += w[0] * __uint_as_float(u0.x << 16) + w[1] * __uint_as_float(u0.x & 0xffff0000u);
      z += w[2] * __uint_as_float(u0.y << 16) + w[3] * __uint_as_float(u0.y & 0xffff0000u);
      z += w[4] * __uint_as_float(u0.z << 16) + w[5] * __uint_as_float(u0.z & 0xffff0000u);
      z += w[6] * __uint_as_float(u0.w << 16) + w[7] * __uint_as_float(u0.w & 0xffff0000u);
      z += w[8] * __uint_as_float(u1.x << 16) + w[9] * __uint_as_float(u1.x & 0xffff0000u);
      z += w[10] * __uint_as_float(u1.y << 16) + w[11] * __uint_as_float(u1.y & 0xffff0000u);
      z += w[12] * __uint_as_float(u1.z << 16) + w[13] * __uint_as_float(u1.z & 0xffff0000u);
      z += w[14] * __uint_as_float(u1.w << 16) + w[15] * __uint_as_float(u1.w & 0xffff0000u);
      g = log_sigmoid_f(z) * (1.f / 16.f);
      kval = bf2f(bz);
      qval = bf2f(a) * 0.125f;
    } else {
      const float z = bf2f(bz);
      const float e = __expf(-z);
      const float sg = frcp(1.f + e);
      kval = (1.f - lb) * e * sg;
      g = 1.f - kval;
      qval = bf2f(a) * 0.08838834764831845f;
    }
  }
  __device__ __forceinline__ void eval(const bf16* row, float& g, float& kval, float& qval) const {
    if (MODE == 0) {
      uint4 u0 = *(const uint4*)(row + 3584 + d * 16);
      uint4 u1 = *(const uint4*)(row + 3584 + d * 16 + 8);
      float z = bias;
      z += w[0] * __uint_as_float(u0.x << 16) + w[1] * __uint_as_float(u0.x & 0xffff0000u);
      z += w[2] * __uint_as_float(u0.y << 16) + w[3] * __uint_as_float(u0.y & 0xffff0000u);
      z += w[4] * __uint_as_float(u0.z << 16) + w[5] * __uint_as_float(u0.z & 0xffff0000u);
      z += w[6] * __uint_as_float(u0.w << 16) + w[7] * __uint_as_float(u0.w & 0xffff0000u);
      z += w[8] * __uint_as_float(u1.x << 16) + w[9] * __uint_as_float(u1.x & 0xffff0000u);
      z += w[10] * __uint_as_float(u1.y << 16) + w[11] * __uint_as_float(u1.y & 0xffff0000u);
      z += w[12] * __uint_as_float(u1.z << 16) + w[13] * __uint_as_float(u1.z & 0xffff0000u);
      z += w[14] * __uint_as_float(u1.w << 16) + w[15] * __uint_as_float(u1.w & 0xffff0000u);
      g = log_sigmoid_f(z) * (1.f / 16.f);
      kval = bf2f(row[2304 + ch]);
      qval = bf2f(row[2048 + ch]) * 0.125f;
    } else {
      const float z = bf2f(row[512 + d * 512 + ch]);
      const float e = __expf(-z);
      const float sg = frcp(1.f + e);
      kval = (1.f - lb) * e * sg;
      g = flog(1.f - kval);
      qval = bf2f(row[ch]) * 0.08838834764831845f;
    }
  }
};

template <int MODE>
__device__ __forceinline__ void stage_vt(const bf16* proj, int h, bf16* VT) {
  constexpr int LDP = MODE == 0 ? EVEN_N : ODD_N;
  constexpr int VOFF = MODE == 0 ? 2560 : 1536;
  const int j = threadIdx.x & 63, cgp = threadIdx.x >> 6;
#pragma unroll
  for (int cc = 0; cc < 4; ++cc) {
    const int c = cgp * 4 + cc;
    uint4 u = *(const uint4*)(proj + (size_t)j * LDP + VOFF + h * 128 + c * 8);
    bf16* dst = VT + (c * 8) * 72 + j;
    dst[0 * 72] = (bf16)(u.x & 0xffffu); dst[1 * 72] = (bf16)(u.x >> 16);
    dst[2 * 72] = (bf16)(u.y & 0xffffu); dst[3 * 72] = (bf16)(u.y >> 16);
    dst[4 * 72] = (bf16)(u.z & 0xffffu); dst[5 * 72] = (bf16)(u.z >> 16);
    dst[6 * 72] = (bf16)(u.w & 0xffffu); dst[7 * 72] = (bf16)(u.w >> 16);
  }
}

__device__ __forceinline__ uint2 pack4(f32x4 a) {
  uint2 o;
  o.x = (unsigned)f2bf(a[0]) | ((unsigned)f2bf(a[1]) << 16);
  o.y = (unsigned)f2bf(a[2]) | ((unsigned)f2bf(a[3]) << 16);
  return o;
}

template <int K, int MODE>
__device__ __forceinline__ void rec_pass1_item(const P& p, int item, unsigned char* smem) {
  constexpr int LDP = MODE == 0 ? EVEN_N : ODD_N;
  const int h = item & 3, blk = (item >> 2) & 63, b = item >> 8;
  bf16* KT = (bf16*)smem;
  bf16* VT = KT + 2 * K * 72;
  const bf16* proj = (const bf16*)(p.ws + WS_PROJ) + (size_t)(b * 4096 + blk * 64) * LDP;
  bf16* ST = (bf16*)(p.ws + WS_ST);
  float* DEC = (float*)(p.ws + WS_DEC);
  const int tid = threadIdx.x, lane = tid & 63, wave = tid >> 6;
  bf16* TMP = VT;
  if (MODE == 1) {
#pragma unroll
    for (int i = 0; i < 8; ++i) {
      const int c = i * 256 + tid;
      const int ch = c & 15, j = (c >> 4) & 63, d = c >> 10;
      *(uint4*)(TMP + (d * 64 + j) * 128 + ch * 8) = *(const uint4*)(proj + (size_t)j * LDP + 512 + d * 512 + h * 128 + ch * 8);
    }
  } else {
#pragma unroll
    for (int i = 0; i < 2; ++i) {
      const int c = i * 256 + tid;
      const int ch = c & 7, j = c >> 3;
      *(uint4*)(TMP + j * 64 + ch * 8) = *(const uint4*)(proj + (size_t)j * LDP + 2304 + h * 64 + ch * 8);
    }
    {
      const int ch = tid & 3, j = tid >> 2;
      *(uint4*)(TMP + 4096 + j * 32 + ch * 8) = *(const uint4*)(proj + (size_t)j * LDP + 3584 + ch * 8);
    }
  }
  __syncthreads();
  if (tid < 2 * K) {
    const int d = tid / K, k = tid % K;
    GateC<K, MODE> gc;
    gc.init(p, d, h, k);
    bf16* row = KT + (d * K + k) * 72;
    float r = MODE == 1 ? 1.f : 0.f, rhi = r;
#pragma unroll 4
    for (int i = 63; i >= 0; --i) {
      const int j = d ? 63 - i : i;
      float g, kv, qv;
      if (MODE == 1) {
        gc.eval_vals(0, TMP[(d * 64 + j) * 128 + k], nullptr, g, kv, qv);
        row[j] = f2bf(kv * r);
        r *= g;
      } else {
        gc.eval_vals(0, TMP[j * 64 + k], TMP + 4096 + j * 32 + d * 16, g, kv, qv);
        row[j] = f2bf(kv * __expf(r));
        r += g;
      }
      if (i == 32) rhi = r;
    }
    DEC[(size_t)((((d * 4 + b) * 4 + h) * 64 + blk)) * K + k] = MODE == 1 ? r : __expf(r);
    ((float*)(p.ws + WS_CMID))[(size_t)((((d * 4 + b) * 4 + h) * 64 + blk)) * K + k] = MODE == 1 ? r * frcp(rhi) : __expf(r - rhi);
  }
  __syncthreads();
  stage_vt<MODE>(proj, h, VT);
  __syncthreads();
#pragma unroll 1
  for (int d = 0; d < 2; ++d) {
    f32x4 acc[K / 16][2];
#pragma unroll
    for (int kt = 0; kt < K / 16; ++kt) { acc[kt][0] = (f32x4){0.f, 0.f, 0.f, 0.f}; acc[kt][1] = (f32x4){0.f, 0.f, 0.f, 0.f}; }
#pragma unroll
    for (int ks = 0; ks < 2; ++ks) {
      bf16x8 vf0 = *(const bf16x8*)(VT + ((wave * 2 + 0) * 16 + (lane & 15)) * 72 + ks * 32 + (lane >> 4) * 8);
      bf16x8 vf1 = *(const bf16x8*)(VT + ((wave * 2 + 1) * 16 + (lane & 15)) * 72 + ks * 32 + (lane >> 4) * 8);
#pragma unroll
      for (int kt = 0; kt < K / 16; ++kt) {
        bf16x8 kf = *(const bf16x8*)(KT + (d * K + kt * 16 + (lane & 15)) * 72 + ks * 32 + (lane >> 4) * 8);
        acc[kt][0] = __builtin_amdgcn_mfma_f32_16x16x32_bf16(kf, vf0, acc[kt][0], 0, 0, 0);
        acc[kt][1] = __builtin_amdgcn_mfma_f32_16x16x32_bf16(kf, vf1, acc[kt][1], 0, 0, 0);
      }
    }
    bf16* stb = ST + (size_t)((((d * 4 + b) * 4 + h) * 64 + blk)) * 128 * K;
#pragma unroll
    for (int kt = 0; kt < K / 16; ++kt)
#pragma unroll
      for (int vv = 0; vv < 2; ++vv) {
        const int v = (wave * 2 + vv) * 16 + (lane & 15);
        const int k0 = kt * 16 + (lane >> 4) * 4;
        *(uint2*)(stb + (size_t)v * K + k0) = pack4(acc[kt][vv]);
      }
  }
}

template <int K>
__device__ __forceinline__ void phase_rec_scan(const P& p) {
  bf16* ST = (bf16*)(p.ws + WS_ST);
  const float* DEC = (const float*)(p.ws + WS_DEC);
  const float* CMID = (const float*)(p.ws + WS_CMID);
  constexpr int KV = K / 4;
  const int total = 32 * 128 * KV;
  for (int idx = blockIdx.x * 256 + threadIdx.x; idx < total; idx += gridDim.x * 256) {
    const int kq = idx % KV, v = (idx / KV) & 127, s = idx / (KV * 128);
    const int d = s >> 4;
    float st0 = 0.f, st1 = 0.f, st2 = 0.f, st3 = 0.f;
#pragma unroll 1
    for (int n0 = 0; n0 < 64; n0 += 8) {
      uint2 u[8];
      float4 dc[8], cm[8];
#pragma unroll
      for (int q = 0; q < 8; ++q) {
        const int blk = d ? 63 - (n0 + q) : (n0 + q);
        u[q] = *(const uint2*)(ST + ((size_t)(s * 64 + blk) * 128 + v) * K + kq * 4);
        dc[q] = *(const float4*)(DEC + (size_t)(s * 64 + blk) * K + kq * 4);
        cm[q] = *(const float4*)(CMID + (size_t)(s * 64 + blk) * K + kq * 4);
      }
#pragma unroll
      for (int q = 0; q < 8; ++q) {
        const int blk = d ? 63 - (n0 + q) : (n0 + q);
        uint2 o;
        o.x = (unsigned)f2bf(st0 * cm[q].x) | ((unsigned)f2bf(st1 * cm[q].y) << 16);
        o.y = (unsigned)f2bf(st2 * cm[q].z) | ((unsigned)f2bf(st3 * cm[q].w) << 16);
        *(uint2*)(ST + ((size_t)(s * 64 + blk) * 128 + v) * K + kq * 4) = o;
        st0 = dc[q].x * st0 + __uint_as_float(u[q].x << 16);
        st1 = dc[q].y * st1 + __uint_as_float(u[q].x & 0xffff0000u);
        st2 = dc[q].z * st2 + __uint_as_float(u[q].y << 16);
        st3 = dc[q].w * st3 + __uint_as_float(u[q].y & 0xffff0000u);
      }
    }
  }
}

template <int K, int MODE>
__device__ __forceinline__ void rec_pass3_item(const P& p, int item, unsigned char* smem) {
  constexpr int LDP = MODE == 0 ? EVEN_N : ODD_N;
  constexpr int KS = K + 8;
  constexpr int GOFF = MODE == 0 ? 3072 : 2048;
  constexpr int YOFF = MODE == 0 ? 512 : 0;
  const int h = item & 3, blk = (item >> 2) & 63, b = item >> 8;
  bf16* QI = (bf16*)smem;
  bf16* KI = QI + 64 * KS;
  bf16* VT = KI + 64 * KS;
  bf16* AI = VT + 128 * 72;
  float* CV = (float*)(AI + 64 * 72);
  float* SSQ = CV + K;
  bf16* LRB = (bf16*)(SSQ + 256);
  const bf16* proj = (const bf16*)(p.ws + WS_PROJ) + (size_t)(b * 4096 + blk * 64) * LDP;
  const bf16* ST = (const bf16*)(p.ws + WS_ST);
  bf16* yb = (bf16*)(p.ws + WS_H);
  const int tid = threadIdx.x, lane = tid & 63, wave = tid >> 6;
  constexpr int VOFF = MODE == 0 ? 2560 : 1536;
  constexpr int QOFF = MODE == 0 ? 2048 : 0;
  constexpr int NQ = K / 32;
  u32x4 rvt[4], rq[4], rz[2][4], rlr[2], stf[2][4][2];
  {
    const int j = tid & 63, cgp = tid >> 6;
#pragma unroll
    for (int cc = 0; cc < 4; ++cc) rvt[cc] = gload16_asm(proj + (size_t)j * LDP + VOFF + h * 128 + (cgp * 4 + cc) * 8);
  }
#pragma unroll
  for (int i = 0; i < NQ; ++i) {
    const int c = i * 256 + tid, ch = c % (K / 8), j = c / (K / 8);
    rq[i] = gload16_asm(proj + (size_t)j * LDP + QOFF + h * K + ch * 8);
    rz[0][i] = gload16_asm(proj + (size_t)j * LDP + (MODE == 0 ? 2304 : 512) + h * K + ch * 8);
  }
  if (MODE == 0) {
    const int ch = tid & 1, j = (tid >> 1) & 63;
    rlr[0] = gload16_asm(proj + (size_t)j * LDP + 3584 + ch * 8);
    rlr[1] = gload16_asm(proj + (size_t)j * LDP + 3600 + ch * 8);
  }
  {
    const bf16* stb = ST + (size_t)((((0 * 4 + b) * 4 + h) * 64 + blk)) * 128 * K;
#pragma unroll
    for (int ks = 0; ks < NQ; ++ks)
#pragma unroll
      for (int vv = 0; vv < 2; ++vv)
        stf[0][ks][vv] = gload16_asm(stb + (size_t)((wave * 2 + vv) * 16 + (lane & 15)) * K + ks * 32 + (lane >> 4) * 8);
  }
  if (MODE == 1) {
    asm volatile("s_waitcnt vmcnt(8)"
                 : "+v"(rvt[0]), "+v"(rvt[1]), "+v"(rvt[2]), "+v"(rvt[3]), "+v"(rq[0]), "+v"(rq[1]), "+v"(rq[2]), "+v"(rq[3]),
                   "+v"(rz[0][0]), "+v"(rz[0][1]), "+v"(rz[0][2]), "+v"(rz[0][3])
                 :: "memory");
  } else {
    asm volatile("s_waitcnt vmcnt(4)"
                 : "+v"(rvt[0]), "+v"(rvt[1]), "+v"(rvt[2]), "+v"(rvt[3]), "+v"(rq[0]), "+v"(rq[1]), "+v"(rz[0][0]), "+v"(rz[0][1]), "+v"(rlr[0]), "+v"(rlr[1])
                 :: "memory");
  }
  {
    const int j = tid & 63, cgp = tid >> 6;
#pragma unroll
    for (int cc = 0; cc < 4; ++cc) {
      const u32x4 u = rvt[cc];
      bf16* dst = VT + ((cgp * 4 + cc) * 8) * 72 + j;
      dst[0 * 72] = (bf16)(u[0] & 0xffffu); dst[1 * 72] = (bf16)(u[0] >> 16);
      dst[2 * 72] = (bf16)(u[1] & 0xffffu); dst[3 * 72] = (bf16)(u[1] >> 16);
      dst[4 * 72] = (bf16)(u[2] & 0xffffu); dst[5 * 72] = (bf16)(u[2] >> 16);
      dst[6 * 72] = (bf16)(u[3] & 0xffffu); dst[7 * 72] = (bf16)(u[3] >> 16);
    }
  }
  f32x4 o[2][4];
#pragma unroll
  for (int vv = 0; vv < 2; ++vv)
#pragma unroll
    for (int it = 0; it < 4; ++it) o[vv][it] = (f32x4){0.f, 0.f, 0.f, 0.f};
#pragma unroll
  for (int d = 0; d < 2; ++d) {
    if (d) __syncthreads();
    if (MODE == 1 && d == 1) {
      asm volatile("s_waitcnt vmcnt(0)" : "+v"(rz[1][0]), "+v"(rz[1][1]), "+v"(rz[1][2]), "+v"(rz[1][3]) :: "memory");
    }
#pragma unroll
    for (int i = 0; i < NQ; ++i) {
      const int c = i * 256 + tid, ch = c % (K / 8), j = c / (K / 8);
      *(u32x4*)(QI + j * KS + ch * 8) = rq[i];
      *(u32x4*)(KI + j * KS + ch * 8) = rz[MODE == 1 ? d : 0][i];
    }
    if (d == 1) {
      const bf16* stb = ST + (size_t)((((1 * 4 + b) * 4 + h) * 64 + blk)) * 128 * K;
#pragma unroll
      for (int ks = 0; ks < NQ; ++ks)
#pragma unroll
        for (int vv = 0; vv < 2; ++vv)
          stf[1][ks][vv] = gload16_asm(stb + (size_t)((wave * 2 + vv) * 16 + (lane & 15)) * K + ks * 32 + (lane >> 4) * 8);
    }
    if (MODE == 1 && d == 0) {
#pragma unroll
      for (int i = 0; i < NQ; ++i) {
        const int c = i * 256 + tid, ch = c % (K / 8), j = c / (K / 8);
        rz[1][i] = gload16_asm(proj + (size_t)j * LDP + 1024 + h * K + ch * 8);
      }
    }
    if (MODE == 0 && tid < 128) {
      const int ch = tid & 1, j = tid >> 1;
      *(u32x4*)(LRB + j * 16 + ch * 8) = rlr[d];
    }
    __syncthreads();
    if (tid < 2 * K) {
      const int k = tid % K, half = tid / K;
      GateC<K, MODE> gc;
      gc.init(p, d, h, k);
      float run = MODE == 1 ? 1.f : 0.f;
      if (half) {
#pragma unroll 4
        for (int i = 32; i < 64; ++i) {
          const int j = d ? 63 - i : i;
          float g, kv, qv;
          gc.eval_vals(QI[j * KS + k], KI[j * KS + k], LRB + j * 16, g, kv, qv);
          if (MODE == 1) {
            run *= g;
            QI[j * KS + k] = f2bf(qv * run);
            KI[j * KS + k] = f2bf(kv * frcp(run));
          } else {
            run += g;
            QI[j * KS + k] = f2bf(qv * __expf(run));
            KI[j * KS + k] = f2bf(kv * __expf(-run));
          }
        }
      } else {
#pragma unroll 4
        for (int i = 31; i >= 0; --i) {
          const int j = d ? 63 - i : i;
          float g, kv, qv;
          gc.eval_vals(QI[j * KS + k], KI[j * KS + k], LRB + j * 16, g, kv, qv);
          if (MODE == 1) {
            QI[j * KS + k] = f2bf(qv * frcp(run));
            KI[j * KS + k] = f2bf(kv * run);
            run *= g;
          } else {
            QI[j * KS + k] = f2bf(qv * __expf(-run));
            KI[j * KS + k] = f2bf(kv * __expf(run));
            run += g;
          }
        }
        CV[k] = MODE == 1 ? run : __expf(run);
      }
    }
    __syncthreads();
    {
      f32x4 a[4];
#pragma unroll
      for (int jt = 0; jt < 4; ++jt) a[jt] = (f32x4){0.f, 0.f, 0.f, 0.f};
#pragma unroll
      for (int ks = 0; ks < K / 32; ++ks) {
        bf16x8 qf = *(const bf16x8*)(QI + (wave * 16 + (lane & 15)) * KS + ks * 32 + (lane >> 4) * 8);
#pragma unroll
        for (int jt = 0; jt < 4; ++jt) {
          bf16x8 kf = *(const bf16x8*)(KI + (jt * 16 + (lane & 15)) * KS + ks * 32 + (lane >> 4) * 8);
          a[jt] = __builtin_amdgcn_mfma_f32_16x16x32_bf16(kf, qf, a[jt], 0, 0, 0);
        }
      }
      const int i = wave * 16 + (lane & 15);
#pragma unroll
      for (int jt = 0; jt < 4; ++jt) {
        const int j0 = jt * 16 + (lane >> 4) * 4;
        f32x4 m;
#pragma unroll
        for (int r = 0; r < 4; ++r) {
          const int j = j0 + r;
          const bool valid = d ? (j >= i) : (j <= i);
          m[r] = valid ? a[jt][r] : 0.f;
        }
        *(uint2*)(AI + i * 72 + j0) = pack4(m);
      }
    }
    __syncthreads();
#pragma unroll
    for (int ks = 0; ks < 2; ++ks) {
      bf16x8 vf0 = *(const bf16x8*)(VT + ((wave * 2 + 0) * 16 + (lane & 15)) * 72 + ks * 32 + (lane >> 4) * 8);
      bf16x8 vf1 = *(const bf16x8*)(VT + ((wave * 2 + 1) * 16 + (lane & 15)) * 72 + ks * 32 + (lane >> 4) * 8);
#pragma unroll
      for (int it = 0; it < 4; ++it) {
        bf16x8 af = *(const bf16x8*)(AI + (it * 16 + (lane & 15)) * 72 + ks * 32 + (lane >> 4) * 8);
        o[0][it] = __builtin_amdgcn_mfma_f32_16x16x32_bf16(vf0, af, o[0][it], 0, 0, 0);
        o[1][it] = __builtin_amdgcn_mfma_f32_16x16x32_bf16(vf1, af, o[1][it], 0, 0, 0);
      }
    }
    if (d == 0) {
      if (K == 128) {
        asm volatile("s_waitcnt vmcnt(4)"
                     : "+v"(stf[0][0][0]), "+v"(stf[0][0][1]), "+v"(stf[0][1][0]), "+v"(stf[0][1][1]), "+v"(stf[0][2][0]), "+v"(stf[0][2][1]), "+v"(stf[0][3][0]), "+v"(stf[0][3][1])
                     :: "memory");
      } else {
        asm volatile("s_waitcnt vmcnt(0)" : "+v"(stf[0][0][0]), "+v"(stf[0][0][1]), "+v"(stf[0][1][0]), "+v"(stf[0][1][1]) :: "memory");
      }
    } else {
      if (K == 128) {
        asm volatile("s_waitcnt vmcnt(0)"
                     : "+v"(stf[1][0][0]), "+v"(stf[1][0][1]), "+v"(stf[1][1][0]), "+v"(stf[1][1][1]), "+v"(stf[1][2][0]), "+v"(stf[1][2][1]), "+v"(stf[1][3][0]), "+v"(stf[1][3][1])
                     :: "memory");
      } else {
        asm volatile("s_waitcnt vmcnt(0)" : "+v"(stf[1][0][0]), "+v"(stf[1][0][1]), "+v"(stf[1][1][0]), "+v"(stf[1][1][1]) :: "memory");
      }
    }
#pragma unroll
    for (int ks = 0; ks < K / 32; ++ks) {
      const int kk = ks * 32 + (lane >> 4) * 8;
      bf16x8 sf[2];
      sf[0] = *(bf16x8*)&stf[d][ks][0];
      sf[1] = *(bf16x8*)&stf[d][ks][1];
#pragma unroll
      for (int it = 0; it < 4; ++it) {
        bf16x8 qf = *(const bf16x8*)(QI + (it * 16 + (lane & 15)) * KS + kk);
        o[0][it] = __builtin_amdgcn_mfma_f32_16x16x32_bf16(sf[0], qf, o[0][it], 0, 0, 0);
        o[1][it] = __builtin_amdgcn_mfma_f32_16x16x32_bf16(sf[1], qf, o[1][it], 0, 0, 0);
      }
    }
  }
  {
    float ss[4];
#pragma unroll
    for (int it = 0; it < 4; ++it) {
      float s = 0.f;
#pragma unroll
      for (int vv = 0; vv < 2; ++vv)
#pragma unroll
        for (int r = 0; r < 4; ++r) s += o[vv][it][r] * o[vv][it][r];
      s += __shfl_xor(s, 16, 64);
      s += __shfl_xor(s, 32, 64);
      ss[it] = s;
    }
    if (lane < 16) {
#pragma unroll
      for (int it = 0; it < 4; ++it) SSQ[wave * 64 + it * 16 + lane] = ss[it];
    }
    __syncthreads();
    const float* gn = MODE == 0 ? p.gla_g : p.hgrn_g;
#pragma unroll
    for (int it = 0; it < 4; ++it) {
      const int i = it * 16 + (lane & 15);
      const float tot = SSQ[i] + SSQ[64 + i] + SSQ[128 + i] + SSQ[192 + i];
      const float rs = rsqrtf(tot * (1.f / 128.f) + 1e-6f);
#pragma unroll
      for (int vv = 0; vv < 2; ++vv) {
        const int v0 = (wave * 2 + vv) * 16 + (lane >> 4) * 4;
        uint2 gu = *(const uint2*)(proj + (size_t)i * LDP + GOFF + h * 128 + v0);
        float4 gg = *(const float4*)(gn + v0);
        f32x4 y;
        y[0] = o[vv][it][0] * rs * gg.x * silu_f(__uint_as_float(gu.x << 16));
        y[1] = o[vv][it][1] * rs * gg.y * silu_f(__uint_as_float(gu.x & 0xffff0000u));
        y[2] = o[vv][it][2] * rs * gg.z * silu_f(__uint_as_float(gu.y << 16));
        y[3] = o[vv][it][3] * rs * gg.w * silu_f(__uint_as_float(gu.y & 0xffff0000u));
        if (MODE == 1) *(uint2*)((bf16*)proj + (size_t)i * LDP + GOFF + h * 128 + v0) = pack4(y);
        else *(uint2*)(yb + (size_t)(b * 4096 + blk * 64 + i) * 1024 + YOFF + h * 128 + v0) = pack4(y);
      }
    }
  }
}

__device__ __forceinline__ void conv8(const P& p, const bf16* projb, int t, int c0, float* o8) {
  c0 = __builtin_amdgcn_readfirstlane(c0);
  float4 b0 = *(const float4*)(p.conv_b + c0), b1 = *(const float4*)(p.conv_b + c0 + 4);
  float a[8] = {b0.x, b0.y, b0.z, b0.w, b1.x, b1.y, b1.z, b1.w};
#pragma unroll
  for (int jt = 0; jt < 4; ++jt) {
    const int tt = t + jt - 2;
    if (tt >= 0 && tt < 4096) {
      uint4 u = *(const uint4*)(projb + (size_t)tt * ODD_N + 3072 + c0);
      float4 w0 = *(const float4*)(p.conv_w + jt * 1024 + c0), w1 = *(const float4*)(p.conv_w + jt * 1024 + c0 + 4);
      a[0] += w0.x * __uint_as_float(u.x << 16); a[1] += w0.y * __uint_as_float(u.x & 0xffff0000u);
      a[2] += w0.z * __uint_as_float(u.y << 16); a[3] += w0.w * __uint_as_float(u.y & 0xffff0000u);
      a[4] += w1.x * __uint_as_float(u.z << 16); a[5] += w1.y * __uint_as_float(u.z & 0xffff0000u);
      a[6] += w1.z * __uint_as_float(u.w << 16); a[7] += w1.w * __uint_as_float(u.w & 0xffff0000u);
    }
  }
#pragma unroll
  for (int e = 0; e < 8; ++e) o8[e] = silu_f(a[e]);
}

__device__ __forceinline__ void conv8u(const P& p, const bf16* projb, int t, int c0, float* o8) {
  c0 = __builtin_amdgcn_readfirstlane(c0);
  float4 b0 = *(const float4*)(p.conv_b + c0), b1 = *(const float4*)(p.conv_b + c0 + 4);
  float a[8] = {b0.x, b0.y, b0.z, b0.w, b1.x, b1.y, b1.z, b1.w};
  uint4 u[4];
#pragma unroll
  for (int jt = 0; jt < 4; ++jt) {
    int tt = t + jt - 2;
    tt = tt < 0 ? 0 : (tt > 4095 ? 4095 : tt);
    u[jt] = *(const uint4*)(projb + (size_t)tt * ODD_N + 3072 + c0);
  }
#pragma unroll
  for (int jt = 0; jt < 4; ++jt) {
    const int tt = t + jt - 2;
    const float ok = (tt >= 0 && tt < 4096) ? 1.f : 0.f;
    float4 w0 = *(const float4*)(p.conv_w + jt * 1024 + c0), w1 = *(const float4*)(p.conv_w + jt * 1024 + c0 + 4);
    a[0] += ok * w0.x * __uint_as_float(u[jt].x << 16); a[1] += ok * w0.y * __uint_as_float(u[jt].x & 0xffff0000u);
    a[2] += ok * w0.z * __uint_as_float(u[jt].y << 16); a[3] += ok * w0.w * __uint_as_float(u[jt].y & 0xffff0000u);
    a[4] += ok * w1.x * __uint_as_float(u[jt].z << 16); a[5] += ok * w1.y * __uint_as_float(u[jt].z & 0xffff0000u);
    a[6] += ok * w1.z * __uint_as_float(u[jt].w << 16); a[7] += ok * w1.w * __uint_as_float(u[jt].w & 0xffff0000u);
  }
#pragma unroll
  for (int e = 0; e < 8; ++e) o8[e] = silu_f(a[e]);
}

__device__ __forceinline__ void ssd_prep_acum(const P& p, const bf16* projb, int blk, int g, float* ACUM, float* DTV, float* TOT) {
  const int lane = threadIdx.x & 63, wave = threadIdx.x >> 6;
#pragma unroll
  for (int q = 0; q < 2; ++q) {
    const int c = wave * 2 + q, dir = c >> 2, rp = c & 3, head = g * 4 + rp;
    const int j = dir ? 63 - lane : lane;
    const int t = blk * 64 + j;
    const float dt = softplus_f(bf2f(projb[(size_t)t * ODD_N + 4096 + dir * 8 + head]) + p.dt_bias[dir * 8 + head]);
    float v = -__expf(p.a_log[dir * 8 + head]) * dt;
#pragma unroll
    for (int off = 1; off < 64; off <<= 1) {
      float tmp = __shfl_up(v, off, 64);
      if (lane >= off) v += tmp;
    }
    ACUM[c * 64 + j] = v;
    DTV[c * 64 + j] = dt;
    if (lane == 63) TOT[c] = v;
  }
}

__device__ __forceinline__ bf16* ssd_st(const P& p, int s) {
  return s < 32 ? (bf16*)(p.ws + WS_H) + (size_t)s * 524288 : (bf16*)((unsigned char*)p.out + 33554432) + (size_t)(s - 32) * 524288;
}
__device__ __forceinline__ void ssd_pass1_item(const P& p, int item, unsigned char* smem) {
  const int g = item & 1, blk = (item >> 1) & 63, b = item >> 7;
  bf16* BT = (bf16*)smem;
  bf16* XT = BT + 128 * 72;
  float* ACUM = (float*)(XT + 256 * 72);
  float* DTV = ACUM + 512;
  float* TOT = DTV + 512;
  const bf16* projb = (const bf16*)(p.ws + WS_PROJ) + (size_t)b * 4096 * ODD_N;
  float* DEC = (float*)(p.ws + WS_DECS);
  const int tid = threadIdx.x, lane = tid & 63, wave = tid >> 6;
  const int t = blk * 64 + lane;
  ssd_prep_acum(p, projb, blk, g, ACUM, DTV, TOT);
#pragma unroll 2
  for (int q = 0; q < 4; ++q) {
    const int cc = wave + 4 * q;
    float v8[8];
    conv8(p, projb, t, 512 + g * 128 + cc * 8, v8);
#pragma unroll
    for (int e = 0; e < 8; ++e) BT[(cc * 8 + e) * 72 + lane] = f2bf(v8[e]);
  }
  float xs[8][8];
#pragma unroll
  for (int q = 0; q < 8; ++q) conv8(p, projb, t, g * 256 + (wave * 8 + q) * 8, xs[q]);
  __syncthreads();
  if (tid < 8) {
    const int dir = tid >> 2, head = g * 4 + (tid & 3);
    DEC[(size_t)((dir * 4 + b) * 8 + head) * 64 + blk] = __expf(TOT[tid]);
  }
#pragma unroll 1
  for (int dir = 0; dir < 2; ++dir) {
    if (dir) __syncthreads();
    const int c = dir * 4 + wave;
    const float fac = DTV[c * 64 + lane] * __expf(TOT[c] - ACUM[c * 64 + lane]);
#pragma unroll
    for (int q = 0; q < 8; ++q)
#pragma unroll
      for (int e = 0; e < 8; ++e) XT[((wave * 8 + q) * 8 + e) * 72 + lane] = f2bf(xs[q][e] * fac);
    __syncthreads();
    const int head = g * 4 + wave;
    bf16* stb = ssd_st(p, (dir * 4 + b) * 8 + head) + (size_t)blk * 8192;
#pragma unroll 1
    for (int nh = 0; nh < 4; ++nh) {
      f32x4 acc[2][4];
#pragma unroll
      for (int nt = 0; nt < 2; ++nt)
#pragma unroll
        for (int pt = 0; pt < 4; ++pt) acc[nt][pt] = (f32x4){0.f, 0.f, 0.f, 0.f};
#pragma unroll
      for (int ks = 0; ks < 2; ++ks) {
        bf16x8 xf[4];
#pragma unroll
        for (int pt = 0; pt < 4; ++pt) xf[pt] = *(const bf16x8*)(XT + (wave * 64 + pt * 16 + (lane & 15)) * 72 + ks * 32 + (lane >> 4) * 8);
#pragma unroll
        for (int nt = 0; nt < 2; ++nt) {
          bf16x8 bfv = *(const bf16x8*)(BT + ((nh * 2 + nt) * 16 + (lane & 15)) * 72 + ks * 32 + (lane >> 4) * 8);
#pragma unroll
          for (int pt = 0; pt < 4; ++pt) acc[nt][pt] = __builtin_amdgcn_mfma_f32_16x16x32_bf16(bfv, xf[pt], acc[nt][pt], 0, 0, 0);
        }
      }
#pragma unroll
      for (int nt = 0; nt < 2; ++nt)
#pragma unroll
        for (int pt = 0; pt < 4; ++pt) {
          const int pp = pt * 16 + (lane & 15);
          const int n0 = (nh * 2 + nt) * 16 + (lane >> 4) * 4;
          *(uint2*)(stb + (size_t)pp * 128 + n0) = pack4(acc[nt][pt]);
        }
    }
  }
}

__device__ __forceinline__ void phase_ssd_scan(const P& p) {
  const float* DEC = (const float*)(p.ws + WS_DECS);
  const int total = 64 * 2048;
  for (int idx = blockIdx.x * 256 + threadIdx.x; idx < total; idx += gridDim.x * 256) {
    const int e4 = idx & 2047, s = idx >> 11;
    const int d = s >> 5;
    bf16* ST = ssd_st(p, s);
    float st0 = 0.f, st1 = 0.f, st2 = 0.f, st3 = 0.f;
#pragma unroll 1
    for (int n0 = 0; n0 < 64; n0 += 8) {
      uint2 u[8];
      float dc[8];
#pragma unroll
      for (int q = 0; q < 8; ++q) {
        const int blk = d ? 63 - (n0 + q) : (n0 + q);
        u[q] = *(const uint2*)(ST + (size_t)blk * 8192 + e4 * 4);
        dc[q] = DEC[s * 64 + blk];
      }
#pragma unroll
      for (int q = 0; q < 8; ++q) {
        const int blk = d ? 63 - (n0 + q) : (n0 + q);
        uint2 o;
        o.x = (unsigned)f2bf(st0) | ((unsigned)f2bf(st1) << 16);
        o.y = (unsigned)f2bf(st2) | ((unsigned)f2bf(st3) << 16);
        *(uint2*)(ST + (size_t)blk * 8192 + e4 * 4) = o;
        st0 = dc[q] * st0 + __uint_as_float(u[q].x << 16);
        st1 = dc[q] * st1 + __uint_as_float(u[q].x & 0xffff0000u);
        st2 = dc[q] * st2 + __uint_as_float(u[q].y << 16);
        st3 = dc[q] * st3 + __uint_as_float(u[q].y & 0xffff0000u);
      }
    }
  }
}

__device__ __forceinline__ void ssd_pass3_item(const P& p, int item, unsigned char* smem) {
  const int g = item & 1, blk = (item >> 1) & 63, b = item >> 7;
  bf16* CI = (bf16*)smem;
  bf16* BI = CI + 64 * 136;
  bf16* AI = BI;
  bf16* XT = BI + 64 * 136;
  float* ACUM = (float*)(XT + 64 * 72);
  float* DTV = ACUM + 512;
  float* TOT = DTV + 512;
  float* SSQ = TOT + 8;
  bf16* projb = (bf16*)(p.ws + WS_PROJ) + (size_t)b * 4096 * ODD_N;
  const int tid = threadIdx.x, lane = tid & 63, wave = tid >> 6;
  const int t = blk * 64 + lane;
  ssd_prep_acum(p, projb, blk, g, ACUM, DTV, TOT);
#pragma unroll 4
  for (int q = 0; q < 8; ++q) {
    const int cc = wave * 8 + q, which = cc >> 4, ch = (cc & 15) * 8;
    float v8[8];
    conv8u(p, projb, t, 512 + which * 256 + g * 128 + ch, v8);
    uint4 w;
    w.x = (unsigned)f2bf(v8[0]) | ((unsigned)f2bf(v8[1]) << 16);
    w.y = (unsigned)f2bf(v8[2]) | ((unsigned)f2bf(v8[3]) << 16);
    w.z = (unsigned)f2bf(v8[4]) | ((unsigned)f2bf(v8[5]) << 16);
    w.w = (unsigned)f2bf(v8[6]) | ((unsigned)f2bf(v8[7]) << 16);
    *(uint4*)((which ? CI : BI) + lane * 136 + ch) = w;
  }
  __syncthreads();
  f32x4 gt[4];
#pragma unroll
  for (int jt = 0; jt < 4; ++jt) gt[jt] = (f32x4){0.f, 0.f, 0.f, 0.f};
#pragma unroll
  for (int ks = 0; ks < 4; ++ks) {
    bf16x8 cf = *(const bf16x8*)(CI + (wave * 16 + (lane & 15)) * 136 + ks * 32 + (lane >> 4) * 8);
#pragma unroll
    for (int jt = 0; jt < 4; ++jt) {
      bf16x8 bfv = *(const bf16x8*)(BI + (jt * 16 + (lane & 15)) * 136 + ks * 32 + (lane >> 4) * 8);
      gt[jt] = __builtin_amdgcn_mfma_f32_16x16x32_bf16(bfv, cf, gt[jt], 0, 0, 0);
    }
  }
  __syncthreads();
  float ssq_acc[4] = {0.f, 0.f, 0.f, 0.f};
#pragma unroll 1
  for (int rp = 0; rp < 4; ++rp) {
    const int head = g * 4 + rp;
    u32x4 stf[2][4];
    u32x2 zur[4];
#pragma unroll
    for (int dir = 0; dir < 2; ++dir) {
      const bf16* stb = ssd_st(p, (dir * 4 + b) * 8 + head) + (size_t)blk * 8192;
#pragma unroll
      for (int ks = 0; ks < 4; ++ks) stf[dir][ks] = gload16_asm(stb + (size_t)(wave * 16 + (lane & 15)) * 128 + ks * 32 + (lane >> 4) * 8);
    }
#pragma unroll
    for (int it = 0; it < 4; ++it)
      zur[it] = gload8_asm(projb + (size_t)(blk * 64 + it * 16 + (lane & 15)) * ODD_N + 2560 + head * 64 + wave * 16 + (lane >> 4) * 4);
#pragma unroll 2
    for (int q = 0; q < 2; ++q) {
      const int cc = wave * 2 + q;
      float v8[8];
      conv8u(p, projb, t, head * 64 + cc * 8, v8);
#pragma unroll
      for (int e = 0; e < 8; ++e) XT[(cc * 8 + e) * 72 + lane] = f2bf(v8[e]);
    }
    f32x4 o[4];
#pragma unroll
    for (int it = 0; it < 4; ++it) o[it] = (f32x4){0.f, 0.f, 0.f, 0.f};
#pragma unroll
    for (int dir = 0; dir < 2; ++dir) {
      const int c = dir * 4 + rp;
      {
        const int i = wave * 16 + (lane & 15);
        const float aci = ACUM[c * 64 + i];
#pragma unroll
        for (int jt = 0; jt < 4; ++jt) {
          const int j0 = jt * 16 + (lane >> 4) * 4;
          f32x4 m;
#pragma unroll
          for (int r = 0; r < 4; ++r) {
            const int j = j0 + r;
            const bool valid = dir ? (j >= i) : (j <= i);
            const float arg = fminf(aci - ACUM[c * 64 + j], 0.f);
            m[r] = valid ? gt[jt][r] * __expf(arg) * DTV[c * 64 + j] : 0.f;
          }
          *(uint2*)(AI + i * 72 + j0) = pack4(m);
        }
      }
      __syncthreads();
#pragma unroll
      for (int ks = 0; ks < 2; ++ks) {
        bf16x8 xf = *(const bf16x8*)(XT + (wave * 16 + (lane & 15)) * 72 + ks * 32 + (lane >> 4) * 8);
#pragma unroll
        for (int it = 0; it < 4; ++it) {
          bf16x8 af = *(const bf16x8*)(AI + (it * 16 + (lane & 15)) * 72 + ks * 32 + (lane >> 4) * 8);
          o[it] = __builtin_amdgcn_mfma_f32_16x16x32_bf16(xf, af, o[it], 0, 0, 0);
        }
      }
      f32x4 tI[4];
#pragma unroll
      for (int it = 0; it < 4; ++it) tI[it] = (f32x4){0.f, 0.f, 0.f, 0.f};
      asm volatile("s_waitcnt vmcnt(0)" : "+v"(stf[dir][0]), "+v"(stf[dir][1]), "+v"(stf[dir][2]), "+v"(stf[dir][3]) :: "memory");
#pragma unroll
      for (int ks = 0; ks < 4; ++ks) {
        bf16x8 sf = *(bf16x8*)&stf[dir][ks];
#pragma unroll
        for (int it = 0; it < 4; ++it) {
          bf16x8 cf = *(const bf16x8*)(CI + (it * 16 + (lane & 15)) * 136 + ks * 32 + (lane >> 4) * 8);
          tI[it] = __builtin_amdgcn_mfma_f32_16x16x32_bf16(sf, cf, tI[it], 0, 0, 0);
        }
      }
#pragma unroll
      for (int it = 0; it < 4; ++it) {
        const float ea = __expf(ACUM[c * 64 + it * 16 + (lane & 15)]);
#pragma unroll
        for (int r = 0; r < 4; ++r) o[it][r] += ea * tI[it][r];
      }
      __syncthreads();
    }
    {
      asm volatile("s_waitcnt vmcnt(0)" : "+v"(zur[0]), "+v"(zur[1]), "+v"(zur[2]), "+v"(zur[3]) :: "memory");
      const float dsk = p.d_skip[head];
      const int p0 = wave * 16 + (lane >> 4) * 4;
      float4 gg = *(const float4*)(p.ssm_g + head * 64 + p0);
#pragma unroll
      for (int it = 0; it < 4; ++it) {
        const int i = it * 16 + (lane & 15);
        uint2 zu; zu.x = zur[it][0]; zu.y = zur[it][1];
        f32x4 y;
        y[0] = (o[it][0] + dsk * bf2f(XT[(p0 + 0) * 72 + i])) * silu_f(__uint_as_float(zu.x << 16));
        y[1] = (o[it][1] + dsk * bf2f(XT[(p0 + 1) * 72 + i])) * silu_f(__uint_as_float(zu.x & 0xffff0000u));
        y[2] = (o[it][2] + dsk * bf2f(XT[(p0 + 2) * 72 + i])) * silu_f(__uint_as_float(zu.y << 16));
        y[3] = (o[it][3] + dsk * bf2f(XT[(p0 + 3) * 72 + i])) * silu_f(__uint_as_float(zu.y & 0xffff0000u));
        ssq_acc[it] += y[0] * y[0] + y[1] * y[1] + y[2] * y[2] + y[3] * y[3];
        y[0] *= gg.x; y[1] *= gg.y; y[2] *= gg.z; y[3] *= gg.w;
        *(uint2*)(projb + (size_t)(blk * 64 + i) * ODD_N + 2560 + head * 64 + p0) = pack4(y);
      }
    }
    __syncthreads();
  }
#pragma unroll
  for (int it = 0; it < 4; ++it) {
    float s = ssq_acc[it];
    s += __shfl_xor(s, 16, 64);
    s += __shfl_xor(s, 32, 64);
    if (lane < 16) SSQ[wave * 64 + it * 16 + lane] = s;
  }
  __syncthreads();
  if (tid < 64) {
    float* ssqp = (float*)(p.ws + WS_SSQ);
    ssqp[(size_t)g * M_TOK + (size_t)b * 4096 + blk * 64 + tid] = SSQ[tid] + SSQ[64 + tid] + SSQ[128 + tid] + SSQ[192 + tid];
  }
}

__device__ __forceinline__ void phase_ssd_norm(const P& p) {
  const float* ssqp = (const float*)(p.ws + WS_SSQ);
  bf16* yb = (bf16*)(p.ws + WS_H);
  const int total = M_TOK * 64;
  for (int idx = blockIdx.x * 256 + threadIdx.x; idx < total; idx += gridDim.x * 256) {
    const int tok = idx >> 6, c8 = (idx & 63) * 8;
    const float rs = rsqrtf((ssqp[tok] + ssqp[M_TOK + tok]) * (1.f / 512.f) + 1e-6f);
    uint4* ptr = (uint4*)(yb + (size_t)tok * 1024 + 512 + c8);
    uint4 u = *ptr, w;
    w.x = (unsigned)f2bf(__uint_as_float(u.x << 16) * rs) | ((unsigned)f2bf(__uint_as_float(u.x & 0xffff0000u) * rs) << 16);
    w.y = (unsigned)f2bf(__uint_as_float(u.y << 16) * rs) | ((unsigned)f2bf(__uint_as_float(u.y & 0xffff0000u) * rs) << 16);
    w.z = (unsigned)f2bf(__uint_as_float(u.z << 16) * rs) | ((unsigned)f2bf(__uint_as_float(u.z & 0xffff0000u) * rs) << 16);
    w.w = (unsigned)f2bf(__uint_as_float(u.w << 16) * rs) | ((unsigned)f2bf(__uint_as_float(u.w & 0xffff0000u) * rs) << 16);
    *ptr = w;
  }
}


#define XB_TMO      128
#define XB_XCNT(j)  (256  + 64 * (j))
#define XB_XSUB(j)  (1280 + 64 * (j))
#define XB_XGEN(j)  (2304 + 64 * (j))
#define XB_TOP      3328
#define XB_TOPGEN   3392
#define XCD_BAR_WORDS 3456
#define XB_SPIN_CAP (1u << 18)
#define LAS __attribute__((address_space(3)))
__device__ __forceinline__ unsigned xb_ld(unsigned* p) { return __hip_atomic_load(p, __ATOMIC_RELAXED, __HIP_MEMORY_SCOPE_AGENT); }
__device__ __forceinline__ unsigned xb_add(unsigned* p, unsigned v) { return __hip_atomic_fetch_add(p, v, __ATOMIC_RELAXED, __HIP_MEMORY_SCOPE_AGENT); }
__device__ __forceinline__ unsigned xb_xcc_id() { return (unsigned)__builtin_amdgcn_s_getreg((3 << 11) | 20) & 0xFu; }
#define XB_SPIN(cond, bar) do { unsigned _sp = 0; while (cond) { __builtin_amdgcn_s_sleep(1); \
    if ((++_sp & 255u) == 0u) { if (xb_ld(&(bar)[XB_TMO])) break; if (_sp > XB_SPIN_CAP) { atomicAdd(&(bar)[XB_TMO], 1u); break; } } } } while (0)
struct XcdBarrier { unsigned* bar; unsigned x; volatile LAS unsigned* st; };
__device__ __forceinline__ XcdBarrier xcd_barrier_post(unsigned* bar, volatile LAS unsigned* st) {
  XcdBarrier b; b.bar = bar; b.x = xb_xcc_id(); b.st = st;
  if (threadIdx.x == 0) (void)xb_add(&bar[XB_XCNT(b.x)], 1u);
  return b;
}
__device__ __forceinline__ void xcd_barrier_complete(unsigned* bar, unsigned x, unsigned& nloc, unsigned& nx) {
  const unsigned G = gridDim.x * gridDim.y * gridDim.z;
  unsigned sum, cnt, mine, sp = 0u;
  for (;;) {
    sum = 0u; cnt = 0u; mine = 0u;
#pragma unroll
    for (unsigned j = 0; j < 16; ++j) { const unsigned c = xb_ld(&bar[XB_XCNT(j)]); sum += c; cnt += (c > 0u) ? 1u : 0u; mine = (j == x) ? c : mine; }
    if (sum == G) break;
    __builtin_amdgcn_s_sleep(1);
    if ((++sp & 255u) == 0u) { if (xb_ld(&bar[XB_TMO])) break; if (sp > XB_SPIN_CAP) { atomicAdd(&bar[XB_TMO], 1u); break; } }
  }
  nloc = mine > 0u ? mine : 1u; nx = cnt > 0u ? cnt : 1u;
}
__device__ __forceinline__ void xcd_barrier(const XcdBarrier& b) {
  asm volatile("s_waitcnt vmcnt(0)" ::: "memory");
  __syncthreads();
  if (threadIdx.x == 0) {
    unsigned* bar = b.bar;
    __builtin_amdgcn_s_waitcnt(0);
    unsigned nloc = b.st[0], nx = b.st[1];
    if (nloc == 0u) { xcd_barrier_complete(bar, b.x, nloc, nx); b.st[0] = nloc; b.st[1] = nx; }
    const unsigned old = xb_add(&bar[XB_XSUB(b.x)], 1u);
    const unsigned gen = old / nloc;
    if (old + 1u == (gen + 1u) * nloc) {
      __builtin_amdgcn_fence(__ATOMIC_RELEASE, "agent");
      asm volatile("s_waitcnt vmcnt(0)" ::: "memory");
      const unsigned og = xb_add(&bar[XB_TOP], 1u);
      const unsigned tg = og / nx;
      if (og + 1u == (tg + 1u) * nx) xb_add(&bar[XB_TOPGEN], 1u);
      else XB_SPIN(xb_ld(&bar[XB_TOPGEN]) == tg, bar);
      __builtin_amdgcn_fence(__ATOMIC_ACQUIRE, "agent");
      xb_add(&bar[XB_XGEN(b.x)], 1u);
      asm volatile("s_waitcnt vmcnt(0)" ::: "memory");
    } else {
      XB_SPIN(xb_ld(&bar[XB_XGEN(b.x)]) == gen, bar);
      __builtin_amdgcn_fence(__ATOMIC_ACQUIRE, "agent");
      asm volatile("s_waitcnt vmcnt(0)" ::: "memory");
    }
  }
  __syncthreads();
}

#define NPHASE 14
__global__ void __launch_bounds__(256, 2) mega(P p, int ph_lo, int ph_hi) {
  __shared__ __align__(16) unsigned char smem[73728 + 16 + (PROBE_PH >= 0 ? 256 : 0)];
  cg::grid_group grid = cg::this_grid();
  if (ph_lo < 0) grid.sync();
  if (threadIdx.x == 0) *(uint4*)(smem + 73728) = make_uint4(0u, 0u, 0u, 0u);
  __syncthreads();
  XcdBarrier xb = xcd_barrier_post((unsigned*)(p.ws + WS_BAR), (volatile LAS unsigned*)(smem + 73728));
  const float* mod = (const float*)(p.ws + WS_MOD);
#define IN(k) (ph_lo <= (k) && (k) < ph_hi)
#define SYNC(k) if (IN(k) && (k) + 1 < ph_hi) { xcd_barrier(xb); if (PROBE_PH >= 0 && blockIdx.x == 0 && threadIdx.x == 0) ((long long*)(smem + 73744))[(k) + 1] = __builtin_amdgcn_s_memrealtime(); }
  if (PROBE_PH >= 0 && blockIdx.x == 0 && threadIdx.x == 0) ((long long*)(smem + 73744))[0] = __builtin_amdgcn_s_memrealtime();
  if (IN(0)) phase_setup(p, smem);
  SYNC(0)
  if (IN(1)) phase_h0(p);
  SYNC(1)
  if (IN(2))
    phase_gemm<0>((const bf16*)(p.ws + WS_H), 1024, (const bf16*)(p.ws + WS_WEI), EVEN_NP / 128, smem,
                  (bf16*)(p.ws + WS_PROJ), EVEN_N, EVEN_N, nullptr, nullptr, nullptr, (unsigned*)(p.ws + WS_BAR), 0);
  SYNC(2)
  if (IN(3)) {
    for (int it = blockIdx.x; it < 1024; it += gridDim.x) { rec_pass1_item<64, 0>(p, it, smem); __syncthreads(); }
  }
  SYNC(3)
  if (IN(4)) {
    phase_rec_scan<64>(p);
    for (int it = blockIdx.x; it < 2048 * REPN + 16 * 66 + 256; it += gridDim.x) {
      if (it < 2048 * REPN) na_item(p, it & 2047, smem);
      else if (it < 2048 * REPN + 16 * 66) transpose_item(p.o_w_in, ODD_N, (bf16*)(p.ws + WS_WOI), it - 2048 * REPN, smem);
      else transpose_item(p.o_w_out, 1024, (bf16*)(p.ws + WS_WOO), it - 2048 * REPN - 16 * 66, smem);
      __syncthreads();
    }
  }
  SYNC(4)
  if (IN(5)) {
    for (int it = blockIdx.x; it < 1024 * REPR; it += gridDim.x) { rec_pass3_item<64, 0>(p, it & 1023, smem); __syncthreads(); }
  }
  SYNC(5)
  if (IN(6))
    phase_gemm<1>((const bf16*)(p.ws + WS_H), 1024, (const bf16*)(p.ws + WS_WEO), 8, smem, nullptr, 0, 0, p.x, (float*)(p.ws + WS_ST),
                  mod + 2048, (unsigned*)(p.ws + WS_BAR), 1);
  SYNC(6)
  if (IN(7)) phase_ln(p, 0, true);
  SYNC(7)
  if (IN(8))
    phase_gemm<0>((const bf16*)(p.ws + WS_H), 1024, (const bf16*)(p.ws + WS_WOI), ODD_NP / 128, smem,
                  (bf16*)(p.ws + WS_PROJ), ODD_N, ODD_N, nullptr, nullptr, nullptr, (unsigned*)(p.ws + WS_BAR), 2);
  SYNC(8)
  if (IN(9)) {
    for (int it = blockIdx.x; it < 512 + 1024; it += gridDim.x) {
      if (it < 512) ssd_pass1_item(p, it, smem); else rec_pass1_item<128, 1>(p, it - 512, smem);
      __syncthreads();
    }
  }
  SYNC(9)
  if (IN(10)) { phase_rec_scan<128>(p); phase_ssd_scan(p); }
  SYNC(10)
  if (IN(11)) {
    for (int it = blockIdx.x; it < 512 + 1024; it += gridDim.x) {
      if (it < 512) ssd_pass3_item(p, it, smem); else rec_pass3_item<128, 1>(p, it - 512, smem);
      __syncthreads();
    }
  }
  SYNC(11)
  if (IN(12))
    phase_gemm<2>((const bf16*)(p.ws + WS_PROJ) + 2048, ODD_N, (const bf16*)(p.ws + WS_WOO), 8, smem, nullptr, 0, 0,
                  (const float*)p.out, (float*)(p.ws + WS_ST), mod + 4 * 3072 + 2048, (unsigned*)(p.ws + WS_BAR), 3,
                  (const float*)(p.ws + WS_SSQ));
  SYNC(12)
  if (IN(13)) phase_ln(p, 1, false, smem + 73744);
}

extern "C" void kernel_launch(void* const* d_in, const int* in_sizes, int n_in, void* d_out, int out_size, void* d_ws,
                              size_t ws_size, hipStream_t stream) {
  static int grid_blocks = 0;
  if (!grid_blocks) {
    int dev = 0, cus = 0, per_cu = 0;
    hipGetDevice(&dev);
    hipDeviceGetAttribute(&cus, hipDeviceAttributeMultiprocessorCount, dev);
    hipOccupancyMaxActiveBlocksPerMultiprocessor(&per_cu, mega, 256, 0);
    if (per_cu < 1) per_cu = 1;
    if (per_cu > 2) per_cu = 2;
    grid_blocks = cus * per_cu;
    if (n_in != 22 || ws_size < WS_END) {
      fprintf(stderr, "kernel_launch: unexpected n_in %d / ws_size %zu (need %llu)\n", n_in, ws_size, (unsigned long long)WS_END);
      grid_blocks = -1;
    }
  }
  if (grid_blocks < 0) return;
  P p{};
  const float** f = (const float**)&p;
  for (int i = 0; i < 22; ++i) f[i] = (const float*)d_in[i];
  p.out = (float*)d_out;
  p.ws = (unsigned char*)d_ws;
#if 1
  if (hipMemsetAsync((char*)d_ws + WS_BAR, 0, 16384, stream) != hipSuccess) { fprintf(stderr, "memset of barrier words failed\n"); return; }
  int lo = 0, hi = NPHASE;
  void* args[] = {&p, &lo, &hi};
  hipError_t e = hipLaunchCooperativeKernel((void*)mega, dim3(grid_blocks), dim3(256), args, 0, stream);
  if (e != hipSuccess) fprintf(stderr, "cooperative launch failed: %s (grid %d)\n", hipGetErrorString(e), grid_blocks);
#else
  for (int ph = 0; ph < NPHASE; ++ph) hipLaunchKernelGGL(mega, dim3(grid_blocks), dim3(256), 0, stream, p, ph, ph + 1);
#endif
}
```

```cpp
#include <hip/hip_runtime.h>
#include <hip/hip_cooperative_groups.h>
#include <cstdio>
namespace cg = cooperative_groups;

typedef unsigned short bf16;
using bf16x8 = __attribute__((ext_vector_type(8))) short;
using f32x4 = __attribute__((ext_vector_type(4))) float;

#define M_TOK 16384
#define DM 1024
#define SEQ 4096
#define EVEN_N 3616
#define EVEN_NP 3712
#define ODD_N 4112
#define ODD_NP 4224
#define ALPHA 1.4142135623730951f
#ifndef PROBE_PH
#define PROBE_PH -1
#endif
#ifndef REPG
#define REPG 1
#endif
#ifndef REPN
#define REPN 1
#endif
#ifndef REP3
#define REP3 1
#endif
#ifndef REPS
#define REPS 1
#endif
#ifndef REP0
#define REP0 1
#endif
#ifndef REPR
#define REPR 1
#endif

#define WS_MOD 0ull
#define WS_LB (WS_MOD + 98304ull)
#define WS_WEI (WS_LB + 2048ull)
#define WS_WEO (WS_WEI + 3712ull * 2048)
#define WS_WOI (WS_WEO + 1024ull * 2048)
#define WS_WOO (WS_WOI + 4224ull * 2048)
#define WS_H (WS_WOO + 1024ull * 2048)
#define WS_PROJ (WS_H + 16384ull * 2048)
#define WS_O (WS_PROJ + 16384ull * 4112 * 2)
#define WS_ST WS_O
#define WS_DEC (WS_O + 2ull * 16384 * 512 * 4)
#define WS_SSQ (WS_DEC + 2ull * 16 * 64 * 128 * 4)
#define WS_BAR (WS_SSQ + 2ull * 16384 * 4)
#define WS_CMID (WS_BAR + 16384ull)
#define WS_DECS (WS_CMID + 2ull * 16 * 64 * 128 * 4)
#define WS_END (WS_DECS + 16384ull)

struct P {
  const float *x, *c, *ada_w, *ada_b, *ln_g, *ln_b, *e_w_in, *e_rpb, *gla_w_up, *gla_b, *gla_g, *e_w_out;
  const float *o_w_in, *hgrn_lb, *hgrn_g, *conv_w, *conv_b, *dt_bias, *a_log, *d_skip, *ssm_g, *o_w_out;
  float* out;
  unsigned char* ws;
};

__device__ __forceinline__ bf16 f2bf(float f) {
  __bf16 h = (__bf16)f;
  return *(bf16*)&h;
}
using u32x4 = __attribute__((ext_vector_type(4))) unsigned;
__device__ __forceinline__ u32x4 gload16_asm(const void* ptr) {
  u32x4 r;
  asm volatile("global_load_dwordx4 %0, %1, off" : "=v"(r) : "v"(ptr));
  return r;
}
using u32x2 = __attribute__((ext_vector_type(2))) unsigned;
__device__ __forceinline__ u32x2 gload8_asm(const void* ptr) {
  u32x2 r;
  asm volatile("global_load_dwordx2 %0, %1, off" : "=v"(r) : "v"(ptr));
  return r;
}
__device__ __forceinline__ float bf2f(bf16 h) { return __uint_as_float(((unsigned)h) << 16); }
__device__ __forceinline__ float frcp(float x) { return __builtin_amdgcn_rcpf(x); }
__device__ __forceinline__ float silu_f(float v) { return v * frcp(1.f + __expf(-v)); }
__device__ __forceinline__ float sigmoid_f(float v) { return frcp(1.f + __expf(-v)); }
__device__ __forceinline__ float flog(float x) { return __builtin_amdgcn_logf(x) * 0.6931471805599453f; }
__device__ __forceinline__ float log_sigmoid_f(float z) { return fminf(z, 0.f) - flog(1.f + __expf(-fabsf(z))); }
__device__ __forceinline__ float softplus_f(float z) { return fmaxf(z, 0.f) + log1pf(__expf(-fabsf(z))); }
__device__ __forceinline__ float wave_sum(float v) {
#pragma unroll
  for (int o = 32; o > 0; o >>= 1) v += __shfl_xor(v, o, 64);
  return v;
}

__device__ __forceinline__ void transpose_item(const float* __restrict__ src, int N, bf16* __restrict__ dst, int li, unsigned char* smem) {
  float* tile = (float*)smem;
  const int tid = threadIdx.x;
  const int kt = li & 15, ntile = li >> 4;
#pragma unroll
  for (int i = 0; i < 16; ++i) {
    int row = i * 4 + (tid >> 6), col = tid & 63;
    int n = ntile * 64 + col;
    float v = (n < N) ? src[(size_t)(kt * 64 + row) * N + n] : 0.f;
    tile[row * 65 + col] = v;
  }
  __syncthreads();
#pragma unroll
  for (int i = 0; i < 16; ++i) {
    int r = i * 4 + (tid >> 6), cc = tid & 63;
    dst[(size_t)(ntile * 64 + r) * 1024 + kt * 64 + cc] = f2bf(tile[cc * 65 + r]);
  }
}

__device__ __forceinline__ void mod_item(const P& p, int idx, unsigned char* smem) {
  float* cond = (float*)smem;
  float* red = cond + 4096;
  const int tid = threadIdx.x;
  const int l = idx / 192, nc = idx % 192;
  for (int e = tid; e < 4096; e += 256) cond[e] = silu_f(p.c[e]);
  __syncthreads();
  const int kg = tid >> 4, col = tid & 15, n = nc * 16 + col;
  float a0 = 0.f, a1 = 0.f, a2 = 0.f, a3 = 0.f;
  const float* w = p.ada_w + (size_t)l * 1024 * 3072 + n;
#pragma unroll 16
  for (int k = kg * 64; k < kg * 64 + 64; ++k) {
    float wv = w[(size_t)k * 3072];
    a0 += cond[k] * wv; a1 += cond[1024 + k] * wv; a2 += cond[2048 + k] * wv; a3 += cond[3072 + k] * wv;
  }
  red[(kg * 4 + 0) * 16 + col] = a0; red[(kg * 4 + 1) * 16 + col] = a1;
  red[(kg * 4 + 2) * 16 + col] = a2; red[(kg * 4 + 3) * 16 + col] = a3;
  __syncthreads();
  if (tid < 64) {
    const int b = tid >> 4;
    float sum = 0.f;
#pragma unroll
    for (int q = 0; q < 16; ++q) sum += red[(q * 4 + b) * 16 + col];
    float* mod = (float*)(p.ws + WS_MOD);
    mod[(size_t)(l * 4 + b) * 3072 + n] = sum + p.ada_b[l * 3072 + n];
  }
}

__device__ __forceinline__ void phase_setup(const P& p, unsigned char* smem) {
  const int M0 = 384, T0 = M0 + 16 * 58, T1 = T0 + 256, T5 = T1 + 1;
  for (int rep = 0; rep < REP0; ++rep)
  for (int it = blockIdx.x; it < T5; it += gridDim.x) {
    if (it < M0) mod_item(p, it, smem);
    else if (it < T0) transpose_item(p.e_w_in, EVEN_N, (bf16*)(p.ws + WS_WEI), it - M0, smem);
    else if (it < T1) transpose_item(p.e_w_out, 1024, (bf16*)(p.ws + WS_WEO), it - T0, smem);
    else {
      float* lbv = (float*)(p.ws + WS_LB);
      for (int j = threadIdx.x; j < 512; j += 256) {
        float a = p.hgrn_lb[j], bb = p.hgrn_lb[512 + j];
        lbv[j] = 1.f / (1.f + __expf(a - bb));
      }
    }
    __syncthreads();
  }
}

__device__ __forceinline__ void phase_h0(const P& p) {
  const float* mod = (const float*)(p.ws + WS_MOD);
  bf16* hb = (bf16*)(p.ws + WS_H);
  const size_t total = (size_t)M_TOK * 128;
  for (size_t i = (size_t)blockIdx.x * 256 + threadIdx.x; i < total; i += (size_t)gridDim.x * 256) {
    int m = (int)(i >> 7), n = (int)(i & 127) * 8, b = m >> 12;
    const float4* xp = (const float4*)(p.x + (size_t)m * 1024 + n);
    const float4* sh = (const float4*)(mod + (size_t)b * 3072 + n);
    const float4* sc = (const float4*)(mod + (size_t)b * 3072 + 1024 + n);
    float4 x0 = xp[0], x1 = xp[1], s0 = sh[0], s1 = sh[1], c0 = sc[0], c1 = sc[1];
    uint4 o;
    o.x = (unsigned)f2bf(x0.x * (1.f + c0.x) + s0.x) | ((unsigned)f2bf(x0.y * (1.f + c0.y) + s0.y) << 16);
    o.y = (unsigned)f2bf(x0.z * (1.f + c0.z) + s0.z) | ((unsigned)f2bf(x0.w * (1.f + c0.w) + s0.w) << 16);
    o.z = (unsigned)f2bf(x1.x * (1.f + c1.x) + s1.x) | ((unsigned)f2bf(x1.y * (1.f + c1.y) + s1.y) << 16);
    o.w = (unsigned)f2bf(x1.z * (1.f + c1.z) + s1.z) | ((unsigned)f2bf(x1.w * (1.f + c1.w) + s1.w) << 16);
    *(uint4*)(hb + (size_t)m * 1024 + n) = o;
  }
}

#ifndef GEMM_NST
#define GEMM_NST 2
#endif
#define LSTR 64
__device__ __forceinline__ void gemm_issue(const bf16* __restrict__ A, int lda, const bf16* __restrict__ Bt, int m0, int n0,
                                           u32x4 (&ra)[GEMM_NST][4], u32x4 (&rb)[GEMM_NST][4]) {
  const int tid = threadIdx.x, lrow = tid >> 3, lkc = tid & 7;
  const bf16* Ag = A + (size_t)(m0 + lrow) * lda + lkc * 8;
  const bf16* Bg = Bt + (size_t)(n0 + lrow) * 1024 + lkc * 8;
#pragma unroll
  for (int t = 0; t < GEMM_NST; ++t)
#pragma unroll
    for (int i = 0; i < 4; ++i) {
      ra[t][i] = gload16_asm(Ag + (size_t)i * 32 * lda + t * 64);
      rb[t][i] = gload16_asm(Bg + (size_t)i * 32 * 1024 + t * 64);
    }
}

template <int EPI, typename NextFn>
__device__ __forceinline__ void gemm_tile(const bf16* __restrict__ A, int lda, const bf16* __restrict__ Bt, int m0, int n0,
                                          unsigned char* smem, bf16* __restrict__ C, int ldc, int nreal,
                                          const float* __restrict__ X, float* __restrict__ R, const float* __restrict__ gate,
                                          const float* __restrict__ ssqp, u32x4 (&ra)[GEMM_NST][4], u32x4 (&rb)[GEMM_NST][4],
                                          NextFn&& next_issue) {
  bf16* As = (bf16*)smem;
  bf16* Bs = As + 2 * 128 * LSTR;
  const int tid = threadIdx.x, lane = tid & 63, wave = tid >> 6;
  const int wm = wave >> 1, wn = wave & 1;
  f32x4 acc[4][4];
#pragma unroll
  for (int i = 0; i < 4; ++i)
#pragma unroll
    for (int j = 0; j < 4; ++j) acc[i][j] = (f32x4){0.f, 0.f, 0.f, 0.f};
  float rsv[4] = {1.f, 1.f, 1.f, 1.f};
  if (EPI == 2) {
#pragma unroll
    for (int j = 0; j < 4; ++j) {
      const int m = m0 + wm * 64 + j * 16 + (lane & 15);
      rsv[j] = rsqrtf((ssqp[m] + ssqp[M_TOK + m]) * (1.f / 512.f) + 1e-6f);
    }
  }
  const int lrow = tid >> 3, lkc = tid & 7;
  const int lsw = (lkc ^ (lrow & 7)) * 8;
  const bf16* Ag = A + (size_t)(m0 + lrow) * lda + lkc * 8;
  const bf16* Bg = Bt + (size_t)(n0 + lrow) * 1024 + lkc * 8;
  if (GEMM_NST == 3) {
    asm volatile("s_waitcnt vmcnt(16)"
                 : "+v"(ra[0][0]), "+v"(ra[0][1]), "+v"(ra[0][2]), "+v"(ra[0][3]), "+v"(rb[0][0]), "+v"(rb[0][1]), "+v"(rb[0][2]), "+v"(rb[0][3])
                 :: "memory");
  } else {
    asm volatile("s_waitcnt vmcnt(8)"
                 : "+v"(ra[0][0]), "+v"(ra[0][1]), "+v"(ra[0][2]), "+v"(ra[0][3]), "+v"(rb[0][0]), "+v"(rb[0][1]), "+v"(rb[0][2]), "+v"(rb[0][3])
                 :: "memory");
  }
#pragma unroll
  for (int i = 0; i < 4; ++i) {
    *(u32x4*)(As + (lrow + i * 32) * LSTR + lsw) = ra[0][i];
    *(u32x4*)(Bs + (lrow + i * 32) * LSTR + lsw) = rb[0][i];
  }
  __syncthreads();
#pragma unroll
  for (int kt = 0; kt < 16; ++kt) {
    const int buf = kt & 1;
    if (kt + 1 < 16) {
      const int sn = (kt + 1) % GEMM_NST;
      if (GEMM_NST == 3 && kt + 2 < 16) {
        asm volatile("s_waitcnt vmcnt(8)"
                     : "+v"(ra[sn][0]), "+v"(ra[sn][1]), "+v"(ra[sn][2]), "+v"(ra[sn][3]), "+v"(rb[sn][0]), "+v"(rb[sn][1]), "+v"(rb[sn][2]), "+v"(rb[sn][3])
                     :: "memory");
      } else {
        asm volatile("s_waitcnt vmcnt(0)"
                     : "+v"(ra[sn][0]), "+v"(ra[sn][1]), "+v"(ra[sn][2]), "+v"(ra[sn][3]), "+v"(rb[sn][0]), "+v"(rb[sn][1]), "+v"(rb[sn][2]), "+v"(rb[sn][3])
                     :: "memory");
      }
      bf16* Aw = As + (buf ^ 1) * 128 * LSTR;
      bf16* Bw = Bs + (buf ^ 1) * 128 * LSTR;
#pragma unroll
      for (int i = 0; i < 4; ++i) {
        *(u32x4*)(Aw + (lrow + i * 32) * LSTR + lsw) = ra[sn][i];
        *(u32x4*)(Bw + (lrow + i * 32) * LSTR + lsw) = rb[sn][i];
      }
    }
    if (kt + GEMM_NST < 16) {
#pragma unroll
      for (int i = 0; i < 4; ++i) {
        ra[kt % GEMM_NST][i] = gload16_asm(Ag + (size_t)i * 32 * lda + (kt + GEMM_NST) * 64);
        rb[kt % GEMM_NST][i] = gload16_asm(Bg + (size_t)i * 32 * 1024 + (kt + GEMM_NST) * 64);
      }
    }
    const bf16* Ab = As + buf * 128 * LSTR;
    const bf16* Bb = Bs + buf * 128 * LSTR;
    if (EPI == 2 && kt == 8) {
#pragma unroll
      for (int j = 0; j < 4; ++j) {
        const float inv = frcp(rsv[j]);
#pragma unroll
        for (int i = 0; i < 4; ++i) { acc[i][j][0] *= inv; acc[i][j][1] *= inv; acc[i][j][2] *= inv; acc[i][j][3] *= inv; }
      }
    }
#pragma unroll
    for (int s = 0; s < 2; ++s) {
      bf16x8 wf[4], xf[4];
#pragma unroll
      for (int i = 0; i < 4; ++i) {
        wf[i] = *(const bf16x8*)(Bb + (wn * 64 + i * 16 + (lane & 15)) * LSTR + (((s * 4 + (lane >> 4)) ^ (lane & 7)) * 8));
        xf[i] = *(const bf16x8*)(Ab + (wm * 64 + i * 16 + (lane & 15)) * LSTR + (((s * 4 + (lane >> 4)) ^ (lane & 7)) * 8));
      }
#pragma unroll
      for (int i = 0; i < 4; ++i)
#pragma unroll
        for (int j = 0; j < 4; ++j) acc[i][j] = __builtin_amdgcn_mfma_f32_16x16x32_bf16(wf[i], xf[j], acc[i][j], 0, 0, 0);
    }
    __syncthreads();
  }
  next_issue();
#pragma unroll
  for (int i = 0; i < 4; ++i) {
    const int n = n0 + wn * 64 + i * 16 + (lane >> 4) * 4;
#pragma unroll
    for (int j = 0; j < 4; ++j) {
      const int m = m0 + wm * 64 + j * 16 + (lane & 15);
      f32x4 a = acc[i][j];
      if (EPI == 2) { a[0] *= rsv[j]; a[1] *= rsv[j]; a[2] *= rsv[j]; a[3] *= rsv[j]; }
      if (EPI == 0) {
        uint2 o;
        o.x = (unsigned)f2bf(a[0]) | ((unsigned)f2bf(a[1]) << 16);
        o.y = (unsigned)f2bf(a[2]) | ((unsigned)f2bf(a[3]) << 16);
        *(uint2*)((bf16*)smem + (wm * 64 + j * 16 + (lane & 15)) * 136 + wn * 64 + i * 16 + (lane >> 4) * 4) = o;
      } else {
        *(f32x4*)((float*)smem + (wm * 64 + j * 16 + (lane & 15)) * 132 + wn * 64 + i * 16 + (lane >> 4) * 4) = a;
      }
    }
  }
  if (EPI == 0) {
    __syncthreads();
#pragma unroll
    for (int q = 0; q < 8; ++q) {
      const int c = q * 256 + tid, row = c >> 4, c16 = c & 15;
      const int n = n0 + c16 * 8;
      if (n < nreal) *(u32x4*)(C + (size_t)(m0 + row) * ldc + n) = *(const u32x4*)((const bf16*)smem + row * 136 + c16 * 8);
    }
    __syncthreads();
  } else {
    __syncthreads();
#pragma unroll 4
    for (int q = 0; q < 16; ++q) {
      const int c = q * 256 + tid, row = c >> 5, c4 = c & 31;
      const int m = m0 + row, n = n0 + c4 * 4, b = m >> 12;
      const f32x4 a = *(const f32x4*)((const float*)smem + row * 132 + c4 * 4);
      float4 xv;
      if (EPI == 2) {
        uint2 xu = *(const uint2*)((const bf16*)X + (size_t)m * 1024 + n);
        xv.x = __uint_as_float(xu.x << 16); xv.y = __uint_as_float(xu.x & 0xffff0000u);
        xv.z = __uint_as_float(xu.y << 16); xv.w = __uint_as_float(xu.y & 0xffff0000u);
      } else xv = *(const float4*)(X + (size_t)m * 1024 + n);
      const float4 g = *(const float4*)(gate + (size_t)b * 3072 + n);
      float4 o;
      o.x = ALPHA * xv.x + g.x * a[0];
      o.y = ALPHA * xv.y + g.y * a[1];
      o.z = ALPHA * xv.z + g.z * a[2];
      o.w = ALPHA * xv.w + g.w * a[3];
      uint2 ob;
      ob.x = (unsigned)f2bf(o.x) | ((unsigned)f2bf(o.y) << 16);
      ob.y = (unsigned)f2bf(o.z) | ((unsigned)f2bf(o.w) << 16);
      *(uint2*)((bf16*)R + (size_t)m * 1024 + n) = ob;
    }
    __syncthreads();
  }
}

template <int EPI>
__device__ __forceinline__ void phase_gemm(const bf16* A, int lda, const bf16* Bt, int ntn, unsigned char* smem, bf16* C, int ldc, int nreal,
                           const float* X, float* R, const float* gate, unsigned* bar, int gidx, const float* ssqp = nullptr) {
  volatile unsigned* stw = (volatile unsigned*)(smem + 73728);
  const unsigned xid = (unsigned)__builtin_amdgcn_s_getreg((3 << 11) | 20) & 0xFu;
  int xidx = 0, nx = 0;
#pragma unroll
  for (int j = 0; j < 16; ++j) {
    const unsigned c = __hip_atomic_load(&bar[256 + 64 * j], __ATOMIC_RELAXED, __HIP_MEMORY_SCOPE_AGENT);
    if (c > 0u) { nx++; if ((unsigned)j < xid) xidx++; }
  }
  const int mt_lo = (xidx * 128) / nx, mt_hi = ((xidx + 1) * 128) / nx;
  const int total = (mt_hi - mt_lo) * ntn;
  unsigned* qc = bar + 3456 + (gidx * 16 + xidx) * 8;
  u32x4 ra[GEMM_NST][4], rb[GEMM_NST][4];
  int mt = 0, nt = 0;
  bool valid = false;
  auto fetch = [&](int& mt_o, int& nt_o) -> bool {
    __syncthreads();
    if (threadIdx.x == 0) stw[2] = __hip_atomic_fetch_add(qc, 1u, __ATOMIC_RELAXED, __HIP_MEMORY_SCOPE_AGENT);
    __syncthreads();
    const int t = (int)stw[2];
    if (t >= total) return false;
    const int g8 = t / (8 * ntn), r = t - g8 * 8 * ntn;
    const int rows = mt_hi - mt_lo - g8 * 8;
    const int gm = rows < 8 ? rows : 8;
    nt_o = r / gm; mt_o = mt_lo + g8 * 8 + (r - nt_o * gm);
    return true;
  };
  valid = fetch(mt, nt);
  if (valid) gemm_issue(A, lda, Bt, mt * 128, nt * 128, ra, rb);
  while (valid) {
    int mt2 = 0, nt2 = 0;
    bool valid2 = false;
    gemm_tile<EPI>(A, lda, Bt, mt * 128, nt * 128, smem, C, ldc, nreal, X, R, gate, ssqp, ra, rb, [&]() {
      valid2 = fetch(mt2, nt2);
      if (valid2) gemm_issue(A, lda, Bt, mt2 * 128, nt2 * 128, ra, rb);
    });
    mt = mt2; nt = nt2; valid = valid2;
  }
}

__device__ __forceinline__ void phase_ln(const P& p, int l, bool write_h, const unsigned char* probe_ts = nullptr) {
  const float* mod = (const float*)(p.ws + WS_MOD);
  bf16* hb = (bf16*)(p.ws + WS_H);
  const int lane = threadIdx.x & 63, wave = threadIdx.x >> 6;
  const float* g = p.ln_g + l * 1024;
  const float* bb = p.ln_b + l * 1024;
  constexpr int NR = 4;
  for (int grp = blockIdx.x * 4 + wave; grp < M_TOK / NR; grp += gridDim.x * 4) {
    float4 v[NR][4];
    float s[NR];
#pragma unroll
    for (int r = 0; r < NR; ++r) {
      const bf16* rp = (const bf16*)(p.ws + WS_ST) + (size_t)(grp * NR + r) * 1024;
#pragma unroll
      for (int q = 0; q < 4; ++q) {
        const uint2 u = *(const uint2*)(rp + (lane + 64 * q) * 4);
        v[r][q].x = __uint_as_float(u.x << 16); v[r][q].y = __uint_as_float(u.x & 0xffff0000u);
        v[r][q].z = __uint_as_float(u.y << 16); v[r][q].w = __uint_as_float(u.y & 0xffff0000u);
      }
    }
#pragma unroll
    for (int r = 0; r < NR; ++r) {
      s[r] = 0.f;
#pragma unroll
      for (int q = 0; q < 4; ++q) s[r] += v[r][q].x + v[r][q].y + v[r][q].z + v[r][q].w;
    }
#pragma unroll
    for (int o = 32; o > 0; o >>= 1)
#pragma unroll
      for (int r = 0; r < NR; ++r) s[r] += __shfl_xor(s[r], o, 64);
    float mu[NR], s2[NR];
#pragma unroll
    for (int r = 0; r < NR; ++r) {
      mu[r] = s[r] * (1.f / 1024.f);
      s2[r] = 0.f;
#pragma unroll
      for (int q = 0; q < 4; ++q) {
        float a = v[r][q].x - mu[r], b2 = v[r][q].y - mu[r], c2 = v[r][q].z - mu[r], d2 = v[r][q].w - mu[r];
        s2[r] += a * a + b2 * b2 + c2 * c2 + d2 * d2;
      }
    }
#pragma unroll
    for (int o = 32; o > 0; o >>= 1)
#pragma unroll
      for (int r = 0; r < NR; ++r) s2[r] += __shfl_xor(s2[r], o, 64);
#pragma unroll
    for (int q = 0; q < 4; ++q) {
      const int n = (lane + 64 * q) * 4;
      const float4 gg = *(const float4*)(g + n), be = *(const float4*)(bb + n);
#pragma unroll
      for (int r = 0; r < NR; ++r) {
        const int row = grp * NR + r;
        const float rstd = rsqrtf(s2[r] * (1.f / 1024.f) + 1e-5f);
        float4 o;
        o.x = (v[r][q].x - mu[r]) * rstd * gg.x + be.x;
        o.y = (v[r][q].y - mu[r]) * rstd * gg.y + be.y;
        o.z = (v[r][q].z - mu[r]) * rstd * gg.z + be.z;
        o.w = (v[r][q].w - mu[r]) * rstd * gg.w + be.w;
        if (PROBE_PH >= 0 && l == 1 && row == 0) {
          const long long* ts = (const long long*)(probe_ts);
          const int kus = (int)((ts[PROBE_PH + 1] - ts[PROBE_PH]) / 100);
          if (n + 0 < kus) o.x += 0.125f;
          if (n + 1 < kus) o.y += 0.125f;
          if (n + 2 < kus) o.z += 0.125f;
          if (n + 3 < kus) o.w += 0.125f;
        }
        if (!write_h) *(float4*)(p.out + (size_t)row * 1024 + n) = o;
        if (write_h) {
          const int b = row >> 12;
          uint2 xb16;
          xb16.x = (unsigned)f2bf(o.x) | ((unsigned)f2bf(o.y) << 16);
          xb16.y = (unsigned)f2bf(o.z) | ((unsigned)f2bf(o.w) << 16);
          *(uint2*)((bf16*)p.out + (size_t)row * 1024 + n) = xb16;
          const float* md = mod + (size_t)(4 + b) * 3072;
          float4 sh = *(const float4*)(md + n), sc = *(const float4*)(md + 1024 + n);
          uint2 hh;
          hh.x = (unsigned)f2bf(o.x * (1.f + sc.x) + sh.x) | ((unsigned)f2bf(o.y * (1.f + sc.y) + sh.y) << 16);
          hh.y = (unsigned)f2bf(o.z * (1.f + sc.z) + sh.z) | ((unsigned)f2bf(o.w * (1.f + sc.w) + sh.w) << 16);
          *(uint2*)(hb + (size_t)row * 1024 + n) = hh;
        }
      }
    }
  }
}

__device__ __forceinline__ void na_item(const P& p, int item, unsigned char* smem) {
  const int h = item & 7, r = (item >> 3) & 63, b = item >> 9;
  bf16* VT = (bf16*)smem;
  float* RPB = (float*)(VT + 64 * 520);
  const bf16* projb = (const bf16*)(p.ws + WS_PROJ) + (size_t)b * 4096 * EVEN_N;
  bf16* yb = (bf16*)(p.ws + WS_H);
  const int tid = threadIdx.x, lane = tid & 63, n = tid >> 6;
  const int q = lane & 15, g4 = lane >> 4;
  int rs = r - 4; rs = rs < 0 ? 0 : (rs > 56 ? 56 : rs);
  const int bs_pre = n == 0 ? 0 : (n == 1 ? 8 : (n == 2 ? 24 : 32));
  u32x4 kpre[8][2];
#pragma unroll
  for (int tt = 0; tt < 8; ++tt) {
    const int ktok = (rs + (tt >> 1)) * 64 + bs_pre + (tt & 1) * 16 + q;
    const bf16* kp = projb + (size_t)ktok * EVEN_N + 512 + h * 64 + g4 * 8;
    kpre[tt][0] = gload16_asm(kp);
    kpre[tt][1] = gload16_asm(kp + 32);
  }
#pragma unroll 8
  for (int i = 0; i < 16; ++i) {
    const int key = (i >> 3) * 256 + tid, ch = i & 7;
    const int tok = (rs + (key >> 6)) * 64 + (key & 63);
    uint4 u = *(const uint4*)(projb + (size_t)tok * EVEN_N + 1024 + h * 64 + ch * 8);
    bf16* dst = VT + (ch * 8) * 520 + key;
    dst[0 * 520] = (bf16)(u.x & 0xffffu); dst[1 * 520] = (bf16)(u.x >> 16);
    dst[2 * 520] = (bf16)(u.y & 0xffffu); dst[3 * 520] = (bf16)(u.y >> 16);
    dst[4 * 520] = (bf16)(u.z & 0xffffu); dst[5 * 520] = (bf16)(u.z >> 16);
    dst[6 * 520] = (bf16)(u.w & 0xffffu); dst[7 * 520] = (bf16)(u.w >> 16);
  }
  for (int i = tid; i < 465; i += 256) RPB[i] = p.e_rpb[h * 465 + i];
  const int qcol = n * 16 + q;
  const int qtok = r * 64 + qcol;
  const int bs = n == 0 ? 0 : (n == 1 ? 8 : (n == 2 ? 24 : 32));
  const bf16x8 qf0 = *(const bf16x8*)(projb + (size_t)qtok * EVEN_N + h * 64 + g4 * 8);
  const bf16x8 qf1 = *(const bf16x8*)(projb + (size_t)qtok * EVEN_N + h * 64 + 32 + g4 * 8);
  f32x4 st[16];
  asm volatile("s_waitcnt vmcnt(0)"
               : "+v"(kpre[0][0]), "+v"(kpre[0][1]), "+v"(kpre[1][0]), "+v"(kpre[1][1]), "+v"(kpre[2][0]), "+v"(kpre[2][1]), "+v"(kpre[3][0]), "+v"(kpre[3][1]),
                 "+v"(kpre[4][0]), "+v"(kpre[4][1]), "+v"(kpre[5][0]), "+v"(kpre[5][1]), "+v"(kpre[6][0]), "+v"(kpre[6][1]), "+v"(kpre[7][0]), "+v"(kpre[7][1])
               :: "memory");
  u32x4 kpre2[8][2];
#pragma unroll
  for (int tt = 0; tt < 8; ++tt) {
    const int ktok = (rs + 4 + (tt >> 1)) * 64 + bs + (tt & 1) * 16 + q;
    const bf16* kp = projb + (size_t)ktok * EVEN_N + 512 + h * 64 + g4 * 8;
    kpre2[tt][0] = gload16_asm(kp);
    kpre2[tt][1] = gload16_asm(kp + 32);
  }
#pragma unroll
  for (int tt = 0; tt < 16; ++tt) {
    if (tt == 8) {
      asm volatile("s_waitcnt vmcnt(0)"
                   : "+v"(kpre2[0][0]), "+v"(kpre2[0][1]), "+v"(kpre2[1][0]), "+v"(kpre2[1][1]), "+v"(kpre2[2][0]), "+v"(kpre2[2][1]), "+v"(kpre2[3][0]), "+v"(kpre2[3][1]),
                     "+v"(kpre2[4][0]), "+v"(kpre2[4][1]), "+v"(kpre2[5][0]), "+v"(kpre2[5][1]), "+v"(kpre2[6][0]), "+v"(kpre2[6][1]), "+v"(kpre2[7][0]), "+v"(kpre2[7][1])
                   :: "memory");
    }
    bf16x8 kf0, kf1;
    if (tt < 8) { kf0 = *(bf16x8*)&kpre[tt][0]; kf1 = *(bf16x8*)&kpre[tt][1]; }
    else { kf0 = *(bf16x8*)&kpre2[tt - 8][0]; kf1 = *(bf16x8*)&kpre2[tt - 8][1]; }
    f32x4 z = (f32x4){0.f, 0.f, 0.f, 0.f};
    z = __builtin_amdgcn_mfma_f32_16x16x32_bf16(kf0, qf0, z, 0, 0, 0);
    st[tt] = __builtin_amdgcn_mfma_f32_16x16x32_bf16(kf1, qf1, z, 0, 0, 0);
  }
  __syncthreads();
  int cs = qcol - 8; cs = cs < 0 ? 0 : (cs > 48 ? 48 : cs);
  float mx = -1e30f;
#pragma unroll
  for (int tt = 0; tt < 16; ++tt) {
    const float* brow = RPB + (rs + (tt >> 1) - r + 7) * 31;
#pragma unroll
    for (int rr = 0; rr < 4; ++rr) {
      const int kcol = bs + (tt & 1) * 16 + g4 * 4 + rr;
      const bool valid = (kcol >= cs) && (kcol < cs + 16);
      int dc = kcol - qcol + 15; dc = dc < 0 ? 0 : (dc > 30 ? 30 : dc);
      const float sc = valid ? st[tt][rr] * 0.125f + brow[dc] : -1e30f;
      st[tt][rr] = sc;
      mx = fmaxf(mx, sc);
    }
  }
  mx = fmaxf(mx, __shfl_xor(mx, 16, 64));
  mx = fmaxf(mx, __shfl_xor(mx, 32, 64));
  float lsum = 0.f;
#pragma unroll
  for (int tt = 0; tt < 16; ++tt)
#pragma unroll
    for (int rr = 0; rr < 4; ++rr) {
      const float pe = __expf(st[tt][rr] - mx);
      st[tt][rr] = pe;
      lsum += pe;
    }
  lsum += __shfl_xor(lsum, 16, 64);
  lsum += __shfl_xor(lsum, 32, 64);
  f32x4 ot[4];
#pragma unroll
  for (int dt = 0; dt < 4; ++dt) ot[dt] = (f32x4){0.f, 0.f, 0.f, 0.f};
#pragma unroll
  for (int kr = 0; kr < 8; ++kr) {
    uint4 pw;
    pw.x = (unsigned)f2bf(st[2 * kr][0]) | ((unsigned)f2bf(st[2 * kr][1]) << 16);
    pw.y = (unsigned)f2bf(st[2 * kr][2]) | ((unsigned)f2bf(st[2 * kr][3]) << 16);
    pw.z = (unsigned)f2bf(st[2 * kr + 1][0]) | ((unsigned)f2bf(st[2 * kr + 1][1]) << 16);
    pw.w = (unsigned)f2bf(st[2 * kr + 1][2]) | ((unsigned)f2bf(st[2 * kr + 1][3]) << 16);
    const bf16x8 pf = *(bf16x8*)&pw;
#pragma unroll
    for (int dt = 0; dt < 4; ++dt) {
      const bf16* vp = VT + (dt * 16 + q) * 520 + kr * 64 + bs + g4 * 4;
      uint2 lo = *(const uint2*)vp, hi = *(const uint2*)(vp + 16);
      uint4 vw; vw.x = lo.x; vw.y = lo.y; vw.z = hi.x; vw.w = hi.y;
      ot[dt] = __builtin_amdgcn_mfma_f32_16x16x32_bf16(*(bf16x8*)&vw, pf, ot[dt], 0, 0, 0);
    }
  }
  const float inv = frcp(lsum);
#pragma unroll
  for (int dt = 0; dt < 4; ++dt) {
    const int d0 = dt * 16 + g4 * 4;
    uint2 gu = *(const uint2*)(projb + (size_t)qtok * EVEN_N + 1536 + h * 64 + d0);
    f32x4 y;
    y[0] = ot[dt][0] * inv * silu_f(__uint_as_float(gu.x << 16));
    y[1] = ot[dt][1] * inv * silu_f(__uint_as_float(gu.x & 0xffff0000u));
    y[2] = ot[dt][2] * inv * silu_f(__uint_as_float(gu.y << 16));
    y[3] = ot[dt][3] * inv * silu_f(__uint_as_float(gu.y & 0xffff0000u));
    uint2 o;
    o.x = (unsigned)f2bf(y[0]) | ((unsigned)f2bf(y[1]) << 16);
    o.y = (unsigned)f2bf(y[2]) | ((unsigned)f2bf(y[3]) << 16);
    *(uint2*)(yb + ((size_t)b * 4096 + qtok) * 1024 + h * 64 + d0) = o;
  }
}

template <int K, int MODE>
struct GateC {
  float w[16];
  float bias, lb;
  int d, ch;
  __device__ __forceinline__ void init(const P& p, int d_, int h, int k) {
    d = d_; ch = h * K + k;
    if (MODE == 0) {
#pragma unroll
      for (int r = 0; r < 16; ++r) w[r] = p.gla_w_up[(d * 16 + r) * 256 + ch];
      bias = p.gla_b[d * 256 + ch];
      lb = 0.f;
    } else {
      lb = ((const float*)(p.ws + WS_LB))[ch];
      bias = 0.f;
    }
  }
  __device__ __forceinline__ void eval_vals(bf16 a, bf16 bz, const bf16* lr, float& g, float& kval, float& qval) const {
    if (MODE == 0) {
      uint4 u0 = *(const uint4*)(lr);
      uint4 u1 = *(const uint4*)(lr + 8);
      float z = bias;
      z += w[0] * __uint_as_float(u0.x << 16) + w[1] * __uint_as_float(u0.x & 0xffff0000u);
      z += w[2] * __uint_as_float(u0.y << 16) + w[3] * __uint_as_float(u0.y & 0xffff0000u);
      z += w[4] * __uint_as_float(u0.z << 16) + w[5] * __uint_as_float(u0.z & 0xffff0000u);
      z += w[6] * __uint_as_float(u0.w << 16) + w[7] * __uint_as_float(u0.w & 0xffff0000u);
      z += w[8] * __uint_as_float(u1.x << 16) + w[9] * __uint_as_float(u1.x & 0xffff0000u);
      z += w[10] * __uint_as_float(u1.y << 16) + w[11] * __uint_as_float(u1.y & 0xffff0000u);
      z += w[12] * __uint_as_float(u1.z << 16) + w[13] * __uint_as_float(u1.z & 0xffff0000u);
      z += w[14] * __uint_as_float(u1.w << 16) + w[15] * __uint_as_float(u1.w & 0xffff0000u);
      g = log_sigmoid_f(z) * (1.f / 16.f);
      kval = bf2f(bz);
      qval = bf2f(a) * 0.125f;
    } else {
      const float z = bf2f(bz);
      const float e = __expf(-z);
      const float sg = frcp(1.f + e);
      kval = (1.f - lb) * e * sg;
      g = 1.f - kval;
      qval = bf2f(a) * 0.08838834764831845f;
    }
  }
  __device__ __forceinline__ void eval(const bf16* row, float& g, float& kval, float& qval) const {
    if (MODE == 0) {
      uint4 u0 = *(const uint4*)(row + 3584 + d * 16);
      uint4 u1 = *(const uint4*)(row + 3584 + d * 16 + 8);
      float z = bias;
      z += w[0] * __uint_as_float(u0.x << 16) + w[1] * __uint_as_float(u0.x & 0xffff0000u);
      z += w[2] * __uint_as_float(u0.y << 16) + w[3] * __uint_as_float(u0.y & 0xffff0000u);
      z += w[4] * __uint_as_float(u0.z << 16) + w[5] * __uint_as_float(u0.z & 0xffff0000u);
      z += w[6] * __uint_as_float(u0.w << 16) + w[7] * __uint_as_float(u0.w & 0xffff0000u);
      z += w[8] * __uint_as_float(u1.x << 16) + w[9] * __uint_as_float(u1.x & 0xffff0000u);
      z += w[10] * __uint_as_float(u1.y << 16) + w[11] * __uint_as_float(u1.y & 0xffff0000u);
      z += w[12] * __uint_as_float(u1.z << 16) + w[13] * __uint_as_float(u1.z & 0xffff0000u);
      z += w[14] * __uint_as_float(u1.w << 16) + w[15] * __uint_as_float(u1.w & 0xffff0000u);
      g = log_sigmoid_f(z) * (1.f / 16.f);
      kval = bf2f(row[2304 + ch]);
      qval = bf2f(row[2048 + ch]) * 0.125f;
    } else {
      const float z = bf2f(row[512 + d * 512 + ch]);
      const float e = __expf(-z);
      const float sg = frcp(1.f + e);
      kval = (1.f - lb) * e * sg;
      g = flog(1.f - kval);
      qval = bf2f(row[ch]) * 0.08838834764831845f;
    }
  }
};

template <int MODE>
__device__ __forceinline__ void stage_vt(const bf16* proj, int h, bf16* VT) {
  constexpr int LDP = MODE == 0 ? EVEN_N : ODD_N;
  constexpr int VOFF = MODE == 0 ? 2560 : 1536;
  const int j = threadIdx.x & 63, cgp = threadIdx.x >> 6;
#pragma unroll
  for (int cc = 0; cc < 4; ++cc) {
    const int c = cgp * 4 + cc;
    uint4 u = *(const uint4*)(proj + (size_t)j * LDP + VOFF + h * 128 + c * 8);
    bf16* dst = VT + (c * 8) * 72 + j;
    dst[0 * 72] = (bf16)(u.x & 0xffffu); dst[1 * 72] = (bf16)(u.x >> 16);
    dst[2 * 72] = (bf16)(u.y & 0xffffu); dst[3 * 72] = (bf16)(u.y >> 16);
    dst[4 * 72] = (bf16)(u.z & 0xffffu); dst[5 * 72] = (bf16)(u.z >> 16);
    dst[6 * 72] = (bf16)(u.w & 0xffffu); dst[7 * 72] = (bf16)(u.w >> 16);
  }
}

__device__ __forceinline__ uint2 pack4(f32x4 a) {
  uint2 o;
  o.x = (unsigned)f2bf(a[0]) | ((unsigned)f2bf(a[1]) << 16);
  o.y = (unsigned)f2bf(a[2]) | ((unsigned)f2bf(a[3]) << 16);
  return o;
}

template <int K, int MODE>
__device__ __forceinline__ void rec_pass1_item(const P& p, int item, unsigned char* smem) {
  constexpr int LDP = MODE == 0 ? EVEN_N : ODD_N;
  const int h = item & 3, blk = (item >> 2) & 63, b = item >> 8;
  bf16* KT = (bf16*)smem;
  bf16* VT = KT + 2 * K * 72;
  const bf16* proj = (const bf16*)(p.ws + WS_PROJ) + (size_t)(b * 4096 + blk * 64) * LDP;
  bf16* ST = (bf16*)(p.ws + WS_ST);
  float* DEC = (float*)(p.ws + WS_DEC);
  const int tid = threadIdx.x, lane = tid & 63, wave = tid >> 6;
  bf16* TMP = VT;
  if (MODE == 1) {
#pragma unroll
    for (int i = 0; i < 8; ++i) {
      const int c = i * 256 + tid;
      const int ch = c & 15, j = (c >> 4) & 63, d = c >> 10;
      *(uint4*)(TMP + (d * 64 + j) * 128 + ch * 8) = *(const uint4*)(proj + (size_t)j * LDP + 512 + d * 512 + h * 128 + ch * 8);
    }
  } else {
#pragma unroll
    for (int i = 0; i < 2; ++i) {
      const int c = i * 256 + tid;
      const int ch = c & 7, j = c >> 3;
      *(uint4*)(TMP + j * 64 + ch * 8) = *(const uint4*)(proj + (size_t)j * LDP + 2304 + h * 64 + ch * 8);
    }
    {
      const int ch = tid & 3, j = tid >> 2;
      *(uint4*)(TMP + 4096 + j * 32 + ch * 8) = *(const uint4*)(proj + (size_t)j * LDP + 3584 + ch * 8);
    }
  }
  __syncthreads();
  if (tid < 2 * K) {
    const int d = tid / K, k = tid % K;
    GateC<K, MODE> gc;
    gc.init(p, d, h, k);
    bf16* row = KT + (d * K + k) * 72;
    float r = MODE == 1 ? 1.f : 0.f, rhi = r;
#pragma unroll 4
    for (int i = 63; i >= 0; --i) {
      const int j = d ? 63 - i : i;
      float g, kv, qv;
      if (MODE == 1) {
        gc.eval_vals(0, TMP[(d * 64 + j) * 128 + k], nullptr, g, kv, qv);
        row[j] = f2bf(kv * r);
        r *= g;
      } else {
        gc.eval_vals(0, TMP[j * 64 + k], TMP + 4096 + j * 32 + d * 16, g, kv, qv);
        row[j] = f2bf(kv * __expf(r));
        r += g;
      }
      if (i == 32) rhi = r;
    }
    DEC[(size_t)((((d * 4 + b) * 4 + h) * 64 + blk)) * K + k] = MODE == 1 ? r : __expf(r);
    ((float*)(p.ws + WS_CMID))[(size_t)((((d * 4 + b) * 4 + h) * 64 + blk)) * K + k] = MODE == 1 ? r * frcp(rhi) : __expf(r - rhi);
  }
  __syncthreads();
  stage_vt<MODE>(proj, h, VT);
  __syncthreads();
#pragma unroll 1
  for (int d = 0; d < 2; ++d) {
    f32x4 acc[K / 16][2];
#pragma unroll
    for (int kt = 0; kt < K / 16; ++kt) { acc[kt][0] = (f32x4){0.f, 0.f, 0.f, 0.f}; acc[kt][1] = (f32x4){0.f, 0.f, 0.f, 0.f}; }
#pragma unroll
    for (int ks = 0; ks < 2; ++ks) {
      bf16x8 vf0 = *(const bf16x8*)(VT + ((wave * 2 + 0) * 16 + (lane & 15)) * 72 + ks * 32 + (lane >> 4) * 8);
      bf16x8 vf1 = *(const bf16x8*)(VT + ((wave * 2 + 1) * 16 + (lane & 15)) * 72 + ks * 32 + (lane >> 4) * 8);
#pragma unroll
      for (int kt = 0; kt < K / 16; ++kt) {
        bf16x8 kf = *(const bf16x8*)(KT + (d * K + kt * 16 + (lane & 15)) * 72 + ks * 32 + (lane >> 4) * 8);
        acc[kt][0] = __builtin_amdgcn_mfma_f32_16x16x32_bf16(kf, vf0, acc[kt][0], 0, 0, 0);
        acc[kt][1] = __builtin_amdgcn_mfma_f32_16x16x32_bf16(kf, vf1, acc[kt][1], 0, 0, 0);
      }
    }
    bf16* stb = ST + (size_t)((((d * 4 + b) * 4 + h) * 64 + blk)) * 128 * K;
#pragma unroll
    for (int kt = 0; kt < K / 16; ++kt)
#pragma unroll
      for (int vv = 0; vv < 2; ++vv) {
        const int v = (wave * 2 + vv) * 16 + (lane & 15);
        const int k0 = kt * 16 + (lane >> 4) * 4;
        *(uint2*)(stb + (size_t)v * K + k0) = pack4(acc[kt][vv]);
      }
  }
}

template <int K>
__device__ __forceinline__ void phase_rec_scan(const P& p) {
  bf16* ST = (bf16*)(p.ws + WS_ST);
  const float* DEC = (const float*)(p.ws + WS_DEC);
  const float* CMID = (const float*)(p.ws + WS_CMID);
  constexpr int KV = K / 4;
  const int total = 32 * 128 * KV;
  for (int idx = blockIdx.x * 256 + threadIdx.x; idx < total; idx += gridDim.x * 256) {
    const int kq = idx % KV, v = (idx / KV) & 127, s = idx / (KV * 128);
    const int d = s >> 4;
    float st0 = 0.f, st1 = 0.f, st2 = 0.f, st3 = 0.f;
#pragma unroll 1
    for (int n0 = 0; n0 < 64; n0 += 8) {
      uint2 u[8];
      float4 dc[8], cm[8];
#pragma unroll
      for (int q = 0; q < 8; ++q) {
        const int blk = d ? 63 - (n0 + q) : (n0 + q);
        u[q] = *(const uint2*)(ST + ((size_t)(s * 64 + blk) * 128 + v) * K + kq * 4);
        dc[q] = *(const float4*)(DEC + (size_t)(s * 64 + blk) * K + kq * 4);
        cm[q] = *(const float4*)(CMID + (size_t)(s * 64 + blk) * K + kq * 4);
      }
#pragma unroll
      for (int q = 0; q < 8; ++q) {
        const int blk = d ? 63 - (n0 + q) : (n0 + q);
        uint2 o;
        o.x = (unsigned)f2bf(st0 * cm[q].x) | ((unsigned)f2bf(st1 * cm[q].y) << 16);
        o.y = (unsigned)f2bf(st2 * cm[q].z) | ((unsigned)f2bf(st3 * cm[q].w) << 16);
        *(uint2*)(ST + ((size_t)(s * 64 + blk) * 128 + v) * K + kq * 4) = o;
        st0 = dc[q].x * st0 + __uint_as_float(u[q].x << 16);
        st1 = dc[q].y * st1 + __uint_as_float(u[q].x & 0xffff0000u);
        st2 = dc[q].z * st2 + __uint_as_float(u[q].y << 16);
        st3 = dc[q].w * st3 + __uint_as_float(u[q].y & 0xffff0000u);
      }
    }
  }
}

template <int K, int MODE>
__device__ __forceinline__ void rec_pass3_item(const P& p, int item, unsigned char* smem) {
  constexpr int LDP = MODE == 0 ? EVEN_N : ODD_N;
  constexpr int KS = K + 8;
  constexpr int GOFF = MODE == 0 ? 3072 : 2048;
  constexpr int YOFF = MODE == 0 ? 512 : 0;
  const int h = item & 3, blk = (item >> 2) & 63, b = item >> 8;
  bf16* QI = (bf16*)smem;
  bf16* KI = QI + 64 * KS;
  bf16* VT = KI + 64 * KS;
  bf16* AI = VT + 128 * 72;
  float* CV = (float*)(AI + 64 * 72);
  float* SSQ = CV + K;
  bf16* LRB = (bf16*)(SSQ + 256);
  const bf16* proj = (const bf16*)(p.ws + WS_PROJ) + (size_t)(b * 4096 + blk * 64) * LDP;
  const bf16* ST = (const bf16*)(p.ws + WS_ST);
  bf16* yb = (bf16*)(p.ws + WS_H);
  const int tid = threadIdx.x, lane = tid & 63, wave = tid >> 6;
  constexpr int VOFF = MODE == 0 ? 2560 : 1536;
  constexpr int QOFF = MODE == 0 ? 2048 : 0;
  constexpr int NQ = K / 32;
  u32x4 rvt[4], rq[4], rz[2][4], rlr[2], stf[2][4][2];
  {
    const int j = tid & 63, cgp = tid >> 6;
#pragma unroll
    for (int cc = 0; cc < 4; ++cc) rvt[cc] = gload16_asm(proj + (size_t)j * LDP + VOFF + h * 128 + (cgp * 4 + cc) * 8);
  }
#pragma unroll
  for (int i = 0; i < NQ; ++i) {
    const int c = i * 256 + tid, ch = c % (K / 8), j = c / (K / 8);
    rq[i] = gload16_asm(proj + (size_t)j * LDP + QOFF + h * K + ch * 8);
    rz[0][i] = gload16_asm(proj + (size_t)j * LDP + (MODE == 0 ? 2304 : 512) + h * K + ch * 8);
  }
  if (MODE == 0) {
    const int ch = tid & 1, j = (tid >> 1) & 63;
    rlr[0] = gload16_asm(proj + (size_t)j * LDP + 3584 + ch * 8);
    rlr[1] = gload16_asm(proj + (size_t)j * LDP + 3600 + ch * 8);
  }
  {
    const bf16* stb = ST + (size_t)((((0 * 4 + b) * 4 + h) * 64 + blk)) * 128 * K;
#pragma unroll
    for (int ks = 0; ks < NQ; ++ks)
#pragma unroll
      for (int vv = 0; vv < 2; ++vv)
        stf[0][ks][vv] = gload16_asm(stb + (size_t)((wave * 2 + vv) * 16 + (lane & 15)) * K + ks * 32 + (lane >> 4) * 8);
  }
  if (MODE == 1) {
    asm volatile("s_waitcnt vmcnt(8)"
                 : "+v"(rvt[0]), "+v"(rvt[1]), "+v"(rvt[2]), "+v"(rvt[3]), "+v"(rq[0]), "+v"(rq[1]), "+v"(rq[2]), "+v"(rq[3]),
                   "+v"(rz[0][0]), "+v"(rz[0][1]), "+v"(rz[0][2]), "+v"(rz[0][3])
                 :: "memory");
  } else {
    asm volatile("s_waitcnt vmcnt(4)"
                 : "+v"(rvt[0]), "+v"(rvt[1]), "+v"(rvt[2]), "+v"(rvt[3]), "+v"(rq[0]), "+v"(rq[1]), "+v"(rz[0][0]), "+v"(rz[0][1]), "+v"(rlr[0]), "+v"(rlr[1])
                 :: "memory");
  }
  {
    const int j = tid & 63, cgp = tid >> 6;
#pragma unroll
    for (int cc = 0; cc < 4; ++cc) {
      const u32x4 u = rvt[cc];
      bf16* dst = VT + ((cgp * 4 + cc) * 8) * 72 + j;
      dst[0 * 72] = (bf16)(u[0] & 0xffffu); dst[1 * 72] = (bf16)(u[0] >> 16);
      dst[2 * 72] = (bf16)(u[1] & 0xffffu); dst[3 * 72] = (bf16)(u[1] >> 16);
      dst[4 * 72] = (bf16)(u[2] & 0xffffu); dst[5 * 72] = (bf16)(u[2] >> 16);
      dst[6 * 72] = (bf16)(u[3] & 0xffffu); dst[7 * 72] = (bf16)(u[3] >> 16);
    }
  }
  f32x4 o[2][4];
#pragma unroll
  for (int vv = 0; vv < 2; ++vv)
#pragma unroll
    for (int it = 0; it < 4; ++it) o[vv][it] = (f32x4){0.f, 0.f, 0.f, 0.f};
#pragma unroll
  for (int d = 0; d < 2; ++d) {
    if (d) __syncthreads();
    if (MODE == 1 && d == 1) {
      asm volatile("s_waitcnt vmcnt(0)" : "+v"(rz[1][0]), "+v"(rz[1][1]), "+v"(rz[1][2]), "+v"(rz[1][3]) :: "memory");
    }
#pragma unroll
    for (int i = 0; i < NQ; ++i) {
      const int c = i * 256 + tid, ch = c % (K / 8), j = c / (K / 8);
      *(u32x4*)(QI + j * KS + ch * 8) = rq[i];
      *(u32x4*)(KI + j * KS + ch * 8) = rz[MODE == 1 ? d : 0][i];
    }
    if (d == 1) {
      const bf16* stb = ST + (size_t)((((1 * 4 + b) * 4 + h) * 64 + blk)) * 128 * K;
#pragma unroll
      for (int ks = 0; ks < NQ; ++ks)
#pragma unroll
        for (int vv = 0; vv < 2; ++vv)
          stf[1][ks][vv] = gload16_asm(stb + (size_t)((wave * 2 + vv) * 16 + (lane & 15)) * K + ks * 32 + (lane >> 4) * 8);
    }
    if (MODE == 1 && d == 0) {
#pragma unroll
      for (int i = 0; i < NQ; ++i) {
        const int c = i * 256 + tid, ch = c % (K / 8), j = c / (K / 8);
        rz[1][i] = gload16_asm(proj + (size_t)j * LDP + 1024 + h * K + ch * 8);
      }
    }
    if (MODE == 0 && tid < 128) {
      const int ch = tid & 1, j = tid >> 1;
      *(u32x4*)(LRB + j * 16 + ch * 8) = rlr[d];
    }
    __syncthreads();
    if (tid < 2 * K) {
      const int k = tid % K, half = tid / K;
      GateC<K, MODE> gc;
      gc.init(p, d, h, k);
      float run = MODE == 1 ? 1.f : 0.f;
      if (half) {
#pragma unroll 4
        for (int i = 32; i < 64; ++i) {
          const int j = d ? 63 - i : i;
          float g, kv, qv;
          gc.eval_vals(QI[j * KS + k], KI[j * KS + k], LRB + j * 16, g, kv, qv);
          if (MODE == 1) {
            run *= g;
            QI[j * KS + k] = f2bf(qv * run);
            KI[j * KS + k] = f2bf(kv * frcp(run));
          } else {
            run += g;
            QI[j * KS + k] = f2bf(qv * __expf(run));
            KI[j * KS + k] = f2bf(kv * __expf(-run));
          }
        }
      } else {
#pragma unroll 4
        for (int i = 31; i >= 0; --i) {
          const int j = d ? 63 - i : i;
          float g, kv, qv;
          gc.eval_vals(QI[j * KS + k], KI[j * KS + k], LRB + j * 16, g, kv, qv);
          if (MODE == 1) {
            QI[j * KS + k] = f2bf(qv * frcp(run));
            KI[j * KS + k] = f2bf(kv * run);
            run *= g;
          } else {
            QI[j * KS + k] = f2bf(qv * __expf(-run));
            KI[j * KS + k] = f2bf(kv * __expf(run));
            run += g;
          }
        }
        CV[k] = MODE == 1 ? run : __expf(run);
      }
    }
    __syncthreads();
    {
      f32x4 a[4];
#pragma unroll
      for (int jt = 0; jt < 4; ++jt) a[jt] = (f32x4){0.f, 0.f, 0.f, 0.f};
#pragma unroll
      for (int ks = 0; ks < K / 32; ++ks) {
        bf16x8 qf = *(const bf16x8*)(QI + (wave * 16 + (lane & 15)) * KS + ks * 32 + (lane >> 4) * 8);
#pragma unroll
        for (int jt = 0; jt < 4; ++jt) {
          bf16x8 kf = *(const bf16x8*)(KI + (jt * 16 + (lane & 15)) * KS + ks * 32 + (lane >> 4) * 8);
          a[jt] = __builtin_amdgcn_mfma_f32_16x16x32_bf16(kf, qf, a[jt], 0, 0, 0);
        }
      }
      const int i = wave * 16 + (lane & 15);
#pragma unroll
      for (int jt = 0; jt < 4; ++jt) {
        const int j0 = jt * 16 + (lane >> 4) * 4;
        f32x4 m;
#pragma unroll
        for (int r = 0; r < 4; ++r) {
          const int j = j0 + r;
          const bool valid = d ? (j >= i) : (j <= i);
          m[r] = valid ? a[jt][r] : 0.f;
        }
        *(uint2*)(AI + i * 72 + j0) = pack4(m);
      }
    }
    __syncthreads();
#pragma unroll
    for (int ks = 0; ks < 2; ++ks) {
      bf16x8 vf0 = *(const bf16x8*)(VT + ((wave * 2 + 0) * 16 + (lane & 15)) * 72 + ks * 32 + (lane >> 4) * 8);
      bf16x8 vf1 = *(const bf16x8*)(VT + ((wave * 2 + 1) * 16 + (lane & 15)) * 72 + ks * 32 + (lane >> 4) * 8);
#pragma unroll
      for (int it = 0; it < 4; ++it) {
        bf16x8 af = *(const bf16x8*)(AI + (it * 16 + (lane & 15)) * 72 + ks * 32 + (lane >> 4) * 8);
        o[0][it] = __builtin_amdgcn_mfma_f32_16x16x32_bf16(vf0, af, o[0][it], 0, 0, 0);
        o[1][it] = __builtin_amdgcn_mfma_f32_16x16x32_bf16(vf1, af, o[1][it], 0, 0, 0);
      }
    }
    if (d == 0) {
      if (K == 128) {
        asm volatile("s_waitcnt vmcnt(4)"
                     : "+v"(stf[0][0][0]), "+v"(stf[0][0][1]), "+v"(stf[0][1][0]), "+v"(stf[0][1][1]), "+v"(stf[0][2][0]), "+v"(stf[0][2][1]), "+v"(stf[0][3][0]), "+v"(stf[0][3][1])
                     :: "memory");
      } else {
        asm volatile("s_waitcnt vmcnt(0)" : "+v"(stf[0][0][0]), "+v"(stf[0][0][1]), "+v"(stf[0][1][0]), "+v"(stf[0][1][1]) :: "memory");
      }
    } else {
      if (K == 128) {
        asm volatile("s_waitcnt vmcnt(0)"
                     : "+v"(stf[1][0][0]), "+v"(stf[1][0][1]), "+v"(stf[1][1][0]), "+v"(stf[1][1][1]), "+v"(stf[1][2][0]), "+v"(stf[1][2][1]), "+v"(stf[1][3][0]), "+v"(stf[1][3][1])
                     :: "memory");
      } else {
        asm volatile("s_waitcnt vmcnt(0)" : "+v"(stf[1][0][0]), "+v"(stf[1][0][1]), "+v"(stf[1][1][0]), "+v"(stf[1][1][1]) :: "memory");
      }
    }
#pragma unroll
    for (int ks = 0; ks < K / 32; ++ks) {
      const int kk = ks * 32 + (lane >> 4) * 8;
      bf16x8 sf[2];
      sf[0] = *(bf16x8*)&stf[d][ks][0];
      sf[1] = *(bf16x8*)&stf[d][ks][1];
#pragma unroll
      for (int it = 0; it < 4; ++it) {
        bf16x8 qf = *(const bf16x8*)(QI + (it * 16 + (lane & 15)) * KS + kk);
        o[0][it] = __builtin_amdgcn_mfma_f32_16x16x32_bf16(sf[0], qf, o[0][it], 0, 0, 0);
        o[1][it] = __builtin_amdgcn_mfma_f32_16x16x32_bf16(sf[1], qf, o[1][it], 0, 0, 0);
      }
    }
  }
  {
    float ss[4];
#pragma unroll
    for (int it = 0; it < 4; ++it) {
      float s = 0.f;
#pragma unroll
      for (int vv = 0; vv < 2; ++vv)
#pragma unroll
        for (int r = 0; r < 4; ++r) s += o[vv][it][r] * o[vv][it][r];
      s += __shfl_xor(s, 16, 64);
      s += __shfl_xor(s, 32, 64);
      ss[it] = s;
    }
    if (lane < 16) {
#pragma unroll
      for (int it = 0; it < 4; ++it) SSQ[wave * 64 + it * 16 + lane] = ss[it];
    }
    __syncthreads();
    const float* gn = MODE == 0 ? p.gla_g : p.hgrn_g;
#pragma unroll
    for (int it = 0; it < 4; ++it) {
      const int i = it * 16 + (lane & 15);
      const float tot = SSQ[i] + SSQ[64 + i] + SSQ[128 + i] + SSQ[192 + i];
      const float rs = rsqrtf(tot * (1.f / 128.f) + 1e-6f);
#pragma unroll
      for (int vv = 0; vv < 2; ++vv) {
        const int v0 = (wave * 2 + vv) * 16 + (lane >> 4) * 4;
        uint2 gu = *(const uint2*)(proj + (size_t)i * LDP + GOFF + h * 128 + v0);
        float4 gg = *(const float4*)(gn + v0);
        f32x4 y;
        y[0] = o[vv][it][0] * rs * gg.x * silu_f(__uint_as_float(gu.x << 16));
        y[1] = o[vv][it][1] * rs * gg.y * silu_f(__uint_as_float(gu.x & 0xffff0000u));
        y[2] = o[vv][it][2] * rs * gg.z * silu_f(__uint_as_float(gu.y << 16));
        y[3] = o[vv][it][3] * rs * gg.w * silu_f(__uint_as_float(gu.y & 0xffff0000u));
        if (MODE == 1) *(uint2*)((bf16*)proj + (size_t)i * LDP + GOFF + h * 128 + v0) = pack4(y);
        else *(uint2*)(yb + (size_t)(b * 4096 + blk * 64 + i) * 1024 + YOFF + h * 128 + v0) = pack4(y);
      }
    }
  }
}

__device__ __forceinline__ void conv8(const P& p, const bf16* projb, int t, int c0, float* o8) {
  c0 = __builtin_amdgcn_readfirstlane(c0);
  float4 b0 = *(const float4*)(p.conv_b + c0), b1 = *(const float4*)(p.conv_b + c0 + 4);
  float a[8] = {b0.x, b0.y, b0.z, b0.w, b1.x, b1.y, b1.z, b1.w};
#pragma unroll
  for (int jt = 0; jt < 4; ++jt) {
    const int tt = t + jt - 2;
    if (tt >= 0 && tt < 4096) {
      uint4 u = *(const uint4*)(projb + (size_t)tt * ODD_N + 3072 + c0);
      float4 w0 = *(const float4*)(p.conv_w + jt * 1024 + c0), w1 = *(const float4*)(p.conv_w + jt * 1024 + c0 + 4);
      a[0] += w0.x * __uint_as_float(u.x << 16); a[1] += w0.y * __uint_as_float(u.x & 0xffff0000u);
      a[2] += w0.z * __uint_as_float(u.y << 16); a[3] += w0.w * __uint_as_float(u.y & 0xffff0000u);
      a[4] += w1.x * __uint_as_float(u.z << 16); a[5] += w1.y * __uint_as_float(u.z & 0xffff0000u);
      a[6] += w1.z * __uint_as_float(u.w << 16); a[7] += w1.w * __uint_as_float(u.w & 0xffff0000u);
    }
  }
#pragma unroll
  for (int e = 0; e < 8; ++e) o8[e] = silu_f(a[e]);
}

__device__ __forceinline__ void conv8u(const P& p, const bf16* projb, int t, int c0, float* o8) {
  c0 = __builtin_amdgcn_readfirstlane(c0);
  float4 b0 = *(const float4*)(p.conv_b + c0), b1 = *(const float4*)(p.conv_b + c0 + 4);
  float a[8] = {b0.x, b0.y, b0.z, b0.w, b1.x, b1.y, b1.z, b1.w};
  uint4 u[4];
#pragma unroll
  for (int jt = 0; jt < 4; ++jt) {
    int tt = t + jt - 2;
    tt = tt < 0 ? 0 : (tt > 4095 ? 4095 : tt);
    u[jt] = *(const uint4*)(projb + (size_t)tt * ODD_N + 3072 + c0);
  }
#pragma unroll
  for (int jt = 0; jt < 4; ++jt) {
    const int tt = t + jt - 2;
    const float ok = (tt >= 0 && tt < 4096) ? 1.f : 0.f;
    float4 w0 = *(const float4*)(p.conv_w + jt * 1024 + c0), w1 = *(const float4*)(p.conv_w + jt * 1024 + c0 + 4);
    a[0] += ok * w0.x * __uint_as_float(u[jt].x << 16); a[1] += ok * w0.y * __uint_as_float(u[jt].x & 0xffff0000u);
    a[2] += ok * w0.z * __uint_as_float(u[jt].y << 16); a[3] += ok * w0.w * __uint_as_float(u[jt].y & 0xffff0000u);
    a[4] += ok * w1.x * __uint_as_float(u[jt].z << 16); a[5] += ok * w1.y * __uint_as_float(u[jt].z & 0xffff0000u);
    a[6] += ok * w1.z * __uint_as_float(u[jt].w << 16); a[7] += ok * w1.w * __uint_as_float(u[jt].w & 0xffff0000u);
  }
#pragma unroll
  for (int e = 0; e < 8; ++e) o8[e] = silu_f(a[e]);
}

__device__ __forceinline__ void ssd_prep_acum(const P& p, const bf16* projb, int blk, int g, float* ACUM, float* DTV, float* TOT) {
  const int lane = threadIdx.x & 63, wave = threadIdx.x >> 6;
#pragma unroll
  for (int q = 0; q < 2; ++q) {
    const int c = wave * 2 + q, dir = c >> 2, rp = c & 3, head = g * 4 + rp;
    const int j = dir ? 63 - lane : lane;
    const int t = blk * 64 + j;
    const float dt = softplus_f(bf2f(projb[(size_t)t * ODD_N + 4096 + dir * 8 + head]) + p.dt_bias[dir * 8 + head]);
    float v = -__expf(p.a_log[dir * 8 + head]) * dt;
#pragma unroll
    for (int off = 1; off < 64; off <<= 1) {
      float tmp = __shfl_up(v, off, 64);
      if (lane >= off) v += tmp;
    }
    ACUM[c * 64 + j] = v;
    DTV[c * 64 + j] = dt;
    if (lane == 63) TOT[c] = v;
  }
}

__device__ __forceinline__ bf16* ssd_st(const P& p, int s) {
  return s < 32 ? (bf16*)(p.ws + WS_H) + (size_t)s * 524288 : (bf16*)((unsigned char*)p.out + 33554432) + (size_t)(s - 32) * 524288;
}
__device__ __forceinline__ void ssd_pass1_item(const P& p, int item, unsigned char* smem) {
  const int g = item & 1, blk = (item >> 1) & 63, b = item >> 7;
  bf16* BT = (bf16*)smem;
  bf16* XT = BT + 128 * 72;
  float* ACUM = (float*)(XT + 256 * 72);
  float* DTV = ACUM + 512;
  float* TOT = DTV + 512;
  const bf16* projb = (const bf16*)(p.ws + WS_PROJ) + (size_t)b * 4096 * ODD_N;
  float* DEC = (float*)(p.ws + WS_DECS);
  const int tid = threadIdx.x, lane = tid & 63, wave = tid >> 6;
  const int t = blk * 64 + lane;
  ssd_prep_acum(p, projb, blk, g, ACUM, DTV, TOT);
#pragma unroll 2
  for (int q = 0; q < 4; ++q) {
    const int cc = wave + 4 * q;
    float v8[8];
    conv8(p, projb, t, 512 + g * 128 + cc * 8, v8);
#pragma unroll
    for (int e = 0; e < 8; ++e) BT[(cc * 8 + e) * 72 + lane] = f2bf(v8[e]);
  }
  float xs[8][8];
#pragma unroll
  for (int q = 0; q < 8; ++q) conv8(p, projb, t, g * 256 + (wave * 8 + q) * 8, xs[q]);
  __syncthreads();
  if (tid < 8) {
    const int dir = tid >> 2, head = g * 4 + (tid & 3);
    DEC[(size_t)((dir * 4 + b) * 8 + head) * 64 + blk] = __expf(TOT[tid]);
  }
#pragma unroll 1
  for (int dir = 0; dir < 2; ++dir) {
    if (dir) __syncthreads();
    const int c = dir * 4 + wave;
    const float fac = DTV[c * 64 + lane] * __expf(TOT[c] - ACUM[c * 64 + lane]);
#pragma unroll
    for (int q = 0; q < 8; ++q)
#pragma unroll
      for (int e = 0; e < 8; ++e) XT[((wave * 8 + q) * 8 + e) * 72 + lane] = f2bf(xs[q][e] * fac);
    __syncthreads();
    const int head = g * 4 + wave;
    bf16* stb = ssd_st(p, (dir * 4 + b) * 8 + head) + (size_t)blk * 8192;
#pragma unroll 1
    for (int nh = 0; nh < 4; ++nh) {
      f32x4 acc[2][4];
#pragma unroll
      for (int nt = 0; nt < 2; ++nt)
#pragma unroll
        for (int pt = 0; pt < 4; ++pt) acc[nt][pt] = (f32x4){0.f, 0.f, 0.f, 0.f};
#pragma unroll
      for (int ks = 0; ks < 2; ++ks) {
        bf16x8 xf[4];
#pragma unroll
        for (int pt = 0; pt < 4; ++pt) xf[pt] = *(const bf16x8*)(XT + (wave * 64 + pt * 16 + (lane & 15)) * 72 + ks * 32 + (lane >> 4) * 8);
#pragma unroll
        for (int nt = 0; nt < 2; ++nt) {
          bf16x8 bfv = *(const bf16x8*)(BT + ((nh * 2 + nt) * 16 + (lane & 15)) * 72 + ks * 32 + (lane >> 4) * 8);
#pragma unroll
          for (int pt = 0; pt < 4; ++pt) acc[nt][pt] = __builtin_amdgcn_mfma_f32_16x16x32_bf16(bfv, xf[pt], acc[nt][pt], 0, 0, 0);
        }
      }
#pragma unroll
      for (int nt = 0; nt < 2; ++nt)
#pragma unroll
        for (int pt = 0; pt < 4; ++pt) {
          const int pp = pt * 16 + (lane & 15);
          const int n0 = (nh * 2 + nt) * 16 + (lane >> 4) * 4;
          *(uint2*)(stb + (size_t)pp * 128 + n0) = pack4(acc[nt][pt]);
        }
    }
  }
}

__device__ __forceinline__ void phase_ssd_scan(const P& p) {
  const float* DEC = (const float*)(p.ws + WS_DECS);
  const int total = 64 * 2048;
  for (int idx = blockIdx.x * 256 + threadIdx.x; idx < total; idx += gridDim.x * 256) {
    const int e4 = idx & 2047, s = idx >> 11;
    const int d = s >> 5;
    bf16* ST = ssd_st(p, s);
    float st0 = 0.f, st1 = 0.f, st2 = 0.f, st3 = 0.f;
#pragma unroll 1
    for (int n0 = 0; n0 < 64; n0 += 8) {
      uint2 u[8];
      float dc[8];
#pragma unroll
      for (int q = 0; q < 8; ++q) {
        const int blk = d ? 63 - (n0 + q) : (n0 + q);
        u[q] = *(const uint2*)(ST + (size_t)blk * 8192 + e4 * 4);
        dc[q] = DEC[s * 64 + blk];
      }
#pragma unroll
      for (int q = 0; q < 8; ++q) {
        const int blk = d ? 63 - (n0 + q) : (n0 + q);
        uint2 o;
        o.x = (unsigned)f2bf(st0) | ((unsigned)f2bf(st1) << 16);
        o.y = (unsigned)f2bf(st2) | ((unsigned)f2bf(st3) << 16);
        *(uint2*)(ST + (size_t)blk * 8192 + e4 * 4) = o;
        st0 = dc[q] * st0 + __uint_as_float(u[q].x << 16);
        st1 = dc[q] * st1 + __uint_as_float(u[q].x & 0xffff0000u);
        st2 = dc[q] * st2 + __uint_as_float(u[q].y << 16);
        st3 = dc[q] * st3 + __uint_as_float(u[q].y & 0xffff0000u);
      }
    }
  }
}

__device__ __forceinline__ void ssd_pass3_item(const P& p, int item, unsigned char* smem) {
  const int g = item & 1, blk = (item >> 1) & 63, b = item >> 7;
  bf16* CI = (bf16*)smem;
  bf16* BI = CI + 64 * 136;
  bf16* AI = BI;
  bf16* XT = BI + 64 * 136;
  float* ACUM = (float*)(XT + 64 * 72);
  float* DTV = ACUM + 512;
  float* TOT = DTV + 512;
  float* SSQ = TOT + 8;
  bf16* projb = (bf16*)(p.ws + WS_PROJ) + (size_t)b * 4096 * ODD_N;
  const int tid = threadIdx.x, lane = tid & 63, wave = tid >> 6;
  const int t = blk * 64 + lane;
  ssd_prep_acum(p, projb, blk, g, ACUM, DTV, TOT);
#pragma unroll 4
  for (int q = 0; q < 8; ++q) {
    const int cc = wave * 8 + q, which = cc >> 4, ch = (cc & 15) * 8;
    float v8[8];
    conv8u(p, projb, t, 512 + which * 256 + g * 128 + ch, v8);
    uint4 w;
    w.x = (unsigned)f2bf(v8[0]) | ((unsigned)f2bf(v8[1]) << 16);
    w.y = (unsigned)f2bf(v8[2]) | ((unsigned)f2bf(v8[3]) << 16);
    w.z = (unsigned)f2bf(v8[4]) | ((unsigned)f2bf(v8[5]) << 16);
    w.w = (unsigned)f2bf(v8[6]) | ((unsigned)f2bf(v8[7]) << 16);
    *(uint4*)((which ? CI : BI) + lane * 136 + ch) = w;
  }
  __syncthreads();
  f32x4 gt[4];
#pragma unroll
  for (int jt = 0; jt < 4; ++jt) gt[jt] = (f32x4){0.f, 0.f, 0.f, 0.f};
#pragma unroll
  for (int ks = 0; ks < 4; ++ks) {
    bf16x8 cf = *(const bf16x8*)(CI + (wave * 16 + (lane & 15)) * 136 + ks * 32 + (lane >> 4) * 8);
#pragma unroll
    for (int jt = 0; jt < 4; ++jt) {
      bf16x8 bfv = *(const bf16x8*)(BI + (jt * 16 + (lane & 15)) * 136 + ks * 32 + (lane >> 4) * 8);
      gt[jt] = __builtin_amdgcn_mfma_f32_16x16x32_bf16(bfv, cf, gt[jt], 0, 0, 0);
    }
  }
  __syncthreads();
  float ssq_acc[4] = {0.f, 0.f, 0.f, 0.f};
#pragma unroll 1
  for (int rp = 0; rp < 4; ++rp) {
    const int head = g * 4 + rp;
    u32x4 stf[2][4];
    u32x2 zur[4];
#pragma unroll
    for (int dir = 0; dir < 2; ++dir) {
      const bf16* stb = ssd_st(p, (dir * 4 + b) * 8 + head) + (size_t)blk * 8192;
#pragma unroll
      for (int ks = 0; ks < 4; ++ks) stf[dir][ks] = gload16_asm(stb + (size_t)(wave * 16 + (lane & 15)) * 128 + ks * 32 + (lane >> 4) * 8);
    }
#pragma unroll
    for (int it = 0; it < 4; ++it)
      zur[it] = gload8_asm(projb + (size_t)(blk * 64 + it * 16 + (lane & 15)) * ODD_N + 2560 + head * 64 + wave * 16 + (lane >> 4) * 4);
#pragma unroll 2
    for (int q = 0; q < 2; ++q) {
      const int cc = wave * 2 + q;
      float v8[8];
      conv8u(p, projb, t, head * 64 + cc * 8, v8);
#pragma unroll
      for (int e = 0; e < 8; ++e) XT[(cc * 8 + e) * 72 + lane] = f2bf(v8[e]);
    }
    f32x4 o[4];
#pragma unroll
    for (int it = 0; it < 4; ++it) o[it] = (f32x4){0.f, 0.f, 0.f, 0.f};
#pragma unroll
    for (int dir = 0; dir < 2; ++dir) {
      const int c = dir * 4 + rp;
      {
        const int i = wave * 16 + (lane & 15);
        const float aci = ACUM[c * 64 + i];
#pragma unroll
        for (int jt = 0; jt < 4; ++jt) {
          const int j0 = jt * 16 + (lane >> 4) * 4;
          f32x4 m;
#pragma unroll
          for (int r = 0; r < 4; ++r) {
            const int j = j0 + r;
            const bool valid = dir ? (j >= i) : (j <= i);
            const float arg = fminf(aci - ACUM[c * 64 + j], 0.f);
            m[r] = valid ? gt[jt][r] * __expf(arg) * DTV[c * 64 + j] : 0.f;
          }
          *(uint2*)(AI + i * 72 + j0) = pack4(m);
        }
      }
      __syncthreads();
#pragma unroll
      for (int ks = 0; ks < 2; ++ks) {
        bf16x8 xf = *(const bf16x8*)(XT + (wave * 16 + (lane & 15)) * 72 + ks * 32 + (lane >> 4) * 8);
#pragma unroll
        for (int it = 0; it < 4; ++it) {
          bf16x8 af = *(const bf16x8*)(AI + (it * 16 + (lane & 15)) * 72 + ks * 32 + (lane >> 4) * 8);
          o[it] = __builtin_amdgcn_mfma_f32_16x16x32_bf16(xf, af, o[it], 0, 0, 0);
        }
      }
      f32x4 tI[4];
#pragma unroll
      for (int it = 0; it < 4; ++it) tI[it] = (f32x4){0.f, 0.f, 0.f, 0.f};
      asm volatile("s_waitcnt vmcnt(0)" : "+v"(stf[dir][0]), "+v"(stf[dir][1]), "+v"(stf[dir][2]), "+v"(stf[dir][3]) :: "memory");
#pragma unroll
      for (int ks = 0; ks < 4; ++ks) {
        bf16x8 sf = *(bf16x8*)&stf[dir][ks];
#pragma unroll
        for (int it = 0; it < 4; ++it) {
          bf16x8 cf = *(const bf16x8*)(CI + (it * 16 + (lane & 15)) * 136 + ks * 32 + (lane >> 4) * 8);
          tI[it] = __builtin_amdgcn_mfma_f32_16x16x32_bf16(sf, cf, tI[it], 0, 0, 0);
        }
      }
#pragma unroll
      for (int it = 0; it < 4; ++it) {
        const float ea = __expf(ACUM[c * 64 + it * 16 + (lane & 15)]);
#pragma unroll
        for (int r = 0; r < 4; ++r) o[it][r] += ea * tI[it][r];
      }
      __syncthreads();
    }
    {
      asm volatile("s_waitcnt vmcnt(0)" : "+v"(zur[0]), "+v"(zur[1]), "+v"(zur[2]), "+v"(zur[3]) :: "memory");
      const float dsk = p.d_skip[head];
      const int p0 = wave * 16 + (lane >> 4) * 4;
      float4 gg = *(const float4*)(p.ssm_g + head * 64 + p0);
#pragma unroll
      for (int it = 0; it < 4; ++it) {
        const int i = it * 16 + (lane & 15);
        uint2 zu; zu.x = zur[it][0]; zu.y = zur[it][1];
        f32x4 y;
        y[0] = (o[it][0] + dsk * bf2f(XT[(p0 + 0) * 72 + i])) * silu_f(__uint_as_float(zu.x << 16));
        y[1] = (o[it][1] + dsk * bf2f(XT[(p0 + 1) * 72 + i])) * silu_f(__uint_as_float(zu.x & 0xffff0000u));
        y[2] = (o[it][2] + dsk * bf2f(XT[(p0 + 2) * 72 + i])) * silu_f(__uint_as_float(zu.y << 16));
        y[3] = (o[it][3] + dsk * bf2f(XT[(p0 + 3) * 72 + i])) * silu_f(__uint_as_float(zu.y & 0xffff0000u));
        ssq_acc[it] += y[0] * y[0] + y[1] * y[1] + y[2] * y[2] + y[3] * y[3];
        y[0] *= gg.x; y[1] *= gg.y; y[2] *= gg.z; y[3] *= gg.w;
        *(uint2*)(projb + (size_t)(blk * 64 + i) * ODD_N + 2560 + head * 64 + p0) = pack4(y);
      }
    }
    __syncthreads();
  }
#pragma unroll
  for (int it = 0; it < 4; ++it) {
    float s = ssq_acc[it];
    s += __shfl_xor(s, 16, 64);
    s += __shfl_xor(s, 32, 64);
    if (lane < 16) SSQ[wave * 64 + it * 16 + lane] = s;
  }
  __syncthreads();
  if (tid < 64) {
    float* ssqp = (float*)(p.ws + WS_SSQ);
    ssqp[(size_t)g * M_TOK + (size_t)b * 4096 + blk * 64 + tid] = SSQ[tid] + SSQ[64 + tid] + SSQ[128 + tid] + SSQ[192 + tid];
  }
}

__device__ __forceinline__ void phase_ssd_norm(const P& p) {
  const float* ssqp = (const float*)(p.ws + WS_SSQ);
  bf16* yb = (bf16*)(p.ws + WS_H);
  const int total = M_TOK * 64;
  for (int idx = blockIdx.x * 256 + threadIdx.x; idx < total; idx += gridDim.x * 256) {
    const int tok = idx >> 6, c8 = (idx & 63) * 8;
    const float rs = rsqrtf((ssqp[tok] + ssqp[M_TOK + tok]) * (1.f / 512.f) + 1e-6f);
    uint4* ptr = (uint4*)(yb + (size_t)tok * 1024 + 512 + c8);
    uint4 u = *ptr, w;
    w.x = (unsigned)f2bf(__uint_as_float(u.x << 16) * rs) | ((unsigned)f2bf(__uint_as_float(u.x & 0xffff0000u) * rs) << 16);
    w.y = (unsigned)f2bf(__uint_as_float(u.y << 16) * rs) | ((unsigned)f2bf(__uint_as_float(u.y & 0xffff0000u) * rs) << 16);
    w.z = (unsigned)f2bf(__uint_as_float(u.z << 16) * rs) | ((unsigned)f2bf(__uint_as_float(u.z & 0xffff0000u) * rs) << 16);
    w.w = (unsigned)f2bf(__uint_as_float(u.w << 16) * rs) | ((unsigned)f2bf(__uint_as_float(u.w & 0xffff0000u) * rs) << 16);
    *ptr = w;
  }
}


#define XB_TMO      128
#define XB_XCNT(j)  (256  + 64 * (j))
#define XB_XSUB(j)  (1280 + 64 * (j))
#define XB_XGEN(j)  (2304 + 64 * (j))
#define XB_TOP      3328
#define XB_TOPGEN   3392
#define XCD_BAR_WORDS 3456
#define XB_SPIN_CAP (1u << 18)
#define LAS __attribute__((address_space(3)))
__device__ __forceinline__ unsigned xb_ld(unsigned* p) { return __hip_atomic_load(p, __ATOMIC_RELAXED, __HIP_MEMORY_SCOPE_AGENT); }
__device__ __forceinline__ unsigned xb_add(unsigned* p, unsigned v) { return __hip_atomic_fetch_add(p, v, __ATOMIC_RELAXED, __HIP_MEMORY_SCOPE_AGENT); }
__device__ __forceinline__ unsigned xb_xcc_id() { return (unsigned)__builtin_amdgcn_s_getreg((3 << 11) | 20) & 0xFu; }
#define XB_SPIN(cond, bar) do { unsigned _sp = 0; while (cond) { __builtin_amdgcn_s_sleep(1); \
    if ((++_sp & 255u) == 0u) { if (xb_ld(&(bar)[XB_TMO])) break; if (_sp > XB_SPIN_CAP) { atomicAdd(&(bar)[XB_TMO], 1u); break; } } } } while (0)
struct XcdBarrier { unsigned* bar; unsigned x; volatile LAS unsigned* st; };
__device__ __forceinline__ XcdBarrier xcd_barrier_post(unsigned* bar, volatile LAS unsigned* st) {
  XcdBarrier b; b.bar = bar; b.x = xb_xcc_id(); b.st = st;
  if (threadIdx.x == 0) (void)xb_add(&bar[XB_XCNT(b.x)], 1u);
  return b;
}
__device__ __forceinline__ void xcd_barrier_complete(unsigned* bar, unsigned x, unsigned& nloc, unsigned& nx) {
  const unsigned G = gridDim.x * gridDim.y * gridDim.z;
  unsigned sum, cnt, mine, sp = 0u;
  for (;;) {
    sum = 0u; cnt = 0u; mine = 0u;
#pragma unroll
    for (unsigned j = 0; j < 16; ++j) { const unsigned c = xb_ld(&bar[XB_XCNT(j)]); sum += c; cnt += (c > 0u) ? 1u : 0u; mine = (j == x) ? c : mine; }
    if (sum == G) break;
    __builtin_amdgcn_s_sleep(1);
    if ((++sp & 255u) == 0u) { if (xb_ld(&bar[XB_TMO])) break; if (sp > XB_SPIN_CAP) { atomicAdd(&bar[XB_TMO], 1u); break; } }
  }
  nloc = mine > 0u ? mine : 1u; nx = cnt > 0u ? cnt : 1u;
}
__device__ __forceinline__ void xcd_barrier(const XcdBarrier& b) {
  asm volatile("s_waitcnt vmcnt(0)" ::: "memory");
  __syncthreads();
  if (threadIdx.x == 0) {
    unsigned* bar = b.bar;
    __builtin_amdgcn_s_waitcnt(0);
    unsigned nloc = b.st[0], nx = b.st[1];
    if (nloc == 0u) { xcd_barrier_complete(bar, b.x, nloc, nx); b.st[0] = nloc; b.st[1] = nx; }
    const unsigned old = xb_add(&bar[XB_XSUB(b.x)], 1u);
    const unsigned gen = old / nloc;
    if (old + 1u == (gen + 1u) * nloc) {
      __builtin_amdgcn_fence(__ATOMIC_RELEASE, "agent");
      asm volatile("s_waitcnt vmcnt(0)" ::: "memory");
      const unsigned og = xb_add(&bar[XB_TOP], 1u);
      const unsigned tg = og / nx;
      if (og + 1u == (tg + 1u) * nx) xb_add(&bar[XB_TOPGEN], 1u);
      else XB_SPIN(xb_ld(&bar[XB_TOPGEN]) == tg, bar);
      __builtin_amdgcn_fence(__ATOMIC_ACQUIRE, "agent");
      xb_add(&bar[XB_XGEN(b.x)], 1u);
      asm volatile("s_waitcnt vmcnt(0)" ::: "memory");
    } else {
      XB_SPIN(xb_ld(&bar[XB_XGEN(b.x)]) == gen, bar);
      __builtin_amdgcn_fence(__ATOMIC_ACQUIRE, "agent");
      asm volatile("s_waitcnt vmcnt(0)" ::: "memory");
    }
  }
  __syncthreads();
}

#define NPHASE 14
__global__ void __launch_bounds__(256, 2) mega(P p, int ph_lo, int ph_hi) {
  __shared__ __align__(16) unsigned char smem[73728 + 16 + (PROBE_PH >= 0 ? 256 : 0)];
  cg::grid_group grid = cg::this_grid();
  if (ph_lo < 0) grid.sync();
  if (threadIdx.x == 0) *(uint4*)(smem + 73728) = make_uint4(0u, 0u, 0u, 0u);
  __syncthreads();
  XcdBarrier xb = xcd_barrier_post((unsigned*)(p.ws + WS_BAR), (volatile LAS unsigned*)(smem + 73728));
  const float* mod = (const float*)(p.ws + WS_MOD);
#define IN(k) (ph_lo <= (k) && (k) < ph_hi)
#define SYNC(k) if (IN(k) && (k) + 1 < ph_hi) { xcd_barrier(xb); if (PROBE_PH >= 0 && blockIdx.x == 0 && threadIdx.x == 0) ((long long*)(smem + 73744))[(k) + 1] = __builtin_amdgcn_s_memrealtime(); }
  if (PROBE_PH >= 0 && blockIdx.x == 0 && threadIdx.x == 0) ((long long*)(smem + 73744))[0] = __builtin_amdgcn_s_memrealtime();
  if (IN(0)) phase_setup(p, smem);
  SYNC(0)
  if (IN(1)) phase_h0(p);
  SYNC(1)
  if (IN(2))
    phase_gemm<0>((const bf16*)(p.ws + WS_H), 1024, (const bf16*)(p.ws + WS_WEI), EVEN_NP / 128, smem,
                  (bf16*)(p.ws + WS_PROJ), EVEN_N, EVEN_N, nullptr, nullptr, nullptr, (unsigned*)(p.ws + WS_BAR), 0);
  SYNC(2)
  if (IN(3)) {
    for (int it = blockIdx.x; it < 1024; it += gridDim.x) { rec_pass1_item<64, 0>(p, it, smem); __syncthreads(); }
  }
  SYNC(3)
  if (IN(4)) {
    phase_rec_scan<64>(p);
    for (int it = blockIdx.x; it < 2048 * REPN + 16 * 66 + 256; it += gridDim.x) {
      if (it < 2048 * REPN) na_item(p, it & 2047, smem);
      else if (it < 2048 * REPN + 16 * 66) transpose_item(p.o_w_in, ODD_N, (bf16*)(p.ws + WS_WOI), it - 2048 * REPN, smem);
      else transpose_item(p.o_w_out, 1024, (bf16*)(p.ws + WS_WOO), it - 2048 * REPN - 16 * 66, smem);
      __syncthreads();
    }
  }
  SYNC(4)
  if (IN(5)) {
    for (int it = blockIdx.x; it < 1024 * REPR; it += gridDim.x) { rec_pass3_item<64, 0>(p, it & 1023, smem); __syncthreads(); }
  }
  SYNC(5)
  if (IN(6))
    phase_gemm<1>((const bf16*)(p.ws + WS_H), 1024, (const bf16*)(p.ws + WS_WEO), 8, smem, nullptr, 0, 0, p.x, (float*)(p.ws + WS_ST),
                  mod + 2048, (unsigned*)(p.ws + WS_BAR), 1);
  SYNC(6)
  if (IN(7)) phase_ln(p, 0, true);
  SYNC(7)
  if (IN(8))
    phase_gemm<0>((const bf16*)(p.ws + WS_H), 1024, (const bf16*)(p.ws + WS_WOI), ODD_NP / 128, smem,
                  (bf16*)(p.ws + WS_PROJ), ODD_N, ODD_N, nullptr, nullptr, nullptr, (unsigned*)(p.ws + WS_BAR), 2);
  SYNC(8)
  if (IN(9)) {
    for (int it = blockIdx.x; it < 512 + 1024; it += gridDim.x) {
      if (it < 512) ssd_pass1_item(p, it, smem); else rec_pass1_item<128, 1>(p, it - 512, smem);
      __syncthreads();
    }
  }
  SYNC(9)
  if (IN(10)) { phase_rec_scan<128>(p); phase_ssd_scan(p); }
  SYNC(10)
  if (IN(11)) {
    for (int it = blockIdx.x; it < 512 + 1024; it += gridDim.x) {
      if (it < 512) ssd_pass3_item(p, it, smem); else rec_pass3_item<128, 1>(p, it - 512, smem);
      __syncthreads();
    }
  }
  SYNC(11)
  if (IN(12))
    phase_gemm<2>((const bf16*)(p.ws + WS_PROJ) + 2048, ODD_N, (const bf16*)(p.ws + WS_WOO), 8, smem, nullptr, 0, 0,
                  (const float*)p.out, (float*)(p.ws + WS_ST), mod + 4 * 3072 + 2048, (unsigned*)(p.ws + WS_BAR), 3,
                  (const float*)(p.ws + WS_SSQ));
  SYNC(12)
  if (IN(13)) phase_ln(p, 1, false, smem + 73744);
}

extern "C" void kernel_launch(void* const* d_in, const int* in_sizes, int n_in, void* d_out, int out_size, void* d_ws,
                              size_t ws_size, hipStream_t stream) {
  static int grid_blocks = 0;
  if (!grid_blocks) {
    int dev = 0, cus = 0, per_cu = 0;
    hipGetDevice(&dev);
    hipDeviceGetAttribute(&cus, hipDeviceAttributeMultiprocessorCount, dev);
    hipOccupancyMaxActiveBlocksPerMultiprocessor(&per_cu, mega, 256, 0);
    if (per_cu < 1) per_cu = 1;
    if (per_cu > 2) per_cu = 2;
    grid_blocks = cus * per_cu;
    if (n_in != 22 || ws_size < WS_END) {
      fprintf(stderr, "kernel_launch: unexpected n_in %d / ws_size %zu (need %llu)\n", n_in, ws_size, (unsigned long long)WS_END);
      grid_blocks = -1;
    }
  }
  if (grid_blocks < 0) return;
  P p{};
  const float** f = (const float**)&p;
  for (int i = 0; i < 22; ++i) f[i] = (const float*)d_in[i];
  p.out = (float*)d_out;
  p.ws = (unsigned char*)d_ws;
#if 1
  if (hipMemsetAsync((char*)d_ws + WS_BAR, 0, 16384, stream) != hipSuccess) { fprintf(stderr, "memset of barrier words failed\n"); return; }
  int lo = 0, hi = NPHASE;
  void* args[] = {&p, &lo, &hi};
  hipError_t e = hipLaunchCooperativeKernel((void*)mega, dim3(grid_blocks), dim3(256), args, 0, stream);
  if (e != hipSuccess) fprintf(stderr, "cooperative launch failed: %s (grid %d)\n", hipGetErrorString(e), grid_blocks);
#else
  for (int ph = 0; ph < NPHASE; ++ph) hipLaunchKernelGGL(mega, dim3(grid_blocks), dim3(256), 0, stream, p, ph, ph + 1);
#endif
}
```

```cpp
#include <hip/hip_runtime.h>
#include <hip/hip_cooperative_groups.h>
#include <cstdio>
namespace cg = cooperative_groups;

typedef unsigned short bf16;
using bf16x8 = __attribute__((ext_vector_type(8))) short;
using f32x4 = __attribute__((ext_vector_type(4))) float;

#define M_TOK 16384
#define DM 1024
#define SEQ 4096
#define EVEN_N 3616
#define EVEN_NP 3712
#define ODD_N 4112
#define ODD_NP 4224
#define ALPHA 1.4142135623730951f
#ifndef PROBE_PH
#define PROBE_PH -1
#endif
#ifndef REPG
#define REPG 1
#endif
#ifndef REPN
#define REPN 1
#endif
#ifndef REP3
#define REP3 1
#endif
#ifndef REPS
#define REPS 1
#endif
#ifndef REP0
#define REP0 1
#endif
#ifndef REPR
#define REPR 1
#endif

#define WS_MOD 0ull
#define WS_LB (WS_MOD + 98304ull)
#define WS_WEI (WS_LB + 2048ull)
#define WS_WEO (WS_WEI + 3712ull * 2048)
#define WS_WOI (WS_WEO + 1024ull * 2048)
#define WS_WOO (WS_WOI + 4224ull * 2048)
#define WS_H (WS_WOO + 1024ull * 2048)
#define WS_PROJ (WS_H + 16384ull * 2048)
#define WS_O (WS_PROJ + 16384ull * 4112 * 2)
#define WS_ST WS_O
#define WS_DEC (WS_O + 2ull * 16384 * 512 * 4)
#define WS_SSQ (WS_DEC + 2ull * 16 * 64 * 128 * 4)
#define WS_BAR (WS_SSQ + 2ull * 16384 * 4)
#define WS_CMID (WS_BAR + 16384ull)
#define WS_DECS (WS_CMID + 2ull * 16 * 64 * 128 * 4)
#define WS_END (WS_DECS + 16384ull)

struct P {
  const float *x, *c, *ada_w, *ada_b, *ln_g, *ln_b, *e_w_in, *e_rpb, *gla_w_up, *gla_b, *gla_g, *e_w_out;
  const float *o_w_in, *hgrn_lb, *hgrn_g, *conv_w, *conv_b, *dt_bias, *a_log, *d_skip, *ssm_g, *o_w_out;
  float* out;
  unsigned char* ws;
};

__device__ __forceinline__ bf16 f2bf(float f) {
  __bf16 h = (__bf16)f;
  return *(bf16*)&h;
}
using u32x4 = __attribute__((ext_vector_type(4))) unsigned;
__device__ __forceinline__ u32x4 gload16_asm(const void* ptr) {
  u32x4 r;
  asm volatile("global_load_dwordx4 %0, %1, off" : "=v"(r) : "v"(ptr));
  return r;
}
using u32x2 = __attribute__((ext_vector_type(2))) unsigned;
__device__ __forceinline__ u32x2 gload8_asm(const void* ptr) {
  u32x2 r;
  asm volatile("global_load_dwordx2 %0, %1, off" : "=v"(r) : "v"(ptr));
  return r;
}
__device__ __forceinline__ float bf2f(bf16 h) { return __uint_as_float(((unsigned)h) << 16); }
__device__ __forceinline__ float frcp(float x) { return __builtin_amdgcn_rcpf(x); }
__device__ __forceinline__ float silu_f(float v) { return v * frcp(1.f + __expf(-v)); }
__device__ __forceinline__ float sigmoid_f(float v) { return frcp(1.f + __expf(-v)); }
__device__ __forceinline__ float flog(float x) { return __builtin_amdgcn_logf(x) * 0.6931471805599453f; }
__device__ __forceinline__ float log_sigmoid_f(float z) { return fminf(z, 0.f) - flog(1.f + __expf(-fabsf(z))); }
__device__ __forceinline__ float softplus_f(float z) { return fmaxf(z, 0.f) + log1pf(__expf(-fabsf(z))); }
__device__ __forceinline__ float wave_sum(float v) {
#pragma unroll
  for (int o = 32; o > 0; o >>= 1) v += __shfl_xor(v, o, 64);
  return v;
}

__device__ __forceinline__ void transpose_item(const float* __restrict__ src, int N, bf16* __restrict__ dst, int li, unsigned char* smem) {
  float* tile = (float*)smem;
  const int tid = threadIdx.x;
  const int kt = li & 15, ntile = li >> 4;
#pragma unroll
  for (int i = 0; i < 16; ++i) {
    int row = i * 4 + (tid >> 6), col = tid & 63;
    int n = ntile * 64 + col;
    float v = (n < N) ? src[(size_t)(kt * 64 + row) * N + n] : 0.f;
    tile[row * 65 + col] = v;
  }
  __syncthreads();
#pragma unroll
  for (int i = 0; i < 16; ++i) {
    int r = i * 4 + (tid >> 6), cc = tid & 63;
    dst[(size_t)(ntile * 64 + r) * 1024 + kt * 64 + cc] = f2bf(tile[cc * 65 + r]);
  }
}

__device__ __forceinline__ void mod_item(const P& p, int idx, unsigned char* smem) {
  float* cond = (float*)smem;
  float* red = cond + 4096;
  const int tid = threadIdx.x;
  const int l = idx / 192, nc = idx % 192;
  for (int e = tid; e < 4096; e += 256) cond[e] = silu_f(p.c[e]);
  __syncthreads();
  const int kg = tid >> 4, col = tid & 15, n = nc * 16 + col;
  float a0 = 0.f, a1 = 0.f, a2 = 0.f, a3 = 0.f;
  const float* w = p.ada_w + (size_t)l * 1024 * 3072 + n;
#pragma unroll 16
  for (int k = kg * 64; k < kg * 64 + 64; ++k) {
    float wv = w[(size_t)k * 3072];
    a0 += cond[k] * wv; a1 += cond[1024 + k] * wv; a2 += cond[2048 + k] * wv; a3 += cond[3072 + k] * wv;
  }
  red[(kg * 4 + 0) * 16 + col] = a0; red[(kg * 4 + 1) * 16 + col] = a1;
  red[(kg * 4 + 2) * 16 + col] = a2; red[(kg * 4 + 3) * 16 + col] = a3;
  __syncthreads();
  if (tid < 64) {
    const int b = tid >> 4;
    float sum = 0.f;
#pragma unroll
    for (int q = 0; q < 16; ++q) sum += red[(q * 4 + b) * 16 + col];
    float* mod = (float*)(p.ws + WS_MOD);
    mod[(size_t)(l * 4 + b) * 3072 + n] = sum + p.ada_b[l * 3072 + n];
  }
}

__device__ __forceinline__ void phase_setup(const P& p, unsigned char* smem) {
  const int M0 = 384, T0 = M0 + 16 * 58, T1 = T0 + 256, T5 = T1 + 1;
  for (int rep = 0; rep < REP0; ++rep)
  for (int it = blockIdx.x; it < T5; it += gridDim.x) {
    if (it < M0) mod_item(p, it, smem);
    else if (it < T0) transpose_item(p.e_w_in, EVEN_N, (bf16*)(p.ws + WS_WEI), it - M0, smem);
    else if (it < T1) transpose_item(p.e_w_out, 1024, (bf16*)(p.ws + WS_WEO), it - T0, smem);
    else {
      float* lbv = (float*)(p.ws + WS_LB);
      for (int j = threadIdx.x; j < 512; j += 256) {
        float a = p.hgrn_lb[j], bb = p.hgrn_lb[512 + j];
        lbv[j] = 1.f / (1.f + __expf(a - bb));
      }
    }
    __syncthreads();
  }
}

__device__ __forceinline__ void phase_h0(const P& p) {
  const float* mod = (const float*)(p.ws + WS_MOD);
  bf16* hb = (bf16*)(p.ws + WS_H);
  const size_t total = (size_t)M_TOK * 128;
  for (size_t i = (size_t)blockIdx.x * 256 + threadIdx.x; i < total; i += (size_t)gridDim.x * 256) {
    int m = (int)(i >> 7), n = (int)(i & 127) * 8, b = m >> 12;
    const float4* xp = (const float4*)(p.x + (size_t)m * 1024 + n);
    const float4* sh = (const float4*)(mod + (size_t)b * 3072 + n);
    const float4* sc = (const float4*)(mod + (size_t)b * 3072 + 1024 + n);
    float4 x0 = xp[0], x1 = xp[1], s0 = sh[0], s1 = sh[1], c0 = sc[0], c1 = sc[1];
    uint4 o;
    o.x = (unsigned)f2bf(x0.x * (1.f + c0.x) + s0.x) | ((unsigned)f2bf(x0.y * (1.f + c0.y) + s0.y) << 16);
    o.y = (unsigned)f2bf(x0.z * (1.f + c0.z) + s0.z) | ((unsigned)f2bf(x0.w * (1.f + c0.w) + s0.w) << 16);
    o.z = (unsigned)f2bf(x1.x * (1.f + c1.x) + s1.x) | ((unsigned)f2bf(x1.y * (1.f + c1.y) + s1.y) << 16);
    o.w = (unsigned)f2bf(x1.z * (1.f + c1.z) + s1.z) | ((unsigned)f2bf(x1.w * (1.f + c1.w) + s1.w) << 16);
    *(uint4*)(hb + (size_t)m * 1024 + n) = o;
  }
}

#ifndef GEMM_NST
#define GEMM_NST 2
#endif
#define LSTR 64
__device__ __forceinline__ void gemm_issue(const bf16* __restrict__ A, int lda, const bf16* __restrict__ Bt, int m0, int n0,
                                           u32x4 (&ra)[GEMM_NST][4], u32x4 (&rb)[GEMM_NST][4]) {
  const int tid = threadIdx.x, lrow = tid >> 3, lkc = tid & 7;
  const bf16* Ag = A + (size_t)(m0 + lrow) * lda + lkc * 8;
  const bf16* Bg = Bt + (size_t)(n0 + lrow) * 1024 + lkc * 8;
#pragma unroll
  for (int t = 0; t < GEMM_NST; ++t)
#pragma unroll
    for (int i = 0; i < 4; ++i) {
      ra[t][i] = gload16_asm(Ag + (size_t)i * 32 * lda + t * 64);
      rb[t][i] = gload16_asm(Bg + (size_t)i * 32 * 1024 + t * 64);
    }
}

template <int EPI, typename NextFn>
__device__ __forceinline__ void gemm_tile(const bf16* __restrict__ A, int lda, const bf16* __restrict__ Bt, int m0, int n0,
                                          unsigned char* smem, bf16* __restrict__ C, int ldc, int nreal,
                                          const float* __restrict__ X, float* __restrict__ R, const float* __restrict__ gate,
                                          const float* __restrict__ ssqp, u32x4 (&ra)[GEMM_NST][4], u32x4 (&rb)[GEMM_NST][4],
                                          NextFn&& next_issue) {
  bf16* As = (bf16*)smem;
  bf16* Bs = As + 2 * 128 * LSTR;
  const int tid = threadIdx.x, lane = tid & 63, wave = tid >> 6;
  const int wm = wave >> 1, wn = wave & 1;
  f32x4 acc[4][4];
#pragma unroll
  for (int i = 0; i < 4; ++i)
#pragma unroll
    for (int j = 0; j < 4; ++j) acc[i][j] = (f32x4){0.f, 0.f, 0.f, 0.f};
  float rsv[4] = {1.f, 1.f, 1.f, 1.f};
  if (EPI == 2) {
#pragma unroll
    for (int j = 0; j < 4; ++j) {
      const int m = m0 + wm * 64 + j * 16 + (lane & 15);
      rsv[j] = rsqrtf((ssqp[m] + ssqp[M_TOK + m]) * (1.f / 512.f) + 1e-6f);
    }
  }
  const int lrow = tid >> 3, lkc = tid & 7;
  const int lsw = (lkc ^ (lrow & 7)) * 8;
  const bf16* Ag = A + (size_t)(m0 + lrow) * lda + lkc * 8;
  const bf16* Bg = Bt + (size_t)(n0 + lrow) * 1024 + lkc * 8;
  if (GEMM_NST == 3) {
    asm volatile("s_waitcnt vmcnt(16)"
                 : "+v"(ra[0][0]), "+v"(ra[0][1]), "+v"(ra[0][2]), "+v"(ra[0][3]), "+v"(rb[0][0]), "+v"(rb[0][1]), "+v"(rb[0][2]), "+v"(rb[0][3])
                 :: "memory");
  } else {
    asm volatile("s_waitcnt vmcnt(8)"
                 : "+v"(ra[0][0]), "+v"(ra[0][1]), "+v"(ra[0][2]), "+v"(ra[0][3]), "+v"(rb[0][0]), "+v"(rb[0][1]), "+v"(rb[0][2]), "+v"(rb[0][3])
                 :: "memory");
  }
#pragma unroll
  for (int i = 0; i < 4; ++i) {
    *(u32x4*)(As + (lrow + i * 32) * LSTR + lsw) = ra[0][i];
    *(u32x4*)(Bs + (lrow + i * 32) * LSTR + lsw) = rb[0][i];
  }
  __syncthreads();
#pragma unroll
  for (int kt = 0; kt < 16; ++kt) {
    const int buf = kt & 1;
    if (kt + 1 < 16) {
      const int sn = (kt + 1) % GEMM_NST;
      if (GEMM_NST == 3 && kt + 2 < 16) {
        asm volatile("s_waitcnt vmcnt(8)"
                     : "+v"(ra[sn][0]), "+v"(ra[sn][1]), "+v"(ra[sn][2]), "+v"(ra[sn][3]), "+v"(rb[sn][0]), "+v"(rb[sn][1]), "+v"(rb[sn][2]), "+v"(rb[sn][3])
                     :: "memory");
      } else {
        asm volatile("s_waitcnt vmcnt(0)"
                     : "+v"(ra[sn][0]), "+v"(ra[sn][1]), "+v"(ra[sn][2]), "+v"(ra[sn][3]), "+v"(rb[sn][0]), "+v"(rb[sn][1]), "+v"(rb[sn][2]), "+v"(rb[sn][3])
                     :: "memory");
      }
      bf16* Aw = As + (buf ^ 1) * 128 * LSTR;
      bf16* Bw = Bs + (buf ^ 1) * 128 * LSTR;
#pragma unroll
      for (int i = 0; i < 4; ++i) {
        *(u32x4*)(Aw + (lrow + i * 32) * LSTR + lsw) = ra[sn][i];
        *(u32x4*)(Bw + (lrow + i * 32) * LSTR + lsw) = rb[sn][i];
      }
    }
    if (kt + GEMM_NST < 16) {
#pragma unroll
      for (int i = 0; i < 4; ++i) {
        ra[kt % GEMM_NST][i] = gload16_asm(Ag + (size_t)i * 32 * lda + (kt + GEMM_NST) * 64);
        rb[kt % GEMM_NST][i] = gload16_asm(Bg + (size_t)i * 32 * 1024 + (kt + GEMM_NST) * 64);
      }
    }
    const bf16* Ab = As + buf * 128 * LSTR;
    const bf16* Bb = Bs + buf * 128 * LSTR;
    if (EPI == 2 && kt == 8) {
#pragma unroll
      for (int j = 0; j < 4; ++j) {
        const float inv = frcp(rsv[j]);
#pragma unroll
        for (int i = 0; i < 4; ++i) { acc[i][j][0] *= inv; acc[i][j][1] *= inv; acc[i][j][2] *= inv; acc[i][j][3] *= inv; }
      }
    }
#pragma unroll
    for (int s = 0; s < 2; ++s) {
      bf16x8 wf[4], xf[4];
#pragma unroll
      for (int i = 0; i < 4; ++i) {
        wf[i] = *(const bf16x8*)(Bb + (wn * 64 + i * 16 + (lane & 15)) * LSTR + (((s * 4 + (lane >> 4)) ^ (lane & 7)) * 8));
        xf[i] = *(const bf16x8*)(Ab + (wm * 64 + i * 16 + (lane & 15)) * LSTR + (((s * 4 + (lane >> 4)) ^ (lane & 7)) * 8));
      }
#pragma unroll
      for (int i = 0; i < 4; ++i)
#pragma unroll
        for (int j = 0; j < 4; ++j) acc[i][j] = __builtin_amdgcn_mfma_f32_16x16x32_bf16(wf[i], xf[j], acc[i][j], 0, 0, 0);
    }
    __syncthreads();
  }
  next_issue();
#pragma unroll
  for (int i = 0; i < 4; ++i) {
    const int n = n0 + wn * 64 + i * 16 + (lane >> 4) * 4;
#pragma unroll
    for (int j = 0; j < 4; ++j) {
      const int m = m0 + wm * 64 + j * 16 + (lane & 15);
      f32x4 a = acc[i][j];
      if (EPI == 2) { a[0] *= rsv[j]; a[1] *= rsv[j]; a[2] *= rsv[j]; a[3] *= rsv[j]; }
      if (EPI == 0) {
        uint2 o;
        o.x = (unsigned)f2bf(a[0]) | ((unsigned)f2bf(a[1]) << 16);
        o.y = (unsigned)f2bf(a[2]) | ((unsigned)f2bf(a[3]) << 16);
        *(uint2*)((bf16*)smem + (wm * 64 + j * 16 + (lane & 15)) * 136 + wn * 64 + i * 16 + (lane >> 4) * 4) = o;
      } else {
        *(f32x4*)((float*)smem + (wm * 64 + j * 16 + (lane & 15)) * 132 + wn * 64 + i * 16 + (lane >> 4) * 4) = a;
      }
    }
  }
  if (EPI == 0) {
    __syncthreads();
#pragma unroll
    for (int q = 0; q < 8; ++q) {
      const int c = q * 256 + tid, row = c >> 4, c16 = c & 15;
      const int n = n0 + c16 * 8;
      if (n < nreal) *(u32x4*)(C + (size_t)(m0 + row) * ldc + n) = *(const u32x4*)((const bf16*)smem + row * 136 + c16 * 8);
    }
    __syncthreads();
  } else {
    __syncthreads();
#pragma unroll 4
    for (int q = 0; q < 16; ++q) {
      const int c = q * 256 + tid, row = c >> 5, c4 = c & 31;
      const int m = m0 + row, n = n0 + c4 * 4, b = m >> 12;
      const f32x4 a = *(const f32x4*)((const float*)smem + row * 132 + c4 * 4);
      float4 xv;
      if (EPI == 2) {
        uint2 xu = *(const uint2*)((const bf16*)X + (size_t)m * 1024 + n);
        xv.x = __uint_as_float(xu.x << 16); xv.y = __uint_as_float(xu.x & 0xffff0000u);
        xv.z = __uint_as_float(xu.y << 16); xv.w = __uint_as_float(xu.y & 0xffff0000u);
      } else xv = *(const float4*)(X + (size_t)m * 1024 + n);
      const float4 g = *(const float4*)(gate + (size_t)b * 3072 + n);
      float4 o;
      o.x = ALPHA * xv.x + g.x * a[0];
      o.y = ALPHA * xv.y + g.y * a[1];
      o.z = ALPHA * xv.z + g.z * a[2];
      o.w = ALPHA * xv.w + g.w * a[3];
      uint2 ob;
      ob.x = (unsigned)f2bf(o.x) | ((unsigned)f2bf(o.y) << 16);
      ob.y = (unsigned)f2bf(o.z) | ((unsigned)f2bf(o.w) << 16);
      *(uint2*)((bf16*)R + (size_t)m * 1024 + n) = ob;
    }
    __syncthreads();
  }
}

template <int EPI>
__device__ __forceinline__ void phase_gemm(const bf16* A, int lda, const bf16* Bt, int ntn, unsigned char* smem, bf16* C, int ldc, int nreal,
                           const float* X, float* R, const float* gate, unsigned* bar, int gidx, const float* ssqp = nullptr) {
  volatile unsigned* stw = (volatile unsigned*)(smem + 73728);
  const unsigned xid = (unsigned)__builtin_amdgcn_s_getreg((3 << 11) | 20) & 0xFu;
  int xidx = 0, nx = 0;
#pragma unroll
  for (int j = 0; j < 16; ++j) {
    const unsigned c = __hip_atomic_load(&bar[256 + 64 * j], __ATOMIC_RELAXED, __HIP_MEMORY_SCOPE_AGENT);
    if (c > 0u) { nx++; if ((unsigned)j < xid) xidx++; }
  }
  const int mt_lo = (xidx * 128) / nx, mt_hi = ((xidx + 1) * 128) / nx;
  const int total = (mt_hi - mt_lo) * ntn;
  unsigned* qc = bar + 3456 + (gidx * 16 + xidx) * 8;
  u32x4 ra[GEMM_NST][4], rb[GEMM_NST][4];
  int mt = 0, nt = 0;
  bool valid = false;
  auto fetch = [&](int& mt_o, int& nt_o) -> bool {
    __syncthreads();
    if (threadIdx.x == 0) stw[2] = __hip_atomic_fetch_add(qc, 1u, __ATOMIC_RELAXED, __HIP_MEMORY_SCOPE_AGENT);
    __syncthreads();
    const int t = (int)stw[2];
    if (t >= total) return false;
    const int g8 = t / (8 * ntn), r = t - g8 * 8 * ntn;
    const int rows = mt_hi - mt_lo - g8 * 8;
    const int gm = rows < 8 ? rows : 8;
    nt_o = r / gm; mt_o = mt_lo + g8 * 8 + (r - nt_o * gm);
    return true;
  };
  valid = fetch(mt, nt);
  if (valid) gemm_issue(A, lda, Bt, mt * 128, nt * 128, ra, rb);
  while (valid) {
    int mt2 = 0, nt2 = 0;
    bool valid2 = false;
    gemm_tile<EPI>(A, lda, Bt, mt * 128, nt * 128, smem, C, ldc, nreal, X, R, gate, ssqp, ra, rb, [&]() {
      valid2 = fetch(mt2, nt2);
      if (valid2) gemm_issue(A, lda, Bt, mt2 * 128, nt2 * 128, ra, rb);
    });
    mt = mt2; nt = nt2; valid = valid2;
  }
}

__device__ __forceinline__ void phase_ln(const P& p, int l, bool write_h, const unsigned char* probe_ts = nullptr) {
  const float* mod = (const float*)(p.ws + WS_MOD);
  bf16* hb = (bf16*)(p.ws + WS_H);
  const int lane = threadIdx.x & 63, wave = threadIdx.x >> 6;
  const float* g = p.ln_g + l * 1024;
  const float* bb = p.ln_b + l * 1024;
  constexpr int NR = 4;
  for (int grp = blockIdx.x * 4 + wave; grp < M_TOK / NR; grp += gridDim.x * 4) {
    float4 v[NR][4];
    float s[NR];
#pragma unroll
    for (int r = 0; r < NR; ++r) {
      const bf16* rp = (const bf16*)(p.ws + WS_ST) + (size_t)(grp * NR + r) * 1024;
#pragma unroll
      for (int q = 0; q < 4; ++q) {
        const uint2 u = *(const uint2*)(rp + (lane + 64 * q) * 4);
        v[r][q].x = __uint_as_float(u.x << 16); v[r][q].y = __uint_as_float(u.x & 0xffff0000u);
        v[r][q].z = __uint_as_float(u.y << 16); v[r][q].w = __uint_as_float(u.y & 0xffff0000u);
      }
    }
#pragma unroll
    for (int r = 0; r < NR; ++r) {
      s[r] = 0.f;
#pragma unroll
      for (int q = 0; q < 4; ++q) s[r] += v[r][q].x + v[r][q].y + v[r][q].z + v[r][q].w;
    }
#pragma unroll
    for (int o = 32; o > 0; o >>= 1)
#pragma unroll
      for (int r = 0; r < NR; ++r) s[r] += __shfl_xor(s[r], o, 64);
    float mu[NR], s2[NR];
#pragma unroll
    for (int r = 0; r < NR; ++r) {
      mu[r] = s[r] * (1.f / 1024.f);
      s2[r] = 0.f;
#pragma unroll
      for (int q = 0; q < 4; ++q) {
        float a = v[r][q].x - mu[r], b2 = v[r][q].y - mu[r], c2 = v[r][q].z - mu[r], d2 = v[r][q].w - mu[r];
        s2[r] += a * a + b2 * b2 + c2 * c2 + d2 * d2;
      }
    }
#pragma unroll
    for (int o = 32; o > 0; o >>= 1)
#pragma unroll
      for (int r = 0; r < NR; ++r) s2[r] += __shfl_xor(s2[r], o, 64);
#pragma unroll
    for (int q = 0; q < 4; ++q) {
      const int n = (lane + 64 * q) * 4;
      const float4 gg = *(const float4*)(g + n), be = *(const float4*)(bb + n);
#pragma unroll
      for (int r = 0; r < NR; ++r) {
        const int row = grp * NR + r;
        const float rstd = rsqrtf(s2[r] * (1.f / 1024.f) + 1e-5f);
        float4 o;
        o.x = (v[r][q].x - mu[r]) * rstd * gg.x + be.x;
        o.y = (v[r][q].y - mu[r]) * rstd * gg.y + be.y;
        o.z = (v[r][q].z - mu[r]) * rstd * gg.z + be.z;
        o.w = (v[r][q].w - mu[r]) * rstd * gg.w + be.w;
        if (PROBE_PH >= 0 && l == 1 && row == 0) {
          const long long* ts = (const long long*)(probe_ts);
          const int kus = (int)((ts[PROBE_PH + 1] - ts[PROBE_PH]) / 100);
          if (n + 0 < kus) o.x += 0.125f;
          if (n + 1 < kus) o.y += 0.125f;
          if (n + 2 < kus) o.z += 0.125f;
          if (n + 3 < kus) o.w += 0.125f;
        }
        if (!write_h) *(float4*)(p.out + (size_t)row * 1024 + n) = o;
        if (write_h) {
          const int b = row >> 12;
          uint2 xb16;
          xb16.x = (unsigned)f2bf(o.x) | ((unsigned)f2bf(o.y) << 16);
          xb16.y = (unsigned)f2bf(o.z) | ((unsigned)f2bf(o.w) << 16);
          *(uint2*)((bf16*)p.out + (size_t)row * 1024 + n) = xb16;
          const float* md = mod + (size_t)(4 + b) * 3072;
          float4 sh = *(const float4*)(md + n), sc = *(const float4*)(md + 1024 + n);
          uint2 hh;
          hh.x = (unsigned)f2bf(o.x * (1.f + sc.x) + sh.x) | ((unsigned)f2bf(o.y * (1.f + sc.y) + sh.y) << 16);
          hh.y = (unsigned)f2bf(o.z * (1.f + sc.z) + sh.z) | ((unsigned)f2bf(o.w * (1.f + sc.w) + sh.w) << 16);
          *(uint2*)(hb + (size_t)row * 1024 + n) = hh;
        }
      }
    }
  }
}

__device__ __forceinline__ void na_item(const P& p, int item, unsigned char* smem) {
  const int h = item & 7, r = (item >> 3) & 63, b = item >> 9;
  bf16* VT = (bf16*)smem;
  float* RPB = (float*)(VT + 64 * 520);
  const bf16* projb = (const bf16*)(p.ws + WS_PROJ) + (size_t)b * 4096 * EVEN_N;
  bf16* yb = (bf16*)(p.ws + WS_H);
  const int tid = threadIdx.x, lane = tid & 63, n = tid >> 6;
  const int q = lane & 15, g4 = lane >> 4;
  int rs = r - 4; rs = rs < 0 ? 0 : (rs > 56 ? 56 : rs);
  const int bs_pre = n == 0 ? 0 : (n == 1 ? 8 : (n == 2 ? 24 : 32));
  u32x4 kpre[8][2];
#pragma unroll
  for (int tt = 0; tt < 8; ++tt) {
    const int ktok = (rs + (tt >> 1)) * 64 + bs_pre + (tt & 1) * 16 + q;
    const bf16* kp = projb + (size_t)ktok * EVEN_N + 512 + h * 64 + g4 * 8;
    kpre[tt][0] = gload16_asm(kp);
    kpre[tt][1] = gload16_asm(kp + 32);
  }
  u32x2 gpre[4];
#pragma unroll
  for (int dt = 0; dt < 4; ++dt)
    gpre[dt] = gload8_asm(projb + (size_t)(r * 64 + n * 16 + q) * EVEN_N + 1536 + h * 64 + dt * 16 + g4 * 4);
#pragma unroll 8
  for (int i = 0; i < 16; ++i) {
    const int key = (i >> 3) * 256 + tid, ch = i & 7;
    const int tok = (rs + (key >> 6)) * 64 + (key & 63);
    uint4 u = *(const uint4*)(projb + (size_t)tok * EVEN_N + 1024 + h * 64 + ch * 8);
    bf16* dst = VT + (ch * 8) * 520 + key;
    dst[0 * 520] = (bf16)(u.x & 0xffffu); dst[1 * 520] = (bf16)(u.x >> 16);
    dst[2 * 520] = (bf16)(u.y & 0xffffu); dst[3 * 520] = (bf16)(u.y >> 16);
    dst[4 * 520] = (bf16)(u.z & 0xffffu); dst[5 * 520] = (bf16)(u.z >> 16);
    dst[6 * 520] = (bf16)(u.w & 0xffffu); dst[7 * 520] = (bf16)(u.w >> 16);
  }
  for (int i = tid; i < 465; i += 256) RPB[i] = p.e_rpb[h * 465 + i];
  const int qcol = n * 16 + q;
  const int qtok = r * 64 + qcol;
  const int bs = n == 0 ? 0 : (n == 1 ? 8 : (n == 2 ? 24 : 32));
  const bf16x8 qf0 = *(const bf16x8*)(projb + (size_t)qtok * EVEN_N + h * 64 + g4 * 8);
  const bf16x8 qf1 = *(const bf16x8*)(projb + (size_t)qtok * EVEN_N + h * 64 + 32 + g4 * 8);
  f32x4 st[16];
  asm volatile("s_waitcnt vmcnt(0)"
               : "+v"(kpre[0][0]), "+v"(kpre[0][1]), "+v"(kpre[1][0]), "+v"(kpre[1][1]), "+v"(kpre[2][0]), "+v"(kpre[2][1]), "+v"(kpre[3][0]), "+v"(kpre[3][1]),
                 "+v"(kpre[4][0]), "+v"(kpre[4][1]), "+v"(kpre[5][0]), "+v"(kpre[5][1]), "+v"(kpre[6][0]), "+v"(kpre[6][1]), "+v"(kpre[7][0]), "+v"(kpre[7][1])
               :: "memory");
  u32x4 kpre2[8][2];
#pragma unroll
  for (int tt = 0; tt < 8; ++tt) {
    const int ktok = (rs + 4 + (tt >> 1)) * 64 + bs + (tt & 1) * 16 + q;
    const bf16* kp = projb + (size_t)ktok * EVEN_N + 512 + h * 64 + g4 * 8;
    kpre2[tt][0] = gload16_asm(kp);
    kpre2[tt][1] = gload16_asm(kp + 32);
  }
#pragma unroll
  for (int tt = 0; tt < 16; ++tt) {
    if (tt == 8) {
      asm volatile("s_waitcnt vmcnt(0)"
                   : "+v"(kpre2[0][0]), "+v"(kpre2[0][1]), "+v"(kpre2[1][0]), "+v"(kpre2[1][1]), "+v"(kpre2[2][0]), "+v"(kpre2[2][1]), "+v"(kpre2[3][0]), "+v"(kpre2[3][1]),
                     "+v"(kpre2[4][0]), "+v"(kpre2[4][1]), "+v"(kpre2[5][0]), "+v"(kpre2[5][1]), "+v"(kpre2[6][0]), "+v"(kpre2[6][1]), "+v"(kpre2[7][0]), "+v"(kpre2[7][1])
                   :: "memory");
    }
    bf16x8 kf0, kf1;
    if (tt < 8) { kf0 = *(bf16x8*)&kpre[tt][0]; kf1 = *(bf16x8*)&kpre[tt][1]; }
    else { kf0 = *(bf16x8*)&kpre2[tt - 8][0]; kf1 = *(bf16x8*)&kpre2[tt - 8][1]; }
    f32x4 z = (f32x4){0.f, 0.f, 0.f, 0.f};
    z = __builtin_amdgcn_mfma_f32_16x16x32_bf16(kf0, qf0, z, 0, 0, 0);
    st[tt] = __builtin_amdgcn_mfma_f32_16x16x32_bf16(kf1, qf1, z, 0, 0, 0);
  }
  __syncthreads();
  int cs = qcol - 8; cs = cs < 0 ? 0 : (cs > 48 ? 48 : cs);
  float mx = -1e30f;
#pragma unroll
  for (int tt = 0; tt < 16; ++tt) {
    const float* brow = RPB + (rs + (tt >> 1) - r + 7) * 31;
#pragma unroll
    for (int rr = 0; rr < 4; ++rr) {
      const int kcol = bs + (tt & 1) * 16 + g4 * 4 + rr;
      const bool valid = (kcol >= cs) && (kcol < cs + 16);
      int dc = kcol - qcol + 15; dc = dc < 0 ? 0 : (dc > 30 ? 30 : dc);
      const float sc = valid ? st[tt][rr] * 0.125f + brow[dc] : -1e30f;
      st[tt][rr] = sc;
      mx = fmaxf(mx, sc);
    }
  }
  mx = fmaxf(mx, __shfl_xor(mx, 16, 64));
  mx = fmaxf(mx, __shfl_xor(mx, 32, 64));
  float lsum = 0.f;
#pragma unroll
  for (int tt = 0; tt < 16; ++tt)
#pragma unroll
    for (int rr = 0; rr < 4; ++rr) {
      const float pe = __expf(st[tt][rr] - mx);
      st[tt][rr] = pe;
      lsum += pe;
    }
  lsum += __shfl_xor(lsum, 16, 64);
  lsum += __shfl_xor(lsum, 32, 64);
  f32x4 ot[4];
#pragma unroll
  for (int dt = 0; dt < 4; ++dt) ot[dt] = (f32x4){0.f, 0.f, 0.f, 0.f};
#pragma unroll
  for (int kr = 0; kr < 8; ++kr) {
    uint4 pw;
    pw.x = (unsigned)f2bf(st[2 * kr][0]) | ((unsigned)f2bf(st[2 * kr][1]) << 16);
    pw.y = (unsigned)f2bf(st[2 * kr][2]) | ((unsigned)f2bf(st[2 * kr][3]) << 16);
    pw.z = (unsigned)f2bf(st[2 * kr + 1][0]) | ((unsigned)f2bf(st[2 * kr + 1][1]) << 16);
    pw.w = (unsigned)f2bf(st[2 * kr + 1][2]) | ((unsigned)f2bf(st[2 * kr + 1][3]) << 16);
    const bf16x8 pf = *(bf16x8*)&pw;
#pragma unroll
    for (int dt = 0; dt < 4; ++dt) {
      const bf16* vp = VT + (dt * 16 + q) * 520 + kr * 64 + bs + g4 * 4;
      uint2 lo = *(const uint2*)vp, hi = *(const uint2*)(vp + 16);
      uint4 vw; vw.x = lo.x; vw.y = lo.y; vw.z = hi.x; vw.w = hi.y;
      ot[dt] = __builtin_amdgcn_mfma_f32_16x16x32_bf16(*(bf16x8*)&vw, pf, ot[dt], 0, 0, 0);
    }
  }
  const float inv = frcp(lsum);
  asm volatile("s_waitcnt vmcnt(0)" : "+v"(gpre[0]), "+v"(gpre[1]), "+v"(gpre[2]), "+v"(gpre[3]) :: "memory");
#pragma unroll
  for (int dt = 0; dt < 4; ++dt) {
    const int d0 = dt * 16 + g4 * 4;
    uint2 gu; gu.x = gpre[dt][0]; gu.y = gpre[dt][1];
    f32x4 y;
    y[0] = ot[dt][0] * inv * silu_f(__uint_as_float(gu.x << 16));
    y[1] = ot[dt][1] * inv * silu_f(__uint_as_float(gu.x & 0xffff0000u));
    y[2] = ot[dt][2] * inv * silu_f(__uint_as_float(gu.y << 16));
    y[3] = ot[dt][3] * inv * silu_f(__uint_as_float(gu.y & 0xffff0000u));
    uint2 o;
    o.x = (unsigned)f2bf(y[0]) | ((unsigned)f2bf(y[1]) << 16);
    o.y = (unsigned)f2bf(y[2]) | ((unsigned)f2bf(y[3]) << 16);
    *(uint2*)(yb + ((size_t)b * 4096 + qtok) * 1024 + h * 64 + d0) = o;
  }
}

template <int K, int MODE>
struct GateC {
  float w[16];
  float bias, lb;
  int d, ch;
  __device__ __forceinline__ void init(const P& p, int d_, int h, int k) {
    d = d_; ch = h * K + k;
    if (MODE == 0) {
#pragma unroll
      for (int r = 0; r < 16; ++r) w[r] = p.gla_w_up[(d * 16 + r) * 256 + ch];
      bias = p.gla_b[d * 256 + ch];
      lb = 0.f;
    } else {
      lb = ((const float*)(p.ws + WS_LB))[ch];
      bias = 0.f;
    }
  }
  __device__ __forceinline__ void eval_vals(bf16 a, bf16 bz, const bf16* lr, float& g, float& kval, float& qval) const {
    if (MODE == 0) {
      uint4 u0 = *(const uint4*)(lr);
      uint4 u1 = *(const uint4*)(lr + 8);
      float z = bias;
      z += w[0] * __uint_as_float(u0.x << 16) + w[1] * __uint_as_float(u0.x & 0xffff0000u);
      z += w[2] * __uint_as_float(u0.y << 16) + w[3] * __uint_as_float(u0.y & 0xffff0000u);
      z += w[4] * __uint_as_float(u0.z << 16) + w[5] * __uint_as_float(u0.z & 0xffff0000u);
      z += w[6] * __uint_as_float(u0.w << 16) + w[7] * __uint_as_float(u0.w & 0xffff0000u);
      z += w[8] * __uint_as_float(u1.x << 16) + w[9] * __uint_as_float(u1.x & 0xffff0000u);
      z += w[10] * __uint_as_float(u1.y << 16) + w[11] * __uint_as_float(u1.y & 0xffff0000u);
      z += w[12] * __uint_as_float(u1.z << 16) + w[13] * __uint_as_float(u1.z & 0xffff0000u);
      z += w[14] * __uint_as_float(u1.w << 16) + w[15] * __uint_as_float(u1.w & 0xffff0000u);
      g = log_sigmoid_f(z) * (1.f / 16.f);
      kval = bf2f(bz);
      qval = bf2f(a) * 0.125f;
    } else {
      const float z = bf2f(bz);
      const float e = __expf(-z);
      const float sg = frcp(1.f + e);
      kval = (1.f - lb) * e * sg;
      g = 1.f - kval;
      qval = bf2f(a) * 0.08838834764831845f;
    }
  }
  __device__ __forceinline__ void eval(const bf16* row, float& g, float& kval, float& qval) const {
    if (MODE == 0) {
      uint4 u0 = *(const uint4*)(row + 3584 + d * 16);
      uint4 u1 = *(const uint4*)(row + 3584 + d * 16 + 8);
      float z = bias;
      z += w[0] * __uint_as_float(u0.x << 16) + w[1] * __uint_as_float(u0.x & 0xffff0000u);
      z += w[2] * __uint_as_float(u0.y << 16) + w[3] * __uint_as_float(u0.y & 0xffff0000u);
      z += w[4] * __uint_as_float(u0.z << 16) + w[5] * __uint_as_float(u0.z & 0xffff0000u);
      z += w[6] * __uint_as_float(u0.w << 16) + w[7] * __uint_as_float(u0.w & 0xffff0000u);
      z += w[8] * __uint_as_float(u1.x << 16) + w[9] * __uint_as_float(u1.x & 0xffff0000u);
      z += w[10] * __uint_as_float(u1.y << 16) + w[11] * __uint_as_float(u1.y & 0xffff0000u);
      z += w[12] * __uint_as_float(u1.z << 16) + w[13] * __uint_as_float(u1.z & 0xffff0000u);
      z += w[14] * __uint_as_float(u1.w << 16) + w[15] * __uint_as_float(u1.w & 0xffff0000u);
      g = log_sigmoid_f(z) * (1.f / 16.f);
      kval = bf2f(row[2304 + ch]);
      qval = bf2f(row[2048 + ch]) * 0.125f;
    } else {
      const float z = bf2f(row[512 + d * 512 + ch]);
      const float e = __expf(-z);
      const float sg = frcp(1.f + e);
      kval = (1.f - lb) * e * sg;
      g = flog(1.f - kval);
      qval = bf2f(row[ch]) * 0.08838834764831845f;
    }
  }
};

template <int MODE>
__device__ __forceinline__ void stage_vt(const bf16* proj, int h, bf16* VT) {
  constexpr int LDP = MODE == 0 ? EVEN_N : ODD_N;
  constexpr int VOFF = MODE == 0 ? 2560 : 1536;
  const int j = threadIdx.x & 63, cgp = threadIdx.x >> 6;
#pragma unroll
  for (int cc = 0; cc < 4; ++cc) {
    const int c = cgp * 4 + cc;
    uint4 u = *(const uint4*)(proj + (size_t)j * LDP + VOFF + h * 128 + c * 8);
    bf16* dst = VT + (c * 8) * 72 + j;
    dst[0 * 72] = (bf16)(u.x & 0xffffu); dst[1 * 72] = (bf16)(u.x >> 16);
    dst[2 * 72] = (bf16)(u.y & 0xffffu); dst[3 * 72] = (bf16)(u.y >> 16);
    dst[4 * 72] = (bf16)(u.z & 0xffffu); dst[5 * 72] = (bf16)(u.z >> 16);
    dst[6 * 72] = (bf16)(u.w & 0xffffu); dst[7 * 72] = (bf16)(u.w >> 16);
  }
}

__device__ __forceinline__ uint2 pack4(f32x4 a) {
  uint2 o;
  o.x = (unsigned)f2bf(a[0]) | ((unsigned)f2bf(a[1]) << 16);
  o.y = (unsigned)f2bf(a[2]) | ((unsigned)f2bf(a[3]) << 16);
  return o;
}

template <int K, int MODE>
__device__ __forceinline__ void rec_pass1_item(const P& p, int item, unsigned char* smem) {
  constexpr int LDP = MODE == 0 ? EVEN_N : ODD_N;
  const int h = item & 3, blk = (item >> 2) & 63, b = item >> 8;
  bf16* KT = (bf16*)smem;
  bf16* VT = KT + 2 * K * 72;
  const bf16* proj = (const bf16*)(p.ws + WS_PROJ) + (size_t)(b * 4096 + blk * 64) * LDP;
  bf16* ST = (bf16*)(p.ws + WS_ST);
  float* DEC = (float*)(p.ws + WS_DEC);
  const int tid = threadIdx.x, lane = tid & 63, wave = tid >> 6;
  bf16* TMP = VT;
  if (MODE == 1) {
#pragma unroll
    for (int i = 0; i < 8; ++i) {
      const int c = i * 256 + tid;
      const int ch = c & 15, j = (c >> 4) & 63, d = c >> 10;
      *(uint4*)(TMP + (d * 64 + j) * 128 + ch * 8) = *(const uint4*)(proj + (size_t)j * LDP + 512 + d * 512 + h * 128 + ch * 8);
    }
  } else {
#pragma unroll
    for (int i = 0; i < 2; ++i) {
      const int c = i * 256 + tid;
      const int ch = c & 7, j = c >> 3;
      *(uint4*)(TMP + j * 64 + ch * 8) = *(const uint4*)(proj + (size_t)j * LDP + 2304 + h * 64 + ch * 8);
    }
    {
      const int ch = tid & 3, j = tid >> 2;
      *(uint4*)(TMP + 4096 + j * 32 + ch * 8) = *(const uint4*)(proj + (size_t)j * LDP + 3584 + ch * 8);
    }
  }
  __syncthreads();
  if (tid < 2 * K) {
    const int d = tid / K, k = tid % K;
    GateC<K, MODE> gc;
    gc.init(p, d, h, k);
    bf16* row = KT + (d * K + k) * 72;
    float r = MODE == 1 ? 1.f : 0.f, rhi = r;
#pragma unroll 4
    for (int i = 63; i >= 0; --i) {
      const int j = d ? 63 - i : i;
      float g, kv, qv;
      if (MODE == 1) {
        gc.eval_vals(0, TMP[(d * 64 + j) * 128 + k], nullptr, g, kv, qv);
        row[j] = f2bf(kv * r);
        r *= g;
      } else {
        gc.eval_vals(0, TMP[j * 64 + k], TMP + 4096 + j * 32 + d * 16, g, kv, qv);
        row[j] = f2bf(kv * __expf(r));
        r += g;
      }
      if (i == 32) rhi = r;
    }
    DEC[(size_t)((((d * 4 + b) * 4 + h) * 64 + blk)) * K + k] = MODE == 1 ? r : __expf(r);
    ((float*)(p.ws + WS_CMID))[(size_t)((((d * 4 + b) * 4 + h) * 64 + blk)) * K + k] = MODE == 1 ? r * frcp(rhi) : __expf(r - rhi);
  }
  __syncthreads();
  stage_vt<MODE>(proj, h, VT);
  __syncthreads();
#pragma unroll 1
  for (int d = 0; d < 2; ++d) {
    f32x4 acc[K / 16][2];
#pragma unroll
    for (int kt = 0; kt < K / 16; ++kt) { acc[kt][0] = (f32x4){0.f, 0.f, 0.f, 0.f}; acc[kt][1] = (f32x4){0.f, 0.f, 0.f, 0.f}; }
#pragma unroll
    for (int ks = 0; ks < 2; ++ks) {
      bf16x8 vf0 = *(const bf16x8*)(VT + ((wave * 2 + 0) * 16 + (lane & 15)) * 72 + ks * 32 + (lane >> 4) * 8);
      bf16x8 vf1 = *(const bf16x8*)(VT + ((wave * 2 + 1) * 16 + (lane & 15)) * 72 + ks * 32 + (lane >> 4) * 8);
#pragma unroll
      for (int kt = 0; kt < K / 16; ++kt) {
        bf16x8 kf = *(const bf16x8*)(KT + (d * K + kt * 16 + (lane & 15)) * 72 + ks * 32 + (lane >> 4) * 8);
        acc[kt][0] = __builtin_amdgcn_mfma_f32_16x16x32_bf16(kf, vf0, acc[kt][0], 0, 0, 0);
        acc[kt][1] = __builtin_amdgcn_mfma_f32_16x16x32_bf16(kf, vf1, acc[kt][1], 0, 0, 0);
      }
    }
    bf16* stb = ST + (size_t)((((d * 4 + b) * 4 + h) * 64 + blk)) * 128 * K;
#pragma unroll
    for (int kt = 0; kt < K / 16; ++kt)
#pragma unroll
      for (int vv = 0; vv < 2; ++vv) {
        const int v = (wave * 2 + vv) * 16 + (lane & 15);
        const int k0 = kt * 16 + (lane >> 4) * 4;
        *(uint2*)(stb + (size_t)v * K + k0) = pack4(acc[kt][vv]);
      }
  }
}

template <int K>
__device__ __forceinline__ void phase_rec_scan(const P& p) {
  bf16* ST = (bf16*)(p.ws + WS_ST);
  const float* DEC = (const float*)(p.ws + WS_DEC);
  const float* CMID = (const float*)(p.ws + WS_CMID);
  constexpr int KV = K / 4;
  const int total = 32 * 128 * KV;
  for (int idx = blockIdx.x * 256 + threadIdx.x; idx < total; idx += gridDim.x * 256) {
    const int kq = idx % KV, v = (idx / KV) & 127, s = idx / (KV * 128);
    const int d = s >> 4;
    float st0 = 0.f, st1 = 0.f, st2 = 0.f, st3 = 0.f;
#pragma unroll 1
    for (int n0 = 0; n0 < 64; n0 += 8) {
      uint2 u[8];
      float4 dc[8], cm[8];
#pragma unroll
      for (int q = 0; q < 8; ++q) {
        const int blk = d ? 63 - (n0 + q) : (n0 + q);
        u[q] = *(const uint2*)(ST + ((size_t)(s * 64 + blk) * 128 + v) * K + kq * 4);
        dc[q] = *(const float4*)(DEC + (size_t)(s * 64 + blk) * K + kq * 4);
        cm[q] = *(const float4*)(CMID + (size_t)(s * 64 + blk) * K + kq * 4);
      }
#pragma unroll
      for (int q = 0; q < 8; ++q) {
        const int blk = d ? 63 - (n0 + q) : (n0 + q);
        uint2 o;
        o.x = (unsigned)f2bf(st0 * cm[q].x) | ((unsigned)f2bf(st1 * cm[q].y) << 16);
        o.y = (unsigned)f2bf(st2 * cm[q].z) | ((unsigned)f2bf(st3 * cm[q].w) << 16);
        *(uint2*)(ST + ((size_t)(s * 64 + blk) * 128 + v) * K + kq * 4) = o;
        st0 = dc[q].x * st0 + __uint_as_float(u[q].x << 16);
        st1 = dc[q].y * st1 + __uint_as_float(u[q].x & 0xffff0000u);
        st2 = dc[q].z * st2 + __uint_as_float(u[q].y << 16);
        st3 = dc[q].w * st3 + __uint_as_float(u[q].y & 0xffff0000u);
      }
    }
  }
}

template <int K, int MODE>
__device__ __forceinline__ void rec_pass3_item(const P& p, int item, unsigned char* smem) {
  constexpr int LDP = MODE == 0 ? EVEN_N : ODD_N;
  constexpr int KS = K + 8;
  constexpr int GOFF = MODE == 0 ? 3072 : 2048;
  constexpr int YOFF = MODE == 0 ? 512 : 0;
  const int h = item & 3, blk = (item >> 2) & 63, b = item >> 8;
  bf16* QI = (bf16*)smem;
  bf16* KI = QI + 64 * KS;
  bf16* VT = KI + 64 * KS;
  bf16* AI = VT + 128 * 72;
  float* CV = (float*)(AI + 64 * 72);
  float* SSQ = CV + K;
  bf16* LRB = (bf16*)(SSQ + 256);
  const bf16* proj = (const bf16*)(p.ws + WS_PROJ) + (size_t)(b * 4096 + blk * 64) * LDP;
  const bf16* ST = (const bf16*)(p.ws + WS_ST);
  bf16* yb = (bf16*)(p.ws + WS_H);
  const int tid = threadIdx.x, lane = tid & 63, wave = tid >> 6;
  constexpr int VOFF = MODE == 0 ? 2560 : 1536;
  constexpr int QOFF = MODE == 0 ? 2048 : 0;
  constexpr int NQ = K / 32;
  u32x4 rvt[4], rq[4], rz[2][4], rlr[2], stf[2][4][2];
  {
    const int j = tid & 63, cgp = tid >> 6;
#pragma unroll
    for (int cc = 0; cc < 4; ++cc) rvt[cc] = gload16_asm(proj + (size_t)j * LDP + VOFF + h * 128 + (cgp * 4 + cc) * 8);
  }
#pragma unroll
  for (int i = 0; i < NQ; ++i) {
    const int c = i * 256 + tid, ch = c % (K / 8), j = c / (K / 8);
    rq[i] = gload16_asm(proj + (size_t)j * LDP + QOFF + h * K + ch * 8);
    rz[0][i] = gload16_asm(proj + (size_t)j * LDP + (MODE == 0 ? 2304 : 512) + h * K + ch * 8);
  }
  if (MODE == 0) {
    const int ch = tid & 1, j = (tid >> 1) & 63;
    rlr[0] = gload16_asm(proj + (size_t)j * LDP + 3584 + ch * 8);
    rlr[1] = gload16_asm(proj + (size_t)j * LDP + 3600 + ch * 8);
  }
  {
    const bf16* stb = ST + (size_t)((((0 * 4 + b) * 4 + h) * 64 + blk)) * 128 * K;
#pragma unroll
    for (int ks = 0; ks < NQ; ++ks)
#pragma unroll
      for (int vv = 0; vv < 2; ++vv)
        stf[0][ks][vv] = gload16_asm(stb + (size_t)((wave * 2 + vv) * 16 + (lane & 15)) * K + ks * 32 + (lane >> 4) * 8);
  }
  if (MODE == 1) {
    asm volatile("s_waitcnt vmcnt(8)"
                 : "+v"(rvt[0]), "+v"(rvt[1]), "+v"(rvt[2]), "+v"(rvt[3]), "+v"(rq[0]), "+v"(rq[1]), "+v"(rq[2]), "+v"(rq[3]),
                   "+v"(rz[0][0]), "+v"(rz[0][1]), "+v"(rz[0][2]), "+v"(rz[0][3])
                 :: "memory");
  } else {
    asm volatile("s_waitcnt vmcnt(4)"
                 : "+v"(rvt[0]), "+v"(rvt[1]), "+v"(rvt[2]), "+v"(rvt[3]), "+v"(rq[0]), "+v"(rq[1]), "+v"(rz[0][0]), "+v"(rz[0][1]), "+v"(rlr[0]), "+v"(rlr[1])
                 :: "memory");
  }
  {
    const int j = tid & 63, cgp = tid >> 6;
#pragma unroll
    for (int cc = 0; cc < 4; ++cc) {
      const u32x4 u = rvt[cc];
      bf16* dst = VT + ((cgp * 4 + cc) * 8) * 72 + j;
      dst[0 * 72] = (bf16)(u[0] & 0xffffu); dst[1 * 72] = (bf16)(u[0] >> 16);
      dst[2 * 72] = (bf16)(u[1] & 0xffffu); dst[3 * 72] = (bf16)(u[1] >> 16);
      dst[4 * 72] = (bf16)(u[2] & 0xffffu); dst[5 * 72] = (bf16)(u[2] >> 16);
      dst[6 * 72] = (bf16)(u[3] & 0xffffu); dst[7 * 72] = (bf16)(u[3] >> 16);
    }
  }
  f32x4 o[2][4];
#pragma unroll
  for (int vv = 0; vv < 2; ++vv)
#pragma unroll
    for (int it = 0; it < 4; ++it) o[vv][it] = (f32x4){0.f, 0.f, 0.f, 0.f};
#pragma unroll
  for (int d = 0; d < 2; ++d) {
    if (d) __syncthreads();
    if (MODE == 1 && d == 1) {
      asm volatile("s_waitcnt vmcnt(0)" : "+v"(rz[1][0]), "+v"(rz[1][1]), "+v"(rz[1][2]), "+v"(rz[1][3]) :: "memory");
    }
#pragma unroll
    for (int i = 0; i < NQ; ++i) {
      const int c = i * 256 + tid, ch = c % (K / 8), j = c / (K / 8);
      *(u32x4*)(QI + j * KS + ch * 8) = rq[i];
      *(u32x4*)(KI + j * KS + ch * 8) = rz[MODE == 1 ? d : 0][i];
    }
    if (d == 1) {
      const bf16* stb = ST + (size_t)((((1 * 4 + b) * 4 + h) * 64 + blk)) * 128 * K;
#pragma unroll
      for (int ks = 0; ks < NQ; ++ks)
#pragma unroll
        for (int vv = 0; vv < 2; ++vv)
          stf[1][ks][vv] = gload16_asm(stb + (size_t)((wave * 2 + vv) * 16 + (lane & 15)) * K + ks * 32 + (lane >> 4) * 8);
    }
    if (MODE == 1 && d == 0) {
#pragma unroll
      for (int i = 0; i < NQ; ++i) {
        const int c = i * 256 + tid, ch = c % (K / 8), j = c / (K / 8);
        rz[1][i] = gload16_asm(proj + (size_t)j * LDP + 1024 + h * K + ch * 8);
      }
    }
    if (MODE == 0 && tid < 128) {
      const int ch = tid & 1, j = tid >> 1;
      *(u32x4*)(LRB + j * 16 + ch * 8) = rlr[d];
    }
    __syncthreads();
    if (tid < 2 * K) {
      const int k = tid % K, half = tid / K;
      GateC<K, MODE> gc;
      gc.init(p, d, h, k);
      float run = MODE == 1 ? 1.f : 0.f;
      if (half) {
#pragma unroll 4
        for (int i = 32; i < 64; ++i) {
          const int j = d ? 63 - i : i;
          float g, kv, qv;
          gc.eval_vals(QI[j * KS + k], KI[j * KS + k], LRB + j * 16, g, kv, qv);
          if (MODE == 1) {
            run *= g;
            QI[j * KS + k] = f2bf(qv * run);
            KI[j * KS + k] = f2bf(kv * frcp(run));
          } else {
            run += g;
            QI[j * KS + k] = f2bf(qv * __expf(run));
            KI[j * KS + k] = f2bf(kv * __expf(-run));
          }
        }
      } else {
#pragma unroll 4
        for (int i = 31; i >= 0; --i) {
          const int j = d ? 63 - i : i;
          float g, kv, qv;
          gc.eval_vals(QI[j * KS + k], KI[j * KS + k], LRB + j * 16, g, kv, qv);
          if (MODE == 1) {
            QI[j * KS + k] = f2bf(qv * frcp(run));
            KI[j * KS + k] = f2bf(kv * run);
            run *= g;
          } else {
            QI[j * KS + k] = f2bf(qv * __expf(-run));
            KI[j * KS + k] = f2bf(kv * __expf(run));
            run += g;
          }
        }
        CV[k] = MODE == 1 ? run : __expf(run);
      }
    }
    __syncthreads();
    {
      f32x4 a[4];
#pragma unroll
      for (int jt = 0; jt < 4; ++jt) a[jt] = (f32x4){0.f, 0.f, 0.f, 0.f};
#pragma unroll
      for (int ks = 0; ks < K / 32; ++ks) {
        bf16x8 qf = *(const bf16x8*)(QI + (wave * 16 + (lane & 15)) * KS + ks * 32 + (lane >> 4) * 8);
#pragma unroll
        for (int jt = 0; jt < 4; ++jt) {
          bf16x8 kf = *(const bf16x8*)(KI + (jt * 16 + (lane & 15)) * KS + ks * 32 + (lane >> 4) * 8);
          a[jt] = __builtin_amdgcn_mfma_f32_16x16x32_bf16(kf, qf, a[jt], 0, 0, 0);
        }
      }
      const int i = wave * 16 + (lane & 15);
#pragma unroll
      for (int jt = 0; jt < 4; ++jt) {
        const int j0 = jt * 16 + (lane >> 4) * 4;
        f32x4 m;
#pragma unroll
        for (int r = 0; r < 4; ++r) {
          const int j = j0 + r;
          const bool valid = d ? (j >= i) : (j <= i);
          m[r] = valid ? a[jt][r] : 0.f;
        }
        *(uint2*)(AI + i * 72 + j0) = pack4(m);
      }
    }
    __syncthreads();
#pragma unroll
    for (int ks = 0; ks < 2; ++ks) {
      bf16x8 vf0 = *(const bf16x8*)(VT + ((wave * 2 + 0) * 16 + (lane & 15)) * 72 + ks * 32 + (lane >> 4) * 8);
      bf16x8 vf1 = *(const bf16x8*)(VT + ((wave * 2 + 1) * 16 + (lane & 15)) * 72 + ks * 32 + (lane >> 4) * 8);
#pragma unroll
      for (int it = 0; it < 4; ++it) {
        bf16x8 af = *(const bf16x8*)(AI + (it * 16 + (lane & 15)) * 72 + ks * 32 + (lane >> 4) * 8);
        o[0][it] = __builtin_amdgcn_mfma_f32_16x16x32_bf16(vf0, af, o[0][it], 0, 0, 0);
        o[1][it] = __builtin_amdgcn_mfma_f32_16x16x32_bf16(vf1, af, o[1][it], 0, 0, 0);
      }
    }
    if (d == 0) {
      if (K == 128) {
        asm volatile("s_waitcnt vmcnt(4)"
                     : "+v"(stf[0][0][0]), "+v"(stf[0][0][1]), "+v"(stf[0][1][0]), "+v"(stf[0][1][1]), "+v"(stf[0][2][0]), "+v"(stf[0][2][1]), "+v"(stf[0][3][0]), "+v"(stf[0][3][1])
                     :: "memory");
      } else {
        asm volatile("s_waitcnt vmcnt(0)" : "+v"(stf[0][0][0]), "+v"(stf[0][0][1]), "+v"(stf[0][1][0]), "+v"(stf[0][1][1]) :: "memory");
      }
    } else {
      if (K == 128) {
        asm volatile("s_waitcnt vmcnt(0)"
                     : "+v"(stf[1][0][0]), "+v"(stf[1][0][1]), "+v"(stf[1][1][0]), "+v"(stf[1][1][1]), "+v"(stf[1][2][0]), "+v"(stf[1][2][1]), "+v"(stf[1][3][0]), "+v"(stf[1][3][1])
                     :: "memory");
      } else {
        asm volatile("s_waitcnt vmcnt(0)" : "+v"(stf[1][0][0]), "+v"(stf[1][0][1]), "+v"(stf[1][1][0]), "+v"(stf[1][1][1]) :: "memory");
      }
    }
#pragma unroll
    for (int ks = 0; ks < K / 32; ++ks) {
      const int kk = ks * 32 + (lane >> 4) * 8;
      bf16x8 sf[2];
      sf[0] = *(bf16x8*)&stf[d][ks][0];
      sf[1] = *(bf16x8*)&stf[d][ks][1];
#pragma unroll
      for (int it = 0; it < 4; ++it) {
        bf16x8 qf = *(const bf16x8*)(QI + (it * 16 + (lane & 15)) * KS + kk);
        o[0][it] = __builtin_amdgcn_mfma_f32_16x16x32_bf16(sf[0], qf, o[0][it], 0, 0, 0);
        o[1][it] = __builtin_amdgcn_mfma_f32_16x16x32_bf16(sf[1], qf, o[1][it], 0, 0, 0);
      }
    }
  }
  {
    float ss[4];
#pragma unroll
    for (int it = 0; it < 4; ++it) {
      float s = 0.f;
#pragma unroll
      for (int vv = 0; vv < 2; ++vv)
#pragma unroll
        for (int r = 0; r < 4; ++r) s += o[vv][it][r] * o[vv][it][r];
      s += __shfl_xor(s, 16, 64);
      s += __shfl_xor(s, 32, 64);
      ss[it] = s;
    }
    if (lane < 16) {
#pragma unroll
      for (int it = 0; it < 4; ++it) SSQ[wave * 64 + it * 16 + lane] = ss[it];
    }
    __syncthreads();
    const float* gn = MODE == 0 ? p.gla_g : p.hgrn_g;
#pragma unroll
    for (int it = 0; it < 4; ++it) {
      const int i = it * 16 + (lane & 15);
      const float tot = SSQ[i] + SSQ[64 + i] + SSQ[128 + i] + SSQ[192 + i];
      const float rs = rsqrtf(tot * (1.f / 128.f) + 1e-6f);
#pragma unroll
      for (int vv = 0; vv < 2; ++vv) {
        const int v0 = (wave * 2 + vv) * 16 + (lane >> 4) * 4;
        uint2 gu = *(const uint2*)(proj + (size_t)i * LDP + GOFF + h * 128 + v0);
        float4 gg = *(const float4*)(gn + v0);
        f32x4 y;
        y[0] = o[vv][it][0] * rs * gg.x * silu_f(__uint_as_float(gu.x << 16));
        y[1] = o[vv][it][1] * rs * gg.y * silu_f(__uint_as_float(gu.x & 0xffff0000u));
        y[2] = o[vv][it][2] * rs * gg.z * silu_f(__uint_as_float(gu.y << 16));
        y[3] = o[vv][it][3] * rs * gg.w * silu_f(__uint_as_float(gu.y & 0xffff0000u));
        if (MODE == 1) *(uint2*)((bf16*)proj + (size_t)i * LDP + GOFF + h * 128 + v0) = pack4(y);
        else *(uint2*)(yb + (size_t)(b * 4096 + blk * 64 + i) * 1024 + YOFF + h * 128 + v0) = pack4(y);
      }
    }
  }
}

__device__ __forceinline__ void conv8(const P& p, const bf16* projb, int t, int c0, float* o8) {
  c0 = __builtin_amdgcn_readfirstlane(c0);
  float4 b0 = *(const float4*)(p.conv_b + c0), b1 = *(const float4*)(p.conv_b + c0 + 4);
  float a[8] = {b0.x, b0.y, b0.z, b0.w, b1.x, b1.y, b1.z, b1.w};
#pragma unroll
  for (int jt = 0; jt < 4; ++jt) {
    const int tt = t + jt - 2;
    if (tt >= 0 && tt < 4096) {
      uint4 u = *(const uint4*)(projb + (size_t)tt * ODD_N + 3072 + c0);
      float4 w0 = *(const float4*)(p.conv_w + jt * 1024 + c0), w1 = *(const float4*)(p.conv_w + jt * 1024 + c0 + 4);
      a[0] += w0.x * __uint_as_float(u.x << 16); a[1] += w0.y * __uint_as_float(u.x & 0xffff0000u);
      a[2] += w0.z * __uint_as_float(u.y << 16); a[3] += w0.w * __uint_as_float(u.y & 0xffff0000u);
      a[4] += w1.x * __uint_as_float(u.z << 16); a[5] += w1.y * __uint_as_float(u.z & 0xffff0000u);
      a[6] += w1.z * __uint_as_float(u.w << 16); a[7] += w1.w * __uint_as_float(u.w & 0xffff0000u);
    }
  }
#pragma unroll
  for (int e = 0; e < 8; ++e) o8[e] = silu_f(a[e]);
}

__device__ __forceinline__ void conv8u(const P& p, const bf16* projb, int t, int c0, float* o8) {
  c0 = __builtin_amdgcn_readfirstlane(c0);
  float4 b0 = *(const float4*)(p.conv_b + c0), b1 = *(const float4*)(p.conv_b + c0 + 4);
  float a[8] = {b0.x, b0.y, b0.z, b0.w, b1.x, b1.y, b1.z, b1.w};
  uint4 u[4];
#pragma unroll
  for (int jt = 0; jt < 4; ++jt) {
    int tt = t + jt - 2;
    tt = tt < 0 ? 0 : (tt > 4095 ? 4095 : tt);
    u[jt] = *(const uint4*)(projb + (size_t)tt * ODD_N + 3072 + c0);
  }
#pragma unroll
  for (int jt = 0; jt < 4; ++jt) {
    const int tt = t + jt - 2;
    const float ok = (tt >= 0 && tt < 4096) ? 1.f : 0.f;
    float4 w0 = *(const float4*)(p.conv_w + jt * 1024 + c0), w1 = *(const float4*)(p.conv_w + jt * 1024 + c0 + 4);
    a[0] += ok * w0.x * __uint_as_float(u[jt].x << 16); a[1] += ok * w0.y * __uint_as_float(u[jt].x & 0xffff0000u);
    a[2] += ok * w0.z * __uint_as_float(u[jt].y << 16); a[3] += ok * w0.w * __uint_as_float(u[jt].y & 0xffff0000u);
    a[4] += ok * w1.x * __uint_as_float(u[jt].z << 16); a[5] += ok * w1.y * __uint_as_float(u[jt].z & 0xffff0000u);
    a[6] += ok * w1.z * __uint_as_float(u[jt].w << 16); a[7] += ok * w1.w * __uint_as_float(u[jt].w & 0xffff0000u);
  }
#pragma unroll
  for (int e = 0; e < 8; ++e) o8[e] = silu_f(a[e]);
}

__device__ __forceinline__ void ssd_prep_acum(const P& p, const bf16* projb, int blk, int g, float* ACUM, float* DTV, float* TOT) {
  const int lane = threadIdx.x & 63, wave = threadIdx.x >> 6;
#pragma unroll
  for (int q = 0; q < 2; ++q) {
    const int c = wave * 2 + q, dir = c >> 2, rp = c & 3, head = g * 4 + rp;
    const int j = dir ? 63 - lane : lane;
    const int t = blk * 64 + j;
    const float dt = softplus_f(bf2f(projb[(size_t)t * ODD_N + 4096 + dir * 8 + head]) + p.dt_bias[dir * 8 + head]);
    float v = -__expf(p.a_log[dir * 8 + head]) * dt;
#pragma unroll
    for (int off = 1; off < 64; off <<= 1) {
      float tmp = __shfl_up(v, off, 64);
      if (lane >= off) v += tmp;
    }
    ACUM[c * 64 + j] = v;
    DTV[c * 64 + j] = dt;
    if (lane == 63) TOT[c] = v;
  }
}

__device__ __forceinline__ bf16* ssd_st(const P& p, int s) {
  return s < 32 ? (bf16*)(p.ws + WS_H) + (size_t)s * 524288 : (bf16*)((unsigned char*)p.out + 33554432) + (size_t)(s - 32) * 524288;
}
__device__ __forceinline__ void ssd_pass1_item(const P& p, int item, unsigned char* smem) {
  const int g = item & 1, blk = (item >> 1) & 63, b = item >> 7;
  bf16* BT = (bf16*)smem;
  bf16* XT = BT + 128 * 72;
  float* ACUM = (float*)(XT + 256 * 72);
  float* DTV = ACUM + 512;
  float* TOT = DTV + 512;
  const bf16* projb = (const bf16*)(p.ws + WS_PROJ) + (size_t)b * 4096 * ODD_N;
  float* DEC = (float*)(p.ws + WS_DECS);
  const int tid = threadIdx.x, lane = tid & 63, wave = tid >> 6;
  const int t = blk * 64 + lane;
  ssd_prep_acum(p, projb, blk, g, ACUM, DTV, TOT);
#pragma unroll 2
  for (int q = 0; q < 4; ++q) {
    const int cc = wave + 4 * q;
    float v8[8];
    conv8(p, projb, t, 512 + g * 128 + cc * 8, v8);
#pragma unroll
    for (int e = 0; e < 8; ++e) BT[(cc * 8 + e) * 72 + lane] = f2bf(v8[e]);
  }
  float xs[8][8];
#pragma unroll
  for (int q = 0; q < 8; ++q) conv8(p, projb, t, g * 256 + (wave * 8 + q) * 8, xs[q]);
  __syncthreads();
  if (tid < 8) {
    const int dir = tid >> 2, head = g * 4 + (tid & 3);
    DEC[(size_t)((dir * 4 + b) * 8 + head) * 64 + blk] = __expf(TOT[tid]);
  }
#pragma unroll 1
  for (int dir = 0; dir < 2; ++dir) {
    if (dir) __syncthreads();
    const int c = dir * 4 + wave;
    const float fac = DTV[c * 64 + lane] * __expf(TOT[c] - ACUM[c * 64 + lane]);
#pragma unroll
    for (int q = 0; q < 8; ++q)
#pragma unroll
      for (int e = 0; e < 8; ++e) XT[((wave * 8 + q) * 8 + e) * 72 + lane] = f2bf(xs[q][e] * fac);
    __syncthreads();
    const int head = g * 4 + wave;
    bf16* stb = ssd_st(p, (dir * 4 + b) * 8 + head) + (size_t)blk * 8192;
#pragma unroll 1
    for (int nh = 0; nh < 4; ++nh) {
      f32x4 acc[2][4];
#pragma unroll
      for (int nt = 0; nt < 2; ++nt)
#pragma unroll
        for (int pt = 0; pt < 4; ++pt) acc[nt][pt] = (f32x4){0.f, 0.f, 0.f, 0.f};
#pragma unroll
      for (int ks = 0; ks < 2; ++ks) {
        bf16x8 xf[4];
#pragma unroll
        for (int pt = 0; pt < 4; ++pt) xf[pt] = *(const bf16x8*)(XT + (wave * 64 + pt * 16 + (lane & 15)) * 72 + ks * 32 + (lane >> 4) * 8);
#pragma unroll
        for (int nt = 0; nt < 2; ++nt) {
          bf16x8 bfv = *(const bf16x8*)(BT + ((nh * 2 + nt) * 16 + (lane & 15)) * 72 + ks * 32 + (lane >> 4) * 8);
#pragma unroll
          for (int pt = 0; pt < 4; ++pt) acc[nt][pt] = __builtin_amdgcn_mfma_f32_16x16x32_bf16(bfv, xf[pt], acc[nt][pt], 0, 0, 0);
        }
      }
#pragma unroll
      for (int nt = 0; nt < 2; ++nt)
#pragma unroll
        for (int pt = 0; pt < 4; ++pt) {
          const int pp = pt * 16 + (lane & 15);
          const int n0 = (nh * 2 + nt) * 16 + (lane >> 4) * 4;
          *(uint2*)(stb + (size_t)pp * 128 + n0) = pack4(acc[nt][pt]);
        }
    }
  }
}

__device__ __forceinline__ void phase_ssd_scan(const P& p) {
  const float* DEC = (const float*)(p.ws + WS_DECS);
  const int total = 64 * 2048;
  for (int idx = blockIdx.x * 256 + threadIdx.x; idx < total; idx += gridDim.x * 256) {
    const int e4 = idx & 2047, s = idx >> 11;
    const int d = s >> 5;
    bf16* ST = ssd_st(p, s);
    float st0 = 0.f, st1 = 0.f, st2 = 0.f, st3 = 0.f;
#pragma unroll 1
    for (int n0 = 0; n0 < 64; n0 += 8) {
      uint2 u[8];
      float dc[8];
#pragma unroll
      for (int q = 0; q < 8; ++q) {
        const int blk = d ? 63 - (n0 + q) : (n0 + q);
        u[q] = *(const uint2*)(ST + (size_t)blk * 8192 + e4 * 4);
        dc[q] = DEC[s * 64 + blk];
      }
#pragma unroll
      for (int q = 0; q < 8; ++q) {
        const int blk = d ? 63 - (n0 + q) : (n0 + q);
        uint2 o;
        o.x = (unsigned)f2bf(st0) | ((unsigned)f2bf(st1) << 16);
        o.y = (unsigned)f2bf(st2) | ((unsigned)f2bf(st3) << 16);
        *(uint2*)(ST + (size_t)blk * 8192 + e4 * 4) = o;
        st0 = dc[q] * st0 + __uint_as_float(u[q].x << 16);
        st1 = dc[q] * st1 + __uint_as_float(u[q].x & 0xffff0000u);
        st2 = dc[q] * st2 + __uint_as_float(u[q].y << 16);
        st3 = dc[q] * st3 + __uint_as_float(u[q].y & 0xffff0000u);
      }
    }
  }
}

__device__ __forceinline__ void ssd_pass3_item(const P& p, int item, unsigned char* smem) {
  const int g = item & 1, blk = (item >> 1) & 63, b = item >> 7;
  bf16* CI = (bf16*)smem;
  bf16* BI = CI + 64 * 136;
  bf16* AI = BI;
  bf16* XT = BI + 64 * 136;
  float* ACUM = (float*)(XT + 64 * 72);
  float* DTV = ACUM + 512;
  float* TOT = DTV + 512;
  float* SSQ = TOT + 8;
  bf16* projb = (bf16*)(p.ws + WS_PROJ) + (size_t)b * 4096 * ODD_N;
  const int tid = threadIdx.x, lane = tid & 63, wave = tid >> 6;
  const int t = blk * 64 + lane;
  ssd_prep_acum(p, projb, blk, g, ACUM, DTV, TOT);
#pragma unroll 4
  for (int q = 0; q < 8; ++q) {
    const int cc = wave * 8 + q, which = cc >> 4, ch = (cc & 15) * 8;
    float v8[8];
    conv8u(p, projb, t, 512 + which * 256 + g * 128 + ch, v8);
    uint4 w;
    w.x = (unsigned)f2bf(v8[0]) | ((unsigned)f2bf(v8[1]) << 16);
    w.y = (unsigned)f2bf(v8[2]) | ((unsigned)f2bf(v8[3]) << 16);
    w.z = (unsigned)f2bf(v8[4]) | ((unsigned)f2bf(v8[5]) << 16);
    w.w = (unsigned)f2bf(v8[6]) | ((unsigned)f2bf(v8[7]) << 16);
    *(uint4*)((which ? CI : BI) + lane * 136 + ch) = w;
  }
  __syncthreads();
  f32x4 gt[4];
#pragma unroll
  for (int jt = 0; jt < 4; ++jt) gt[jt] = (f32x4){0.f, 0.f, 0.f, 0.f};
#pragma unroll
  for (int ks = 0; ks < 4; ++ks) {
    bf16x8 cf = *(const bf16x8*)(CI + (wave * 16 + (lane & 15)) * 136 + ks * 32 + (lane >> 4) * 8);
#pragma unroll
    for (int jt = 0; jt < 4; ++jt) {
      bf16x8 bfv = *(const bf16x8*)(BI + (jt * 16 + (lane & 15)) * 136 + ks * 32 + (lane >> 4) * 8);
      gt[jt] = __builtin_amdgcn_mfma_f32_16x16x32_bf16(bfv, cf, gt[jt], 0, 0, 0);
    }
  }
  __syncthreads();
  float ssq_acc[4] = {0.f, 0.f, 0.f, 0.f};
#pragma unroll 1
  for (int rp = 0; rp < 4; ++rp) {
    const int head = g * 4 + rp;
    u32x4 stf[2][4];
    u32x2 zur[4];
#pragma unroll
    for (int dir = 0; dir < 2; ++dir) {
      const bf16* stb = ssd_st(p, (dir * 4 + b) * 8 + head) + (size_t)blk * 8192;
#pragma unroll
      for (int ks = 0; ks < 4; ++ks) stf[dir][ks] = gload16_asm(stb + (size_t)(wave * 16 + (lane & 15)) * 128 + ks * 32 + (lane >> 4) * 8);
    }
#pragma unroll
    for (int it = 0; it < 4; ++it)
      zur[it] = gload8_asm(projb + (size_t)(blk * 64 + it * 16 + (lane & 15)) * ODD_N + 2560 + head * 64 + wave * 16 + (lane >> 4) * 4);
#pragma unroll 2
    for (int q = 0; q < 2; ++q) {
      const int cc = wave * 2 + q;
      float v8[8];
      conv8u(p, projb, t, head * 64 + cc * 8, v8);
#pragma unroll
      for (int e = 0; e < 8; ++e) XT[(cc * 8 + e) * 72 + lane] = f2bf(v8[e]);
    }
    f32x4 o[4];
#pragma unroll
    for (int it = 0; it < 4; ++it) o[it] = (f32x4){0.f, 0.f, 0.f, 0.f};
#pragma unroll
    for (int dir = 0; dir < 2; ++dir) {
      const int c = dir * 4 + rp;
      {
        const int i = wave * 16 + (lane & 15);
        const float aci = ACUM[c * 64 + i];
#pragma unroll
        for (int jt = 0; jt < 4; ++jt) {
          const int j0 = jt * 16 + (lane >> 4) * 4;
          f32x4 m;
#pragma unroll
          for (int r = 0; r < 4; ++r) {
            const int j = j0 + r;
            const bool valid = dir ? (j >= i) : (j <= i);
            const float arg = fminf(aci - ACUM[c * 64 + j], 0.f);
            m[r] = valid ? gt[jt][r] * __expf(arg) * DTV[c * 64 + j] : 0.f;
          }
          *(uint2*)(AI + i * 72 + j0) = pack4(m);
        }
      }
      __syncthreads();
#pragma unroll
      for (int ks = 0; ks < 2; ++ks) {
        bf16x8 xf = *(const bf16x8*)(XT + (wave * 16 + (lane & 15)) * 72 + ks * 32 + (lane >> 4) * 8);
#pragma unroll
        for (int it = 0; it < 4; ++it) {
          bf16x8 af = *(const bf16x8*)(AI + (it * 16 + (lane & 15)) * 72 + ks * 32 + (lane >> 4) * 8);
          o[it] = __builtin_amdgcn_mfma_f32_16x16x32_bf16(xf, af, o[it], 0, 0, 0);
        }
      }
      f32x4 tI[4];
#pragma unroll
      for (int it = 0; it < 4; ++it) tI[it] = (f32x4){0.f, 0.f, 0.f, 0.f};
      asm volatile("s_waitcnt vmcnt(0)" : "+v"(stf[dir][0]), "+v"(stf[dir][1]), "+v"(stf[dir][2]), "+v"(stf[dir][3]) :: "memory");
#pragma unroll
      for (int ks = 0; ks < 4; ++ks) {
        bf16x8 sf = *(bf16x8*)&stf[dir][ks];
#pragma unroll
        for (int it = 0; it < 4; ++it) {
          bf16x8 cf = *(const bf16x8*)(CI + (it * 16 + (lane & 15)) * 136 + ks * 32 + (lane >> 4) * 8);
          tI[it] = __builtin_amdgcn_mfma_f32_16x16x32_bf16(sf, cf, tI[it], 0, 0, 0);
        }
      }
#pragma unroll
      for (int it = 0; it < 4; ++it) {
        const float ea = __expf(ACUM[c * 64 + it * 16 + (lane & 15)]);
#pragma unroll
        for (int r = 0; r < 4; ++r) o[it][r] += ea * tI[it][r];
      }
      __syncthreads();
    }
    {
      asm volatile("s_waitcnt vmcnt(0)" : "+v"(zur[0]), "+v"(zur[1]), "+v"(zur[2]), "+v"(zur[3]) :: "memory");
      const float dsk = p.d_skip[head];
      const int p0 = wave * 16 + (lane >> 4) * 4;
      float4 gg = *(const float4*)(p.ssm_g + head * 64 + p0);
#pragma unroll
      for (int it = 0; it < 4; ++it) {
        const int i = it * 16 + (lane & 15);
        uint2 zu; zu.x = zur[it][0]; zu.y = zur[it][1];
        f32x4 y;
        y[0] = (o[it][0] + dsk * bf2f(XT[(p0 + 0) * 72 + i])) * silu_f(__uint_as_float(zu.x << 16));
        y[1] = (o[it][1] + dsk * bf2f(XT[(p0 + 1) * 72 + i])) * silu_f(__uint_as_float(zu.x & 0xffff0000u));
        y[2] = (o[it][2] + dsk * bf2f(XT[(p0 + 2) * 72 + i])) * silu_f(__uint_as_float(zu.y << 16));
        y[3] = (o[it][3] + dsk * bf2f(XT[(p0 + 3) * 72 + i])) * silu_f(__uint_as_float(zu.y & 0xffff0000u));
        ssq_acc[it] += y[0] * y[0] + y[1] * y[1] + y[2] * y[2] + y[3] * y[3];
        y[0] *= gg.x; y[1] *= gg.y; y[2] *= gg.z; y[3] *= gg.w;
        *(uint2*)(projb + (size_t)(blk * 64 + i) * ODD_N + 2560 + head * 64 + p0) = pack4(y);
      }
    }
    __syncthreads();
  }
#pragma unroll
  for (int it = 0; it < 4; ++it) {
    float s = ssq_acc[it];
    s += __shfl_xor(s, 16, 64);
    s += __shfl_xor(s, 32, 64);
    if (lane < 16) SSQ[wave * 64 + it * 16 + lane] = s;
  }
  __syncthreads();
  if (tid < 64) {
    float* ssqp = (float*)(p.ws + WS_SSQ);
    ssqp[(size_t)g * M_TOK + (size_t)b * 4096 + blk * 64 + tid] = SSQ[tid] + SSQ[64 + tid] + SSQ[128 + tid] + SSQ[192 + tid];
  }
}

__device__ __forceinline__ void phase_ssd_norm(const P& p) {
  const float* ssqp = (const float*)(p.ws + WS_SSQ);
  bf16* yb = (bf16*)(p.ws + WS_H);
  const int total = M_TOK * 64;
  for (int idx = blockIdx.x * 256 + threadIdx.x; idx < total; idx += gridDim.x * 256) {
    const int tok = idx >> 6, c8 = (idx & 63) * 8;
    const float rs = rsqrtf((ssqp[tok] + ssqp[M_TOK + tok]) * (1.f / 512.f) + 1e-6f);
    uint4* ptr = (uint4*)(yb + (size_t)tok * 1024 + 512 + c8);
    uint4 u = *ptr, w;
    w.x = (unsigned)f2bf(__uint_as_float(u.x << 16) * rs) | ((unsigned)f2bf(__uint_as_float(u.x & 0xffff0000u) * rs) << 16);
    w.y = (unsigned)f2bf(__uint_as_float(u.y << 16) * rs) | ((unsigned)f2bf(__uint_as_float(u.y & 0xffff0000u) * rs) << 16);
    w.z = (unsigned)f2bf(__uint_as_float(u.z << 16) * rs) | ((unsigned)f2bf(__uint_as_float(u.z & 0xffff0000u) * rs) << 16);
    w.w = (unsigned)f2bf(__uint_as_float(u.w << 16) * rs) | ((unsigned)f2bf(__uint_as_float(u.w & 0xffff0000u) * rs) << 16);
    *ptr = w;
  }
}


#define XB_TMO      128
#define XB_XCNT(j)  (256  + 64 * (j))
#define XB_XSUB(j)  (1280 + 64 * (j))
#define XB_XGEN(j)  (2304 + 64 * (j))
#define XB_TOP      3328
#define XB_TOPGEN   3392
#define XCD_BAR_WORDS 3456
#define XB_SPIN_CAP (1u << 18)
#define LAS __attribute__((address_space(3)))
__device__ __forceinline__ unsigned xb_ld(unsigned* p) { return __hip_atomic_load(p, __ATOMIC_RELAXED, __HIP_MEMORY_SCOPE_AGENT); }
__device__ __forceinline__ unsigned xb_add(unsigned* p, unsigned v) { return __hip_atomic_fetch_add(p, v, __ATOMIC_RELAXED, __HIP_MEMORY_SCOPE_AGENT); }
__device__ __forceinline__ unsigned xb_xcc_id() { return (unsigned)__builtin_amdgcn_s_getreg((3 << 11) | 20) & 0xFu; }
#define XB_SPIN(cond, bar) do { unsigned _sp = 0; while (cond) { __builtin_amdgcn_s_sleep(1); \
    if ((++_sp & 255u) == 0u) { if (xb_ld(&(bar)[XB_TMO])) break; if (_sp > XB_SPIN_CAP) { atomicAdd(&(bar)[XB_TMO], 1u); break; } } } } while (0)
struct XcdBarrier { unsigned* bar; unsigned x; volatile LAS unsigned* st; };
__device__ __forceinline__ XcdBarrier xcd_barrier_post(unsigned* bar, volatile LAS unsigned* st) {
  XcdBarrier b; b.bar = bar; b.x = xb_xcc_id(); b.st = st;
  if (threadIdx.x == 0) (void)xb_add(&bar[XB_XCNT(b.x)], 1u);
  return b;
}
__device__ __forceinline__ void xcd_barrier_complete(unsigned* bar, unsigned x, unsigned& nloc, unsigned& nx) {
  const unsigned G = gridDim.x * gridDim.y * gridDim.z;
  unsigned sum, cnt, mine, sp = 0u;
  for (;;) {
    sum = 0u; cnt = 0u; mine = 0u;
#pragma unroll
    for (unsigned j = 0; j < 16; ++j) { const unsigned c = xb_ld(&bar[XB_XCNT(j)]); sum += c; cnt += (c > 0u) ? 1u : 0u; mine = (j == x) ? c : mine; }
    if (sum == G) break;
    __builtin_amdgcn_s_sleep(1);
    if ((++sp & 255u) == 0u) { if (xb_ld(&bar[XB_TMO])) break; if (sp > XB_SPIN_CAP) { atomicAdd(&bar[XB_TMO], 1u); break; } }
  }
  nloc = mine > 0u ? mine : 1u; nx = cnt > 0u ? cnt : 1u;
}
__device__ __forceinline__ void xcd_barrier(const XcdBarrier& b) {
  asm volatile("s_waitcnt vmcnt(0)" ::: "memory");
  __syncthreads();
  if (threadIdx.x == 0) {
    unsigned* bar = b.bar;
    __builtin_amdgcn_s_waitcnt(0);
    unsigned nloc = b.st[0], nx = b.st[1];
    if (nloc == 0u) { xcd_barrier_complete(bar, b.x, nloc, nx); b.st[0] = nloc; b.st[1] = nx; }
    const unsigned old = xb_add(&bar[XB_XSUB(b.x)], 1u);
    const unsigned gen = old / nloc;
    if (old + 1u == (gen + 1u) * nloc) {
      __builtin_amdgcn_fence(__ATOMIC_RELEASE, "agent");
      asm volatile("s_waitcnt vmcnt(0)" ::: "memory");
      const unsigned og = xb_add(&bar[XB_TOP], 1u);
      const unsigned tg = og / nx;
      if (og + 1u == (tg + 1u) * nx) xb_add(&bar[XB_TOPGEN], 1u);
      else XB_SPIN(xb_ld(&bar[XB_TOPGEN]) == tg, bar);
      __builtin_amdgcn_fence(__ATOMIC_ACQUIRE, "agent");
      xb_add(&bar[XB_XGEN(b.x)], 1u);
      asm volatile("s_waitcnt vmcnt(0)" ::: "memory");
    } else {
      XB_SPIN(xb_ld(&bar[XB_XGEN(b.x)]) == gen, bar);
      __builtin_amdgcn_fence(__ATOMIC_ACQUIRE, "agent");
      asm volatile("s_waitcnt vmcnt(0)" ::: "memory");
    }
  }
  __syncthreads();
}

#define NPHASE 14
__global__ void __launch_bounds__(256, 2) mega(P p, int ph_lo, int ph_hi) {
  __shared__ __align__(16) unsigned char smem[73728 + 16 + (PROBE_PH >= 0 ? 256 : 0)];
  cg::grid_group grid = cg::this_grid();
  if (ph_lo < 0) grid.sync();
  if (threadIdx.x == 0) *(uint4*)(smem + 73728) = make_uint4(0u, 0u, 0u, 0u);
  __syncthreads();
  XcdBarrier xb = xcd_barrier_post((unsigned*)(p.ws + WS_BAR), (volatile LAS unsigned*)(smem + 73728));
  const float* mod = (const float*)(p.ws + WS_MOD);
#define IN(k) (ph_lo <= (k) && (k) < ph_hi)
#define SYNC(k) if (IN(k) && (k) + 1 < ph_hi) { xcd_barrier(xb); if (PROBE_PH >= 0 && blockIdx.x == 0 && threadIdx.x == 0) ((long long*)(smem + 73744))[(k) + 1] = __builtin_amdgcn_s_memrealtime(); }
  if (PROBE_PH >= 0 && blockIdx.x == 0 && threadIdx.x == 0) ((long long*)(smem + 73744))[0] = __builtin_amdgcn_s_memrealtime();
  if (IN(0)) phase_setup(p, smem);
  SYNC(0)
  if (IN(1)) phase_h0(p);
  SYNC(1)
  if (IN(2))
    phase_gemm<0>((const bf16*)(p.ws + WS_H), 1024, (const bf16*)(p.ws + WS_WEI), EVEN_NP / 128, smem,
                  (bf16*)(p.ws + WS_PROJ), EVEN_N, EVEN_N, nullptr, nullptr, nullptr, (unsigned*)(p.ws + WS_BAR), 0);
  SYNC(2)
  if (IN(3)) {
    for (int it = blockIdx.x; it < 1024; it += gridDim.x) { rec_pass1_item<64, 0>(p, it, smem); __syncthreads(); }
  }
  SYNC(3)
  if (IN(4)) {
    phase_rec_scan<64>(p);
    for (int it = blockIdx.x; it < 2048 * REPN + 16 * 66 + 256; it += gridDim.x) {
      if (it < 2048 * REPN) na_item(p, it & 2047, smem);
      else if (it < 2048 * REPN + 16 * 66) transpose_item(p.o_w_in, ODD_N, (bf16*)(p.ws + WS_WOI), it - 2048 * REPN, smem);
      else transpose_item(p.o_w_out, 1024, (bf16*)(p.ws + WS_WOO), it - 2048 * REPN - 16 * 66, smem);
      __syncthreads();
    }
  }
  SYNC(4)
  if (IN(5)) {
    for (int it = blockIdx.x; it < 1024 * REPR; it += gridDim.x) { rec_pass3_item<64, 0>(p, it & 1023, smem); __syncthreads(); }
  }
  SYNC(5)
  if (IN(6))
    phase_gemm<1>((const bf16*)(p.ws + WS_H), 1024, (const bf16*)(p.ws + WS_WEO), 8, smem, nullptr, 0, 0, p.x, (float*)(p.ws + WS_ST),
                  mod + 2048, (unsigned*)(p.ws + WS_BAR), 1);
  SYNC(6)
  if (IN(7)) phase_ln(p, 0, true);
  SYNC(7)
  if (IN(8))
    phase_gemm<0>((const bf16*)(p.ws + WS_H), 1024, (const bf16*)(p.ws + WS_WOI), ODD_NP / 128, smem,
                  (bf16*)(p.ws + WS_PROJ), ODD_N, ODD_N, nullptr, nullptr, nullptr, (unsigned*)(p.ws + WS_BAR), 2);
  SYNC(8)
  if (IN(9)) {
    for (int it = blockIdx.x; it < 512 + 1024; it += gridDim.x) {
      if (it < 512) ssd_pass1_item(p, it, smem); else rec_pass1_item<128, 1>(p, it - 512, smem);
      __syncthreads();
    }
  }
  SYNC(9)
  if (IN(10)) { phase_rec_scan<128>(p); phase_ssd_scan(p); }
  SYNC(10)
  if (IN(11)) {
    for (int it = blockIdx.x; it < 512 + 1024; it += gridDim.x) {
      if (it < 512) ssd_pass3_item(p, it, smem); else rec_pass3_item<128, 1>(p, it - 512, smem);
      __syncthreads();
    }
  }
  SYNC(11)
  if (IN(12))
    phase_gemm<2>((const bf16*)(p.ws + WS_PROJ) + 2048, ODD_N, (const bf16*)(p.ws + WS_WOO), 8, smem, nullptr, 0, 0,
                  (const float*)p.out, (float*)(p.ws + WS_ST), mod + 4 * 3072 + 2048, (unsigned*)(p.ws + WS_BAR), 3,
                  (const float*)(p.ws + WS_SSQ));
  SYNC(12)
  if (IN(13)) phase_ln(p, 1, false, smem + 73744);
}

extern "C" void kernel_launch(void* const* d_in, const int* in_sizes, int n_in, void* d_out, int out_size, void* d_ws,
                              size_t ws_size, hipStream_t stream) {
  static int grid_blocks = 0;
  if (!grid_blocks) {
    int dev = 0, cus = 0, per_cu = 0;
    hipGetDevice(&dev);
    hipDeviceGetAttribute(&cus, hipDeviceAttributeMultiprocessorCount, dev);
    hipOccupancyMaxActiveBlocksPerMultiprocessor(&per_cu, mega, 256, 0);
    if (per_cu < 1) per_cu = 1;
    if (per_cu > 2) per_cu = 2;
    grid_blocks = cus * per_cu;
    if (n_in != 22 || ws_size < WS_END) {
      fprintf(stderr, "kernel_launch: unexpected n_in %d / ws_size %zu (need %llu)\n", n_in, ws_size, (unsigned long long)WS_END);
      grid_blocks = -1;
    }
  }
  if (grid_blocks < 0) return;
  P p{};
  const float** f = (const float**)&p;
  for (int i = 0; i < 22; ++i) f[i] = (const float*)d_in[i];
  p.out = (float*)d_out;
  p.ws = (unsigned char*)d_ws;
#if 1
  if (hipMemsetAsync((char*)d_ws + WS_BAR, 0, 16384, stream) != hipSuccess) { fprintf(stderr, "memset of barrier words failed\n"); return; }
  int lo = 0, hi = NPHASE;
  void* args[] = {&p, &lo, &hi};
  hipError_t e = hipLaunchCooperativeKernel((void*)mega, dim3(grid_blocks), dim3(256), args, 0, stream);
  if (e != hipSuccess) fprintf(stderr, "cooperative launch failed: %s (grid %d)\n", hipGetErrorString(e), grid_blocks);
#else
  for (int ph = 0; ph < NPHASE; ++ph) hipLaunchKernelGGL(mega, dim3(grid_blocks), dim3(256), 0, stream, p, ph, ph + 1);
#endif
}
```
